# Optimizing an MI355X kernel written in HIP

```python
import math
import jax, jax.numpy as jnp
from jax import lax
import numpy as np

D_MODEL = 1024
BATCH = 4
SEQ = 4096
DEPTH = 2

HEAD_DIM = 64
N_MIXERS = 4
N_HEADS_PER_MIXER = D_MODEL // (N_MIXERS * HEAD_DIM)
GROUP_W = N_HEADS_PER_MIXER * HEAD_DIM
MLA_NOPE_DIM = 64
MLA_ROPE_DIM = 32
MLA_V_DIM = HEAD_DIM
MLA_Q_LORA = D_MODEL // 4
MLA_KV_LORA = D_MODEL // 8
MIX_W = N_MIXERS * GROUP_W
IN_SIZES = (GROUP_W, GROUP_W, GROUP_W, N_HEADS_PER_MIXER,
            GROUP_W, GROUP_W, GROUP_W,
            GROUP_W, GROUP_W, GROUP_W,
            MLA_Q_LORA, MLA_KV_LORA, MLA_ROPE_DIM,
            MIX_W)
IN_W = sum(IN_SIZES)
Q_BLOCK = 128
MOBA_BLOCK = 256
MOBA_TOPK = 3
MOBA_Q_CHUNK = 64
DIL_PATTERNS = ((128, 1), (512, 4), (2048, 16))
DIL_BLOCK = 128
N_BUCKETS = 32
MAX_DISTANCE = 2048
N_BIAS_HEADS = 2 * N_HEADS_PER_MIXER
PLE_DIM = 256
ROPE_THETA = 10000.0
EPS = 1e-6
NEG = -1e30

kernel_name = "hymba_fox_moba_dilated_mla_block"


def rms_norm(x, g):
    xf = x.astype(jnp.float32)
    y = xf * lax.rsqrt(jnp.mean(xf * xf, axis=-1, keepdims=True) + EPS)
    return y * g.astype(jnp.float32)


def to_heads(t, n):
    b, s, _ = t.shape
    return t.reshape(b, s, n, -1).transpose(0, 2, 1, 3)


def from_heads(o):
    b, h, s, d = o.shape
    return o.transpose(0, 2, 1, 3).reshape(b, s, h * d)


def t5_bucket(dist):
    dist = jnp.maximum(dist, 0)
    max_exact = N_BUCKETS // 2
    d_f = jnp.maximum(dist, 1).astype(jnp.float32)
    large = max_exact + (jnp.log(d_f / max_exact) / math.log(MAX_DISTANCE / max_exact)
                         * (N_BUCKETS - max_exact)).astype(jnp.int32)
    large = jnp.minimum(large, N_BUCKETS - 1)
    return jnp.where(dist < max_exact, dist, large)


def rotary(x, pos):
    half = MLA_ROPE_DIM // 2
    inv = 1.0 / (ROPE_THETA ** (jnp.arange(half, dtype=jnp.float32) * 2.0 / MLA_ROPE_DIM))
    ang = pos.astype(jnp.float32)[:, None] * inv[None, :]
    cos, sin = jnp.cos(ang), jnp.sin(ang)
    x1, x2 = x[..., :half], x[..., half:]
    return jnp.concatenate([x1 * cos - x2 * sin, x1 * sin + x2 * cos], axis=-1)


def causal_block_attention(q, k, v, log_f_cum=None):
    b, h, s, _ = q.shape
    key_pos = jnp.arange(s)

    def one_block(i):
        start = i * Q_BLOCK
        qb = lax.dynamic_slice_in_dim(q, start, Q_BLOCK, axis=2)
        sc = jnp.einsum('bhqd,bhkd->bhqk', qb, k)
        if log_f_cum is not None:
            cq = lax.dynamic_slice_in_dim(log_f_cum, start, Q_BLOCK, axis=2)
            sc = sc + cq[..., :, None] - log_f_cum[..., None, :]
        q_pos = start + jnp.arange(Q_BLOCK)
        sc = jnp.where(key_pos[None, :] <= q_pos[:, None], sc, NEG)
        pr = jax.nn.softmax(sc, axis=-1)
        return jnp.einsum('bhqk,bhkd->bhqd', pr, v)

    out = lax.map(one_block, jnp.arange(s // Q_BLOCK))
    return out.transpose(1, 2, 0, 3, 4).reshape(b, h, s, -1)


def moba_attention(q, k, v, bias_table):
    b, h, s, hd = q.shape
    n_kb = -(-s // MOBA_BLOCK)
    pad = n_kb * MOBA_BLOCK - s
    kp = jnp.pad(k, ((0, 0), (0, 0), (0, pad), (0, 0))).reshape(b, h, n_kb, MOBA_BLOCK, hd)
    vp = jnp.pad(v, ((0, 0), (0, 0), (0, pad), (0, 0))).reshape(b, h, n_kb, MOBA_BLOCK, hd)
    k_mean = kp.mean(axis=3)
    n_sel = min(MOBA_TOPK, n_kb)
    bi = jnp.arange(b)[:, None, None, None]
    hi = jnp.arange(h)[None, :, None, None]
    blk_ids = jnp.arange(n_kb)
    in_blk = jnp.arange(MOBA_BLOCK)

    def one_chunk(i):
        start = i * MOBA_Q_CHUNK
        qc = lax.dynamic_slice_in_dim(q, start, MOBA_Q_CHUNK, axis=2)
        q_pos = start + jnp.arange(MOBA_Q_CHUNK)
        own = start // MOBA_BLOCK
        gate = jnp.einsum('bhqd,bhnd->bhqn', qc, k_mean)
        gate = jnp.where(blk_ids < own, gate, NEG)
        _, sel = lax.top_k(gate, n_sel)
        sel_ok = sel < own
        k_sel = kp[bi, hi, sel]
        v_sel = vp[bi, hi, sel]
        s_sel = jnp.einsum('bhqd,bhqnkd->bhqnk', qc, k_sel)
        pos_sel = sel[..., None] * MOBA_BLOCK + in_blk
        b_sel = bias_table[hi[..., None], t5_bucket(q_pos[:, None, None] - pos_sel)]
        s_sel = jnp.where(sel_ok[..., None], s_sel + b_sel, NEG)
        s_sel = s_sel.reshape(b, h, MOBA_Q_CHUNK, n_sel * MOBA_BLOCK)
        k_own = lax.dynamic_index_in_dim(kp, own, axis=2, keepdims=False)
        v_own = lax.dynamic_index_in_dim(vp, own, axis=2, keepdims=False)
        rel_own = q_pos[:, None] - (own * MOBA_BLOCK + in_blk)[None, :]
        s_own = jnp.einsum('bhqd,bhkd->bhqk', qc, k_own) + bias_table[:, t5_bucket(rel_own)]
        s_own = jnp.where(rel_own >= 0, s_own, NEG)
        pr = jax.nn.softmax(jnp.concatenate([s_sel, s_own], axis=-1), axis=-1)
        p_sel = pr[..., :n_sel * MOBA_BLOCK].reshape(b, h, MOBA_Q_CHUNK, n_sel, MOBA_BLOCK)
        p_own = pr[..., n_sel * MOBA_BLOCK:]
        return (jnp.einsum('bhqnk,bhqnkd->bhqd', p_sel, v_sel)
                + jnp.einsum('bhqk,bhkd->bhqd', p_own, v_own))

    out = lax.map(one_chunk, jnp.arange(s // MOBA_Q_CHUNK))
    return out.transpose(1, 2, 0, 3, 4).reshape(b, h, s, hd)


def dilated_branch(q, k, v, bias_table, window, dil):
    b, h, s, hd = q.shape
    L = s // dil
    n_back = window // dil
    nb = -(-L // DIL_BLOCK)
    Lp = nb * DIL_BLOCK

    def sub(t):
        return t.reshape(b, h, L, dil, hd).transpose(0, 1, 3, 2, 4)

    qs = jnp.pad(sub(q), ((0, 0), (0, 0), (0, 0), (0, Lp - L), (0, 0))).reshape(b, h, dil, nb, DIL_BLOCK, hd)

    def band(t):
        tp = jnp.pad(sub(t), ((0, 0), (0, 0), (0, 0), (DIL_BLOCK, Lp - L), (0, 0)))
        tp = tp.reshape(b, h, dil, nb + 1, DIL_BLOCK, hd)
        return jnp.concatenate([tp[:, :, :, :-1], tp[:, :, :, 1:]], axis=4)

    kb, vb = band(k), band(v)
    qi = jnp.arange(DIL_BLOCK)[:, None]
    kj = jnp.arange(2 * DIL_BLOCK)[None, :]
    rel = qi + DIL_BLOCK - kj
    key_idx = jnp.arange(nb)[:, None, None] * DIL_BLOCK - DIL_BLOCK + kj
    valid = (rel >= 0) & (rel <= n_back) & (key_idx >= 0)
    bias = bias_table[:, t5_bucket(rel * dil)]
    sc = jnp.einsum('bhrnqd,bhrnkd->bhrnqk', qs, kb) + bias[None, :, None, None]
    sc = jnp.where(valid, sc, NEG)
    lse = jax.nn.logsumexp(sc, axis=-1)
    pr = jnp.exp(sc - lse[..., None])
    o = jnp.einsum('bhrnqk,bhrnkd->bhrnqd', pr, vb)
    o = o.reshape(b, h, dil, Lp, hd)[:, :, :, :L].transpose(0, 1, 3, 2, 4).reshape(b, h, s, hd)
    lse = lse.reshape(b, h, dil, Lp)[..., :L].transpose(0, 1, 3, 2).reshape(b, h, s)
    return o, lse


def dilated_attention(q, k, v, bias_table):
    outs, lses = [], []
    for window, dil in DIL_PATTERNS:
        o, l = dilated_branch(q, k, v, bias_table, window, dil)
        outs.append(o)
        lses.append(l)
    w = jax.nn.softmax(jnp.stack(lses, axis=0), axis=0)
    return jnp.sum(w[..., None] * jnp.stack(outs, axis=0), axis=0)


def split_points():
    pts, acc = [], 0
    for sz in IN_SIZES[:-1]:
        acc += sz
        pts.append(acc)
    return pts


def hybrid_layer(x, p_i, ln_g, w_in, b_forget, qk_gain, mla_q_norm, mla_kv_norm,
                 mla_nope_gain, mla_rope_gain, w_uq, w_ukv, w_out, rel_bias,
                 ple_norm_g, w_ple_gate, w_ple_proj):
    b, s, _ = x.shape
    nh = N_HEADS_PER_MIXER
    scale = HEAD_DIM ** -0.5
    h = rms_norm(x, ln_g)
    proj = h @ w_in
    (fq, fk, fv, ff, mq, mk, mv, dq, dk, dv, cq, ckv, kr, gate) = jnp.split(proj, split_points(), axis=-1)

    q = rms_norm(to_heads(fq, nh), qk_gain[0]) * scale
    k = rms_norm(to_heads(fk, nh), qk_gain[1])
    log_f = jax.nn.log_sigmoid((ff + b_forget).astype(jnp.float32)).transpose(0, 2, 1)
    o_fox = causal_block_attention(q, k, to_heads(fv, nh), jnp.cumsum(log_f, axis=-1))

    q = rms_norm(to_heads(mq, nh), qk_gain[2]) * scale
    k = rms_norm(to_heads(mk, nh), qk_gain[3])
    o_moba = moba_attention(q, k, to_heads(mv, nh), rel_bias[:, :nh].T)

    q = rms_norm(to_heads(dq, nh), qk_gain[4]) * scale
    k = rms_norm(to_heads(dk, nh), qk_gain[5])
    o_dil = dilated_attention(q, k, to_heads(dv, nh), rel_bias[:, nh:].T)

    pos = jnp.arange(s)
    qf = to_heads(rms_norm(cq, mla_q_norm) @ w_uq, nh)
    kvf = to_heads(rms_norm(ckv, mla_kv_norm) @ w_ukv, nh)
    q_nope = rms_norm(qf[..., :MLA_NOPE_DIM], mla_nope_gain[0])
    q_rope = rotary(rms_norm(qf[..., MLA_NOPE_DIM:], mla_rope_gain[0]), pos)
    k_nope = rms_norm(kvf[..., :MLA_NOPE_DIM], mla_nope_gain[1])
    v_mla = kvf[..., MLA_NOPE_DIM:]
    k_rope = rotary(rms_norm(kr, mla_rope_gain[1]), pos)[:, None]
    q_m = jnp.concatenate([q_nope, q_rope], axis=-1) * (MLA_NOPE_DIM + MLA_ROPE_DIM) ** -0.5
    k_m = jnp.concatenate([k_nope, jnp.broadcast_to(k_rope, (b, nh, s, MLA_ROPE_DIM))], axis=-1)
    o_mla = causal_block_attention(q_m, k_m, v_mla)

    mix = jnp.concatenate([from_heads(o_fox), from_heads(o_moba), from_heads(o_dil), from_heads(o_mla)], axis=-1)
    x = x + (mix * jax.nn.silu(gate)) @ w_out

    ple_gate = jax.nn.sigmoid(rms_norm(x, ple_norm_g) @ w_ple_gate)
    return x + ple_gate * (p_i @ w_ple_proj)


def setup_inputs(seed: int = 0) -> dict:
    key = jax.random.key(seed)
    ks = jax.random.split(key, 18)

    def nrm(k, shape, sc):
        return sc * jax.random.normal(k, shape, jnp.float32)

    nh = N_HEADS_PER_MIXER
    return {
        "x": nrm(ks[0], (BATCH, SEQ, D_MODEL), 1.0),
        "p": nrm(ks[1], (DEPTH, BATCH, SEQ, PLE_DIM), 1.0),
        "ln_g": 1.0 + nrm(ks[2], (DEPTH, D_MODEL), 0.05),
        "w_in": nrm(ks[3], (DEPTH, D_MODEL, IN_W), D_MODEL ** -0.5),
        "b_forget": 2.0 + nrm(ks[4], (DEPTH, nh), 0.5),
        "qk_gain": 1.0 + nrm(ks[5], (DEPTH, 6, HEAD_DIM), 0.05),
        "mla_q_norm": 1.0 + nrm(ks[6], (DEPTH, MLA_Q_LORA), 0.05),
        "mla_kv_norm": 1.0 + nrm(ks[7], (DEPTH, MLA_KV_LORA), 0.05),
        "mla_nope_gain": 1.0 + nrm(ks[8], (DEPTH, 2, MLA_NOPE_DIM), 0.05),
        "mla_rope_gain": 1.0 + nrm(ks[9], (DEPTH, 2, MLA_ROPE_DIM), 0.05),
        "w_uq": nrm(ks[10], (DEPTH, MLA_Q_LORA, nh * (MLA_NOPE_DIM + MLA_ROPE_DIM)), MLA_Q_LORA ** -0.5),
        "w_ukv": nrm(ks[11], (DEPTH, MLA_KV_LORA, nh * (MLA_NOPE_DIM + MLA_V_DIM)), MLA_KV_LORA ** -0.5),
        "w_out": nrm(ks[12], (DEPTH, MIX_W, D_MODEL), MIX_W ** -0.5),
        "rel_bias": nrm(ks[13], (N_BUCKETS, N_BIAS_HEADS), 0.2),
        "ple_norm_g": 1.0 + nrm(ks[14], (DEPTH, D_MODEL), 0.05),
        "w_ple_gate": nrm(ks[15], (DEPTH, D_MODEL, D_MODEL), D_MODEL ** -0.5),
        "w_ple_proj": nrm(ks[16], (DEPTH, PLE_DIM, D_MODEL), PLE_DIM ** -0.5),
    }


def reference(x, p, ln_g, w_in, b_forget, qk_gain, mla_q_norm, mla_kv_norm,
              mla_nope_gain, mla_rope_gain, w_uq, w_ukv, w_out, rel_bias,
              ple_norm_g, w_ple_gate, w_ple_proj):
    for i in range(DEPTH):
        x = hybrid_layer(x, p[i], ln_g[i], w_in[i], b_forget[i], qk_gain[i],
                         mla_q_norm[i], mla_kv_norm[i], mla_nope_gain[i], mla_rope_gain[i],
                         w_uq[i], w_ukv[i], w_out[i], rel_bias,
                         ple_norm_g[i], w_ple_gate[i], w_ple_proj[i])
    return x
```

```cpp
#include <hip/hip_runtime.h>
#include <hip/hip_cooperative_groups.h>
#include <cstdint>
#include <cstdio>

#ifndef ONE_LAUNCH
#define ONE_LAUNCH 0
#endif

namespace {
#define DEVINL __device__ __forceinline__
typedef unsigned short bf16_t;
typedef short bf16x8 __attribute__((ext_vector_type(8)));
typedef float f32x4 __attribute__((ext_vector_type(4)));
typedef unsigned u32x2 __attribute__((ext_vector_type(2)));
typedef unsigned u32x4 __attribute__((ext_vector_type(4)));

constexpr int NB = 4, SEQ = 4096, DM = 1024, NT = NB * SEQ, NH = 4, NBH = NB * NH;
constexpr int INW = 3748, NP1 = 3840;
constexpr float EPS = 1e-6f, LOG2E = 1.4426950408889634f;
constexpr float SC_Q = 0.125f * LOG2E;
constexpr float SC_MLA = 0.10206207261596575f * LOG2E;
constexpr int NTHREADS = 256;

constexpr size_t SZ_WT_IN = (size_t)NP1 * 1024 * 2, SZ_WT_UQ = 384 * 256 * 2, SZ_WT_UKV = 512 * 128 * 2, SZ_WT_SQ = 1024 * 1024 * 2, SZ_WT_PP = 1024 * 256 * 2;
constexpr size_t OFF_WT_IN = 0;
constexpr size_t OFF_WT_UQ = OFF_WT_IN + 2 * SZ_WT_IN;
constexpr size_t OFF_WT_UKV = OFF_WT_UQ + 2 * SZ_WT_UQ;
constexpr size_t OFF_WT_OUT = OFF_WT_UKV + 2 * SZ_WT_UKV;
constexpr size_t OFF_WT_PG = OFF_WT_OUT + 2 * SZ_WT_SQ;
constexpr size_t OFF_WT_PP = OFF_WT_PG + 2 * SZ_WT_SQ;
constexpr size_t OFF_LUT = OFF_WT_PP + 2 * SZ_WT_PP;
constexpr size_t OFF_ROPE = OFF_LUT + 8 * 4096 * 4;
constexpr size_t OFF_H = OFF_ROPE + 4096 * 16 * 8;
constexpr size_t SZ_HEADBUF = (size_t)NT * 256 * 2;
constexpr size_t OFF_QKV = OFF_H + (size_t)NT * 1024 * 2;
constexpr size_t OFF_CQ = OFF_QKV + 9 * SZ_HEADBUF;
constexpr size_t OFF_CKV = OFF_CQ + (size_t)NT * 256 * 2;
constexpr size_t OFF_CQSS = OFF_CKV + (size_t)NT * 128 * 2;
constexpr size_t OFF_CKVSS = OFF_CQSS + (size_t)NT * 4 * 4;
constexpr size_t OFF_LOGF = OFF_CKVSS + (size_t)NT * 2 * 4;
constexpr size_t OFF_KMEAN = OFF_LOGF + (size_t)NBH * SEQ * 4;
constexpr size_t OFF_PB = OFF_KMEAN + (size_t)NBH * 16 * 64 * 4;
constexpr size_t OFF_X = OFF_PB + (size_t)NT * 256 * 2;
constexpr size_t WS_NEED = OFF_X + (size_t)NT * 1024 * 4;
constexpr size_t OOFF_G = 0;
constexpr size_t OOFF_QM = (size_t)NT * 1024 * 2;
constexpr size_t OOFF_KM = OOFF_QM + (size_t)NBH * SEQ * 96 * 2;
constexpr size_t OOFF_VM = OOFF_KM + (size_t)NBH * SEQ * 96 * 2;

struct Params {
    const float *x, *p, *ln_g, *w_in, *b_forget, *qk_gain, *mla_q_norm, *mla_kv_norm, *mla_nope_gain, *mla_rope_gain, *w_uq, *w_ukv, *w_out, *rel_bias, *ple_norm_g, *w_ple_gate, *w_ple_proj;
    float* out;
    char* ws;
};

DEVINL bf16_t f2bf(float f) { unsigned u = __float_as_uint(f); u += 0x7fffu + ((u >> 16) & 1u); return (bf16_t)(u >> 16); }
DEVINL float bf2f(bf16_t h) { return __uint_as_float(((unsigned)h) << 16); }
DEVINL unsigned pack2(float a, float b) { return (unsigned)f2bf(a) | ((unsigned)f2bf(b) << 16); }
DEVINL float bflo(unsigned u) { return __uint_as_float(u << 16); }
DEVINL float bfhi(unsigned u) { return __uint_as_float(u & 0xffff0000u); }

__device__ __constant__ float ROPE_INV[16] = {1.0f, 0.5623413251903491f, 0.31622776601683794f, 0.1778279410038923f, 0.1f, 0.05623413251903491f, 0.03162277660168379f, 0.01778279410038923f,
                                              0.01f, 0.005623413251903491f, 0.0031622776601683794f, 0.0017782794100389228f, 0.001f, 0.0005623413251903491f, 0.00031622776601683794f, 0.00017782794100389227f};

DEVINL int t5_bucket(int d) {
    if (d < 16) return d;
    int b = 16;
    b += (d >= 22); b += (d >= 30); b += (d >= 40); b += (d >= 54); b += (d >= 73); b += (d >= 99); b += (d >= 134); b += (d >= 182);
    b += (d >= 246); b += (d >= 332); b += (d >= 450); b += (d >= 609); b += (d >= 825); b += (d >= 1117); b += (d >= 1513);
    return b;
}

DEVINL int map_w_in(int n) { return n < 768 ? n : (n < 2720 ? n + 4 : (n < 2724 ? n - 2720 + 768 : (n < 2816 ? -1 : n - 92))); }
DEVINL int map_w_uq(int n) { if (n < 256) return (n >> 6) * 96 + (n & 63); const int r = n - 256; return (r >> 5) * 96 + 64 + (r & 31); }

DEVINL void transpose_tile(const float* src, int Nsrc, bf16_t* dst, int K, int tn, int tk, int mode, const float* fold, float* tile  ) {
    const int tid = threadIdx.x, c = tid & 63, rb = tid >> 6, n0 = tn * 64, k0 = tk * 64;
    const int n = n0 + c, oc = mode == 1 ? map_w_in(n) : (mode == 2 ? map_w_uq(n) : n);
#pragma unroll 4
    for (int i = 0; i < 16; ++i) { const int kk = rb + 4 * i; float v = 0.f; if (oc >= 0) { v = src[(size_t)(k0 + kk) * Nsrc + oc]; if (fold) v *= fold[k0 + kk]; } tile[kk * 65 + c] = v; }
    __syncthreads();
#pragma unroll 4
    for (int i = 0; i < 16; ++i) { const int nn = rb + 4 * i; dst[(size_t)(n0 + nn) * K + k0 + c] = f2bf(tile[c * 65 + nn]); }
    __syncthreads();
}

constexpr int PREP_T_IN = 60 * 16, PREP_T_UQ = 6 * 4, PREP_T_UKV = 8 * 2, PREP_T_SQ = 16 * 16, PREP_T_PP = 16 * 4;
constexpr int PREP_PER_LAYER = PREP_T_IN + PREP_T_UQ + PREP_T_UKV + 2 * PREP_T_SQ + PREP_T_PP;
constexpr int PREP_LUT_UNITS = 8 * 4096 / 256, PREP_ROPE_UNITS = 4096 * 16 / 256;
constexpr int PREP_UNITS = 2 * PREP_PER_LAYER + PREP_LUT_UNITS + PREP_ROPE_UNITS;

DEVINL void phase_prep(const Params& P, char* smem) {
    float* tile = (float*)smem;
    for (int u = blockIdx.x; u < PREP_UNITS; u += gridDim.x) {
        if (u < 2 * PREP_PER_LAYER) {
            const int l = u / PREP_PER_LAYER; int r = u % PREP_PER_LAYER;
            if (r < PREP_T_IN) { transpose_tile(P.w_in + (size_t)l * 1024 * INW, INW, (bf16_t*)(P.ws + OFF_WT_IN + l * SZ_WT_IN), 1024, r % 60, r / 60, 1, nullptr, tile); continue; }
            r -= PREP_T_IN;
            if (r < PREP_T_UQ) { transpose_tile(P.w_uq + (size_t)l * 256 * 384, 384, (bf16_t*)(P.ws + OFF_WT_UQ + l * SZ_WT_UQ), 256, r % 6, r / 6, 2, P.mla_q_norm + l * 256, tile); continue; }
            r -= PREP_T_UQ;
            if (r < PREP_T_UKV) { transpose_tile(P.w_ukv + (size_t)l * 128 * 512, 512, (bf16_t*)(P.ws + OFF_WT_UKV + l * SZ_WT_UKV), 128, r % 8, r / 8, 0, P.mla_kv_norm + l * 128, tile); continue; }
            r -= PREP_T_UKV;
            if (r < PREP_T_SQ) { transpose_tile(P.w_out + (size_t)l * 1024 * 1024, 1024, (bf16_t*)(P.ws + OFF_WT_OUT + l * SZ_WT_SQ), 1024, r % 16, r / 16, 0, nullptr, tile); continue; }
            r -= PREP_T_SQ;
            if (r < PREP_T_SQ) { transpose_tile(P.w_ple_gate + (size_t)l * 1024 * 1024, 1024, (bf16_t*)(P.ws + OFF_WT_PG + l * SZ_WT_SQ), 1024, r % 16, r / 16, 0, nullptr, tile); continue; }
            r -= PREP_T_SQ;
            transpose_tile(P.w_ple_proj + (size_t)l * 256 * 1024, 1024, (bf16_t*)(P.ws + OFF_WT_PP + l * SZ_WT_PP), 256, r % 16, r / 16, 0, nullptr, tile);
        } else if (u < 2 * PREP_PER_LAYER + PREP_LUT_UNITS) {
            const int e = (u - 2 * PREP_PER_LAYER) * 256 + threadIdx.x, hh = e >> 12, d = e & 4095;
            ((float*)(P.ws + OFF_LUT))[e] = P.rel_bias[t5_bucket(d) * 8 + hh] * LOG2E;
        } else {
            const int e = (u - 2 * PREP_PER_LAYER - PREP_LUT_UNITS) * 256 + threadIdx.x, pos = e >> 4, i = e & 15;
            const double rev = (double)pos * (double)ROPE_INV[i] * 0.15915494309189535; const float fr = (float)(rev - floor(rev));
            ((float2*)(P.ws + OFF_ROPE))[e] = make_float2(__builtin_amdgcn_cosf(fr), __builtin_amdgcn_sinf(fr));
        }
    }
}

DEVINL float wave_sum(float v) {
#pragma unroll
    for (int o = 32; o > 0; o >>= 1) v += __shfl_xor(v, o);
    return v;
}
DEVINL void phase_rms(const float* src, const float* g, bf16_t* dst, const float* psrc, bf16_t* pb) {
    const int wid = threadIdx.x >> 6, lane = threadIdx.x & 63;
    for (int u = blockIdx.x; u < NT / 4; u += gridDim.x) {
        const int row = u * 4 + wid; const float* xr = src + (size_t)row * DM;
        f32x4 v[4]; float ss = 0.f;
#pragma unroll
        for (int i = 0; i < 4; ++i) { v[i] = *(const f32x4*)(xr + i * 256 + lane * 4); ss += v[i][0] * v[i][0] + v[i][1] * v[i][1] + v[i][2] * v[i][2] + v[i][3] * v[i][3]; }
        ss = wave_sum(ss); const float r = rsqrtf(ss * (1.0f / DM) + EPS);
#pragma unroll
        for (int i = 0; i < 4; ++i) { const f32x4 gg = *(const f32x4*)(g + i * 256 + lane * 4); u32x2 w; w.x = pack2(v[i][0] * r * gg[0], v[i][1] * r * gg[1]); w.y = pack2(v[i][2] * r * gg[2], v[i][3] * r * gg[3]);
            *(u32x2*)(dst + (size_t)row * DM + i * 256 + lane * 4) = w; }
        if (psrc) { const f32x4 pv = *(const f32x4*)(psrc + (size_t)row * 256 + lane * 4); u32x2 w; w.x = pack2(pv[0], pv[1]); w.y = pack2(pv[2], pv[3]); *(u32x2*)(pb + (size_t)row * 256 + lane * 4) = w; }
    }
}

constexpr int GST = 40;
template <class Epi>
DEVINL void gemm_phase(const bf16_t* A, const bf16_t* Bt, int M, int N, int K, const Epi& epi, char* smem) {
    bf16_t* As = (bf16_t*)smem; bf16_t* Bs = As + 128 * GST;
    const int tid = threadIdx.x, wid = tid >> 6, lane = tid & 63, wr = wid >> 1, wc = wid & 1, fr = lane & 15, fq = lane >> 4;
    const int ntm = M / 128, ntn = N / 128, nk = K / 32;
    const int lr = tid >> 2, lc = (tid & 3) * 8;
    for (int tile = blockIdx.x; tile < ntm * ntn; tile += gridDim.x) {
        const int tm = tile % ntm, tn = tile / ntm;
        const bf16_t* Ag = A + (size_t)(tm * 128 + lr) * K + lc; const bf16_t* Bg = Bt + (size_t)(tn * 128 + lr) * K + lc;
        f32x4 acc[4][4];
#pragma unroll
        for (int m = 0; m < 4; ++m)
#pragma unroll
            for (int n = 0; n < 4; ++n) acc[m][n] = (f32x4){0.f, 0.f, 0.f, 0.f};
        u32x4 ra0 = *(const u32x4*)Ag, ra1 = *(const u32x4*)(Ag + (size_t)64 * K), rb0 = *(const u32x4*)Bg, rb1 = *(const u32x4*)(Bg + (size_t)64 * K);
        for (int kt = 0; kt < nk; ++kt) {
            __syncthreads();
            *(u32x4*)(As + lr * GST + lc) = ra0; *(u32x4*)(As + (lr + 64) * GST + lc) = ra1; *(u32x4*)(Bs + lr * GST + lc) = rb0; *(u32x4*)(Bs + (lr + 64) * GST + lc) = rb1;
            __syncthreads();
            if (kt + 1 < nk) { const int ko = (kt + 1) * 32; ra0 = *(const u32x4*)(Ag + ko); ra1 = *(const u32x4*)(Ag + (size_t)64 * K + ko); rb0 = *(const u32x4*)(Bg + ko); rb1 = *(const u32x4*)(Bg + (size_t)64 * K + ko); }
            bf16x8 af[4], bfr[4];
#pragma unroll
            for (int m = 0; m < 4; ++m) af[m] = *(const bf16x8*)(As + (wr * 64 + m * 16 + fr) * GST + fq * 8);
#pragma unroll
            for (int n = 0; n < 4; ++n) bfr[n] = *(const bf16x8*)(Bs + (wc * 64 + n * 16 + fr) * GST + fq * 8);
#pragma unroll
            for (int m = 0; m < 4; ++m)
#pragma unroll
                for (int n = 0; n < 4; ++n) acc[m][n] = __builtin_amdgcn_mfma_f32_16x16x32_bf16(bfr[n], af[m], acc[m][n], 0, 0, 0);
        }
        epi(acc, tm * 128 + wr * 64, tn * 2 + wc, fr, fq);
    }
}

DEVINL float quad_sum(float v) { v += __shfl_xor(v, 16); v += __shfl_xor(v, 32); return v; }
DEVINL void store4bf(bf16_t* p, float a, float b, float c, float d) { u32x2 w; w.x = pack2(a, b); w.y = pack2(c, d); *(u32x2*)p = w; }
DEVINL float log_sigmoid(float z) { return fminf(z, 0.f) - log1pf(__expf(-fabsf(z))); }

struct EpiIn {
    Params P; int l;
    DEVINL void operator()(f32x4 (&acc)[4][4], int row0, int chunk, int fr, int fq) const {
        char* ws = P.ws; char* ob = (char*)P.out;
        if (chunk < 36) {
            const int g = chunk >> 2, h = chunk & 3, role = g % 3, mix = g / 3;
            bf16_t* dst = (bf16_t*)(ws + OFF_QKV + (size_t)g * SZ_HEADBUF);
            const float* gain = P.qk_gain + ((size_t)l * 6 + 2 * mix + (role == 1 ? 1 : 0)) * 64;
#pragma unroll
            for (int m = 0; m < 4; ++m) {
                const int t = row0 + 16 * m + fr, b = t >> 12, s = t & 4095; bf16_t* d = dst + ((size_t)(b * 4 + h) * SEQ + s) * 64 + 4 * fq;
                float r = 1.f;
                if (role != 2) { float ss = 0.f;
#pragma unroll
                    for (int n = 0; n < 4; ++n) ss += acc[m][n][0] * acc[m][n][0] + acc[m][n][1] * acc[m][n][1] + acc[m][n][2] * acc[m][n][2] + acc[m][n][3] * acc[m][n][3];
                    ss = quad_sum(ss); r = rsqrtf(ss * (1.0f / 64.0f) + EPS) * (role == 0 ? SC_Q : 1.0f); }
#pragma unroll
                for (int n = 0; n < 4; ++n) { f32x4 gg = (f32x4){1.f, 1.f, 1.f, 1.f}; if (role != 2) gg = *(const f32x4*)(gain + 16 * n + 4 * fq);
                    store4bf(d + 16 * n, acc[m][n][0] * r * gg[0], acc[m][n][1] * r * gg[1], acc[m][n][2] * r * gg[2], acc[m][n][3] * r * gg[3]); }
            }
        } else if (chunk < 42) {
            const bool isq = chunk < 40; const int c = isq ? chunk - 36 : chunk - 40;
            bf16_t* dst = isq ? (bf16_t*)(ws + OFF_CQ) : (bf16_t*)(ws + OFF_CKV); const int ld = isq ? 256 : 128;
            float* ssp = isq ? (float*)(ws + OFF_CQSS) : (float*)(ws + OFF_CKVSS); const int nss = isq ? 4 : 2;
#pragma unroll
            for (int m = 0; m < 4; ++m) {
                const int t = row0 + 16 * m + fr; float ss = 0.f;
#pragma unroll
                for (int n = 0; n < 4; ++n) { ss += acc[m][n][0] * acc[m][n][0] + acc[m][n][1] * acc[m][n][1] + acc[m][n][2] * acc[m][n][2] + acc[m][n][3] * acc[m][n][3];
                    store4bf(dst + (size_t)t * ld + c * 64 + 16 * n + 4 * fq, acc[m][n][0], acc[m][n][1], acc[m][n][2], acc[m][n][3]); }
                ss = quad_sum(ss); if (fq == 0) ssp[(size_t)t * nss + c] = ss;
            }
        } else if (chunk == 42) {
            const float* gr = P.mla_rope_gain + ((size_t)l * 2 + 1) * 32; const float2* rope = (const float2*)(ws + OFF_ROPE);
            bf16_t* km = (bf16_t*)(ob + OOFF_KM); float* logf_ = (float*)(ws + OFF_LOGF);
            const f32x4 g1 = *(const f32x4*)(gr + 4 * fq), g2 = *(const f32x4*)(gr + 16 + 4 * fq); const f32x4 bfv = *(const f32x4*)(P.b_forget + l * 4);
#pragma unroll
            for (int m = 0; m < 4; ++m) {
                const int t = row0 + 16 * m + fr, b = t >> 12, s = t & 4095;
                float ss = 0.f;
#pragma unroll
                for (int n = 0; n < 2; ++n) ss += acc[m][n][0] * acc[m][n][0] + acc[m][n][1] * acc[m][n][1] + acc[m][n][2] * acc[m][n][2] + acc[m][n][3] * acc[m][n][3];
                ss = quad_sum(ss); const float r = rsqrtf(ss * (1.0f / 32.0f) + EPS);
                float o1[4], o2[4];
#pragma unroll
                for (int j = 0; j < 4; ++j) { const float2 cs = rope[s * 16 + 4 * fq + j]; const float x1 = acc[m][0][j] * r * g1[j], x2 = acc[m][1][j] * r * g2[j]; o1[j] = x1 * cs.x - x2 * cs.y; o2[j] = x1 * cs.y + x2 * cs.x; }
#pragma unroll
                for (int h = 0; h < 4; ++h) { bf16_t* d = km + ((size_t)(b * 4 + h) * SEQ + s) * 96 + 64 + 4 * fq; store4bf(d, o1[0], o1[1], o1[2], o1[3]); store4bf(d + 16, o2[0], o2[1], o2[2], o2[3]); }
                if (fq == 0) {
#pragma unroll
                    for (int j = 0; j < 4; ++j) logf_[(size_t)(b * 4 + j) * SEQ + s] = log_sigmoid(acc[m][2][j] + bfv[j]) * LOG2E;
                }
            }
        } else if (chunk >= 44) {
            bf16_t* G = (bf16_t*)(ob + OOFF_G); const int c0 = (chunk - 44) * 64;
#pragma unroll
            for (int m = 0; m < 4; ++m) { const int t = row0 + 16 * m + fr;
#pragma unroll
                for (int n = 0; n < 4; ++n) { float o[4];
#pragma unroll
                    for (int j = 0; j < 4; ++j) { const float z = acc[m][n][j]; o[j] = z / (1.0f + __expf(-z)); }
                    store4bf(G + (size_t)t * DM + c0 + 16 * n + 4 * fq, o[0], o[1], o[2], o[3]); } }
        }
    }
};

struct EpiUq {
    Params P; int l;
    DEVINL void operator()(f32x4 (&acc)[4][4], int row0, int chunk, int fr, int fq) const {
        const float* cqss = (const float*)(P.ws + OFF_CQSS); bf16_t* qm = (bf16_t*)((char*)P.out + OOFF_QM); const float2* rope = (const float2*)(P.ws + OFF_ROPE);
#pragma unroll
        for (int m = 0; m < 4; ++m) {
            const int t = row0 + 16 * m + fr, b = t >> 12, s = t & 4095; const f32x4 pss = *(const f32x4*)(cqss + (size_t)t * 4);
            const float rt = rsqrtf((pss[0] + pss[1] + pss[2] + pss[3]) * (1.0f / 256.0f) + EPS);
            if (chunk < 4) {
                const float* gain = P.mla_nope_gain + ((size_t)l * 2 + 0) * 64; float ss = 0.f;
#pragma unroll
                for (int n = 0; n < 4; ++n) { acc[m][n] = acc[m][n] * rt; ss += acc[m][n][0] * acc[m][n][0] + acc[m][n][1] * acc[m][n][1] + acc[m][n][2] * acc[m][n][2] + acc[m][n][3] * acc[m][n][3]; }
                ss = quad_sum(ss); const float r = rsqrtf(ss * (1.0f / 64.0f) + EPS) * SC_MLA; bf16_t* d = qm + ((size_t)(b * 4 + chunk) * SEQ + s) * 96 + 4 * fq;
#pragma unroll
                for (int n = 0; n < 4; ++n) { const f32x4 gg = *(const f32x4*)(gain + 16 * n + 4 * fq); store4bf(d + 16 * n, acc[m][n][0] * r * gg[0], acc[m][n][1] * r * gg[1], acc[m][n][2] * r * gg[2], acc[m][n][3] * r * gg[3]); }
            } else {
                const float* gr = P.mla_rope_gain + ((size_t)l * 2 + 0) * 32; const f32x4 g1 = *(const f32x4*)(gr + 4 * fq), g2 = *(const f32x4*)(gr + 16 + 4 * fq);
#pragma unroll
                for (int hh = 0; hh < 2; ++hh) {
                    const int h = (chunk - 4) * 2 + hh; float ss = 0.f;
#pragma unroll
                    for (int n = 0; n < 2; ++n) { acc[m][2 * hh + n] = acc[m][2 * hh + n] * rt; const f32x4 a = acc[m][2 * hh + n]; ss += a[0] * a[0] + a[1] * a[1] + a[2] * a[2] + a[3] * a[3]; }
                    ss = quad_sum(ss); const float r = rsqrtf(ss * (1.0f / 32.0f) + EPS);
                    float o1[4], o2[4];
#pragma unroll
                    for (int j = 0; j < 4; ++j) { const float2 cs = rope[s * 16 + 4 * fq + j]; const float x1 = acc[m][2 * hh][j] * r * g1[j], x2 = acc[m][2 * hh + 1][j] * r * g2[j];
                        o1[j] = (x1 * cs.x - x2 * cs.y) * SC_MLA; o2[j] = (x1 * cs.y + x2 * cs.x) * SC_MLA; }
                    bf16_t* d = qm + ((size_t)(b * 4 + h) * SEQ + s) * 96 + 64 + 4 * fq; store4bf(d, o1[0], o1[1], o1[2], o1[3]); store4bf(d + 16, o2[0], o2[1], o2[2], o2[3]);
                }
            }
        }
    }
};
struct EpiUkv {
    Params P; int l;
    DEVINL void operator()(f32x4 (&acc)[4][4], int row0, int chunk, int fr, int fq) const {
        const float* ckvss = (const float*)(P.ws + OFF_CKVSS); bf16_t* km = (bf16_t*)((char*)P.out + OOFF_KM); bf16_t* vm = (bf16_t*)((char*)P.out + OOFF_VM);
        const int h = chunk >> 1; const bool isk = (chunk & 1) == 0; const float* gain = P.mla_nope_gain + ((size_t)l * 2 + 1) * 64;
#pragma unroll
        for (int m = 0; m < 4; ++m) {
            const int t = row0 + 16 * m + fr, b = t >> 12, s = t & 4095; const float rt = rsqrtf((ckvss[(size_t)t * 2] + ckvss[(size_t)t * 2 + 1]) * (1.0f / 128.0f) + EPS);
            float ss = 0.f;
#pragma unroll
            for (int n = 0; n < 4; ++n) { acc[m][n] = acc[m][n] * rt; ss += acc[m][n][0] * acc[m][n][0] + acc[m][n][1] * acc[m][n][1] + acc[m][n][2] * acc[m][n][2] + acc[m][n][3] * acc[m][n][3]; }
            if (isk) { ss = quad_sum(ss); const float r = rsqrtf(ss * (1.0f / 64.0f) + EPS); bf16_t* d = km + ((size_t)(b * 4 + h) * SEQ + s) * 96 + 4 * fq;
#pragma unroll
                for (int n = 0; n < 4; ++n) { const f32x4 gg = *(const f32x4*)(gain + 16 * n + 4 * fq); store4bf(d + 16 * n, acc[m][n][0] * r * gg[0], acc[m][n][1] * r * gg[1], acc[m][n][2] * r * gg[2], acc[m][n][3] * r * gg[3]); }
            } else { bf16_t* d = vm + ((size_t)(b * 4 + h) * SEQ + s) * 64 + 4 * fq;
#pragma unroll
                for (int n = 0; n < 4; ++n) store4bf(d + 16 * n, acc[m][n][0], acc[m][n][1], acc[m][n][2], acc[m][n][3]); }
        }
    }
};
struct EpiResid { const float* base; float* out;
    DEVINL void operator()(f32x4 (&acc)[4][4], int row0, int chunk, int fr, int fq) const {
#pragma unroll
        for (int m = 0; m < 4; ++m) { const size_t o = (size_t)(row0 + 16 * m + fr) * DM + chunk * 64 + 4 * fq;
#pragma unroll
            for (int n = 0; n < 4; ++n) { const f32x4 bv = *(const f32x4*)(base + o + 16 * n); *(f32x4*)(out + o + 16 * n) = bv + acc[m][n]; } } } };
struct EpiStore { float* out;
    DEVINL void operator()(f32x4 (&acc)[4][4], int row0, int chunk, int fr, int fq) const {
#pragma unroll
        for (int m = 0; m < 4; ++m) { const size_t o = (size_t)(row0 + 16 * m + fr) * DM + chunk * 64 + 4 * fq;
#pragma unroll
            for (int n = 0; n < 4; ++n) *(f32x4*)(out + o + 16 * n) = acc[m][n]; } } };
struct EpiPle { const float* xa; const float* pp; float* out;
    DEVINL void operator()(f32x4 (&acc)[4][4], int row0, int chunk, int fr, int fq) const {
#pragma unroll
        for (int m = 0; m < 4; ++m) { const size_t o = (size_t)(row0 + 16 * m + fr) * DM + chunk * 64 + 4 * fq;
#pragma unroll
            for (int n = 0; n < 4; ++n) { const f32x4 xv = *(const f32x4*)(xa + o + 16 * n), pv = *(const f32x4*)(pp + o + 16 * n); f32x4 r;
#pragma unroll
                for (int j = 0; j < 4; ++j) r[j] = xv[j] + pv[j] / (1.0f + __expf(-acc[m][n][j]));
                *(f32x4*)(out + o + 16 * n) = r; } } } };

DEVINL void phase_kmean(const Params& P, char* smem) {
    float* red = (float*)smem; const bf16_t* K = (const bf16_t*)(P.ws + OFF_QKV + 4 * SZ_HEADBUF); float* km = (float*)(P.ws + OFF_KMEAN);
    const int tid = threadIdx.x, d = tid & 63, part = tid >> 6;
    for (int u = blockIdx.x; u < NBH * 16; u += gridDim.x) {
        const bf16_t* kp = K + ((size_t)(u >> 4) * SEQ + (u & 15) * 256 + part * 64) * 64 + d; float s = 0.f;
        for (int i = 0; i < 64; ++i) s += bf2f(kp[(size_t)i * 64]);
        red[tid] = s; __syncthreads();
        if (part == 0) km[(size_t)u * 64 + d] = (red[d] + red[64 + d] + red[128 + d] + red[192 + d]) * (1.0f / 256.0f);
        __syncthreads();
    }
}

template <int DK> DEVINL float dot_row(const float (&q)[DK], const bf16_t* krow) {
    float s = 0.f;
#pragma unroll
    for (int c = 0; c < DK / 8; ++c) { const u32x4 w = *(const u32x4*)(krow + c * 8);
        s += q[c * 8 + 0] * bflo(w.x) + q[c * 8 + 1] * bfhi(w.x) + q[c * 8 + 2] * bflo(w.y) + q[c * 8 + 3] * bfhi(w.y) + q[c * 8 + 4] * bflo(w.z) + q[c * 8 + 5] * bfhi(w.z) + q[c * 8 + 6] * bflo(w.w) + q[c * 8 + 7] * bfhi(w.w); }
    return s;
}
DEVINL void acc_row(float (&o)[64], float p, const bf16_t* vrow) {
#pragma unroll
    for (int c = 0; c < 8; ++c) { const u32x4 w = *(const u32x4*)(vrow + c * 8);
        o[c * 8 + 0] += p * bflo(w.x); o[c * 8 + 1] += p * bfhi(w.x); o[c * 8 + 2] += p * bflo(w.y); o[c * 8 + 3] += p * bfhi(w.y); o[c * 8 + 4] += p * bflo(w.z); o[c * 8 + 5] += p * bfhi(w.z); o[c * 8 + 6] += p * bflo(w.w); o[c * 8 + 7] += p * bfhi(w.w); }
}
DEVINL void online_update(float s, float& m, float& lsum, float (&o)[64], const bf16_t* vrow) {
    if (s > m) { const float sc = exp2f(m - s); lsum *= sc;
#pragma unroll
        for (int d = 0; d < 64; ++d) o[d] *= sc;
        m = s; }
    const float p = exp2f(s - m); lsum += p; acc_row(o, p, vrow);
}
DEVINL void write_mix(const Params& P, int b, int h, int s, int colbase, float lsum, const float (&o)[64]) {
    const size_t t = (size_t)b * SEQ + s; const bf16_t* G = (const bf16_t*)((const char*)P.out + OOFF_G) + t * DM + colbase + h * 64; bf16_t* A2 = (bf16_t*)(P.ws + OFF_H) + t * DM + colbase + h * 64;
    const float inv = 1.0f / lsum;
#pragma unroll
    for (int c = 0; c < 8; ++c) { const u32x4 g = *(const u32x4*)(G + c * 8); u32x4 w;
        w.x = pack2(o[c * 8 + 0] * inv * bflo(g.x), o[c * 8 + 1] * inv * bfhi(g.x)); w.y = pack2(o[c * 8 + 2] * inv * bflo(g.y), o[c * 8 + 3] * inv * bfhi(g.y));
        w.z = pack2(o[c * 8 + 4] * inv * bflo(g.z), o[c * 8 + 5] * inv * bfhi(g.z)); w.w = pack2(o[c * 8 + 6] * inv * bflo(g.w), o[c * 8 + 7] * inv * bfhi(g.w));
        *(u32x4*)(A2 + c * 8) = w; }
}

template <int DK, int MODE>
DEVINL void attn_naive_phase(const Params& P, char* smem) {
    bf16_t* Ks = (bf16_t*)smem;
    bf16_t* Vs = Ks + 64 * DK;
    float* aux = (float*)(Vs + 64 * 64);
    float* tot = aux + 4096;
    const int tid = threadIdx.x;
    const bf16_t *Qb, *Kb, *Vb;
    if (MODE == 0) { Qb = (const bf16_t*)(P.ws + OFF_QKV); Kb = Qb + SZ_HEADBUF / 2; Vb = Kb + SZ_HEADBUF / 2; }
    else if (MODE == 1) { Qb = (const bf16_t*)(P.ws + OFF_QKV + 3 * SZ_HEADBUF); Kb = Qb + SZ_HEADBUF / 2; Vb = Kb + SZ_HEADBUF / 2; }
    else { Qb = (const bf16_t*)((const char*)P.out + OOFF_QM); Kb = (const bf16_t*)((const char*)P.out + OOFF_KM); Vb = (const bf16_t*)((const char*)P.out + OOFF_VM); }
    for (int u = blockIdx.x; u < NBH * 16; u += gridDim.x) {
        const int bh = u >> 4, qb = 15 - (u & 15), b = bh >> 2, h = bh & 3, q0 = qb * 256, t = q0 + tid;
        float q[DK];
        { const bf16_t* qp = Qb + ((size_t)bh * SEQ + t) * DK;
#pragma unroll
          for (int c = 0; c < DK / 8; ++c) { const u32x4 w = *(const u32x4*)(qp + c * 8); q[c * 8] = bflo(w.x); q[c * 8 + 1] = bfhi(w.x); q[c * 8 + 2] = bflo(w.y); q[c * 8 + 3] = bfhi(w.y); q[c * 8 + 4] = bflo(w.z); q[c * 8 + 5] = bfhi(w.z); q[c * 8 + 6] = bflo(w.w); q[c * 8 + 7] = bfhi(w.w); } }
        unsigned sel = 0;
        if (MODE == 0) {
            const float* lf = (const float*)(P.ws + OFF_LOGF) + (size_t)bh * SEQ + tid * 16; float v[16]; float run = 0.f;
#pragma unroll
            for (int i = 0; i < 16; ++i) { run += lf[i]; v[i] = run; }
            tot[tid] = run; __syncthreads();
            if (tid < 64) { float a0 = tot[tid * 4], a1 = a0 + tot[tid * 4 + 1], a2 = a1 + tot[tid * 4 + 2], a3 = a2 + tot[tid * 4 + 3]; float incl = a3;
#pragma unroll
                for (int o = 1; o < 64; o <<= 1) { const float nb = __shfl_up(incl, o); if ((tid & 63) >= o) incl += nb; }
                const float ex = incl - a3; tot[tid * 4] = ex; tot[tid * 4 + 1] = ex + a0; tot[tid * 4 + 2] = ex + a1; tot[tid * 4 + 3] = ex + a2; }
            __syncthreads();
            const float base = tot[tid];
#pragma unroll
            for (int i = 0; i < 16; ++i) aux[tid * 16 + i] = -(base + v[i]);
        } else if (MODE == 1) {
            const float* lut = (const float*)(P.ws + OFF_LUT) + (size_t)h * 4096;
            for (int i = tid; i < 4096; i += 256) aux[i] = lut[i];
            const float* km = (const float*)(P.ws + OFF_KMEAN) + (size_t)bh * 16 * 64; float gt[15];
#pragma unroll
            for (int n = 0; n < 15; ++n) { float s = 0.f; if (n < qb) {
#pragma unroll
                    for (int d = 0; d < 64; ++d) s += q[d] * km[n * 64 + d]; } gt[n] = s; }
#pragma unroll
            for (int k = 0; k < 3; ++k) { float best = -3.0e38f; int bi = -1;
#pragma unroll
                for (int n = 0; n < 15; ++n) if (n < qb && !((sel >> n) & 1u) && gt[n] > best) { best = gt[n]; bi = n; }
                if (bi >= 0) sel |= 1u << bi; }
            sel |= 1u << qb;
        }
        float o[64], m = -3.0e38f, lsum = 0.f;
#pragma unroll
        for (int d = 0; d < 64; ++d) o[d] = 0.f;
        const int ntiles = (q0 + 256) / 64;
        for (int kt = 0; kt < ntiles; ++kt) {
            __syncthreads();
            { const bf16_t* kg = Kb + ((size_t)bh * SEQ + kt * 64) * DK; for (int i = tid; i < 64 * DK / 8; i += 256) *(u32x4*)(Ks + i * 8) = *(const u32x4*)(kg + i * 8);
              const bf16_t* vg = Vb + ((size_t)bh * SEQ + kt * 64) * 64; for (int i = tid; i < 64 * 64 / 8; i += 256) *(u32x4*)(Vs + i * 8) = *(const u32x4*)(vg + i * 8); }
            __syncthreads();
            if (MODE == 1 && !((sel >> (kt >> 2)) & 1u)) continue;
            const int k0 = kt * 64;
            for (int kk = 0; kk < 64; ++kk) { const int s = k0 + kk; if (s > t) break;
                float sc = dot_row<DK>(q, Ks + kk * DK);
                if (MODE == 0) sc += aux[s];
                if (MODE == 1) sc += aux[t - s];
                online_update(sc, m, lsum, o, Vs + kk * 64); }
        }
        write_mix(P, b, h, t, MODE == 0 ? 0 : (MODE == 1 ? 256 : 768), lsum, o);
        __syncthreads();
    }
}

DEVINL void dil_naive_phase(const Params& P, char* smem) {
    float* lut_s = (float*)smem; const int tid = threadIdx.x;
    const bf16_t* Qb = (const bf16_t*)(P.ws + OFF_QKV + 6 * SZ_HEADBUF); const bf16_t* Kb = Qb + SZ_HEADBUF / 2; const bf16_t* Vb = Kb + SZ_HEADBUF / 2;
    for (int u = blockIdx.x; u < NBH * 16; u += gridDim.x) {
        const int bh = u >> 4, qb = u & 15, b = bh >> 2, h = bh & 3, t = qb * 256 + tid;
        __syncthreads();
        { const float* lut = (const float*)(P.ws + OFF_LUT) + (size_t)(4 + h) * 4096; for (int i = tid; i < 2304; i += 256) lut_s[i] = lut[i]; }
        __syncthreads();
        float q[64];
        { const bf16_t* qp = Qb + ((size_t)bh * SEQ + t) * 64;
#pragma unroll
          for (int c = 0; c < 8; ++c) { const u32x4 w = *(const u32x4*)(qp + c * 8); q[c * 8] = bflo(w.x); q[c * 8 + 1] = bfhi(w.x); q[c * 8 + 2] = bflo(w.y); q[c * 8 + 3] = bfhi(w.y); q[c * 8 + 4] = bflo(w.z); q[c * 8 + 5] = bfhi(w.z); q[c * 8 + 6] = bflo(w.w); q[c * 8 + 7] = bfhi(w.w); } }
        float o[64], m = -3.0e38f, lsum = 0.f;
#pragma unroll
        for (int d = 0; d < 64; ++d) o[d] = 0.f;
        for (int pat = 0; pat < 3; ++pat) { const int dil = pat == 0 ? 1 : (pat == 1 ? 4 : 16);
            for (int j = 0; j <= 128; ++j) { const int dd = dil * j, s = t - dd; if (s < 0) break;
                const float sc = dot_row<64>(q, Kb + ((size_t)bh * SEQ + s) * 64) + lut_s[dd];
                online_update(sc, m, lsum, o, Vb + ((size_t)bh * SEQ + s) * 64); } }
        write_mix(P, b, h, t, 512, lsum, o);
    }
}

constexpr int SMEM_BYTES = 64 * 96 * 2 + 64 * 64 * 2 + 4096 * 4 + 256 * 4;

template <int PH> DEVINL void run_phase(const Params& P, int l, char* smem) {
    char* ws = P.ws; char* ob = (char*)P.out;
    const float* xin = l == 0 ? P.x : (const float*)(ws + OFF_X);
    float* xa = P.out;
    float* xout = l == 0 ? (float*)(ws + OFF_X) : P.out;
    if (PH == 0) phase_prep(P, smem);
    if (PH == 1) phase_rms(xin, P.ln_g + l * DM, (bf16_t*)(ws + OFF_H), P.p + (size_t)l * NT * 256, (bf16_t*)(ws + OFF_PB));
    if (PH == 2) gemm_phase((const bf16_t*)(ws + OFF_H), (const bf16_t*)(ws + OFF_WT_IN + l * SZ_WT_IN), NT, NP1, 1024, EpiIn{P, l}, smem);
    if (PH == 3) { gemm_phase((const bf16_t*)(ws + OFF_CQ), (const bf16_t*)(ws + OFF_WT_UQ + l * SZ_WT_UQ), NT, 384, 256, EpiUq{P, l}, smem);
                   gemm_phase((const bf16_t*)(ws + OFF_CKV), (const bf16_t*)(ws + OFF_WT_UKV + l * SZ_WT_UKV), NT, 512, 128, EpiUkv{P, l}, smem);
                   phase_kmean(P, smem); }
    if (PH == 4) attn_naive_phase<64, 0>(P, smem);
    if (PH == 5) attn_naive_phase<64, 1>(P, smem);
    if (PH == 6) attn_naive_phase<96, 2>(P, smem);
    if (PH == 7) dil_naive_phase(P, smem);
    if (PH == 8) { gemm_phase((const bf16_t*)(ws + OFF_H), (const bf16_t*)(ws + OFF_WT_OUT + l * SZ_WT_SQ), NT, 1024, 1024, EpiResid{xin, xa}, smem);
                   gemm_phase((const bf16_t*)(ws + OFF_PB), (const bf16_t*)(ws + OFF_WT_PP + l * SZ_WT_PP), NT, 1024, 256, EpiStore{(float*)(ws + OFF_QKV)}, smem); }
    if (PH == 9) phase_rms(xa, P.ple_norm_g + l * DM, (bf16_t*)(ws + OFF_H), nullptr, nullptr);
    if (PH == 10) gemm_phase((const bf16_t*)(ws + OFF_H), (const bf16_t*)(ws + OFF_WT_PG + l * SZ_WT_SQ), NT, 1024, 1024, EpiPle{xa, (const float*)(ws + OFF_QKV), xout}, smem);
    (void)ob;
}

template <int PH> __global__ void __launch_bounds__(NTHREADS) k_phase(Params P, int l) {
    __shared__ __attribute__((aligned(16))) char smem[SMEM_BYTES];
    run_phase<PH>(P, l, smem);
}
}

extern "C" void kernel_launch(void* const* d_in, const int* in_sizes, int n_in, void* d_out, int out_size, void* d_ws, size_t ws_size, hipStream_t stream) {
    Params P{};
    P.x = (const float*)d_in[0]; P.p = (const float*)d_in[1]; P.ln_g = (const float*)d_in[2]; P.w_in = (const float*)d_in[3]; P.b_forget = (const float*)d_in[4]; P.qk_gain = (const float*)d_in[5];
    P.mla_q_norm = (const float*)d_in[6]; P.mla_kv_norm = (const float*)d_in[7]; P.mla_nope_gain = (const float*)d_in[8]; P.mla_rope_gain = (const float*)d_in[9]; P.w_uq = (const float*)d_in[10];
    P.w_ukv = (const float*)d_in[11]; P.w_out = (const float*)d_in[12]; P.rel_bias = (const float*)d_in[13]; P.ple_norm_g = (const float*)d_in[14]; P.w_ple_gate = (const float*)d_in[15]; P.w_ple_proj = (const float*)d_in[16];
    P.out = (float*)d_out; P.ws = (char*)d_ws;
    if (ws_size < WS_NEED) { fprintf(stderr, "workspace too small: %zu < %zu\n", ws_size, (size_t)WS_NEED); return; }
    const dim3 blk(NTHREADS);
    k_phase<0><<<2048, blk, 0, stream>>>(P, 0);
    for (int l = 0; l < 2; ++l) {
        k_phase<1><<<2048, blk, 0, stream>>>(P, l);
        k_phase<2><<<3840, blk, 0, stream>>>(P, l);
        k_phase<3><<<1024, blk, 0, stream>>>(P, l);
        k_phase<4><<<256, blk, 0, stream>>>(P, l);
        k_phase<5><<<256, blk, 0, stream>>>(P, l);
        k_phase<6><<<256, blk, 0, stream>>>(P, l);
        k_phase<7><<<256, blk, 0, stream>>>(P, l);
        k_phase<8><<<2048, blk, 0, stream>>>(P, l);
        k_phase<9><<<2048, blk, 0, stream>>>(P, l);
        k_phase<10><<<1024, blk, 0, stream>>>(P, l);
    }
}
```

```cpp
#include <hip/hip_runtime.h>
#include <hip/hip_cooperative_groups.h>
#include <cstdint>
#include <cstdio>

#ifndef ONE_LAUNCH
#define ONE_LAUNCH 1
#endif

namespace {
#define DEVINL __device__ __forceinline__
typedef unsigned short bf16_t;
typedef short bf16x8 __attribute__((ext_vector_type(8)));
typedef float f32x4 __attribute__((ext_vector_type(4)));
typedef unsigned u32x2 __attribute__((ext_vector_type(2)));
typedef unsigned u32x4 __attribute__((ext_vector_type(4)));

constexpr int NB = 4, SEQ = 4096, DM = 1024, NT = NB * SEQ, NH = 4, NBH = NB * NH;
constexpr int INW = 3748, NP1 = 3840;
constexpr float EPS = 1e-6f, LOG2E = 1.4426950408889634f;
constexpr float SC_Q = 0.125f * LOG2E;
constexpr float SC_MLA = 0.10206207261596575f * LOG2E;
constexpr int NTHREADS = 256;

constexpr size_t SZ_WT_IN = (size_t)NP1 * 1024 * 2, SZ_WT_UQ = 384 * 256 * 2, SZ_WT_UKV = 512 * 128 * 2, SZ_WT_SQ = 1024 * 1024 * 2, SZ_WT_PP = 1024 * 256 * 2;
constexpr size_t OFF_WT_IN = 0;
constexpr size_t OFF_WT_UQ = OFF_WT_IN + 2 * SZ_WT_IN;
constexpr size_t OFF_WT_UKV = OFF_WT_UQ + 2 * SZ_WT_UQ;
constexpr size_t OFF_WT_OUT = OFF_WT_UKV + 2 * SZ_WT_UKV;
constexpr size_t OFF_WT_PG = OFF_WT_OUT + 2 * SZ_WT_SQ;
constexpr size_t OFF_WT_PP = OFF_WT_PG + 2 * SZ_WT_SQ;
constexpr size_t OFF_LUT = OFF_WT_PP + 2 * SZ_WT_PP;
constexpr size_t OFF_ROPE = OFF_LUT + 8 * 4096 * 4;
constexpr size_t OFF_H = OFF_ROPE + 4096 * 16 * 8;
constexpr size_t SZ_HEADBUF = (size_t)NT * 256 * 2;
constexpr size_t OFF_QKV = OFF_H + (size_t)NT * 1024 * 2;
constexpr size_t OFF_CQ = OFF_QKV + 9 * SZ_HEADBUF;
constexpr size_t OFF_CKV = OFF_CQ + (size_t)NT * 256 * 2;
constexpr size_t OFF_CQSS = OFF_CKV + (size_t)NT * 128 * 2;
constexpr size_t OFF_CKVSS = OFF_CQSS + (size_t)NT * 4 * 4;
constexpr size_t OFF_LOGF = OFF_CKVSS + (size_t)NT * 2 * 4;
constexpr size_t OFF_KMEAN = OFF_LOGF + (size_t)NBH * SEQ * 4;
constexpr size_t OFF_PB = OFF_KMEAN + (size_t)NBH * 16 * 64 * 4;
constexpr size_t OFF_X = OFF_PB + (size_t)NT * 256 * 2;
constexpr size_t WS_NEED = OFF_X + (size_t)NT * 1024 * 4;
constexpr size_t OOFF_G = 0;
constexpr size_t OOFF_QM = (size_t)NT * 1024 * 2;
constexpr size_t OOFF_KM = OOFF_QM + (size_t)NBH * SEQ * 96 * 2;
constexpr size_t OOFF_VM = OOFF_KM + (size_t)NBH * SEQ * 96 * 2;

struct Params {
    const float *x, *p, *ln_g, *w_in, *b_forget, *qk_gain, *mla_q_norm, *mla_kv_norm, *mla_nope_gain, *mla_rope_gain, *w_uq, *w_ukv, *w_out, *rel_bias, *ple_norm_g, *w_ple_gate, *w_ple_proj;
    float* out;
    char* ws;
};

DEVINL bf16_t f2bf(float f) { unsigned u = __float_as_uint(f); u += 0x7fffu + ((u >> 16) & 1u); return (bf16_t)(u >> 16); }
DEVINL float bf2f(bf16_t h) { return __uint_as_float(((unsigned)h) << 16); }
DEVINL unsigned pack2(float a, float b) { return (unsigned)f2bf(a) | ((unsigned)f2bf(b) << 16); }
DEVINL float bflo(unsigned u) { return __uint_as_float(u << 16); }
DEVINL float bfhi(unsigned u) { return __uint_as_float(u & 0xffff0000u); }

__device__ __constant__ float ROPE_INV[16] = {1.0f, 0.5623413251903491f, 0.31622776601683794f, 0.1778279410038923f, 0.1f, 0.05623413251903491f, 0.03162277660168379f, 0.01778279410038923f,
                                              0.01f, 0.005623413251903491f, 0.0031622776601683794f, 0.0017782794100389228f, 0.001f, 0.0005623413251903491f, 0.00031622776601683794f, 0.00017782794100389227f};

DEVINL int t5_bucket(int d) {
    if (d < 16) return d;
    int b = 16;
    b += (d >= 22); b += (d >= 30); b += (d >= 40); b += (d >= 54); b += (d >= 73); b += (d >= 99); b += (d >= 134); b += (d >= 182);
    b += (d >= 246); b += (d >= 332); b += (d >= 450); b += (d >= 609); b += (d >= 825); b += (d >= 1117); b += (d >= 1513);
    return b;
}

DEVINL int map_w_in(int n) { return n < 768 ? n : (n < 2720 ? n + 4 : (n < 2724 ? n - 2720 + 768 : (n < 2816 ? -1 : n - 92))); }
DEVINL int map_w_uq(int n) { if (n < 256) return (n >> 6) * 96 + (n & 63); const int r = n - 256; return (r >> 5) * 96 + 64 + (r & 31); }

DEVINL void transpose_tile(const float* src, int Nsrc, bf16_t* dst, int K, int tn, int tk, int mode, const float* fold, float* tile  ) {
    const int tid = threadIdx.x, c = tid & 63, rb = tid >> 6, n0 = tn * 64, k0 = tk * 64;
    const int n = n0 + c, oc = mode == 1 ? map_w_in(n) : (mode == 2 ? map_w_uq(n) : n);
#pragma unroll 4
    for (int i = 0; i < 16; ++i) { const int kk = rb + 4 * i; float v = 0.f; if (oc >= 0) { v = src[(size_t)(k0 + kk) * Nsrc + oc]; if (fold) v *= fold[k0 + kk]; } tile[kk * 65 + c] = v; }
    __syncthreads();
#pragma unroll 4
    for (int i = 0; i < 16; ++i) { const int nn = rb + 4 * i; dst[(size_t)(n0 + nn) * K + k0 + c] = f2bf(tile[c * 65 + nn]); }
    __syncthreads();
}

constexpr int PREP_T_IN = 60 * 16, PREP_T_UQ = 6 * 4, PREP_T_UKV = 8 * 2, PREP_T_SQ = 16 * 16, PREP_T_PP = 16 * 4;
constexpr int PREP_PER_LAYER = PREP_T_IN + PREP_T_UQ + PREP_T_UKV + 2 * PREP_T_SQ + PREP_T_PP;
constexpr int PREP_LUT_UNITS = 8 * 4096 / 256, PREP_ROPE_UNITS = 4096 * 16 / 256;
constexpr int PREP_UNITS = 2 * PREP_PER_LAYER + PREP_LUT_UNITS + PREP_ROPE_UNITS;

DEVINL void phase_prep(const Params& P, char* smem) {
    float* tile = (float*)smem;
    for (int u = blockIdx.x; u < PREP_UNITS; u += gridDim.x) {
        if (u < 2 * PREP_PER_LAYER) {
            const int l = u / PREP_PER_LAYER; int r = u % PREP_PER_LAYER;
            if (r < PREP_T_IN) { transpose_tile(P.w_in + (size_t)l * 1024 * INW, INW, (bf16_t*)(P.ws + OFF_WT_IN + l * SZ_WT_IN), 1024, r % 60, r / 60, 1, nullptr, tile); continue; }
            r -= PREP_T_IN;
            if (r < PREP_T_UQ) { transpose_tile(P.w_uq + (size_t)l * 256 * 384, 384, (bf16_t*)(P.ws + OFF_WT_UQ + l * SZ_WT_UQ), 256, r % 6, r / 6, 2, P.mla_q_norm + l * 256, tile); continue; }
            r -= PREP_T_UQ;
            if (r < PREP_T_UKV) { transpose_tile(P.w_ukv + (size_t)l * 128 * 512, 512, (bf16_t*)(P.ws + OFF_WT_UKV + l * SZ_WT_UKV), 128, r % 8, r / 8, 0, P.mla_kv_norm + l * 128, tile); continue; }
            r -= PREP_T_UKV;
            if (r < PREP_T_SQ) { transpose_tile(P.w_out + (size_t)l * 1024 * 1024, 1024, (bf16_t*)(P.ws + OFF_WT_OUT + l * SZ_WT_SQ), 1024, r % 16, r / 16, 0, nullptr, tile); continue; }
            r -= PREP_T_SQ;
            if (r < PREP_T_SQ) { transpose_tile(P.w_ple_gate + (size_t)l * 1024 * 1024, 1024, (bf16_t*)(P.ws + OFF_WT_PG + l * SZ_WT_SQ), 1024, r % 16, r / 16, 0, nullptr, tile); continue; }
            r -= PREP_T_SQ;
            transpose_tile(P.w_ple_proj + (size_t)l * 256 * 1024, 1024, (bf16_t*)(P.ws + OFF_WT_PP + l * SZ_WT_PP), 256, r % 16, r / 16, 0, nullptr, tile);
        } else if (u < 2 * PREP_PER_LAYER + PREP_LUT_UNITS) {
            const int e = (u - 2 * PREP_PER_LAYER) * 256 + threadIdx.x, hh = e >> 12, d = e & 4095;
            ((float*)(P.ws + OFF_LUT))[e] = P.rel_bias[t5_bucket(d) * 8 + hh] * LOG2E;
        } else {
            const int e = (u - 2 * PREP_PER_LAYER - PREP_LUT_UNITS) * 256 + threadIdx.x, pos = e >> 4, i = e & 15;
            const double rev = (double)pos * (double)ROPE_INV[i] * 0.15915494309189535; const float fr = (float)(rev - floor(rev));
            ((float2*)(P.ws + OFF_ROPE))[e] = make_float2(__builtin_amdgcn_cosf(fr), __builtin_amdgcn_sinf(fr));
        }
    }
}

DEVINL float wave_sum(float v) {
#pragma unroll
    for (int o = 32; o > 0; o >>= 1) v += __shfl_xor(v, o);
    return v;
}
DEVINL void phase_rms(const float* src, const float* g, bf16_t* dst, const float* psrc, bf16_t* pb) {
    const int wid = threadIdx.x >> 6, lane = threadIdx.x & 63;
    for (int u = blockIdx.x; u < NT / 4; u += gridDim.x) {
        const int row = u * 4 + wid; const float* xr = src + (size_t)row * DM;
        f32x4 v[4]; float ss = 0.f;
#pragma unroll
        for (int i = 0; i < 4; ++i) { v[i] = *(const f32x4*)(xr + i * 256 + lane * 4); ss += v[i][0] * v[i][0] + v[i][1] * v[i][1] + v[i][2] * v[i][2] + v[i][3] * v[i][3]; }
        ss = wave_sum(ss); const float r = rsqrtf(ss * (1.0f / DM) + EPS);
#pragma unroll
        for (int i = 0; i < 4; ++i) { const f32x4 gg = *(const f32x4*)(g + i * 256 + lane * 4); u32x2 w; w.x = pack2(v[i][0] * r * gg[0], v[i][1] * r * gg[1]); w.y = pack2(v[i][2] * r * gg[2], v[i][3] * r * gg[3]);
            *(u32x2*)(dst + (size_t)row * DM + i * 256 + lane * 4) = w; }
        if (psrc) { const f32x4 pv = *(const f32x4*)(psrc + (size_t)row * 256 + lane * 4); u32x2 w; w.x = pack2(pv[0], pv[1]); w.y = pack2(pv[2], pv[3]); *(u32x2*)(pb + (size_t)row * 256 + lane * 4) = w; }
    }
}

constexpr int GST = 40;
template <class Epi>
DEVINL void gemm_phase(const bf16_t* A, const bf16_t* Bt, int M, int N, int K, const Epi& epi, char* smem) {
    bf16_t* As = (bf16_t*)smem; bf16_t* Bs = As + 128 * GST;
    const int tid = threadIdx.x, wid = tid >> 6, lane = tid & 63, wr = wid >> 1, wc = wid & 1, fr = lane & 15, fq = lane >> 4;
    const int ntm = M / 128, ntn = N / 128, nk = K / 32;
    const int lr = tid >> 2, lc = (tid & 3) * 8;
    for (int tile = blockIdx.x; tile < ntm * ntn; tile += gridDim.x) {
        const int tm = tile % ntm, tn = tile / ntm;
        const bf16_t* Ag = A + (size_t)(tm * 128 + lr) * K + lc; const bf16_t* Bg = Bt + (size_t)(tn * 128 + lr) * K + lc;
        f32x4 acc[4][4];
#pragma unroll
        for (int m = 0; m < 4; ++m)
#pragma unroll
            for (int n = 0; n < 4; ++n) acc[m][n] = (f32x4){0.f, 0.f, 0.f, 0.f};
        u32x4 ra0 = *(const u32x4*)Ag, ra1 = *(const u32x4*)(Ag + (size_t)64 * K), rb0 = *(const u32x4*)Bg, rb1 = *(const u32x4*)(Bg + (size_t)64 * K);
        for (int kt = 0; kt < nk; ++kt) {
            __syncthreads();
            *(u32x4*)(As + lr * GST + lc) = ra0; *(u32x4*)(As + (lr + 64) * GST + lc) = ra1; *(u32x4*)(Bs + lr * GST + lc) = rb0; *(u32x4*)(Bs + (lr + 64) * GST + lc) = rb1;
            __syncthreads();
            if (kt + 1 < nk) { const int ko = (kt + 1) * 32; ra0 = *(const u32x4*)(Ag + ko); ra1 = *(const u32x4*)(Ag + (size_t)64 * K + ko); rb0 = *(const u32x4*)(Bg + ko); rb1 = *(const u32x4*)(Bg + (size_t)64 * K + ko); }
            bf16x8 af[4], bfr[4];
#pragma unroll
            for (int m = 0; m < 4; ++m) af[m] = *(const bf16x8*)(As + (wr * 64 + m * 16 + fr) * GST + fq * 8);
#pragma unroll
            for (int n = 0; n < 4; ++n) bfr[n] = *(const bf16x8*)(Bs + (wc * 64 + n * 16 + fr) * GST + fq * 8);
#pragma unroll
            for (int m = 0; m < 4; ++m)
#pragma unroll
                for (int n = 0; n < 4; ++n) acc[m][n] = __builtin_amdgcn_mfma_f32_16x16x32_bf16(bfr[n], af[m], acc[m][n], 0, 0, 0);
        }
        epi(acc, tm * 128 + wr * 64, tn * 2 + wc, fr, fq);
    }
}

DEVINL float quad_sum(float v) { v += __shfl_xor(v, 16); v += __shfl_xor(v, 32); return v; }
DEVINL void store4bf(bf16_t* p, float a, float b, float c, float d) { u32x2 w; w.x = pack2(a, b); w.y = pack2(c, d); *(u32x2*)p = w; }
DEVINL float log_sigmoid(float z) { return fminf(z, 0.f) - log1pf(__expf(-fabsf(z))); }

struct EpiIn {
    Params P; int l;
    DEVINL void operator()(f32x4 (&acc)[4][4], int row0, int chunk, int fr, int fq) const {
        char* ws = P.ws; char* ob = (char*)P.out;
        if (chunk < 36) {
            const int g = chunk >> 2, h = chunk & 3, role = g % 3, mix = g / 3;
            bf16_t* dst = (bf16_t*)(ws + OFF_QKV + (size_t)g * SZ_HEADBUF);
            const float* gain = P.qk_gain + ((size_t)l * 6 + 2 * mix + (role == 1 ? 1 : 0)) * 64;
#pragma unroll
            for (int m = 0; m < 4; ++m) {
                const int t = row0 + 16 * m + fr, b = t >> 12, s = t & 4095; bf16_t* d = dst + ((size_t)(b * 4 + h) * SEQ + s) * 64 + 4 * fq;
                float r = 1.f;
                if (role != 2) { float ss = 0.f;
#pragma unroll
                    for (int n = 0; n < 4; ++n) ss += acc[m][n][0] * acc[m][n][0] + acc[m][n][1] * acc[m][n][1] + acc[m][n][2] * acc[m][n][2] + acc[m][n][3] * acc[m][n][3];
                    ss = quad_sum(ss); r = rsqrtf(ss * (1.0f / 64.0f) + EPS) * (role == 0 ? SC_Q : 1.0f); }
#pragma unroll
                for (int n = 0; n < 4; ++n) { f32x4 gg = (f32x4){1.f, 1.f, 1.f, 1.f}; if (role != 2) gg = *(const f32x4*)(gain + 16 * n + 4 * fq);
                    store4bf(d + 16 * n, acc[m][n][0] * r * gg[0], acc[m][n][1] * r * gg[1], acc[m][n][2] * r * gg[2], acc[m][n][3] * r * gg[3]); }
            }
        } else if (chunk < 42) {
            const bool isq = chunk < 40; const int c = isq ? chunk - 36 : chunk - 40;
            bf16_t* dst = isq ? (bf16_t*)(ws + OFF_CQ) : (bf16_t*)(ws + OFF_CKV); const int ld = isq ? 256 : 128;
            float* ssp = isq ? (float*)(ws + OFF_CQSS) : (float*)(ws + OFF_CKVSS); const int nss = isq ? 4 : 2;
#pragma unroll
            for (int m = 0; m < 4; ++m) {
                const int t = row0 + 16 * m + fr; float ss = 0.f;
#pragma unroll
                for (int n = 0; n < 4; ++n) { ss += acc[m][n][0] * acc[m][n][0] + acc[m][n][1] * acc[m][n][1] + acc[m][n][2] * acc[m][n][2] + acc[m][n][3] * acc[m][n][3];
                    store4bf(dst + (size_t)t * ld + c * 64 + 16 * n + 4 * fq, acc[m][n][0], acc[m][n][1], acc[m][n][2], acc[m][n][3]); }
                ss = quad_sum(ss); if (fq == 0) ssp[(size_t)t * nss + c] = ss;
            }
        } else if (chunk == 42) {
            const float* gr = P.mla_rope_gain + ((size_t)l * 2 + 1) * 32; const float2* rope = (const float2*)(ws + OFF_ROPE);
            bf16_t* km = (bf16_t*)(ob + OOFF_KM); float* logf_ = (float*)(ws + OFF_LOGF);
            const f32x4 g1 = *(const f32x4*)(gr + 4 * fq), g2 = *(const f32x4*)(gr + 16 + 4 * fq); const f32x4 bfv = *(const f32x4*)(P.b_forget + l * 4);
#pragma unroll
            for (int m = 0; m < 4; ++m) {
                const int t = row0 + 16 * m + fr, b = t >> 12, s = t & 4095;
                float ss = 0.f;
#pragma unroll
                for (int n = 0; n < 2; ++n) ss += acc[m][n][0] * acc[m][n][0] + acc[m][n][1] * acc[m][n][1] + acc[m][n][2] * acc[m][n][2] + acc[m][n][3] * acc[m][n][3];
                ss = quad_sum(ss); const float r = rsqrtf(ss * (1.0f / 32.0f) + EPS);
                float o1[4], o2[4];
#pragma unroll
                for (int j = 0; j < 4; ++j) { const float2 cs = rope[s * 16 + 4 * fq + j]; const float x1 = acc[m][0][j] * r * g1[j], x2 = acc[m][1][j] * r * g2[j]; o1[j] = x1 * cs.x - x2 * cs.y; o2[j] = x1 * cs.y + x2 * cs.x; }
#pragma unroll
                for (int h = 0; h < 4; ++h) { bf16_t* d = km + ((size_t)(b * 4 + h) * SEQ + s) * 96 + 64 + 4 * fq; store4bf(d, o1[0], o1[1], o1[2], o1[3]); store4bf(d + 16, o2[0], o2[1], o2[2], o2[3]); }
                if (fq == 0) {
#pragma unroll
                    for (int j = 0; j < 4; ++j) logf_[(size_t)(b * 4 + j) * SEQ + s] = log_sigmoid(acc[m][2][j] + bfv[j]) * LOG2E;
                }
            }
        } else if (chunk >= 44) {
            bf16_t* G = (bf16_t*)(ob + OOFF_G); const int c0 = (chunk - 44) * 64;
#pragma unroll
            for (int m = 0; m < 4; ++m) { const int t = row0 + 16 * m + fr;
#pragma unroll
                for (int n = 0; n < 4; ++n) { float o[4];
#pragma unroll
                    for (int j = 0; j < 4; ++j) { const float z = acc[m][n][j]; o[j] = z / (1.0f + __expf(-z)); }
                    store4bf(G + (size_t)t * DM + c0 + 16 * n + 4 * fq, o[0], o[1], o[2], o[3]); } }
        }
    }
};

struct EpiUq {
    Params P; int l;
    DEVINL void operator()(f32x4 (&acc)[4][4], int row0, int chunk, int fr, int fq) const {
        const float* cqss = (const float*)(P.ws + OFF_CQSS); bf16_t* qm = (bf16_t*)((char*)P.out + OOFF_QM); const float2* rope = (const float2*)(P.ws + OFF_ROPE);
#pragma unroll
        for (int m = 0; m < 4; ++m) {
            const int t = row0 + 16 * m + fr, b = t >> 12, s = t & 4095; const f32x4 pss = *(const f32x4*)(cqss + (size_t)t * 4);
            const float rt = rsqrtf((pss[0] + pss[1] + pss[2] + pss[3]) * (1.0f / 256.0f) + EPS);
            if (chunk < 4) {
                const float* gain = P.mla_nope_gain + ((size_t)l * 2 + 0) * 64; float ss = 0.f;
#pragma unroll
                for (int n = 0; n < 4; ++n) { acc[m][n] = acc[m][n] * rt; ss += acc[m][n][0] * acc[m][n][0] + acc[m][n][1] * acc[m][n][1] + acc[m][n][2] * acc[m][n][2] + acc[m][n][3] * acc[m][n][3]; }
                ss = quad_sum(ss); const float r = rsqrtf(ss * (1.0f / 64.0f) + EPS) * SC_MLA; bf16_t* d = qm + ((size_t)(b * 4 + chunk) * SEQ + s) * 96 + 4 * fq;
#pragma unroll
                for (int n = 0; n < 4; ++n) { const f32x4 gg = *(const f32x4*)(gain + 16 * n + 4 * fq); store4bf(d + 16 * n, acc[m][n][0] * r * gg[0], acc[m][n][1] * r * gg[1], acc[m][n][2] * r * gg[2], acc[m][n][3] * r * gg[3]); }
            } else {
                const float* gr = P.mla_rope_gain + ((size_t)l * 2 + 0) * 32; const f32x4 g1 = *(const f32x4*)(gr + 4 * fq), g2 = *(const f32x4*)(gr + 16 + 4 * fq);
#pragma unroll
                for (int hh = 0; hh < 2; ++hh) {
                    const int h = (chunk - 4) * 2 + hh; float ss = 0.f;
#pragma unroll
                    for (int n = 0; n < 2; ++n) { acc[m][2 * hh + n] = acc[m][2 * hh + n] * rt; const f32x4 a = acc[m][2 * hh + n]; ss += a[0] * a[0] + a[1] * a[1] + a[2] * a[2] + a[3] * a[3]; }
                    ss = quad_sum(ss); const float r = rsqrtf(ss * (1.0f / 32.0f) + EPS);
                    float o1[4], o2[4];
#pragma unroll
                    for (int j = 0; j < 4; ++j) { const float2 cs = rope[s * 16 + 4 * fq + j]; const float x1 = acc[m][2 * hh][j] * r * g1[j], x2 = acc[m][2 * hh + 1][j] * r * g2[j];
                        o1[j] = (x1 * cs.x - x2 * cs.y) * SC_MLA; o2[j] = (x1 * cs.y + x2 * cs.x) * SC_MLA; }
                    bf16_t* d = qm + ((size_t)(b * 4 + h) * SEQ + s) * 96 + 64 + 4 * fq; store4bf(d, o1[0], o1[1], o1[2], o1[3]); store4bf(d + 16, o2[0], o2[1], o2[2], o2[3]);
                }
            }
        }
    }
};
struct EpiUkv {
    Params P; int l;
    DEVINL void operator()(f32x4 (&acc)[4][4], int row0, int chunk, int fr, int fq) const {
        const float* ckvss = (const float*)(P.ws + OFF_CKVSS); bf16_t* km = (bf16_t*)((char*)P.out + OOFF_KM); bf16_t* vm = (bf16_t*)((char*)P.out + OOFF_VM);
        const int h = chunk >> 1; const bool isk = (chunk & 1) == 0; const float* gain = P.mla_nope_gain + ((size_t)l * 2 + 1) * 64;
#pragma unroll
        for (int m = 0; m < 4; ++m) {
            const int t = row0 + 16 * m + fr, b = t >> 12, s = t & 4095; const float rt = rsqrtf((ckvss[(size_t)t * 2] + ckvss[(size_t)t * 2 + 1]) * (1.0f / 128.0f) + EPS);
            float ss = 0.f;
#pragma unroll
            for (int n = 0; n < 4; ++n) { acc[m][n] = acc[m][n] * rt; ss += acc[m][n][0] * acc[m][n][0] + acc[m][n][1] * acc[m][n][1] + acc[m][n][2] * acc[m][n][2] + acc[m][n][3] * acc[m][n][3]; }
            if (isk) { ss = quad_sum(ss); const float r = rsqrtf(ss * (1.0f / 64.0f) + EPS); bf16_t* d = km + ((size_t)(b * 4 + h) * SEQ + s) * 96 + 4 * fq;
#pragma unroll
                for (int n = 0; n < 4; ++n) { const f32x4 gg = *(const f32x4*)(gain + 16 * n + 4 * fq); store4bf(d + 16 * n, acc[m][n][0] * r * gg[0], acc[m][n][1] * r * gg[1], acc[m][n][2] * r * gg[2], acc[m][n][3] * r * gg[3]); }
            } else { bf16_t* d = vm + ((size_t)(b * 4 + h) * SEQ + s) * 64 + 4 * fq;
#pragma unroll
                for (int n = 0; n < 4; ++n) store4bf(d + 16 * n, acc[m][n][0], acc[m][n][1], acc[m][n][2], acc[m][n][3]); }
        }
    }
};
struct EpiResid { const float* base; float* out;
    DEVINL void operator()(f32x4 (&acc)[4][4], int row0, int chunk, int fr, int fq) const {
#pragma unroll
        for (int m = 0; m < 4; ++m) { const size_t o = (size_t)(row0 + 16 * m + fr) * DM + chunk * 64 + 4 * fq;
#pragma unroll
            for (int n = 0; n < 4; ++n) { const f32x4 bv = *(const f32x4*)(base + o + 16 * n); *(f32x4*)(out + o + 16 * n) = bv + acc[m][n]; } } } };
struct EpiStore { float* out;
    DEVINL void operator()(f32x4 (&acc)[4][4], int row0, int chunk, int fr, int fq) const {
#pragma unroll
        for (int m = 0; m < 4; ++m) { const size_t o = (size_t)(row0 + 16 * m + fr) * DM + chunk * 64 + 4 * fq;
#pragma unroll
            for (int n = 0; n < 4; ++n) *(f32x4*)(out + o + 16 * n) = acc[m][n]; } } };
struct EpiPle { const float* xa; const float* pp; float* out;
    DEVINL void operator()(f32x4 (&acc)[4][4], int row0, int chunk, int fr, int fq) const {
#pragma unroll
        for (int m = 0; m < 4; ++m) { const size_t o = (size_t)(row0 + 16 * m + fr) * DM + chunk * 64 + 4 * fq;
#pragma unroll
            for (int n = 0; n < 4; ++n) { const f32x4 xv = *(const f32x4*)(xa + o + 16 * n), pv = *(const f32x4*)(pp + o + 16 * n); f32x4 r;
#pragma unroll
                for (int j = 0; j < 4; ++j) r[j] = xv[j] + pv[j] / (1.0f + __expf(-acc[m][n][j]));
                *(f32x4*)(out + o + 16 * n) = r; } } } };

DEVINL void phase_kmean(const Params& P, char* smem) {
    float* red = (float*)smem; const bf16_t* K = (const bf16_t*)(P.ws + OFF_QKV + 4 * SZ_HEADBUF); float* km = (float*)(P.ws + OFF_KMEAN);
    const int tid = threadIdx.x, d = tid & 63, part = tid >> 6;
    for (int u = blockIdx.x; u < NBH * 16; u += gridDim.x) {
        const bf16_t* kp = K + ((size_t)(u >> 4) * SEQ + (u & 15) * 256 + part * 64) * 64 + d; float s = 0.f;
        for (int i = 0; i < 64; ++i) s += bf2f(kp[(size_t)i * 64]);
        red[tid] = s; __syncthreads();
        if (part == 0) km[(size_t)u * 64 + d] = (red[d] + red[64 + d] + red[128 + d] + red[192 + d]) * (1.0f / 256.0f);
        __syncthreads();
    }
}

template <int DK> DEVINL float dot_row(const float (&q)[DK], const bf16_t* krow) {
    float s = 0.f;
#pragma unroll
    for (int c = 0; c < DK / 8; ++c) { const u32x4 w = *(const u32x4*)(krow + c * 8);
        s += q[c * 8 + 0] * bflo(w.x) + q[c * 8 + 1] * bfhi(w.x) + q[c * 8 + 2] * bflo(w.y) + q[c * 8 + 3] * bfhi(w.y) + q[c * 8 + 4] * bflo(w.z) + q[c * 8 + 5] * bfhi(w.z) + q[c * 8 + 6] * bflo(w.w) + q[c * 8 + 7] * bfhi(w.w); }
    return s;
}
DEVINL void acc_row(float (&o)[64], float p, const bf16_t* vrow) {
#pragma unroll
    for (int c = 0; c < 8; ++c) { const u32x4 w = *(const u32x4*)(vrow + c * 8);
        o[c * 8 + 0] += p * bflo(w.x); o[c * 8 + 1] += p * bfhi(w.x); o[c * 8 + 2] += p * bflo(w.y); o[c * 8 + 3] += p * bfhi(w.y); o[c * 8 + 4] += p * bflo(w.z); o[c * 8 + 5] += p * bfhi(w.z); o[c * 8 + 6] += p * bflo(w.w); o[c * 8 + 7] += p * bfhi(w.w); }
}
DEVINL void online_update(float s, float& m, float& lsum, float (&o)[64], const bf16_t* vrow) {
    if (s > m) { const float sc = exp2f(m - s); lsum *= sc;
#pragma unroll
        for (int d = 0; d < 64; ++d) o[d] *= sc;
        m = s; }
    const float p = exp2f(s - m); lsum += p; acc_row(o, p, vrow);
}
DEVINL void write_mix(const Params& P, int b, int h, int s, int colbase, float lsum, const float (&o)[64]) {
    const size_t t = (size_t)b * SEQ + s; const bf16_t* G = (const bf16_t*)((const char*)P.out + OOFF_G) + t * DM + colbase + h * 64; bf16_t* A2 = (bf16_t*)(P.ws + OFF_H) + t * DM + colbase + h * 64;
    const float inv = 1.0f / lsum;
#pragma unroll
    for (int c = 0; c < 8; ++c) { const u32x4 g = *(const u32x4*)(G + c * 8); u32x4 w;
        w.x = pack2(o[c * 8 + 0] * inv * bflo(g.x), o[c * 8 + 1] * inv * bfhi(g.x)); w.y = pack2(o[c * 8 + 2] * inv * bflo(g.y), o[c * 8 + 3] * inv * bfhi(g.y));
        w.z = pack2(o[c * 8 + 4] * inv * bflo(g.z), o[c * 8 + 5] * inv * bfhi(g.z)); w.w = pack2(o[c * 8 + 6] * inv * bflo(g.w), o[c * 8 + 7] * inv * bfhi(g.w));
        *(u32x4*)(A2 + c * 8) = w; }
}

template <int DK, int MODE>
DEVINL void attn_naive_phase(const Params& P, char* smem) {
    bf16_t* Ks = (bf16_t*)smem;
    bf16_t* Vs = Ks + 64 * DK;
    float* aux = (float*)(Vs + 64 * 64);
    float* tot = aux + 4096;
    const int tid = threadIdx.x;
    const bf16_t *Qb, *Kb, *Vb;
    if (MODE == 0) { Qb = (const bf16_t*)(P.ws + OFF_QKV); Kb = Qb + SZ_HEADBUF / 2; Vb = Kb + SZ_HEADBUF / 2; }
    else if (MODE == 1) { Qb = (const bf16_t*)(P.ws + OFF_QKV + 3 * SZ_HEADBUF); Kb = Qb + SZ_HEADBUF / 2; Vb = Kb + SZ_HEADBUF / 2; }
    else { Qb = (const bf16_t*)((const char*)P.out + OOFF_QM); Kb = (const bf16_t*)((const char*)P.out + OOFF_KM); Vb = (const bf16_t*)((const char*)P.out + OOFF_VM); }
    for (int u = blockIdx.x; u < NBH * 16; u += gridDim.x) {
        const int bh = u >> 4, qb = 15 - (u & 15), b = bh >> 2, h = bh & 3, q0 = qb * 256, t = q0 + tid;
        float q[DK];
        { const bf16_t* qp = Qb + ((size_t)bh * SEQ + t) * DK;
#pragma unroll
          for (int c = 0; c < DK / 8; ++c) { const u32x4 w = *(const u32x4*)(qp + c * 8); q[c * 8] = bflo(w.x); q[c * 8 + 1] = bfhi(w.x); q[c * 8 + 2] = bflo(w.y); q[c * 8 + 3] = bfhi(w.y); q[c * 8 + 4] = bflo(w.z); q[c * 8 + 5] = bfhi(w.z); q[c * 8 + 6] = bflo(w.w); q[c * 8 + 7] = bfhi(w.w); } }
        unsigned sel = 0;
        if (MODE == 0) {
            const float* lf = (const float*)(P.ws + OFF_LOGF) + (size_t)bh * SEQ + tid * 16; float v[16]; float run = 0.f;
#pragma unroll
            for (int i = 0; i < 16; ++i) { run += lf[i]; v[i] = run; }
            tot[tid] = run; __syncthreads();
            if (tid < 64) { float a0 = tot[tid * 4], a1 = a0 + tot[tid * 4 + 1], a2 = a1 + tot[tid * 4 + 2], a3 = a2 + tot[tid * 4 + 3]; float incl = a3;
#pragma unroll
                for (int o = 1; o < 64; o <<= 1) { const float nb = __shfl_up(incl, o); if ((tid & 63) >= o) incl += nb; }
                const float ex = incl - a3; tot[tid * 4] = ex; tot[tid * 4 + 1] = ex + a0; tot[tid * 4 + 2] = ex + a1; tot[tid * 4 + 3] = ex + a2; }
            __syncthreads();
            const float base = tot[tid];
#pragma unroll
            for (int i = 0; i < 16; ++i) aux[tid * 16 + i] = -(base + v[i]);
        } else if (MODE == 1) {
            const float* lut = (const float*)(P.ws + OFF_LUT) + (size_t)h * 4096;
            for (int i = tid; i < 4096; i += 256) aux[i] = lut[i];
            const float* km = (const float*)(P.ws + OFF_KMEAN) + (size_t)bh * 16 * 64; float gt[15];
#pragma unroll
            for (int n = 0; n < 15; ++n) { float s = 0.f; if (n < qb) {
#pragma unroll
                    for (int d = 0; d < 64; ++d) s += q[d] * km[n * 64 + d]; } gt[n] = s; }
#pragma unroll
            for (int k = 0; k < 3; ++k) { float best = -3.0e38f; int bi = -1;
#pragma unroll
                for (int n = 0; n < 15; ++n) if (n < qb && !((sel >> n) & 1u) && gt[n] > best) { best = gt[n]; bi = n; }
                if (bi >= 0) sel |= 1u << bi; }
            sel |= 1u << qb;
        }
        float o[64], m = -3.0e38f, lsum = 0.f;
#pragma unroll
        for (int d = 0; d < 64; ++d) o[d] = 0.f;
        const int ntiles = (q0 + 256) / 64;
        for (int kt = 0; kt < ntiles; ++kt) {
            __syncthreads();
            { const bf16_t* kg = Kb + ((size_t)bh * SEQ + kt * 64) * DK; for (int i = tid; i < 64 * DK / 8; i += 256) *(u32x4*)(Ks + i * 8) = *(const u32x4*)(kg + i * 8);
              const bf16_t* vg = Vb + ((size_t)bh * SEQ + kt * 64) * 64; for (int i = tid; i < 64 * 64 / 8; i += 256) *(u32x4*)(Vs + i * 8) = *(const u32x4*)(vg + i * 8); }
            __syncthreads();
            if (MODE == 1 && !((sel >> (kt >> 2)) & 1u)) continue;
            const int k0 = kt * 64;
            for (int kk = 0; kk < 64; ++kk) { const int s = k0 + kk; if (s > t) break;
                float sc = dot_row<DK>(q, Ks + kk * DK);
                if (MODE == 0) sc += aux[s];
                if (MODE == 1) sc += aux[t - s];
                online_update(sc, m, lsum, o, Vs + kk * 64); }
        }
        write_mix(P, b, h, t, MODE == 0 ? 0 : (MODE == 1 ? 256 : 768), lsum, o);
        __syncthreads();
    }
}

DEVINL void dil_naive_phase(const Params& P, char* smem) {
    float* lut_s = (float*)smem; const int tid = threadIdx.x;
    const bf16_t* Qb = (const bf16_t*)(P.ws + OFF_QKV + 6 * SZ_HEADBUF); const bf16_t* Kb = Qb + SZ_HEADBUF / 2; const bf16_t* Vb = Kb + SZ_HEADBUF / 2;
    for (int u = blockIdx.x; u < NBH * 16; u += gridDim.x) {
        const int bh = u >> 4, qb = u & 15, b = bh >> 2, h = bh & 3, t = qb * 256 + tid;
        __syncthreads();
        { const float* lut = (const float*)(P.ws + OFF_LUT) + (size_t)(4 + h) * 4096; for (int i = tid; i < 2304; i += 256) lut_s[i] = lut[i]; }
        __syncthreads();
        float q[64];
        { const bf16_t* qp = Qb + ((size_t)bh * SEQ + t) * 64;
#pragma unroll
          for (int c = 0; c < 8; ++c) { const u32x4 w = *(const u32x4*)(qp + c * 8); q[c * 8] = bflo(w.x); q[c * 8 + 1] = bfhi(w.x); q[c * 8 + 2] = bflo(w.y); q[c * 8 + 3] = bfhi(w.y); q[c * 8 + 4] = bflo(w.z); q[c * 8 + 5] = bfhi(w.z); q[c * 8 + 6] = bflo(w.w); q[c * 8 + 7] = bfhi(w.w); } }
        float o[64], m = -3.0e38f, lsum = 0.f;
#pragma unroll
        for (int d = 0; d < 64; ++d) o[d] = 0.f;
        for (int pat = 0; pat < 3; ++pat) { const int dil = pat == 0 ? 1 : (pat == 1 ? 4 : 16);
            for (int j = 0; j <= 128; ++j) { const int dd = dil * j, s = t - dd; if (s < 0) break;
                const float sc = dot_row<64>(q, Kb + ((size_t)bh * SEQ + s) * 64) + lut_s[dd];
                online_update(sc, m, lsum, o, Vb + ((size_t)bh * SEQ + s) * 64); } }
        write_mix(P, b, h, t, 512, lsum, o);
    }
}

constexpr int SMEM_BYTES = 64 * 96 * 2 + 64 * 64 * 2 + 4096 * 4 + 256 * 4;

template <int PH> DEVINL void run_phase(const Params& P, int l, char* smem) {
    char* ws = P.ws; char* ob = (char*)P.out;
    const float* xin = l == 0 ? P.x : (const float*)(ws + OFF_X);
    float* xa = P.out;
    float* xout = l == 0 ? (float*)(ws + OFF_X) : P.out;
    if (PH == 0) phase_prep(P, smem);
    if (PH == 1) phase_rms(xin, P.ln_g + l * DM, (bf16_t*)(ws + OFF_H), P.p + (size_t)l * NT * 256, (bf16_t*)(ws + OFF_PB));
    if (PH == 2) gemm_phase((const bf16_t*)(ws + OFF_H), (const bf16_t*)(ws + OFF_WT_IN + l * SZ_WT_IN), NT, NP1, 1024, EpiIn{P, l}, smem);
    if (PH == 3) { gemm_phase((const bf16_t*)(ws + OFF_CQ), (const bf16_t*)(ws + OFF_WT_UQ + l * SZ_WT_UQ), NT, 384, 256, EpiUq{P, l}, smem);
                   gemm_phase((const bf16_t*)(ws + OFF_CKV), (const bf16_t*)(ws + OFF_WT_UKV + l * SZ_WT_UKV), NT, 512, 128, EpiUkv{P, l}, smem);
                   phase_kmean(P, smem); }
    if (PH == 4) attn_naive_phase<64, 0>(P, smem);
    if (PH == 5) attn_naive_phase<64, 1>(P, smem);
    if (PH == 6) attn_naive_phase<96, 2>(P, smem);
    if (PH == 7) dil_naive_phase(P, smem);
    if (PH == 8) { gemm_phase((const bf16_t*)(ws + OFF_H), (const bf16_t*)(ws + OFF_WT_OUT + l * SZ_WT_SQ), NT, 1024, 1024, EpiResid{xin, xa}, smem);
                   gemm_phase((const bf16_t*)(ws + OFF_PB), (const bf16_t*)(ws + OFF_WT_PP + l * SZ_WT_PP), NT, 1024, 256, EpiStore{(float*)(ws + OFF_QKV)}, smem); }
    if (PH == 9) phase_rms(xa, P.ple_norm_g + l * DM, (bf16_t*)(ws + OFF_H), nullptr, nullptr);
    if (PH == 10) gemm_phase((const bf16_t*)(ws + OFF_H), (const bf16_t*)(ws + OFF_WT_PG + l * SZ_WT_SQ), NT, 1024, 1024, EpiPle{xa, (const float*)(ws + OFF_QKV), xout}, smem);
    (void)ob;
}

template <int PH> __global__ void __launch_bounds__(NTHREADS) k_phase(Params P, int l) {
    __shared__ __attribute__((aligned(16))) char smem[SMEM_BYTES];
    run_phase<PH>(P, l, smem);
}

__global__ void __launch_bounds__(NTHREADS) k_mega(Params P) {
    __shared__ __attribute__((aligned(16))) char smem[SMEM_BYTES];
    cooperative_groups::grid_group grid = cooperative_groups::this_grid();
    run_phase<0>(P, 0, smem); grid.sync();
    for (int l = 0; l < 2; ++l) {
        run_phase<1>(P, l, smem); grid.sync();
        run_phase<2>(P, l, smem); grid.sync();
        run_phase<3>(P, l, smem); grid.sync();
        run_phase<4>(P, l, smem); run_phase<5>(P, l, smem); run_phase<6>(P, l, smem); run_phase<7>(P, l, smem); grid.sync();
        run_phase<8>(P, l, smem); grid.sync();
        run_phase<9>(P, l, smem); grid.sync();
        run_phase<10>(P, l, smem); grid.sync();
    }
}
}

extern "C" void kernel_launch(void* const* d_in, const int* in_sizes, int n_in, void* d_out, int out_size, void* d_ws, size_t ws_size, hipStream_t stream) {
    Params P{};
    P.x = (const float*)d_in[0]; P.p = (const float*)d_in[1]; P.ln_g = (const float*)d_in[2]; P.w_in = (const float*)d_in[3]; P.b_forget = (const float*)d_in[4]; P.qk_gain = (const float*)d_in[5];
    P.mla_q_norm = (const float*)d_in[6]; P.mla_kv_norm = (const float*)d_in[7]; P.mla_nope_gain = (const float*)d_in[8]; P.mla_rope_gain = (const float*)d_in[9]; P.w_uq = (const float*)d_in[10];
    P.w_ukv = (const float*)d_in[11]; P.w_out = (const float*)d_in[12]; P.rel_bias = (const float*)d_in[13]; P.ple_norm_g = (const float*)d_in[14]; P.w_ple_gate = (const float*)d_in[15]; P.w_ple_proj = (const float*)d_in[16];
    P.out = (float*)d_out; P.ws = (char*)d_ws;
    if (ws_size < WS_NEED) { fprintf(stderr, "workspace too small: %zu < %zu\n", ws_size, (size_t)WS_NEED); return; }
    const dim3 blk(NTHREADS);
#if ONE_LAUNCH
    static int grid_blocks = 0;
    if (!grid_blocks) {
        int dev = 0, cus = 0, per_cu = 0;
        hipGetDevice(&dev);
        hipDeviceGetAttribute(&cus, hipDeviceAttributeMultiprocessorCount, dev);
        hipOccupancyMaxActiveBlocksPerMultiprocessor(&per_cu, k_mega, NTHREADS, 0);
        if (per_cu > 4) per_cu = 4;
        grid_blocks = cus * per_cu;
    }
    void* args[] = {&P};
    hipError_t e = hipLaunchCooperativeKernel((void*)k_mega, dim3(grid_blocks), blk, args, 0, stream);
    if (e != hipSuccess) fprintf(stderr, "cooperative launch failed: %s (grid %d)\n", hipGetErrorString(e), grid_blocks);
#else
    k_phase<0><<<2048, blk, 0, stream>>>(P, 0);
    for (int l = 0; l < 2; ++l) {
        k_phase<1><<<2048, blk, 0, stream>>>(P, l);
        k_phase<2><<<3840, blk, 0, stream>>>(P, l);
        k_phase<3><<<1024, blk, 0, stream>>>(P, l);
        k_phase<4><<<256, blk, 0, stream>>>(P, l);
        k_phase<5><<<256, blk, 0, stream>>>(P, l);
        k_phase<6><<<256, blk, 0, stream>>>(P, l);
        k_phase<7><<<256, blk, 0, stream>>>(P, l);
        k_phase<8><<<2048, blk, 0, stream>>>(P, l);
        k_phase<9><<<2048, blk, 0, stream>>>(P, l);
        k_phase<10><<<1024, blk, 0, stream>>>(P, l);
    }
#endif
}
```

```cpp
#include <hip/hip_runtime.h>
#include <hip/hip_cooperative_groups.h>
#include <cstdint>
#include <cstdio>

#ifndef ONE_LAUNCH
#define ONE_LAUNCH 1
#endif

namespace {
#define DEVINL __device__ __forceinline__
typedef unsigned short bf16_t;
typedef short bf16x8 __attribute__((ext_vector_type(8)));
typedef float f32x4 __attribute__((ext_vector_type(4)));
typedef unsigned u32x2 __attribute__((ext_vector_type(2)));
typedef unsigned u32x4 __attribute__((ext_vector_type(4)));

constexpr int NB = 4, SEQ = 4096, DM = 1024, NT = NB * SEQ, NH = 4, NBH = NB * NH;
constexpr int INW = 3748, NP1 = 3840;
constexpr float EPS = 1e-6f, LOG2E = 1.4426950408889634f;
constexpr float SC_Q = 0.125f * LOG2E;
constexpr float SC_MLA = 0.10206207261596575f * LOG2E;
constexpr int NTHREADS = 512;

constexpr size_t SZ_WT_IN = (size_t)NP1 * 1024 * 2, SZ_WT_UQ = 384 * 256 * 2, SZ_WT_UKV = 512 * 128 * 2, SZ_WT_SQ = 1024 * 1024 * 2, SZ_WT_PP = 1024 * 256 * 2;
constexpr size_t OFF_WT_IN = 0;
constexpr size_t OFF_WT_UQ = OFF_WT_IN + 2 * SZ_WT_IN;
constexpr size_t OFF_WT_UKV = OFF_WT_UQ + 2 * SZ_WT_UQ;
constexpr size_t OFF_WT_OUT = OFF_WT_UKV + 2 * SZ_WT_UKV;
constexpr size_t OFF_WT_PG = OFF_WT_OUT + 2 * SZ_WT_SQ;
constexpr size_t OFF_WT_PP = OFF_WT_PG + 2 * SZ_WT_SQ;
constexpr size_t OFF_LUT = OFF_WT_PP + 2 * SZ_WT_PP;
constexpr size_t OFF_ROPE = OFF_LUT + 8 * 4096 * 4;
constexpr size_t OFF_H = OFF_ROPE + 4096 * 16 * 8;
constexpr size_t SZ_HEADBUF = (size_t)NT * 256 * 2;
constexpr size_t OFF_QKV = OFF_H + (size_t)NT * 1024 * 2;
constexpr size_t OFF_CQ = OFF_QKV + 9 * SZ_HEADBUF;
constexpr size_t OFF_CKV = OFF_CQ + (size_t)NT * 256 * 2;
constexpr size_t OFF_CQSS = OFF_CKV + (size_t)NT * 128 * 2;
constexpr size_t OFF_CKVSS = OFF_CQSS + (size_t)NT * 4 * 4;
constexpr size_t OFF_LOGF = OFF_CKVSS + (size_t)NT * 2 * 4;
constexpr size_t OFF_KMEAN = OFF_LOGF + (size_t)NBH * SEQ * 4;
constexpr size_t OFF_PB = OFF_KMEAN + (size_t)NBH * 16 * 64 * 4;
constexpr size_t OFF_X = OFF_PB + (size_t)NT * 256 * 2;
constexpr size_t OFF_DPART = OFF_X + (size_t)NT * 1024 * 4;
constexpr size_t OFF_DLSE = OFF_DPART + 3 * (size_t)NT * 256 * 2;
constexpr size_t OFF_CTR = OFF_DLSE + 3 * (size_t)NT * 4 * 4;
constexpr size_t WS_NEED = OFF_CTR + 256;
constexpr size_t OOFF_G = 0;
constexpr size_t OOFF_QM = (size_t)NT * 1024 * 2;
constexpr size_t OOFF_KM = OOFF_QM + (size_t)NBH * SEQ * 96 * 2;
constexpr size_t OOFF_VM = OOFF_KM + (size_t)NBH * SEQ * 96 * 2;

struct Params {
    const float *x, *p, *ln_g, *w_in, *b_forget, *qk_gain, *mla_q_norm, *mla_kv_norm, *mla_nope_gain, *mla_rope_gain, *w_uq, *w_ukv, *w_out, *rel_bias, *ple_norm_g, *w_ple_gate, *w_ple_proj;
    float* out;
    char* ws;
};

DEVINL int ltid() { int t = threadIdx.x; asm volatile("" : "+v"(t)); return t; }
DEVINL bf16_t f2bf(float f) { unsigned u = __float_as_uint(f); u += 0x7fffu + ((u >> 16) & 1u); return (bf16_t)(u >> 16); }
DEVINL float bf2f(bf16_t h) { return __uint_as_float(((unsigned)h) << 16); }
DEVINL unsigned pack2(float a, float b) { return (unsigned)f2bf(a) | ((unsigned)f2bf(b) << 16); }
DEVINL float bflo(unsigned u) { return __uint_as_float(u << 16); }
DEVINL float bfhi(unsigned u) { return __uint_as_float(u & 0xffff0000u); }

__device__ __constant__ float ROPE_INV[16] = {1.0f, 0.5623413251903491f, 0.31622776601683794f, 0.1778279410038923f, 0.1f, 0.05623413251903491f, 0.03162277660168379f, 0.01778279410038923f,
                                              0.01f, 0.005623413251903491f, 0.0031622776601683794f, 0.0017782794100389228f, 0.001f, 0.0005623413251903491f, 0.00031622776601683794f, 0.00017782794100389227f};

DEVINL int t5_bucket(int d) {
    if (d < 16) return d;
    int b = 16;
    b += (d >= 22); b += (d >= 30); b += (d >= 40); b += (d >= 54); b += (d >= 73); b += (d >= 99); b += (d >= 134); b += (d >= 182);
    b += (d >= 246); b += (d >= 332); b += (d >= 450); b += (d >= 609); b += (d >= 825); b += (d >= 1117); b += (d >= 1513);
    return b;
}

DEVINL int map_w_in(int n) { return n < 768 ? n : (n < 2720 ? n + 4 : (n < 2724 ? n - 2720 + 768 : (n < 2816 ? -1 : n - 92))); }
DEVINL int map_w_uq(int n) { if (n < 256) return (n >> 6) * 96 + (n & 63); const int r = n - 256; return (r >> 5) * 96 + 64 + (r & 31); }

DEVINL void transpose_tile(const float* src, int Nsrc, bf16_t* dst, int K, int tn, int tk, int mode, const float* fold, float* tile  ) {
    const int tid = ltid(), c = tid & 63, rb = tid >> 6  , n0 = tn * 64, k0 = tk * 64;
    const int n = n0 + c, oc = mode == 1 ? map_w_in(n) : (mode == 2 ? map_w_uq(n) : n);
#pragma unroll 4
    for (int i = 0; i < 8; ++i) { const int kk = rb + 8 * i; float v = 0.f; if (oc >= 0) { v = src[(size_t)(k0 + kk) * Nsrc + oc]; if (fold) v *= fold[k0 + kk]; } tile[kk * 65 + c] = v; }
    __syncthreads();
#pragma unroll 4
    for (int i = 0; i < 8; ++i) { const int nn = rb + 8 * i; dst[(size_t)(n0 + nn) * K + k0 + c] = f2bf(tile[c * 65 + nn]); }
    __syncthreads();
}

constexpr int PREP_T_IN = 60 * 16, PREP_T_UQ = 6 * 4, PREP_T_UKV = 8 * 2, PREP_T_SQ = 16 * 16, PREP_T_PP = 16 * 4;
constexpr int PREP_PER_LAYER = PREP_T_IN + PREP_T_UQ + PREP_T_UKV + 2 * PREP_T_SQ + PREP_T_PP;
constexpr int PREP_LUT_UNITS = 8 * 4096 / 512, PREP_ROPE_UNITS = 4096 * 16 / 512;
constexpr int PREP_UNITS = 2 * PREP_PER_LAYER + PREP_LUT_UNITS + PREP_ROPE_UNITS;

DEVINL void phase_prep(const Params& P, char* smem) {
    float* tile = (float*)smem;
    if (blockIdx.x == 0 && ltid() < 64) ((unsigned*)(P.ws + OFF_CTR))[ltid()] = 0u;
    for (int u = blockIdx.x; u < PREP_UNITS; u += gridDim.x) {
        if (u < 2 * PREP_PER_LAYER) {
            const int l = u / PREP_PER_LAYER; int r = u % PREP_PER_LAYER;
            if (r < PREP_T_IN) { transpose_tile(P.w_in + (size_t)l * 1024 * INW, INW, (bf16_t*)(P.ws + OFF_WT_IN + l * SZ_WT_IN), 1024, r % 60, r / 60, 1, nullptr, tile); continue; }
            r -= PREP_T_IN;
            if (r < PREP_T_UQ) { transpose_tile(P.w_uq + (size_t)l * 256 * 384, 384, (bf16_t*)(P.ws + OFF_WT_UQ + l * SZ_WT_UQ), 256, r % 6, r / 6, 2, P.mla_q_norm + l * 256, tile); continue; }
            r -= PREP_T_UQ;
            if (r < PREP_T_UKV) { transpose_tile(P.w_ukv + (size_t)l * 128 * 512, 512, (bf16_t*)(P.ws + OFF_WT_UKV + l * SZ_WT_UKV), 128, r % 8, r / 8, 0, P.mla_kv_norm + l * 128, tile); continue; }
            r -= PREP_T_UKV;
            if (r < PREP_T_SQ) { transpose_tile(P.w_out + (size_t)l * 1024 * 1024, 1024, (bf16_t*)(P.ws + OFF_WT_OUT + l * SZ_WT_SQ), 1024, r % 16, r / 16, 0, nullptr, tile); continue; }
            r -= PREP_T_SQ;
            if (r < PREP_T_SQ) { transpose_tile(P.w_ple_gate + (size_t)l * 1024 * 1024, 1024, (bf16_t*)(P.ws + OFF_WT_PG + l * SZ_WT_SQ), 1024, r % 16, r / 16, 0, nullptr, tile); continue; }
            r -= PREP_T_SQ;
            transpose_tile(P.w_ple_proj + (size_t)l * 256 * 1024, 1024, (bf16_t*)(P.ws + OFF_WT_PP + l * SZ_WT_PP), 256, r % 16, r / 16, 0, nullptr, tile);
        } else if (u < 2 * PREP_PER_LAYER + PREP_LUT_UNITS) {
            const int e = (u - 2 * PREP_PER_LAYER) * 512 + ltid(), hh = e >> 12, d = e & 4095;
            ((float*)(P.ws + OFF_LUT))[e] = P.rel_bias[t5_bucket(d) * 8 + hh] * LOG2E;
        } else {
            const int e = (u - 2 * PREP_PER_LAYER - PREP_LUT_UNITS) * 512 + ltid(), pos = e >> 4, i = e & 15;
            const double rev = (double)pos * (double)ROPE_INV[i] * 0.15915494309189535; const float fr = (float)(rev - floor(rev));
            ((float2*)(P.ws + OFF_ROPE))[e] = make_float2(__builtin_amdgcn_cosf(fr), __builtin_amdgcn_sinf(fr));
        }
    }
}

DEVINL float wave_sum(float v) {
#pragma unroll
    for (int o = 32; o > 0; o >>= 1) v += __shfl_xor(v, o);
    return v;
}
DEVINL void phase_rms(const float* src, const float* g, bf16_t* dst, const float* psrc, bf16_t* pb) {
    const int wid = ltid() >> 6, lane = ltid() & 63;
    for (int u = blockIdx.x; u < NT / 8; u += gridDim.x) {
        const int row = u * 8 + wid; const float* xr = src + (size_t)row * DM;
        f32x4 v[4]; float ss = 0.f;
#pragma unroll
        for (int i = 0; i < 4; ++i) { v[i] = *(const f32x4*)(xr + i * 256 + lane * 4); ss += v[i][0] * v[i][0] + v[i][1] * v[i][1] + v[i][2] * v[i][2] + v[i][3] * v[i][3]; }
        ss = wave_sum(ss); const float r = rsqrtf(ss * (1.0f / DM) + EPS);
#pragma unroll
        for (int i = 0; i < 4; ++i) { const f32x4 gg = *(const f32x4*)(g + i * 256 + lane * 4); u32x2 w; w.x = pack2(v[i][0] * r * gg[0], v[i][1] * r * gg[1]); w.y = pack2(v[i][2] * r * gg[2], v[i][3] * r * gg[3]);
            *(u32x2*)(dst + (size_t)row * DM + i * 256 + lane * 4) = w; }
        if (psrc) { const f32x4 pv = *(const f32x4*)(psrc + (size_t)row * 256 + lane * 4); u32x2 w; w.x = pack2(pv[0], pv[1]); w.y = pack2(pv[2], pv[3]); *(u32x2*)(pb + (size_t)row * 256 + lane * 4) = w; }
    }
}

constexpr int GST = 40;
template <class Epi>
DEVINL void gemm_phase(const bf16_t* A, const bf16_t* Bt, int M, int N, int K, const Epi& epi, char* smem) {
    bf16_t* As = (bf16_t*)smem; bf16_t* Bs = As + 256 * GST;
    const int tid = ltid(), wid = tid >> 6, lane = tid & 63, wr = wid >> 1, wc = wid & 1, fr = lane & 15, fq = lane >> 4;
    const int ntm = M / 256, ntn = N / 128, nk = K / 32;
    const int lr = tid >> 2, lc = (tid & 3) * 8;
    for (int tile = blockIdx.x; tile < ntm * ntn; tile += gridDim.x) {
        const int tm = tile % ntm, tn = tile / ntm;
        const bf16_t* Ag = A + (size_t)(tm * 256 + lr) * K + lc; const bf16_t* Bg = Bt + (size_t)(tn * 128 + lr) * K + lc;
        f32x4 acc[4][4];
#pragma unroll
        for (int m = 0; m < 4; ++m)
#pragma unroll
            for (int n = 0; n < 4; ++n) acc[m][n] = (f32x4){0.f, 0.f, 0.f, 0.f};
        u32x4 ra0 = *(const u32x4*)Ag, ra1 = *(const u32x4*)(Ag + (size_t)128 * K), rb0 = *(const u32x4*)Bg;
        for (int kt = 0; kt < nk; ++kt) {
            __syncthreads();
            *(u32x4*)(As + lr * GST + lc) = ra0; *(u32x4*)(As + (lr + 128) * GST + lc) = ra1; *(u32x4*)(Bs + lr * GST + lc) = rb0;
            __syncthreads();
            if (kt + 1 < nk) { const int ko = (kt + 1) * 32; ra0 = *(const u32x4*)(Ag + ko); ra1 = *(const u32x4*)(Ag + (size_t)128 * K + ko); rb0 = *(const u32x4*)(Bg + ko); }
            bf16x8 af[4], bfr[4];
#pragma unroll
            for (int m = 0; m < 4; ++m) af[m] = *(const bf16x8*)(As + (wr * 64 + m * 16 + fr) * GST + fq * 8);
#pragma unroll
            for (int n = 0; n < 4; ++n) bfr[n] = *(const bf16x8*)(Bs + (wc * 64 + n * 16 + fr) * GST + fq * 8);
#pragma unroll
            for (int m = 0; m < 4; ++m)
#pragma unroll
                for (int n = 0; n < 4; ++n) acc[m][n] = __builtin_amdgcn_mfma_f32_16x16x32_bf16(bfr[n], af[m], acc[m][n], 0, 0, 0);
        }
        epi(acc, tm * 256 + wr * 64, tn * 2 + wc, fr, fq);
    }
    __syncthreads();
}

DEVINL float quad_sum(float v) { v += __shfl_xor(v, 16); v += __shfl_xor(v, 32); return v; }
DEVINL void store4bf(bf16_t* p, float a, float b, float c, float d) { u32x2 w; w.x = pack2(a, b); w.y = pack2(c, d); *(u32x2*)p = w; }
DEVINL float log_sigmoid(float z) { return fminf(z, 0.f) - log1pf(__expf(-fabsf(z))); }

struct EpiIn {
    Params P; int l;
    DEVINL void operator()(f32x4 (&acc)[4][4], int row0, int chunk, int fr, int fq) const {
        char* ws = P.ws; char* ob = (char*)P.out;
        if (chunk < 36) {
            const int g = chunk >> 2, h = chunk & 3, role = g % 3, mix = g / 3;
            bf16_t* dst = (bf16_t*)(ws + OFF_QKV + (size_t)g * SZ_HEADBUF);
            const float* gain = P.qk_gain + ((size_t)l * 6 + 2 * mix + (role == 1 ? 1 : 0)) * 64;
#pragma unroll
            for (int m = 0; m < 4; ++m) {
                const int t = row0 + 16 * m + fr, b = t >> 12, s = t & 4095; bf16_t* d = dst + ((size_t)(b * 4 + h) * SEQ + s) * 64 + 4 * fq;
                float r = 1.f;
                if (role != 2) { float ss = 0.f;
#pragma unroll
                    for (int n = 0; n < 4; ++n) ss += acc[m][n][0] * acc[m][n][0] + acc[m][n][1] * acc[m][n][1] + acc[m][n][2] * acc[m][n][2] + acc[m][n][3] * acc[m][n][3];
                    ss = quad_sum(ss); r = rsqrtf(ss * (1.0f / 64.0f) + EPS) * (role == 0 ? SC_Q : 1.0f); }
#pragma unroll
                for (int n = 0; n < 4; ++n) { f32x4 gg = (f32x4){1.f, 1.f, 1.f, 1.f}; if (role != 2) gg = *(const f32x4*)(gain + 16 * n + 4 * fq);
                    store4bf(d + 16 * n, acc[m][n][0] * r * gg[0], acc[m][n][1] * r * gg[1], acc[m][n][2] * r * gg[2], acc[m][n][3] * r * gg[3]); }
            }
        } else if (chunk < 42) {
            const bool isq = chunk < 40; const int c = isq ? chunk - 36 : chunk - 40;
            bf16_t* dst = isq ? (bf16_t*)(ws + OFF_CQ) : (bf16_t*)(ws + OFF_CKV); const int ld = isq ? 256 : 128;
            float* ssp = isq ? (float*)(ws + OFF_CQSS) : (float*)(ws + OFF_CKVSS); const int nss = isq ? 4 : 2;
#pragma unroll
            for (int m = 0; m < 4; ++m) {
                const int t = row0 + 16 * m + fr; float ss = 0.f;
#pragma unroll
                for (int n = 0; n < 4; ++n) { ss += acc[m][n][0] * acc[m][n][0] + acc[m][n][1] * acc[m][n][1] + acc[m][n][2] * acc[m][n][2] + acc[m][n][3] * acc[m][n][3];
                    store4bf(dst + (size_t)t * ld + c * 64 + 16 * n + 4 * fq, acc[m][n][0], acc[m][n][1], acc[m][n][2], acc[m][n][3]); }
                ss = quad_sum(ss); if (fq == 0) ssp[(size_t)t * nss + c] = ss;
            }
        } else if (chunk == 42) {
            const float* gr = P.mla_rope_gain + ((size_t)l * 2 + 1) * 32; const float2* rope = (const float2*)(ws + OFF_ROPE);
            bf16_t* km = (bf16_t*)(ob + OOFF_KM); float* logf_ = (float*)(ws + OFF_LOGF);
            const f32x4 g1 = *(const f32x4*)(gr + 4 * fq), g2 = *(const f32x4*)(gr + 16 + 4 * fq); const f32x4 bfv = *(const f32x4*)(P.b_forget + l * 4);
#pragma unroll
            for (int m = 0; m < 4; ++m) {
                const int t = row0 + 16 * m + fr, b = t >> 12, s = t & 4095;
                float ss = 0.f;
#pragma unroll
                for (int n = 0; n < 2; ++n) ss += acc[m][n][0] * acc[m][n][0] + acc[m][n][1] * acc[m][n][1] + acc[m][n][2] * acc[m][n][2] + acc[m][n][3] * acc[m][n][3];
                ss = quad_sum(ss); const float r = rsqrtf(ss * (1.0f / 32.0f) + EPS);
                float o1[4], o2[4];
#pragma unroll
                for (int j = 0; j < 4; ++j) { const float2 cs = rope[s * 16 + 4 * fq + j]; const float x1 = acc[m][0][j] * r * g1[j], x2 = acc[m][1][j] * r * g2[j]; o1[j] = x1 * cs.x - x2 * cs.y; o2[j] = x1 * cs.y + x2 * cs.x; }
#pragma unroll
                for (int h = 0; h < 4; ++h) { bf16_t* d = km + ((size_t)(b * 4 + h) * SEQ + s) * 96 + 64 + 4 * fq; store4bf(d, o1[0], o1[1], o1[2], o1[3]); store4bf(d + 16, o2[0], o2[1], o2[2], o2[3]); }
                if (fq == 0) {
#pragma unroll
                    for (int j = 0; j < 4; ++j) logf_[(size_t)(b * 4 + j) * SEQ + s] = log_sigmoid(acc[m][2][j] + bfv[j]) * LOG2E;
                }
            }
        } else if (chunk >= 44) {
            bf16_t* G = (bf16_t*)(ob + OOFF_G); const int c0 = (chunk - 44) * 64;
#pragma unroll
            for (int m = 0; m < 4; ++m) { const int t = row0 + 16 * m + fr;
#pragma unroll
                for (int n = 0; n < 4; ++n) { float o[4];
#pragma unroll
                    for (int j = 0; j < 4; ++j) { const float z = acc[m][n][j]; o[j] = z / (1.0f + __expf(-z)); }
                    store4bf(G + (size_t)t * DM + c0 + 16 * n + 4 * fq, o[0], o[1], o[2], o[3]); } }
        }
    }
};

struct EpiUq {
    Params P; int l;
    DEVINL void operator()(f32x4 (&acc)[4][4], int row0, int chunk, int fr, int fq) const {
        const float* cqss = (const float*)(P.ws + OFF_CQSS); bf16_t* qm = (bf16_t*)((char*)P.out + OOFF_QM); const float2* rope = (const float2*)(P.ws + OFF_ROPE);
#pragma unroll
        for (int m = 0; m < 4; ++m) {
            const int t = row0 + 16 * m + fr, b = t >> 12, s = t & 4095; const f32x4 pss = *(const f32x4*)(cqss + (size_t)t * 4);
            const float rt = rsqrtf((pss[0] + pss[1] + pss[2] + pss[3]) * (1.0f / 256.0f) + EPS);
            if (chunk < 4) {
                const float* gain = P.mla_nope_gain + ((size_t)l * 2 + 0) * 64; float ss = 0.f;
#pragma unroll
                for (int n = 0; n < 4; ++n) { acc[m][n] = acc[m][n] * rt; ss += acc[m][n][0] * acc[m][n][0] + acc[m][n][1] * acc[m][n][1] + acc[m][n][2] * acc[m][n][2] + acc[m][n][3] * acc[m][n][3]; }
                ss = quad_sum(ss); const float r = rsqrtf(ss * (1.0f / 64.0f) + EPS) * SC_MLA; bf16_t* d = qm + ((size_t)(b * 4 + chunk) * SEQ + s) * 96 + 4 * fq;
#pragma unroll
                for (int n = 0; n < 4; ++n) { const f32x4 gg = *(const f32x4*)(gain + 16 * n + 4 * fq); store4bf(d + 16 * n, acc[m][n][0] * r * gg[0], acc[m][n][1] * r * gg[1], acc[m][n][2] * r * gg[2], acc[m][n][3] * r * gg[3]); }
            } else {
                const float* gr = P.mla_rope_gain + ((size_t)l * 2 + 0) * 32; const f32x4 g1 = *(const f32x4*)(gr + 4 * fq), g2 = *(const f32x4*)(gr + 16 + 4 * fq);
#pragma unroll
                for (int hh = 0; hh < 2; ++hh) {
                    const int h = (chunk - 4) * 2 + hh; float ss = 0.f;
#pragma unroll
                    for (int n = 0; n < 2; ++n) { acc[m][2 * hh + n] = acc[m][2 * hh + n] * rt; const f32x4 a = acc[m][2 * hh + n]; ss += a[0] * a[0] + a[1] * a[1] + a[2] * a[2] + a[3] * a[3]; }
                    ss = quad_sum(ss); const float r = rsqrtf(ss * (1.0f / 32.0f) + EPS);
                    float o1[4], o2[4];
#pragma unroll
                    for (int j = 0; j < 4; ++j) { const float2 cs = rope[s * 16 + 4 * fq + j]; const float x1 = acc[m][2 * hh][j] * r * g1[j], x2 = acc[m][2 * hh + 1][j] * r * g2[j];
                        o1[j] = (x1 * cs.x - x2 * cs.y) * SC_MLA; o2[j] = (x1 * cs.y + x2 * cs.x) * SC_MLA; }
                    bf16_t* d = qm + ((size_t)(b * 4 + h) * SEQ + s) * 96 + 64 + 4 * fq; store4bf(d, o1[0], o1[1], o1[2], o1[3]); store4bf(d + 16, o2[0], o2[1], o2[2], o2[3]);
                }
            }
        }
    }
};
struct EpiUkv {
    Params P; int l;
    DEVINL void operator()(f32x4 (&acc)[4][4], int row0, int chunk, int fr, int fq) const {
        const float* ckvss = (const float*)(P.ws + OFF_CKVSS); bf16_t* km = (bf16_t*)((char*)P.out + OOFF_KM); bf16_t* vm = (bf16_t*)((char*)P.out + OOFF_VM);
        const int h = chunk >> 1; const bool isk = (chunk & 1) == 0; const float* gain = P.mla_nope_gain + ((size_t)l * 2 + 1) * 64;
#pragma unroll
        for (int m = 0; m < 4; ++m) {
            const int t = row0 + 16 * m + fr, b = t >> 12, s = t & 4095; const float rt = rsqrtf((ckvss[(size_t)t * 2] + ckvss[(size_t)t * 2 + 1]) * (1.0f / 128.0f) + EPS);
            float ss = 0.f;
#pragma unroll
            for (int n = 0; n < 4; ++n) { acc[m][n] = acc[m][n] * rt; ss += acc[m][n][0] * acc[m][n][0] + acc[m][n][1] * acc[m][n][1] + acc[m][n][2] * acc[m][n][2] + acc[m][n][3] * acc[m][n][3]; }
            if (isk) { ss = quad_sum(ss); const float r = rsqrtf(ss * (1.0f / 64.0f) + EPS); bf16_t* d = km + ((size_t)(b * 4 + h) * SEQ + s) * 96 + 4 * fq;
#pragma unroll
                for (int n = 0; n < 4; ++n) { const f32x4 gg = *(const f32x4*)(gain + 16 * n + 4 * fq); store4bf(d + 16 * n, acc[m][n][0] * r * gg[0], acc[m][n][1] * r * gg[1], acc[m][n][2] * r * gg[2], acc[m][n][3] * r * gg[3]); }
            } else { bf16_t* d = vm + ((size_t)(b * 4 + h) * SEQ + s) * 64 + 4 * fq;
#pragma unroll
                for (int n = 0; n < 4; ++n) store4bf(d + 16 * n, acc[m][n][0], acc[m][n][1], acc[m][n][2], acc[m][n][3]); }
        }
    }
};
struct EpiResid { const float* base; float* out;
    DEVINL void operator()(f32x4 (&acc)[4][4], int row0, int chunk, int fr, int fq) const {
#pragma unroll
        for (int m = 0; m < 4; ++m) { const size_t o = (size_t)(row0 + 16 * m + fr) * DM + chunk * 64 + 4 * fq;
#pragma unroll
            for (int n = 0; n < 4; ++n) { const f32x4 bv = *(const f32x4*)(base + o + 16 * n); *(f32x4*)(out + o + 16 * n) = bv + acc[m][n]; } } } };
struct EpiStore { float* out;
    DEVINL void operator()(f32x4 (&acc)[4][4], int row0, int chunk, int fr, int fq) const {
#pragma unroll
        for (int m = 0; m < 4; ++m) { const size_t o = (size_t)(row0 + 16 * m + fr) * DM + chunk * 64 + 4 * fq;
#pragma unroll
            for (int n = 0; n < 4; ++n) *(f32x4*)(out + o + 16 * n) = acc[m][n]; } } };
struct EpiPle { const float* xa; const float* pp; float* out;
    DEVINL void operator()(f32x4 (&acc)[4][4], int row0, int chunk, int fr, int fq) const {
#pragma unroll
        for (int m = 0; m < 4; ++m) { const size_t o = (size_t)(row0 + 16 * m + fr) * DM + chunk * 64 + 4 * fq;
#pragma unroll
            for (int n = 0; n < 4; ++n) { const f32x4 xv = *(const f32x4*)(xa + o + 16 * n), pv = *(const f32x4*)(pp + o + 16 * n); f32x4 r;
#pragma unroll
                for (int j = 0; j < 4; ++j) r[j] = xv[j] + pv[j] / (1.0f + __expf(-acc[m][n][j]));
                *(f32x4*)(out + o + 16 * n) = r; } } } };

DEVINL void kmean_unit(const Params& P, int u, char* smem) {
    float* red = (float*)smem; const bf16_t* K = (const bf16_t*)(P.ws + OFF_QKV + 4 * SZ_HEADBUF); float* km = (float*)(P.ws + OFF_KMEAN);
    const int tid = ltid(), d = tid & 63, part = tid >> 6;
    const bf16_t* kp = K + ((size_t)(u >> 4) * SEQ + (u & 15) * 256 + part * 32) * 64 + d; float s = 0.f;
    for (int i = 0; i < 32; ++i) s += bf2f(kp[(size_t)i * 64]);
    __syncthreads(); red[tid] = s; __syncthreads();
    if (part == 0) { float a = 0.f;
#pragma unroll
        for (int i = 0; i < 8; ++i) a += red[i * 64 + d];
        km[(size_t)u * 64 + d] = a * (1.0f / 256.0f); }
}

typedef float f32x16 __attribute__((ext_vector_type(16)));
typedef short s16x4 __attribute__((ext_vector_type(4)));
typedef short v4i16_t __attribute__((ext_vector_type(4)));
typedef __bf16 bf16v2 __attribute__((ext_vector_type(2)));
typedef float f32v2 __attribute__((ext_vector_type(2)));
#define LAS __attribute__((address_space(3)))
#define MFMA32(a, b, c) __builtin_amdgcn_mfma_f32_32x32x16_bf16(a, b, c, 0, 0, 0)
DEVINL unsigned cvt2(float a, float b) { f32v2 v = {a, b}; return __builtin_bit_cast(unsigned, __builtin_convertvector(v, bf16v2)); }
DEVINL s16x4 vtr(const LAS char* p) { return __builtin_bit_cast(s16x4, __builtin_amdgcn_ds_read_tr16_b64_v4i16((LAS v4i16_t*)p)); }
DEVINL float swap_max(float v) { auto rr = __builtin_amdgcn_permlane32_swap(__float_as_uint(v), __float_as_uint(v), false, false); return fmaxf(__uint_as_float(rr[0]), __uint_as_float(rr[1])); }
DEVINL float swap_sum(float v) { auto rr = __builtin_amdgcn_permlane32_swap(__float_as_uint(v), __float_as_uint(v), false, false); return __uint_as_float(rr[0]) + __uint_as_float(rr[1]); }
DEVINL constexpr int crow(int r) { return (r & 3) + 8 * (r >> 2); }

constexpr int L_KB = 0, L_VB = 16384, L_KR = 32768, L_AUX = 40960, L_SCR = 40960 + 16640, L_KMS = L_SCR + 2048, L_ATT_END = L_KMS + 4096;
constexpr float NEGBIG = -3.0e38f, THR = 8.0f;

template <int MODE>
DEVINL void attn_unit(const Params& P, int u, char* smem) {
    constexpr int DK = MODE == 2 ? 96 : 64, ND0 = DK / 16;
    LAS char* lds = (LAS char*)smem;
    const int tid = ltid(), lane = tid & 63, r32 = lane & 31, hi = lane >> 5; const int wid = __builtin_amdgcn_readfirstlane(tid >> 6);
    int bh, q0, t_lo, t_hi, dil = 1, res = 0, pat = 0, qb = 0;
    if (MODE != 3) { bh = u & 15; qb = 15 - (u >> 4); q0 = qb * 256; t_lo = 0; t_hi = (q0 + 255) >> 6; }
    else { pat = u >> 8; const int v = u & 255; bh = v & 15; const int w = v >> 4; dil = pat == 0 ? 1 : (pat == 1 ? 4 : 16); res = w % dil; q0 = (w / dil) * 256; t_lo = (q0 >= 128 ? q0 - 128 : 0) >> 6; t_hi = (q0 + 255) >> 6; }
    const int b = bh >> 2, h = bh & 3;
    const bf16_t *Qg, *Kg, *Vg; int rsq, rsk, rsv;
    if (MODE == 0) { Qg = (const bf16_t*)(P.ws + OFF_QKV) + (size_t)bh * SEQ * 64; Kg = Qg + SZ_HEADBUF / 2; Vg = Kg + SZ_HEADBUF / 2; rsq = rsk = rsv = 64; }
    else if (MODE == 1) { Qg = (const bf16_t*)(P.ws + OFF_QKV + 3 * SZ_HEADBUF) + (size_t)bh * SEQ * 64; Kg = Qg + SZ_HEADBUF / 2; Vg = Kg + SZ_HEADBUF / 2; rsq = rsk = rsv = 64; }
    else if (MODE == 2) { Qg = (const bf16_t*)((const char*)P.out + OOFF_QM) + (size_t)bh * SEQ * 96; Kg = (const bf16_t*)((const char*)P.out + OOFF_KM) + (size_t)bh * SEQ * 96; Vg = (const bf16_t*)((const char*)P.out + OOFF_VM) + (size_t)bh * SEQ * 64; rsq = rsk = 96; rsv = 64; }
    else { Qg = (const bf16_t*)(P.ws + OFF_QKV + 6 * SZ_HEADBUF) + ((size_t)bh * SEQ + res) * 64; Kg = Qg + SZ_HEADBUF / 2; Vg = Kg + SZ_HEADBUF / 2; rsq = rsk = rsv = 64 * dil; }
    const int qw = q0 + 32 * wid;

    __syncthreads();
    LAS float* aux = (LAS float*)(lds + L_AUX);
    if (MODE == 0) {
        LAS float* tot = (LAS float*)(lds + L_SCR);
        const float* lf = (const float*)(P.ws + OFF_LOGF) + (size_t)bh * SEQ + tid * 8; float v[8]; float run = 0.f;
        { const f32x4 a = *(const f32x4*)lf, c = *(const f32x4*)(lf + 4); v[0] = a[0]; v[1] = a[1]; v[2] = a[2]; v[3] = a[3]; v[4] = c[0]; v[5] = c[1]; v[6] = c[2]; v[7] = c[3]; }
#pragma unroll
        for (int i = 0; i < 8; ++i) { run += v[i]; v[i] = run; }
        tot[tid] = run; __syncthreads();
        if (tid < 64) { float a[8]; float acc = 0.f;
#pragma unroll
            for (int i = 0; i < 8; ++i) { acc += tot[tid * 8 + i]; a[i] = acc; }
            float incl = acc;
#pragma unroll
            for (int o = 1; o < 64; o <<= 1) { const float nb = __shfl_up(incl, o); if (tid >= o) incl += nb; }
            const float ex = incl - acc; tot[tid * 8] = ex;
#pragma unroll
            for (int i = 1; i < 8; ++i) tot[tid * 8 + i] = ex + a[i - 1]; }
        __syncthreads();
        const float base = tot[tid];
#pragma unroll
        for (int i = 0; i < 8; ++i) aux[tid * 8 + i] = -(base + v[i]);
    } else if (MODE == 1) {
        const float* lut = (const float*)(P.ws + OFF_LUT) + (size_t)h * 4096;
        for (int i = tid; i < 4160; i += NTHREADS) aux[i] = i >= 64 ? lut[i - 64] : 0.f;
        LAS float* kms = (LAS float*)(lds + L_KMS); const float* km = (const float*)(P.ws + OFF_KMEAN) + (size_t)bh * 1024;
        for (int i = tid; i < 1024; i += NTHREADS) kms[i] = km[i];
    } else if (MODE == 3) {
        const float* lut = (const float*)(P.ws + OFF_LUT) + (size_t)(4 + h) * 4096;
        if (tid < 320) { const int rel = tid - 64; aux[tid] = (rel >= 0 && rel * dil < 4096) ? lut[rel * dil] : 0.f; }
    }
    bf16x8 qf[ND0];
    { const bf16_t* qp = Qg + (size_t)(qw + r32) * rsq + 8 * hi;
#pragma unroll
      for (int d0 = 0; d0 < ND0; ++d0) qf[d0] = *(const bf16x8*)(qp + 16 * d0); }
    __syncthreads();
    unsigned sel = 0;
    if (MODE == 1) {
        const LAS float* kms = (const LAS float*)(lds + L_KMS); float gt[15];
#pragma unroll
        for (int n = 0; n < 15; ++n) { float s = 0.f;
            if (n < qb) {
#pragma unroll
                for (int d0 = 0; d0 < 4; ++d0) { const f32x4 ka = *(const LAS f32x4*)(kms + n * 64 + 16 * d0 + 8 * hi), kb = *(const LAS f32x4*)(kms + n * 64 + 16 * d0 + 8 * hi + 4);
                    const u32x4 w = __builtin_bit_cast(u32x4, qf[d0]);
                    s += bflo(w.x) * ka[0] + bfhi(w.x) * ka[1] + bflo(w.y) * ka[2] + bfhi(w.y) * ka[3] + bflo(w.z) * kb[0] + bfhi(w.z) * kb[1] + bflo(w.w) * kb[2] + bfhi(w.w) * kb[3]; }
                s = swap_sum(s); }
            gt[n] = s; }
#pragma unroll
        for (int k = 0; k < 3; ++k) { float best = NEGBIG; int bi = -1;
#pragma unroll
            for (int n = 0; n < 15; ++n) if (n < qb && !((sel >> n) & 1u) && gt[n] > best) { best = gt[n]; bi = n; }
            if (bi >= 0) sel |= 1u << bi; }
        sel |= 1u << qb;
    }
    const bf16_t* kgp = Kg + (size_t)(tid >> 3) * rsk + (tid & 7) * 8;
    const bf16_t* vgp = Vg + (size_t)((tid >> 2) & 63) * rsv + (tid >> 8) * 32 + (tid & 3) * 8;
    const bf16_t* rgp = Kg + (size_t)((tid >> 2) & 63) * rsk + 64 + (tid & 3) * 8;
    const int kws = (tid >> 3) * 128 + (((tid & 7) ^ ((tid >> 4) & 7)) << 4);
    const int rws = ((tid >> 2) & 63) * 64 + (((tid & 3) ^ ((tid >> 4) & 3)) << 4);
    u32x4 kreg, vreg, rreg;
#define ATT_LOAD(t) do { kreg = *(const u32x4*)(kgp + (size_t)(t) * 64 * rsk); vreg = *(const u32x4*)(vgp + (size_t)(t) * 64 * rsv); if (MODE == 2 && tid < 256) rreg = *(const u32x4*)(rgp + (size_t)(t) * 64 * rsk); } while (0)
#define ATT_WRITE(buf) do { *(LAS u32x4*)(lds + L_KB + (buf) * 8192 + kws) = kreg; *(LAS u32x4*)(lds + L_VB + (buf) * 8192 + tid * 16) = vreg; if (MODE == 2 && tid < 256) *(LAS u32x4*)(lds + L_KR + (buf) * 4096 + rws) = rreg; } while (0)
    int kfo[4];
#pragma unroll
    for (int d0 = 0; d0 < 4; ++d0) kfo[d0] = L_KB + r32 * 128 + (((2 * d0 + hi) ^ ((r32 >> 1) & 7)) << 4);
    int rfo[2];
#pragma unroll
    for (int d0 = 0; d0 < 2; ++d0) rfo[d0] = L_KR + r32 * 64 + (((2 * d0 + hi) ^ ((r32 >> 2) & 3)) << 4);
    const int vfo = L_VB + ((lane >> 4) & 1) * 32 + (lane & 3) * 8 + (4 * hi + ((lane & 15) >> 2)) * 64;

    f32x16 o0, o1;
#pragma unroll
    for (int r = 0; r < 16; ++r) { o0[r] = 0.f; o1[r] = 0.f; }
    float m = NEGBIG, lsum = 0.f;

    ATT_LOAD(t_lo); ATT_WRITE(0); __syncthreads();
    if (t_lo < t_hi) ATT_LOAD(t_lo + 1);
    int cur = 0;
    for (int t = t_lo; t <= t_hi; ++t) {
        const int k0 = t * 64;
        bool skip = k0 > qw + 31; bool need_mask = k0 + 63 > qw;
        if (MODE == 3) { skip = skip || (k0 + 63 < qw - 128); need_mask = need_mask || (k0 < qw + 31 - 128); }
        bool selected = true;
        if (MODE == 1) { selected = (sel >> (t >> 2)) & 1u; skip = skip || !__any(selected); }
        if (!skip) {
            f32x16 p0, p1;
            const int dl = qw + r32 - k0 - 4 * hi;
            if (MODE == 0) { const LAS float* nb = aux + k0 + 4 * hi;
#pragma unroll
                for (int g = 0; g < 4; ++g) { const f32x4 a = *(const LAS f32x4*)(nb + 8 * g), c = *(const LAS f32x4*)(nb + 32 + 8 * g);
                    p0[4 * g] = a[0]; p0[4 * g + 1] = a[1]; p0[4 * g + 2] = a[2]; p0[4 * g + 3] = a[3]; p1[4 * g] = c[0]; p1[4 * g + 1] = c[1]; p1[4 * g + 2] = c[2]; p1[4 * g + 3] = c[3]; }
            } else if (MODE == 1 || MODE == 3) { const LAS float* lp = aux + (dl + 64 - 59);
#pragma unroll
                for (int r = 0; r < 16; ++r) { p0[r] = lp[59 - crow(r)]; p1[r] = lp[59 - crow(r) - 32]; }
            } else {
#pragma unroll
                for (int r = 0; r < 16; ++r) { p0[r] = 0.f; p1[r] = 0.f; }
            }
            const LAS char* kb_ = lds + cur * 8192;
#pragma unroll
            for (int d0 = 0; d0 < 4; ++d0) { const bf16x8 k0f = *(const LAS bf16x8*)(kb_ + kfo[d0]), k1f = *(const LAS bf16x8*)(kb_ + kfo[d0] + 4096);
                p0 = MFMA32(k0f, qf[d0], p0); p1 = MFMA32(k1f, qf[d0], p1); }
            if (MODE == 2) { const LAS char* rb_ = lds + cur * 4096;
#pragma unroll
                for (int d0 = 0; d0 < 2; ++d0) { const bf16x8 k0f = *(const LAS bf16x8*)(rb_ + rfo[d0]), k1f = *(const LAS bf16x8*)(rb_ + rfo[d0] + 2048);
                    p0 = MFMA32(k0f, qf[4 + d0], p0); p1 = MFMA32(k1f, qf[4 + d0], p1); } }
            if (need_mask) {
#pragma unroll
                for (int r = 0; r < 16; ++r) { const int rel0 = dl - crow(r), rel1 = rel0 - 32;
                    const bool v0 = MODE == 3 ? ((unsigned)rel0 <= 128u) : (rel0 >= 0), v1 = MODE == 3 ? ((unsigned)rel1 <= 128u) : (rel1 >= 0);
                    p0[r] = v0 ? p0[r] : NEGBIG; p1[r] = v1 ? p1[r] : NEGBIG; }
            }
            float mx = fmaxf(p0[0], p1[0]);
#pragma unroll
            for (int r = 1; r < 16; ++r) mx = fmaxf(mx, fmaxf(p0[r], p1[r]));
            mx = swap_max(mx);
            if (MODE == 1) mx = selected ? mx : NEGBIG;
            if (__any(mx > m + THR)) {
                const float mn = fmaxf(m, mx), alpha = __builtin_amdgcn_exp2f(m - mn); m = mn; lsum *= alpha;
#pragma unroll
                for (int r = 0; r < 16; ++r) { o0[r] *= alpha; o1[r] *= alpha; }
            }
            const float mu = (MODE == 1 && !selected) ? 3.0e38f : m;
            float ps = 0.f;
#pragma unroll
            for (int r = 0; r < 16; ++r) { p0[r] = __builtin_amdgcn_exp2f(p0[r] - mu); p1[r] = __builtin_amdgcn_exp2f(p1[r] - mu); ps += p0[r] + p1[r]; }
            lsum += ps;
            bf16x8 pb[4];
#pragma unroll
            for (int s = 0; s < 2; ++s) { u32x4 w0, w1;
                w0.x = cvt2(p0[8 * s], p0[8 * s + 1]); w0.y = cvt2(p0[8 * s + 2], p0[8 * s + 3]); w0.z = cvt2(p0[8 * s + 4], p0[8 * s + 5]); w0.w = cvt2(p0[8 * s + 6], p0[8 * s + 7]);
                w1.x = cvt2(p1[8 * s], p1[8 * s + 1]); w1.y = cvt2(p1[8 * s + 2], p1[8 * s + 3]); w1.z = cvt2(p1[8 * s + 4], p1[8 * s + 5]); w1.w = cvt2(p1[8 * s + 6], p1[8 * s + 7]);
                pb[s] = __builtin_bit_cast(bf16x8, w0); pb[2 + s] = __builtin_bit_cast(bf16x8, w1); }
            const LAS char* vb_ = lds + cur * 8192 + vfo;
#pragma unroll
            for (int s = 0; s < 4; ++s) {
                const s16x4 a0 = vtr(vb_ + s * 1024), a1 = vtr(vb_ + s * 1024 + 512), c0 = vtr(vb_ + 4096 + s * 1024), c1 = vtr(vb_ + 4096 + s * 1024 + 512);
                const bf16x8 va = __builtin_shufflevector(a0, a1, 0, 1, 2, 3, 4, 5, 6, 7), vc = __builtin_shufflevector(c0, c1, 0, 1, 2, 3, 4, 5, 6, 7);
                o0 = MFMA32(va, pb[s], o0); o1 = MFMA32(vc, pb[s], o1); }
        }
        if (t < t_hi) ATT_WRITE(cur ^ 1);
        __syncthreads();
        if (t + 2 <= t_hi) ATT_LOAD(t + 2);
        cur ^= 1;
    }
#undef ATT_LOAD
#undef ATT_WRITE
    const float ltot = swap_sum(lsum), inv = 1.0f / ltot;
    if (MODE != 3) {
        const size_t tok = (size_t)b * SEQ + qw + r32; const int colbase = (MODE == 0 ? 0 : (MODE == 1 ? 256 : 768)) + h * 64 + 4 * hi;
        const bf16_t* G = (const bf16_t*)((const char*)P.out + OOFF_G) + tok * DM + colbase; bf16_t* A2 = (bf16_t*)(P.ws + OFF_H) + tok * DM + colbase;
#pragma unroll
        for (int g = 0; g < 4; ++g) {
            const u32x2 g0 = *(const u32x2*)(G + 8 * g), g1 = *(const u32x2*)(G + 32 + 8 * g); u32x2 w0, w1;
            w0.x = cvt2(o0[4 * g] * inv * bflo(g0.x), o0[4 * g + 1] * inv * bfhi(g0.x)); w0.y = cvt2(o0[4 * g + 2] * inv * bflo(g0.y), o0[4 * g + 3] * inv * bfhi(g0.y));
            w1.x = cvt2(o1[4 * g] * inv * bflo(g1.x), o1[4 * g + 1] * inv * bfhi(g1.x)); w1.y = cvt2(o1[4 * g + 2] * inv * bflo(g1.y), o1[4 * g + 3] * inv * bfhi(g1.y));
            *(u32x2*)(A2 + 8 * g) = w0; *(u32x2*)(A2 + 32 + 8 * g) = w1; }
    } else {
        const size_t tok = (size_t)b * SEQ + (size_t)(qw + r32) * dil + res;
        bf16_t* dp = (bf16_t*)(P.ws + OFF_DPART) + ((size_t)pat * NT + tok) * 256 + h * 64 + 4 * hi;
#pragma unroll
        for (int g = 0; g < 4; ++g) { u32x2 w0, w1;
            w0.x = cvt2(o0[4 * g] * inv, o0[4 * g + 1] * inv); w0.y = cvt2(o0[4 * g + 2] * inv, o0[4 * g + 3] * inv);
            w1.x = cvt2(o1[4 * g] * inv, o1[4 * g + 1] * inv); w1.y = cvt2(o1[4 * g + 2] * inv, o1[4 * g + 3] * inv);
            *(u32x2*)(dp + 8 * g) = w0; *(u32x2*)(dp + 32 + 8 * g) = w1; }
        if (hi == 0) ((float*)(P.ws + OFF_DLSE))[((size_t)pat * NT + tok) * 4 + h] = m + __builtin_amdgcn_logf(ltot);
    }
}

DEVINL void dilmix_unit(const Params& P, int u) {
    const int e = u * NTHREADS + ltid(), tok = e >> 5, hd = e & 31, h = hd >> 3, d8 = (hd & 7) * 8;
    const float* ls = (const float*)(P.ws + OFF_DLSE); const bf16_t* dp = (const bf16_t*)(P.ws + OFF_DPART);
    const float l0 = ls[(size_t)tok * 4 + h], l1 = ls[((size_t)NT + tok) * 4 + h], l2 = ls[((size_t)2 * NT + tok) * 4 + h];
    const float mx = fmaxf(l0, fmaxf(l1, l2)); float w0 = __builtin_amdgcn_exp2f(l0 - mx), w1 = __builtin_amdgcn_exp2f(l1 - mx), w2 = __builtin_amdgcn_exp2f(l2 - mx);
    const float inv = 1.0f / (w0 + w1 + w2); w0 *= inv; w1 *= inv; w2 *= inv;
    const size_t off = (size_t)tok * 256 + h * 64 + d8;
    const u32x4 a = *(const u32x4*)(dp + off), b = *(const u32x4*)(dp + (size_t)NT * 256 + off), c = *(const u32x4*)(dp + (size_t)2 * NT * 256 + off);
    const u32x4 g = *(const u32x4*)((const bf16_t*)((const char*)P.out + OOFF_G) + (size_t)tok * DM + 512 + h * 64 + d8);
    u32x4 r;
    r.x = cvt2((w0 * bflo(a.x) + w1 * bflo(b.x) + w2 * bflo(c.x)) * bflo(g.x), (w0 * bfhi(a.x) + w1 * bfhi(b.x) + w2 * bfhi(c.x)) * bfhi(g.x));
    r.y = cvt2((w0 * bflo(a.y) + w1 * bflo(b.y) + w2 * bflo(c.y)) * bflo(g.y), (w0 * bfhi(a.y) + w1 * bfhi(b.y) + w2 * bfhi(c.y)) * bfhi(g.y));
    r.z = cvt2((w0 * bflo(a.z) + w1 * bflo(b.z) + w2 * bflo(c.z)) * bflo(g.z), (w0 * bfhi(a.z) + w1 * bfhi(b.z) + w2 * bfhi(c.z)) * bfhi(g.z));
    r.w = cvt2((w0 * bflo(a.w) + w1 * bflo(b.w) + w2 * bflo(c.w)) * bflo(g.w), (w0 * bfhi(a.w) + w1 * bfhi(b.w) + w2 * bfhi(c.w)) * bfhi(g.w));
    *(u32x4*)((bf16_t*)(P.ws + OFF_H) + (size_t)tok * DM + 512 + h * 64 + d8) = r;
}

constexpr int SMEM_BYTES = L_ATT_END + 64;

DEVINL int next_unit(unsigned* ctr, char* smem) {
    int* su = (int*)(smem + L_ATT_END);
    __syncthreads();
    if (ltid() == 0) *su = (int)atomicAdd(ctr, 1u);
    __syncthreads();
    return *su;
}

DEVINL void phase_b1(const Params& P, int l, char* smem) {
    gemm_phase((const bf16_t*)(P.ws + OFF_CQ), (const bf16_t*)(P.ws + OFF_WT_UQ + l * SZ_WT_UQ), NT, 384, 256, EpiUq{P, l}, smem);
    gemm_phase((const bf16_t*)(P.ws + OFF_CKV), (const bf16_t*)(P.ws + OFF_WT_UKV + l * SZ_WT_UKV), NT, 512, 128, EpiUkv{P, l}, smem);
    unsigned* ctr = (unsigned*)(P.ws + OFF_CTR) + l * 2;
    for (;;) { const int u = next_unit(ctr, smem); if (u >= 256 + 768 + 256) break;
        if (u < 256) attn_unit<0>(P, u, smem); else if (u < 1024) attn_unit<3>(P, u - 256, smem); else kmean_unit(P, u - 1024, smem); }
}
DEVINL void phase_b2(const Params& P, int l, char* smem) {
    unsigned* ctr = (unsigned*)(P.ws + OFF_CTR) + l * 2 + 1;
    for (;;) { const int u = next_unit(ctr, smem); if (u >= 512 + 1024) break;
        if (u < 512) { const int v = u >> 5, w = u & 31; if (w < 16) attn_unit<2>(P, v * 16 + w, smem); else attn_unit<1>(P, v * 16 + (w - 16), smem); }
        else dilmix_unit(P, u - 512); }
}

template <int PH> DEVINL void run_phase(const Params& P0, int l, char* smem) {
    Params P = P0; asm volatile("" : "+s"(P.ws), "+s"(P.out), "+s"(l));
    char* ws = P.ws;
    const float* xin = l == 0 ? P.x : (const float*)(ws + OFF_X);
    float* xa = P.out;
    float* xout = l == 0 ? (float*)(ws + OFF_X) : P.out;
    if (PH == 0) phase_prep(P, smem);
    if (PH == 1) phase_rms(xin, P.ln_g + l * DM, (bf16_t*)(ws + OFF_H), P.p + (size_t)l * NT * 256, (bf16_t*)(ws + OFF_PB));
    if (PH == 2) gemm_phase((const bf16_t*)(ws + OFF_H), (const bf16_t*)(ws + OFF_WT_IN + l * SZ_WT_IN), NT, NP1, 1024, EpiIn{P, l}, smem);
    if (PH == 3) phase_b1(P, l, smem);
    if (PH == 4) phase_b2(P, l, smem);
    if (PH == 5) { gemm_phase((const bf16_t*)(ws + OFF_H), (const bf16_t*)(ws + OFF_WT_OUT + l * SZ_WT_SQ), NT, 1024, 1024, EpiResid{xin, xa}, smem);
                   gemm_phase((const bf16_t*)(ws + OFF_PB), (const bf16_t*)(ws + OFF_WT_PP + l * SZ_WT_PP), NT, 1024, 256, EpiStore{(float*)(ws + OFF_QKV)}, smem); }
    if (PH == 6) phase_rms(xa, P.ple_norm_g + l * DM, (bf16_t*)(ws + OFF_H), nullptr, nullptr);
    if (PH == 7) gemm_phase((const bf16_t*)(ws + OFF_H), (const bf16_t*)(ws + OFF_WT_PG + l * SZ_WT_SQ), NT, 1024, 1024, EpiPle{xa, (const float*)(ws + OFF_QKV), xout}, smem);
}

__global__ void __launch_bounds__(NTHREADS) k_mega(Params P) {
    __shared__ __attribute__((aligned(16))) char smem[SMEM_BYTES];
    cooperative_groups::grid_group grid = cooperative_groups::this_grid();
    run_phase<0>(P, 0, smem); grid.sync();
    for (int l = 0; l < 2; ++l) {
        run_phase<1>(P, l, smem); grid.sync();
        run_phase<2>(P, l, smem); grid.sync();
        run_phase<3>(P, l, smem); grid.sync();
        run_phase<4>(P, l, smem); grid.sync();
        run_phase<5>(P, l, smem); grid.sync();
        run_phase<6>(P, l, smem); grid.sync();
        run_phase<7>(P, l, smem); grid.sync();
    }
}
}

extern "C" void kernel_launch(void* const* d_in, const int* in_sizes, int n_in, void* d_out, int out_size, void* d_ws, size_t ws_size, hipStream_t stream) {
    Params P{};
    P.x = (const float*)d_in[0]; P.p = (const float*)d_in[1]; P.ln_g = (const float*)d_in[2]; P.w_in = (const float*)d_in[3]; P.b_forget = (const float*)d_in[4]; P.qk_gain = (const float*)d_in[5];
    P.mla_q_norm = (const float*)d_in[6]; P.mla_kv_norm = (const float*)d_in[7]; P.mla_nope_gain = (const float*)d_in[8]; P.mla_rope_gain = (const float*)d_in[9]; P.w_uq = (const float*)d_in[10];
    P.w_ukv = (const float*)d_in[11]; P.w_out = (const float*)d_in[12]; P.rel_bias = (const float*)d_in[13]; P.ple_norm_g = (const float*)d_in[14]; P.w_ple_gate = (const float*)d_in[15]; P.w_ple_proj = (const float*)d_in[16];
    P.out = (float*)d_out; P.ws = (char*)d_ws;
    if (ws_size < WS_NEED) { fprintf(stderr, "workspace too small: %zu < %zu\n", ws_size, (size_t)WS_NEED); return; }
    static int grid_blocks = 0;
    if (!grid_blocks) {
        int dev = 0, cus = 0, per_cu = 0;
        hipGetDevice(&dev);
        hipDeviceGetAttribute(&cus, hipDeviceAttributeMultiprocessorCount, dev);
        hipOccupancyMaxActiveBlocksPerMultiprocessor(&per_cu, k_mega, NTHREADS, 0);
        if (per_cu > 1) per_cu = 1;
        grid_blocks = cus * per_cu;
    }
    void* args[] = {&P};
    hipError_t e = hipLaunchCooperativeKernel((void*)k_mega, dim3(grid_blocks), dim3(NTHREADS), args, 0, stream);
    if (e != hipSuccess) fprintf(stderr, "cooperative launch failed: %s (grid %d)\n", hipGetErrorString(e), grid_blocks);
}
```

```cpp
#include <hip/hip_runtime.h>
#include <hip/hip_cooperative_groups.h>
#include <cstdint>
#include <cstdio>

#ifndef ONE_LAUNCH
#define ONE_LAUNCH 1
#endif

namespace {
#define DEVINL __device__ __forceinline__
typedef unsigned short bf16_t;
typedef short bf16x8 __attribute__((ext_vector_type(8)));
typedef float f32x4 __attribute__((ext_vector_type(4)));
typedef unsigned u32x2 __attribute__((ext_vector_type(2)));
typedef unsigned u32x4 __attribute__((ext_vector_type(4)));

constexpr int NB = 4, SEQ = 4096, DM = 1024, NT = NB * SEQ, NH = 4, NBH = NB * NH;
constexpr int INW = 3748, NP1 = 3840;
constexpr float EPS = 1e-6f, LOG2E = 1.4426950408889634f;
constexpr float SC_Q = 0.125f * LOG2E;
constexpr float SC_MLA = 0.10206207261596575f * LOG2E;
constexpr int NTHREADS = 512;

constexpr size_t SZ_WT_IN = (size_t)NP1 * 1024 * 2, SZ_WT_UQ = 384 * 256 * 2, SZ_WT_UKV = 512 * 128 * 2, SZ_WT_SQ = 1024 * 1024 * 2, SZ_WT_PP = 1024 * 256 * 2;
constexpr size_t OFF_WT_IN = 0;
constexpr size_t OFF_WT_UQ = OFF_WT_IN + 2 * SZ_WT_IN;
constexpr size_t OFF_WT_UKV = OFF_WT_UQ + 2 * SZ_WT_UQ;
constexpr size_t OFF_WT_OUT = OFF_WT_UKV + 2 * SZ_WT_UKV;
constexpr size_t OFF_WT_PG = OFF_WT_OUT + 2 * SZ_WT_SQ;
constexpr size_t OFF_WT_PP = OFF_WT_PG + 2 * SZ_WT_SQ;
constexpr size_t OFF_LUT = OFF_WT_PP + 2 * SZ_WT_PP;
constexpr size_t OFF_ROPE = OFF_LUT + 8 * 4096 * 4;
constexpr size_t OFF_H = OFF_ROPE + 4096 * 16 * 8;
constexpr size_t SZ_HEADBUF = (size_t)NT * 256 * 2;
constexpr size_t OFF_QKV = OFF_H + (size_t)NT * 1024 * 2;
constexpr size_t OFF_CQ = OFF_QKV + 9 * SZ_HEADBUF;
constexpr size_t OFF_CKV = OFF_CQ + (size_t)NT * 256 * 2;
constexpr size_t OFF_CQSS = OFF_CKV + (size_t)NT * 128 * 2;
constexpr size_t OFF_CKVSS = OFF_CQSS + (size_t)NT * 4 * 4;
constexpr size_t OFF_LOGF = OFF_CKVSS + (size_t)NT * 2 * 4;
constexpr size_t OFF_KMEAN = OFF_LOGF + (size_t)NBH * SEQ * 4;
constexpr size_t OFF_PB = OFF_KMEAN + (size_t)NBH * 16 * 64 * 4;
constexpr size_t OFF_X = OFF_PB + (size_t)NT * 256 * 2;
constexpr size_t OFF_DPART = OFF_X + (size_t)NT * 1024 * 4;
constexpr size_t OFF_DLSE = OFF_DPART + 3 * (size_t)NT * 256 * 2;
constexpr size_t OFF_CTR = OFF_DLSE + 3 * (size_t)NT * 4 * 4;
constexpr size_t OFF_BAR = OFF_CTR + 256;
constexpr size_t WS_NEED = OFF_BAR + 3456 * 4;
constexpr size_t OOFF_G = 0;
constexpr size_t OOFF_QM = (size_t)NT * 1024 * 2;
constexpr size_t OOFF_KM = OOFF_QM + (size_t)NBH * SEQ * 96 * 2;
constexpr size_t OOFF_VM = OOFF_KM + (size_t)NBH * SEQ * 96 * 2;

struct Params {
    const float *x, *p, *ln_g, *w_in, *b_forget, *qk_gain, *mla_q_norm, *mla_kv_norm, *mla_nope_gain, *mla_rope_gain, *w_uq, *w_ukv, *w_out, *rel_bias, *ple_norm_g, *w_ple_gate, *w_ple_proj;
    float* out;
    char* ws;
};

DEVINL int ltid() { int t = threadIdx.x; asm volatile("" : "+v"(t)); return t; }
DEVINL bf16_t f2bf(float f) { unsigned u = __float_as_uint(f); u += 0x7fffu + ((u >> 16) & 1u); return (bf16_t)(u >> 16); }
DEVINL float bf2f(bf16_t h) { return __uint_as_float(((unsigned)h) << 16); }
DEVINL unsigned pack2(float a, float b) { return (unsigned)f2bf(a) | ((unsigned)f2bf(b) << 16); }
DEVINL float bflo(unsigned u) { return __uint_as_float(u << 16); }
DEVINL float bfhi(unsigned u) { return __uint_as_float(u & 0xffff0000u); }

__device__ __constant__ float ROPE_INV[16] = {1.0f, 0.5623413251903491f, 0.31622776601683794f, 0.1778279410038923f, 0.1f, 0.05623413251903491f, 0.03162277660168379f, 0.01778279410038923f,
                                              0.01f, 0.005623413251903491f, 0.0031622776601683794f, 0.0017782794100389228f, 0.001f, 0.0005623413251903491f, 0.00031622776601683794f, 0.00017782794100389227f};

DEVINL int t5_bucket(int d) {
    if (d < 16) return d;
    int b = 16;
    b += (d >= 22); b += (d >= 30); b += (d >= 40); b += (d >= 54); b += (d >= 73); b += (d >= 99); b += (d >= 134); b += (d >= 182);
    b += (d >= 246); b += (d >= 332); b += (d >= 450); b += (d >= 609); b += (d >= 825); b += (d >= 1117); b += (d >= 1513);
    return b;
}

DEVINL int map_w_in(int n) { return n < 768 ? n : (n < 2720 ? n + 4 : (n < 2724 ? n - 2720 + 768 : (n < 2816 ? -1 : n - 92))); }
DEVINL int map_w_uq(int n) { if (n < 256) return (n >> 6) * 96 + (n & 63); const int r = n - 256; return (r >> 5) * 96 + 64 + (r & 31); }

DEVINL void transpose_tile(const float* src, int Nsrc, bf16_t* dst, int K, int tn, int tk, int mode, const float* fold, float* tile  ) {
    const int tid = ltid(), c = tid & 63, rb = tid >> 6  , n0 = tn * 64, k0 = tk * 64;
    const int n = n0 + c, oc = mode == 1 ? map_w_in(n) : (mode == 2 ? map_w_uq(n) : n);
#pragma unroll 4
    for (int i = 0; i < 8; ++i) { const int kk = rb + 8 * i; float v = 0.f; if (oc >= 0) { v = src[(size_t)(k0 + kk) * Nsrc + oc]; if (fold) v *= fold[k0 + kk]; } tile[kk * 65 + c] = v; }
    __syncthreads();
#pragma unroll 4
    for (int i = 0; i < 8; ++i) { const int nn = rb + 8 * i; dst[(size_t)(n0 + nn) * K + k0 + c] = f2bf(tile[c * 65 + nn]); }
    __syncthreads();
}

constexpr int PREP_T_IN = 60 * 16, PREP_T_UQ = 6 * 4, PREP_T_UKV = 8 * 2, PREP_T_SQ = 16 * 16, PREP_T_PP = 16 * 4;
constexpr int PREP_PER_LAYER = PREP_T_IN + PREP_T_UQ + PREP_T_UKV + 2 * PREP_T_SQ + PREP_T_PP;
constexpr int PREP_LUT_UNITS = 8 * 4096 / 512, PREP_ROPE_UNITS = 4096 * 16 / 512;
constexpr int PREP_UNITS = 2 * PREP_PER_LAYER + PREP_LUT_UNITS + PREP_ROPE_UNITS;

DEVINL void phase_prep(const Params& P, char* smem) {
    float* tile = (float*)smem;
    for (int u = blockIdx.x; u < PREP_UNITS; u += gridDim.x) {
        if (u < 2 * PREP_PER_LAYER) {
            const int l = u / PREP_PER_LAYER; int r = u % PREP_PER_LAYER;
            if (r < PREP_T_IN) { transpose_tile(P.w_in + (size_t)l * 1024 * INW, INW, (bf16_t*)(P.ws + OFF_WT_IN + l * SZ_WT_IN), 1024, r % 60, r / 60, 1, nullptr, tile); continue; }
            r -= PREP_T_IN;
            if (r < PREP_T_UQ) { transpose_tile(P.w_uq + (size_t)l * 256 * 384, 384, (bf16_t*)(P.ws + OFF_WT_UQ + l * SZ_WT_UQ), 256, r % 6, r / 6, 2, P.mla_q_norm + l * 256, tile); continue; }
            r -= PREP_T_UQ;
            if (r < PREP_T_UKV) { transpose_tile(P.w_ukv + (size_t)l * 128 * 512, 512, (bf16_t*)(P.ws + OFF_WT_UKV + l * SZ_WT_UKV), 128, r % 8, r / 8, 0, P.mla_kv_norm + l * 128, tile); continue; }
            r -= PREP_T_UKV;
            if (r < PREP_T_SQ) { transpose_tile(P.w_out + (size_t)l * 1024 * 1024, 1024, (bf16_t*)(P.ws + OFF_WT_OUT + l * SZ_WT_SQ), 1024, r % 16, r / 16, 0, nullptr, tile); continue; }
            r -= PREP_T_SQ;
            if (r < PREP_T_SQ) { transpose_tile(P.w_ple_gate + (size_t)l * 1024 * 1024, 1024, (bf16_t*)(P.ws + OFF_WT_PG + l * SZ_WT_SQ), 1024, r % 16, r / 16, 0, nullptr, tile); continue; }
            r -= PREP_T_SQ;
            transpose_tile(P.w_ple_proj + (size_t)l * 256 * 1024, 1024, (bf16_t*)(P.ws + OFF_WT_PP + l * SZ_WT_PP), 256, r % 16, r / 16, 0, nullptr, tile);
        } else if (u < 2 * PREP_PER_LAYER + PREP_LUT_UNITS) {
            const int e = (u - 2 * PREP_PER_LAYER) * 512 + ltid(), hh = e >> 12, d = e & 4095;
            ((float*)(P.ws + OFF_LUT))[e] = P.rel_bias[t5_bucket(d) * 8 + hh] * LOG2E;
        } else {
            const int e = (u - 2 * PREP_PER_LAYER - PREP_LUT_UNITS) * 512 + ltid(), pos = e >> 4, i = e & 15;
            const double rev = (double)pos * (double)ROPE_INV[i] * 0.15915494309189535; const float fr = (float)(rev - floor(rev));
            ((float2*)(P.ws + OFF_ROPE))[e] = make_float2(__builtin_amdgcn_cosf(fr), __builtin_amdgcn_sinf(fr));
        }
    }
}

DEVINL float wave_sum(float v) {
#pragma unroll
    for (int o = 32; o > 0; o >>= 1) v += __shfl_xor(v, o);
    return v;
}
DEVINL void phase_rms(const float* src, const float* g, bf16_t* dst, const float* psrc, bf16_t* pb) {
    const int wid = ltid() >> 6, lane = ltid() & 63;
    for (int u = blockIdx.x; u < NT / 8; u += gridDim.x) {
        const int row = u * 8 + wid; const float* xr = src + (size_t)row * DM;
        f32x4 v[4]; float ss = 0.f;
#pragma unroll
        for (int i = 0; i < 4; ++i) { v[i] = *(const f32x4*)(xr + i * 256 + lane * 4); ss += v[i][0] * v[i][0] + v[i][1] * v[i][1] + v[i][2] * v[i][2] + v[i][3] * v[i][3]; }
        ss = wave_sum(ss); const float r = rsqrtf(ss * (1.0f / DM) + EPS);
#pragma unroll
        for (int i = 0; i < 4; ++i) { const f32x4 gg = *(const f32x4*)(g + i * 256 + lane * 4); u32x2 w; w.x = pack2(v[i][0] * r * gg[0], v[i][1] * r * gg[1]); w.y = pack2(v[i][2] * r * gg[2], v[i][3] * r * gg[3]);
            *(u32x2*)(dst + (size_t)row * DM + i * 256 + lane * 4) = w; }
        if (psrc) { const f32x4 pv = *(const f32x4*)(psrc + (size_t)row * 256 + lane * 4); u32x2 w; w.x = pack2(pv[0], pv[1]); w.y = pack2(pv[2], pv[3]); *(u32x2*)(pb + (size_t)row * 256 + lane * 4) = w; }
    }
}

constexpr int GST = 40;
template <class Epi>
DEVINL void gemm_phase(const bf16_t* A, const bf16_t* Bt, int M, int N, int K, const Epi& epi, char* smem) {
    bf16_t* As = (bf16_t*)smem; bf16_t* Bs = As + 256 * GST;
    const int tid = ltid(), wid = tid >> 6, lane = tid & 63, wr = wid >> 1, wc = wid & 1, fr = lane & 15, fq = lane >> 4;
    const int ntm = M / 256, ntn = N / 128, nk = K / 32;
    const int lr = tid >> 2, lc = (tid & 3) * 8;
    for (int tile = blockIdx.x; tile < ntm * ntn; tile += gridDim.x) {
        const int tm = tile % ntm, tn = tile / ntm;
        const bf16_t* Ag = A + (size_t)(tm * 256 + lr) * K + lc; const bf16_t* Bg = Bt + (size_t)(tn * 128 + lr) * K + lc;
        f32x4 acc[4][4];
#pragma unroll
        for (int m = 0; m < 4; ++m)
#pragma unroll
            for (int n = 0; n < 4; ++n) acc[m][n] = (f32x4){0.f, 0.f, 0.f, 0.f};
        u32x4 ra0 = *(const u32x4*)Ag, ra1 = *(const u32x4*)(Ag + (size_t)128 * K), rb0 = *(const u32x4*)Bg;
        for (int kt = 0; kt < nk; ++kt) {
            __syncthreads();
            *(u32x4*)(As + lr * GST + lc) = ra0; *(u32x4*)(As + (lr + 128) * GST + lc) = ra1; *(u32x4*)(Bs + lr * GST + lc) = rb0;
            __syncthreads();
            if (kt + 1 < nk) { const int ko = (kt + 1) * 32; ra0 = *(const u32x4*)(Ag + ko); ra1 = *(const u32x4*)(Ag + (size_t)128 * K + ko); rb0 = *(const u32x4*)(Bg + ko); }
            bf16x8 af[4], bfr[4];
#pragma unroll
            for (int m = 0; m < 4; ++m) af[m] = *(const bf16x8*)(As + (wr * 64 + m * 16 + fr) * GST + fq * 8);
#pragma unroll
            for (int n = 0; n < 4; ++n) bfr[n] = *(const bf16x8*)(Bs + (wc * 64 + n * 16 + fr) * GST + fq * 8);
#pragma unroll
            for (int m = 0; m < 4; ++m)
#pragma unroll
                for (int n = 0; n < 4; ++n) acc[m][n] = __builtin_amdgcn_mfma_f32_16x16x32_bf16(bfr[n], af[m], acc[m][n], 0, 0, 0);
        }
        epi(acc, tm * 256 + wr * 64, tn * 2 + wc, fr, fq);
    }
    __syncthreads();
}

DEVINL float quad_sum(float v) { v += __shfl_xor(v, 16); v += __shfl_xor(v, 32); return v; }
DEVINL void store4bf(bf16_t* p, float a, float b, float c, float d) { u32x2 w; w.x = pack2(a, b); w.y = pack2(c, d); *(u32x2*)p = w; }
DEVINL float log_sigmoid(float z) { return fminf(z, 0.f) - log1pf(__expf(-fabsf(z))); }

struct EpiIn {
    Params P; int l;
    DEVINL void operator()(f32x4 (&acc)[4][4], int row0, int chunk, int fr, int fq) const {
        char* ws = P.ws; char* ob = (char*)P.out;
        if (chunk < 36) {
            const int g = chunk >> 2, h = chunk & 3, role = g % 3, mix = g / 3;
            bf16_t* dst = (bf16_t*)(ws + OFF_QKV + (size_t)g * SZ_HEADBUF);
            const float* gain = P.qk_gain + ((size_t)l * 6 + 2 * mix + (role == 1 ? 1 : 0)) * 64;
#pragma unroll
            for (int m = 0; m < 4; ++m) {
                const int t = row0 + 16 * m + fr, b = t >> 12, s = t & 4095; bf16_t* d = dst + ((size_t)(b * 4 + h) * SEQ + s) * 64 + 4 * fq;
                float r = 1.f;
                if (role != 2) { float ss = 0.f;
#pragma unroll
                    for (int n = 0; n < 4; ++n) ss += acc[m][n][0] * acc[m][n][0] + acc[m][n][1] * acc[m][n][1] + acc[m][n][2] * acc[m][n][2] + acc[m][n][3] * acc[m][n][3];
                    ss = quad_sum(ss); r = rsqrtf(ss * (1.0f / 64.0f) + EPS) * (role == 0 ? SC_Q : 1.0f); }
#pragma unroll
                for (int n = 0; n < 4; ++n) { f32x4 gg = (f32x4){1.f, 1.f, 1.f, 1.f}; if (role != 2) gg = *(const f32x4*)(gain + 16 * n + 4 * fq);
                    store4bf(d + 16 * n, acc[m][n][0] * r * gg[0], acc[m][n][1] * r * gg[1], acc[m][n][2] * r * gg[2], acc[m][n][3] * r * gg[3]); }
            }
        } else if (chunk < 42) {
            const bool isq = chunk < 40; const int c = isq ? chunk - 36 : chunk - 40;
            bf16_t* dst = isq ? (bf16_t*)(ws + OFF_CQ) : (bf16_t*)(ws + OFF_CKV); const int ld = isq ? 256 : 128;
            float* ssp = isq ? (float*)(ws + OFF_CQSS) : (float*)(ws + OFF_CKVSS); const int nss = isq ? 4 : 2;
#pragma unroll
            for (int m = 0; m < 4; ++m) {
                const int t = row0 + 16 * m + fr; float ss = 0.f;
#pragma unroll
                for (int n = 0; n < 4; ++n) { ss += acc[m][n][0] * acc[m][n][0] + acc[m][n][1] * acc[m][n][1] + acc[m][n][2] * acc[m][n][2] + acc[m][n][3] * acc[m][n][3];
                    store4bf(dst + (size_t)t * ld + c * 64 + 16 * n + 4 * fq, acc[m][n][0], acc[m][n][1], acc[m][n][2], acc[m][n][3]); }
                ss = quad_sum(ss); if (fq == 0) ssp[(size_t)t * nss + c] = ss;
            }
        } else if (chunk == 42) {
            const float* gr = P.mla_rope_gain + ((size_t)l * 2 + 1) * 32; const float2* rope = (const float2*)(ws + OFF_ROPE);
            bf16_t* km = (bf16_t*)(ob + OOFF_KM); float* logf_ = (float*)(ws + OFF_LOGF);
            const f32x4 g1 = *(const f32x4*)(gr + 4 * fq), g2 = *(const f32x4*)(gr + 16 + 4 * fq); const f32x4 bfv = *(const f32x4*)(P.b_forget + l * 4);
#pragma unroll
            for (int m = 0; m < 4; ++m) {
                const int t = row0 + 16 * m + fr, b = t >> 12, s = t & 4095;
                float ss = 0.f;
#pragma unroll
                for (int n = 0; n < 2; ++n) ss += acc[m][n][0] * acc[m][n][0] + acc[m][n][1] * acc[m][n][1] + acc[m][n][2] * acc[m][n][2] + acc[m][n][3] * acc[m][n][3];
                ss = quad_sum(ss); const float r = rsqrtf(ss * (1.0f / 32.0f) + EPS);
                float o1[4], o2[4];
#pragma unroll
                for (int j = 0; j < 4; ++j) { const float2 cs = rope[s * 16 + 4 * fq + j]; const float x1 = acc[m][0][j] * r * g1[j], x2 = acc[m][1][j] * r * g2[j]; o1[j] = x1 * cs.x - x2 * cs.y; o2[j] = x1 * cs.y + x2 * cs.x; }
#pragma unroll
                for (int h = 0; h < 4; ++h) { bf16_t* d = km + ((size_t)(b * 4 + h) * SEQ + s) * 96 + 64 + 4 * fq; store4bf(d, o1[0], o1[1], o1[2], o1[3]); store4bf(d + 16, o2[0], o2[1], o2[2], o2[3]); }
                if (fq == 0) {
#pragma unroll
                    for (int j = 0; j < 4; ++j) logf_[(size_t)(b * 4 + j) * SEQ + s] = log_sigmoid(acc[m][2][j] + bfv[j]) * LOG2E;
                }
            }
        } else if (chunk >= 44) {
            bf16_t* G = (bf16_t*)(ob + OOFF_G); const int c0 = (chunk - 44) * 64;
#pragma unroll
            for (int m = 0; m < 4; ++m) { const int t = row0 + 16 * m + fr;
#pragma unroll
                for (int n = 0; n < 4; ++n) { float o[4];
#pragma unroll
                    for (int j = 0; j < 4; ++j) { const float z = acc[m][n][j]; o[j] = z / (1.0f + __expf(-z)); }
                    store4bf(G + (size_t)t * DM + c0 + 16 * n + 4 * fq, o[0], o[1], o[2], o[3]); } }
        }
    }
};

struct EpiUq {
    Params P; int l;
    DEVINL void operator()(f32x4 (&acc)[4][4], int row0, int chunk, int fr, int fq) const {
        const float* cqss = (const float*)(P.ws + OFF_CQSS); bf16_t* qm = (bf16_t*)((char*)P.out + OOFF_QM); const float2* rope = (const float2*)(P.ws + OFF_ROPE);
#pragma unroll
        for (int m = 0; m < 4; ++m) {
            const int t = row0 + 16 * m + fr, b = t >> 12, s = t & 4095; const f32x4 pss = *(const f32x4*)(cqss + (size_t)t * 4);
            const float rt = rsqrtf((pss[0] + pss[1] + pss[2] + pss[3]) * (1.0f / 256.0f) + EPS);
            if (chunk < 4) {
                const float* gain = P.mla_nope_gain + ((size_t)l * 2 + 0) * 64; float ss = 0.f;
#pragma unroll
                for (int n = 0; n < 4; ++n) { acc[m][n] = acc[m][n] * rt; ss += acc[m][n][0] * acc[m][n][0] + acc[m][n][1] * acc[m][n][1] + acc[m][n][2] * acc[m][n][2] + acc[m][n][3] * acc[m][n][3]; }
                ss = quad_sum(ss); const float r = rsqrtf(ss * (1.0f / 64.0f) + EPS) * SC_MLA; bf16_t* d = qm + ((size_t)(b * 4 + chunk) * SEQ + s) * 96 + 4 * fq;
#pragma unroll
                for (int n = 0; n < 4; ++n) { const f32x4 gg = *(const f32x4*)(gain + 16 * n + 4 * fq); store4bf(d + 16 * n, acc[m][n][0] * r * gg[0], acc[m][n][1] * r * gg[1], acc[m][n][2] * r * gg[2], acc[m][n][3] * r * gg[3]); }
            } else {
                const float* gr = P.mla_rope_gain + ((size_t)l * 2 + 0) * 32; const f32x4 g1 = *(const f32x4*)(gr + 4 * fq), g2 = *(const f32x4*)(gr + 16 + 4 * fq);
#pragma unroll
                for (int hh = 0; hh < 2; ++hh) {
                    const int h = (chunk - 4) * 2 + hh; float ss = 0.f;
#pragma unroll
                    for (int n = 0; n < 2; ++n) { acc[m][2 * hh + n] = acc[m][2 * hh + n] * rt; const f32x4 a = acc[m][2 * hh + n]; ss += a[0] * a[0] + a[1] * a[1] + a[2] * a[2] + a[3] * a[3]; }
                    ss = quad_sum(ss); const float r = rsqrtf(ss * (1.0f / 32.0f) + EPS);
                    float o1[4], o2[4];
#pragma unroll
                    for (int j = 0; j < 4; ++j) { const float2 cs = rope[s * 16 + 4 * fq + j]; const float x1 = acc[m][2 * hh][j] * r * g1[j], x2 = acc[m][2 * hh + 1][j] * r * g2[j];
                        o1[j] = (x1 * cs.x - x2 * cs.y) * SC_MLA; o2[j] = (x1 * cs.y + x2 * cs.x) * SC_MLA; }
                    bf16_t* d = qm + ((size_t)(b * 4 + h) * SEQ + s) * 96 + 64 + 4 * fq; store4bf(d, o1[0], o1[1], o1[2], o1[3]); store4bf(d + 16, o2[0], o2[1], o2[2], o2[3]);
                }
            }
        }
    }
};
struct EpiUkv {
    Params P; int l;
    DEVINL void operator()(f32x4 (&acc)[4][4], int row0, int chunk, int fr, int fq) const {
        const float* ckvss = (const float*)(P.ws + OFF_CKVSS); bf16_t* km = (bf16_t*)((char*)P.out + OOFF_KM); bf16_t* vm = (bf16_t*)((char*)P.out + OOFF_VM);
        const int h = chunk >> 1; const bool isk = (chunk & 1) == 0; const float* gain = P.mla_nope_gain + ((size_t)l * 2 + 1) * 64;
#pragma unroll
        for (int m = 0; m < 4; ++m) {
            const int t = row0 + 16 * m + fr, b = t >> 12, s = t & 4095; const float rt = rsqrtf((ckvss[(size_t)t * 2] + ckvss[(size_t)t * 2 + 1]) * (1.0f / 128.0f) + EPS);
            float ss = 0.f;
#pragma unroll
            for (int n = 0; n < 4; ++n) { acc[m][n] = acc[m][n] * rt; ss += acc[m][n][0] * acc[m][n][0] + acc[m][n][1] * acc[m][n][1] + acc[m][n][2] * acc[m][n][2] + acc[m][n][3] * acc[m][n][3]; }
            if (isk) { ss = quad_sum(ss); const float r = rsqrtf(ss * (1.0f / 64.0f) + EPS); bf16_t* d = km + ((size_t)(b * 4 + h) * SEQ + s) * 96 + 4 * fq;
#pragma unroll
                for (int n = 0; n < 4; ++n) { const f32x4 gg = *(const f32x4*)(gain + 16 * n + 4 * fq); store4bf(d + 16 * n, acc[m][n][0] * r * gg[0], acc[m][n][1] * r * gg[1], acc[m][n][2] * r * gg[2], acc[m][n][3] * r * gg[3]); }
            } else { bf16_t* d = vm + ((size_t)(b * 4 + h) * SEQ + s) * 64 + 4 * fq;
#pragma unroll
                for (int n = 0; n < 4; ++n) store4bf(d + 16 * n, acc[m][n][0], acc[m][n][1], acc[m][n][2], acc[m][n][3]); }
        }
    }
};
struct EpiResid { const float* base; float* out;
    DEVINL void operator()(f32x4 (&acc)[4][4], int row0, int chunk, int fr, int fq) const {
#pragma unroll
        for (int m = 0; m < 4; ++m) { const size_t o = (size_t)(row0 + 16 * m + fr) * DM + chunk * 64 + 4 * fq;
#pragma unroll
            for (int n = 0; n < 4; ++n) { const f32x4 bv = *(const f32x4*)(base + o + 16 * n); *(f32x4*)(out + o + 16 * n) = bv + acc[m][n]; } } } };
struct EpiStore { float* out;
    DEVINL void operator()(f32x4 (&acc)[4][4], int row0, int chunk, int fr, int fq) const {
#pragma unroll
        for (int m = 0; m < 4; ++m) { const size_t o = (size_t)(row0 + 16 * m + fr) * DM + chunk * 64 + 4 * fq;
#pragma unroll
            for (int n = 0; n < 4; ++n) *(f32x4*)(out + o + 16 * n) = acc[m][n]; } } };
struct EpiPle { const float* xa; const float* pp; float* out;
    DEVINL void operator()(f32x4 (&acc)[4][4], int row0, int chunk, int fr, int fq) const {
#pragma unroll
        for (int m = 0; m < 4; ++m) { const size_t o = (size_t)(row0 + 16 * m + fr) * DM + chunk * 64 + 4 * fq;
#pragma unroll
            for (int n = 0; n < 4; ++n) { const f32x4 xv = *(const f32x4*)(xa + o + 16 * n), pv = *(const f32x4*)(pp + o + 16 * n); f32x4 r;
#pragma unroll
                for (int j = 0; j < 4; ++j) r[j] = xv[j] + pv[j] / (1.0f + __expf(-acc[m][n][j]));
                *(f32x4*)(out + o + 16 * n) = r; } } } };

DEVINL void kmean_unit(const Params& P, int u, char* smem) {
    float* red = (float*)smem; const bf16_t* K = (const bf16_t*)(P.ws + OFF_QKV + 4 * SZ_HEADBUF); float* km = (float*)(P.ws + OFF_KMEAN);
    const int tid = ltid(), d = tid & 63, part = tid >> 6;
    const bf16_t* kp = K + ((size_t)(u >> 4) * SEQ + (u & 15) * 256 + part * 32) * 64 + d; float s = 0.f;
    for (int i = 0; i < 32; ++i) s += bf2f(kp[(size_t)i * 64]);
    __syncthreads(); red[tid] = s; __syncthreads();
    if (part == 0) { float a = 0.f;
#pragma unroll
        for (int i = 0; i < 8; ++i) a += red[i * 64 + d];
        km[(size_t)u * 64 + d] = a * (1.0f / 256.0f); }
}

typedef float f32x16 __attribute__((ext_vector_type(16)));
typedef short s16x4 __attribute__((ext_vector_type(4)));
typedef short v4i16_t __attribute__((ext_vector_type(4)));
typedef __bf16 bf16v2 __attribute__((ext_vector_type(2)));
typedef float f32v2 __attribute__((ext_vector_type(2)));
#define LAS __attribute__((address_space(3)))
#define MFMA32(a, b, c) __builtin_amdgcn_mfma_f32_32x32x16_bf16(a, b, c, 0, 0, 0)
DEVINL unsigned cvt2(float a, float b) { f32v2 v = {a, b}; return __builtin_bit_cast(unsigned, __builtin_convertvector(v, bf16v2)); }
DEVINL s16x4 vtr(const LAS char* p) { return __builtin_bit_cast(s16x4, __builtin_amdgcn_ds_read_tr16_b64_v4i16((LAS v4i16_t*)p)); }
DEVINL float swap_max(float v) { auto rr = __builtin_amdgcn_permlane32_swap(__float_as_uint(v), __float_as_uint(v), false, false); return fmaxf(__uint_as_float(rr[0]), __uint_as_float(rr[1])); }
DEVINL float swap_sum(float v) { auto rr = __builtin_amdgcn_permlane32_swap(__float_as_uint(v), __float_as_uint(v), false, false); return __uint_as_float(rr[0]) + __uint_as_float(rr[1]); }
DEVINL constexpr int crow(int r) { return (r & 3) + 8 * (r >> 2); }

constexpr int L_KB = 0, L_VB = 16384, L_KR = 32768, L_AUX = 40960, L_SCR = 40960 + 16640, L_KMS = L_SCR + 2048, L_ATT_END = L_KMS + 4096;
constexpr float NEGBIG = -3.0e38f, THR = 8.0f;

template <int MODE>
DEVINL void attn_unit(const Params& P, int u, char* smem) {
    constexpr int DK = MODE == 2 ? 96 : 64, ND0 = DK / 16;
    LAS char* lds = (LAS char*)smem;
    const int tid = ltid(), lane = tid & 63, r32 = lane & 31, hi = lane >> 5; const int wid = __builtin_amdgcn_readfirstlane(tid >> 6);
    int bh, q0, t_lo, t_hi, dil = 1, res = 0, pat = 0, qb = 0;
    if (MODE != 3) { bh = u & 15; qb = 15 - (u >> 4); q0 = qb * 256; t_lo = 0; t_hi = (q0 + 255) >> 6; }
    else { pat = u >> 8; const int v = u & 255; bh = v & 15; const int w = v >> 4; dil = pat == 0 ? 1 : (pat == 1 ? 4 : 16); res = w % dil; q0 = (w / dil) * 256; t_lo = (q0 >= 128 ? q0 - 128 : 0) >> 6; t_hi = (q0 + 255) >> 6; }
    const int b = bh >> 2, h = bh & 3;
    const bf16_t *Qg, *Kg, *Vg; int rsq, rsk, rsv;
    if (MODE == 0) { Qg = (const bf16_t*)(P.ws + OFF_QKV) + (size_t)bh * SEQ * 64; Kg = Qg + SZ_HEADBUF / 2; Vg = Kg + SZ_HEADBUF / 2; rsq = rsk = rsv = 64; }
    else if (MODE == 1) { Qg = (const bf16_t*)(P.ws + OFF_QKV + 3 * SZ_HEADBUF) + (size_t)bh * SEQ * 64; Kg = Qg + SZ_HEADBUF / 2; Vg = Kg + SZ_HEADBUF / 2; rsq = rsk = rsv = 64; }
    else if (MODE == 2) { Qg = (const bf16_t*)((const char*)P.out + OOFF_QM) + (size_t)bh * SEQ * 96; Kg = (const bf16_t*)((const char*)P.out + OOFF_KM) + (size_t)bh * SEQ * 96; Vg = (const bf16_t*)((const char*)P.out + OOFF_VM) + (size_t)bh * SEQ * 64; rsq = rsk = 96; rsv = 64; }
    else { Qg = (const bf16_t*)(P.ws + OFF_QKV + 6 * SZ_HEADBUF) + ((size_t)bh * SEQ + res) * 64; Kg = Qg + SZ_HEADBUF / 2; Vg = Kg + SZ_HEADBUF / 2; rsq = rsk = rsv = 64 * dil; }
    const int qw = q0 + 32 * wid;

    __syncthreads();
    LAS float* aux = (LAS float*)(lds + L_AUX);
    if (MODE == 0) {
        LAS float* tot = (LAS float*)(lds + L_SCR);
        const float* lf = (const float*)(P.ws + OFF_LOGF) + (size_t)bh * SEQ + tid * 8; float v[8]; float run = 0.f;
        { const f32x4 a = *(const f32x4*)lf, c = *(const f32x4*)(lf + 4); v[0] = a[0]; v[1] = a[1]; v[2] = a[2]; v[3] = a[3]; v[4] = c[0]; v[5] = c[1]; v[6] = c[2]; v[7] = c[3]; }
#pragma unroll
        for (int i = 0; i < 8; ++i) { run += v[i]; v[i] = run; }
        tot[tid] = run; __syncthreads();
        if (tid < 64) { float a[8]; float acc = 0.f;
#pragma unroll
            for (int i = 0; i < 8; ++i) { acc += tot[tid * 8 + i]; a[i] = acc; }
            float incl = acc;
#pragma unroll
            for (int o = 1; o < 64; o <<= 1) { const float nb = __shfl_up(incl, o); if (tid >= o) incl += nb; }
            const float ex = incl - acc; tot[tid * 8] = ex;
#pragma unroll
            for (int i = 1; i < 8; ++i) tot[tid * 8 + i] = ex + a[i - 1]; }
        __syncthreads();
        const float base = tot[tid];
#pragma unroll
        for (int i = 0; i < 8; ++i) aux[tid * 8 + i] = -(base + v[i]);
    } else if (MODE == 1) {
        const float* lut = (const float*)(P.ws + OFF_LUT) + (size_t)h * 4096;
        for (int i = tid; i < 4160; i += NTHREADS) aux[i] = i >= 64 ? lut[i - 64] : 0.f;
        LAS float* kms = (LAS float*)(lds + L_KMS); const float* km = (const float*)(P.ws + OFF_KMEAN) + (size_t)bh * 1024;
        for (int i = tid; i < 1024; i += NTHREADS) kms[i] = km[i];
    } else if (MODE == 3) {
        const float* lut = (const float*)(P.ws + OFF_LUT) + (size_t)(4 + h) * 4096;
        if (tid < 320) { const int rel = tid - 64; aux[tid] = (rel >= 0 && rel * dil < 4096) ? lut[rel * dil] : 0.f; }
    }
    bf16x8 qf[ND0];
    { const bf16_t* qp = Qg + (size_t)(qw + r32) * rsq + 8 * hi;
#pragma unroll
      for (int d0 = 0; d0 < ND0; ++d0) qf[d0] = *(const bf16x8*)(qp + 16 * d0); }
    __syncthreads();
    unsigned sel = 0;
    if (MODE == 1) {
        const LAS float* kms = (const LAS float*)(lds + L_KMS); float gt[15];
#pragma unroll
        for (int n = 0; n < 15; ++n) { float s = 0.f;
            if (n < qb) {
#pragma unroll
                for (int d0 = 0; d0 < 4; ++d0) { const f32x4 ka = *(const LAS f32x4*)(kms + n * 64 + 16 * d0 + 8 * hi), kb = *(const LAS f32x4*)(kms + n * 64 + 16 * d0 + 8 * hi + 4);
                    const u32x4 w = __builtin_bit_cast(u32x4, qf[d0]);
                    s += bflo(w.x) * ka[0] + bfhi(w.x) * ka[1] + bflo(w.y) * ka[2] + bfhi(w.y) * ka[3] + bflo(w.z) * kb[0] + bfhi(w.z) * kb[1] + bflo(w.w) * kb[2] + bfhi(w.w) * kb[3]; }
                s = swap_sum(s); }
            gt[n] = s; }
#pragma unroll
        for (int k = 0; k < 3; ++k) { float best = NEGBIG; int bi = -1;
#pragma unroll
            for (int n = 0; n < 15; ++n) if (n < qb && !((sel >> n) & 1u) && gt[n] > best) { best = gt[n]; bi = n; }
            if (bi >= 0) sel |= 1u << bi; }
        sel |= 1u << qb;
    }
    const bf16_t* kgp = Kg + (size_t)(tid >> 3) * rsk + (tid & 7) * 8;
    const bf16_t* vgp = Vg + (size_t)((tid >> 2) & 63) * rsv + (tid >> 8) * 32 + (tid & 3) * 8;
    const bf16_t* rgp = Kg + (size_t)((tid >> 2) & 63) * rsk + 64 + (tid & 3) * 8;
    const int kws = (tid >> 3) * 128 + (((tid & 7) ^ ((tid >> 4) & 7)) << 4);
    const int rws = ((tid >> 2) & 63) * 64 + (((tid & 3) ^ ((tid >> 4) & 3)) << 4);
    u32x4 kreg, vreg, rreg;
#define ATT_LOAD(t) do { kreg = *(const u32x4*)(kgp + (size_t)(t) * 64 * rsk); vreg = *(const u32x4*)(vgp + (size_t)(t) * 64 * rsv); if (MODE == 2 && tid < 256) rreg = *(const u32x4*)(rgp + (size_t)(t) * 64 * rsk); } while (0)
#define ATT_WRITE(buf) do { *(LAS u32x4*)(lds + L_KB + (buf) * 8192 + kws) = kreg; *(LAS u32x4*)(lds + L_VB + (buf) * 8192 + tid * 16) = vreg; if (MODE == 2 && tid < 256) *(LAS u32x4*)(lds + L_KR + (buf) * 4096 + rws) = rreg; } while (0)
    int kfo[4];
#pragma unroll
    for (int d0 = 0; d0 < 4; ++d0) kfo[d0] = L_KB + r32 * 128 + (((2 * d0 + hi) ^ ((r32 >> 1) & 7)) << 4);
    int rfo[2];
#pragma unroll
    for (int d0 = 0; d0 < 2; ++d0) rfo[d0] = L_KR + r32 * 64 + (((2 * d0 + hi) ^ ((r32 >> 2) & 3)) << 4);
    const int vfo = L_VB + ((lane >> 4) & 1) * 32 + (lane & 3) * 8 + (4 * hi + ((lane & 15) >> 2)) * 64;

    f32x16 o0, o1;
#pragma unroll
    for (int r = 0; r < 16; ++r) { o0[r] = 0.f; o1[r] = 0.f; }
    float m = NEGBIG, lsum = 0.f;

    ATT_LOAD(t_lo); ATT_WRITE(0); __syncthreads();
    if (t_lo < t_hi) ATT_LOAD(t_lo + 1);
    int cur = 0;
    for (int t = t_lo; t <= t_hi; ++t) {
        const int k0 = t * 64;
        bool skip = k0 > qw + 31; bool need_mask = k0 + 63 > qw;
        if (MODE == 3) { skip = skip || (k0 + 63 < qw - 128); need_mask = need_mask || (k0 < qw + 31 - 128); }
        bool selected = true;
        if (MODE == 1) { selected = (sel >> (t >> 2)) & 1u; skip = skip || !__any(selected); }
        if (!skip) {
            f32x16 p0, p1;
            const int dl = qw + r32 - k0 - 4 * hi;
            if (MODE == 0) { const LAS float* nb = aux + k0 + 4 * hi;
#pragma unroll
                for (int g = 0; g < 4; ++g) { const f32x4 a = *(const LAS f32x4*)(nb + 8 * g), c = *(const LAS f32x4*)(nb + 32 + 8 * g);
                    p0[4 * g] = a[0]; p0[4 * g + 1] = a[1]; p0[4 * g + 2] = a[2]; p0[4 * g + 3] = a[3]; p1[4 * g] = c[0]; p1[4 * g + 1] = c[1]; p1[4 * g + 2] = c[2]; p1[4 * g + 3] = c[3]; }
            } else if (MODE == 1 || MODE == 3) { const LAS float* lp = aux + (dl + 64 - 59);
#pragma unroll
                for (int r = 0; r < 16; ++r) { p0[r] = lp[59 - crow(r)]; p1[r] = lp[59 - crow(r) - 32]; }
            } else {
#pragma unroll
                for (int r = 0; r < 16; ++r) { p0[r] = 0.f; p1[r] = 0.f; }
            }
            const LAS char* kb_ = lds + cur * 8192;
#pragma unroll
            for (int d0 = 0; d0 < 4; ++d0) { const bf16x8 k0f = *(const LAS bf16x8*)(kb_ + kfo[d0]), k1f = *(const LAS bf16x8*)(kb_ + kfo[d0] + 4096);
                p0 = MFMA32(k0f, qf[d0], p0); p1 = MFMA32(k1f, qf[d0], p1); }
            if (MODE == 2) { const LAS char* rb_ = lds + cur * 4096;
#pragma unroll
                for (int d0 = 0; d0 < 2; ++d0) { const bf16x8 k0f = *(const LAS bf16x8*)(rb_ + rfo[d0]), k1f = *(const LAS bf16x8*)(rb_ + rfo[d0] + 2048);
                    p0 = MFMA32(k0f, qf[4 + d0], p0); p1 = MFMA32(k1f, qf[4 + d0], p1); } }
            if (need_mask) {
#pragma unroll
                for (int r = 0; r < 16; ++r) { const int rel0 = dl - crow(r), rel1 = rel0 - 32;
                    const bool v0 = MODE == 3 ? ((unsigned)rel0 <= 128u) : (rel0 >= 0), v1 = MODE == 3 ? ((unsigned)rel1 <= 128u) : (rel1 >= 0);
                    p0[r] = v0 ? p0[r] : NEGBIG; p1[r] = v1 ? p1[r] : NEGBIG; }
            }
            float mx = fmaxf(p0[0], p1[0]);
#pragma unroll
            for (int r = 1; r < 16; ++r) mx = fmaxf(mx, fmaxf(p0[r], p1[r]));
            mx = swap_max(mx);
            if (MODE == 1) mx = selected ? mx : NEGBIG;
            if (__any(mx > m + THR)) {
                const float mn = fmaxf(m, mx), alpha = __builtin_amdgcn_exp2f(m - mn); m = mn; lsum *= alpha;
#pragma unroll
                for (int r = 0; r < 16; ++r) { o0[r] *= alpha; o1[r] *= alpha; }
            }
            const float mu = (MODE == 1 && !selected) ? 3.0e38f : m;
            float ps = 0.f;
#pragma unroll
            for (int r = 0; r < 16; ++r) { p0[r] = __builtin_amdgcn_exp2f(p0[r] - mu); p1[r] = __builtin_amdgcn_exp2f(p1[r] - mu); ps += p0[r] + p1[r]; }
            lsum += ps;
            bf16x8 pb[4];
#pragma unroll
            for (int s = 0; s < 2; ++s) { u32x4 w0, w1;
                w0.x = cvt2(p0[8 * s], p0[8 * s + 1]); w0.y = cvt2(p0[8 * s + 2], p0[8 * s + 3]); w0.z = cvt2(p0[8 * s + 4], p0[8 * s + 5]); w0.w = cvt2(p0[8 * s + 6], p0[8 * s + 7]);
                w1.x = cvt2(p1[8 * s], p1[8 * s + 1]); w1.y = cvt2(p1[8 * s + 2], p1[8 * s + 3]); w1.z = cvt2(p1[8 * s + 4], p1[8 * s + 5]); w1.w = cvt2(p1[8 * s + 6], p1[8 * s + 7]);
                pb[s] = __builtin_bit_cast(bf16x8, w0); pb[2 + s] = __builtin_bit_cast(bf16x8, w1); }
            const LAS char* vb_ = lds + cur * 8192 + vfo;
#pragma unroll
            for (int s = 0; s < 4; ++s) {
                const s16x4 a0 = vtr(vb_ + s * 1024), a1 = vtr(vb_ + s * 1024 + 512), c0 = vtr(vb_ + 4096 + s * 1024), c1 = vtr(vb_ + 4096 + s * 1024 + 512);
                const bf16x8 va = __builtin_shufflevector(a0, a1, 0, 1, 2, 3, 4, 5, 6, 7), vc = __builtin_shufflevector(c0, c1, 0, 1, 2, 3, 4, 5, 6, 7);
                o0 = MFMA32(va, pb[s], o0); o1 = MFMA32(vc, pb[s], o1); }
        }
        if (t < t_hi) ATT_WRITE(cur ^ 1);
        __syncthreads();
        if (t + 2 <= t_hi) ATT_LOAD(t + 2);
        cur ^= 1;
    }
#undef ATT_LOAD
#undef ATT_WRITE
    const float ltot = swap_sum(lsum), inv = 1.0f / ltot;
    if (MODE != 3) {
        const size_t tok = (size_t)b * SEQ + qw + r32; const int colbase = (MODE == 0 ? 0 : (MODE == 1 ? 256 : 768)) + h * 64 + 4 * hi;
        const bf16_t* G = (const bf16_t*)((const char*)P.out + OOFF_G) + tok * DM + colbase; bf16_t* A2 = (bf16_t*)(P.ws + OFF_H) + tok * DM + colbase;
#pragma unroll
        for (int g = 0; g < 4; ++g) {
            const u32x2 g0 = *(const u32x2*)(G + 8 * g), g1 = *(const u32x2*)(G + 32 + 8 * g); u32x2 w0, w1;
            w0.x = cvt2(o0[4 * g] * inv * bflo(g0.x), o0[4 * g + 1] * inv * bfhi(g0.x)); w0.y = cvt2(o0[4 * g + 2] * inv * bflo(g0.y), o0[4 * g + 3] * inv * bfhi(g0.y));
            w1.x = cvt2(o1[4 * g] * inv * bflo(g1.x), o1[4 * g + 1] * inv * bfhi(g1.x)); w1.y = cvt2(o1[4 * g + 2] * inv * bflo(g1.y), o1[4 * g + 3] * inv * bfhi(g1.y));
            *(u32x2*)(A2 + 8 * g) = w0; *(u32x2*)(A2 + 32 + 8 * g) = w1; }
    } else {
        const size_t tok = (size_t)b * SEQ + (size_t)(qw + r32) * dil + res;
        bf16_t* dp = (bf16_t*)(P.ws + OFF_DPART) + ((size_t)pat * NT + tok) * 256 + h * 64 + 4 * hi;
#pragma unroll
        for (int g = 0; g < 4; ++g) { u32x2 w0, w1;
            w0.x = cvt2(o0[4 * g] * inv, o0[4 * g + 1] * inv); w0.y = cvt2(o0[4 * g + 2] * inv, o0[4 * g + 3] * inv);
            w1.x = cvt2(o1[4 * g] * inv, o1[4 * g + 1] * inv); w1.y = cvt2(o1[4 * g + 2] * inv, o1[4 * g + 3] * inv);
            *(u32x2*)(dp + 8 * g) = w0; *(u32x2*)(dp + 32 + 8 * g) = w1; }
        if (hi == 0) ((float*)(P.ws + OFF_DLSE))[((size_t)pat * NT + tok) * 4 + h] = m + __builtin_amdgcn_logf(ltot);
    }
}

DEVINL void dilmix_unit(const Params& P, int u) {
    const int e = u * NTHREADS + ltid(), tok = e >> 5, hd = e & 31, h = hd >> 3, d8 = (hd & 7) * 8;
    const float* ls = (const float*)(P.ws + OFF_DLSE); const bf16_t* dp = (const bf16_t*)(P.ws + OFF_DPART);
    const float l0 = ls[(size_t)tok * 4 + h], l1 = ls[((size_t)NT + tok) * 4 + h], l2 = ls[((size_t)2 * NT + tok) * 4 + h];
    const float mx = fmaxf(l0, fmaxf(l1, l2)); float w0 = __builtin_amdgcn_exp2f(l0 - mx), w1 = __builtin_amdgcn_exp2f(l1 - mx), w2 = __builtin_amdgcn_exp2f(l2 - mx);
    const float inv = 1.0f / (w0 + w1 + w2); w0 *= inv; w1 *= inv; w2 *= inv;
    const size_t off = (size_t)tok * 256 + h * 64 + d8;
    const u32x4 a = *(const u32x4*)(dp + off), b = *(const u32x4*)(dp + (size_t)NT * 256 + off), c = *(const u32x4*)(dp + (size_t)2 * NT * 256 + off);
    const u32x4 g = *(const u32x4*)((const bf16_t*)((const char*)P.out + OOFF_G) + (size_t)tok * DM + 512 + h * 64 + d8);
    u32x4 r;
    r.x = cvt2((w0 * bflo(a.x) + w1 * bflo(b.x) + w2 * bflo(c.x)) * bflo(g.x), (w0 * bfhi(a.x) + w1 * bfhi(b.x) + w2 * bfhi(c.x)) * bfhi(g.x));
    r.y = cvt2((w0 * bflo(a.y) + w1 * bflo(b.y) + w2 * bflo(c.y)) * bflo(g.y), (w0 * bfhi(a.y) + w1 * bfhi(b.y) + w2 * bfhi(c.y)) * bfhi(g.y));
    r.z = cvt2((w0 * bflo(a.z) + w1 * bflo(b.z) + w2 * bflo(c.z)) * bflo(g.z), (w0 * bfhi(a.z) + w1 * bfhi(b.z) + w2 * bfhi(c.z)) * bfhi(g.z));
    r.w = cvt2((w0 * bflo(a.w) + w1 * bflo(b.w) + w2 * bflo(c.w)) * bflo(g.w), (w0 * bfhi(a.w) + w1 * bfhi(b.w) + w2 * bfhi(c.w)) * bfhi(g.w));
    *(u32x4*)((bf16_t*)(P.ws + OFF_H) + (size_t)tok * DM + 512 + h * 64 + d8) = r;
}


#define XB_TMO      128
#define XB_XCNT(j)  (256  + 64 * (j))
#define XB_XSUB(j)  (1280 + 64 * (j))
#define XB_XGEN(j)  (2304 + 64 * (j))
#define XB_TOP      3328
#define XB_TOPGEN   3392
#define XCD_BAR_WORDS 3456
#define XB_SPIN_CAP (1u << 20)
DEVINL unsigned xb_ld(unsigned* p) { return __hip_atomic_load(p, __ATOMIC_RELAXED, __HIP_MEMORY_SCOPE_AGENT); }
DEVINL unsigned xb_add(unsigned* p, unsigned v) { return __hip_atomic_fetch_add(p, v, __ATOMIC_RELAXED, __HIP_MEMORY_SCOPE_AGENT); }
DEVINL unsigned xb_xcc_id() { return (unsigned)__builtin_amdgcn_s_getreg((3 << 11) | 20) & 0xFu; }
#define XB_SPIN(cond, bar) do { unsigned _sp = 0; while (cond) { __builtin_amdgcn_s_sleep(1); \
    if ((++_sp & 255u) == 0u) { if (xb_ld(&(bar)[XB_TMO])) break; if (_sp > XB_SPIN_CAP) { atomicAdd(&(bar)[XB_TMO], 1u); break; } } } } while (0)
struct XcdBarrier { unsigned* bar; unsigned x; volatile LAS unsigned* st; };
DEVINL XcdBarrier xcd_barrier_post(unsigned* bar, volatile LAS unsigned* st) {
    XcdBarrier b; b.bar = bar; b.x = xb_xcc_id(); b.st = st;
    if (threadIdx.x == 0) (void)xb_add(&bar[XB_XCNT(b.x)], 1u);
    return b;
}
DEVINL void xcd_barrier_complete(unsigned* bar, unsigned x, unsigned& nloc, unsigned& nx) {
    const unsigned G = gridDim.x * gridDim.y * gridDim.z;
    unsigned sum, cnt, mine, sp = 0u;
    for (;;) {
        sum = 0u; cnt = 0u; mine = 0u;
#pragma unroll
        for (unsigned j = 0; j < 16; ++j) { const unsigned c = xb_ld(&bar[XB_XCNT(j)]); sum += c; cnt += (c > 0u) ? 1u : 0u; mine = (j == x) ? c : mine; }
        if (sum == G) break;
        __builtin_amdgcn_s_sleep(1);
        if ((++sp & 255u) == 0u) { if (xb_ld(&bar[XB_TMO])) break; if (sp > XB_SPIN_CAP) { atomicAdd(&bar[XB_TMO], 1u); break; } }
    }
    nloc = mine > 0u ? mine : 1u; nx = cnt > 0u ? cnt : 1u;
}
DEVINL void xcd_barrier(const XcdBarrier& b) {
    asm volatile("s_waitcnt vmcnt(0)" ::: "memory");
    __syncthreads();
    if (threadIdx.x == 0) {
        unsigned* bar = b.bar;
        __builtin_amdgcn_s_waitcnt(0);
        unsigned nloc = b.st[0], nx = b.st[1];
        if (nloc == 0u) { xcd_barrier_complete(bar, b.x, nloc, nx); b.st[0] = nloc; b.st[1] = nx; }
        const unsigned old = xb_add(&bar[XB_XSUB(b.x)], 1u);
        const unsigned gen = old / nloc;
        if (old + 1u == (gen + 1u) * nloc) {
            __builtin_amdgcn_fence(__ATOMIC_RELEASE, "agent");
            asm volatile("s_waitcnt vmcnt(0)" ::: "memory");
            const unsigned og = xb_add(&bar[XB_TOP], 1u);
            const unsigned tg = og / nx;
            if (og + 1u == (tg + 1u) * nx) xb_add(&bar[XB_TOPGEN], 1u);
            else XB_SPIN(xb_ld(&bar[XB_TOPGEN]) == tg, bar);
            __builtin_amdgcn_fence(__ATOMIC_ACQUIRE, "agent");
            xb_add(&bar[XB_XGEN(b.x)], 1u);
            asm volatile("s_waitcnt vmcnt(0)" ::: "memory");
        } else {
            XB_SPIN(xb_ld(&bar[XB_XGEN(b.x)]) == gen, bar);
            __builtin_amdgcn_fence(__ATOMIC_ACQUIRE, "agent");
            asm volatile("s_waitcnt vmcnt(0)" ::: "memory");
        }
    }
    __syncthreads();
}

constexpr int L_XB = L_ATT_END + 16;
constexpr int SMEM_BYTES = L_ATT_END + 64;

DEVINL int next_unit(unsigned* ctr, char* smem) {
    int* su = (int*)(smem + L_ATT_END);
    __syncthreads();
    if (ltid() == 0) *su = (int)atomicAdd(ctr, 1u);
    __syncthreads();
    return *su;
}

DEVINL void phase_b1(const Params& P, int l, char* smem) {
    gemm_phase((const bf16_t*)(P.ws + OFF_CQ), (const bf16_t*)(P.ws + OFF_WT_UQ + l * SZ_WT_UQ), NT, 384, 256, EpiUq{P, l}, smem);
    gemm_phase((const bf16_t*)(P.ws + OFF_CKV), (const bf16_t*)(P.ws + OFF_WT_UKV + l * SZ_WT_UKV), NT, 512, 128, EpiUkv{P, l}, smem);
    unsigned* ctr = (unsigned*)(P.ws + OFF_CTR) + l * 2;
    for (;;) { const int u = next_unit(ctr, smem); if (u >= 256 + 768 + 256) break;
        if (u < 256) attn_unit<0>(P, u, smem); else if (u < 1024) attn_unit<3>(P, u - 256, smem); else kmean_unit(P, u - 1024, smem); }
}
DEVINL void phase_b2(const Params& P, int l, char* smem) {
    unsigned* ctr = (unsigned*)(P.ws + OFF_CTR) + l * 2 + 1;
    for (;;) { const int u = next_unit(ctr, smem); if (u >= 512 + 1024) break;
        if (u < 512) { const int v = u >> 5, w = u & 31; if (w < 16) attn_unit<2>(P, v * 16 + w, smem); else attn_unit<1>(P, v * 16 + (w - 16), smem); }
        else dilmix_unit(P, u - 512); }
}

template <int PH> DEVINL void run_phase(const Params& P0, int l, char* smem) {
    Params P = P0; asm volatile("" : "+s"(P.ws), "+s"(P.out), "+s"(l));
    char* ws = P.ws;
    const float* xin = l == 0 ? P.x : (const float*)(ws + OFF_X);
    float* xa = P.out;
    float* xout = l == 0 ? (float*)(ws + OFF_X) : P.out;
    if (PH == 0) phase_prep(P, smem);
    if (PH == 1) phase_rms(xin, P.ln_g + l * DM, (bf16_t*)(ws + OFF_H), P.p + (size_t)l * NT * 256, (bf16_t*)(ws + OFF_PB));
    if (PH == 2) gemm_phase((const bf16_t*)(ws + OFF_H), (const bf16_t*)(ws + OFF_WT_IN + l * SZ_WT_IN), NT, NP1, 1024, EpiIn{P, l}, smem);
    if (PH == 3) phase_b1(P, l, smem);
    if (PH == 4) phase_b2(P, l, smem);
    if (PH == 5) { gemm_phase((const bf16_t*)(ws + OFF_H), (const bf16_t*)(ws + OFF_WT_OUT + l * SZ_WT_SQ), NT, 1024, 1024, EpiResid{xin, xa}, smem);
                   gemm_phase((const bf16_t*)(ws + OFF_PB), (const bf16_t*)(ws + OFF_WT_PP + l * SZ_WT_PP), NT, 1024, 256, EpiStore{(float*)(ws + OFF_QKV)}, smem); }
    if (PH == 6) phase_rms(xa, P.ple_norm_g + l * DM, (bf16_t*)(ws + OFF_H), nullptr, nullptr);
    if (PH == 7) gemm_phase((const bf16_t*)(ws + OFF_H), (const bf16_t*)(ws + OFF_WT_PG + l * SZ_WT_SQ), NT, 1024, 1024, EpiPle{xa, (const float*)(ws + OFF_QKV), xout}, smem);
}

__global__ void __launch_bounds__(NTHREADS) k_mega(Params P) {
    __shared__ __attribute__((aligned(16))) char smem[SMEM_BYTES];
    cooperative_groups::grid_group grid = cooperative_groups::this_grid();
    if (threadIdx.x < 4) ((LAS unsigned*)((LAS char*)smem + L_XB))[threadIdx.x] = 0u;
    __syncthreads();
    const XcdBarrier xb = xcd_barrier_post((unsigned*)(P.ws + OFF_BAR), (volatile LAS unsigned*)((LAS char*)smem + L_XB));
    run_phase<0>(P, 0, smem); grid.sync();
    for (int l = 0; l < 2; ++l) {
        run_phase<1>(P, l, smem); xcd_barrier(xb);
        run_phase<2>(P, l, smem); xcd_barrier(xb);
        run_phase<3>(P, l, smem); xcd_barrier(xb);
        run_phase<4>(P, l, smem); xcd_barrier(xb);
        run_phase<5>(P, l, smem); xcd_barrier(xb);
        run_phase<6>(P, l, smem); xcd_barrier(xb);
        run_phase<7>(P, l, smem); if (l == 0) xcd_barrier(xb);
    }
}
}

extern "C" void kernel_launch(void* const* d_in, const int* in_sizes, int n_in, void* d_out, int out_size, void* d_ws, size_t ws_size, hipStream_t stream) {
    Params P{};
    P.x = (const float*)d_in[0]; P.p = (const float*)d_in[1]; P.ln_g = (const float*)d_in[2]; P.w_in = (const float*)d_in[3]; P.b_forget = (const float*)d_in[4]; P.qk_gain = (const float*)d_in[5];
    P.mla_q_norm = (const float*)d_in[6]; P.mla_kv_norm = (const float*)d_in[7]; P.mla_nope_gain = (const float*)d_in[8]; P.mla_rope_gain = (const float*)d_in[9]; P.w_uq = (const float*)d_in[10];
    P.w_ukv = (const float*)d_in[11]; P.w_out = (const float*)d_in[12]; P.rel_bias = (const float*)d_in[13]; P.ple_norm_g = (const float*)d_in[14]; P.w_ple_gate = (const float*)d_in[15]; P.w_ple_proj = (const float*)d_in[16];
    P.out = (float*)d_out; P.ws = (char*)d_ws;
    if (ws_size < WS_NEED) { fprintf(stderr, "workspace too small: %zu < %zu\n", ws_size, (size_t)WS_NEED); return; }
    static int grid_blocks = 0;
    if (!grid_blocks) {
        int dev = 0, cus = 0, per_cu = 0;
        hipGetDevice(&dev);
        hipDeviceGetAttribute(&cus, hipDeviceAttributeMultiprocessorCount, dev);
        hipOccupancyMaxActiveBlocksPerMultiprocessor(&per_cu, k_mega, NTHREADS, 0);
        if (per_cu > 1) per_cu = 1;
        grid_blocks = cus * per_cu;
    }
    hipMemsetAsync((char*)d_ws + OFF_CTR, 0, 256 + 3456 * 4, stream);
    void* args[] = {&P};
    hipError_t e = hipLaunchCooperativeKernel((void*)k_mega, dim3(grid_blocks), dim3(NTHREADS), args, 0, stream);
    if (e != hipSuccess) fprintf(stderr, "cooperative launch failed: %s (grid %d)\n", hipGetErrorString(e), grid_blocks);
}
```

```cpp
#include <hip/hip_runtime.h>
#include <hip/hip_cooperative_groups.h>
#include <cstdint>
#include <cstdio>

#ifndef ONE_LAUNCH
#define ONE_LAUNCH 1
#endif

namespace {
#define DEVINL __device__ __forceinline__
typedef unsigned short bf16_t;
typedef short bf16x8 __attribute__((ext_vector_type(8)));
typedef float f32x4 __attribute__((ext_vector_type(4)));
typedef unsigned u32x2 __attribute__((ext_vector_type(2)));
typedef unsigned u32x4 __attribute__((ext_vector_type(4)));

constexpr int NB = 4, SEQ = 4096, DM = 1024, NT = NB * SEQ, NH = 4, NBH = NB * NH;
constexpr int INW = 3748, NP1 = 3840;
constexpr float EPS = 1e-6f, LOG2E = 1.4426950408889634f;
constexpr float SC_Q = 0.125f * LOG2E;
constexpr float SC_MLA = 0.10206207261596575f * LOG2E;
constexpr int NTHREADS = 512;

constexpr size_t SZ_WT_IN = (size_t)NP1 * 1024 * 2, SZ_WT_UQ = 384 * 256 * 2, SZ_WT_UKV = 512 * 128 * 2, SZ_WT_SQ = 1024 * 1024 * 2, SZ_WT_PP = 1024 * 256 * 2;
constexpr size_t OFF_WT_IN = 0;
constexpr size_t OFF_WT_UQ = OFF_WT_IN + 2 * SZ_WT_IN;
constexpr size_t OFF_WT_UKV = OFF_WT_UQ + 2 * SZ_WT_UQ;
constexpr size_t OFF_WT_OUT = OFF_WT_UKV + 2 * SZ_WT_UKV;
constexpr size_t OFF_WT_PG = OFF_WT_OUT + 2 * SZ_WT_SQ;
constexpr size_t OFF_WT_PP = OFF_WT_PG + 2 * SZ_WT_SQ;
constexpr size_t OFF_LUT = OFF_WT_PP + 2 * SZ_WT_PP;
constexpr size_t OFF_ROPE = OFF_LUT + 8 * 4096 * 4;
constexpr size_t OFF_H = OFF_ROPE + 4096 * 16 * 8;
constexpr size_t SZ_HEADBUF = (size_t)NT * 256 * 2;
constexpr size_t OFF_QKV = OFF_H + (size_t)NT * 1024 * 2;
constexpr size_t OFF_CQ = OFF_QKV + 9 * SZ_HEADBUF;
constexpr size_t OFF_CKV = OFF_CQ + (size_t)NT * 256 * 2;
constexpr size_t OFF_CQSS = OFF_CKV + (size_t)NT * 128 * 2;
constexpr size_t OFF_CKVSS = OFF_CQSS + (size_t)NT * 4 * 4;
constexpr size_t OFF_LOGF = OFF_CKVSS + (size_t)NT * 2 * 4;
constexpr size_t OFF_KMEAN = OFF_LOGF + (size_t)NBH * SEQ * 4;
constexpr size_t OFF_PB = OFF_KMEAN + (size_t)NBH * 16 * 64 * 4;
constexpr size_t OFF_X = OFF_PB + (size_t)NT * 256 * 2;
constexpr size_t OFF_DPART = OFF_X + (size_t)NT * 1024 * 4;
constexpr size_t OFF_DLSE = OFF_DPART + 3 * (size_t)NT * 256 * 2;
constexpr size_t OFF_CTR = OFF_DLSE + 3 * (size_t)NT * 4 * 4;
constexpr size_t OFF_BAR = OFF_CTR + 256;
constexpr size_t WS_NEED = OFF_BAR + 3456 * 4;
constexpr size_t OOFF_G = 0;
constexpr size_t OOFF_QM = (size_t)NT * 1024 * 2;
constexpr size_t OOFF_KM = OOFF_QM + (size_t)NBH * SEQ * 96 * 2;
constexpr size_t OOFF_VM = OOFF_KM + (size_t)NBH * SEQ * 96 * 2;

struct Params {
    const float *x, *p, *ln_g, *w_in, *b_forget, *qk_gain, *mla_q_norm, *mla_kv_norm, *mla_nope_gain, *mla_rope_gain, *w_uq, *w_ukv, *w_out, *rel_bias, *ple_norm_g, *w_ple_gate, *w_ple_proj;
    float* out;
    char* ws;
};

DEVINL int ltid() { int t = threadIdx.x; asm volatile("" : "+v"(t)); return t; }
DEVINL bf16_t f2bf(float f) { unsigned u = __float_as_uint(f); u += 0x7fffu + ((u >> 16) & 1u); return (bf16_t)(u >> 16); }
DEVINL float bf2f(bf16_t h) { return __uint_as_float(((unsigned)h) << 16); }
DEVINL unsigned pack2(float a, float b) { return (unsigned)f2bf(a) | ((unsigned)f2bf(b) << 16); }
typedef __bf16 bf16v2 __attribute__((ext_vector_type(2)));
typedef float f32v2 __attribute__((ext_vector_type(2)));
DEVINL unsigned cvt2(float a, float b) { f32v2 v = {a, b}; return __builtin_bit_cast(unsigned, __builtin_convertvector(v, bf16v2)); }
DEVINL float bflo(unsigned u) { return __uint_as_float(u << 16); }
DEVINL float bfhi(unsigned u) { return __uint_as_float(u & 0xffff0000u); }

__device__ __constant__ float ROPE_INV[16] = {1.0f, 0.5623413251903491f, 0.31622776601683794f, 0.1778279410038923f, 0.1f, 0.05623413251903491f, 0.03162277660168379f, 0.01778279410038923f,
                                              0.01f, 0.005623413251903491f, 0.0031622776601683794f, 0.0017782794100389228f, 0.001f, 0.0005623413251903491f, 0.00031622776601683794f, 0.00017782794100389227f};

DEVINL int t5_bucket(int d) {
    if (d < 16) return d;
    int b = 16;
    b += (d >= 22); b += (d >= 30); b += (d >= 40); b += (d >= 54); b += (d >= 73); b += (d >= 99); b += (d >= 134); b += (d >= 182);
    b += (d >= 246); b += (d >= 332); b += (d >= 450); b += (d >= 609); b += (d >= 825); b += (d >= 1117); b += (d >= 1513);
    return b;
}

DEVINL int map_w_in(int n) { return n < 768 ? n : (n < 2720 ? n + 4 : (n < 2724 ? n - 2720 + 768 : (n < 2816 ? -1 : n - 92))); }
DEVINL int virt_col(int nv) { const int v = nv & 255; return (nv & ~255) + 64 * ((v >> 5) & 3) + 32 * (v >> 7) + (v & 31); }
DEVINL int map_w_in_virt(int nv) { int a = virt_col(nv); const int chunk = a >> 6; int hc = a & 63;
    if (chunk == 42 && hc < 32) hc = 16 * ((hc >> 2) & 1) + 4 * (hc >> 3) + (hc & 3);
    return map_w_in(chunk * 64 + hc); }
DEVINL int map_w_uq(int n) { if (n < 256) return (n >> 6) * 96 + (n & 63); const int r = n - 256; return (r >> 5) * 96 + 64 + (r & 31); }

DEVINL void transpose_tile(const float* src, int Nsrc, bf16_t* dst, int K, int tn, int tk, int mode, const float* fold, float* tile  ) {
    const int tid = ltid(), c = tid & 63, rb = tid >> 6  , n0 = tn * 64, k0 = tk * 64;
    const int n = n0 + c, oc = mode == 1 ? map_w_in_virt(n) : (mode == 2 ? map_w_uq(n) : (mode == 3 ? virt_col(n) : n));
#pragma unroll 4
    for (int i = 0; i < 8; ++i) { const int kk = rb + 8 * i; float v = 0.f; if (oc >= 0) { v = src[(size_t)(k0 + kk) * Nsrc + oc]; if (fold) v *= fold[k0 + kk]; } tile[kk * 65 + c] = v; }
    __syncthreads();
#pragma unroll 4
    for (int i = 0; i < 8; ++i) { const int nn = rb + 8 * i; dst[(size_t)(n0 + nn) * K + k0 + c] = f2bf(tile[c * 65 + nn]); }
    __syncthreads();
}

constexpr int PREP_T_IN = 60 * 16, PREP_T_UQ = 6 * 4, PREP_T_UKV = 8 * 2, PREP_T_SQ = 16 * 16, PREP_T_PP = 16 * 4;
constexpr int PREP_PER_LAYER = PREP_T_IN + PREP_T_UQ + PREP_T_UKV + 2 * PREP_T_SQ + PREP_T_PP;
constexpr int PREP_LUT_UNITS = 8 * 4096 / 512, PREP_ROPE_UNITS = 4096 * 16 / 512;
constexpr int PREP_UNITS = 2 * PREP_PER_LAYER + PREP_LUT_UNITS + PREP_ROPE_UNITS;

DEVINL void phase_prep(const Params& P, char* smem) {
    float* tile = (float*)smem;
    for (int u = blockIdx.x; u < PREP_UNITS; u += gridDim.x) {
        if (u < 2 * PREP_PER_LAYER) {
            const int l = u / PREP_PER_LAYER; int r = u % PREP_PER_LAYER;
            if (r < PREP_T_IN) { transpose_tile(P.w_in + (size_t)l * 1024 * INW, INW, (bf16_t*)(P.ws + OFF_WT_IN + l * SZ_WT_IN), 1024, r % 60, r / 60, 1, nullptr, tile); continue; }
            r -= PREP_T_IN;
            if (r < PREP_T_UQ) { transpose_tile(P.w_uq + (size_t)l * 256 * 384, 384, (bf16_t*)(P.ws + OFF_WT_UQ + l * SZ_WT_UQ), 256, r % 6, r / 6, 2, P.mla_q_norm + l * 256, tile); continue; }
            r -= PREP_T_UQ;
            if (r < PREP_T_UKV) { transpose_tile(P.w_ukv + (size_t)l * 128 * 512, 512, (bf16_t*)(P.ws + OFF_WT_UKV + l * SZ_WT_UKV), 128, r % 8, r / 8, 0, P.mla_kv_norm + l * 128, tile); continue; }
            r -= PREP_T_UKV;
            if (r < PREP_T_SQ) { transpose_tile(P.w_out + (size_t)l * 1024 * 1024, 1024, (bf16_t*)(P.ws + OFF_WT_OUT + l * SZ_WT_SQ), 1024, r % 16, r / 16, 3, nullptr, tile); continue; }
            r -= PREP_T_SQ;
            if (r < PREP_T_SQ) { transpose_tile(P.w_ple_gate + (size_t)l * 1024 * 1024, 1024, (bf16_t*)(P.ws + OFF_WT_PG + l * SZ_WT_SQ), 1024, r % 16, r / 16, 3, nullptr, tile); continue; }
            r -= PREP_T_SQ;
            transpose_tile(P.w_ple_proj + (size_t)l * 256 * 1024, 1024, (bf16_t*)(P.ws + OFF_WT_PP + l * SZ_WT_PP), 256, r % 16, r / 16, 3, nullptr, tile);
        } else if (u < 2 * PREP_PER_LAYER + PREP_LUT_UNITS) {
            const int e = (u - 2 * PREP_PER_LAYER) * 512 + ltid(), hh = e >> 12, d = e & 4095;
            ((float*)(P.ws + OFF_LUT))[e] = P.rel_bias[t5_bucket(d) * 8 + hh] * LOG2E;
        } else {
            const int e = (u - 2 * PREP_PER_LAYER - PREP_LUT_UNITS) * 512 + ltid(), pos = e >> 4, i = e & 15;
            const double rev = (double)pos * (double)ROPE_INV[i] * 0.15915494309189535; const float fr = (float)(rev - floor(rev));
            ((float2*)(P.ws + OFF_ROPE))[e] = make_float2(__builtin_amdgcn_cosf(fr), __builtin_amdgcn_sinf(fr));
        }
    }
}

DEVINL float wave_sum(float v) {
#pragma unroll
    for (int o = 32; o > 0; o >>= 1) v += __shfl_xor(v, o);
    return v;
}
DEVINL void phase_rms(const float* src, const float* g, bf16_t* dst, const float* psrc, bf16_t* pb) {
    const int wid = ltid() >> 6, lane = ltid() & 63;
    for (int u = blockIdx.x; u < NT / 8; u += gridDim.x) {
        const int row = u * 8 + wid; const float* xr = src + (size_t)row * DM;
        f32x4 v[4]; float ss = 0.f;
#pragma unroll
        for (int i = 0; i < 4; ++i) { v[i] = *(const f32x4*)(xr + i * 256 + lane * 4); ss += v[i][0] * v[i][0] + v[i][1] * v[i][1] + v[i][2] * v[i][2] + v[i][3] * v[i][3]; }
        ss = wave_sum(ss); const float r = rsqrtf(ss * (1.0f / DM) + EPS);
#pragma unroll
        for (int i = 0; i < 4; ++i) { const f32x4 gg = *(const f32x4*)(g + i * 256 + lane * 4); u32x2 w; w.x = pack2(v[i][0] * r * gg[0], v[i][1] * r * gg[1]); w.y = pack2(v[i][2] * r * gg[2], v[i][3] * r * gg[3]);
            *(u32x2*)(dst + (size_t)row * DM + i * 256 + lane * 4) = w; }
        if (psrc) { const f32x4 pv = *(const f32x4*)(psrc + (size_t)row * 256 + lane * 4); u32x2 w; w.x = pack2(pv[0], pv[1]); w.y = pack2(pv[2], pv[3]); *(u32x2*)(pb + (size_t)row * 256 + lane * 4) = w; }
    }
}

constexpr int GST = 40;
template <class Epi>
DEVINL void gemm_phase(const bf16_t* A, const bf16_t* Bt, int M, int N, int K, const Epi& epi, char* smem) {
    bf16_t* As = (bf16_t*)smem; bf16_t* Bs = As + 256 * GST;
    const int tid = ltid(), wid = tid >> 6, lane = tid & 63, wr = wid >> 1, wc = wid & 1, fr = lane & 15, fq = lane >> 4;
    const int ntm = M / 256, ntn = N / 128, nk = K / 32;
    const int lr = tid >> 2, lc = (tid & 3) * 8;
    for (int tile = blockIdx.x; tile < ntm * ntn; tile += gridDim.x) {
        const int tm = tile % ntm, tn = tile / ntm;
        const bf16_t* Ag = A + (size_t)(tm * 256 + lr) * K + lc; const bf16_t* Bg = Bt + (size_t)(tn * 128 + lr) * K + lc;
        f32x4 acc[4][4];
#pragma unroll
        for (int m = 0; m < 4; ++m)
#pragma unroll
            for (int n = 0; n < 4; ++n) acc[m][n] = (f32x4){0.f, 0.f, 0.f, 0.f};
        u32x4 ra0 = *(const u32x4*)Ag, ra1 = *(const u32x4*)(Ag + (size_t)128 * K), rb0 = *(const u32x4*)Bg;
        for (int kt = 0; kt < nk; ++kt) {
            __syncthreads();
            *(u32x4*)(As + lr * GST + lc) = ra0; *(u32x4*)(As + (lr + 128) * GST + lc) = ra1; *(u32x4*)(Bs + lr * GST + lc) = rb0;
            __syncthreads();
            if (kt + 1 < nk) { const int ko = (kt + 1) * 32; ra0 = *(const u32x4*)(Ag + ko); ra1 = *(const u32x4*)(Ag + (size_t)128 * K + ko); rb0 = *(const u32x4*)(Bg + ko); }
            bf16x8 af[4], bfr[4];
#pragma unroll
            for (int m = 0; m < 4; ++m) af[m] = *(const bf16x8*)(As + (wr * 64 + m * 16 + fr) * GST + fq * 8);
#pragma unroll
            for (int n = 0; n < 4; ++n) bfr[n] = *(const bf16x8*)(Bs + (wc * 64 + n * 16 + fr) * GST + fq * 8);
#pragma unroll
            for (int m = 0; m < 4; ++m)
#pragma unroll
                for (int n = 0; n < 4; ++n) acc[m][n] = __builtin_amdgcn_mfma_f32_16x16x32_bf16(bfr[n], af[m], acc[m][n], 0, 0, 0);
        }
        epi(acc, tm * 256 + wr * 64, tn * 2 + wc, fr, fq);
    }
    __syncthreads();
}

DEVINL float quad_sum(float v) { v += __shfl_xor(v, 16); v += __shfl_xor(v, 32); return v; }
DEVINL void store4bf(bf16_t* p, float a, float b, float c, float d) { u32x2 w; w.x = pack2(a, b); w.y = pack2(c, d); *(u32x2*)p = w; }
DEVINL float log_sigmoid(float z) { return fminf(z, 0.f) - log1pf(__expf(-fabsf(z))); }

struct EpiIn {
    Params P; int l;
    DEVINL void operator()(f32x4 (&acc)[4][4], int row0, int chunk, int fr, int fq) const {
        char* ws = P.ws; char* ob = (char*)P.out;
        if (chunk < 36) {
            const int g = chunk >> 2, h = chunk & 3, role = g % 3, mix = g / 3;
            bf16_t* dst = (bf16_t*)(ws + OFF_QKV + (size_t)g * SZ_HEADBUF);
            const float* gain = P.qk_gain + ((size_t)l * 6 + 2 * mix + (role == 1 ? 1 : 0)) * 64;
#pragma unroll
            for (int m = 0; m < 4; ++m) {
                const int t = row0 + 16 * m + fr, b = t >> 12, s = t & 4095; bf16_t* d = dst + ((size_t)(b * 4 + h) * SEQ + s) * 64 + 4 * fq;
                float r = 1.f;
                if (role != 2) { float ss = 0.f;
#pragma unroll
                    for (int n = 0; n < 4; ++n) ss += acc[m][n][0] * acc[m][n][0] + acc[m][n][1] * acc[m][n][1] + acc[m][n][2] * acc[m][n][2] + acc[m][n][3] * acc[m][n][3];
                    ss = quad_sum(ss); r = rsqrtf(ss * (1.0f / 64.0f) + EPS) * (role == 0 ? SC_Q : 1.0f); }
#pragma unroll
                for (int n = 0; n < 4; ++n) { f32x4 gg = (f32x4){1.f, 1.f, 1.f, 1.f}; if (role != 2) gg = *(const f32x4*)(gain + 16 * n + 4 * fq);
                    store4bf(d + 16 * n, acc[m][n][0] * r * gg[0], acc[m][n][1] * r * gg[1], acc[m][n][2] * r * gg[2], acc[m][n][3] * r * gg[3]); }
            }
        } else if (chunk < 42) {
            const bool isq = chunk < 40; const int c = isq ? chunk - 36 : chunk - 40;
            bf16_t* dst = isq ? (bf16_t*)(ws + OFF_CQ) : (bf16_t*)(ws + OFF_CKV); const int ld = isq ? 256 : 128;
            float* ssp = isq ? (float*)(ws + OFF_CQSS) : (float*)(ws + OFF_CKVSS); const int nss = isq ? 4 : 2;
#pragma unroll
            for (int m = 0; m < 4; ++m) {
                const int t = row0 + 16 * m + fr; float ss = 0.f;
#pragma unroll
                for (int n = 0; n < 4; ++n) { ss += acc[m][n][0] * acc[m][n][0] + acc[m][n][1] * acc[m][n][1] + acc[m][n][2] * acc[m][n][2] + acc[m][n][3] * acc[m][n][3];
                    store4bf(dst + (size_t)t * ld + c * 64 + 16 * n + 4 * fq, acc[m][n][0], acc[m][n][1], acc[m][n][2], acc[m][n][3]); }
                ss = quad_sum(ss); if (fq == 0) ssp[(size_t)t * nss + c] = ss;
            }
        } else if (chunk == 42) {
            const float* gr = P.mla_rope_gain + ((size_t)l * 2 + 1) * 32; const float2* rope = (const float2*)(ws + OFF_ROPE);
            bf16_t* km = (bf16_t*)(ob + OOFF_KM); float* logf_ = (float*)(ws + OFF_LOGF);
            const f32x4 g1 = *(const f32x4*)(gr + 4 * fq), g2 = *(const f32x4*)(gr + 16 + 4 * fq); const f32x4 bfv = *(const f32x4*)(P.b_forget + l * 4);
#pragma unroll
            for (int m = 0; m < 4; ++m) {
                const int t = row0 + 16 * m + fr, b = t >> 12, s = t & 4095;
                float ss = 0.f;
#pragma unroll
                for (int n = 0; n < 2; ++n) ss += acc[m][n][0] * acc[m][n][0] + acc[m][n][1] * acc[m][n][1] + acc[m][n][2] * acc[m][n][2] + acc[m][n][3] * acc[m][n][3];
                ss = quad_sum(ss); const float r = rsqrtf(ss * (1.0f / 32.0f) + EPS);
                float o1[4], o2[4];
#pragma unroll
                for (int j = 0; j < 4; ++j) { const float2 cs = rope[s * 16 + 4 * fq + j]; const float x1 = acc[m][0][j] * r * g1[j], x2 = acc[m][1][j] * r * g2[j]; o1[j] = x1 * cs.x - x2 * cs.y; o2[j] = x1 * cs.y + x2 * cs.x; }
#pragma unroll
                for (int h = 0; h < 4; ++h) { bf16_t* d = km + ((size_t)(b * 4 + h) * SEQ + s) * 96 + 64 + 4 * fq; store4bf(d, o1[0], o1[1], o1[2], o1[3]); store4bf(d + 16, o2[0], o2[1], o2[2], o2[3]); }
                if (fq == 0) {
#pragma unroll
                    for (int j = 0; j < 4; ++j) logf_[(size_t)(b * 4 + j) * SEQ + s] = log_sigmoid(acc[m][2][j] + bfv[j]) * LOG2E;
                }
            }
        } else if (chunk >= 44) {
            bf16_t* G = (bf16_t*)(ob + OOFF_G); const int c0 = (chunk - 44) * 64;
#pragma unroll
            for (int m = 0; m < 4; ++m) { const int t = row0 + 16 * m + fr;
#pragma unroll
                for (int n = 0; n < 4; ++n) { float o[4];
#pragma unroll
                    for (int j = 0; j < 4; ++j) { const float z = acc[m][n][j]; o[j] = z / (1.0f + __expf(-z)); }
                    store4bf(G + (size_t)t * DM + c0 + 16 * n + 4 * fq, o[0], o[1], o[2], o[3]); } }
        }
    }
};

struct EpiUq {
    Params P; int l;
    DEVINL void operator()(f32x4 (&acc)[4][4], int row0, int chunk, int fr, int fq) const {
        const float* cqss = (const float*)(P.ws + OFF_CQSS); bf16_t* qm = (bf16_t*)((char*)P.out + OOFF_QM); const float2* rope = (const float2*)(P.ws + OFF_ROPE);
#pragma unroll
        for (int m = 0; m < 4; ++m) {
            const int t = row0 + 16 * m + fr, b = t >> 12, s = t & 4095; const f32x4 pss = *(const f32x4*)(cqss + (size_t)t * 4);
            const float rt = rsqrtf((pss[0] + pss[1] + pss[2] + pss[3]) * (1.0f / 256.0f) + EPS);
            if (chunk < 4) {
                const float* gain = P.mla_nope_gain + ((size_t)l * 2 + 0) * 64; float ss = 0.f;
#pragma unroll
                for (int n = 0; n < 4; ++n) { acc[m][n] = acc[m][n] * rt; ss += acc[m][n][0] * acc[m][n][0] + acc[m][n][1] * acc[m][n][1] + acc[m][n][2] * acc[m][n][2] + acc[m][n][3] * acc[m][n][3]; }
                ss = quad_sum(ss); const float r = rsqrtf(ss * (1.0f / 64.0f) + EPS) * SC_MLA; bf16_t* d = qm + ((size_t)(b * 4 + chunk) * SEQ + s) * 96 + 4 * fq;
#pragma unroll
                for (int n = 0; n < 4; ++n) { const f32x4 gg = *(const f32x4*)(gain + 16 * n + 4 * fq); store4bf(d + 16 * n, acc[m][n][0] * r * gg[0], acc[m][n][1] * r * gg[1], acc[m][n][2] * r * gg[2], acc[m][n][3] * r * gg[3]); }
            } else {
                const float* gr = P.mla_rope_gain + ((size_t)l * 2 + 0) * 32; const f32x4 g1 = *(const f32x4*)(gr + 4 * fq), g2 = *(const f32x4*)(gr + 16 + 4 * fq);
#pragma unroll
                for (int hh = 0; hh < 2; ++hh) {
                    const int h = (chunk - 4) * 2 + hh; float ss = 0.f;
#pragma unroll
                    for (int n = 0; n < 2; ++n) { acc[m][2 * hh + n] = acc[m][2 * hh + n] * rt; const f32x4 a = acc[m][2 * hh + n]; ss += a[0] * a[0] + a[1] * a[1] + a[2] * a[2] + a[3] * a[3]; }
                    ss = quad_sum(ss); const float r = rsqrtf(ss * (1.0f / 32.0f) + EPS);
                    float o1[4], o2[4];
#pragma unroll
                    for (int j = 0; j < 4; ++j) { const float2 cs = rope[s * 16 + 4 * fq + j]; const float x1 = acc[m][2 * hh][j] * r * g1[j], x2 = acc[m][2 * hh + 1][j] * r * g2[j];
                        o1[j] = (x1 * cs.x - x2 * cs.y) * SC_MLA; o2[j] = (x1 * cs.y + x2 * cs.x) * SC_MLA; }
                    bf16_t* d = qm + ((size_t)(b * 4 + h) * SEQ + s) * 96 + 64 + 4 * fq; store4bf(d, o1[0], o1[1], o1[2], o1[3]); store4bf(d + 16, o2[0], o2[1], o2[2], o2[3]);
                }
            }
        }
    }
};
struct EpiUkv {
    Params P; int l;
    DEVINL void operator()(f32x4 (&acc)[4][4], int row0, int chunk, int fr, int fq) const {
        const float* ckvss = (const float*)(P.ws + OFF_CKVSS); bf16_t* km = (bf16_t*)((char*)P.out + OOFF_KM); bf16_t* vm = (bf16_t*)((char*)P.out + OOFF_VM);
        const int h = chunk >> 1; const bool isk = (chunk & 1) == 0; const float* gain = P.mla_nope_gain + ((size_t)l * 2 + 1) * 64;
#pragma unroll
        for (int m = 0; m < 4; ++m) {
            const int t = row0 + 16 * m + fr, b = t >> 12, s = t & 4095; const float rt = rsqrtf((ckvss[(size_t)t * 2] + ckvss[(size_t)t * 2 + 1]) * (1.0f / 128.0f) + EPS);
            float ss = 0.f;
#pragma unroll
            for (int n = 0; n < 4; ++n) { acc[m][n] = acc[m][n] * rt; ss += acc[m][n][0] * acc[m][n][0] + acc[m][n][1] * acc[m][n][1] + acc[m][n][2] * acc[m][n][2] + acc[m][n][3] * acc[m][n][3]; }
            if (isk) { ss = quad_sum(ss); const float r = rsqrtf(ss * (1.0f / 64.0f) + EPS); bf16_t* d = km + ((size_t)(b * 4 + h) * SEQ + s) * 96 + 4 * fq;
#pragma unroll
                for (int n = 0; n < 4; ++n) { const f32x4 gg = *(const f32x4*)(gain + 16 * n + 4 * fq); store4bf(d + 16 * n, acc[m][n][0] * r * gg[0], acc[m][n][1] * r * gg[1], acc[m][n][2] * r * gg[2], acc[m][n][3] * r * gg[3]); }
            } else { bf16_t* d = vm + ((size_t)(b * 4 + h) * SEQ + s) * 64 + 4 * fq;
#pragma unroll
                for (int n = 0; n < 4; ++n) store4bf(d + 16 * n, acc[m][n][0], acc[m][n][1], acc[m][n][2], acc[m][n][3]); }
        }
    }
};
struct EpiResid { const float* base; float* out;
    DEVINL void operator()(f32x4 (&acc)[4][4], int row0, int chunk, int fr, int fq) const {
#pragma unroll
        for (int m = 0; m < 4; ++m) { const size_t o = (size_t)(row0 + 16 * m + fr) * DM + chunk * 64 + 4 * fq;
#pragma unroll
            for (int n = 0; n < 4; ++n) { const f32x4 bv = *(const f32x4*)(base + o + 16 * n); *(f32x4*)(out + o + 16 * n) = bv + acc[m][n]; } } } };
struct EpiStore { float* out;
    DEVINL void operator()(f32x4 (&acc)[4][4], int row0, int chunk, int fr, int fq) const {
#pragma unroll
        for (int m = 0; m < 4; ++m) { const size_t o = (size_t)(row0 + 16 * m + fr) * DM + chunk * 64 + 4 * fq;
#pragma unroll
            for (int n = 0; n < 4; ++n) *(f32x4*)(out + o + 16 * n) = acc[m][n]; } } };
struct EpiPle { const float* xa; const float* pp; float* out;
    DEVINL void operator()(f32x4 (&acc)[4][4], int row0, int chunk, int fr, int fq) const {
#pragma unroll
        for (int m = 0; m < 4; ++m) { const size_t o = (size_t)(row0 + 16 * m + fr) * DM + chunk * 64 + 4 * fq;
#pragma unroll
            for (int n = 0; n < 4; ++n) { const f32x4 xv = *(const f32x4*)(xa + o + 16 * n), pv = *(const f32x4*)(pp + o + 16 * n); f32x4 r;
#pragma unroll
                for (int j = 0; j < 4; ++j) r[j] = xv[j] + pv[j] / (1.0f + __expf(-acc[m][n][j]));
                *(f32x4*)(out + o + 16 * n) = r; } } } };

namespace pg8 {
#define PG8_LAS __attribute__((address_space(3)))
constexpr int BM = 256, BK = 64, HALF = 128, HTB = HALF * BK * 2  , STAGE_BYTES = 8 * HTB, NXCD = 8, WGM = 8;

__host__ __device__ __forceinline__ int lds_byte(int r, int c) { const int st = (r >> 4) * 2 + (c >> 5), rr = r & 15, cc = c & 31, ob = rr * 64 + cc * 2; return st * 1024 + (ob ^ (((ob >> 9) & 1) << 5)); }
__host__ __device__ __forceinline__ void stage_rc(int b, int& R, int& C) { const int st = b / 1024, sb = b % 1024, swz = sb ^ (((sb >> 9) & 1) << 5); R = (st >> 1) * 16 + swz / 64; C = (st & 1) * 32 + (swz % 64) / 2; }
__host__ __device__ __forceinline__ int perm32(int rho) { const int n = rho >> 4, i = rho & 15; return 8 * (i >> 2) + 4 * n + (i & 3); }

struct Unit { int pm, pn; };
struct Gemm { const bf16_t* A; const bf16_t* Bt; int M, N, K; };

struct StaticOrder {
    int nM, nN, nwg, G, c;
    __host__ __device__ void init(int M, int N, int G_, int c_) { nM = M / BM; nN = N / BM; nwg = nM * nN; G = G_; c = c_; }
    __host__ __device__ bool next(int i, Unit& u) const {
        const long L = (long)i * G + c; if (L >= nwg) return false;
        int wgid = (int)L; { const int q = nwg / NXCD, r = nwg % NXCD, xcd = wgid % NXCD, off = wgid / NXCD; wgid = (xcd < r ? xcd * (q + 1) : r * (q + 1) + (xcd - r) * q) + off; }
        const int nig = WGM * nN, gid = wgid / nig, fm = gid * WGM, gsz = (nM - fm) < WGM ? (nM - fm) : WGM;
        u.pm = fm + ((wgid % nig) % gsz); u.pn = (wgid % nig) / gsz; return true;
    }
    __device__ __forceinline__ void a_ready(const Unit&) const {}
    __device__ __forceinline__ void done(const Unit&) const {}
};

template <class Epi, class Sched, bool ALIGN_EPI = false, bool SP2 = false>
__device__ __forceinline__ void gemm_phase(PG8_LAS unsigned char* lds, const Gemm g, const Sched& S, const Epi& E) {
    const int tid = ltid(), wid = __builtin_amdgcn_readfirstlane(tid >> 6), lane = tid & 63, wr = wid >> 2, wc = wid & 3, fr = lane & 15, fq = lane >> 4;
    const int K = g.K, nt = K / BK;
    unsigned voffA[2], voffB[2];
#pragma unroll
    for (int i = 0; i < 2; ++i) { int R, C; stage_rc(tid * 16 + i * 8192, R, C); const int Rb = Epi::PERM ? ((R & ~31) + perm32(R & 31)) : R;
        voffA[i] = (unsigned)(R * K + C) * 2u; voffB[i] = (unsigned)(Rb * K + C) * 2u; }
    const size_t kstep = (size_t)(BK * 2);
    const size_t hstep = (size_t)HALF * K * 2;
    const size_t tstep = 2 * hstep;
    const unsigned ldsw = (unsigned)wid * 1024u;
    const int aoff = lds_byte(wr * 64 + fr, fq * 8), boff = lds_byte(wc * 32 + fr, fq * 8);
#define PG8_SA(b, h) (((b) * 2 + (h)) * HTB)
#define PG8_SB(b, h) ((4 + (b) * 2 + (h)) * HTB)
#define PG8_STAGE(bufoff, gbase, voff) do { _Pragma("unroll") for (int _i = 0; _i < 2; ++_i) \
        __builtin_amdgcn_global_load_lds((const unsigned*)((const char*)(gbase) + (voff)[_i]), (PG8_LAS unsigned*)(lds + (bufoff) + ldsw + _i * 8192), 16, 0, 0); } while (0)
#define PG8_LDA(dst, b, h) do { _Pragma("unroll") for (int m = 0; m < 4; ++m) _Pragma("unroll") for (int k = 0; k < 2; ++k) dst[m][k] = *(const PG8_LAS bf16x8*)(lds + PG8_SA(b, h) + aoff + m * 2048 + k * 1024); } while (0)
#define PG8_LDB(dst, b, h) do { _Pragma("unroll") for (int n = 0; n < 2; ++n) _Pragma("unroll") for (int k = 0; k < 2; ++k) dst[n][k] = *(const PG8_LAS bf16x8*)(lds + PG8_SB(b, h) + boff + n * 2048 + k * 1024); } while (0)
#define PG8_MMA(ai, bj, At, Bt) do { __builtin_amdgcn_s_setprio(1); _Pragma("unroll") for (int m = 0; m < 4; ++m) _Pragma("unroll") for (int n = 0; n < 2; ++n) _Pragma("unroll") for (int k = 0; k < 2; ++k) \
        acc[ai][bj][m][n] = __builtin_amdgcn_mfma_f32_16x16x32_bf16(Bt[n][k], At[m][k], acc[ai][bj][m][n], 0, 0, 0); __builtin_amdgcn_s_setprio(0); } while (0)
#define PG8_WAIT_V(n) asm volatile("s_waitcnt vmcnt(" #n ")" ::: "memory")
#define PG8_WAIT_L(n) asm volatile("s_waitcnt lgkmcnt(" #n ")" ::: "memory")
#define PG8_BAR __builtin_amdgcn_s_barrier()
#define PG8_SCHED __builtin_amdgcn_sched_barrier(0)
    Unit cur, nxt; int ui = 0;
    if (!S.next(0, cur)) return;
    f32x4 acc[2][2][4][2];
#pragma unroll
    for (int a = 0; a < 2; ++a)
#pragma unroll
        for (int b = 0; b < 2; ++b)
#pragma unroll
            for (int m = 0; m < 4; ++m)
#pragma unroll
                for (int n = 0; n < 2; ++n) acc[a][b][m][n] = (f32x4){0.f, 0.f, 0.f, 0.f};
    bf16x8 At[4][2], B0[2][2], B1[2][2];
    const char* cA = (const char*)g.A + (size_t)cur.pm * tstep; const char* cB = (const char*)g.Bt + (size_t)cur.pn * tstep;
    S.a_ready(cur);
    if constexpr (SP2) {
        PG8_STAGE(PG8_SB(0, 0), cB, voffB); PG8_STAGE(PG8_SB(0, 1), cB + hstep, voffB); PG8_STAGE(PG8_SA(0, 0), cA, voffA); PG8_STAGE(PG8_SA(0, 1), cA + hstep, voffA);
        if (wr == 1) PG8_BAR;
        PG8_WAIT_V(2); PG8_BAR;
        PG8_STAGE(PG8_SB(1, 0), cB + kstep, voffB); PG8_STAGE(PG8_SA(1, 0), cA + kstep, voffA); PG8_STAGE(PG8_SB(1, 1), cB + hstep + kstep, voffB);
        PG8_WAIT_V(6); PG8_BAR;
    } else {
        PG8_STAGE(PG8_SB(0, 0), cB, voffB); PG8_STAGE(PG8_SA(0, 0), cA, voffA); PG8_STAGE(PG8_SB(0, 1), cB + hstep, voffB); PG8_STAGE(PG8_SA(0, 1), cA + hstep, voffA);
        if (wr == 1) PG8_BAR;
        PG8_WAIT_V(4); PG8_BAR;
        PG8_STAGE(PG8_SB(1, 0), cB + kstep, voffB); PG8_STAGE(PG8_SA(1, 0), cA + kstep, voffA); PG8_STAGE(PG8_SB(1, 1), cB + hstep + kstep, voffB);
        PG8_WAIT_V(6); PG8_BAR;
    }
    for (;;) {
        const bool has_next = S.next(ui + 1, nxt);
        const char* nA = has_next ? (const char*)g.A + (size_t)nxt.pm * tstep : cA; const char* nB = has_next ? (const char*)g.Bt + (size_t)nxt.pn * tstep : cB;
        for (int t = 0; t < nt; t += 2) {
            const bool last = (t == nt - 2);
            const char* a1 = cA + (size_t)(t + 1) * kstep;
            const char* a2 = last ? nA : cA + (size_t)(t + 2) * kstep; const char* b2 = last ? nB : cB + (size_t)(t + 2) * kstep;
            const char* a3 = a2 + kstep; const char* b3 = b2 + kstep;
            if (last && has_next) S.a_ready(nxt);
            if constexpr (SP2) {
            PG8_LDB(B0, 0, 0); PG8_LDB(B1, 0, 1); PG8_SCHED; PG8_LDA(At, 0, 0); PG8_STAGE(PG8_SA(1, 1), a1 + hstep, voffA);
            PG8_WAIT_V(8); PG8_WAIT_L(0); PG8_BAR; PG8_MMA(0, 0, At, B0); PG8_MMA(0, 1, At, B1); PG8_BAR; PG8_SCHED;
            PG8_LDA(At, 0, 1); PG8_STAGE(PG8_SB(0, 0), b2, voffB); PG8_STAGE(PG8_SB(0, 1), b2 + hstep, voffB); PG8_STAGE(PG8_SA(0, 0), a2, voffA);
            PG8_WAIT_V(8); PG8_WAIT_L(0); PG8_BAR; PG8_MMA(1, 0, At, B0); PG8_MMA(1, 1, At, B1); PG8_BAR; PG8_SCHED;
            PG8_LDB(B0, 1, 0); PG8_LDB(B1, 1, 1); PG8_SCHED; PG8_LDA(At, 1, 0); PG8_STAGE(PG8_SA(0, 1), a2 + hstep, voffA);
            PG8_WAIT_V(8); PG8_WAIT_L(0); PG8_BAR; PG8_MMA(0, 0, At, B0); PG8_MMA(0, 1, At, B1); PG8_BAR; PG8_SCHED;
            PG8_LDA(At, 1, 1); PG8_STAGE(PG8_SB(1, 0), b3, voffB); PG8_STAGE(PG8_SB(1, 1), b3 + hstep, voffB); PG8_STAGE(PG8_SA(1, 0), a3, voffA);
            PG8_WAIT_V(8); PG8_WAIT_L(0); PG8_BAR; PG8_MMA(1, 0, At, B0); PG8_MMA(1, 1, At, B1); PG8_BAR; PG8_SCHED;
            } else {
            PG8_LDB(B0, 0, 0); PG8_SCHED; PG8_LDA(At, 0, 0); PG8_STAGE(PG8_SA(1, 1), a1 + hstep, voffA);
            PG8_WAIT_L(8); PG8_BAR; PG8_WAIT_L(0); PG8_MMA(0, 0, At, B0); PG8_BAR; PG8_SCHED;
            PG8_LDB(B1, 0, 1); PG8_STAGE(PG8_SB(0, 0), b2, voffB);
            PG8_BAR; PG8_WAIT_L(0); PG8_MMA(0, 1, At, B1); PG8_BAR;
            PG8_LDA(At, 0, 1); PG8_STAGE(PG8_SA(0, 0), a2, voffA);
            PG8_BAR; PG8_WAIT_L(0); PG8_MMA(1, 0, At, B0); PG8_BAR; PG8_SCHED;
            PG8_STAGE(PG8_SB(0, 1), b2 + hstep, voffB);
            PG8_WAIT_V(6); PG8_BAR; PG8_MMA(1, 1, At, B1); PG8_BAR;
            PG8_LDB(B0, 1, 0); PG8_SCHED; PG8_LDA(At, 1, 0); PG8_STAGE(PG8_SA(0, 1), a2 + hstep, voffA);
            PG8_WAIT_L(8); PG8_BAR; PG8_WAIT_L(0); PG8_MMA(0, 0, At, B0); PG8_BAR; PG8_SCHED;
            PG8_LDB(B1, 1, 1); PG8_STAGE(PG8_SB(1, 0), b3, voffB);
            PG8_BAR; PG8_WAIT_L(0); PG8_MMA(0, 1, At, B1); PG8_BAR;
            PG8_LDA(At, 1, 1); PG8_STAGE(PG8_SA(1, 0), a3, voffA);
            PG8_BAR; PG8_WAIT_L(0); PG8_MMA(1, 0, At, B0); PG8_BAR; PG8_SCHED;
            PG8_STAGE(PG8_SB(1, 1), b3 + hstep, voffB);
            PG8_WAIT_V(6); PG8_BAR; PG8_MMA(1, 1, At, B1); PG8_BAR;
            }
        }
        if constexpr (ALIGN_EPI) { if (wr == 0) PG8_BAR; }
        if constexpr (!Epi::AFTER_DRAIN) { E(acc, cur, wr, wc, fr, fq); S.done(cur); }
        if (!has_next) break;
#pragma unroll
        for (int a = 0; a < 2; ++a)
#pragma unroll
            for (int b = 0; b < 2; ++b)
#pragma unroll
                for (int m = 0; m < 4; ++m)
#pragma unroll
                    for (int n = 0; n < 2; ++n) acc[a][b][m][n] = (f32x4){0.f, 0.f, 0.f, 0.f};
        cur = nxt; cA = nA; cB = nB; ++ui;
        if constexpr (ALIGN_EPI) { if (wr == 1) PG8_BAR; }
    }
    PG8_WAIT_V(0);
    if constexpr (!ALIGN_EPI) { if (wr == 0) PG8_BAR; }
    PG8_BAR;
    if constexpr (Epi::AFTER_DRAIN) { E.fused(acc, cur, wr, wc, fr, fq, lds, wid, lane); S.done(cur); }
#undef PG8_SA
#undef PG8_SB
#undef PG8_STAGE
#undef PG8_LDA
#undef PG8_LDB
#undef PG8_MMA
#undef PG8_WAIT_V
#undef PG8_WAIT_L
#undef PG8_BAR
#undef PG8_SCHED
}
}


DEVINL u32x4 pack8(const f32x4& a, const f32x4& b) { u32x4 w; w.x = cvt2(a[0], a[1]); w.y = cvt2(a[2], a[3]); w.z = cvt2(b[0], b[1]); w.w = cvt2(b[2], b[3]); return w; }
DEVINL float sq4(const f32x4& a) { return a[0] * a[0] + a[1] * a[1] + a[2] * a[2] + a[3] * a[3]; }
struct EpiIn8 {
    static constexpr bool PERM = true, AFTER_DRAIN = false;
    Params P; int l;
    DEVINL void operator()(const f32x4 (&acc)[2][2][4][2], const pg8::Unit& u, int wr, int wc, int fr, int fq) const {
        asm volatile("" : "+v"(fr), "+v"(fq));
        char* ws = P.ws; char* ob = (char*)P.out; const int chunk = u.pn * 4 + wc;
        if (chunk < 36) {
            const int g = chunk >> 2, h = chunk & 3, role = g % 3, mix = g / 3;
            bf16_t* dst = (bf16_t*)(ws + OFF_QKV + (size_t)g * SZ_HEADBUF);
            const float* gain = P.qk_gain + ((size_t)l * 6 + 2 * mix + (role == 1 ? 1 : 0)) * 64 + 8 * fq;
            f32x4 gg[2][2];
#pragma unroll
            for (int bj = 0; bj < 2; ++bj)
#pragma unroll
                for (int n = 0; n < 2; ++n) gg[bj][n] = role != 2 ? *(const f32x4*)(gain + 32 * bj + 4 * n) : (f32x4){1.f, 1.f, 1.f, 1.f};
#pragma unroll
            for (int ai = 0; ai < 2; ++ai)
#pragma unroll
                for (int m = 0; m < 4; ++m) {
                    const int t = u.pm * 256 + 128 * ai + 64 * wr + 16 * m + fr, b = t >> 12, s = t & 4095; bf16_t* d = dst + ((size_t)(b * 4 + h) * SEQ + s) * 64 + 8 * fq;
                    float r = 1.f;
                    if (role != 2) { float ss = sq4(acc[ai][0][m][0]) + sq4(acc[ai][0][m][1]) + sq4(acc[ai][1][m][0]) + sq4(acc[ai][1][m][1]); ss = quad_sum(ss); r = rsqrtf(ss * (1.0f / 64.0f) + EPS) * (role == 0 ? SC_Q : 1.0f); }
#pragma unroll
                    for (int bj = 0; bj < 2; ++bj) *(u32x4*)(d + 32 * bj) = pack8(acc[ai][bj][m][0] * r * gg[bj][0], acc[ai][bj][m][1] * r * gg[bj][1]);
                }
        } else if (chunk < 42) {
            const bool isq = chunk < 40; const int c = isq ? chunk - 36 : chunk - 40;
            bf16_t* dst = isq ? (bf16_t*)(ws + OFF_CQ) : (bf16_t*)(ws + OFF_CKV); const int ld = isq ? 256 : 128;
            float* ssp = isq ? (float*)(ws + OFF_CQSS) : (float*)(ws + OFF_CKVSS); const int nss = isq ? 4 : 2;
#pragma unroll
            for (int ai = 0; ai < 2; ++ai)
#pragma unroll
                for (int m = 0; m < 4; ++m) {
                    const int t = u.pm * 256 + 128 * ai + 64 * wr + 16 * m + fr;
                    float ss = sq4(acc[ai][0][m][0]) + sq4(acc[ai][0][m][1]) + sq4(acc[ai][1][m][0]) + sq4(acc[ai][1][m][1]); ss = quad_sum(ss);
#pragma unroll
                    for (int bj = 0; bj < 2; ++bj) *(u32x4*)(dst + (size_t)t * ld + c * 64 + 32 * bj + 8 * fq) = pack8(acc[ai][bj][m][0], acc[ai][bj][m][1]);
                    if (fq == 0) ssp[(size_t)t * nss + c] = ss;
                }
        } else if (chunk == 42) {
            const float* gr = P.mla_rope_gain + ((size_t)l * 2 + 1) * 32; const float2* rope = (const float2*)(ws + OFF_ROPE);
            bf16_t* km = (bf16_t*)(ob + OOFF_KM); float* logf_ = (float*)(ws + OFF_LOGF);
            const f32x4 g1 = *(const f32x4*)(gr + 4 * fq), g2 = *(const f32x4*)(gr + 16 + 4 * fq); const f32x4 bfv = *(const f32x4*)(P.b_forget + l * 4);
#pragma unroll
            for (int ai = 0; ai < 2; ++ai)
#pragma unroll
                for (int m = 0; m < 4; ++m) {
                    const int t = u.pm * 256 + 128 * ai + 64 * wr + 16 * m + fr, b = t >> 12, s = t & 4095;
                    float ss = sq4(acc[ai][0][m][0]) + sq4(acc[ai][0][m][1]); ss = quad_sum(ss); const float r = rsqrtf(ss * (1.0f / 32.0f) + EPS);
                    float o1[4], o2[4];
#pragma unroll
                    for (int j = 0; j < 4; ++j) { const float2 cs = rope[s * 16 + 4 * fq + j]; const float x1 = acc[ai][0][m][0][j] * r * g1[j], x2 = acc[ai][0][m][1][j] * r * g2[j]; o1[j] = x1 * cs.x - x2 * cs.y; o2[j] = x1 * cs.y + x2 * cs.x; }
#pragma unroll
                    for (int h = 0; h < 4; ++h) { bf16_t* d = km + ((size_t)(b * 4 + h) * SEQ + s) * 96 + 64 + 4 * fq; store4bf(d, o1[0], o1[1], o1[2], o1[3]); store4bf(d + 16, o2[0], o2[1], o2[2], o2[3]); }
                    if (fq == 0) {
#pragma unroll
                        for (int j = 0; j < 4; ++j) logf_[(size_t)(b * 4 + j) * SEQ + s] = log_sigmoid(acc[ai][1][m][0][j] + bfv[j]) * LOG2E;
                    }
                }
        } else if (chunk >= 44) {
            bf16_t* G = (bf16_t*)(ob + OOFF_G); const int c0 = (chunk - 44) * 64 + 8 * fq;
#pragma unroll
            for (int ai = 0; ai < 2; ++ai)
#pragma unroll
                for (int m = 0; m < 4; ++m) {
                    const int t = u.pm * 256 + 128 * ai + 64 * wr + 16 * m + fr;
#pragma unroll
                    for (int bj = 0; bj < 2; ++bj) { f32x4 o0, o1;
#pragma unroll
                        for (int j = 0; j < 4; ++j) { const float z0 = acc[ai][bj][m][0][j], z1 = acc[ai][bj][m][1][j]; o0[j] = z0 / (1.0f + __expf(-z0)); o1[j] = z1 / (1.0f + __expf(-z1)); }
                        *(u32x4*)(G + (size_t)t * DM + c0 + 32 * bj) = pack8(o0, o1); }
                }
        }
    }
};
struct EpiResid8 { static constexpr bool PERM = false, AFTER_DRAIN = false; const float* base; float* out;
    DEVINL void operator()(const f32x4 (&acc)[2][2][4][2], const pg8::Unit& u, int wr, int wc, int fr, int fq) const {
        asm volatile("" : "+v"(fr), "+v"(fq));
#pragma unroll
        for (int ai = 0; ai < 2; ++ai)
#pragma unroll
            for (int m = 0; m < 4; ++m) { const size_t o = (size_t)(u.pm * 256 + 128 * ai + 64 * wr + 16 * m + fr) * DM + u.pn * 256 + 64 * wc + 4 * fq;
#pragma unroll
                for (int bj = 0; bj < 2; ++bj)
#pragma unroll
                    for (int n = 0; n < 2; ++n) { const f32x4 bv = *(const f32x4*)(base + o + 32 * bj + 16 * n); *(f32x4*)(out + o + 32 * bj + 16 * n) = bv + acc[ai][bj][m][n]; } } } };
struct EpiStore8 { static constexpr bool PERM = false, AFTER_DRAIN = false; float* out;
    DEVINL void operator()(const f32x4 (&acc)[2][2][4][2], const pg8::Unit& u, int wr, int wc, int fr, int fq) const {
        asm volatile("" : "+v"(fr), "+v"(fq));
#pragma unroll
        for (int ai = 0; ai < 2; ++ai)
#pragma unroll
            for (int m = 0; m < 4; ++m) { const size_t o = (size_t)(u.pm * 256 + 128 * ai + 64 * wr + 16 * m + fr) * DM + u.pn * 256 + 64 * wc + 4 * fq;
#pragma unroll
                for (int bj = 0; bj < 2; ++bj)
#pragma unroll
                    for (int n = 0; n < 2; ++n) *(f32x4*)(out + o + 32 * bj + 16 * n) = acc[ai][bj][m][n]; } } };
struct EpiPle8 { static constexpr bool PERM = false, AFTER_DRAIN = false; const float* xa; const float* pp; float* out;
    DEVINL void operator()(const f32x4 (&acc)[2][2][4][2], const pg8::Unit& u, int wr, int wc, int fr, int fq) const {
        asm volatile("" : "+v"(fr), "+v"(fq));
#pragma unroll
        for (int ai = 0; ai < 2; ++ai)
#pragma unroll
            for (int m = 0; m < 4; ++m) { const size_t o = (size_t)(u.pm * 256 + 128 * ai + 64 * wr + 16 * m + fr) * DM + u.pn * 256 + 64 * wc + 4 * fq;
#pragma unroll
                for (int bj = 0; bj < 2; ++bj)
#pragma unroll
                    for (int n = 0; n < 2; ++n) { const f32x4 xv = *(const f32x4*)(xa + o + 32 * bj + 16 * n), pv = *(const f32x4*)(pp + o + 32 * bj + 16 * n); f32x4 r;
#pragma unroll
                        for (int j = 0; j < 4; ++j) r[j] = xv[j] + pv[j] / (1.0f + __expf(-acc[ai][bj][m][n][j]));
                        *(f32x4*)(out + o + 32 * bj + 16 * n) = r; } } } };
template <class Epi> DEVINL void gemm8(const bf16_t* A, const bf16_t* Bt, int M, int N, int K, const Epi& E, char* smem) {
    int G = (int)gridDim.x, c = (int)blockIdx.x; asm volatile("" : "+s"(G), "+s"(c));
    pg8::Gemm g{A, Bt, M, N, K}; pg8::StaticOrder S; S.init(M, N, G, c);
    pg8::gemm_phase<Epi, pg8::StaticOrder, true, true>((PG8_LAS unsigned char*)smem, g, S, E);
}

DEVINL void kmean_unit(const Params& P, int u, char* smem) {
    float* red = (float*)smem; const bf16_t* K = (const bf16_t*)(P.ws + OFF_QKV + 4 * SZ_HEADBUF); float* km = (float*)(P.ws + OFF_KMEAN);
    const int tid = ltid(), d = tid & 63, part = tid >> 6;
    const bf16_t* kp = K + ((size_t)(u >> 4) * SEQ + (u & 15) * 256 + part * 32) * 64 + d; float s = 0.f;
    for (int i = 0; i < 32; ++i) s += bf2f(kp[(size_t)i * 64]);
    __syncthreads(); red[tid] = s; __syncthreads();
    if (part == 0) { float a = 0.f;
#pragma unroll
        for (int i = 0; i < 8; ++i) a += red[i * 64 + d];
        km[(size_t)u * 64 + d] = a * (1.0f / 256.0f); }
}

typedef float f32x16 __attribute__((ext_vector_type(16)));
typedef short s16x4 __attribute__((ext_vector_type(4)));
typedef short v4i16_t __attribute__((ext_vector_type(4)));
#define LAS __attribute__((address_space(3)))
#define MFMA32(a, b, c) __builtin_amdgcn_mfma_f32_32x32x16_bf16(a, b, c, 0, 0, 0)
DEVINL s16x4 vtr(const LAS char* p) { return __builtin_bit_cast(s16x4, __builtin_amdgcn_ds_read_tr16_b64_v4i16((LAS v4i16_t*)p)); }
DEVINL float swap_max(float v) { auto rr = __builtin_amdgcn_permlane32_swap(__float_as_uint(v), __float_as_uint(v), false, false); return fmaxf(__uint_as_float(rr[0]), __uint_as_float(rr[1])); }
DEVINL float swap_sum(float v) { auto rr = __builtin_amdgcn_permlane32_swap(__float_as_uint(v), __float_as_uint(v), false, false); return __uint_as_float(rr[0]) + __uint_as_float(rr[1]); }
DEVINL constexpr int crow(int r) { return (r & 3) + 8 * (r >> 2); }

constexpr int L_KB = 0, L_VB = 16384, L_KR = 32768, L_AUX = 40960, L_SCR = 40960 + 16640, L_KMS = L_SCR + 2048, L_ATT_END = L_KMS + 4096;
constexpr float NEGBIG = -3.0e38f, THR = 8.0f;

template <int MODE>
DEVINL void attn_unit(const Params& P, int u, char* smem) {
    constexpr int DK = MODE == 2 ? 96 : 64, ND0 = DK / 16;
    LAS char* lds = (LAS char*)smem;
    const int tid = ltid(), lane = tid & 63, r32 = lane & 31, hi = lane >> 5; const int wid = __builtin_amdgcn_readfirstlane(tid >> 6);
    int bh, q0, t_lo, t_hi, dil = 1, res = 0, pat = 0, qb = 0;
    if (MODE != 3) { bh = u & 15; qb = 15 - (u >> 4); q0 = qb * 256; t_lo = 0; t_hi = (q0 + 255) >> 6; }
    else { pat = u >> 8; const int v = u & 255; bh = v & 15; const int w = v >> 4; dil = pat == 0 ? 1 : (pat == 1 ? 4 : 16); res = w % dil; q0 = (w / dil) * 256; t_lo = (q0 >= 128 ? q0 - 128 : 0) >> 6; t_hi = (q0 + 255) >> 6; }
    const int b = bh >> 2, h = bh & 3;
    const bf16_t *Qg, *Kg, *Vg; int rsq, rsk, rsv;
    if (MODE == 0) { Qg = (const bf16_t*)(P.ws + OFF_QKV) + (size_t)bh * SEQ * 64; Kg = Qg + SZ_HEADBUF / 2; Vg = Kg + SZ_HEADBUF / 2; rsq = rsk = rsv = 64; }
    else if (MODE == 1) { Qg = (const bf16_t*)(P.ws + OFF_QKV + 3 * SZ_HEADBUF) + (size_t)bh * SEQ * 64; Kg = Qg + SZ_HEADBUF / 2; Vg = Kg + SZ_HEADBUF / 2; rsq = rsk = rsv = 64; }
    else if (MODE == 2) { Qg = (const bf16_t*)((const char*)P.out + OOFF_QM) + (size_t)bh * SEQ * 96; Kg = (const bf16_t*)((const char*)P.out + OOFF_KM) + (size_t)bh * SEQ * 96; Vg = (const bf16_t*)((const char*)P.out + OOFF_VM) + (size_t)bh * SEQ * 64; rsq = rsk = 96; rsv = 64; }
    else { Qg = (const bf16_t*)(P.ws + OFF_QKV + 6 * SZ_HEADBUF) + ((size_t)bh * SEQ + res) * 64; Kg = Qg + SZ_HEADBUF / 2; Vg = Kg + SZ_HEADBUF / 2; rsq = rsk = rsv = 64 * dil; }
    const int qw = q0 + 32 * wid;

    __syncthreads();
    LAS float* aux = (LAS float*)(lds + L_AUX);
    if (MODE == 0) {
        LAS float* tot = (LAS float*)(lds + L_SCR);
        const float* lf = (const float*)(P.ws + OFF_LOGF) + (size_t)bh * SEQ + tid * 8; float v[8]; float run = 0.f;
        { const f32x4 a = *(const f32x4*)lf, c = *(const f32x4*)(lf + 4); v[0] = a[0]; v[1] = a[1]; v[2] = a[2]; v[3] = a[3]; v[4] = c[0]; v[5] = c[1]; v[6] = c[2]; v[7] = c[3]; }
#pragma unroll
        for (int i = 0; i < 8; ++i) { run += v[i]; v[i] = run; }
        tot[tid] = run; __syncthreads();
        if (tid < 64) { float a[8]; float acc = 0.f;
#pragma unroll
            for (int i = 0; i < 8; ++i) { acc += tot[tid * 8 + i]; a[i] = acc; }
            float incl = acc;
#pragma unroll
            for (int o = 1; o < 64; o <<= 1) { const float nb = __shfl_up(incl, o); if (tid >= o) incl += nb; }
            const float ex = incl - acc; tot[tid * 8] = ex;
#pragma unroll
            for (int i = 1; i < 8; ++i) tot[tid * 8 + i] = ex + a[i - 1]; }
        __syncthreads();
        const float base = tot[tid];
#pragma unroll
        for (int i = 0; i < 8; ++i) aux[tid * 8 + i] = -(base + v[i]);
    } else if (MODE == 1) {
        const float* lut = (const float*)(P.ws + OFF_LUT) + (size_t)h * 4096;
        for (int i = tid; i < 4160; i += NTHREADS) aux[i] = i >= 64 ? lut[i - 64] : 0.f;
        LAS float* kms = (LAS float*)(lds + L_KMS); const float* km = (const float*)(P.ws + OFF_KMEAN) + (size_t)bh * 1024;
        for (int i = tid; i < 1024; i += NTHREADS) kms[i] = km[i];
    } else if (MODE == 3) {
        const float* lut = (const float*)(P.ws + OFF_LUT) + (size_t)(4 + h) * 4096;
        if (tid < 320) { const int rel = tid - 64; aux[tid] = (rel >= 0 && rel * dil < 4096) ? lut[rel * dil] : 0.f; }
    }
    bf16x8 qf[ND0];
    { const bf16_t* qp = Qg + (size_t)(qw + r32) * rsq + 8 * hi;
#pragma unroll
      for (int d0 = 0; d0 < ND0; ++d0) qf[d0] = *(const bf16x8*)(qp + 16 * d0); }
    __syncthreads();
    unsigned sel = 0;
    if (MODE == 1) {
        const LAS float* kms = (const LAS float*)(lds + L_KMS); float gt[15];
#pragma unroll
        for (int n = 0; n < 15; ++n) { float s = 0.f;
            if (n < qb) {
#pragma unroll
                for (int d0 = 0; d0 < 4; ++d0) { const f32x4 ka = *(const LAS f32x4*)(kms + n * 64 + 16 * d0 + 8 * hi), kb = *(const LAS f32x4*)(kms + n * 64 + 16 * d0 + 8 * hi + 4);
                    const u32x4 w = __builtin_bit_cast(u32x4, qf[d0]);
                    s += bflo(w.x) * ka[0] + bfhi(w.x) * ka[1] + bflo(w.y) * ka[2] + bfhi(w.y) * ka[3] + bflo(w.z) * kb[0] + bfhi(w.z) * kb[1] + bflo(w.w) * kb[2] + bfhi(w.w) * kb[3]; }
                s = swap_sum(s); }
            gt[n] = s; }
#pragma unroll
        for (int k = 0; k < 3; ++k) { float best = NEGBIG; int bi = -1;
#pragma unroll
            for (int n = 0; n < 15; ++n) if (n < qb && !((sel >> n) & 1u) && gt[n] > best) { best = gt[n]; bi = n; }
            if (bi >= 0) sel |= 1u << bi; }
        sel |= 1u << qb;
    }
    const bf16_t* kgp = Kg + (size_t)(tid >> 3) * rsk + (tid & 7) * 8;
    const bf16_t* vgp = Vg + (size_t)((tid >> 2) & 63) * rsv + (tid >> 8) * 32 + (tid & 3) * 8;
    const bf16_t* rgp = Kg + (size_t)((tid >> 2) & 63) * rsk + 64 + (tid & 3) * 8;
    const int kws = (tid >> 3) * 128 + (((tid & 7) ^ ((tid >> 4) & 7)) << 4);
    const int rws = ((tid >> 2) & 63) * 64 + (((tid & 3) ^ ((tid >> 4) & 3)) << 4);
    u32x4 kreg, vreg, rreg;
#define ATT_LOAD(t) do { kreg = *(const u32x4*)(kgp + (size_t)(t) * 64 * rsk); vreg = *(const u32x4*)(vgp + (size_t)(t) * 64 * rsv); if (MODE == 2 && tid < 256) rreg = *(const u32x4*)(rgp + (size_t)(t) * 64 * rsk); } while (0)
#define ATT_WRITE(buf) do { *(LAS u32x4*)(lds + L_KB + (buf) * 8192 + kws) = kreg; *(LAS u32x4*)(lds + L_VB + (buf) * 8192 + tid * 16) = vreg; if (MODE == 2 && tid < 256) *(LAS u32x4*)(lds + L_KR + (buf) * 4096 + rws) = rreg; } while (0)
    int kfo[4];
#pragma unroll
    for (int d0 = 0; d0 < 4; ++d0) kfo[d0] = L_KB + r32 * 128 + (((2 * d0 + hi) ^ ((r32 >> 1) & 7)) << 4);
    int rfo[2];
#pragma unroll
    for (int d0 = 0; d0 < 2; ++d0) rfo[d0] = L_KR + r32 * 64 + (((2 * d0 + hi) ^ ((r32 >> 2) & 3)) << 4);
    const int vfo = L_VB + ((lane >> 4) & 1) * 32 + (lane & 3) * 8 + (4 * hi + ((lane & 15) >> 2)) * 64;

    f32x16 o0, o1;
#pragma unroll
    for (int r = 0; r < 16; ++r) { o0[r] = 0.f; o1[r] = 0.f; }
    float m = NEGBIG, lsum = 0.f;

    ATT_LOAD(t_lo); ATT_WRITE(0); __syncthreads();
    if (t_lo < t_hi) ATT_LOAD(t_lo + 1);
    int cur = 0;
    for (int t = t_lo; t <= t_hi; ++t) {
        const int k0 = t * 64;
        bool skip = k0 > qw + 31; bool need_mask = k0 + 63 > qw;
        if (MODE == 3) { skip = skip || (k0 + 63 < qw - 128); need_mask = need_mask || (k0 < qw + 31 - 128); }
        bool selected = true;
        if (MODE == 1) { selected = (sel >> (t >> 2)) & 1u; skip = skip || !__any(selected); }
        if (!skip) {
            f32x16 p0, p1;
            const int dl = qw + r32 - k0 - 4 * hi;
            if (MODE == 0) { const LAS float* nb = aux + k0 + 4 * hi;
#pragma unroll
                for (int g = 0; g < 4; ++g) { const f32x4 a = *(const LAS f32x4*)(nb + 8 * g), c = *(const LAS f32x4*)(nb + 32 + 8 * g);
                    p0[4 * g] = a[0]; p0[4 * g + 1] = a[1]; p0[4 * g + 2] = a[2]; p0[4 * g + 3] = a[3]; p1[4 * g] = c[0]; p1[4 * g + 1] = c[1]; p1[4 * g + 2] = c[2]; p1[4 * g + 3] = c[3]; }
            } else if (MODE == 1 || MODE == 3) { const LAS float* lp = aux + (dl + 64 - 59);
#pragma unroll
                for (int r = 0; r < 16; ++r) { p0[r] = lp[59 - crow(r)]; p1[r] = lp[59 - crow(r) - 32]; }
            } else {
#pragma unroll
                for (int r = 0; r < 16; ++r) { p0[r] = 0.f; p1[r] = 0.f; }
            }
            const LAS char* kb_ = lds + cur * 8192;
#pragma unroll
            for (int d0 = 0; d0 < 4; ++d0) { const bf16x8 k0f = *(const LAS bf16x8*)(kb_ + kfo[d0]), k1f = *(const LAS bf16x8*)(kb_ + kfo[d0] + 4096);
                p0 = MFMA32(k0f, qf[d0], p0); p1 = MFMA32(k1f, qf[d0], p1); }
            if (MODE == 2) { const LAS char* rb_ = lds + cur * 4096;
#pragma unroll
                for (int d0 = 0; d0 < 2; ++d0) { const bf16x8 k0f = *(const LAS bf16x8*)(rb_ + rfo[d0]), k1f = *(const LAS bf16x8*)(rb_ + rfo[d0] + 2048);
                    p0 = MFMA32(k0f, qf[4 + d0], p0); p1 = MFMA32(k1f, qf[4 + d0], p1); } }
            if (need_mask) {
#pragma unroll
                for (int r = 0; r < 16; ++r) { const int rel0 = dl - crow(r), rel1 = rel0 - 32;
                    const bool v0 = MODE == 3 ? ((unsigned)rel0 <= 128u) : (rel0 >= 0), v1 = MODE == 3 ? ((unsigned)rel1 <= 128u) : (rel1 >= 0);
                    p0[r] = v0 ? p0[r] : NEGBIG; p1[r] = v1 ? p1[r] : NEGBIG; }
            }
            float mx = fmaxf(p0[0], p1[0]);
#pragma unroll
            for (int r = 1; r < 16; ++r) mx = fmaxf(mx, fmaxf(p0[r], p1[r]));
            mx = swap_max(mx);
            if (MODE == 1) mx = selected ? mx : NEGBIG;
            if (__any(mx > m + THR)) {
                const float mn = fmaxf(m, mx), alpha = __builtin_amdgcn_exp2f(m - mn); m = mn; lsum *= alpha;
#pragma unroll
                for (int r = 0; r < 16; ++r) { o0[r] *= alpha; o1[r] *= alpha; }
            }
            const float mu = (MODE == 1 && !selected) ? 3.0e38f : m;
            float ps = 0.f;
#pragma unroll
            for (int r = 0; r < 16; ++r) { p0[r] = __builtin_amdgcn_exp2f(p0[r] - mu); p1[r] = __builtin_amdgcn_exp2f(p1[r] - mu); ps += p0[r] + p1[r]; }
            lsum += ps;
            bf16x8 pb[4];
#pragma unroll
            for (int s = 0; s < 2; ++s) { u32x4 w0, w1;
                w0.x = cvt2(p0[8 * s], p0[8 * s + 1]); w0.y = cvt2(p0[8 * s + 2], p0[8 * s + 3]); w0.z = cvt2(p0[8 * s + 4], p0[8 * s + 5]); w0.w = cvt2(p0[8 * s + 6], p0[8 * s + 7]);
                w1.x = cvt2(p1[8 * s], p1[8 * s + 1]); w1.y = cvt2(p1[8 * s + 2], p1[8 * s + 3]); w1.z = cvt2(p1[8 * s + 4], p1[8 * s + 5]); w1.w = cvt2(p1[8 * s + 6], p1[8 * s + 7]);
                pb[s] = __builtin_bit_cast(bf16x8, w0); pb[2 + s] = __builtin_bit_cast(bf16x8, w1); }
            const LAS char* vb_ = lds + cur * 8192 + vfo;
#pragma unroll
            for (int s = 0; s < 4; ++s) {
                const s16x4 a0 = vtr(vb_ + s * 1024), a1 = vtr(vb_ + s * 1024 + 512), c0 = vtr(vb_ + 4096 + s * 1024), c1 = vtr(vb_ + 4096 + s * 1024 + 512);
                const bf16x8 va = __builtin_shufflevector(a0, a1, 0, 1, 2, 3, 4, 5, 6, 7), vc = __builtin_shufflevector(c0, c1, 0, 1, 2, 3, 4, 5, 6, 7);
                o0 = MFMA32(va, pb[s], o0); o1 = MFMA32(vc, pb[s], o1); }
        }
        if (t < t_hi) ATT_WRITE(cur ^ 1);
        __syncthreads();
        if (t + 2 <= t_hi) ATT_LOAD(t + 2);
        cur ^= 1;
    }
#undef ATT_LOAD
#undef ATT_WRITE
    const float ltot = swap_sum(lsum), inv = 1.0f / ltot;
    if (MODE != 3) {
        const size_t tok = (size_t)b * SEQ + qw + r32; const int colbase = (MODE == 0 ? 0 : (MODE == 1 ? 256 : 768)) + h * 64 + 4 * hi;
        const bf16_t* G = (const bf16_t*)((const char*)P.out + OOFF_G) + tok * DM + colbase; bf16_t* A2 = (bf16_t*)(P.ws + OFF_H) + tok * DM + colbase;
#pragma unroll
        for (int g = 0; g < 4; ++g) {
            const u32x2 g0 = *(const u32x2*)(G + 8 * g), g1 = *(const u32x2*)(G + 32 + 8 * g); u32x2 w0, w1;
            w0.x = cvt2(o0[4 * g] * inv * bflo(g0.x), o0[4 * g + 1] * inv * bfhi(g0.x)); w0.y = cvt2(o0[4 * g + 2] * inv * bflo(g0.y), o0[4 * g + 3] * inv * bfhi(g0.y));
            w1.x = cvt2(o1[4 * g] * inv * bflo(g1.x), o1[4 * g + 1] * inv * bfhi(g1.x)); w1.y = cvt2(o1[4 * g + 2] * inv * bflo(g1.y), o1[4 * g + 3] * inv * bfhi(g1.y));
            *(u32x2*)(A2 + 8 * g) = w0; *(u32x2*)(A2 + 32 + 8 * g) = w1; }
    } else {
        const size_t tok = (size_t)b * SEQ + (size_t)(qw + r32) * dil + res;
        bf16_t* dp = (bf16_t*)(P.ws + OFF_DPART) + ((size_t)pat * NT + tok) * 256 + h * 64 + 4 * hi;
#pragma unroll
        for (int g = 0; g < 4; ++g) { u32x2 w0, w1;
            w0.x = cvt2(o0[4 * g] * inv, o0[4 * g + 1] * inv); w0.y = cvt2(o0[4 * g + 2] * inv, o0[4 * g + 3] * inv);
            w1.x = cvt2(o1[4 * g] * inv, o1[4 * g + 1] * inv); w1.y = cvt2(o1[4 * g + 2] * inv, o1[4 * g + 3] * inv);
            *(u32x2*)(dp + 8 * g) = w0; *(u32x2*)(dp + 32 + 8 * g) = w1; }
        if (hi == 0) ((float*)(P.ws + OFF_DLSE))[((size_t)pat * NT + tok) * 4 + h] = m + __builtin_amdgcn_logf(ltot);
    }
}

DEVINL void dilmix_unit(const Params& P, int u) {
    const int e = u * NTHREADS + ltid(), tok = e >> 5, hd = e & 31, h = hd >> 3, d8 = (hd & 7) * 8;
    const float* ls = (const float*)(P.ws + OFF_DLSE); const bf16_t* dp = (const bf16_t*)(P.ws + OFF_DPART);
    const float l0 = ls[(size_t)tok * 4 + h], l1 = ls[((size_t)NT + tok) * 4 + h], l2 = ls[((size_t)2 * NT + tok) * 4 + h];
    const float mx = fmaxf(l0, fmaxf(l1, l2)); float w0 = __builtin_amdgcn_exp2f(l0 - mx), w1 = __builtin_amdgcn_exp2f(l1 - mx), w2 = __builtin_amdgcn_exp2f(l2 - mx);
    const float inv = 1.0f / (w0 + w1 + w2); w0 *= inv; w1 *= inv; w2 *= inv;
    const size_t off = (size_t)tok * 256 + h * 64 + d8;
    const u32x4 a = *(const u32x4*)(dp + off), b = *(const u32x4*)(dp + (size_t)NT * 256 + off), c = *(const u32x4*)(dp + (size_t)2 * NT * 256 + off);
    const u32x4 g = *(const u32x4*)((const bf16_t*)((const char*)P.out + OOFF_G) + (size_t)tok * DM + 512 + h * 64 + d8);
    u32x4 r;
    r.x = cvt2((w0 * bflo(a.x) + w1 * bflo(b.x) + w2 * bflo(c.x)) * bflo(g.x), (w0 * bfhi(a.x) + w1 * bfhi(b.x) + w2 * bfhi(c.x)) * bfhi(g.x));
    r.y = cvt2((w0 * bflo(a.y) + w1 * bflo(b.y) + w2 * bflo(c.y)) * bflo(g.y), (w0 * bfhi(a.y) + w1 * bfhi(b.y) + w2 * bfhi(c.y)) * bfhi(g.y));
    r.z = cvt2((w0 * bflo(a.z) + w1 * bflo(b.z) + w2 * bflo(c.z)) * bflo(g.z), (w0 * bfhi(a.z) + w1 * bfhi(b.z) + w2 * bfhi(c.z)) * bfhi(g.z));
    r.w = cvt2((w0 * bflo(a.w) + w1 * bflo(b.w) + w2 * bflo(c.w)) * bflo(g.w), (w0 * bfhi(a.w) + w1 * bfhi(b.w) + w2 * bfhi(c.w)) * bfhi(g.w));
    *(u32x4*)((bf16_t*)(P.ws + OFF_H) + (size_t)tok * DM + 512 + h * 64 + d8) = r;
}


#define XB_TMO      128
#define XB_XCNT(j)  (256  + 64 * (j))
#define XB_XSUB(j)  (1280 + 64 * (j))
#define XB_XGEN(j)  (2304 + 64 * (j))
#define XB_TOP      3328
#define XB_TOPGEN   3392
#define XCD_BAR_WORDS 3456
#define XB_SPIN_CAP (1u << 20)
DEVINL unsigned xb_ld(unsigned* p) { return __hip_atomic_load(p, __ATOMIC_RELAXED, __HIP_MEMORY_SCOPE_AGENT); }
DEVINL unsigned xb_add(unsigned* p, unsigned v) { return __hip_atomic_fetch_add(p, v, __ATOMIC_RELAXED, __HIP_MEMORY_SCOPE_AGENT); }
DEVINL unsigned xb_xcc_id() { return (unsigned)__builtin_amdgcn_s_getreg((3 << 11) | 20) & 0xFu; }
#define XB_SPIN(cond, bar) do { unsigned _sp = 0; while (cond) { __builtin_amdgcn_s_sleep(1); \
    if ((++_sp & 255u) == 0u) { if (xb_ld(&(bar)[XB_TMO])) break; if (_sp > XB_SPIN_CAP) { atomicAdd(&(bar)[XB_TMO], 1u); break; } } } } while (0)
DEVINL void xcd_barrier_post(unsigned* bar) { if (ltid() == 0) (void)xb_add(&bar[XB_XCNT(xb_xcc_id())], 1u); }
DEVINL void xcd_barrier_complete(unsigned* bar, unsigned x, unsigned& nloc, unsigned& nx) {
    const unsigned G = gridDim.x * gridDim.y * gridDim.z;
    unsigned sum, cnt, mine, sp = 0u;
    for (;;) {
        sum = 0u; cnt = 0u; mine = 0u;
        for (unsigned j = 0; j < 16; ++j) { const unsigned c = xb_ld(&bar[XB_XCNT(j)]); sum += c; cnt += (c > 0u) ? 1u : 0u; mine = (j == x) ? c : mine; }
        if (sum == G) break;
        __builtin_amdgcn_s_sleep(1);
        if ((++sp & 255u) == 0u) { if (xb_ld(&bar[XB_TMO])) break; if (sp > XB_SPIN_CAP) { atomicAdd(&bar[XB_TMO], 1u); break; } }
    }
    nloc = mine > 0u ? mine : 1u; nx = cnt > 0u ? cnt : 1u;
}
DEVINL void xcd_barrier(unsigned* bar_in, volatile LAS unsigned* st) {
    asm volatile("s_waitcnt vmcnt(0)" ::: "memory");
    __syncthreads();
    if (ltid() == 0) {
        unsigned* bar = bar_in;
        const unsigned x = xb_xcc_id();
        __builtin_amdgcn_s_waitcnt(0);
        unsigned nloc = st[0], nx = st[1];
        if (nloc == 0u) { xcd_barrier_complete(bar, x, nloc, nx); st[0] = nloc; st[1] = nx; }
        const unsigned old = xb_add(&bar[XB_XSUB(x)], 1u);
        const unsigned gen = old / nloc;
        if (old + 1u == (gen + 1u) * nloc) {
            __builtin_amdgcn_fence(__ATOMIC_RELEASE, "agent");
            asm volatile("s_waitcnt vmcnt(0)" ::: "memory");
            const unsigned og = xb_add(&bar[XB_TOP], 1u);
            const unsigned tg = og / nx;
            if (og + 1u == (tg + 1u) * nx) xb_add(&bar[XB_TOPGEN], 1u);
            else XB_SPIN(xb_ld(&bar[XB_TOPGEN]) == tg, bar);
            __builtin_amdgcn_fence(__ATOMIC_ACQUIRE, "agent");
            xb_add(&bar[XB_XGEN(x)], 1u);
            asm volatile("s_waitcnt vmcnt(0)" ::: "memory");
        } else {
            XB_SPIN(xb_ld(&bar[XB_XGEN(x)]) == gen, bar);
            __builtin_amdgcn_fence(__ATOMIC_ACQUIRE, "agent");
            asm volatile("s_waitcnt vmcnt(0)" ::: "memory");
        }
    }
    __syncthreads();
}

constexpr int L_MISC = 131072;
constexpr int L_XB = L_MISC + 16;
constexpr int SMEM_BYTES = L_MISC + 64;

DEVINL int next_unit(unsigned* ctr, char* smem) {
    int* su = (int*)(smem + L_MISC);
    __syncthreads();
    if (ltid() == 0) *su = (int)atomicAdd(ctr, 1u);
    __syncthreads();
    return *su;
}

DEVINL void phase_b1(const Params& P, int l, char* smem) {
    gemm_phase((const bf16_t*)(P.ws + OFF_CQ), (const bf16_t*)(P.ws + OFF_WT_UQ + l * SZ_WT_UQ), NT, 384, 256, EpiUq{P, l}, smem);
    gemm_phase((const bf16_t*)(P.ws + OFF_CKV), (const bf16_t*)(P.ws + OFF_WT_UKV + l * SZ_WT_UKV), NT, 512, 128, EpiUkv{P, l}, smem);
    unsigned* ctr = (unsigned*)(P.ws + OFF_CTR) + l * 2;
    for (;;) { const int u = next_unit(ctr, smem); if (u >= 256 + 768 + 256) break;
        if (u < 256) attn_unit<0>(P, u, smem); else if (u < 1024) attn_unit<3>(P, u - 256, smem); else kmean_unit(P, u - 1024, smem); }
}
DEVINL void phase_b2(const Params& P, int l, char* smem) {
    unsigned* ctr = (unsigned*)(P.ws + OFF_CTR) + l * 2 + 1;
    for (;;) { const int u = next_unit(ctr, smem); if (u >= 512 + 1024) break;
        if (u < 512) { const int v = u >> 5, w = u & 31; if (w < 16) attn_unit<2>(P, v * 16 + w, smem); else attn_unit<1>(P, v * 16 + (w - 16), smem); }
        else dilmix_unit(P, u - 512); }
}

template <int PH> DEVINL void run_phase(const Params& P0, int l, char* smem) {
    const Params& P = P0; asm volatile("" : "+s"(l));
    char* ws = P.ws;
    const float* xin = l == 0 ? P.x : (const float*)(ws + OFF_X);
    float* xa = P.out;
    float* xout = l == 0 ? (float*)(ws + OFF_X) : P.out;
    if (PH == 0) phase_prep(P, smem);
    if (PH == 1) phase_rms(xin, P.ln_g + l * DM, (bf16_t*)(ws + OFF_H), P.p + (size_t)l * NT * 256, (bf16_t*)(ws + OFF_PB));
    if (PH == 2) gemm8((const bf16_t*)(ws + OFF_H), (const bf16_t*)(ws + OFF_WT_IN + l * SZ_WT_IN), NT, NP1, 1024, EpiIn8{P, l}, smem);
    if (PH == 3) phase_b1(P, l, smem);
    if (PH == 4) phase_b2(P, l, smem);
    if (PH == 5) { gemm8((const bf16_t*)(ws + OFF_H), (const bf16_t*)(ws + OFF_WT_OUT + l * SZ_WT_SQ), NT, 1024, 1024, EpiResid8{xin, xa}, smem);
                   gemm8((const bf16_t*)(ws + OFF_PB), (const bf16_t*)(ws + OFF_WT_PP + l * SZ_WT_PP), NT, 1024, 256, EpiStore8{(float*)(ws + OFF_QKV)}, smem); }
    if (PH == 6) phase_rms(xa, P.ple_norm_g + l * DM, (bf16_t*)(ws + OFF_H), nullptr, nullptr);
    if (PH == 7) gemm8((const bf16_t*)(ws + OFF_H), (const bf16_t*)(ws + OFF_WT_PG + l * SZ_WT_SQ), NT, 1024, 1024, EpiPle8{xa, (const float*)(ws + OFF_QKV), xout}, smem);
}

__global__ void __launch_bounds__(NTHREADS) k_mega(Params P) {
    __shared__ __attribute__((aligned(16))) char smem[SMEM_BYTES];
    cooperative_groups::grid_group grid = cooperative_groups::this_grid();
    { const int t0 = ltid(); if (t0 < 4) ((LAS unsigned*)((LAS char*)smem + L_XB))[t0] = 0u; }
    __syncthreads();
    xcd_barrier_post((unsigned*)(P.ws + OFF_BAR));
    int ph = 0, l = 0;
    for (int step = 0; step < 15; ++step) {
        switch (ph) {
            case 0: run_phase<0>(P, l, smem); break;
            case 1: run_phase<1>(P, l, smem); break;
            case 2: run_phase<2>(P, l, smem); break;
            case 3: run_phase<3>(P, l, smem); break;
            case 4: run_phase<4>(P, l, smem); break;
            case 5: run_phase<5>(P, l, smem); break;
            case 6: run_phase<6>(P, l, smem); break;
            default: run_phase<7>(P, l, smem); break;
        }
        if (step == 0) grid.sync();
        else if (step < 14) xcd_barrier((unsigned*)(P.ws + OFF_BAR), (volatile LAS unsigned*)((LAS char*)smem + L_XB));
        if (++ph == 8) { ph = 1; ++l; }
    }
}
}

extern "C" void kernel_launch(void* const* d_in, const int* in_sizes, int n_in, void* d_out, int out_size, void* d_ws, size_t ws_size, hipStream_t stream) {
    Params P{};
    P.x = (const float*)d_in[0]; P.p = (const float*)d_in[1]; P.ln_g = (const float*)d_in[2]; P.w_in = (const float*)d_in[3]; P.b_forget = (const float*)d_in[4]; P.qk_gain = (const float*)d_in[5];
    P.mla_q_norm = (const float*)d_in[6]; P.mla_kv_norm = (const float*)d_in[7]; P.mla_nope_gain = (const float*)d_in[8]; P.mla_rope_gain = (const float*)d_in[9]; P.w_uq = (const float*)d_in[10];
    P.w_ukv = (const float*)d_in[11]; P.w_out = (const float*)d_in[12]; P.rel_bias = (const float*)d_in[13]; P.ple_norm_g = (const float*)d_in[14]; P.w_ple_gate = (const float*)d_in[15]; P.w_ple_proj = (const float*)d_in[16];
    P.out = (float*)d_out; P.ws = (char*)d_ws;
    if (ws_size < WS_NEED) { fprintf(stderr, "workspace too small: %zu < %zu\n", ws_size, (size_t)WS_NEED); return; }
    static int grid_blocks = 0;
    if (!grid_blocks) {
        int dev = 0, cus = 0, per_cu = 0;
        hipGetDevice(&dev);
        hipDeviceGetAttribute(&cus, hipDeviceAttributeMultiprocessorCount, dev);
        hipOccupancyMaxActiveBlocksPerMultiprocessor(&per_cu, k_mega, NTHREADS, 0);
        if (per_cu > 1) per_cu = 1;
        grid_blocks = cus * per_cu;
    }
    hipMemsetAsync((char*)d_ws + OFF_CTR, 0, 256 + 3456 * 4, stream);
    void* args[] = {&P};
    hipError_t e = hipLaunchCooperativeKernel((void*)k_mega, dim3(grid_blocks), dim3(NTHREADS), args, 0, stream);
    if (e != hipSuccess) fprintf(stderr, "cooperative launch failed: %s (grid %d)\n", hipGetErrorString(e), grid_blocks);
}
```

```cpp
#include <hip/hip_runtime.h>
#include <hip/hip_cooperative_groups.h>
#include <cstdint>
#include <cstdio>

#ifndef ONE_LAUNCH
#define ONE_LAUNCH 1
#endif

namespace {
#define DEVINL __device__ __forceinline__
typedef unsigned short bf16_t;
typedef short bf16x8 __attribute__((ext_vector_type(8)));
typedef float f32x4 __attribute__((ext_vector_type(4)));
typedef unsigned u32x2 __attribute__((ext_vector_type(2)));
typedef unsigned u32x4 __attribute__((ext_vector_type(4)));

constexpr int NB = 4, SEQ = 4096, DM = 1024, NT = NB * SEQ, NH = 4, NBH = NB * NH;
constexpr int INW = 3748, NP1 = 3840;
constexpr float EPS = 1e-6f, LOG2E = 1.4426950408889634f;
constexpr float SC_Q = 0.125f * LOG2E;
constexpr float SC_MLA = 0.10206207261596575f * LOG2E;
constexpr int NTHREADS = 512;

constexpr size_t SZ_WT_IN = (size_t)NP1 * 1024 * 2, SZ_WT_UQ = 512 * 256 * 2  , SZ_WT_UKV = 512 * 256 * 2  , SZ_WT_SQ = 1024 * 1024 * 2, SZ_WT_PP = 1024 * 256 * 2;
constexpr size_t OFF_WT_IN = 0;
constexpr size_t OFF_WT_UQ = OFF_WT_IN + 2 * SZ_WT_IN;
constexpr size_t OFF_WT_UKV = OFF_WT_UQ + 2 * SZ_WT_UQ;
constexpr size_t OFF_WT_OUT = OFF_WT_UKV + 2 * SZ_WT_UKV;
constexpr size_t OFF_WT_PG = OFF_WT_OUT + 2 * SZ_WT_SQ;
constexpr size_t OFF_WT_PP = OFF_WT_PG + 2 * SZ_WT_SQ;
constexpr size_t OFF_LUT = OFF_WT_PP + 2 * SZ_WT_PP;
constexpr size_t OFF_ROPE = OFF_LUT + 8 * 4096 * 4;
constexpr size_t OFF_H = OFF_ROPE + 4096 * 16 * 8;
constexpr size_t SZ_HEADBUF = (size_t)NT * 256 * 2;
constexpr size_t OFF_QKV = OFF_H + (size_t)NT * 1024 * 2;
constexpr size_t OFF_XABF = OFF_QKV + (size_t)NT * 1024 * 2;
constexpr size_t OFF_CQ = OFF_QKV + 9 * SZ_HEADBUF;
constexpr size_t OFF_CKV = OFF_CQ + (size_t)NT * 256 * 2;
constexpr size_t OFF_CQSS = OFF_CKV + (size_t)NT * 256 * 2;
constexpr size_t OFF_CKVSS = OFF_CQSS + (size_t)NT * 4 * 4;
constexpr size_t OFF_LOGF = OFF_CKVSS + (size_t)NT * 2 * 4;
constexpr size_t OFF_KMEAN = OFF_LOGF + (size_t)NBH * SEQ * 4;
constexpr size_t OFF_PB = OFF_KMEAN + (size_t)NBH * 16 * 64 * 4;
constexpr size_t OFF_X = OFF_PB + (size_t)NT * 256 * 2;
constexpr size_t OFF_PB2 = OFF_X + (size_t)NT * 1024 * 4;
constexpr size_t OFF_SSQX = OFF_PB2 + (size_t)NT * 256 * 2;
constexpr size_t OFF_SSQA = OFF_SSQX + (size_t)NT * 16 * 4;
constexpr size_t OFF_DPART = OFF_SSQA + (size_t)NT * 16 * 4;
constexpr size_t OFF_DLSE = OFF_DPART + 3 * (size_t)NT * 256 * 2;
constexpr size_t OFF_CTR = OFF_DLSE + 3 * (size_t)NT * 4 * 4;
constexpr size_t OFF_BOUND = OFF_CTR + 256;
constexpr size_t OFF_BAR = OFF_BOUND + 256;
constexpr size_t WS_NEED = OFF_BAR + 3456 * 4;
constexpr size_t OOFF_G = 0;
constexpr size_t OOFF_QM = (size_t)NT * 1024 * 2;
constexpr size_t OOFF_KM = OOFF_QM + (size_t)NBH * SEQ * 96 * 2;
constexpr size_t OOFF_VM = OOFF_KM + (size_t)NBH * SEQ * 96 * 2;

struct Params {
    const float *x, *p, *ln_g, *w_in, *b_forget, *qk_gain, *mla_q_norm, *mla_kv_norm, *mla_nope_gain, *mla_rope_gain, *w_uq, *w_ukv, *w_out, *rel_bias, *ple_norm_g, *w_ple_gate, *w_ple_proj;
    float* out;
    char* ws;
};

DEVINL char* as_global(const void* p) { __attribute__((address_space(1))) char* g; asm volatile("" : "=s"(g) : "0"(p)); return (char*)g; }
constexpr int L_MISC = 131072;
constexpr int L_XB = L_MISC + 16, L_WTAB = L_MISC + 64, SMEM_BYTES = L_MISC + 64 + 256;
__shared__ __attribute__((aligned(16))) char g_smem[SMEM_BYTES];
DEVINL int ltid() {
    const unsigned hw = (unsigned)__builtin_amdgcn_s_getreg(0x2804);
    const int w = __builtin_amdgcn_readfirstlane(*(const __attribute__((address_space(3))) int*)((__attribute__((address_space(3))) char*)g_smem + L_WTAB + hw * 4));
    int lane; asm volatile("v_mbcnt_lo_u32_b32 %0, -1, 0\n\tv_mbcnt_hi_u32_b32 %0, -1, %0" : "=v"(lane));
    return w * 64 + lane; }
DEVINL float shx(float v, int mask) { return __int_as_float(__builtin_amdgcn_ds_bpermute(((ltid() & 63) ^ mask) << 2, __float_as_int(v))); }
DEVINL float shup(float v, int o) { return __int_as_float(__builtin_amdgcn_ds_bpermute(((ltid() & 63) - o) << 2, __float_as_int(v))); }
DEVINL float sq4(const f32x4& a) { return a[0] * a[0] + a[1] * a[1] + a[2] * a[2] + a[3] * a[3]; }
template <int XM> DEVINL float swz_xor(float v) { return __int_as_float(__builtin_amdgcn_ds_swizzle(__float_as_int(v), (XM << 10) | 0x1F)); }
DEVINL float half_swap_sum(float v) { auto rr = __builtin_amdgcn_permlane32_swap(__float_as_uint(v), __float_as_uint(v), false, false); return __uint_as_float(rr[0]) + __uint_as_float(rr[1]); }
DEVINL float wave_sum(float v) { v += swz_xor<1>(v); v += swz_xor<2>(v); v += swz_xor<4>(v); v += swz_xor<8>(v); v += swz_xor<16>(v); return half_swap_sum(v); }
DEVINL bf16_t f2bf(float f) { unsigned u = __float_as_uint(f); u += 0x7fffu + ((u >> 16) & 1u); return (bf16_t)(u >> 16); }
DEVINL float bf2f(bf16_t h) { return __uint_as_float(((unsigned)h) << 16); }
DEVINL unsigned pack2(float a, float b) { return (unsigned)f2bf(a) | ((unsigned)f2bf(b) << 16); }
typedef __bf16 bf16v2 __attribute__((ext_vector_type(2)));
typedef float f32v2 __attribute__((ext_vector_type(2)));
DEVINL unsigned cvt2(float a, float b) { f32v2 v = {a, b}; return __builtin_bit_cast(unsigned, __builtin_convertvector(v, bf16v2)); }
DEVINL float bflo(unsigned u) { return __uint_as_float(u << 16); }
DEVINL float bfhi(unsigned u) { return __uint_as_float(u & 0xffff0000u); }

__device__ __constant__ float ROPE_INV[16] = {1.0f, 0.5623413251903491f, 0.31622776601683794f, 0.1778279410038923f, 0.1f, 0.05623413251903491f, 0.03162277660168379f, 0.01778279410038923f,
                                              0.01f, 0.005623413251903491f, 0.0031622776601683794f, 0.0017782794100389228f, 0.001f, 0.0005623413251903491f, 0.00031622776601683794f, 0.00017782794100389227f};

DEVINL int t5_bucket(int d) {
    if (d < 16) return d;
    int b = 16;
    b += (d >= 22); b += (d >= 30); b += (d >= 40); b += (d >= 54); b += (d >= 73); b += (d >= 99); b += (d >= 134); b += (d >= 182);
    b += (d >= 246); b += (d >= 332); b += (d >= 450); b += (d >= 609); b += (d >= 825); b += (d >= 1117); b += (d >= 1513);
    return b;
}

DEVINL int map_w_in(int n) { return n < 768 ? n : (n < 2720 ? n + 4 : (n < 2724 ? n - 2720 + 768 : (n < 2816 ? -1 : n - 92))); }
DEVINL int virt_col(int nv) { const int v = nv & 255; return (nv & ~255) + 64 * ((v >> 5) & 3) + 32 * (v >> 7) + (v & 31); }
DEVINL int map_w_in_virt(int nv) { int a = virt_col(nv); const int chunk = a >> 6; int hc = a & 63;
    if (chunk == 42 && hc < 32) hc = 16 * ((hc >> 2) & 1) + 4 * (hc >> 3) + (hc & 3);
    return map_w_in(chunk * 64 + hc); }
DEVINL int map_w_uq_virt(int nv) { const int a = virt_col(nv), chunk = a >> 6; int hc = a & 63; if (chunk >= 6) return -1;
    if (chunk >= 4) { const int e = hc & 31; hc = (hc & 32) + 16 * ((e >> 2) & 1) + 4 * (e >> 3) + (e & 3); }
    const int n = chunk * 64 + hc; if (n < 256) return (n >> 6) * 96 + (n & 63); const int r = n - 256; return (r >> 5) * 96 + 64 + (r & 31); }
DEVINL int map_w_uq(int n) { if (n < 256) return (n >> 6) * 96 + (n & 63); const int r = n - 256; return (r >> 5) * 96 + 64 + (r & 31); }

template <int KT>
DEVINL void transpose_tile(const float* src, int Nsrc, bf16_t* dst, int K, int tn, int tk, int mode, const float* fold, float* tile  ) {
    const int tid = ltid(), c4 = (tid & 15) * 4, kr = tid >> 4  , n0 = tn * 64, k0 = tk * KT;
    const int n = n0 + c4, oc = mode == 1 ? map_w_in_virt(n) : (mode == 2 ? map_w_uq(n) : (mode == 3 ? virt_col(n) : (mode == 4 ? map_w_uq_virt(n) : (mode == 5 ? virt_col(n) : n))));
    f32x4 v[KT / 32];
#pragma unroll
    for (int i = 0; i < KT / 32; ++i) { const int kk = kr + 32 * i; v[i] = (f32x4){0.f, 0.f, 0.f, 0.f}; if (oc >= 0 && !(mode == 5 && k0 + kk >= 128)) { v[i] = __builtin_nontemporal_load((const f32x4*)(src + (size_t)(k0 + kk) * Nsrc + oc)); if (fold) v[i] = v[i] * fold[k0 + kk]; } }
    __syncthreads();
#pragma unroll
    for (int i = 0; i < KT / 32; ++i) *(f32x4*)(tile + (kr + 32 * i) * 68 + c4) = v[i];
    __syncthreads();
#pragma unroll
    for (int h = 0; h < KT / 64; ++h) { const int nn = tid & 63, kc = h * 64 + (tid >> 6) * 8; const float* tp = tile + kc * 68 + nn; u32x4 w;
      w.x = cvt2(tp[0], tp[68]); w.y = cvt2(tp[136], tp[204]); w.z = cvt2(tp[272], tp[340]); w.w = cvt2(tp[408], tp[476]);
      *(u32x4*)(dst + (size_t)(n0 + nn) * K + k0 + kc) = w; }
}

constexpr int PREP_T_IN = 60 * 4, PREP_T_UQ = 8 * 1, PREP_T_UKV = 8 * 1, PREP_T_SQ = 16 * 4, PREP_T_PP = 16 * 1;
constexpr int PREP_PER_LAYER = PREP_T_IN + PREP_T_UQ + PREP_T_UKV + 2 * PREP_T_SQ + PREP_T_PP;
constexpr int PREP_LUT_UNITS = 8 * 4096 / 512, PREP_ROPE_UNITS = 4096 * 16 / 512;
constexpr int PREP_X_UNITS = NT / 32, PREP_P_UNITS = 2 * NT / 64;
constexpr int PREP_UNITS = 2 * PREP_PER_LAYER + PREP_LUT_UNITS + PREP_ROPE_UNITS + PREP_X_UNITS + PREP_P_UNITS;

DEVINL void prep_w_unit(const Params& P, int l, int r, float* tile) {
    if (r < PREP_T_IN) { transpose_tile<256>(P.w_in + (size_t)l * 1024 * INW, INW, (bf16_t*)(P.ws + OFF_WT_IN + l * SZ_WT_IN), 1024, r % 60, r / 60, 1, P.ln_g + l * DM, tile); return; }
    r -= PREP_T_IN;
    if (r < PREP_T_UQ) { transpose_tile<256>(P.w_uq + (size_t)l * 256 * 384, 384, (bf16_t*)(P.ws + OFF_WT_UQ + l * SZ_WT_UQ), 256, r % 8, r / 8, 4, P.mla_q_norm + l * 256, tile); return; }
    r -= PREP_T_UQ;
    if (r < PREP_T_UKV) { transpose_tile<256>(P.w_ukv + (size_t)l * 128 * 512, 512, (bf16_t*)(P.ws + OFF_WT_UKV + l * SZ_WT_UKV), 256, r % 8, r / 8, 5, P.mla_kv_norm + l * 128, tile); return; }
    r -= PREP_T_UKV;
    if (r < PREP_T_SQ) { transpose_tile<256>(P.w_out + (size_t)l * 1024 * 1024, 1024, (bf16_t*)(P.ws + OFF_WT_OUT + l * SZ_WT_SQ), 1024, r % 16, r / 16, 3, nullptr, tile); return; }
    r -= PREP_T_SQ;
    if (r < PREP_T_SQ) { transpose_tile<256>(P.w_ple_gate + (size_t)l * 1024 * 1024, 1024, (bf16_t*)(P.ws + OFF_WT_PG + l * SZ_WT_SQ), 1024, r % 16, r / 16, 3, P.ple_norm_g + l * DM, tile); return; }
    r -= PREP_T_SQ;
    transpose_tile<256>(P.w_ple_proj + (size_t)l * 256 * 1024, 1024, (bf16_t*)(P.ws + OFF_WT_PP + l * SZ_WT_PP), 256, r % 16, r / 16, 3, nullptr, tile);
}
DEVINL void prep_p_unit(const Params& P, int v) {
    const int wid = ltid() >> 6, lane = ltid() & 63; f32x4 a[8];
#pragma unroll
    for (int rr = 0; rr < 8; ++rr) a[rr] = __builtin_nontemporal_load((const f32x4*)(P.p + (size_t)(v * 64 + wid * 8 + rr) * 256 + lane * 4));
#pragma unroll
    for (int rr = 0; rr < 8; ++rr) { const int row = v * 64 + wid * 8 + rr; u32x2 w; w.x = cvt2(a[rr][0], a[rr][1]); w.y = cvt2(a[rr][2], a[rr][3]);
        bf16_t* pb = row < NT ? (bf16_t*)(P.ws + OFF_PB) + (size_t)row * 256 : (bf16_t*)(P.ws + OFF_PB2) + (size_t)(row - NT) * 256; *(u32x2*)(pb + lane * 4) = w; }
}
DEVINL void phase_prep(const Params& P, char* smem) {
    float* tile = (float*)smem;
    if (blockIdx.x == 0 && ltid() < 8) {
        const int l = ltid() >> 2, md = ltid() & 3; float bound;
        auto amax = [](const float* p, int n) { float a = 0.f; for (int i = 0; i < n; ++i) a = fmaxf(a, fabsf(p[i])); return a; };
        if (md == 2) { const float nq = amax(P.mla_nope_gain + (l * 2 + 0) * 64, 64), nk = amax(P.mla_nope_gain + (l * 2 + 1) * 64, 64), rq = amax(P.mla_rope_gain + (l * 2 + 0) * 32, 32), rk = amax(P.mla_rope_gain + (l * 2 + 1) * 32, 32);
            bound = sqrtf(64.f * nq * nq + 32.f * rq * rq) * sqrtf(64.f * nk * nk + 32.f * rk * rk) * SC_MLA; }
        else { const int mix = md == 0 ? 0 : (md == 1 ? 1 : 2); bound = 64.f * amax(P.qk_gain + (l * 6 + 2 * mix) * 64, 64) * amax(P.qk_gain + (l * 6 + 2 * mix + 1) * 64, 64) * SC_Q;
            if (md == 0) bound += 8.f; else bound += amax(P.rel_bias, 256) * LOG2E; }
        ((float*)(P.ws + OFF_BOUND))[l * 4 + md] = bound;
    }
    constexpr int U_W = PREP_PER_LAYER, U_LUT = U_W + PREP_LUT_UNITS, U_ROPE = U_LUT + PREP_ROPE_UNITS, U_X = U_ROPE + PREP_X_UNITS, U_P = U_X + PREP_P_UNITS / 2;
    for (int u = blockIdx.x; u < U_P; u += gridDim.x) {
        if (u < U_W) { if (u < PREP_T_IN + PREP_T_UQ + PREP_T_UKV) prep_w_unit(P, 0, u, tile); }
        else if (u < U_LUT) { const int e = (u - U_W) * 512 + ltid(), hh = e >> 12, d = e & 4095; ((float*)(P.ws + OFF_LUT))[e] = P.rel_bias[t5_bucket(d) * 8 + hh] * LOG2E; }
        else if (u < U_ROPE) { const int e = (u - U_LUT) * 512 + ltid(), pos = e >> 4, i = e & 15;
            const double rev = (double)pos * (double)ROPE_INV[i] * 0.15915494309189535; const float fr = (float)(rev - floor(rev));
            ((float2*)(P.ws + OFF_ROPE))[e] = make_float2(__builtin_amdgcn_cosf(fr), __builtin_amdgcn_sinf(fr)); }
        else if (u < U_X) { const int v = u - U_ROPE, wid = ltid() >> 6, lane = ltid() & 63;
            f32x4 a[4][4];
#pragma unroll
            for (int rr = 0; rr < 4; ++rr)
#pragma unroll
                for (int i = 0; i < 4; ++i) a[rr][i] = __builtin_nontemporal_load((const f32x4*)(P.x + (size_t)(v * 32 + wid * 4 + rr) * DM + i * 256 + lane * 4));
#pragma unroll
            for (int rr = 0; rr < 4; ++rr) { const int row = v * 32 + wid * 4 + rr; float ss = 0.f;
#pragma unroll
                for (int i = 0; i < 4; ++i) { ss += sq4(a[rr][i]); u32x2 w; w.x = cvt2(a[rr][i][0], a[rr][i][1]); w.y = cvt2(a[rr][i][2], a[rr][i][3]); *(u32x2*)((bf16_t*)(P.ws + OFF_H) + (size_t)row * DM + i * 256 + lane * 4) = w; }
                ss = wave_sum(ss); if (lane < 16) ((float*)(P.ws + OFF_SSQX))[(size_t)row * 16 + lane] = lane == 0 ? ss : 0.f;
                if (lane < 16) *(u32x4*)((bf16_t*)(P.ws + OFF_CKV) + (size_t)row * 256 + 128 + lane * 8) = (u32x4){0u, 0u, 0u, 0u}; } }
        else {   }
    }
}

DEVINL void phase_rms(const float* src, const float* g, bf16_t* dst, const float* psrc, bf16_t* pb) {
    const int wid = ltid() >> 6, lane = ltid() & 63;
    for (int u = blockIdx.x; u < NT / 8; u += gridDim.x) {
        const int row = u * 8 + wid; const float* xr = src + (size_t)row * DM;
        f32x4 v[4]; float ss = 0.f;
#pragma unroll
        for (int i = 0; i < 4; ++i) { v[i] = *(const f32x4*)(xr + i * 256 + lane * 4); ss += v[i][0] * v[i][0] + v[i][1] * v[i][1] + v[i][2] * v[i][2] + v[i][3] * v[i][3]; }
        ss = wave_sum(ss); const float r = rsqrtf(ss * (1.0f / DM) + EPS);
#pragma unroll
        for (int i = 0; i < 4; ++i) { const f32x4 gg = *(const f32x4*)(g + i * 256 + lane * 4); u32x2 w; w.x = pack2(v[i][0] * r * gg[0], v[i][1] * r * gg[1]); w.y = pack2(v[i][2] * r * gg[2], v[i][3] * r * gg[3]);
            *(u32x2*)(dst + (size_t)row * DM + i * 256 + lane * 4) = w; }
        if (psrc) { const f32x4 pv = *(const f32x4*)(psrc + (size_t)row * 256 + lane * 4); u32x2 w; w.x = pack2(pv[0], pv[1]); w.y = pack2(pv[2], pv[3]); *(u32x2*)(pb + (size_t)row * 256 + lane * 4) = w; }
    }
}

constexpr int GST = 40;
template <class Epi>
DEVINL void gemm_phase(const bf16_t* A, const bf16_t* Bt, int M, int N, int K, const Epi& epi, char* smem) {
    bf16_t* As = (bf16_t*)smem; bf16_t* Bs = As + 256 * GST;
    const int tid = ltid(), wid = tid >> 6, lane = tid & 63, wr = wid >> 1, wc = wid & 1, fr = lane & 15, fq = lane >> 4;
    const int ntm = M / 256, ntn = N / 128, nk = K / 32;
    const int lr = tid >> 2, lc = (tid & 3) * 8;
    for (int tile = blockIdx.x; tile < ntm * ntn; tile += gridDim.x) {
        const int tm = tile % ntm, tn = tile / ntm;
        const bf16_t* Ag = A + (size_t)(tm * 256 + lr) * K + lc; const bf16_t* Bg = Bt + (size_t)(tn * 128 + lr) * K + lc;
        f32x4 acc[4][4];
#pragma unroll
        for (int m = 0; m < 4; ++m)
#pragma unroll
            for (int n = 0; n < 4; ++n) acc[m][n] = (f32x4){0.f, 0.f, 0.f, 0.f};
        u32x4 ra0 = *(const u32x4*)Ag, ra1 = *(const u32x4*)(Ag + (size_t)128 * K), rb0 = *(const u32x4*)Bg;
        for (int kt = 0; kt < nk; ++kt) {
            __syncthreads();
            *(u32x4*)(As + lr * GST + lc) = ra0; *(u32x4*)(As + (lr + 128) * GST + lc) = ra1; *(u32x4*)(Bs + lr * GST + lc) = rb0;
            __syncthreads();
            if (kt + 1 < nk) { const int ko = (kt + 1) * 32; ra0 = *(const u32x4*)(Ag + ko); ra1 = *(const u32x4*)(Ag + (size_t)128 * K + ko); rb0 = *(const u32x4*)(Bg + ko); }
            bf16x8 af[4], bfr[4];
#pragma unroll
            for (int m = 0; m < 4; ++m) af[m] = *(const bf16x8*)(As + (wr * 64 + m * 16 + fr) * GST + fq * 8);
#pragma unroll
            for (int n = 0; n < 4; ++n) bfr[n] = *(const bf16x8*)(Bs + (wc * 64 + n * 16 + fr) * GST + fq * 8);
#pragma unroll
            for (int m = 0; m < 4; ++m)
#pragma unroll
                for (int n = 0; n < 4; ++n) acc[m][n] = __builtin_amdgcn_mfma_f32_16x16x32_bf16(bfr[n], af[m], acc[m][n], 0, 0, 0);
        }
        epi(acc, tm * 256 + wr * 64, tn * 2 + wc, fr, fq);
    }
    __syncthreads();
}

DEVINL float quad_sum(float v) { v += swz_xor<16>(v); return half_swap_sum(v); }
DEVINL void store4bf(bf16_t* p, float a, float b, float c, float d) { u32x2 w; w.x = pack2(a, b); w.y = pack2(c, d); *(u32x2*)p = w; }
DEVINL float fsigmoid(float z) { return __builtin_amdgcn_rcpf(1.0f + __builtin_amdgcn_exp2f(-LOG2E * z)); }
DEVINL float log_sigmoid(float z) { return fminf(z, 0.f) - log1pf(__expf(-fabsf(z))); }

struct EpiIn {
    Params P; int l;
    DEVINL void operator()(f32x4 (&acc)[4][4], int row0, int chunk, int fr, int fq) const {
        char* ws = P.ws; char* ob = (char*)P.out;
        if (chunk < 36) {
            const int g = chunk >> 2, h = chunk & 3, role = g % 3, mix = g / 3;
            bf16_t* dst = (bf16_t*)(ws + OFF_QKV + (size_t)g * SZ_HEADBUF);
            const float* gain = P.qk_gain + ((size_t)l * 6 + 2 * mix + (role == 1 ? 1 : 0)) * 64;
#pragma unroll
            for (int m = 0; m < 4; ++m) {
                const int t = row0 + 16 * m + fr, b = t >> 12, s = t & 4095; bf16_t* d = dst + ((size_t)(b * 4 + h) * SEQ + s) * 64 + 4 * fq;
                float r = 1.f;
                if (role != 2) { float ss = 0.f;
#pragma unroll
                    for (int n = 0; n < 4; ++n) ss += acc[m][n][0] * acc[m][n][0] + acc[m][n][1] * acc[m][n][1] + acc[m][n][2] * acc[m][n][2] + acc[m][n][3] * acc[m][n][3];
                    ss = quad_sum(ss); r = rsqrtf(ss * (1.0f / 64.0f) + EPS) * (role == 0 ? SC_Q : 1.0f); }
#pragma unroll
                for (int n = 0; n < 4; ++n) { f32x4 gg = (f32x4){1.f, 1.f, 1.f, 1.f}; if (role != 2) gg = *(const f32x4*)(gain + 16 * n + 4 * fq);
                    store4bf(d + 16 * n, acc[m][n][0] * r * gg[0], acc[m][n][1] * r * gg[1], acc[m][n][2] * r * gg[2], acc[m][n][3] * r * gg[3]); }
            }
        } else if (chunk < 42) {
            const bool isq = chunk < 40; const int c = isq ? chunk - 36 : chunk - 40;
            bf16_t* dst = isq ? (bf16_t*)(ws + OFF_CQ) : (bf16_t*)(ws + OFF_CKV); const int ld = isq ? 256 : 128;
            float* ssp = isq ? (float*)(ws + OFF_CQSS) : (float*)(ws + OFF_CKVSS); const int nss = isq ? 4 : 2;
#pragma unroll
            for (int m = 0; m < 4; ++m) {
                const int t = row0 + 16 * m + fr; float ss = 0.f;
#pragma unroll
                for (int n = 0; n < 4; ++n) { ss += acc[m][n][0] * acc[m][n][0] + acc[m][n][1] * acc[m][n][1] + acc[m][n][2] * acc[m][n][2] + acc[m][n][3] * acc[m][n][3];
                    store4bf(dst + (size_t)t * ld + c * 64 + 16 * n + 4 * fq, acc[m][n][0], acc[m][n][1], acc[m][n][2], acc[m][n][3]); }
                ss = quad_sum(ss); if (fq == 0) ssp[(size_t)t * nss + c] = ss;
            }
        } else if (chunk == 42) {
            const float* gr = P.mla_rope_gain + ((size_t)l * 2 + 1) * 32; const float2* rope = (const float2*)(ws + OFF_ROPE);
            bf16_t* km = (bf16_t*)(ob + OOFF_KM); float* logf_ = (float*)(ws + OFF_LOGF);
            const f32x4 g1 = *(const f32x4*)(gr + 4 * fq), g2 = *(const f32x4*)(gr + 16 + 4 * fq); const f32x4 bfv = *(const f32x4*)(P.b_forget + l * 4);
#pragma unroll
            for (int m = 0; m < 4; ++m) {
                const int t = row0 + 16 * m + fr, b = t >> 12, s = t & 4095;
                float ss = 0.f;
#pragma unroll
                for (int n = 0; n < 2; ++n) ss += acc[m][n][0] * acc[m][n][0] + acc[m][n][1] * acc[m][n][1] + acc[m][n][2] * acc[m][n][2] + acc[m][n][3] * acc[m][n][3];
                ss = quad_sum(ss); const float r = rsqrtf(ss * (1.0f / 32.0f) + EPS);
                float o1[4], o2[4];
#pragma unroll
                for (int j = 0; j < 4; ++j) { const float2 cs = rope[s * 16 + 4 * fq + j]; const float x1 = acc[m][0][j] * r * g1[j], x2 = acc[m][1][j] * r * g2[j]; o1[j] = x1 * cs.x - x2 * cs.y; o2[j] = x1 * cs.y + x2 * cs.x; }
#pragma unroll
                for (int h = 0; h < 4; ++h) { bf16_t* d = km + ((size_t)(b * 4 + h) * SEQ + s) * 96 + 64 + 4 * fq; store4bf(d, o1[0], o1[1], o1[2], o1[3]); store4bf(d + 16, o2[0], o2[1], o2[2], o2[3]); }
                if (fq == 0) {
#pragma unroll
                    for (int j = 0; j < 4; ++j) logf_[(size_t)(b * 4 + j) * SEQ + s] = log_sigmoid(acc[m][2][j] + bfv[j]) * LOG2E;
                }
            }
        } else if (chunk >= 44) {
            bf16_t* G = (bf16_t*)(ob + OOFF_G); const int c0 = (chunk - 44) * 64;
#pragma unroll
            for (int m = 0; m < 4; ++m) { const int t = row0 + 16 * m + fr;
#pragma unroll
                for (int n = 0; n < 4; ++n) { float o[4];
#pragma unroll
                    for (int j = 0; j < 4; ++j) { const float z = acc[m][n][j]; o[j] = z / (1.0f + __expf(-z)); }
                    store4bf(G + (size_t)t * DM + c0 + 16 * n + 4 * fq, o[0], o[1], o[2], o[3]); } }
        }
    }
};

struct EpiUq {
    Params P; int l;
    DEVINL void operator()(f32x4 (&acc)[4][4], int row0, int chunk, int fr, int fq) const {
        const float* cqss = (const float*)(P.ws + OFF_CQSS); bf16_t* qm = (bf16_t*)((char*)P.out + OOFF_QM); const float2* rope = (const float2*)(P.ws + OFF_ROPE);
#pragma unroll
        for (int m = 0; m < 4; ++m) {
            const int t = row0 + 16 * m + fr, b = t >> 12, s = t & 4095; const f32x4 pss = *(const f32x4*)(cqss + (size_t)t * 4);
            const float rt = rsqrtf((pss[0] + pss[1] + pss[2] + pss[3]) * (1.0f / 256.0f) + EPS);
            if (chunk < 4) {
                const float* gain = P.mla_nope_gain + ((size_t)l * 2 + 0) * 64; float ss = 0.f;
#pragma unroll
                for (int n = 0; n < 4; ++n) { acc[m][n] = acc[m][n] * rt; ss += acc[m][n][0] * acc[m][n][0] + acc[m][n][1] * acc[m][n][1] + acc[m][n][2] * acc[m][n][2] + acc[m][n][3] * acc[m][n][3]; }
                ss = quad_sum(ss); const float r = rsqrtf(ss * (1.0f / 64.0f) + EPS) * SC_MLA; bf16_t* d = qm + ((size_t)(b * 4 + chunk) * SEQ + s) * 96 + 4 * fq;
#pragma unroll
                for (int n = 0; n < 4; ++n) { const f32x4 gg = *(const f32x4*)(gain + 16 * n + 4 * fq); store4bf(d + 16 * n, acc[m][n][0] * r * gg[0], acc[m][n][1] * r * gg[1], acc[m][n][2] * r * gg[2], acc[m][n][3] * r * gg[3]); }
            } else {
                const float* gr = P.mla_rope_gain + ((size_t)l * 2 + 0) * 32; const f32x4 g1 = *(const f32x4*)(gr + 4 * fq), g2 = *(const f32x4*)(gr + 16 + 4 * fq);
#pragma unroll
                for (int hh = 0; hh < 2; ++hh) {
                    const int h = (chunk - 4) * 2 + hh; float ss = 0.f;
#pragma unroll
                    for (int n = 0; n < 2; ++n) { acc[m][2 * hh + n] = acc[m][2 * hh + n] * rt; const f32x4 a = acc[m][2 * hh + n]; ss += a[0] * a[0] + a[1] * a[1] + a[2] * a[2] + a[3] * a[3]; }
                    ss = quad_sum(ss); const float r = rsqrtf(ss * (1.0f / 32.0f) + EPS);
                    float o1[4], o2[4];
#pragma unroll
                    for (int j = 0; j < 4; ++j) { const float2 cs = rope[s * 16 + 4 * fq + j]; const float x1 = acc[m][2 * hh][j] * r * g1[j], x2 = acc[m][2 * hh + 1][j] * r * g2[j];
                        o1[j] = (x1 * cs.x - x2 * cs.y) * SC_MLA; o2[j] = (x1 * cs.y + x2 * cs.x) * SC_MLA; }
                    bf16_t* d = qm + ((size_t)(b * 4 + h) * SEQ + s) * 96 + 64 + 4 * fq; store4bf(d, o1[0], o1[1], o1[2], o1[3]); store4bf(d + 16, o2[0], o2[1], o2[2], o2[3]);
                }
            }
        }
    }
};
struct EpiUkv {
    Params P; int l;
    DEVINL void operator()(f32x4 (&acc)[4][4], int row0, int chunk, int fr, int fq) const {
        const float* ckvss = (const float*)(P.ws + OFF_CKVSS); bf16_t* km = (bf16_t*)((char*)P.out + OOFF_KM); bf16_t* vm = (bf16_t*)((char*)P.out + OOFF_VM);
        const int h = chunk >> 1; const bool isk = (chunk & 1) == 0; const float* gain = P.mla_nope_gain + ((size_t)l * 2 + 1) * 64;
#pragma unroll
        for (int m = 0; m < 4; ++m) {
            const int t = row0 + 16 * m + fr, b = t >> 12, s = t & 4095; const float rt = rsqrtf((ckvss[(size_t)t * 2] + ckvss[(size_t)t * 2 + 1]) * (1.0f / 128.0f) + EPS);
            float ss = 0.f;
#pragma unroll
            for (int n = 0; n < 4; ++n) { acc[m][n] = acc[m][n] * rt; ss += acc[m][n][0] * acc[m][n][0] + acc[m][n][1] * acc[m][n][1] + acc[m][n][2] * acc[m][n][2] + acc[m][n][3] * acc[m][n][3]; }
            if (isk) { ss = quad_sum(ss); const float r = rsqrtf(ss * (1.0f / 64.0f) + EPS); bf16_t* d = km + ((size_t)(b * 4 + h) * SEQ + s) * 96 + 4 * fq;
#pragma unroll
                for (int n = 0; n < 4; ++n) { const f32x4 gg = *(const f32x4*)(gain + 16 * n + 4 * fq); store4bf(d + 16 * n, acc[m][n][0] * r * gg[0], acc[m][n][1] * r * gg[1], acc[m][n][2] * r * gg[2], acc[m][n][3] * r * gg[3]); }
            } else { bf16_t* d = vm + ((size_t)(b * 4 + h) * SEQ + s) * 64 + 4 * fq;
#pragma unroll
                for (int n = 0; n < 4; ++n) store4bf(d + 16 * n, acc[m][n][0], acc[m][n][1], acc[m][n][2], acc[m][n][3]); }
        }
    }
};
struct EpiResid { const float* base; float* out;
    DEVINL void operator()(f32x4 (&acc)[4][4], int row0, int chunk, int fr, int fq) const {
#pragma unroll
        for (int m = 0; m < 4; ++m) { const size_t o = (size_t)(row0 + 16 * m + fr) * DM + chunk * 64 + 4 * fq;
#pragma unroll
            for (int n = 0; n < 4; ++n) { const f32x4 bv = *(const f32x4*)(base + o + 16 * n); *(f32x4*)(out + o + 16 * n) = bv + acc[m][n]; } } } };
struct EpiStore { float* out;
    DEVINL void operator()(f32x4 (&acc)[4][4], int row0, int chunk, int fr, int fq) const {
#pragma unroll
        for (int m = 0; m < 4; ++m) { const size_t o = (size_t)(row0 + 16 * m + fr) * DM + chunk * 64 + 4 * fq;
#pragma unroll
            for (int n = 0; n < 4; ++n) *(f32x4*)(out + o + 16 * n) = acc[m][n]; } } };
struct EpiPle { const float* xa; const float* pp; float* out;
    DEVINL void operator()(f32x4 (&acc)[4][4], int row0, int chunk, int fr, int fq) const {
#pragma unroll
        for (int m = 0; m < 4; ++m) { const size_t o = (size_t)(row0 + 16 * m + fr) * DM + chunk * 64 + 4 * fq;
#pragma unroll
            for (int n = 0; n < 4; ++n) { const f32x4 xv = *(const f32x4*)(xa + o + 16 * n), pv = *(const f32x4*)(pp + o + 16 * n); f32x4 r;
#pragma unroll
                for (int j = 0; j < 4; ++j) r[j] = xv[j] + pv[j] / (1.0f + __expf(-acc[m][n][j]));
                *(f32x4*)(out + o + 16 * n) = r; } } } };

namespace pg8 {
#define PG8_LAS __attribute__((address_space(3)))
constexpr int BM = 256, BK = 64, HALF = 128, HTB = HALF * BK * 2  , STAGE_BYTES = 8 * HTB, NXCD = 8, WGM = 8;

__host__ __device__ __forceinline__ int lds_byte(int r, int c) { const int st = (r >> 4) * 2 + (c >> 5), rr = r & 15, cc = c & 31, ob = rr * 64 + cc * 2; return st * 1024 + (ob ^ (((ob >> 9) & 1) << 5)); }
__host__ __device__ __forceinline__ void stage_rc(int b, int& R, int& C) { const int st = b / 1024, sb = b % 1024, swz = sb ^ (((sb >> 9) & 1) << 5); R = (st >> 1) * 16 + swz / 64; C = (st & 1) * 32 + (swz % 64) / 2; }
__host__ __device__ __forceinline__ int perm32(int rho) { const int n = rho >> 4, i = rho & 15; return 8 * (i >> 2) + 4 * n + (i & 3); }

struct Unit { int pm, pn; };
struct Gemm { const bf16_t* A; const bf16_t* Bt; int M, N, K; };

struct StaticOrder {
    int nM, nN, nwg, G, c;
    __host__ __device__ void init(int M, int N, int G_, int c_) { nM = M / BM; nN = N / BM; nwg = nM * nN; G = G_; c = c_; }
    __host__ __device__ bool next(int i, Unit& u) const {
        const long L = (long)i * G + c; if (L >= nwg) return false;
        int wgid = (int)L; { const int q = nwg / NXCD, r = nwg % NXCD, xcd = wgid % NXCD, off = wgid / NXCD; wgid = (xcd < r ? xcd * (q + 1) : r * (q + 1) + (xcd - r) * q) + off; }
        const int nig = WGM * nN, gid = wgid / nig, fm = gid * WGM, gsz = (nM - fm) < WGM ? (nM - fm) : WGM;
        u.pm = fm + ((wgid % nig) % gsz); u.pn = (wgid % nig) / gsz; return true;
    }
    __device__ __forceinline__ void a_ready(const Unit&) const {}
    __device__ __forceinline__ void done(const Unit&) const {}
};

template <class Epi, class Sched, bool ALIGN_EPI = false, bool SP2 = false>
__device__ __forceinline__ void gemm_phase(PG8_LAS unsigned char* lds, const Gemm g, const Sched& S, const Epi& E) {
    const int tid = ltid(), wid = __builtin_amdgcn_readfirstlane(tid >> 6), lane = tid & 63, wr = wid >> 2, wc = wid & 3, fr = lane & 15, fq = lane >> 4;
    const int K = g.K, nt = K / BK;
    unsigned voffA[2], voffB[2];
#pragma unroll
    for (int i = 0; i < 2; ++i) { int R, C; stage_rc(tid * 16 + i * 8192, R, C); const int Rb = Epi::PERM ? ((R & ~31) + perm32(R & 31)) : R;
        voffA[i] = (unsigned)(R * K + C) * 2u; voffB[i] = (unsigned)(Rb * K + C) * 2u; }
    const size_t kstep = (size_t)(BK * 2);
    const size_t hstep = (size_t)HALF * K * 2;
    const size_t tstep = 2 * hstep;
    const unsigned ldsw = (unsigned)wid * 1024u;
    const int aoff = lds_byte(wr * 64 + fr, fq * 8), boff = lds_byte(wc * 32 + fr, fq * 8);
    PG8_LAS unsigned char* ldsA = lds + aoff; PG8_LAS unsigned char* ldsB = lds + 65536 + boff; asm volatile("" : "+v"(ldsA), "+v"(ldsB));
#define PG8_SA(b, h) (((b) * 2 + (h)) * HTB)
#define PG8_SB(b, h) ((4 + (b) * 2 + (h)) * HTB)
#define PG8_STAGE(bufoff, gbase, voff) do { _Pragma("unroll") for (int _i = 0; _i < 2; ++_i) \
        __builtin_amdgcn_global_load_lds((const unsigned*)((const char*)(gbase) + (voff)[_i]), (PG8_LAS unsigned*)(lds + (bufoff) + ldsw + _i * 8192), 16, 0, 0); } while (0)
#define PG8_LDA(dst, b, h) do { _Pragma("unroll") for (int m = 0; m < 4; ++m) _Pragma("unroll") for (int k = 0; k < 2; ++k) dst[m][k] = *(const PG8_LAS bf16x8*)(ldsA + PG8_SA(b, h) + m * 2048 + k * 1024); } while (0)
#define PG8_LDB(dst, b, h) do { _Pragma("unroll") for (int n = 0; n < 2; ++n) _Pragma("unroll") for (int k = 0; k < 2; ++k) dst[n][k] = *(const PG8_LAS bf16x8*)(ldsB + (PG8_SB(b, h) - 65536) + n * 2048 + k * 1024); } while (0)
#define PG8_MMA(ai, bj, At, Bt) do { __builtin_amdgcn_s_setprio(1); _Pragma("unroll") for (int m = 0; m < 4; ++m) _Pragma("unroll") for (int n = 0; n < 2; ++n) _Pragma("unroll") for (int k = 0; k < 2; ++k) \
        acc[ai][bj][m][n] = __builtin_amdgcn_mfma_f32_16x16x32_bf16(Bt[n][k], At[m][k], acc[ai][bj][m][n], 0, 0, 0); __builtin_amdgcn_s_setprio(0); } while (0)
#define PG8_WAIT_V(n) asm volatile("s_waitcnt vmcnt(" #n ")" ::: "memory")
#define PG8_WAIT_L(n) asm volatile("s_waitcnt lgkmcnt(" #n ")" ::: "memory")
#define PG8_BAR __builtin_amdgcn_s_barrier()
#define PG8_SCHED __builtin_amdgcn_sched_barrier(0)
    Unit cur, nxt; int ui = 0;
    if (!S.next(0, cur)) return;
    f32x4 acc[2][2][4][2];
#pragma unroll
    for (int a = 0; a < 2; ++a)
#pragma unroll
        for (int b = 0; b < 2; ++b)
#pragma unroll
            for (int m = 0; m < 4; ++m)
#pragma unroll
                for (int n = 0; n < 2; ++n) acc[a][b][m][n] = (f32x4){0.f, 0.f, 0.f, 0.f};
    bf16x8 At[4][2], B0[2][2], B1[2][2];
    const char* cA = (const char*)g.A + (size_t)cur.pm * tstep; const char* cB = (const char*)g.Bt + (size_t)cur.pn * tstep;
    S.a_ready(cur);
    if constexpr (SP2) {
        PG8_STAGE(PG8_SB(0, 0), cB, voffB); PG8_STAGE(PG8_SB(0, 1), cB + hstep, voffB); PG8_STAGE(PG8_SA(0, 0), cA, voffA); PG8_STAGE(PG8_SA(0, 1), cA + hstep, voffA);
        if (wr == 1) PG8_BAR;
        PG8_WAIT_V(2); PG8_BAR;
        PG8_STAGE(PG8_SB(1, 0), cB + kstep, voffB); PG8_STAGE(PG8_SA(1, 0), cA + kstep, voffA); PG8_STAGE(PG8_SB(1, 1), cB + hstep + kstep, voffB);
        PG8_WAIT_V(6); PG8_BAR;
    } else {
        PG8_STAGE(PG8_SB(0, 0), cB, voffB); PG8_STAGE(PG8_SA(0, 0), cA, voffA); PG8_STAGE(PG8_SB(0, 1), cB + hstep, voffB); PG8_STAGE(PG8_SA(0, 1), cA + hstep, voffA);
        if (wr == 1) PG8_BAR;
        PG8_WAIT_V(4); PG8_BAR;
        PG8_STAGE(PG8_SB(1, 0), cB + kstep, voffB); PG8_STAGE(PG8_SA(1, 0), cA + kstep, voffA); PG8_STAGE(PG8_SB(1, 1), cB + hstep + kstep, voffB);
        PG8_WAIT_V(6); PG8_BAR;
    }
    for (;;) {
        const bool has_next = S.next(ui + 1, nxt);
        const char* nA = has_next ? (const char*)g.A + (size_t)nxt.pm * tstep : cA; const char* nB = has_next ? (const char*)g.Bt + (size_t)nxt.pn * tstep : cB;
        for (int t = 0; t < nt; t += 2) {
            const bool last = (t == nt - 2);
            const char* a1 = cA + (size_t)(t + 1) * kstep;
            const char* a2 = last ? nA : cA + (size_t)(t + 2) * kstep; const char* b2 = last ? nB : cB + (size_t)(t + 2) * kstep;
            const char* a3 = a2 + kstep; const char* b3 = b2 + kstep;
            if (last && has_next) S.a_ready(nxt);
            if constexpr (SP2) {
            PG8_LDB(B0, 0, 0); PG8_LDB(B1, 0, 1); PG8_SCHED; PG8_LDA(At, 0, 0); PG8_STAGE(PG8_SA(1, 1), a1 + hstep, voffA);
            PG8_WAIT_V(8); PG8_WAIT_L(0); PG8_BAR; PG8_MMA(0, 0, At, B0); PG8_MMA(0, 1, At, B1); PG8_BAR; PG8_SCHED;
            PG8_LDA(At, 0, 1); PG8_STAGE(PG8_SB(0, 0), b2, voffB); PG8_STAGE(PG8_SB(0, 1), b2 + hstep, voffB); PG8_STAGE(PG8_SA(0, 0), a2, voffA);
            PG8_WAIT_V(8); PG8_WAIT_L(0); PG8_BAR; PG8_MMA(1, 0, At, B0); PG8_MMA(1, 1, At, B1); PG8_BAR; PG8_SCHED;
            PG8_LDB(B0, 1, 0); PG8_LDB(B1, 1, 1); PG8_SCHED; PG8_LDA(At, 1, 0); PG8_STAGE(PG8_SA(0, 1), a2 + hstep, voffA);
            PG8_WAIT_V(8); PG8_WAIT_L(0); PG8_BAR; PG8_MMA(0, 0, At, B0); PG8_MMA(0, 1, At, B1); PG8_BAR; PG8_SCHED;
            PG8_LDA(At, 1, 1); PG8_STAGE(PG8_SB(1, 0), b3, voffB); PG8_STAGE(PG8_SB(1, 1), b3 + hstep, voffB); PG8_STAGE(PG8_SA(1, 0), a3, voffA);
            PG8_WAIT_V(8); PG8_WAIT_L(0); PG8_BAR; PG8_MMA(1, 0, At, B0); PG8_MMA(1, 1, At, B1); PG8_BAR; PG8_SCHED;
            } else {
            PG8_LDB(B0, 0, 0); PG8_SCHED; PG8_LDA(At, 0, 0); PG8_STAGE(PG8_SA(1, 1), a1 + hstep, voffA);
            PG8_WAIT_L(8); PG8_BAR; PG8_WAIT_L(0); PG8_MMA(0, 0, At, B0); PG8_BAR; PG8_SCHED;
            PG8_LDB(B1, 0, 1); PG8_STAGE(PG8_SB(0, 0), b2, voffB);
            PG8_BAR; PG8_WAIT_L(0); PG8_MMA(0, 1, At, B1); PG8_BAR;
            PG8_LDA(At, 0, 1); PG8_STAGE(PG8_SA(0, 0), a2, voffA);
            PG8_BAR; PG8_WAIT_L(0); PG8_MMA(1, 0, At, B0); PG8_BAR; PG8_SCHED;
            PG8_STAGE(PG8_SB(0, 1), b2 + hstep, voffB);
            PG8_WAIT_V(6); PG8_BAR; PG8_MMA(1, 1, At, B1); PG8_BAR;
            PG8_LDB(B0, 1, 0); PG8_SCHED; PG8_LDA(At, 1, 0); PG8_STAGE(PG8_SA(0, 1), a2 + hstep, voffA);
            PG8_WAIT_L(8); PG8_BAR; PG8_WAIT_L(0); PG8_MMA(0, 0, At, B0); PG8_BAR; PG8_SCHED;
            PG8_LDB(B1, 1, 1); PG8_STAGE(PG8_SB(1, 0), b3, voffB);
            PG8_BAR; PG8_WAIT_L(0); PG8_MMA(0, 1, At, B1); PG8_BAR;
            PG8_LDA(At, 1, 1); PG8_STAGE(PG8_SA(1, 0), a3, voffA);
            PG8_BAR; PG8_WAIT_L(0); PG8_MMA(1, 0, At, B0); PG8_BAR; PG8_SCHED;
            PG8_STAGE(PG8_SB(1, 1), b3 + hstep, voffB);
            PG8_WAIT_V(6); PG8_BAR; PG8_MMA(1, 1, At, B1); PG8_BAR;
            }
        }
        if constexpr (ALIGN_EPI) { if (wr == 0) PG8_BAR; }
        if constexpr (!Epi::AFTER_DRAIN) { E(acc, cur, wr, wc, fr, fq); S.done(cur); }
        if (!has_next) break;
#pragma unroll
        for (int a = 0; a < 2; ++a)
#pragma unroll
            for (int b = 0; b < 2; ++b)
#pragma unroll
                for (int m = 0; m < 4; ++m)
#pragma unroll
                    for (int n = 0; n < 2; ++n) acc[a][b][m][n] = (f32x4){0.f, 0.f, 0.f, 0.f};
        cur = nxt; cA = nA; cB = nB; ++ui;
        if constexpr (ALIGN_EPI) { if (wr == 1) PG8_BAR; }
    }
    PG8_WAIT_V(0);
    if constexpr (!ALIGN_EPI) { if (wr == 0) PG8_BAR; }
    PG8_BAR;
    if constexpr (Epi::AFTER_DRAIN) { E.fused(acc, cur, wr, wc, fr, fq, lds, wid, lane); S.done(cur); }
#undef PG8_SA
#undef PG8_SB
#undef PG8_STAGE
#undef PG8_LDA
#undef PG8_LDB
#undef PG8_MMA
#undef PG8_WAIT_V
#undef PG8_WAIT_L
#undef PG8_BAR
#undef PG8_SCHED
}
}


DEVINL u32x4 pack8(const f32x4& a, const f32x4& b) { u32x4 w; w.x = cvt2(a[0], a[1]); w.y = cvt2(a[2], a[3]); w.z = cvt2(b[0], b[1]); w.w = cvt2(b[2], b[3]); return w; }
DEVINL float row_rscale(const float* ssq, int t, int fq) { const f32x4 a = *(const f32x4*)(ssq + (size_t)t * 16 + 4 * fq); return rsqrtf(quad_sum(a[0] + a[1] + a[2] + a[3]) * (1.0f / DM) + EPS); }
struct EpiIn8 {
    static constexpr bool PERM = true, AFTER_DRAIN = false;
    Params P; int l;
    DEVINL void operator()(const f32x4 (&acc0)[2][2][4][2], const pg8::Unit& u, int wr, int wc, int fr, int fq) const {
        { const int t_ = ltid(); fr = t_ & 15; fq = (t_ >> 4) & 3; wc = __builtin_amdgcn_readfirstlane((t_ >> 6) & 3); wr = __builtin_amdgcn_readfirstlane(t_ >> 8); }
        char* ws = P.ws; char* ob = (char*)P.out; const int chunk = u.pn * 4 + wc;
        const float* ssqx = (const float*)(ws + OFF_SSQX);
        if (chunk < 36) {
            const int g = chunk >> 2, h = chunk & 3, role = g % 3, mix = g / 3;
            bf16_t* dst = (bf16_t*)(ws + OFF_QKV + (size_t)g * SZ_HEADBUF);
            const float* gain = P.qk_gain + ((size_t)l * 6 + 2 * mix + (role == 1 ? 1 : 0)) * 64 + 8 * fq;
            f32x4 gg[2][2];
#pragma unroll
            for (int bj = 0; bj < 2; ++bj)
#pragma unroll
                for (int n = 0; n < 2; ++n) gg[bj][n] = role != 2 ? *(const f32x4*)(gain + 32 * bj + 4 * n) : (f32x4){1.f, 1.f, 1.f, 1.f};
#pragma unroll
            for (int ai = 0; ai < 2; ++ai)
#pragma unroll
                for (int m = 0; m < 4; ++m) {
                    const int t = u.pm * 256 + 128 * ai + 64 * wr + 16 * m + fr, b = t >> 12, s = t & 4095; const float rt_ = row_rscale(ssqx, t, fq); const f32x4 a[2][2] = {{acc0[ai][0][m][0] * rt_, acc0[ai][0][m][1] * rt_}, {acc0[ai][1][m][0] * rt_, acc0[ai][1][m][1] * rt_}}; bf16_t* d = dst + ((size_t)(b * 4 + h) * SEQ + s) * 64 + 8 * fq;
                    float r = 1.f;
                    if (role != 2) { float ss = sq4(a[0][0]) + sq4(a[0][1]) + sq4(a[1][0]) + sq4(a[1][1]); ss = quad_sum(ss); r = rsqrtf(ss * (1.0f / 64.0f) + EPS) * (role == 0 ? SC_Q : 1.0f); }
#pragma unroll
                    for (int bj = 0; bj < 2; ++bj) *(u32x4*)(d + 32 * bj) = pack8(a[bj][0] * r * gg[bj][0], a[bj][1] * r * gg[bj][1]);
                }
        } else if (chunk < 42) {
            const bool isq = chunk < 40; const int c = isq ? chunk - 36 : chunk - 40;
            bf16_t* dst = isq ? (bf16_t*)(ws + OFF_CQ) : (bf16_t*)(ws + OFF_CKV); const int ld = 256;
            float* ssp = isq ? (float*)(ws + OFF_CQSS) : (float*)(ws + OFF_CKVSS); const int nss = isq ? 4 : 2;
#pragma unroll
            for (int ai = 0; ai < 2; ++ai)
#pragma unroll
                for (int m = 0; m < 4; ++m) {
                    const int t = u.pm * 256 + 128 * ai + 64 * wr + 16 * m + fr; const float rt_ = row_rscale(ssqx, t, fq); const f32x4 a[2][2] = {{acc0[ai][0][m][0] * rt_, acc0[ai][0][m][1] * rt_}, {acc0[ai][1][m][0] * rt_, acc0[ai][1][m][1] * rt_}};
                    float ss = sq4(a[0][0]) + sq4(a[0][1]) + sq4(a[1][0]) + sq4(a[1][1]); ss = quad_sum(ss);
#pragma unroll
                    for (int bj = 0; bj < 2; ++bj) *(u32x4*)(dst + (size_t)t * ld + c * 64 + 32 * bj + 8 * fq) = pack8(a[bj][0], a[bj][1]);
                    if (fq == 0) ssp[(size_t)t * nss + c] = ss;
                }
        } else if (chunk == 42) {
            const float* gr = P.mla_rope_gain + ((size_t)l * 2 + 1) * 32; const float2* rope = (const float2*)(ws + OFF_ROPE);
            bf16_t* km = (bf16_t*)(ob + OOFF_KM); float* logf_ = (float*)(ws + OFF_LOGF);
            const f32x4 g1 = *(const f32x4*)(gr + 4 * fq), g2 = *(const f32x4*)(gr + 16 + 4 * fq); const f32x4 bfv = *(const f32x4*)(P.b_forget + l * 4);
#pragma unroll
            for (int ai = 0; ai < 2; ++ai)
#pragma unroll
                for (int m = 0; m < 4; ++m) {
                    const int t = u.pm * 256 + 128 * ai + 64 * wr + 16 * m + fr, b = t >> 12, s = t & 4095; const float rt_ = row_rscale(ssqx, t, fq); const f32x4 a[2][2] = {{acc0[ai][0][m][0] * rt_, acc0[ai][0][m][1] * rt_}, {acc0[ai][1][m][0] * rt_, acc0[ai][1][m][1] * rt_}};
                    float ss = sq4(a[0][0]) + sq4(a[0][1]); ss = quad_sum(ss); const float r = rsqrtf(ss * (1.0f / 32.0f) + EPS);
                    float o1[4], o2[4];
#pragma unroll
                    for (int j = 0; j < 4; ++j) { const float2 cs = rope[s * 16 + 4 * fq + j]; const float x1 = a[0][0][j] * r * g1[j], x2 = a[0][1][j] * r * g2[j]; o1[j] = x1 * cs.x - x2 * cs.y; o2[j] = x1 * cs.y + x2 * cs.x; }
#pragma unroll
                    for (int h = 0; h < 4; ++h) { bf16_t* d = km + ((size_t)(b * 4 + h) * SEQ + s) * 96 + 64 + 4 * fq; store4bf(d, o1[0], o1[1], o1[2], o1[3]); store4bf(d + 16, o2[0], o2[1], o2[2], o2[3]); }
                    if (fq == 0) {
#pragma unroll
                        for (int j = 0; j < 4; ++j) logf_[(size_t)(b * 4 + j) * SEQ + s] = log_sigmoid(a[1][0][j] + bfv[j]) * LOG2E;
                    }
                }
        } else if (chunk >= 44) {
            bf16_t* G = (bf16_t*)(ob + OOFF_G); const int c0 = (chunk - 44) * 64 + 8 * fq;
#pragma unroll
            for (int ai = 0; ai < 2; ++ai)
#pragma unroll
                for (int m = 0; m < 4; ++m) {
                    const int t = u.pm * 256 + 128 * ai + 64 * wr + 16 * m + fr; const float rt_ = row_rscale(ssqx, t, fq); const f32x4 a[2][2] = {{acc0[ai][0][m][0] * rt_, acc0[ai][0][m][1] * rt_}, {acc0[ai][1][m][0] * rt_, acc0[ai][1][m][1] * rt_}};
#pragma unroll
                    for (int bj = 0; bj < 2; ++bj) { f32x4 o0, o1;
#pragma unroll
                        for (int j = 0; j < 4; ++j) { const float z0 = a[bj][0][j], z1 = a[bj][1][j]; o0[j] = z0 * fsigmoid(z0); o1[j] = z1 * fsigmoid(z1); }
                        *(u32x4*)(G + (size_t)t * DM + c0 + 32 * bj) = pack8(o0, o1); }
                }
        }
    }
};
struct EpiResid8 { static constexpr bool PERM = true, AFTER_DRAIN = false; const float* base; float* out; bf16_t* obf; float* ssq;
    DEVINL void operator()(const f32x4 (&acc)[2][2][4][2], const pg8::Unit& u, int wr, int wc, int fr, int fq) const {
        { const int t_ = ltid(); fr = t_ & 15; fq = (t_ >> 4) & 3; wc = __builtin_amdgcn_readfirstlane((t_ >> 6) & 3); wr = __builtin_amdgcn_readfirstlane(t_ >> 8); }
#pragma unroll
        for (int ai = 0; ai < 2; ++ai)
#pragma unroll
            for (int m = 0; m < 4; ++m) { const int t = u.pm * 256 + 128 * ai + 64 * wr + 16 * m + fr; const size_t o = (size_t)t * DM + u.pn * 256 + 64 * wc + 8 * fq; float ss = 0.f;
#pragma unroll
                for (int bj = 0; bj < 2; ++bj) { const f32x4 v0 = __builtin_nontemporal_load((const f32x4*)(base + o + 32 * bj)) + acc[ai][bj][m][0], v1 = __builtin_nontemporal_load((const f32x4*)(base + o + 32 * bj + 4)) + acc[ai][bj][m][1];
                    *(f32x4*)(out + o + 32 * bj) = v0; *(f32x4*)(out + o + 32 * bj + 4) = v1; *(u32x4*)(obf + o + 32 * bj) = pack8(v0, v1); ss += sq4(v0) + sq4(v1); }
                ss = quad_sum(ss); if (fq == 0) ssq[(size_t)t * 16 + u.pn * 4 + wc] = ss; } } };
struct EpiStoreBf { static constexpr bool PERM = true, AFTER_DRAIN = false; bf16_t* out;
    DEVINL void operator()(const f32x4 (&acc)[2][2][4][2], const pg8::Unit& u, int wr, int wc, int fr, int fq) const {
        { const int t_ = ltid(); fr = t_ & 15; fq = (t_ >> 4) & 3; wc = __builtin_amdgcn_readfirstlane((t_ >> 6) & 3); wr = __builtin_amdgcn_readfirstlane(t_ >> 8); }
#pragma unroll
        for (int ai = 0; ai < 2; ++ai)
#pragma unroll
            for (int m = 0; m < 4; ++m) { const size_t o = (size_t)(u.pm * 256 + 128 * ai + 64 * wr + 16 * m + fr) * DM + u.pn * 256 + 64 * wc + 8 * fq;
#pragma unroll
                for (int bj = 0; bj < 2; ++bj) *(u32x4*)(out + o + 32 * bj) = pack8(acc[ai][bj][m][0], acc[ai][bj][m][1]); } } };
struct EpiPle8 { static constexpr bool PERM = true, AFTER_DRAIN = false; const float* xa; const bf16_t* pp; float* out; const float* ssq_in; bf16_t* obf; float* ssq_out;
    DEVINL void operator()(const f32x4 (&acc)[2][2][4][2], const pg8::Unit& u, int wr, int wc, int fr, int fq) const {
        { const int t_ = ltid(); fr = t_ & 15; fq = (t_ >> 4) & 3; wc = __builtin_amdgcn_readfirstlane((t_ >> 6) & 3); wr = __builtin_amdgcn_readfirstlane(t_ >> 8); }
#pragma unroll
        for (int ai = 0; ai < 2; ++ai)
#pragma unroll
            for (int m = 0; m < 4; ++m) { const int t = u.pm * 256 + 128 * ai + 64 * wr + 16 * m + fr; const size_t o = (size_t)t * DM + u.pn * 256 + 64 * wc + 8 * fq;
                const float rt = row_rscale(ssq_in, t, fq); float ss = 0.f;
#pragma unroll
                for (int bj = 0; bj < 2; ++bj) { const f32x4 x0 = *(const f32x4*)(xa + o + 32 * bj), x1 = *(const f32x4*)(xa + o + 32 * bj + 4); const u32x4 pw = *(const u32x4*)(pp + o + 32 * bj); f32x4 r0, r1;
                    const float pv[8] = {bflo(pw.x), bfhi(pw.x), bflo(pw.y), bfhi(pw.y), bflo(pw.z), bfhi(pw.z), bflo(pw.w), bfhi(pw.w)};
#pragma unroll
                    for (int jj = 0; jj < 4; ++jj) { r0[jj] = x0[jj] + pv[jj] * fsigmoid(rt * acc[ai][bj][m][0][jj]); r1[jj] = x1[jj] + pv[4 + jj] * fsigmoid(rt * acc[ai][bj][m][1][jj]); }
                    __builtin_nontemporal_store(r0, (f32x4*)(out + o + 32 * bj)); __builtin_nontemporal_store(r1, (f32x4*)(out + o + 32 * bj + 4));
                    if (obf) { *(u32x4*)(obf + o + 32 * bj) = pack8(r0, r1); ss += sq4(r0) + sq4(r1); } }
                if (obf) { ss = quad_sum(ss); if (fq == 0) ssq_out[(size_t)t * 16 + u.pn * 4 + wc] = ss; } } } };
struct EpiUq8 { static constexpr bool PERM = true, AFTER_DRAIN = false; Params P; int l;
    DEVINL void operator()(const f32x4 (&acc)[2][2][4][2], const pg8::Unit& u, int wr, int wc, int fr, int fq) const {
        { const int t_ = ltid(); fr = t_ & 15; fq = (t_ >> 4) & 3; wc = __builtin_amdgcn_readfirstlane((t_ >> 6) & 3); wr = __builtin_amdgcn_readfirstlane(t_ >> 8); }
        const int chunk = u.pn * 4 + wc; if (chunk >= 6) return;
        const float* cqss = (const float*)(P.ws + OFF_CQSS); bf16_t* qm = (bf16_t*)((char*)P.out + OOFF_QM); const float2* rope = (const float2*)(P.ws + OFF_ROPE);
#pragma unroll
        for (int ai = 0; ai < 2; ++ai)
#pragma unroll
            for (int m = 0; m < 4; ++m) {
                const int t = u.pm * 256 + 128 * ai + 64 * wr + 16 * m + fr, b = t >> 12, s = t & 4095;
                const float rt = rsqrtf(quad_sum(cqss[(size_t)t * 4 + fq]) * (1.0f / 256.0f) + EPS);
                const f32x4 a[2][2] = {{acc[ai][0][m][0] * rt, acc[ai][0][m][1] * rt}, {acc[ai][1][m][0] * rt, acc[ai][1][m][1] * rt}};
                if (chunk < 4) {
                    const float* gain = P.mla_nope_gain + ((size_t)l * 2 + 0) * 64 + 8 * fq;
                    float ss = sq4(a[0][0]) + sq4(a[0][1]) + sq4(a[1][0]) + sq4(a[1][1]); ss = quad_sum(ss); const float r = rsqrtf(ss * (1.0f / 64.0f) + EPS) * SC_MLA;
                    bf16_t* d = qm + ((size_t)(b * 4 + chunk) * SEQ + s) * 96 + 8 * fq;
#pragma unroll
                    for (int bj = 0; bj < 2; ++bj) { const f32x4 g0 = *(const f32x4*)(gain + 32 * bj), g1 = *(const f32x4*)(gain + 32 * bj + 4); *(u32x4*)(d + 32 * bj) = pack8(a[bj][0] * r * g0, a[bj][1] * r * g1); }
                } else {
                    const float* gr = P.mla_rope_gain + ((size_t)l * 2 + 0) * 32; const f32x4 g1 = *(const f32x4*)(gr + 4 * fq), g2 = *(const f32x4*)(gr + 16 + 4 * fq);
#pragma unroll
                    for (int bj = 0; bj < 2; ++bj) { const int h = (chunk - 4) * 2 + bj;
                        float ss = sq4(a[bj][0]) + sq4(a[bj][1]); ss = quad_sum(ss); const float r = rsqrtf(ss * (1.0f / 32.0f) + EPS);
                        float o1[4], o2[4];
#pragma unroll
                        for (int j = 0; j < 4; ++j) { const float2 cs = rope[s * 16 + 4 * fq + j]; const float x1 = a[bj][0][j] * r * g1[j], x2 = a[bj][1][j] * r * g2[j]; o1[j] = (x1 * cs.x - x2 * cs.y) * SC_MLA; o2[j] = (x1 * cs.y + x2 * cs.x) * SC_MLA; }
                        bf16_t* d = qm + ((size_t)(b * 4 + h) * SEQ + s) * 96 + 64 + 4 * fq; store4bf(d, o1[0], o1[1], o1[2], o1[3]); store4bf(d + 16, o2[0], o2[1], o2[2], o2[3]); }
                }
            }
    }
};
struct EpiUkv8 { static constexpr bool PERM = true, AFTER_DRAIN = false; Params P; int l;
    DEVINL void operator()(const f32x4 (&acc)[2][2][4][2], const pg8::Unit& u, int wr, int wc, int fr, int fq) const {
        { const int t_ = ltid(); fr = t_ & 15; fq = (t_ >> 4) & 3; wc = __builtin_amdgcn_readfirstlane((t_ >> 6) & 3); wr = __builtin_amdgcn_readfirstlane(t_ >> 8); }
        const int chunk = u.pn * 4 + wc, h = chunk >> 1; const bool isk = (chunk & 1) == 0;
        const float* ckvss = (const float*)(P.ws + OFF_CKVSS); bf16_t* km = (bf16_t*)((char*)P.out + OOFF_KM); bf16_t* vm = (bf16_t*)((char*)P.out + OOFF_VM);
        const float* gain = P.mla_nope_gain + ((size_t)l * 2 + 1) * 64 + 8 * fq;
#pragma unroll
        for (int ai = 0; ai < 2; ++ai)
#pragma unroll
            for (int m = 0; m < 4; ++m) {
                const int t = u.pm * 256 + 128 * ai + 64 * wr + 16 * m + fr, b = t >> 12, s = t & 4095;
                const float rt = rsqrtf(quad_sum(fq < 2 ? ckvss[(size_t)t * 2 + fq] : 0.f) * (1.0f / 128.0f) + EPS);
                const f32x4 a[2][2] = {{acc[ai][0][m][0] * rt, acc[ai][0][m][1] * rt}, {acc[ai][1][m][0] * rt, acc[ai][1][m][1] * rt}};
                if (isk) { float ss = sq4(a[0][0]) + sq4(a[0][1]) + sq4(a[1][0]) + sq4(a[1][1]); ss = quad_sum(ss); const float r = rsqrtf(ss * (1.0f / 64.0f) + EPS);
                    bf16_t* d = km + ((size_t)(b * 4 + h) * SEQ + s) * 96 + 8 * fq;
#pragma unroll
                    for (int bj = 0; bj < 2; ++bj) { const f32x4 g0 = *(const f32x4*)(gain + 32 * bj), g1 = *(const f32x4*)(gain + 32 * bj + 4); *(u32x4*)(d + 32 * bj) = pack8(a[bj][0] * r * g0, a[bj][1] * r * g1); }
                } else { bf16_t* d = vm + ((size_t)(b * 4 + h) * SEQ + s) * 64 + 8 * fq;
#pragma unroll
                    for (int bj = 0; bj < 2; ++bj) *(u32x4*)(d + 32 * bj) = pack8(a[bj][0], a[bj][1]); }
            }
    }
};
template <class Epi> DEVINL void gemm8(const bf16_t* A, const bf16_t* Bt, int M, int N, int K, const Epi& E, char* smem) {
    int G = (int)gridDim.x, c = (int)blockIdx.x; asm volatile("" : "+s"(G), "+s"(c));
    pg8::Gemm g{A, Bt, M, N, K}; pg8::StaticOrder S; S.init(M, N, G, c);
    pg8::gemm_phase<Epi, pg8::StaticOrder, true, true>((PG8_LAS unsigned char*)smem, g, S, E);
}

DEVINL void kmean_unit(const Params& P, int u, char* smem) {
    float* red = (float*)smem; const bf16_t* K = (const bf16_t*)(P.ws + OFF_QKV + 4 * SZ_HEADBUF); float* km = (float*)(P.ws + OFF_KMEAN);
    const int tid = ltid(), dc = tid & 7, rg = tid >> 3;
    const bf16_t* kp = K + ((size_t)(u >> 4) * SEQ + (u & 15) * 256 + rg) * 64 + dc * 8;
    u32x4 w[4];
#pragma unroll
    for (int i = 0; i < 4; ++i) w[i] = *(const u32x4*)(kp + (size_t)i * 64 * 64);
    float s[8] = {0.f, 0.f, 0.f, 0.f, 0.f, 0.f, 0.f, 0.f};
#pragma unroll
    for (int i = 0; i < 4; ++i) { s[0] += bflo(w[i].x); s[1] += bfhi(w[i].x); s[2] += bflo(w[i].y); s[3] += bfhi(w[i].y); s[4] += bflo(w[i].z); s[5] += bfhi(w[i].z); s[6] += bflo(w[i].w); s[7] += bfhi(w[i].w); }
    __syncthreads();
#pragma unroll
    for (int e = 0; e < 8; ++e) red[rg * 65 + dc * 8 + e] = s[e];
    __syncthreads();
    if (tid < 64) { float a = 0.f;
#pragma unroll 8
        for (int i = 0; i < 64; ++i) a += red[i * 65 + tid];
        km[(size_t)u * 64 + tid] = a * (1.0f / 256.0f); }
}

typedef float f32x16 __attribute__((ext_vector_type(16)));
typedef short s16x4 __attribute__((ext_vector_type(4)));
typedef short v4i16_t __attribute__((ext_vector_type(4)));
#define LAS __attribute__((address_space(3)))
#define MFMA32(a, b, c) __builtin_amdgcn_mfma_f32_32x32x16_bf16(a, b, c, 0, 0, 0)
DEVINL s16x4 vtr(const LAS char* p) { return __builtin_bit_cast(s16x4, __builtin_amdgcn_ds_read_tr16_b64_v4i16((LAS v4i16_t*)p)); }
DEVINL float swap_max(float v) { auto rr = __builtin_amdgcn_permlane32_swap(__float_as_uint(v), __float_as_uint(v), false, false); return fmaxf(__uint_as_float(rr[0]), __uint_as_float(rr[1])); }
DEVINL float swap_sum(float v) { auto rr = __builtin_amdgcn_permlane32_swap(__float_as_uint(v), __float_as_uint(v), false, false); return __uint_as_float(rr[0]) + __uint_as_float(rr[1]); }
DEVINL float fadd1(float a, float b) { float r; asm("v_add_f32 %0, %1, %2" : "=v"(r) : "v"(a), "v"(b)); return r; }
DEVINL constexpr int crow(int r) { return (r & 3) + 8 * (r >> 2); }

constexpr int KSLOT = 64 * 144, RSLOT = 64 * 80;
constexpr int L_KB = 0, L_VB = 3 * KSLOT, L_KR = L_VB + 16384, L_AUX = L_KR + 3 * RSLOT, L_SCR = L_AUX + 16640 + 256, L_KMS = L_SCR + 2048, L_ATT_END = L_KMS + 4096;
constexpr float NEGBIG = -3.0e38f, THR = 8.0f;

template <int MODE>
DEVINL void attn_unit(const Params& P, int l, int u, char* smem) {
    constexpr int DK = MODE == 2 ? 96 : 64, ND0 = DK / 16;
    LAS char* lds = (LAS char*)smem;
    const int tid = ltid(), lane = tid & 63, r32 = lane & 31, hi = lane >> 5; const int wid = __builtin_amdgcn_readfirstlane(tid >> 6);
    const bool fast = ((const float*)(P.ws + OFF_BOUND))[l * 4 + MODE] < 100.0f;
    int bh, q0, t_lo, t_hi, dil = 1, res = 0, pat = 0, qb = 0;
    if (MODE != 3) { bh = u & 15; qb = 15 - (u >> 4); q0 = qb * 256; t_lo = 0; t_hi = (q0 + 255) >> 6; }
    else { pat = u >> 8; const int v = u & 255; bh = v & 15; const int w = v >> 4; dil = pat == 0 ? 1 : (pat == 1 ? 4 : 16); res = w % dil; q0 = (w / dil) * 256; t_lo = (q0 >= 128 ? q0 - 128 : 0) >> 6; t_hi = (q0 + 255) >> 6; }
    const int b = bh >> 2, h = bh & 3;
    const bf16_t *Qg, *Kg, *Vg; int rsq, rsk, rsv;
    if (MODE == 0) { Qg = (const bf16_t*)(P.ws + OFF_QKV) + (size_t)bh * SEQ * 64; Kg = Qg + SZ_HEADBUF / 2; Vg = Kg + SZ_HEADBUF / 2; rsq = rsk = rsv = 64; }
    else if (MODE == 1) { Qg = (const bf16_t*)(P.ws + OFF_QKV + 3 * SZ_HEADBUF) + (size_t)bh * SEQ * 64; Kg = Qg + SZ_HEADBUF / 2; Vg = Kg + SZ_HEADBUF / 2; rsq = rsk = rsv = 64; }
    else if (MODE == 2) { Qg = (const bf16_t*)((const char*)P.out + OOFF_QM) + (size_t)bh * SEQ * 96; Kg = (const bf16_t*)((const char*)P.out + OOFF_KM) + (size_t)bh * SEQ * 96; Vg = (const bf16_t*)((const char*)P.out + OOFF_VM) + (size_t)bh * SEQ * 64; rsq = rsk = 96; rsv = 64; }
    else { Qg = (const bf16_t*)(P.ws + OFF_QKV + 6 * SZ_HEADBUF) + ((size_t)bh * SEQ + res) * 64; Kg = Qg + SZ_HEADBUF / 2; Vg = Kg + SZ_HEADBUF / 2; rsq = rsk = rsv = 64 * dil; }
    const int qw = q0 + 32 * wid;

    __syncthreads();
    const unsigned kgo = (unsigned)((tid >> 3) * rsk + (tid & 7) * 8), vgo = (unsigned)(((tid >> 2) & 63) * rsv + (tid >> 8) * 32 + (tid & 3) * 8), rgo = (unsigned)(((tid >> 2) & 63) * rsk + 64 + (tid & 3) * 8);
    const int kws = (tid >> 3) * 144 + (tid & 7) * 16;
    const int rws = ((tid >> 2) & 63) * 80 + (tid & 3) * 16;
    u32x4 kA, vA, rA, kB, rB;
#define ATT_LOADK(j, K_, R_) do { if ((j) <= t_hi) { K_ = *(const u32x4*)(Kg + (size_t)(j) * 64 * rsk + kgo); if (MODE == 2 && tid < 256) R_ = *(const u32x4*)(Kg + (size_t)(j) * 64 * rsk + rgo); } } while (0)
#define ATT_LOADV(j, V_) do { if ((j) <= t_hi) V_ = *(const u32x4*)(Vg + (size_t)(j) * 64 * rsv + vgo); } while (0)
#define ATT_WRITEK(slot, j, K_, R_) do { if ((j) <= t_hi) { *(LAS u32x4*)(lds + L_KB + (slot) * KSLOT + kws) = K_; if (MODE == 2 && tid < 256) *(LAS u32x4*)(lds + L_KR + (slot) * RSLOT + rws) = R_; \
        if (MODE == 0 && tid < 64) { const float bs = aux[(j) * 64 + tid] - auxU; const unsigned hb = cvt2(bs, 0.f) & 0xffffu; const float lo = bs - __uint_as_float(hb << 16); u32x4 w; w.x = hb | (cvt2(lo, 0.f) << 16); w.y = 0x3F80u; w.z = 0u; w.w = 0u; \
            *(LAS u32x4*)(lds + L_KR + (slot) * 1024 + tid * 16) = w; } } } while (0)
#define ATT_WRITEV(slot, j, V_) do { if ((j) <= t_hi) *(LAS u32x4*)(lds + L_VB + (slot) * 8192 + tid * 16) = V_; } while (0)
    bf16x8 qf[ND0];
    { const bf16_t* qp = Qg + (size_t)(qw + r32) * rsq + 8 * hi;
#pragma unroll
      for (int d0 = 0; d0 < ND0; ++d0) qf[d0] = *(const bf16x8*)(qp + 16 * d0); }
    if (MODE != 0) { ATT_LOADK(t_lo, kA, rA); ATT_LOADV(t_lo, vA); ATT_LOADK(t_lo + 1, kB, rB); }
    LAS float* aux = (LAS float*)(lds + L_AUX);
    if (MODE == 0) {
        LAS float* tot = (LAS float*)(lds + L_SCR);
        const float* lf = (const float*)(P.ws + OFF_LOGF) + (size_t)bh * SEQ + tid * 8; float v[8]; float run = 0.f;
        { const f32x4 a = *(const f32x4*)lf, c = *(const f32x4*)(lf + 4); v[0] = a[0]; v[1] = a[1]; v[2] = a[2]; v[3] = a[3]; v[4] = c[0]; v[5] = c[1]; v[6] = c[2]; v[7] = c[3]; }
#pragma unroll
        for (int i = 0; i < 8; ++i) { run += v[i]; v[i] = run; }
        tot[tid] = run; __syncthreads();
        if (tid < 64) { float a[8]; float acc = 0.f;
#pragma unroll
            for (int i = 0; i < 8; ++i) { acc += tot[tid * 8 + i]; a[i] = acc; }
            float incl = acc;
#pragma unroll
            for (int o = 1; o < 64; o <<= 1) { const float nb = shup(incl, o); if (tid >= o) incl += nb; }
            const float ex = incl - acc; tot[tid * 8] = ex;
#pragma unroll
            for (int i = 1; i < 8; ++i) tot[tid * 8 + i] = ex + a[i - 1]; }
        __syncthreads();
        const float base = tot[tid];
#pragma unroll
        for (int i = 0; i < 8; ++i) aux[tid * 8 + i] = -(base + v[i]);
        if (tid < 4) ((LAS unsigned*)(lds + L_KR + 3072))[tid] = 0u;
    } else if (MODE == 1) {
        const float* lut = (const float*)(P.ws + OFF_LUT) + (size_t)h * 4096;
        for (int i = ((4095 - (q0 + 255)) & ~3) + 4 * tid; i < 4160; i += 4 * NTHREADS) {
            f32x4 v = (f32x4){0.f, 0.f, 0.f, 0.f}; if (i < 4096) { const f32x4 s = *(const f32x4*)(lut + 4092 - i); v = (f32x4){s[3], s[2], s[1], s[0]}; }
            *(LAS f32x4*)(aux + i) = v; }
        if (tid < 64) aux[4160 + tid] = -INFINITY;
        LAS float* kms = (LAS float*)(lds + L_KMS); const float* km = (const float*)(P.ws + OFF_KMEAN) + (size_t)bh * 1024;
        for (int i = tid; i < 1024; i += NTHREADS) kms[i] = km[i];
    } else if (MODE == 3) {
        const float* lut = (const float*)(P.ws + OFF_LUT) + (size_t)(4 + h) * 4096;
        if (tid < 320) { const int rel = 255 - tid; aux[tid] = (rel >= 0 && rel * dil < 4096) ? lut[rel * dil] : 0.f; }
    }
    if (MODE == 0 && fast) {
        __syncthreads();
        const float bnd = ((const float*)(P.ws + OFF_BOUND))[l * 4 + (tid >> 30)];
        const bool sk = (lane <= t_hi) && ((aux[64 * lane + 63] - aux[q0]) + bnd < -150.0f);
        t_lo = (int)__builtin_popcountll(__ballot(sk));
    }
    __syncthreads();
    bf16x8 qx = {0, 0, 0, 0, 0, 0, 0, 0}; float auxU = 0.f;
    if (MODE == 0) { auxU = aux[q0 + 255]; const float sh = auxU - aux[qw + r32];
        if (hi == 0) { u32x4 w; w.x = 0x3F803F80u; w.y = cvt2(sh, 0.f); w.z = 0u; w.w = 0u; qx = __builtin_bit_cast(bf16x8, w); } }
    unsigned sel = 0;
    if (MODE == 1) {
        const LAS float* kms = (const LAS float*)(lds + L_KMS); float gt[15];
#pragma unroll
        for (int n = 0; n < 15; ++n) { float s = 0.f;
            if (n < qb) {
#pragma unroll
                for (int d0 = 0; d0 < 4; ++d0) { const f32x4 ka = *(const LAS f32x4*)(kms + n * 64 + 16 * d0 + 8 * hi), kb = *(const LAS f32x4*)(kms + n * 64 + 16 * d0 + 8 * hi + 4);
                    const u32x4 w = __builtin_bit_cast(u32x4, qf[d0]);
                    s += bflo(w.x) * ka[0] + bfhi(w.x) * ka[1] + bflo(w.y) * ka[2] + bfhi(w.y) * ka[3] + bflo(w.z) * kb[0] + bfhi(w.z) * kb[1] + bflo(w.w) * kb[2] + bfhi(w.w) * kb[3]; }
                s = swap_sum(s); }
            gt[n] = s; }
#pragma unroll
        for (int k = 0; k < 3; ++k) { float best = NEGBIG; int bi = -1;
#pragma unroll
            for (int n = 0; n < 15; ++n) if (n < qb && !((sel >> n) & 1u) && gt[n] > best) { best = gt[n]; bi = n; }
            if (bi >= 0) sel |= 1u << bi; }
        sel |= 1u << qb;
    }
    const int kfo = L_KB + r32 * 144 + hi * 16, rfo = L_KR + r32 * 80 + hi * 16;
    const int vfo = L_VB + ((lane >> 4) & 1) * 32 + (lane & 3) * 8 + (4 * hi + ((lane & 15) >> 2)) * 64;

    f32x16 o0, o1;
#pragma unroll
    for (int r = 0; r < 16; ++r) { o0[r] = 0.f; o1[r] = 0.f; }
    float m = fast ? 0.f : NEGBIG, lsum = 0.f;

    auto anysel = [&](int j) -> bool { return MODE != 1 || __any((sel >> (j >> 2)) & 1u); };
    auto is_full = [&](int j) -> bool {
        bool f = fast && (64 * j + 63 <= qw) && anysel(j);
        if (MODE == 3) f = f && (64 * j >= qw + 31 - 128);
        return f; };
    auto stage_a = [&](int j, int ks, int kb, f32x16& p) {
        if (MODE == 1 || MODE == 3) { const LAS float* lp = aux + ((MODE == 1 ? 4095 : 255) - (qw + r32 - 64 * j - 4 * hi));
            if (MODE == 1) lp = ((sel >> (j >> 2)) & 1u) ? lp : aux + 4160;
#pragma unroll
            for (int r = 0; r < 16; ++r) p[r] = lp[crow(r) + 32 * kb];
        } else {
#pragma unroll
            for (int r = 0; r < 16; ++r) p[r] = 0.f;
        }
        const LAS char* kb_ = lds + ks * KSLOT + kb * (32 * 144) + kfo;
#pragma unroll
        for (int d0 = 0; d0 < 4; ++d0) p = MFMA32(*(const LAS bf16x8*)(kb_ + d0 * 32), qf[d0], p);
        if (MODE == 2) { const LAS char* rb_ = lds + ks * RSLOT + kb * (32 * 80) + rfo;
#pragma unroll
            for (int d0 = 0; d0 < 2; ++d0) p = MFMA32(*(const LAS bf16x8*)(rb_ + d0 * 32), qf[4 + d0], p); }
        if (MODE == 0) p = MFMA32(*(const LAS bf16x8*)(lds + (hi ? (L_KR + 3072) : (L_KR + ks * 1024 + kb * 512 + r32 * 16))), qx, p);
    };
    auto stage_b = [&](int j, f32x16& p, u32x4& wa, u32x4& wb) {
        float ps = 0.f;
#pragma unroll
        for (int r = 0; r < 16; ++r) { p[r] = __builtin_amdgcn_exp2f(p[r]); ps += p[r]; }
        wa.x = cvt2(p[0], p[1]); wa.y = cvt2(p[2], p[3]); wa.z = cvt2(p[4], p[5]); wa.w = cvt2(p[6], p[7]);
        wb.x = cvt2(p[8], p[9]); wb.y = cvt2(p[10], p[11]); wb.z = cvt2(p[12], p[13]); wb.w = cvt2(p[14], p[15]);
        lsum += ps;
    };
    auto stage_c = [&](int vs, int kb, const u32x4& wa, const u32x4& wb) {
        const LAS char* vb_ = lds + vs * 8192 + vfo + kb * 2048;
        { const s16x4 a0 = vtr(vb_), a1 = vtr(vb_ + 512), c0 = vtr(vb_ + 4096), c1 = vtr(vb_ + 4096 + 512);
          o0 = MFMA32(__builtin_shufflevector(a0, a1, 0, 1, 2, 3, 4, 5, 6, 7), __builtin_bit_cast(bf16x8, wa), o0); o1 = MFMA32(__builtin_shufflevector(c0, c1, 0, 1, 2, 3, 4, 5, 6, 7), __builtin_bit_cast(bf16x8, wa), o1); }
        { const s16x4 a0 = vtr(vb_ + 1024), a1 = vtr(vb_ + 1024 + 512), c0 = vtr(vb_ + 4096 + 1024), c1 = vtr(vb_ + 4096 + 1024 + 512);
          o0 = MFMA32(__builtin_shufflevector(a0, a1, 0, 1, 2, 3, 4, 5, 6, 7), __builtin_bit_cast(bf16x8, wb), o0); o1 = MFMA32(__builtin_shufflevector(c0, c1, 0, 1, 2, 3, 4, 5, 6, 7), __builtin_bit_cast(bf16x8, wb), o1); }
    };
    auto general = [&](int t, int ks, int vs) {
        const int k0 = t * 64; const bool selected = MODE != 1 || ((sel >> (t >> 2)) & 1u); const bool asel = anysel(t);
        int dl = qw + r32 - k0 - 4 * hi; asm volatile("" : "+v"(dl));
#pragma unroll
        for (int kb = 0; kb < 2; ++kb) {
            const int kh = k0 + 32 * kb;
            bool act = kh <= qw + 31 && asel, need_mask = kh + 31 > qw;
            if (MODE == 3) { act = act && (kh + 31 >= qw - 128); need_mask = need_mask || (kh < qw + 31 - 128); }
            if (!act) continue;
            f32x16 p;
            if (MODE == 1 || MODE == 3) { const LAS float* lp = aux + ((MODE == 1 ? 4095 : 255) - dl);
#pragma unroll
                for (int r = 0; r < 16; ++r) p[r] = lp[crow(r) + 32 * kb];
            } else {
#pragma unroll
                for (int r = 0; r < 16; ++r) p[r] = 0.f;
            }
            const LAS char* kb_ = lds + ks * KSLOT + kb * (32 * 144) + kfo;
#pragma unroll
            for (int d0 = 0; d0 < 4; ++d0) p = MFMA32(*(const LAS bf16x8*)(kb_ + d0 * 32), qf[d0], p);
            if (MODE == 2) { const LAS char* rb_ = lds + ks * RSLOT + kb * (32 * 80) + rfo;
#pragma unroll
                for (int d0 = 0; d0 < 2; ++d0) p = MFMA32(*(const LAS bf16x8*)(rb_ + d0 * 32), qf[4 + d0], p); }
            if (MODE == 0) p = MFMA32(*(const LAS bf16x8*)(lds + (hi ? (L_KR + 3072) : (L_KR + ks * 1024 + kb * 512 + r32 * 16))), qx, p);
            if (need_mask) {
#pragma unroll
                for (int r = 0; r < 16; ++r) { const int rel = dl - crow(r) - 32 * kb; const bool v = MODE == 3 ? ((unsigned)rel <= 128u) : (rel >= 0); p[r] = v ? p[r] : -INFINITY; }
            }
            float ps = 0.f;
            if (fast) {
#pragma unroll
                for (int r = 0; r < 16; ++r) { p[r] = __builtin_amdgcn_exp2f(p[r]); ps += p[r]; }
            } else {
                float mx = fmaxf(p[0], p[1]);
#pragma unroll
                for (int r = 2; r < 16; ++r) mx = fmaxf(mx, p[r]);
                mx = swap_max(mx);
                if (MODE == 1) mx = selected ? mx : NEGBIG;
                if (__any(mx > m + THR)) {
                    const float mn = fmaxf(m, mx), alpha = __builtin_amdgcn_exp2f(m - mn); m = mn; lsum *= alpha;
#pragma unroll
                    for (int r = 0; r < 16; ++r) { o0[r] *= alpha; o1[r] *= alpha; }
                }
#pragma unroll
                for (int r = 0; r < 16; ++r) { p[r] = __builtin_amdgcn_exp2f(p[r] - m); ps += p[r]; }
            }
            u32x4 w0, w1;
            w0.x = cvt2(p[0], p[1]); w0.y = cvt2(p[2], p[3]); w0.z = cvt2(p[4], p[5]); w0.w = cvt2(p[6], p[7]);
            w1.x = cvt2(p[8], p[9]); w1.y = cvt2(p[10], p[11]); w1.z = cvt2(p[12], p[13]); w1.w = cvt2(p[14], p[15]);
            if (MODE == 1) { const unsigned mk = selected ? 0xffffffffu : 0u; ps = selected ? ps : 0.f; w0 = w0 & mk; w1 = w1 & mk; }
            lsum += ps;
            const bf16x8 pb0 = __builtin_bit_cast(bf16x8, w0), pb1 = __builtin_bit_cast(bf16x8, w1);
            const LAS char* vb_ = lds + vs * 8192 + vfo + kb * 2048;
            { const s16x4 a0 = vtr(vb_), a1 = vtr(vb_ + 512), c0 = vtr(vb_ + 4096), c1 = vtr(vb_ + 4096 + 512);
              o0 = MFMA32(__builtin_shufflevector(a0, a1, 0, 1, 2, 3, 4, 5, 6, 7), pb0, o0); o1 = MFMA32(__builtin_shufflevector(c0, c1, 0, 1, 2, 3, 4, 5, 6, 7), pb0, o1); }
            { const s16x4 a0 = vtr(vb_ + 1024), a1 = vtr(vb_ + 1024 + 512), c0 = vtr(vb_ + 4096 + 1024), c1 = vtr(vb_ + 4096 + 1024 + 512);
              o0 = MFMA32(__builtin_shufflevector(a0, a1, 0, 1, 2, 3, 4, 5, 6, 7), pb1, o0); o1 = MFMA32(__builtin_shufflevector(c0, c1, 0, 1, 2, 3, 4, 5, 6, 7), pb1, o1); }
        }
    };

    if (MODE == 0) { ATT_LOADK(t_lo, kA, rA); ATT_LOADV(t_lo, vA); ATT_LOADK(t_lo + 1, kB, rB); }
    ATT_WRITEK(0, t_lo, kA, rA); ATT_WRITEV(0, t_lo, vA); ATT_WRITEK(1, t_lo + 1, kB, rB);
    __syncthreads();
    ATT_LOADK(t_lo + 2, kA, rA); ATT_LOADV(t_lo + 1, vA);
    int ks0 = 0, ks1 = 1, ks2 = 2, vs = 0;
    bool pend = is_full(t_lo);
    f32x16 sa0, sa1, sb0, sb1;
    if (pend) { stage_a(t_lo, 0, 0, sa0); stage_a(t_lo, 0, 1, sa1); }
    auto iter = [&](const int t, f32x16& c0, f32x16& c1, f32x16& n0, f32x16& n1) {
        const bool nxt = (t + 1 <= t_hi) && is_full(t + 1);
#ifdef PROBE_ATT
        const bool pk_ = (pend && nxt) == (PROBE_KIND == 0); unsigned long long ti0 = 0; if (MODE == PROBE_ATT && blockIdx.x == PROBE_BLK && pk_) ti0 = __builtin_amdgcn_s_memrealtime();
#endif
        if (pend && nxt) {
            u32x4 wa, wb, wc, wd;
            stage_a(t + 1, ks1, 0, n0); stage_b(t, c0, wa, wb); __builtin_amdgcn_sched_barrier(0);
            stage_a(t + 1, ks1, 1, n1); stage_c(vs, 0, wa, wb); stage_b(t, c1, wc, wd); __builtin_amdgcn_sched_barrier(0);
            stage_c(vs, 1, wc, wd);
        } else {
            if (pend) { u32x4 wa, wb; stage_b(t, c0, wa, wb); stage_c(vs, 0, wa, wb); stage_b(t, c1, wa, wb); stage_c(vs, 1, wa, wb); } else general(t, ks0, vs);
            if (nxt) { stage_a(t + 1, ks1, 0, n0); stage_a(t + 1, ks1, 1, n1); }
        }
        pend = nxt;
        ATT_WRITEK(ks2, t + 2, kA, rA); ATT_WRITEV(vs ^ 1, t + 1, vA);
        __syncthreads();
#ifdef PROBE_ATT
        if (MODE == PROBE_ATT && blockIdx.x == PROBE_BLK && pk_ && tid == PROBE_TID) { LAS unsigned* pa = (LAS unsigned*)(lds + 131072 + 32); pa[0] += (unsigned)(__builtin_amdgcn_s_memrealtime() - ti0); pa[1] += 1u; }
#endif
        ATT_LOADK(t + 3, kA, rA); ATT_LOADV(t + 2, vA);
        { const int tmp = ks0; ks0 = ks1; ks1 = ks2; ks2 = tmp; } vs ^= 1;
    };
    for (int t = t_lo; t <= t_hi; t += 2) { iter(t, sa0, sa1, sb0, sb1); if (t + 1 <= t_hi) iter(t + 1, sb0, sb1, sa0, sa1); }
#undef ATT_LOADK
#undef ATT_LOADV
#undef ATT_WRITEK
#undef ATT_WRITEV
    const int te_ = ltid(), r32e = te_ & 31, hie = (te_ >> 5) & 1, qwe = q0 + 32 * (te_ >> 6);
    const float ltot = swap_sum(lsum), inv = 1.0f / ltot;
    if (MODE != 3) {
        const size_t tok = (size_t)b * SEQ + qwe + r32e; const int colbase = (MODE == 0 ? 0 : (MODE == 1 ? 256 : 768)) + h * 64 + 4 * hie;
        const bf16_t* G = (const bf16_t*)((const char*)P.out + OOFF_G) + tok * DM + colbase; bf16_t* A2 = (bf16_t*)(P.ws + OFF_H) + tok * DM + colbase;
#pragma unroll
        for (int g = 0; g < 4; ++g) {
            const u32x2 g0 = *(const u32x2*)(G + 8 * g), g1 = *(const u32x2*)(G + 32 + 8 * g); u32x2 w0, w1;
            w0.x = cvt2(o0[4 * g] * inv * bflo(g0.x), o0[4 * g + 1] * inv * bfhi(g0.x)); w0.y = cvt2(o0[4 * g + 2] * inv * bflo(g0.y), o0[4 * g + 3] * inv * bfhi(g0.y));
            w1.x = cvt2(o1[4 * g] * inv * bflo(g1.x), o1[4 * g + 1] * inv * bfhi(g1.x)); w1.y = cvt2(o1[4 * g + 2] * inv * bflo(g1.y), o1[4 * g + 3] * inv * bfhi(g1.y));
            *(u32x2*)(A2 + 8 * g) = w0; *(u32x2*)(A2 + 32 + 8 * g) = w1; }
    } else {
        const size_t tok = (size_t)b * SEQ + (size_t)(qwe + r32e) * dil + res;
        bf16_t* dp = (bf16_t*)(P.ws + OFF_DPART) + ((size_t)pat * NT + tok) * 256 + h * 64 + 4 * hie;
#pragma unroll
        for (int g = 0; g < 4; ++g) { u32x2 w0, w1;
            w0.x = cvt2(o0[4 * g] * inv, o0[4 * g + 1] * inv); w0.y = cvt2(o0[4 * g + 2] * inv, o0[4 * g + 3] * inv);
            w1.x = cvt2(o1[4 * g] * inv, o1[4 * g + 1] * inv); w1.y = cvt2(o1[4 * g + 2] * inv, o1[4 * g + 3] * inv);
            *(u32x2*)(dp + 8 * g) = w0; *(u32x2*)(dp + 32 + 8 * g) = w1; }
        if (hie == 0) ((float*)(P.ws + OFF_DLSE))[((size_t)pat * NT + tok) * 4 + h] = m + __builtin_amdgcn_logf(ltot);
    }
}

DEVINL void dil_unit(const Params& P, int l, int u, char* smem) {
    LAS char* lds = (LAS char*)smem;
    const int tid = ltid(), lane = tid & 63, r32 = lane & 31, hi = lane >> 5; const int wid = __builtin_amdgcn_readfirstlane(tid >> 6);
    const int pat = u >> 8, v = u & 255, bh = v & 15, w = v >> 4, dil = pat == 0 ? 1 : (pat == 1 ? 4 : 16), res = w % dil, q0 = (w / dil) * 256;
    const int t_lo = (q0 >= 128 ? q0 - 128 : 0) >> 6, t_hi = (q0 + 255) >> 6, nt = t_hi - t_lo + 1;
    const int b = bh >> 2, h = bh & 3, rs = 64 * dil;
    const bf16_t* Qg = (const bf16_t*)(P.ws + OFF_QKV + 6 * SZ_HEADBUF) + ((size_t)bh * SEQ + res) * 64; const bf16_t* Kg = Qg + SZ_HEADBUF / 2; const bf16_t* Vg = Kg + SZ_HEADBUF / 2;
    const int qw = q0 + 32 * wid;
    constexpr int D_KB = 0, D_VB = 6 * KSLOT, D_AUX = D_VB + 6 * 8192;
    LAS float* aux = (LAS float*)(lds + D_AUX);
    __syncthreads();
    const unsigned kgo = (unsigned)((tid >> 3) * rs + (tid & 7) * 8), vgo = (unsigned)(((tid >> 2) & 63) * rs + (tid >> 8) * 32 + (tid & 3) * 8);
    u32x4 kr[6], vr[6];
#pragma unroll
    for (int j = 0; j < 6; ++j) if (j < nt) { kr[j] = *(const u32x4*)(Kg + (size_t)(t_lo + j) * 64 * rs + kgo); vr[j] = *(const u32x4*)(Vg + (size_t)(t_lo + j) * 64 * rs + vgo); }
    bf16x8 qf[4];
    { const bf16_t* qp = Qg + (size_t)(qw + r32) * rs + 8 * hi;
#pragma unroll
      for (int d0 = 0; d0 < 4; ++d0) qf[d0] = *(const bf16x8*)(qp + 16 * d0); }
    { const float* lut = (const float*)(P.ws + OFF_LUT) + (size_t)(4 + h) * 4096;
      if (tid < 320) { const int rel = 255 - tid; aux[tid] = (rel >= 0 && rel * dil < 4096) ? lut[rel * dil] : 0.f; } }
    { const int kws = (tid >> 3) * 144 + (tid & 7) * 16;
#pragma unroll
      for (int j = 0; j < 6; ++j) if (j < nt) { *(LAS u32x4*)(lds + D_KB + j * KSLOT + kws) = kr[j]; *(LAS u32x4*)(lds + D_VB + j * 8192 + tid * 16) = vr[j]; } }
    __syncthreads();
    const int kfo = D_KB + r32 * 144 + hi * 16;
    const int vfo = D_VB + ((lane >> 4) & 1) * 32 + (lane & 3) * 8 + (4 * hi + ((lane & 15) >> 2)) * 64;
    f32x16 o0, o1;
#pragma unroll
    for (int r = 0; r < 16; ++r) { o0[r] = 0.f; o1[r] = 0.f; }
    float lsum = 0.f;
    const int hb_hi = qw >> 5, hb_lo = hb_hi >= 4 ? hb_hi - 4 : 0;
    for (int hb = hb_lo; hb <= hb_hi; ++hb) {
        const int kh = hb * 32, jl = (hb >> 1) - t_lo, kb = hb & 1;
        const bool need_mask = (hb == hb_hi) || (kh < qw + 31 - 128);
        const int dl = qw + r32 - kh - 4 * hi;
        f32x16 p;
        { const LAS float* lp = aux + (255 - dl);
#pragma unroll
          for (int r = 0; r < 16; ++r) p[r] = lp[crow(r)]; }
        const LAS char* kb_ = lds + jl * KSLOT + kb * (32 * 144) + kfo;
#pragma unroll
        for (int d0 = 0; d0 < 4; ++d0) p = MFMA32(*(const LAS bf16x8*)(kb_ + d0 * 32), qf[d0], p);
        if (need_mask) {
#pragma unroll
            for (int r = 0; r < 16; ++r) { const int rel = dl - crow(r); p[r] = ((unsigned)rel <= 128u) ? p[r] : -INFINITY; }
        }
        float ps = 0.f;
#pragma unroll
        for (int r = 0; r < 16; ++r) { p[r] = __builtin_amdgcn_exp2f(p[r]); ps += p[r]; }
        lsum += ps;
        u32x4 w0, w1;
        w0.x = cvt2(p[0], p[1]); w0.y = cvt2(p[2], p[3]); w0.z = cvt2(p[4], p[5]); w0.w = cvt2(p[6], p[7]);
        w1.x = cvt2(p[8], p[9]); w1.y = cvt2(p[10], p[11]); w1.z = cvt2(p[12], p[13]); w1.w = cvt2(p[14], p[15]);
        const LAS char* vb_ = lds + jl * 8192 + vfo + kb * 2048;
        { const s16x4 a0 = vtr(vb_), a1 = vtr(vb_ + 512), c0 = vtr(vb_ + 4096), c1 = vtr(vb_ + 4096 + 512);
          o0 = MFMA32(__builtin_shufflevector(a0, a1, 0, 1, 2, 3, 4, 5, 6, 7), __builtin_bit_cast(bf16x8, w0), o0); o1 = MFMA32(__builtin_shufflevector(c0, c1, 0, 1, 2, 3, 4, 5, 6, 7), __builtin_bit_cast(bf16x8, w0), o1); }
        { const s16x4 a0 = vtr(vb_ + 1024), a1 = vtr(vb_ + 1024 + 512), c0 = vtr(vb_ + 4096 + 1024), c1 = vtr(vb_ + 4096 + 1024 + 512);
          o0 = MFMA32(__builtin_shufflevector(a0, a1, 0, 1, 2, 3, 4, 5, 6, 7), __builtin_bit_cast(bf16x8, w1), o0); o1 = MFMA32(__builtin_shufflevector(c0, c1, 0, 1, 2, 3, 4, 5, 6, 7), __builtin_bit_cast(bf16x8, w1), o1); }
    }
    const float ltot = swap_sum(lsum), inv = 1.0f / ltot;
    const size_t tok = (size_t)b * SEQ + (size_t)(qw + r32) * dil + res;
    bf16_t* dp = (bf16_t*)(P.ws + OFF_DPART) + ((size_t)pat * NT + tok) * 256 + h * 64 + 4 * hi;
#pragma unroll
    for (int g = 0; g < 4; ++g) { u32x2 w0, w1;
        w0.x = cvt2(o0[4 * g] * inv, o0[4 * g + 1] * inv); w0.y = cvt2(o0[4 * g + 2] * inv, o0[4 * g + 3] * inv);
        w1.x = cvt2(o1[4 * g] * inv, o1[4 * g + 1] * inv); w1.y = cvt2(o1[4 * g + 2] * inv, o1[4 * g + 3] * inv);
        *(u32x2*)(dp + 8 * g) = w0; *(u32x2*)(dp + 32 + 8 * g) = w1; }
    if (hi == 0) ((float*)(P.ws + OFF_DLSE))[((size_t)pat * NT + tok) * 4 + h] = __builtin_amdgcn_logf(ltot);
}

DEVINL void dilmix_unit(const Params& P, int u) {
    const int e = u * NTHREADS + ltid(), tok = e >> 5, hd = e & 31, h = hd >> 3, d8 = (hd & 7) * 8;
    const float* ls = (const float*)(P.ws + OFF_DLSE); const bf16_t* dp = (const bf16_t*)(P.ws + OFF_DPART);
    const float l0 = ls[(size_t)tok * 4 + h], l1 = ls[((size_t)NT + tok) * 4 + h], l2 = ls[((size_t)2 * NT + tok) * 4 + h];
    const float mx = fmaxf(l0, fmaxf(l1, l2)); float w0 = __builtin_amdgcn_exp2f(l0 - mx), w1 = __builtin_amdgcn_exp2f(l1 - mx), w2 = __builtin_amdgcn_exp2f(l2 - mx);
    const float inv = 1.0f / (w0 + w1 + w2); w0 *= inv; w1 *= inv; w2 *= inv;
    const size_t off = (size_t)tok * 256 + h * 64 + d8;
    const u32x4 a = *(const u32x4*)(dp + off), b = *(const u32x4*)(dp + (size_t)NT * 256 + off), c = *(const u32x4*)(dp + (size_t)2 * NT * 256 + off);
    const u32x4 g = *(const u32x4*)((const bf16_t*)((const char*)P.out + OOFF_G) + (size_t)tok * DM + 512 + h * 64 + d8);
    u32x4 r;
    r.x = cvt2((w0 * bflo(a.x) + w1 * bflo(b.x) + w2 * bflo(c.x)) * bflo(g.x), (w0 * bfhi(a.x) + w1 * bfhi(b.x) + w2 * bfhi(c.x)) * bfhi(g.x));
    r.y = cvt2((w0 * bflo(a.y) + w1 * bflo(b.y) + w2 * bflo(c.y)) * bflo(g.y), (w0 * bfhi(a.y) + w1 * bfhi(b.y) + w2 * bfhi(c.y)) * bfhi(g.y));
    r.z = cvt2((w0 * bflo(a.z) + w1 * bflo(b.z) + w2 * bflo(c.z)) * bflo(g.z), (w0 * bfhi(a.z) + w1 * bfhi(b.z) + w2 * bfhi(c.z)) * bfhi(g.z));
    r.w = cvt2((w0 * bflo(a.w) + w1 * bflo(b.w) + w2 * bflo(c.w)) * bflo(g.w), (w0 * bfhi(a.w) + w1 * bfhi(b.w) + w2 * bfhi(c.w)) * bfhi(g.w));
    *(u32x4*)((bf16_t*)(P.ws + OFF_H) + (size_t)tok * DM + 512 + h * 64 + d8) = r;
}


#define XB_TMO      128
#define XB_XCNT(j)  (256  + 64 * (j))
#define XB_XSUB(j)  (1280 + 64 * (j))
#define XB_XGEN(j)  (2304 + 64 * (j))
#define XB_TOP      3328
#define XB_TOPGEN   3392
#define XCD_BAR_WORDS 3456
#define XB_SPIN_CAP (1u << 20)
DEVINL unsigned xb_ld(unsigned* p) { return __hip_atomic_load(p, __ATOMIC_RELAXED, __HIP_MEMORY_SCOPE_AGENT); }
DEVINL unsigned xb_add(unsigned* p, unsigned v) { return __hip_atomic_fetch_add(p, v, __ATOMIC_RELAXED, __HIP_MEMORY_SCOPE_AGENT); }
DEVINL unsigned xb_xcc_id() { return (unsigned)__builtin_amdgcn_s_getreg((3 << 11) | 20) & 0xFu; }
#define XB_SPIN(cond, bar) do { unsigned _sp = 0; while (cond) { __builtin_amdgcn_s_sleep(1); \
    if ((++_sp & 255u) == 0u) { if (xb_ld(&(bar)[XB_TMO])) break; if (_sp > XB_SPIN_CAP) { atomicAdd(&(bar)[XB_TMO], 1u); break; } } } } while (0)
DEVINL void xcd_barrier_post(unsigned* bar) { if (ltid() == 0) (void)xb_add(&bar[XB_XCNT(xb_xcc_id())], 1u); }
DEVINL void xcd_barrier_complete(unsigned* bar, unsigned x, unsigned& nloc, unsigned& nx) {
    const unsigned G = gridDim.x * gridDim.y * gridDim.z;
    unsigned sum, cnt, mine, sp = 0u;
    for (;;) {
        sum = 0u; cnt = 0u; mine = 0u;
        for (unsigned j = 0; j < 16; ++j) { const unsigned c = xb_ld(&bar[XB_XCNT(j)]); sum += c; cnt += (c > 0u) ? 1u : 0u; mine = (j == x) ? c : mine; }
        if (sum == G) break;
        __builtin_amdgcn_s_sleep(1);
        if ((++sp & 255u) == 0u) { if (xb_ld(&bar[XB_TMO])) break; if (sp > XB_SPIN_CAP) { atomicAdd(&bar[XB_TMO], 1u); break; } }
    }
    nloc = mine > 0u ? mine : 1u; nx = cnt > 0u ? cnt : 1u;
}
DEVINL void xcd_barrier(unsigned* bar_in, volatile LAS unsigned* st) {
    asm volatile("s_waitcnt vmcnt(0)" ::: "memory");
    __syncthreads();
    if (ltid() == 0) {
        unsigned* bar = bar_in;
        const unsigned x = xb_xcc_id();
        __builtin_amdgcn_s_waitcnt(0);
        unsigned nloc = st[0], nx = st[1];
        if (nloc == 0u) { xcd_barrier_complete(bar, x, nloc, nx); st[0] = nloc; st[1] = nx; }
        const unsigned old = xb_add(&bar[XB_XSUB(x)], 1u);
        const unsigned gen = old / nloc;
        if (old + 1u == (gen + 1u) * nloc) {
            __builtin_amdgcn_fence(__ATOMIC_RELEASE, "agent");
            asm volatile("s_waitcnt vmcnt(0)" ::: "memory");
            const unsigned og = xb_add(&bar[XB_TOP], 1u);
            const unsigned tg = og / nx;
            if (og + 1u == (tg + 1u) * nx) xb_add(&bar[XB_TOPGEN], 1u);
            else XB_SPIN(xb_ld(&bar[XB_TOPGEN]) == tg, bar);
            __builtin_amdgcn_fence(__ATOMIC_ACQUIRE, "agent");
            xb_add(&bar[XB_XGEN(x)], 1u);
            asm volatile("s_waitcnt vmcnt(0)" ::: "memory");
        } else {
            XB_SPIN(xb_ld(&bar[XB_XGEN(x)]) == gen, bar);
            __builtin_amdgcn_fence(__ATOMIC_ACQUIRE, "agent");
            asm volatile("s_waitcnt vmcnt(0)" ::: "memory");
        }
    }
    __syncthreads();
}


DEVINL int next_unit(unsigned* ctr, char* smem) {
    int* su = (int*)(smem + L_MISC);
    __syncthreads();
    if (ltid() == 0) *su = (int)atomicAdd(ctr, 1u);
    __syncthreads();
    return *su;
}

template <class Epi> DEVINL void gemm8_sub(const bf16_t* A, const bf16_t* Bt, int M, int N, int K, const Epi& E, char* smem, int G, int c) {
    asm volatile("" : "+s"(G), "+s"(c));
    pg8::Gemm g{A, Bt, M, N, K}; pg8::StaticOrder S; S.init(M, N, G, c);
    pg8::gemm_phase<Epi, pg8::StaticOrder, true, true>((PG8_LAS unsigned char*)smem, g, S, E);
}
DEVINL void phase_pre(const Params& P, int l, char* smem) {
    const int half = (int)gridDim.x >> 1, bid = (int)blockIdx.x;
    if (bid < half) gemm8_sub((const bf16_t*)(P.ws + OFF_CQ), (const bf16_t*)(P.ws + OFF_WT_UQ + l * SZ_WT_UQ), NT, 512, 256, EpiUq8{P, l}, smem, half, bid);
    else gemm8_sub((const bf16_t*)(P.ws + OFF_CKV), (const bf16_t*)(P.ws + OFF_WT_UKV + l * SZ_WT_UKV), NT, 512, 256, EpiUkv8{P, l}, smem, (int)gridDim.x - half, bid - half);
    for (int u = blockIdx.x; u < 256; u += gridDim.x) kmean_unit(P, u, smem);
}
DEVINL void phase_att(const Params& P, int l, char* smem, int rep) {
    unsigned* ctr = (unsigned*)(P.ws + OFF_CTR) + l * 2 + rep * 8;
    constexpr int N_ATT = 384 + 256 + 96 + 768 + 32; const int n_all = N_ATT + (l == 0 ? PREP_PER_LAYER + PREP_P_UNITS / 2 : 0);
    for (;;) { int u = next_unit(ctr, smem); if (u >= n_all) break;
        if (u >= N_ATT) { __syncthreads(); if (u - N_ATT < PREP_PER_LAYER) prep_w_unit(P, 1, u - N_ATT, (float*)smem); else prep_p_unit(P, PREP_P_UNITS / 2 + (u - N_ATT - PREP_PER_LAYER)); continue; }
        if (u >= 384 && u < 640) { attn_unit<0>(P, l, u - 384, smem); continue; }
        if (u >= 736 && u < 736 + 768) { if (((const float*)(P.ws + OFF_BOUND))[l * 4 + 3] < 100.0f) dil_unit(P, l, u - 736, smem); else attn_unit<3>(P, l, u - 736, smem); continue; }
        if (u >= 736 + 768) u -= 768; if (u >= 640) u -= 256;
        const int g = u >> 5, r = u & 31, uu = g * 16 + (r & 15);
        if (r < 16) attn_unit<2>(P, l, uu, smem); else attn_unit<1>(P, l, uu, smem); }
}

template <int PH> DEVINL void run_phase(int l, char* smem, int rep = 0) {
    asm volatile("" : "+s"(l));
    const __attribute__((address_space(4))) Params* kp = (const __attribute__((address_space(4))) Params*)__builtin_amdgcn_kernarg_segment_ptr(); asm volatile("" : "+s"(kp));
    Params P;
    P.x = (const float*)as_global(kp->x); P.p = (const float*)as_global(kp->p); P.ln_g = (const float*)as_global(kp->ln_g); P.w_in = (const float*)as_global(kp->w_in); P.b_forget = (const float*)as_global(kp->b_forget);
    P.qk_gain = (const float*)as_global(kp->qk_gain); P.mla_q_norm = (const float*)as_global(kp->mla_q_norm); P.mla_kv_norm = (const float*)as_global(kp->mla_kv_norm); P.mla_nope_gain = (const float*)as_global(kp->mla_nope_gain);
    P.mla_rope_gain = (const float*)as_global(kp->mla_rope_gain); P.w_uq = (const float*)as_global(kp->w_uq); P.w_ukv = (const float*)as_global(kp->w_ukv); P.w_out = (const float*)as_global(kp->w_out); P.rel_bias = (const float*)as_global(kp->rel_bias);
    P.ple_norm_g = (const float*)as_global(kp->ple_norm_g); P.w_ple_gate = (const float*)as_global(kp->w_ple_gate); P.w_ple_proj = (const float*)as_global(kp->w_ple_proj); P.out = (float*)as_global(kp->out); P.ws = as_global(kp->ws);
    char* ws = P.ws;
    const float* xin = l == 0 ? P.x : (const float*)(ws + OFF_X);
    float* xa = P.out;
    float* xout = l == 0 ? (float*)(ws + OFF_X) : P.out;
    if (PH == 0) phase_prep(P, smem);
    if (PH == 2) { gemm8((const bf16_t*)(ws + OFF_H), (const bf16_t*)(ws + OFF_WT_IN + l * SZ_WT_IN), NT, NP1, 1024, EpiIn8{P, l}, smem);
                   const int G_ = (int)gridDim.x, w0_ = G_ > 192 ? 192 : 0;
                   if (l == 0 && (int)blockIdx.x >= w0_) { __syncthreads(); constexpr int W0 = PREP_T_IN + PREP_T_UQ + PREP_T_UKV, NWL = PREP_PER_LAYER - W0;
                       for (int u = (int)blockIdx.x - w0_; u < NWL + PREP_P_UNITS / 2; u += G_ - w0_) { if (u < NWL) prep_w_unit(P, 0, W0 + u, (float*)smem); else prep_p_unit(P, u - NWL); } } }
    if (PH == 3) phase_pre(P, l, smem);
    if (PH == 4) phase_att(P, l, smem, rep);
    if (PH == 5) { for (int u = blockIdx.x; u < 1024; u += gridDim.x) dilmix_unit(P, u);
                 }
    if (PH == 8) gemm8((const bf16_t*)(ws + OFF_H), (const bf16_t*)(ws + OFF_WT_OUT + l * SZ_WT_SQ), NT, 1024, 1024, EpiResid8{xin, xa, (bf16_t*)(ws + OFF_XABF), (float*)(ws + OFF_SSQA)}, smem);
    if (PH == 7) { gemm8((const bf16_t*)(ws + (l == 0 ? OFF_PB : OFF_PB2)), (const bf16_t*)(ws + OFF_WT_PP + l * SZ_WT_PP), NT, 1024, 256, EpiStoreBf{(bf16_t*)(ws + OFF_QKV)}, smem);
                   __syncthreads();
                   gemm8((const bf16_t*)(ws + OFF_XABF), (const bf16_t*)(ws + OFF_WT_PG + l * SZ_WT_SQ), NT, 1024, 1024, EpiPle8{xa, (const bf16_t*)(ws + OFF_QKV), xout, (const float*)(ws + OFF_SSQA), l == 0 ? (bf16_t*)(ws + OFF_H) : (bf16_t*)nullptr, (float*)(ws + OFF_SSQX)}, smem); }
}

__global__ void __launch_bounds__(NTHREADS) k_mega(Params Parg) {
    char* smem = g_smem;
    { const int t0 = (int)threadIdx.x; if (t0 < 12) ((LAS unsigned*)((LAS char*)smem + L_XB))[t0] = 0u;
      if ((t0 & 63) == 0) *(LAS int*)((LAS char*)smem + L_WTAB + 4u * (unsigned)__builtin_amdgcn_s_getreg(0x2804)) = t0 >> 6; }
    __syncthreads();
    const __attribute__((address_space(4))) Params* kp0 = (const __attribute__((address_space(4))) Params*)__builtin_amdgcn_kernarg_segment_ptr();
    xcd_barrier_post((unsigned*)(as_global(kp0->ws) + OFF_BAR));
#define XBAR() xcd_barrier((unsigned*)(as_global(kp0->ws) + OFF_BAR), (volatile LAS unsigned*)((LAS char*)smem + L_XB))
#ifdef PROBE_IDX
    unsigned long long tA = 0, tB = 0;
#define PT0(i) if (PROBE_IDX == (i)) tA = __builtin_amdgcn_s_memrealtime();
#define PT1(i) if (PROBE_IDX == (i)) tB = __builtin_amdgcn_s_memrealtime();
#else
#define PT0(i)
#define PT1(i)
#endif
    PT0(0) run_phase<0>(0, smem); XBAR(); PT1(0)
    PT0(2) run_phase<2>(0, smem); XBAR(); PT1(2) PT0(3) run_phase<3>(0, smem); XBAR(); PT1(3) PT0(4) run_phase<4>(0, smem); XBAR(); PT1(4)
    PT0(5) run_phase<5>(0, smem); XBAR(); PT1(5) PT0(6) run_phase<8>(0, smem); XBAR(); PT1(6) PT0(8) run_phase<7>(0, smem); XBAR(); PT1(8)
    run_phase<2>(1, smem); XBAR(); run_phase<3>(1, smem); XBAR(); run_phase<4>(1, smem); XBAR(); run_phase<5>(1, smem); XBAR(); run_phase<8>(1, smem); XBAR(); run_phase<7>(1, smem);
#ifdef PROBE_IDX
    if (blockIdx.x == 0) { const unsigned long long t0 = __builtin_amdgcn_s_memrealtime(), want = (tB - tA) * 32ull; while (__builtin_amdgcn_s_memrealtime() - t0 < want) __builtin_amdgcn_s_sleep(32); }
#endif
#undef XBAR
#ifdef PROBE_ATT
    if (blockIdx.x == PROBE_BLK) { __syncthreads(); const LAS unsigned* pa = (const LAS unsigned*)((LAS char*)smem + L_MISC + 32); const unsigned long long tk = pa[0], nt = pa[1] ? pa[1] : 1u;
        const unsigned long long t0 = __builtin_amdgcn_s_memrealtime(), want = tk * 2048ull / nt; while (__builtin_amdgcn_s_memrealtime() - t0 < want) __builtin_amdgcn_s_sleep(32); }
#endif
}
}

extern "C" void kernel_launch(void* const* d_in, const int* in_sizes, int n_in, void* d_out, int out_size, void* d_ws, size_t ws_size, hipStream_t stream) {
    Params P{};
    P.x = (const float*)d_in[0]; P.p = (const float*)d_in[1]; P.ln_g = (const float*)d_in[2]; P.w_in = (const float*)d_in[3]; P.b_forget = (const float*)d_in[4]; P.qk_gain = (const float*)d_in[5];
    P.mla_q_norm = (const float*)d_in[6]; P.mla_kv_norm = (const float*)d_in[7]; P.mla_nope_gain = (const float*)d_in[8]; P.mla_rope_gain = (const float*)d_in[9]; P.w_uq = (const float*)d_in[10];
    P.w_ukv = (const float*)d_in[11]; P.w_out = (const float*)d_in[12]; P.rel_bias = (const float*)d_in[13]; P.ple_norm_g = (const float*)d_in[14]; P.w_ple_gate = (const float*)d_in[15]; P.w_ple_proj = (const float*)d_in[16];
    P.out = (float*)d_out; P.ws = (char*)d_ws;
    if (ws_size < WS_NEED) { fprintf(stderr, "workspace too small: %zu < %zu\n", ws_size, (size_t)WS_NEED); return; }
    static int grid_blocks = 0;
    if (!grid_blocks) {
        int dev = 0, cus = 0, per_cu = 0;
        hipGetDevice(&dev);
        hipDeviceGetAttribute(&cus, hipDeviceAttributeMultiprocessorCount, dev);
        hipOccupancyMaxActiveBlocksPerMultiprocessor(&per_cu, k_mega, NTHREADS, 0);
        if (per_cu > 1) per_cu = 1;
        grid_blocks = cus * per_cu;
    }
    hipMemsetAsync((char*)d_ws + OFF_CTR, 0, 512 + 3456 * 4, stream);
    void* args[] = {&P};
    hipError_t e = hipLaunchCooperativeKernel((void*)k_mega, dim3(grid_blocks), dim3(NTHREADS), args, 0, stream);
    if (e != hipSuccess) fprintf(stderr, "cooperative launch failed: %s (grid %d)\n", hipGetErrorString(e), grid_blocks);
}
```

```cpp
#include <hip/hip_runtime.h>
#include <hip/hip_cooperative_groups.h>
#include <cstdint>
#include <cstdio>

#ifndef ONE_LAUNCH
#define ONE_LAUNCH 1
#endif

namespace {
#define DEVINL __device__ __forceinline__
typedef unsigned short bf16_t;
typedef short bf16x8 __attribute__((ext_vector_type(8)));
typedef float f32x4 __attribute__((ext_vector_type(4)));
typedef unsigned u32x2 __attribute__((ext_vector_type(2)));
typedef unsigned u32x4 __attribute__((ext_vector_type(4)));

constexpr int NB = 4, SEQ = 4096, DM = 1024, NT = NB * SEQ, NH = 4, NBH = NB * NH;
constexpr int INW = 3748, NP1 = 3840;
constexpr float EPS = 1e-6f, LOG2E = 1.4426950408889634f;
constexpr float SC_Q = 0.125f * LOG2E;
constexpr float SC_MLA = 0.10206207261596575f * LOG2E;
constexpr int NTHREADS = 512;

constexpr size_t SZ_WT_IN = (size_t)NP1 * 1024 * 2, SZ_WT_UQ = 512 * 256 * 2  , SZ_WT_UKV = 512 * 256 * 2  , SZ_WT_SQ = 1024 * 1024 * 2, SZ_WT_PP = 1024 * 256 * 2;
constexpr size_t OFF_WT_IN = 0;
constexpr size_t OFF_WT_UQ = OFF_WT_IN + 2 * SZ_WT_IN;
constexpr size_t OFF_WT_UKV = OFF_WT_UQ + 2 * SZ_WT_UQ;
constexpr size_t OFF_WT_OUT = OFF_WT_UKV + 2 * SZ_WT_UKV;
constexpr size_t OFF_WT_PG = OFF_WT_OUT + 2 * SZ_WT_SQ;
constexpr size_t OFF_WT_PP = OFF_WT_PG + 2 * SZ_WT_SQ;
constexpr size_t OFF_LUT = OFF_WT_PP + 2 * SZ_WT_PP;
constexpr size_t OFF_ROPE = OFF_LUT + 8 * 4096 * 4;
constexpr size_t OFF_H = OFF_ROPE + 4096 * 16 * 8;
constexpr size_t SZ_HEADBUF = (size_t)NT * 256 * 2;
constexpr size_t OFF_QKV = OFF_H + (size_t)NT * 1024 * 2;
constexpr size_t OFF_XABF = OFF_QKV + (size_t)NT * 1024 * 2;
constexpr size_t OFF_CQ = OFF_QKV + 9 * SZ_HEADBUF;
constexpr size_t OFF_CKV = OFF_CQ + (size_t)NT * 256 * 2;
constexpr size_t OFF_CQSS = OFF_CKV + (size_t)NT * 256 * 2;
constexpr size_t OFF_CKVSS = OFF_CQSS + (size_t)NT * 4 * 4;
constexpr size_t OFF_LOGF = OFF_CKVSS + (size_t)NT * 2 * 4;
constexpr size_t OFF_KMEAN = OFF_LOGF + (size_t)NBH * SEQ * 4;
constexpr size_t OFF_PB = OFF_KMEAN + (size_t)NBH * 16 * 64 * 4;
constexpr size_t OFF_X = OFF_PB + (size_t)NT * 256 * 2;
constexpr size_t OFF_PB2 = OFF_X + (size_t)NT * 1024 * 4;
constexpr size_t OFF_SSQX = OFF_PB2 + (size_t)NT * 256 * 2;
constexpr size_t OFF_SSQA = OFF_SSQX + (size_t)NT * 16 * 4;
constexpr size_t OFF_DPART = OFF_SSQA + (size_t)NT * 16 * 4;
constexpr size_t OFF_DLSE = OFF_DPART + 3 * (size_t)NT * 256 * 2;
constexpr size_t OFF_CTR = OFF_DLSE + 3 * (size_t)NT * 4 * 4;
constexpr size_t OFF_BOUND = OFF_CTR + 256;
constexpr size_t OFF_BAR = OFF_BOUND + 256;
constexpr size_t WS_NEED = OFF_BAR + 3456 * 4;
constexpr size_t OOFF_G = 0;
constexpr size_t OOFF_QM = (size_t)NT * 1024 * 2;
constexpr size_t OOFF_KM = OOFF_QM + (size_t)NBH * SEQ * 96 * 2;
constexpr size_t OOFF_VM = OOFF_KM + (size_t)NBH * SEQ * 96 * 2;

struct Params {
    const float *x, *p, *ln_g, *w_in, *b_forget, *qk_gain, *mla_q_norm, *mla_kv_norm, *mla_nope_gain, *mla_rope_gain, *w_uq, *w_ukv, *w_out, *rel_bias, *ple_norm_g, *w_ple_gate, *w_ple_proj;
    float* out;
    char* ws;
};

DEVINL char* as_global(const void* p) { __attribute__((address_space(1))) char* g; asm volatile("" : "=s"(g) : "0"(p)); return (char*)g; }
constexpr int L_MISC = 131072;
constexpr int L_XB = L_MISC + 16, L_WTAB = L_MISC + 64, SMEM_BYTES = L_MISC + 64 + 256;
__shared__ __attribute__((aligned(16))) char g_smem[SMEM_BYTES];
DEVINL int ltid() {
    const unsigned hw = (unsigned)__builtin_amdgcn_s_getreg(0x2804);
    const int w = __builtin_amdgcn_readfirstlane(*(const __attribute__((address_space(3))) int*)((__attribute__((address_space(3))) char*)g_smem + L_WTAB + hw * 4));
    int lane; asm volatile("v_mbcnt_lo_u32_b32 %0, -1, 0\n\tv_mbcnt_hi_u32_b32 %0, -1, %0" : "=v"(lane));
    return w * 64 + lane; }
DEVINL float shx(float v, int mask) { return __int_as_float(__builtin_amdgcn_ds_bpermute(((ltid() & 63) ^ mask) << 2, __float_as_int(v))); }
DEVINL float shup(float v, int o) { return __int_as_float(__builtin_amdgcn_ds_bpermute(((ltid() & 63) - o) << 2, __float_as_int(v))); }
DEVINL float sq4(const f32x4& a) { return a[0] * a[0] + a[1] * a[1] + a[2] * a[2] + a[3] * a[3]; }
template <int XM> DEVINL float swz_xor(float v) { return __int_as_float(__builtin_amdgcn_ds_swizzle(__float_as_int(v), (XM << 10) | 0x1F)); }
DEVINL float half_swap_sum(float v) { auto rr = __builtin_amdgcn_permlane32_swap(__float_as_uint(v), __float_as_uint(v), false, false); return __uint_as_float(rr[0]) + __uint_as_float(rr[1]); }
DEVINL float wave_sum(float v) { v += swz_xor<1>(v); v += swz_xor<2>(v); v += swz_xor<4>(v); v += swz_xor<8>(v); v += swz_xor<16>(v); return half_swap_sum(v); }
DEVINL bf16_t f2bf(float f) { unsigned u = __float_as_uint(f); u += 0x7fffu + ((u >> 16) & 1u); return (bf16_t)(u >> 16); }
DEVINL float bf2f(bf16_t h) { return __uint_as_float(((unsigned)h) << 16); }
DEVINL unsigned pack2(float a, float b) { return (unsigned)f2bf(a) | ((unsigned)f2bf(b) << 16); }
typedef __bf16 bf16v2 __attribute__((ext_vector_type(2)));
typedef float f32v2 __attribute__((ext_vector_type(2)));
DEVINL unsigned cvt2(float a, float b) { f32v2 v = {a, b}; return __builtin_bit_cast(unsigned, __builtin_convertvector(v, bf16v2)); }
DEVINL float bflo(unsigned u) { return __uint_as_float(u << 16); }
DEVINL float bfhi(unsigned u) { return __uint_as_float(u & 0xffff0000u); }

__device__ __constant__ float ROPE_INV[16] = {1.0f, 0.5623413251903491f, 0.31622776601683794f, 0.1778279410038923f, 0.1f, 0.05623413251903491f, 0.03162277660168379f, 0.01778279410038923f,
                                              0.01f, 0.005623413251903491f, 0.0031622776601683794f, 0.0017782794100389228f, 0.001f, 0.0005623413251903491f, 0.00031622776601683794f, 0.00017782794100389227f};

DEVINL int t5_bucket(int d) {
    if (d < 16) return d;
    int b = 16;
    b += (d >= 22); b += (d >= 30); b += (d >= 40); b += (d >= 54); b += (d >= 73); b += (d >= 99); b += (d >= 134); b += (d >= 182);
    b += (d >= 246); b += (d >= 332); b += (d >= 450); b += (d >= 609); b += (d >= 825); b += (d >= 1117); b += (d >= 1513);
    return b;
}

DEVINL int map_w_in(int n) { return n < 768 ? n : (n < 2720 ? n + 4 : (n < 2724 ? n - 2720 + 768 : (n < 2816 ? -1 : n - 92))); }
DEVINL int virt_col(int nv) { const int v = nv & 255; return (nv & ~255) + 64 * ((v >> 5) & 3) + 32 * (v >> 7) + (v & 31); }
DEVINL int map_w_in_virt(int nv) { int a = virt_col(nv); const int chunk = a >> 6; int hc = a & 63;
    if (chunk == 42 && hc < 32) hc = 16 * ((hc >> 2) & 1) + 4 * (hc >> 3) + (hc & 3);
    return map_w_in(chunk * 64 + hc); }
DEVINL int map_w_uq_virt(int nv) { const int a = virt_col(nv), chunk = a >> 6; int hc = a & 63; if (chunk >= 6) return -1;
    if (chunk >= 4) { const int e = hc & 31; hc = (hc & 32) + 16 * ((e >> 2) & 1) + 4 * (e >> 3) + (e & 3); }
    const int n = chunk * 64 + hc; if (n < 256) return (n >> 6) * 96 + (n & 63); const int r = n - 256; return (r >> 5) * 96 + 64 + (r & 31); }
DEVINL int map_w_uq(int n) { if (n < 256) return (n >> 6) * 96 + (n & 63); const int r = n - 256; return (r >> 5) * 96 + 64 + (r & 31); }

template <int KT>
DEVINL void transpose_tile(const float* src, int Nsrc, bf16_t* dst, int K, int tn, int tk, int mode, const float* fold, float* tile  ) {
    const int tid = ltid(), c4 = (tid & 15) * 4, kr = tid >> 4  , n0 = tn * 64, k0 = tk * KT;
    const int n = n0 + c4, oc = mode == 1 ? map_w_in_virt(n) : (mode == 2 ? map_w_uq(n) : (mode == 3 ? virt_col(n) : (mode == 4 ? map_w_uq_virt(n) : (mode == 5 ? virt_col(n) : n))));
    f32x4 v[KT / 32];
#pragma unroll
    for (int i = 0; i < KT / 32; ++i) { const int kk = kr + 32 * i; v[i] = (f32x4){0.f, 0.f, 0.f, 0.f}; if (oc >= 0 && !(mode == 5 && k0 + kk >= 128)) { v[i] = __builtin_nontemporal_load((const f32x4*)(src + (size_t)(k0 + kk) * Nsrc + oc)); if (fold) v[i] = v[i] * fold[k0 + kk]; } }
    __syncthreads();
#pragma unroll
    for (int i = 0; i < KT / 32; ++i) *(f32x4*)(tile + (kr + 32 * i) * 68 + c4) = v[i];
    __syncthreads();
#pragma unroll
    for (int h = 0; h < KT / 64; ++h) { const int nn = tid & 63, kc = h * 64 + (tid >> 6) * 8; const float* tp = tile + kc * 68 + nn; u32x4 w;
      w.x = cvt2(tp[0], tp[68]); w.y = cvt2(tp[136], tp[204]); w.z = cvt2(tp[272], tp[340]); w.w = cvt2(tp[408], tp[476]);
      *(u32x4*)(dst + (size_t)(n0 + nn) * K + k0 + kc) = w; }
}

constexpr int PREP_T_IN = 60 * 4, PREP_T_UQ = 8 * 1, PREP_T_UKV = 8 * 1, PREP_T_SQ = 16 * 4, PREP_T_PP = 16 * 1;
constexpr int PREP_PER_LAYER = PREP_T_IN + PREP_T_UQ + PREP_T_UKV + 2 * PREP_T_SQ + PREP_T_PP;
constexpr int PREP_LUT_UNITS = 8 * 4096 / 512, PREP_ROPE_UNITS = 4096 * 16 / 512;
constexpr int PREP_X_UNITS = NT / 32, PREP_P_UNITS = 2 * NT / 64;
constexpr int PREP_UNITS = 2 * PREP_PER_LAYER + PREP_LUT_UNITS + PREP_ROPE_UNITS + PREP_X_UNITS + PREP_P_UNITS;

DEVINL void prep_w_unit(const Params& P, int l, int r, float* tile) {
    if (r < PREP_T_IN) { transpose_tile<256>(P.w_in + (size_t)l * 1024 * INW, INW, (bf16_t*)(P.ws + OFF_WT_IN + l * SZ_WT_IN), 1024, r % 60, r / 60, 1, P.ln_g + l * DM, tile); return; }
    r -= PREP_T_IN;
    if (r < PREP_T_UQ) { transpose_tile<256>(P.w_uq + (size_t)l * 256 * 384, 384, (bf16_t*)(P.ws + OFF_WT_UQ + l * SZ_WT_UQ), 256, r % 8, r / 8, 4, P.mla_q_norm + l * 256, tile); return; }
    r -= PREP_T_UQ;
    if (r < PREP_T_UKV) { transpose_tile<256>(P.w_ukv + (size_t)l * 128 * 512, 512, (bf16_t*)(P.ws + OFF_WT_UKV + l * SZ_WT_UKV), 256, r % 8, r / 8, 5, P.mla_kv_norm + l * 128, tile); return; }
    r -= PREP_T_UKV;
    if (r < PREP_T_SQ) { transpose_tile<256>(P.w_out + (size_t)l * 1024 * 1024, 1024, (bf16_t*)(P.ws + OFF_WT_OUT + l * SZ_WT_SQ), 1024, r % 16, r / 16, 3, nullptr, tile); return; }
    r -= PREP_T_SQ;
    if (r < PREP_T_SQ) { transpose_tile<256>(P.w_ple_gate + (size_t)l * 1024 * 1024, 1024, (bf16_t*)(P.ws + OFF_WT_PG + l * SZ_WT_SQ), 1024, r % 16, r / 16, 3, P.ple_norm_g + l * DM, tile); return; }
    r -= PREP_T_SQ;
    transpose_tile<256>(P.w_ple_proj + (size_t)l * 256 * 1024, 1024, (bf16_t*)(P.ws + OFF_WT_PP + l * SZ_WT_PP), 256, r % 16, r / 16, 3, nullptr, tile);
}
DEVINL void prep_p_unit(const Params& P, int v) {
    const int wid = ltid() >> 6, lane = ltid() & 63; f32x4 a[8];
#pragma unroll
    for (int rr = 0; rr < 8; ++rr) a[rr] = __builtin_nontemporal_load((const f32x4*)(P.p + (size_t)(v * 64 + wid * 8 + rr) * 256 + lane * 4));
#pragma unroll
    for (int rr = 0; rr < 8; ++rr) { const int row = v * 64 + wid * 8 + rr; u32x2 w; w.x = cvt2(a[rr][0], a[rr][1]); w.y = cvt2(a[rr][2], a[rr][3]);
        bf16_t* pb = row < NT ? (bf16_t*)(P.ws + OFF_PB) + (size_t)row * 256 : (bf16_t*)(P.ws + OFF_PB2) + (size_t)(row - NT) * 256; *(u32x2*)(pb + lane * 4) = w; }
}
DEVINL void phase_prep(const Params& P, char* smem) {
    float* tile = (float*)smem;
    if (blockIdx.x == 0 && ltid() < 8) {
        const int l = ltid() >> 2, md = ltid() & 3; float bound;
        auto amax = [](const float* p, int n) { float a = 0.f; for (int i = 0; i < n; ++i) a = fmaxf(a, fabsf(p[i])); return a; };
        if (md == 2) { const float nq = amax(P.mla_nope_gain + (l * 2 + 0) * 64, 64), nk = amax(P.mla_nope_gain + (l * 2 + 1) * 64, 64), rq = amax(P.mla_rope_gain + (l * 2 + 0) * 32, 32), rk = amax(P.mla_rope_gain + (l * 2 + 1) * 32, 32);
            bound = sqrtf(64.f * nq * nq + 32.f * rq * rq) * sqrtf(64.f * nk * nk + 32.f * rk * rk) * SC_MLA; }
        else { const int mix = md == 0 ? 0 : (md == 1 ? 1 : 2); bound = 64.f * amax(P.qk_gain + (l * 6 + 2 * mix) * 64, 64) * amax(P.qk_gain + (l * 6 + 2 * mix + 1) * 64, 64) * SC_Q;
            if (md == 0) bound += 8.f; else bound += amax(P.rel_bias, 256) * LOG2E; }
        ((float*)(P.ws + OFF_BOUND))[l * 4 + md] = bound;
    }
    constexpr int U_W = PREP_PER_LAYER, U_LUT = U_W + PREP_LUT_UNITS, U_ROPE = U_LUT + PREP_ROPE_UNITS, U_X = U_ROPE + PREP_X_UNITS, U_P = U_X + PREP_P_UNITS / 2;
    for (int u = blockIdx.x; u < U_P; u += gridDim.x) {
        if (u < U_W) { if (u < PREP_T_IN + PREP_T_UQ + PREP_T_UKV) prep_w_unit(P, 0, u, tile); }
        else if (u < U_LUT) { const int e = (u - U_W) * 512 + ltid(), hh = e >> 12, d = e & 4095; ((float*)(P.ws + OFF_LUT))[e] = P.rel_bias[t5_bucket(d) * 8 + hh] * LOG2E; }
        else if (u < U_ROPE) { const int e = (u - U_LUT) * 512 + ltid(), pos = e >> 4, i = e & 15;
            const double rev = (double)pos * (double)ROPE_INV[i] * 0.15915494309189535; const float fr = (float)(rev - floor(rev));
            ((float2*)(P.ws + OFF_ROPE))[e] = make_float2(__builtin_amdgcn_cosf(fr), __builtin_amdgcn_sinf(fr)); }
        else if (u < U_X) { const int v = u - U_ROPE, wid = ltid() >> 6, lane = ltid() & 63;
            f32x4 a[4][4];
#pragma unroll
            for (int rr = 0; rr < 4; ++rr)
#pragma unroll
                for (int i = 0; i < 4; ++i) a[rr][i] = __builtin_nontemporal_load((const f32x4*)(P.x + (size_t)(v * 32 + wid * 4 + rr) * DM + i * 256 + lane * 4));
#pragma unroll
            for (int rr = 0; rr < 4; ++rr) { const int row = v * 32 + wid * 4 + rr; float ss = 0.f;
#pragma unroll
                for (int i = 0; i < 4; ++i) { ss += sq4(a[rr][i]); u32x2 w; w.x = cvt2(a[rr][i][0], a[rr][i][1]); w.y = cvt2(a[rr][i][2], a[rr][i][3]); *(u32x2*)((bf16_t*)(P.ws + OFF_H) + (size_t)row * DM + i * 256 + lane * 4) = w; }
                ss = wave_sum(ss); if (lane < 16) ((float*)(P.ws + OFF_SSQX))[(size_t)row * 16 + lane] = lane == 0 ? ss : 0.f;
                if (lane < 16) *(u32x4*)((bf16_t*)(P.ws + OFF_CKV) + (size_t)row * 256 + 128 + lane * 8) = (u32x4){0u, 0u, 0u, 0u}; } }
        else {   }
    }
}

DEVINL void phase_rms(const float* src, const float* g, bf16_t* dst, const float* psrc, bf16_t* pb) {
    const int wid = ltid() >> 6, lane = ltid() & 63;
    for (int u = blockIdx.x; u < NT / 8; u += gridDim.x) {
        const int row = u * 8 + wid; const float* xr = src + (size_t)row * DM;
        f32x4 v[4]; float ss = 0.f;
#pragma unroll
        for (int i = 0; i < 4; ++i) { v[i] = *(const f32x4*)(xr + i * 256 + lane * 4); ss += v[i][0] * v[i][0] + v[i][1] * v[i][1] + v[i][2] * v[i][2] + v[i][3] * v[i][3]; }
        ss = wave_sum(ss); const float r = rsqrtf(ss * (1.0f / DM) + EPS);
#pragma unroll
        for (int i = 0; i < 4; ++i) { const f32x4 gg = *(const f32x4*)(g + i * 256 + lane * 4); u32x2 w; w.x = pack2(v[i][0] * r * gg[0], v[i][1] * r * gg[1]); w.y = pack2(v[i][2] * r * gg[2], v[i][3] * r * gg[3]);
            *(u32x2*)(dst + (size_t)row * DM + i * 256 + lane * 4) = w; }
        if (psrc) { const f32x4 pv = *(const f32x4*)(psrc + (size_t)row * 256 + lane * 4); u32x2 w; w.x = pack2(pv[0], pv[1]); w.y = pack2(pv[2], pv[3]); *(u32x2*)(pb + (size_t)row * 256 + lane * 4) = w; }
    }
}

constexpr int GST = 40;
template <class Epi>
DEVINL void gemm_phase(const bf16_t* A, const bf16_t* Bt, int M, int N, int K, const Epi& epi, char* smem) {
    bf16_t* As = (bf16_t*)smem; bf16_t* Bs = As + 256 * GST;
    const int tid = ltid(), wid = tid >> 6, lane = tid & 63, wr = wid >> 1, wc = wid & 1, fr = lane & 15, fq = lane >> 4;
    const int ntm = M / 256, ntn = N / 128, nk = K / 32;
    const int lr = tid >> 2, lc = (tid & 3) * 8;
    for (int tile = blockIdx.x; tile < ntm * ntn; tile += gridDim.x) {
        const int tm = tile % ntm, tn = tile / ntm;
        const bf16_t* Ag = A + (size_t)(tm * 256 + lr) * K + lc; const bf16_t* Bg = Bt + (size_t)(tn * 128 + lr) * K + lc;
        f32x4 acc[4][4];
#pragma unroll
        for (int m = 0; m < 4; ++m)
#pragma unroll
            for (int n = 0; n < 4; ++n) acc[m][n] = (f32x4){0.f, 0.f, 0.f, 0.f};
        u32x4 ra0 = *(const u32x4*)Ag, ra1 = *(const u32x4*)(Ag + (size_t)128 * K), rb0 = *(const u32x4*)Bg;
        for (int kt = 0; kt < nk; ++kt) {
            __syncthreads();
            *(u32x4*)(As + lr * GST + lc) = ra0; *(u32x4*)(As + (lr + 128) * GST + lc) = ra1; *(u32x4*)(Bs + lr * GST + lc) = rb0;
            __syncthreads();
            if (kt + 1 < nk) { const int ko = (kt + 1) * 32; ra0 = *(const u32x4*)(Ag + ko); ra1 = *(const u32x4*)(Ag + (size_t)128 * K + ko); rb0 = *(const u32x4*)(Bg + ko); }
            bf16x8 af[4], bfr[4];
#pragma unroll
            for (int m = 0; m < 4; ++m) af[m] = *(const bf16x8*)(As + (wr * 64 + m * 16 + fr) * GST + fq * 8);
#pragma unroll
            for (int n = 0; n < 4; ++n) bfr[n] = *(const bf16x8*)(Bs + (wc * 64 + n * 16 + fr) * GST + fq * 8);
#pragma unroll
            for (int m = 0; m < 4; ++m)
#pragma unroll
                for (int n = 0; n < 4; ++n) acc[m][n] = __builtin_amdgcn_mfma_f32_16x16x32_bf16(bfr[n], af[m], acc[m][n], 0, 0, 0);
        }
        epi(acc, tm * 256 + wr * 64, tn * 2 + wc, fr, fq);
    }
    __syncthreads();
}

DEVINL float quad_sum(float v) { v += swz_xor<16>(v); return half_swap_sum(v); }
DEVINL void store4bf(bf16_t* p, float a, float b, float c, float d) { u32x2 w; w.x = pack2(a, b); w.y = pack2(c, d); *(u32x2*)p = w; }
DEVINL float fsigmoid(float z) { return __builtin_amdgcn_rcpf(1.0f + __builtin_amdgcn_exp2f(-LOG2E * z)); }
DEVINL float log_sigmoid(float z) { return fminf(z, 0.f) - log1pf(__expf(-fabsf(z))); }

struct EpiIn {
    Params P; int l;
    DEVINL void operator()(f32x4 (&acc)[4][4], int row0, int chunk, int fr, int fq) const {
        char* ws = P.ws; char* ob = (char*)P.out;
        if (chunk < 36) {
            const int g = chunk >> 2, h = chunk & 3, role = g % 3, mix = g / 3;
            bf16_t* dst = (bf16_t*)(ws + OFF_QKV + (size_t)g * SZ_HEADBUF);
            const float* gain = P.qk_gain + ((size_t)l * 6 + 2 * mix + (role == 1 ? 1 : 0)) * 64;
#pragma unroll
            for (int m = 0; m < 4; ++m) {
                const int t = row0 + 16 * m + fr, b = t >> 12, s = t & 4095; bf16_t* d = dst + ((size_t)(b * 4 + h) * SEQ + s) * 64 + 4 * fq;
                float r = 1.f;
                if (role != 2) { float ss = 0.f;
#pragma unroll
                    for (int n = 0; n < 4; ++n) ss += acc[m][n][0] * acc[m][n][0] + acc[m][n][1] * acc[m][n][1] + acc[m][n][2] * acc[m][n][2] + acc[m][n][3] * acc[m][n][3];
                    ss = quad_sum(ss); r = rsqrtf(ss * (1.0f / 64.0f) + EPS) * (role == 0 ? SC_Q : 1.0f); }
#pragma unroll
                for (int n = 0; n < 4; ++n) { f32x4 gg = (f32x4){1.f, 1.f, 1.f, 1.f}; if (role != 2) gg = *(const f32x4*)(gain + 16 * n + 4 * fq);
                    store4bf(d + 16 * n, acc[m][n][0] * r * gg[0], acc[m][n][1] * r * gg[1], acc[m][n][2] * r * gg[2], acc[m][n][3] * r * gg[3]); }
            }
        } else if (chunk < 42) {
            const bool isq = chunk < 40; const int c = isq ? chunk - 36 : chunk - 40;
            bf16_t* dst = isq ? (bf16_t*)(ws + OFF_CQ) : (bf16_t*)(ws + OFF_CKV); const int ld = isq ? 256 : 128;
            float* ssp = isq ? (float*)(ws + OFF_CQSS) : (float*)(ws + OFF_CKVSS); const int nss = isq ? 4 : 2;
#pragma unroll
            for (int m = 0; m < 4; ++m) {
                const int t = row0 + 16 * m + fr; float ss = 0.f;
#pragma unroll
                for (int n = 0; n < 4; ++n) { ss += acc[m][n][0] * acc[m][n][0] + acc[m][n][1] * acc[m][n][1] + acc[m][n][2] * acc[m][n][2] + acc[m][n][3] * acc[m][n][3];
                    store4bf(dst + (size_t)t * ld + c * 64 + 16 * n + 4 * fq, acc[m][n][0], acc[m][n][1], acc[m][n][2], acc[m][n][3]); }
                ss = quad_sum(ss); if (fq == 0) ssp[(size_t)t * nss + c] = ss;
            }
        } else if (chunk == 42) {
            const float* gr = P.mla_rope_gain + ((size_t)l * 2 + 1) * 32; const float2* rope = (const float2*)(ws + OFF_ROPE);
            bf16_t* km = (bf16_t*)(ob + OOFF_KM); float* logf_ = (float*)(ws + OFF_LOGF);
            const f32x4 g1 = *(const f32x4*)(gr + 4 * fq), g2 = *(const f32x4*)(gr + 16 + 4 * fq); const f32x4 bfv = *(const f32x4*)(P.b_forget + l * 4);
#pragma unroll
            for (int m = 0; m < 4; ++m) {
                const int t = row0 + 16 * m + fr, b = t >> 12, s = t & 4095;
                float ss = 0.f;
#pragma unroll
                for (int n = 0; n < 2; ++n) ss += acc[m][n][0] * acc[m][n][0] + acc[m][n][1] * acc[m][n][1] + acc[m][n][2] * acc[m][n][2] + acc[m][n][3] * acc[m][n][3];
                ss = quad_sum(ss); const float r = rsqrtf(ss * (1.0f / 32.0f) + EPS);
                float o1[4], o2[4];
#pragma unroll
                for (int j = 0; j < 4; ++j) { const float2 cs = rope[s * 16 + 4 * fq + j]; const float x1 = acc[m][0][j] * r * g1[j], x2 = acc[m][1][j] * r * g2[j]; o1[j] = x1 * cs.x - x2 * cs.y; o2[j] = x1 * cs.y + x2 * cs.x; }
#pragma unroll
                for (int h = 0; h < 4; ++h) { bf16_t* d = km + ((size_t)(b * 4 + h) * SEQ + s) * 96 + 64 + 4 * fq; store4bf(d, o1[0], o1[1], o1[2], o1[3]); store4bf(d + 16, o2[0], o2[1], o2[2], o2[3]); }
                if (fq == 0) {
#pragma unroll
                    for (int j = 0; j < 4; ++j) logf_[(size_t)(b * 4 + j) * SEQ + s] = log_sigmoid(acc[m][2][j] + bfv[j]) * LOG2E;
                }
            }
        } else if (chunk >= 44) {
            bf16_t* G = (bf16_t*)(ob + OOFF_G); const int c0 = (chunk - 44) * 64;
#pragma unroll
            for (int m = 0; m < 4; ++m) { const int t = row0 + 16 * m + fr;
#pragma unroll
                for (int n = 0; n < 4; ++n) { float o[4];
#pragma unroll
                    for (int j = 0; j < 4; ++j) { const float z = acc[m][n][j]; o[j] = z / (1.0f + __expf(-z)); }
                    store4bf(G + (size_t)t * DM + c0 + 16 * n + 4 * fq, o[0], o[1], o[2], o[3]); } }
        }
    }
};

struct EpiUq {
    Params P; int l;
    DEVINL void operator()(f32x4 (&acc)[4][4], int row0, int chunk, int fr, int fq) const {
        const float* cqss = (const float*)(P.ws + OFF_CQSS); bf16_t* qm = (bf16_t*)((char*)P.out + OOFF_QM); const float2* rope = (const float2*)(P.ws + OFF_ROPE);
#pragma unroll
        for (int m = 0; m < 4; ++m) {
            const int t = row0 + 16 * m + fr, b = t >> 12, s = t & 4095; const f32x4 pss = *(const f32x4*)(cqss + (size_t)t * 4);
            const float rt = rsqrtf((pss[0] + pss[1] + pss[2] + pss[3]) * (1.0f / 256.0f) + EPS);
            if (chunk < 4) {
                const float* gain = P.mla_nope_gain + ((size_t)l * 2 + 0) * 64; float ss = 0.f;
#pragma unroll
                for (int n = 0; n < 4; ++n) { acc[m][n] = acc[m][n] * rt; ss += acc[m][n][0] * acc[m][n][0] + acc[m][n][1] * acc[m][n][1] + acc[m][n][2] * acc[m][n][2] + acc[m][n][3] * acc[m][n][3]; }
                ss = quad_sum(ss); const float r = rsqrtf(ss * (1.0f / 64.0f) + EPS) * SC_MLA; bf16_t* d = qm + ((size_t)(b * 4 + chunk) * SEQ + s) * 96 + 4 * fq;
#pragma unroll
                for (int n = 0; n < 4; ++n) { const f32x4 gg = *(const f32x4*)(gain + 16 * n + 4 * fq); store4bf(d + 16 * n, acc[m][n][0] * r * gg[0], acc[m][n][1] * r * gg[1], acc[m][n][2] * r * gg[2], acc[m][n][3] * r * gg[3]); }
            } else {
                const float* gr = P.mla_rope_gain + ((size_t)l * 2 + 0) * 32; const f32x4 g1 = *(const f32x4*)(gr + 4 * fq), g2 = *(const f32x4*)(gr + 16 + 4 * fq);
#pragma unroll
                for (int hh = 0; hh < 2; ++hh) {
                    const int h = (chunk - 4) * 2 + hh; float ss = 0.f;
#pragma unroll
                    for (int n = 0; n < 2; ++n) { acc[m][2 * hh + n] = acc[m][2 * hh + n] * rt; const f32x4 a = acc[m][2 * hh + n]; ss += a[0] * a[0] + a[1] * a[1] + a[2] * a[2] + a[3] * a[3]; }
                    ss = quad_sum(ss); const float r = rsqrtf(ss * (1.0f / 32.0f) + EPS);
                    float o1[4], o2[4];
#pragma unroll
                    for (int j = 0; j < 4; ++j) { const float2 cs = rope[s * 16 + 4 * fq + j]; const float x1 = acc[m][2 * hh][j] * r * g1[j], x2 = acc[m][2 * hh + 1][j] * r * g2[j];
                        o1[j] = (x1 * cs.x - x2 * cs.y) * SC_MLA; o2[j] = (x1 * cs.y + x2 * cs.x) * SC_MLA; }
                    bf16_t* d = qm + ((size_t)(b * 4 + h) * SEQ + s) * 96 + 64 + 4 * fq; store4bf(d, o1[0], o1[1], o1[2], o1[3]); store4bf(d + 16, o2[0], o2[1], o2[2], o2[3]);
                }
            }
        }
    }
};
struct EpiUkv {
    Params P; int l;
    DEVINL void operator()(f32x4 (&acc)[4][4], int row0, int chunk, int fr, int fq) const {
        const float* ckvss = (const float*)(P.ws + OFF_CKVSS); bf16_t* km = (bf16_t*)((char*)P.out + OOFF_KM); bf16_t* vm = (bf16_t*)((char*)P.out + OOFF_VM);
        const int h = chunk >> 1; const bool isk = (chunk & 1) == 0; const float* gain = P.mla_nope_gain + ((size_t)l * 2 + 1) * 64;
#pragma unroll
        for (int m = 0; m < 4; ++m) {
            const int t = row0 + 16 * m + fr, b = t >> 12, s = t & 4095; const float rt = rsqrtf((ckvss[(size_t)t * 2] + ckvss[(size_t)t * 2 + 1]) * (1.0f / 128.0f) + EPS);
            float ss = 0.f;
#pragma unroll
            for (int n = 0; n < 4; ++n) { acc[m][n] = acc[m][n] * rt; ss += acc[m][n][0] * acc[m][n][0] + acc[m][n][1] * acc[m][n][1] + acc[m][n][2] * acc[m][n][2] + acc[m][n][3] * acc[m][n][3]; }
            if (isk) { ss = quad_sum(ss); const float r = rsqrtf(ss * (1.0f / 64.0f) + EPS); bf16_t* d = km + ((size_t)(b * 4 + h) * SEQ + s) * 96 + 4 * fq;
#pragma unroll
                for (int n = 0; n < 4; ++n) { const f32x4 gg = *(const f32x4*)(gain + 16 * n + 4 * fq); store4bf(d + 16 * n, acc[m][n][0] * r * gg[0], acc[m][n][1] * r * gg[1], acc[m][n][2] * r * gg[2], acc[m][n][3] * r * gg[3]); }
            } else { bf16_t* d = vm + ((size_t)(b * 4 + h) * SEQ + s) * 64 + 4 * fq;
#pragma unroll
                for (int n = 0; n < 4; ++n) store4bf(d + 16 * n, acc[m][n][0], acc[m][n][1], acc[m][n][2], acc[m][n][3]); }
        }
    }
};
struct EpiResid { const float* base; float* out;
    DEVINL void operator()(f32x4 (&acc)[4][4], int row0, int chunk, int fr, int fq) const {
#pragma unroll
        for (int m = 0; m < 4; ++m) { const size_t o = (size_t)(row0 + 16 * m + fr) * DM + chunk * 64 + 4 * fq;
#pragma unroll
            for (int n = 0; n < 4; ++n) { const f32x4 bv = *(const f32x4*)(base + o + 16 * n); *(f32x4*)(out + o + 16 * n) = bv + acc[m][n]; } } } };
struct EpiStore { float* out;
    DEVINL void operator()(f32x4 (&acc)[4][4], int row0, int chunk, int fr, int fq) const {
#pragma unroll
        for (int m = 0; m < 4; ++m) { const size_t o = (size_t)(row0 + 16 * m + fr) * DM + chunk * 64 + 4 * fq;
#pragma unroll
            for (int n = 0; n < 4; ++n) *(f32x4*)(out + o + 16 * n) = acc[m][n]; } } };
struct EpiPle { const float* xa; const float* pp; float* out;
    DEVINL void operator()(f32x4 (&acc)[4][4], int row0, int chunk, int fr, int fq) const {
#pragma unroll
        for (int m = 0; m < 4; ++m) { const size_t o = (size_t)(row0 + 16 * m + fr) * DM + chunk * 64 + 4 * fq;
#pragma unroll
            for (int n = 0; n < 4; ++n) { const f32x4 xv = *(const f32x4*)(xa + o + 16 * n), pv = *(const f32x4*)(pp + o + 16 * n); f32x4 r;
#pragma unroll
                for (int j = 0; j < 4; ++j) r[j] = xv[j] + pv[j] / (1.0f + __expf(-acc[m][n][j]));
                *(f32x4*)(out + o + 16 * n) = r; } } } };

namespace pg8 {
#define PG8_LAS __attribute__((address_space(3)))
constexpr int BM = 256, BK = 64, HALF = 128, HTB = HALF * BK * 2  , STAGE_BYTES = 8 * HTB, NXCD = 8, WGM = 8;

__host__ __device__ __forceinline__ int lds_byte(int r, int c) { const int st = (r >> 4) * 2 + (c >> 5), rr = r & 15, cc = c & 31, ob = rr * 64 + cc * 2; return st * 1024 + (ob ^ (((ob >> 9) & 1) << 5)); }
__host__ __device__ __forceinline__ void stage_rc(int b, int& R, int& C) { const int st = b / 1024, sb = b % 1024, swz = sb ^ (((sb >> 9) & 1) << 5); R = (st >> 1) * 16 + swz / 64; C = (st & 1) * 32 + (swz % 64) / 2; }
__host__ __device__ __forceinline__ int perm32(int rho) { const int n = rho >> 4, i = rho & 15; return 8 * (i >> 2) + 4 * n + (i & 3); }

struct Unit { int pm, pn; };
struct Gemm { const bf16_t* A; const bf16_t* Bt; int M, N, K; };

struct StaticOrder {
    int nM, nN, nwg, G, c;
    __host__ __device__ void init(int M, int N, int G_, int c_) { nM = M / BM; nN = N / BM; nwg = nM * nN; G = G_; c = c_; }
    __host__ __device__ bool next(int i, Unit& u) const {
        const long L = (long)i * G + c; if (L >= nwg) return false;
        int wgid = (int)L; { const int q = nwg / NXCD, r = nwg % NXCD, xcd = wgid % NXCD, off = wgid / NXCD; wgid = (xcd < r ? xcd * (q + 1) : r * (q + 1) + (xcd - r) * q) + off; }
        const int nig = WGM * nN, gid = wgid / nig, fm = gid * WGM, gsz = (nM - fm) < WGM ? (nM - fm) : WGM;
        u.pm = fm + ((wgid % nig) % gsz); u.pn = (wgid % nig) / gsz; return true;
    }
    __device__ __forceinline__ void a_ready(const Unit&) const {}
    __device__ __forceinline__ void done(const Unit&) const {}
};

template <class Epi, class Sched, bool ALIGN_EPI = false, bool SP2 = false>
__device__ __forceinline__ void gemm_phase(PG8_LAS unsigned char* lds, const Gemm g, const Sched& S, const Epi& E) {
    const int tid = ltid(), wid = __builtin_amdgcn_readfirstlane(tid >> 6), lane = tid & 63, wr = wid >> 2, wc = wid & 3, fr = lane & 15, fq = lane >> 4;
    const int K = g.K, nt = K / BK;
    unsigned voffA[2], voffB[2];
#pragma unroll
    for (int i = 0; i < 2; ++i) { int R, C; stage_rc(tid * 16 + i * 8192, R, C); const int Rb = Epi::PERM ? ((R & ~31) + perm32(R & 31)) : R;
        voffA[i] = (unsigned)(R * K + C) * 2u; voffB[i] = (unsigned)(Rb * K + C) * 2u; }
    const size_t kstep = (size_t)(BK * 2);
    const size_t hstep = (size_t)HALF * K * 2;
    const size_t tstep = 2 * hstep;
    const unsigned ldsw = (unsigned)wid * 1024u;
    const int aoff = lds_byte(wr * 64 + fr, fq * 8), boff = lds_byte(wc * 32 + fr, fq * 8);
    PG8_LAS unsigned char* ldsA = lds + aoff; PG8_LAS unsigned char* ldsB = lds + 65536 + boff; asm volatile("" : "+v"(ldsA), "+v"(ldsB));
#define PG8_SA(b, h) (((b) * 2 + (h)) * HTB)
#define PG8_SB(b, h) ((4 + (b) * 2 + (h)) * HTB)
#define PG8_STAGE(bufoff, gbase, voff) do { _Pragma("unroll") for (int _i = 0; _i < 2; ++_i) \
        __builtin_amdgcn_global_load_lds((const unsigned*)((const char*)(gbase) + (voff)[_i]), (PG8_LAS unsigned*)(lds + (bufoff) + ldsw + _i * 8192), 16, 0, 0); } while (0)
#define PG8_LDA(dst, b, h) do { _Pragma("unroll") for (int m = 0; m < 4; ++m) _Pragma("unroll") for (int k = 0; k < 2; ++k) dst[m][k] = *(const PG8_LAS bf16x8*)(ldsA + PG8_SA(b, h) + m * 2048 + k * 1024); } while (0)
#define PG8_LDB(dst, b, h) do { _Pragma("unroll") for (int n = 0; n < 2; ++n) _Pragma("unroll") for (int k = 0; k < 2; ++k) dst[n][k] = *(const PG8_LAS bf16x8*)(ldsB + (PG8_SB(b, h) - 65536) + n * 2048 + k * 1024); } while (0)
#define PG8_MMA(ai, bj, At, Bt) do { __builtin_amdgcn_s_setprio(1); _Pragma("unroll") for (int m = 0; m < 4; ++m) _Pragma("unroll") for (int n = 0; n < 2; ++n) _Pragma("unroll") for (int k = 0; k < 2; ++k) \
        acc[ai][bj][m][n] = __builtin_amdgcn_mfma_f32_16x16x32_bf16(Bt[n][k], At[m][k], acc[ai][bj][m][n], 0, 0, 0); __builtin_amdgcn_s_setprio(0); } while (0)
#define PG8_WAIT_V(n) asm volatile("s_waitcnt vmcnt(" #n ")" ::: "memory")
#define PG8_WAIT_L(n) asm volatile("s_waitcnt lgkmcnt(" #n ")" ::: "memory")
#define PG8_BAR __builtin_amdgcn_s_barrier()
#define PG8_SCHED __builtin_amdgcn_sched_barrier(0)
    Unit cur, nxt; int ui = 0;
    if (!S.next(0, cur)) return;
    f32x4 acc[2][2][4][2];
#pragma unroll
    for (int a = 0; a < 2; ++a)
#pragma unroll
        for (int b = 0; b < 2; ++b)
#pragma unroll
            for (int m = 0; m < 4; ++m)
#pragma unroll
                for (int n = 0; n < 2; ++n) acc[a][b][m][n] = (f32x4){0.f, 0.f, 0.f, 0.f};
    bf16x8 At[4][2], B0[2][2], B1[2][2];
    const char* cA = (const char*)g.A + (size_t)cur.pm * tstep; const char* cB = (const char*)g.Bt + (size_t)cur.pn * tstep;
    S.a_ready(cur);
    if constexpr (SP2) {
        PG8_STAGE(PG8_SB(0, 0), cB, voffB); PG8_STAGE(PG8_SB(0, 1), cB + hstep, voffB); PG8_STAGE(PG8_SA(0, 0), cA, voffA); PG8_STAGE(PG8_SA(0, 1), cA + hstep, voffA);
        if (wr == 1) PG8_BAR;
        PG8_WAIT_V(2); PG8_BAR;
        PG8_STAGE(PG8_SB(1, 0), cB + kstep, voffB); PG8_STAGE(PG8_SA(1, 0), cA + kstep, voffA); PG8_STAGE(PG8_SB(1, 1), cB + hstep + kstep, voffB);
        PG8_WAIT_V(6); PG8_BAR;
    } else {
        PG8_STAGE(PG8_SB(0, 0), cB, voffB); PG8_STAGE(PG8_SA(0, 0), cA, voffA); PG8_STAGE(PG8_SB(0, 1), cB + hstep, voffB); PG8_STAGE(PG8_SA(0, 1), cA + hstep, voffA);
        if (wr == 1) PG8_BAR;
        PG8_WAIT_V(4); PG8_BAR;
        PG8_STAGE(PG8_SB(1, 0), cB + kstep, voffB); PG8_STAGE(PG8_SA(1, 0), cA + kstep, voffA); PG8_STAGE(PG8_SB(1, 1), cB + hstep + kstep, voffB);
        PG8_WAIT_V(6); PG8_BAR;
    }
    for (;;) {
        const bool has_next = S.next(ui + 1, nxt);
        const char* nA = has_next ? (const char*)g.A + (size_t)nxt.pm * tstep : cA; const char* nB = has_next ? (const char*)g.Bt + (size_t)nxt.pn * tstep : cB;
        for (int t = 0; t < nt; t += 2) {
            const bool last = (t == nt - 2);
            const char* a1 = cA + (size_t)(t + 1) * kstep;
            const char* a2 = last ? nA : cA + (size_t)(t + 2) * kstep; const char* b2 = last ? nB : cB + (size_t)(t + 2) * kstep;
            const char* a3 = a2 + kstep; const char* b3 = b2 + kstep;
            if (last && has_next) S.a_ready(nxt);
            if constexpr (SP2) {
            PG8_LDB(B0, 0, 0); PG8_LDB(B1, 0, 1); PG8_SCHED; PG8_LDA(At, 0, 0); PG8_STAGE(PG8_SA(1, 1), a1 + hstep, voffA);
            PG8_WAIT_V(8); PG8_WAIT_L(0); PG8_BAR; PG8_MMA(0, 0, At, B0); PG8_MMA(0, 1, At, B1); PG8_BAR; PG8_SCHED;
            PG8_LDA(At, 0, 1); PG8_STAGE(PG8_SB(0, 0), b2, voffB); PG8_STAGE(PG8_SB(0, 1), b2 + hstep, voffB); PG8_STAGE(PG8_SA(0, 0), a2, voffA);
            PG8_WAIT_V(8); PG8_WAIT_L(0); PG8_BAR; PG8_MMA(1, 0, At, B0); PG8_MMA(1, 1, At, B1); PG8_BAR; PG8_SCHED;
            PG8_LDB(B0, 1, 0); PG8_LDB(B1, 1, 1); PG8_SCHED; PG8_LDA(At, 1, 0); PG8_STAGE(PG8_SA(0, 1), a2 + hstep, voffA);
            PG8_WAIT_V(8); PG8_WAIT_L(0); PG8_BAR; PG8_MMA(0, 0, At, B0); PG8_MMA(0, 1, At, B1); PG8_BAR; PG8_SCHED;
            PG8_LDA(At, 1, 1); PG8_STAGE(PG8_SB(1, 0), b3, voffB); PG8_STAGE(PG8_SB(1, 1), b3 + hstep, voffB); PG8_STAGE(PG8_SA(1, 0), a3, voffA);
            PG8_WAIT_V(8); PG8_WAIT_L(0); PG8_BAR; PG8_MMA(1, 0, At, B0); PG8_MMA(1, 1, At, B1); PG8_BAR; PG8_SCHED;
            } else {
            PG8_LDB(B0, 0, 0); PG8_SCHED; PG8_LDA(At, 0, 0); PG8_STAGE(PG8_SA(1, 1), a1 + hstep, voffA);
            PG8_WAIT_L(8); PG8_BAR; PG8_WAIT_L(0); PG8_MMA(0, 0, At, B0); PG8_BAR; PG8_SCHED;
            PG8_LDB(B1, 0, 1); PG8_STAGE(PG8_SB(0, 0), b2, voffB);
            PG8_BAR; PG8_WAIT_L(0); PG8_MMA(0, 1, At, B1); PG8_BAR;
            PG8_LDA(At, 0, 1); PG8_STAGE(PG8_SA(0, 0), a2, voffA);
            PG8_BAR; PG8_WAIT_L(0); PG8_MMA(1, 0, At, B0); PG8_BAR; PG8_SCHED;
            PG8_STAGE(PG8_SB(0, 1), b2 + hstep, voffB);
            PG8_WAIT_V(6); PG8_BAR; PG8_MMA(1, 1, At, B1); PG8_BAR;
            PG8_LDB(B0, 1, 0); PG8_SCHED; PG8_LDA(At, 1, 0); PG8_STAGE(PG8_SA(0, 1), a2 + hstep, voffA);
            PG8_WAIT_L(8); PG8_BAR; PG8_WAIT_L(0); PG8_MMA(0, 0, At, B0); PG8_BAR; PG8_SCHED;
            PG8_LDB(B1, 1, 1); PG8_STAGE(PG8_SB(1, 0), b3, voffB);
            PG8_BAR; PG8_WAIT_L(0); PG8_MMA(0, 1, At, B1); PG8_BAR;
            PG8_LDA(At, 1, 1); PG8_STAGE(PG8_SA(1, 0), a3, voffA);
            PG8_BAR; PG8_WAIT_L(0); PG8_MMA(1, 0, At, B0); PG8_BAR; PG8_SCHED;
            PG8_STAGE(PG8_SB(1, 1), b3 + hstep, voffB);
            PG8_WAIT_V(6); PG8_BAR; PG8_MMA(1, 1, At, B1); PG8_BAR;
            }
        }
        if constexpr (ALIGN_EPI) { if (wr == 0) PG8_BAR; }
        if constexpr (!Epi::AFTER_DRAIN) { E(acc, cur, wr, wc, fr, fq); S.done(cur); }
        if (!has_next) break;
#pragma unroll
        for (int a = 0; a < 2; ++a)
#pragma unroll
            for (int b = 0; b < 2; ++b)
#pragma unroll
                for (int m = 0; m < 4; ++m)
#pragma unroll
                    for (int n = 0; n < 2; ++n) acc[a][b][m][n] = (f32x4){0.f, 0.f, 0.f, 0.f};
        cur = nxt; cA = nA; cB = nB; ++ui;
        if constexpr (ALIGN_EPI) { if (wr == 1) PG8_BAR; }
    }
    PG8_WAIT_V(0);
    if constexpr (!ALIGN_EPI) { if (wr == 0) PG8_BAR; }
    PG8_BAR;
    if constexpr (Epi::AFTER_DRAIN) { E.fused(acc, cur, wr, wc, fr, fq, lds, wid, lane); S.done(cur); }
#undef PG8_SA
#undef PG8_SB
#undef PG8_STAGE
#undef PG8_LDA
#undef PG8_LDB
#undef PG8_MMA
#undef PG8_WAIT_V
#undef PG8_WAIT_L
#undef PG8_BAR
#undef PG8_SCHED
}
}


DEVINL u32x4 pack8(const f32x4& a, const f32x4& b) { u32x4 w; w.x = cvt2(a[0], a[1]); w.y = cvt2(a[2], a[3]); w.z = cvt2(b[0], b[1]); w.w = cvt2(b[2], b[3]); return w; }
DEVINL float row_rscale(const float* ssq, int t, int fq) { const f32x4 a = *(const f32x4*)(ssq + (size_t)t * 16 + 4 * fq); return rsqrtf(quad_sum(a[0] + a[1] + a[2] + a[3]) * (1.0f / DM) + EPS); }
struct EpiIn8 {
    static constexpr bool PERM = true, AFTER_DRAIN = false;
    Params P; int l;
    DEVINL void operator()(const f32x4 (&acc0)[2][2][4][2], const pg8::Unit& u, int wr, int wc, int fr, int fq) const {
        { const int t_ = ltid(); fr = t_ & 15; fq = (t_ >> 4) & 3; wc = __builtin_amdgcn_readfirstlane((t_ >> 6) & 3); wr = __builtin_amdgcn_readfirstlane(t_ >> 8); }
        char* ws = P.ws; char* ob = (char*)P.out; const int chunk = u.pn * 4 + wc;
        const float* ssqx = (const float*)(ws + OFF_SSQX);
        if (chunk < 36) {
            const int g = chunk >> 2, h = chunk & 3, role = g % 3, mix = g / 3;
            bf16_t* dst = (bf16_t*)(ws + OFF_QKV + (size_t)g * SZ_HEADBUF);
            const float* gain = P.qk_gain + ((size_t)l * 6 + 2 * mix + (role == 1 ? 1 : 0)) * 64 + 8 * fq;
            f32x4 gg[2][2];
#pragma unroll
            for (int bj = 0; bj < 2; ++bj)
#pragma unroll
                for (int n = 0; n < 2; ++n) gg[bj][n] = role != 2 ? *(const f32x4*)(gain + 32 * bj + 4 * n) : (f32x4){1.f, 1.f, 1.f, 1.f};
#pragma unroll
            for (int ai = 0; ai < 2; ++ai)
#pragma unroll
                for (int m = 0; m < 4; ++m) {
                    const int t = u.pm * 256 + 128 * ai + 64 * wr + 16 * m + fr, b = t >> 12, s = t & 4095; const float rt_ = row_rscale(ssqx, t, fq); const f32x4 a[2][2] = {{acc0[ai][0][m][0] * rt_, acc0[ai][0][m][1] * rt_}, {acc0[ai][1][m][0] * rt_, acc0[ai][1][m][1] * rt_}}; bf16_t* d = dst + ((size_t)(b * 4 + h) * SEQ + s) * 64 + 8 * fq;
                    float r = 1.f;
                    if (role != 2) { float ss = sq4(a[0][0]) + sq4(a[0][1]) + sq4(a[1][0]) + sq4(a[1][1]); ss = quad_sum(ss); r = rsqrtf(ss * (1.0f / 64.0f) + EPS) * (role == 0 ? SC_Q : 1.0f); }
#pragma unroll
                    for (int bj = 0; bj < 2; ++bj) *(u32x4*)(d + 32 * bj) = pack8(a[bj][0] * r * gg[bj][0], a[bj][1] * r * gg[bj][1]);
                }
        } else if (chunk < 42) {
            const bool isq = chunk < 40; const int c = isq ? chunk - 36 : chunk - 40;
            bf16_t* dst = isq ? (bf16_t*)(ws + OFF_CQ) : (bf16_t*)(ws + OFF_CKV); const int ld = 256;
            float* ssp = isq ? (float*)(ws + OFF_CQSS) : (float*)(ws + OFF_CKVSS); const int nss = isq ? 4 : 2;
#pragma unroll
            for (int ai = 0; ai < 2; ++ai)
#pragma unroll
                for (int m = 0; m < 4; ++m) {
                    const int t = u.pm * 256 + 128 * ai + 64 * wr + 16 * m + fr; const float rt_ = row_rscale(ssqx, t, fq); const f32x4 a[2][2] = {{acc0[ai][0][m][0] * rt_, acc0[ai][0][m][1] * rt_}, {acc0[ai][1][m][0] * rt_, acc0[ai][1][m][1] * rt_}};
                    float ss = sq4(a[0][0]) + sq4(a[0][1]) + sq4(a[1][0]) + sq4(a[1][1]); ss = quad_sum(ss);
#pragma unroll
                    for (int bj = 0; bj < 2; ++bj) *(u32x4*)(dst + (size_t)t * ld + c * 64 + 32 * bj + 8 * fq) = pack8(a[bj][0], a[bj][1]);
                    if (fq == 0) ssp[(size_t)t * nss + c] = ss;
                }
        } else if (chunk == 42) {
            const float* gr = P.mla_rope_gain + ((size_t)l * 2 + 1) * 32; const float2* rope = (const float2*)(ws + OFF_ROPE);
            bf16_t* km = (bf16_t*)(ob + OOFF_KM); float* logf_ = (float*)(ws + OFF_LOGF);
            const f32x4 g1 = *(const f32x4*)(gr + 4 * fq), g2 = *(const f32x4*)(gr + 16 + 4 * fq); const f32x4 bfv = *(const f32x4*)(P.b_forget + l * 4);
#pragma unroll
            for (int ai = 0; ai < 2; ++ai)
#pragma unroll
                for (int m = 0; m < 4; ++m) {
                    const int t = u.pm * 256 + 128 * ai + 64 * wr + 16 * m + fr, b = t >> 12, s = t & 4095; const float rt_ = row_rscale(ssqx, t, fq); const f32x4 a[2][2] = {{acc0[ai][0][m][0] * rt_, acc0[ai][0][m][1] * rt_}, {acc0[ai][1][m][0] * rt_, acc0[ai][1][m][1] * rt_}};
                    float ss = sq4(a[0][0]) + sq4(a[0][1]); ss = quad_sum(ss); const float r = rsqrtf(ss * (1.0f / 32.0f) + EPS);
                    float o1[4], o2[4];
#pragma unroll
                    for (int j = 0; j < 4; ++j) { const float2 cs = rope[s * 16 + 4 * fq + j]; const float x1 = a[0][0][j] * r * g1[j], x2 = a[0][1][j] * r * g2[j]; o1[j] = x1 * cs.x - x2 * cs.y; o2[j] = x1 * cs.y + x2 * cs.x; }
#pragma unroll
                    for (int h = 0; h < 4; ++h) { bf16_t* d = km + ((size_t)(b * 4 + h) * SEQ + s) * 96 + 64 + 4 * fq; store4bf(d, o1[0], o1[1], o1[2], o1[3]); store4bf(d + 16, o2[0], o2[1], o2[2], o2[3]); }
                    if (fq == 0) {
#pragma unroll
                        for (int j = 0; j < 4; ++j) logf_[(size_t)(b * 4 + j) * SEQ + s] = log_sigmoid(a[1][0][j] + bfv[j]) * LOG2E;
                    }
                }
        } else if (chunk >= 44) {
            bf16_t* G = (bf16_t*)(ob + OOFF_G); const int c0 = (chunk - 44) * 64 + 8 * fq;
#pragma unroll
            for (int ai = 0; ai < 2; ++ai)
#pragma unroll
                for (int m = 0; m < 4; ++m) {
                    const int t = u.pm * 256 + 128 * ai + 64 * wr + 16 * m + fr; const float rt_ = row_rscale(ssqx, t, fq); const f32x4 a[2][2] = {{acc0[ai][0][m][0] * rt_, acc0[ai][0][m][1] * rt_}, {acc0[ai][1][m][0] * rt_, acc0[ai][1][m][1] * rt_}};
#pragma unroll
                    for (int bj = 0; bj < 2; ++bj) { f32x4 o0, o1;
#pragma unroll
                        for (int j = 0; j < 4; ++j) { const float z0 = a[bj][0][j], z1 = a[bj][1][j]; o0[j] = z0 * fsigmoid(z0); o1[j] = z1 * fsigmoid(z1); }
                        *(u32x4*)(G + (size_t)t * DM + c0 + 32 * bj) = pack8(o0, o1); }
                }
        }
    }
};
struct EpiResid8 { static constexpr bool PERM = true, AFTER_DRAIN = false; const float* base; float* out; bf16_t* obf; float* ssq;
    DEVINL void operator()(const f32x4 (&acc)[2][2][4][2], const pg8::Unit& u, int wr, int wc, int fr, int fq) const {
        { const int t_ = ltid(); fr = t_ & 15; fq = (t_ >> 4) & 3; wc = __builtin_amdgcn_readfirstlane((t_ >> 6) & 3); wr = __builtin_amdgcn_readfirstlane(t_ >> 8); }
#pragma unroll
        for (int ai = 0; ai < 2; ++ai)
#pragma unroll
            for (int m = 0; m < 4; ++m) { const int t = u.pm * 256 + 128 * ai + 64 * wr + 16 * m + fr; const size_t o = (size_t)t * DM + u.pn * 256 + 64 * wc + 8 * fq; float ss = 0.f;
#pragma unroll
                for (int bj = 0; bj < 2; ++bj) { const f32x4 v0 = __builtin_nontemporal_load((const f32x4*)(base + o + 32 * bj)) + acc[ai][bj][m][0], v1 = __builtin_nontemporal_load((const f32x4*)(base + o + 32 * bj + 4)) + acc[ai][bj][m][1];
                    *(f32x4*)(out + o + 32 * bj) = v0; *(f32x4*)(out + o + 32 * bj + 4) = v1; *(u32x4*)(obf + o + 32 * bj) = pack8(v0, v1); ss += sq4(v0) + sq4(v1); }
                ss = quad_sum(ss); if (fq == 0) ssq[(size_t)t * 16 + u.pn * 4 + wc] = ss; } } };
struct EpiStoreBf { static constexpr bool PERM = true, AFTER_DRAIN = false; bf16_t* out;
    DEVINL void operator()(const f32x4 (&acc)[2][2][4][2], const pg8::Unit& u, int wr, int wc, int fr, int fq) const {
        { const int t_ = ltid(); fr = t_ & 15; fq = (t_ >> 4) & 3; wc = __builtin_amdgcn_readfirstlane((t_ >> 6) & 3); wr = __builtin_amdgcn_readfirstlane(t_ >> 8); }
#pragma unroll
        for (int ai = 0; ai < 2; ++ai)
#pragma unroll
            for (int m = 0; m < 4; ++m) { const size_t o = (size_t)(u.pm * 256 + 128 * ai + 64 * wr + 16 * m + fr) * DM + u.pn * 256 + 64 * wc + 8 * fq;
#pragma unroll
                for (int bj = 0; bj < 2; ++bj) *(u32x4*)(out + o + 32 * bj) = pack8(acc[ai][bj][m][0], acc[ai][bj][m][1]); } } };
struct EpiPle8 { static constexpr bool PERM = true, AFTER_DRAIN = false; const float* xa; const bf16_t* pp; float* out; const float* ssq_in; bf16_t* obf; float* ssq_out;
    DEVINL void operator()(const f32x4 (&acc)[2][2][4][2], const pg8::Unit& u, int wr, int wc, int fr, int fq) const {
        { const int t_ = ltid(); fr = t_ & 15; fq = (t_ >> 4) & 3; wc = __builtin_amdgcn_readfirstlane((t_ >> 6) & 3); wr = __builtin_amdgcn_readfirstlane(t_ >> 8); }
#pragma unroll
        for (int ai = 0; ai < 2; ++ai)
#pragma unroll
            for (int m = 0; m < 4; ++m) { const int t = u.pm * 256 + 128 * ai + 64 * wr + 16 * m + fr; const size_t o = (size_t)t * DM + u.pn * 256 + 64 * wc + 8 * fq;
                const float rt = row_rscale(ssq_in, t, fq); float ss = 0.f;
#pragma unroll
                for (int bj = 0; bj < 2; ++bj) { const f32x4 x0 = *(const f32x4*)(xa + o + 32 * bj), x1 = *(const f32x4*)(xa + o + 32 * bj + 4); const u32x4 pw = *(const u32x4*)(pp + o + 32 * bj); f32x4 r0, r1;
                    const float pv[8] = {bflo(pw.x), bfhi(pw.x), bflo(pw.y), bfhi(pw.y), bflo(pw.z), bfhi(pw.z), bflo(pw.w), bfhi(pw.w)};
#pragma unroll
                    for (int jj = 0; jj < 4; ++jj) { r0[jj] = x0[jj] + pv[jj] * fsigmoid(rt * acc[ai][bj][m][0][jj]); r1[jj] = x1[jj] + pv[4 + jj] * fsigmoid(rt * acc[ai][bj][m][1][jj]); }
                    __builtin_nontemporal_store(r0, (f32x4*)(out + o + 32 * bj)); __builtin_nontemporal_store(r1, (f32x4*)(out + o + 32 * bj + 4));
                    if (obf) { *(u32x4*)(obf + o + 32 * bj) = pack8(r0, r1); ss += sq4(r0) + sq4(r1); } }
                if (obf) { ss = quad_sum(ss); if (fq == 0) ssq_out[(size_t)t * 16 + u.pn * 4 + wc] = ss; } } } };
struct EpiUq8 { static constexpr bool PERM = true, AFTER_DRAIN = false; Params P; int l;
    DEVINL void operator()(const f32x4 (&acc)[2][2][4][2], const pg8::Unit& u, int wr, int wc, int fr, int fq) const {
        { const int t_ = ltid(); fr = t_ & 15; fq = (t_ >> 4) & 3; wc = __builtin_amdgcn_readfirstlane((t_ >> 6) & 3); wr = __builtin_amdgcn_readfirstlane(t_ >> 8); }
        const int chunk = u.pn * 4 + wc; if (chunk >= 6) return;
        const float* cqss = (const float*)(P.ws + OFF_CQSS); bf16_t* qm = (bf16_t*)((char*)P.out + OOFF_QM); const float2* rope = (const float2*)(P.ws + OFF_ROPE);
#pragma unroll
        for (int ai = 0; ai < 2; ++ai)
#pragma unroll
            for (int m = 0; m < 4; ++m) {
                const int t = u.pm * 256 + 128 * ai + 64 * wr + 16 * m + fr, b = t >> 12, s = t & 4095;
                const float rt = rsqrtf(quad_sum(cqss[(size_t)t * 4 + fq]) * (1.0f / 256.0f) + EPS);
                const f32x4 a[2][2] = {{acc[ai][0][m][0] * rt, acc[ai][0][m][1] * rt}, {acc[ai][1][m][0] * rt, acc[ai][1][m][1] * rt}};
                if (chunk < 4) {
                    const float* gain = P.mla_nope_gain + ((size_t)l * 2 + 0) * 64 + 8 * fq;
                    float ss = sq4(a[0][0]) + sq4(a[0][1]) + sq4(a[1][0]) + sq4(a[1][1]); ss = quad_sum(ss); const float r = rsqrtf(ss * (1.0f / 64.0f) + EPS) * SC_MLA;
                    bf16_t* d = qm + ((size_t)(b * 4 + chunk) * SEQ + s) * 96 + 8 * fq;
#pragma unroll
                    for (int bj = 0; bj < 2; ++bj) { const f32x4 g0 = *(const f32x4*)(gain + 32 * bj), g1 = *(const f32x4*)(gain + 32 * bj + 4); *(u32x4*)(d + 32 * bj) = pack8(a[bj][0] * r * g0, a[bj][1] * r * g1); }
                } else {
                    const float* gr = P.mla_rope_gain + ((size_t)l * 2 + 0) * 32; const f32x4 g1 = *(const f32x4*)(gr + 4 * fq), g2 = *(const f32x4*)(gr + 16 + 4 * fq);
#pragma unroll
                    for (int bj = 0; bj < 2; ++bj) { const int h = (chunk - 4) * 2 + bj;
                        float ss = sq4(a[bj][0]) + sq4(a[bj][1]); ss = quad_sum(ss); const float r = rsqrtf(ss * (1.0f / 32.0f) + EPS);
                        float o1[4], o2[4];
#pragma unroll
                        for (int j = 0; j < 4; ++j) { const float2 cs = rope[s * 16 + 4 * fq + j]; const float x1 = a[bj][0][j] * r * g1[j], x2 = a[bj][1][j] * r * g2[j]; o1[j] = (x1 * cs.x - x2 * cs.y) * SC_MLA; o2[j] = (x1 * cs.y + x2 * cs.x) * SC_MLA; }
                        bf16_t* d = qm + ((size_t)(b * 4 + h) * SEQ + s) * 96 + 64 + 4 * fq; store4bf(d, o1[0], o1[1], o1[2], o1[3]); store4bf(d + 16, o2[0], o2[1], o2[2], o2[3]); }
                }
            }
    }
};
struct EpiUkv8 { static constexpr bool PERM = true, AFTER_DRAIN = false; Params P; int l;
    DEVINL void operator()(const f32x4 (&acc)[2][2][4][2], const pg8::Unit& u, int wr, int wc, int fr, int fq) const {
        { const int t_ = ltid(); fr = t_ & 15; fq = (t_ >> 4) & 3; wc = __builtin_amdgcn_readfirstlane((t_ >> 6) & 3); wr = __builtin_amdgcn_readfirstlane(t_ >> 8); }
        const int chunk = u.pn * 4 + wc, h = chunk >> 1; const bool isk = (chunk & 1) == 0;
        const float* ckvss = (const float*)(P.ws + OFF_CKVSS); bf16_t* km = (bf16_t*)((char*)P.out + OOFF_KM); bf16_t* vm = (bf16_t*)((char*)P.out + OOFF_VM);
        const float* gain = P.mla_nope_gain + ((size_t)l * 2 + 1) * 64 + 8 * fq;
#pragma unroll
        for (int ai = 0; ai < 2; ++ai)
#pragma unroll
            for (int m = 0; m < 4; ++m) {
                const int t = u.pm * 256 + 128 * ai + 64 * wr + 16 * m + fr, b = t >> 12, s = t & 4095;
                const float rt = rsqrtf(quad_sum(fq < 2 ? ckvss[(size_t)t * 2 + fq] : 0.f) * (1.0f / 128.0f) + EPS);
                const f32x4 a[2][2] = {{acc[ai][0][m][0] * rt, acc[ai][0][m][1] * rt}, {acc[ai][1][m][0] * rt, acc[ai][1][m][1] * rt}};
                if (isk) { float ss = sq4(a[0][0]) + sq4(a[0][1]) + sq4(a[1][0]) + sq4(a[1][1]); ss = quad_sum(ss); const float r = rsqrtf(ss * (1.0f / 64.0f) + EPS);
                    bf16_t* d = km + ((size_t)(b * 4 + h) * SEQ + s) * 96 + 8 * fq;
#pragma unroll
                    for (int bj = 0; bj < 2; ++bj) { const f32x4 g0 = *(const f32x4*)(gain + 32 * bj), g1 = *(const f32x4*)(gain + 32 * bj + 4); *(u32x4*)(d + 32 * bj) = pack8(a[bj][0] * r * g0, a[bj][1] * r * g1); }
                } else { bf16_t* d = vm + ((size_t)(b * 4 + h) * SEQ + s) * 64 + 8 * fq;
#pragma unroll
                    for (int bj = 0; bj < 2; ++bj) *(u32x4*)(d + 32 * bj) = pack8(a[bj][0], a[bj][1]); }
            }
    }
};
template <class Epi> DEVINL void gemm8(const bf16_t* A, const bf16_t* Bt, int M, int N, int K, const Epi& E, char* smem) {
    int G = (int)gridDim.x, c = (int)blockIdx.x; asm volatile("" : "+s"(G), "+s"(c));
    pg8::Gemm g{A, Bt, M, N, K}; pg8::StaticOrder S; S.init(M, N, G, c);
    pg8::gemm_phase<Epi, pg8::StaticOrder, true, true>((PG8_LAS unsigned char*)smem, g, S, E);
}

DEVINL void kmean_unit(const Params& P, int u, char* smem) {
    float* red = (float*)smem; const bf16_t* K = (const bf16_t*)(P.ws + OFF_QKV + 4 * SZ_HEADBUF); float* km = (float*)(P.ws + OFF_KMEAN);
    const int tid = ltid(), dc = tid & 7, rg = tid >> 3;
    const bf16_t* kp = K + ((size_t)(u >> 4) * SEQ + (u & 15) * 256 + rg) * 64 + dc * 8;
    u32x4 w[4];
#pragma unroll
    for (int i = 0; i < 4; ++i) w[i] = *(const u32x4*)(kp + (size_t)i * 64 * 64);
    float s[8] = {0.f, 0.f, 0.f, 0.f, 0.f, 0.f, 0.f, 0.f};
#pragma unroll
    for (int i = 0; i < 4; ++i) { s[0] += bflo(w[i].x); s[1] += bfhi(w[i].x); s[2] += bflo(w[i].y); s[3] += bfhi(w[i].y); s[4] += bflo(w[i].z); s[5] += bfhi(w[i].z); s[6] += bflo(w[i].w); s[7] += bfhi(w[i].w); }
    __syncthreads();
#pragma unroll
    for (int e = 0; e < 8; ++e) red[rg * 65 + dc * 8 + e] = s[e];
    __syncthreads();
    if (tid < 64) { float a = 0.f;
#pragma unroll 8
        for (int i = 0; i < 64; ++i) a += red[i * 65 + tid];
        km[(size_t)u * 64 + tid] = a * (1.0f / 256.0f); }
}

typedef float f32x16 __attribute__((ext_vector_type(16)));
typedef short s16x4 __attribute__((ext_vector_type(4)));
typedef short v4i16_t __attribute__((ext_vector_type(4)));
#define LAS __attribute__((address_space(3)))
#define MFMA32(a, b, c) __builtin_amdgcn_mfma_f32_32x32x16_bf16(a, b, c, 0, 0, 0)
DEVINL s16x4 vtr(const LAS char* p) { return __builtin_bit_cast(s16x4, __builtin_amdgcn_ds_read_tr16_b64_v4i16((LAS v4i16_t*)p)); }
DEVINL float swap_max(float v) { auto rr = __builtin_amdgcn_permlane32_swap(__float_as_uint(v), __float_as_uint(v), false, false); return fmaxf(__uint_as_float(rr[0]), __uint_as_float(rr[1])); }
DEVINL float swap_sum(float v) { auto rr = __builtin_amdgcn_permlane32_swap(__float_as_uint(v), __float_as_uint(v), false, false); return __uint_as_float(rr[0]) + __uint_as_float(rr[1]); }
DEVINL float fadd1(float a, float b) { float r; asm("v_add_f32 %0, %1, %2" : "=v"(r) : "v"(a), "v"(b)); return r; }
DEVINL constexpr int crow(int r) { return (r & 3) + 8 * (r >> 2); }

constexpr int KSLOT = 64 * 144, RSLOT = 64 * 80;
constexpr int L_KB = 0, L_VB = 3 * KSLOT, L_KR = L_VB + 16384, L_AUX = L_KR + 3 * RSLOT, L_SCR = L_AUX + 16640 + 256, L_KMS = L_SCR + 2048, L_ATT_END = L_KMS + 4096;
constexpr float NEGBIG = -3.0e38f, THR = 8.0f;

template <int MODE>
DEVINL void attn_unit(const Params& P, int l, int u, char* smem) {
    constexpr int DK = MODE == 2 ? 96 : 64, ND0 = DK / 16;
    LAS char* lds = (LAS char*)smem;
    const int tid = ltid(), lane = tid & 63, r32 = lane & 31, hi = lane >> 5; const int wid = __builtin_amdgcn_readfirstlane(tid >> 6);
    const bool fast = ((const float*)(P.ws + OFF_BOUND))[l * 4 + MODE] < 100.0f;
    int bh, q0, t_lo, t_hi, dil = 1, res = 0, pat = 0, qb = 0;
    if (MODE != 3) { bh = u & 15; qb = 15 - (u >> 4); q0 = qb * 256; t_lo = 0; t_hi = (q0 + 255) >> 6; }
    else { pat = u >> 8; const int v = u & 255; bh = v & 15; const int w = v >> 4; dil = pat == 0 ? 1 : (pat == 1 ? 4 : 16); res = w % dil; q0 = (w / dil) * 256; t_lo = (q0 >= 128 ? q0 - 128 : 0) >> 6; t_hi = (q0 + 255) >> 6; }
    const int b = bh >> 2, h = bh & 3;
    const bf16_t *Qg, *Kg, *Vg; int rsq, rsk, rsv;
    if (MODE == 0) { Qg = (const bf16_t*)(P.ws + OFF_QKV) + (size_t)bh * SEQ * 64; Kg = Qg + SZ_HEADBUF / 2; Vg = Kg + SZ_HEADBUF / 2; rsq = rsk = rsv = 64; }
    else if (MODE == 1) { Qg = (const bf16_t*)(P.ws + OFF_QKV + 3 * SZ_HEADBUF) + (size_t)bh * SEQ * 64; Kg = Qg + SZ_HEADBUF / 2; Vg = Kg + SZ_HEADBUF / 2; rsq = rsk = rsv = 64; }
    else if (MODE == 2) { Qg = (const bf16_t*)((const char*)P.out + OOFF_QM) + (size_t)bh * SEQ * 96; Kg = (const bf16_t*)((const char*)P.out + OOFF_KM) + (size_t)bh * SEQ * 96; Vg = (const bf16_t*)((const char*)P.out + OOFF_VM) + (size_t)bh * SEQ * 64; rsq = rsk = 96; rsv = 64; }
    else { Qg = (const bf16_t*)(P.ws + OFF_QKV + 6 * SZ_HEADBUF) + ((size_t)bh * SEQ + res) * 64; Kg = Qg + SZ_HEADBUF / 2; Vg = Kg + SZ_HEADBUF / 2; rsq = rsk = rsv = 64 * dil; }
    const int qw = q0 + 32 * wid;

    __syncthreads();
    const unsigned kgo = (unsigned)((tid >> 3) * rsk + (tid & 7) * 8), vgo = (unsigned)(((tid >> 2) & 63) * rsv + (tid >> 8) * 32 + (tid & 3) * 8), rgo = (unsigned)(((tid >> 2) & 63) * rsk + 64 + (tid & 3) * 8);
    const int kws = (tid >> 3) * 144 + (tid & 7) * 16;
    const int rws = ((tid >> 2) & 63) * 80 + (tid & 3) * 16;
    u32x4 kA, rA, kB, rB;
#define ATT_LOADK(j, K_, R_) do { if ((j) <= t_hi) { K_ = *(const u32x4*)(Kg + (size_t)(j) * 64 * rsk + kgo); if (MODE == 2 && tid < 256) R_ = *(const u32x4*)(Kg + (size_t)(j) * 64 * rsk + rgo); } } while (0)
#define ATT_DMAV(j, slot) do { if ((j) <= t_hi) __builtin_amdgcn_global_load_lds((const unsigned*)(Vg + (size_t)(j) * 64 * rsv + vgo), (LAS unsigned*)(lds + L_VB + (slot) * 8192 + wid * 1024), 16, 0, 0); } while (0)
#define ATT_WRITEK(slot, j, K_, R_) do { if ((j) <= t_hi) { *(LAS u32x4*)(lds + L_KB + (slot) * KSLOT + kws) = K_; if (MODE == 2 && tid < 256) *(LAS u32x4*)(lds + L_KR + (slot) * RSLOT + rws) = R_; \
        if (MODE == 0 && tid < 64) { const float bs = aux[(j) * 64 + tid] - auxU; const unsigned hb = cvt2(bs, 0.f) & 0xffffu; const float lo = bs - __uint_as_float(hb << 16); u32x4 w; w.x = hb | (cvt2(lo, 0.f) << 16); w.y = 0x3F80u; w.z = 0u; w.w = 0u; \
            *(LAS u32x4*)(lds + L_KR + (slot) * 1024 + tid * 16) = w; } } } while (0)
    bf16x8 qf[ND0];
    { const bf16_t* qp = Qg + (size_t)(qw + r32) * rsq + 8 * hi;
#pragma unroll
      for (int d0 = 0; d0 < ND0; ++d0) qf[d0] = *(const bf16x8*)(qp + 16 * d0); }
    if (MODE != 0) { ATT_LOADK(t_lo, kA, rA); ATT_LOADK(t_lo + 1, kB, rB); }
    LAS float* aux = (LAS float*)(lds + L_AUX);
    if (MODE == 0) {
        LAS float* tot = (LAS float*)(lds + L_SCR);
        const float* lf = (const float*)(P.ws + OFF_LOGF) + (size_t)bh * SEQ + tid * 8; float v[8]; float run = 0.f;
        { const f32x4 a = *(const f32x4*)lf, c = *(const f32x4*)(lf + 4); v[0] = a[0]; v[1] = a[1]; v[2] = a[2]; v[3] = a[3]; v[4] = c[0]; v[5] = c[1]; v[6] = c[2]; v[7] = c[3]; }
#pragma unroll
        for (int i = 0; i < 8; ++i) { run += v[i]; v[i] = run; }
        tot[tid] = run; __syncthreads();
        if (tid < 64) { float a[8]; float acc = 0.f;
#pragma unroll
            for (int i = 0; i < 8; ++i) { acc += tot[tid * 8 + i]; a[i] = acc; }
            float incl = acc;
#pragma unroll
            for (int o = 1; o < 64; o <<= 1) { const float nb = shup(incl, o); if (tid >= o) incl += nb; }
            const float ex = incl - acc; tot[tid * 8] = ex;
#pragma unroll
            for (int i = 1; i < 8; ++i) tot[tid * 8 + i] = ex + a[i - 1]; }
        __syncthreads();
        const float base = tot[tid];
#pragma unroll
        for (int i = 0; i < 8; ++i) aux[tid * 8 + i] = -(base + v[i]);
        if (tid < 4) ((LAS unsigned*)(lds + L_KR + 3072))[tid] = 0u;
    } else if (MODE == 1) {
        const float* lut = (const float*)(P.ws + OFF_LUT) + (size_t)h * 4096;
        for (int i = ((4095 - (q0 + 255)) & ~3) + 4 * tid; i < 4160; i += 4 * NTHREADS) {
            f32x4 v = (f32x4){0.f, 0.f, 0.f, 0.f}; if (i < 4096) { const f32x4 s = *(const f32x4*)(lut + 4092 - i); v = (f32x4){s[3], s[2], s[1], s[0]}; }
            *(LAS f32x4*)(aux + i) = v; }
        if (tid < 64) aux[4160 + tid] = -INFINITY;
        LAS float* kms = (LAS float*)(lds + L_KMS); const float* km = (const float*)(P.ws + OFF_KMEAN) + (size_t)bh * 1024;
        for (int i = tid; i < 1024; i += NTHREADS) kms[i] = km[i];
    } else if (MODE == 3) {
        const float* lut = (const float*)(P.ws + OFF_LUT) + (size_t)(4 + h) * 4096;
        if (tid < 320) { const int rel = 255 - tid; aux[tid] = (rel >= 0 && rel * dil < 4096) ? lut[rel * dil] : 0.f; }
    }
    if (MODE == 0 && fast) {
        __syncthreads();
        const float bnd = ((const float*)(P.ws + OFF_BOUND))[l * 4 + (tid >> 30)];
        const bool sk = (lane <= t_hi) && ((aux[64 * lane + 63] - aux[q0]) + bnd < -150.0f);
        t_lo = (int)__builtin_popcountll(__ballot(sk));
    }
    __syncthreads();
    bf16x8 qx = {0, 0, 0, 0, 0, 0, 0, 0}; float auxU = 0.f;
    if (MODE == 0) { auxU = aux[q0 + 255]; const float sh = auxU - aux[qw + r32];
        if (hi == 0) { u32x4 w; w.x = 0x3F803F80u; w.y = cvt2(sh, 0.f); w.z = 0u; w.w = 0u; qx = __builtin_bit_cast(bf16x8, w); } }
    unsigned sel = 0;
    if (MODE == 1) {
        const LAS float* kms = (const LAS float*)(lds + L_KMS); float gt[15];
#pragma unroll
        for (int n = 0; n < 15; ++n) { float s = 0.f;
            if (n < qb) {
#pragma unroll
                for (int d0 = 0; d0 < 4; ++d0) { const f32x4 ka = *(const LAS f32x4*)(kms + n * 64 + 16 * d0 + 8 * hi), kb = *(const LAS f32x4*)(kms + n * 64 + 16 * d0 + 8 * hi + 4);
                    const u32x4 w = __builtin_bit_cast(u32x4, qf[d0]);
                    s += bflo(w.x) * ka[0] + bfhi(w.x) * ka[1] + bflo(w.y) * ka[2] + bfhi(w.y) * ka[3] + bflo(w.z) * kb[0] + bfhi(w.z) * kb[1] + bflo(w.w) * kb[2] + bfhi(w.w) * kb[3]; }
                s = swap_sum(s); }
            gt[n] = s; }
#pragma unroll
        for (int k = 0; k < 3; ++k) { float best = NEGBIG; int bi = -1;
#pragma unroll
            for (int n = 0; n < 15; ++n) if (n < qb && !((sel >> n) & 1u) && gt[n] > best) { best = gt[n]; bi = n; }
            if (bi >= 0) sel |= 1u << bi; }
        sel |= 1u << qb;
    }
    const int kfo = L_KB + r32 * 144 + hi * 16, rfo = L_KR + r32 * 80 + hi * 16;
    const int vfo = L_VB + ((lane >> 4) & 1) * 32 + (lane & 3) * 8 + (4 * hi + ((lane & 15) >> 2)) * 64;

    f32x16 o0, o1;
#pragma unroll
    for (int r = 0; r < 16; ++r) { o0[r] = 0.f; o1[r] = 0.f; }
    float m = fast ? 0.f : NEGBIG, lsum = 0.f;

    auto anysel = [&](int j) -> bool { return MODE != 1 || __any((sel >> (j >> 2)) & 1u); };
    auto is_full = [&](int j) -> bool {
        bool f = fast && (64 * j + 63 <= qw) && anysel(j);
        if (MODE == 3) f = f && (64 * j >= qw + 31 - 128);
        return f; };
    auto stage_a = [&](int j, int ks, int kb, f32x16& p) {
        if (MODE == 1 || MODE == 3) { const LAS float* lp = aux + ((MODE == 1 ? 4095 : 255) - (qw + r32 - 64 * j - 4 * hi));
            if (MODE == 1) lp = ((sel >> (j >> 2)) & 1u) ? lp : aux + 4160;
#pragma unroll
            for (int r = 0; r < 16; ++r) p[r] = lp[crow(r) + 32 * kb];
        } else {
#pragma unroll
            for (int r = 0; r < 16; ++r) p[r] = 0.f;
        }
        const LAS char* kb_ = lds + ks * KSLOT + kb * (32 * 144) + kfo;
#pragma unroll
        for (int d0 = 0; d0 < 4; ++d0) p = MFMA32(*(const LAS bf16x8*)(kb_ + d0 * 32), qf[d0], p);
        if (MODE == 2) { const LAS char* rb_ = lds + ks * RSLOT + kb * (32 * 80) + rfo;
#pragma unroll
            for (int d0 = 0; d0 < 2; ++d0) p = MFMA32(*(const LAS bf16x8*)(rb_ + d0 * 32), qf[4 + d0], p); }
        if (MODE == 0) p = MFMA32(*(const LAS bf16x8*)(lds + (hi ? (L_KR + 3072) : (L_KR + ks * 1024 + kb * 512 + r32 * 16))), qx, p);
    };
    auto stage_b = [&](int j, f32x16& p, u32x4& wa, u32x4& wb) {
        float ps = 0.f;
#pragma unroll
        for (int r = 0; r < 16; ++r) { p[r] = __builtin_amdgcn_exp2f(p[r]); ps += p[r]; }
        wa.x = cvt2(p[0], p[1]); wa.y = cvt2(p[2], p[3]); wa.z = cvt2(p[4], p[5]); wa.w = cvt2(p[6], p[7]);
        wb.x = cvt2(p[8], p[9]); wb.y = cvt2(p[10], p[11]); wb.z = cvt2(p[12], p[13]); wb.w = cvt2(p[14], p[15]);
        lsum += ps;
    };
    auto stage_c = [&](int vs, int kb, const u32x4& wa, const u32x4& wb) {
        const LAS char* vb_ = lds + vs * 8192 + vfo + kb * 2048;
        { const s16x4 a0 = vtr(vb_), a1 = vtr(vb_ + 512), c0 = vtr(vb_ + 4096), c1 = vtr(vb_ + 4096 + 512);
          o0 = MFMA32(__builtin_shufflevector(a0, a1, 0, 1, 2, 3, 4, 5, 6, 7), __builtin_bit_cast(bf16x8, wa), o0); o1 = MFMA32(__builtin_shufflevector(c0, c1, 0, 1, 2, 3, 4, 5, 6, 7), __builtin_bit_cast(bf16x8, wa), o1); }
        { const s16x4 a0 = vtr(vb_ + 1024), a1 = vtr(vb_ + 1024 + 512), c0 = vtr(vb_ + 4096 + 1024), c1 = vtr(vb_ + 4096 + 1024 + 512);
          o0 = MFMA32(__builtin_shufflevector(a0, a1, 0, 1, 2, 3, 4, 5, 6, 7), __builtin_bit_cast(bf16x8, wb), o0); o1 = MFMA32(__builtin_shufflevector(c0, c1, 0, 1, 2, 3, 4, 5, 6, 7), __builtin_bit_cast(bf16x8, wb), o1); }
    };
    auto general = [&](int t, int ks, int vs) {
        const int k0 = t * 64; const bool selected = MODE != 1 || ((sel >> (t >> 2)) & 1u); const bool asel = anysel(t);
        int dl = qw + r32 - k0 - 4 * hi; asm volatile("" : "+v"(dl));
#pragma unroll
        for (int kb = 0; kb < 2; ++kb) {
            const int kh = k0 + 32 * kb;
            bool act = kh <= qw + 31 && asel, need_mask = kh + 31 > qw;
            if (MODE == 3) { act = act && (kh + 31 >= qw - 128); need_mask = need_mask || (kh < qw + 31 - 128); }
            if (!act) continue;
            f32x16 p;
            if (MODE == 1 || MODE == 3) { const LAS float* lp = aux + ((MODE == 1 ? 4095 : 255) - dl);
#pragma unroll
                for (int r = 0; r < 16; ++r) p[r] = lp[crow(r) + 32 * kb];
            } else {
#pragma unroll
                for (int r = 0; r < 16; ++r) p[r] = 0.f;
            }
            const LAS char* kb_ = lds + ks * KSLOT + kb * (32 * 144) + kfo;
#pragma unroll
            for (int d0 = 0; d0 < 4; ++d0) p = MFMA32(*(const LAS bf16x8*)(kb_ + d0 * 32), qf[d0], p);
            if (MODE == 2) { const LAS char* rb_ = lds + ks * RSLOT + kb * (32 * 80) + rfo;
#pragma unroll
                for (int d0 = 0; d0 < 2; ++d0) p = MFMA32(*(const LAS bf16x8*)(rb_ + d0 * 32), qf[4 + d0], p); }
            if (MODE == 0) p = MFMA32(*(const LAS bf16x8*)(lds + (hi ? (L_KR + 3072) : (L_KR + ks * 1024 + kb * 512 + r32 * 16))), qx, p);
            if (need_mask) {
#pragma unroll
                for (int r = 0; r < 16; ++r) { const int rel = dl - crow(r) - 32 * kb; const bool v = MODE == 3 ? ((unsigned)rel <= 128u) : (rel >= 0); p[r] = v ? p[r] : -INFINITY; }
            }
            float ps = 0.f;
            if (fast) {
#pragma unroll
                for (int r = 0; r < 16; ++r) { p[r] = __builtin_amdgcn_exp2f(p[r]); ps += p[r]; }
            } else {
                float mx = fmaxf(p[0], p[1]);
#pragma unroll
                for (int r = 2; r < 16; ++r) mx = fmaxf(mx, p[r]);
                mx = swap_max(mx);
                if (MODE == 1) mx = selected ? mx : NEGBIG;
                if (__any(mx > m + THR)) {
                    const float mn = fmaxf(m, mx), alpha = __builtin_amdgcn_exp2f(m - mn); m = mn; lsum *= alpha;
#pragma unroll
                    for (int r = 0; r < 16; ++r) { o0[r] *= alpha; o1[r] *= alpha; }
                }
#pragma unroll
                for (int r = 0; r < 16; ++r) { p[r] = __builtin_amdgcn_exp2f(p[r] - m); ps += p[r]; }
            }
            u32x4 w0, w1;
            w0.x = cvt2(p[0], p[1]); w0.y = cvt2(p[2], p[3]); w0.z = cvt2(p[4], p[5]); w0.w = cvt2(p[6], p[7]);
            w1.x = cvt2(p[8], p[9]); w1.y = cvt2(p[10], p[11]); w1.z = cvt2(p[12], p[13]); w1.w = cvt2(p[14], p[15]);
            if (MODE == 1) { const unsigned mk = selected ? 0xffffffffu : 0u; ps = selected ? ps : 0.f; w0 = w0 & mk; w1 = w1 & mk; }
            lsum += ps;
            const bf16x8 pb0 = __builtin_bit_cast(bf16x8, w0), pb1 = __builtin_bit_cast(bf16x8, w1);
            const LAS char* vb_ = lds + vs * 8192 + vfo + kb * 2048;
            { const s16x4 a0 = vtr(vb_), a1 = vtr(vb_ + 512), c0 = vtr(vb_ + 4096), c1 = vtr(vb_ + 4096 + 512);
              o0 = MFMA32(__builtin_shufflevector(a0, a1, 0, 1, 2, 3, 4, 5, 6, 7), pb0, o0); o1 = MFMA32(__builtin_shufflevector(c0, c1, 0, 1, 2, 3, 4, 5, 6, 7), pb0, o1); }
            { const s16x4 a0 = vtr(vb_ + 1024), a1 = vtr(vb_ + 1024 + 512), c0 = vtr(vb_ + 4096 + 1024), c1 = vtr(vb_ + 4096 + 1024 + 512);
              o0 = MFMA32(__builtin_shufflevector(a0, a1, 0, 1, 2, 3, 4, 5, 6, 7), pb1, o0); o1 = MFMA32(__builtin_shufflevector(c0, c1, 0, 1, 2, 3, 4, 5, 6, 7), pb1, o1); }
        }
    };

    if (MODE == 0) { ATT_LOADK(t_lo, kA, rA); ATT_LOADK(t_lo + 1, kB, rB); }
    ATT_DMAV(t_lo, 0); ATT_DMAV(t_lo + 1, 1);
    ATT_WRITEK(0, t_lo, kA, rA); ATT_WRITEK(1, t_lo + 1, kB, rB);
    __syncthreads();
    ATT_LOADK(t_lo + 2, kA, rA);
    int ks0 = 0, ks1 = 1, ks2 = 2, vs = 0;
    bool pend = is_full(t_lo);
    f32x16 sa0, sa1, sb0, sb1;
    if (pend) { stage_a(t_lo, 0, 0, sa0); stage_a(t_lo, 0, 1, sa1); }
    auto iter = [&](const int t, f32x16& c0, f32x16& c1, f32x16& n0, f32x16& n1) {
        const bool nxt = (t + 1 <= t_hi) && is_full(t + 1);
#ifdef PROBE_ATT
        const bool pk_ = (pend && nxt) == (PROBE_KIND == 0); unsigned long long ti0 = 0; if (MODE == PROBE_ATT && blockIdx.x == PROBE_BLK && pk_) ti0 = __builtin_amdgcn_s_memrealtime();
#endif
        if (pend && nxt) {
            u32x4 wa, wb, wc, wd;
            stage_a(t + 1, ks1, 0, n0); stage_b(t, c0, wa, wb); __builtin_amdgcn_sched_barrier(0);
            stage_a(t + 1, ks1, 1, n1); stage_c(vs, 0, wa, wb); stage_b(t, c1, wc, wd); __builtin_amdgcn_sched_barrier(0);
            stage_c(vs, 1, wc, wd);
        } else {
            if (pend) { u32x4 wa, wb; stage_b(t, c0, wa, wb); stage_c(vs, 0, wa, wb); stage_b(t, c1, wa, wb); stage_c(vs, 1, wa, wb); } else general(t, ks0, vs);
            if (nxt) { stage_a(t + 1, ks1, 0, n0); stage_a(t + 1, ks1, 1, n1); }
        }
        pend = nxt;
        ATT_WRITEK(ks2, t + 2, kA, rA);
        __syncthreads();
#ifdef PROBE_ATT
        if (MODE == PROBE_ATT && blockIdx.x == PROBE_BLK && pk_ && tid == PROBE_TID) { LAS unsigned* pa = (LAS unsigned*)(lds + 131072 + 32); pa[0] += (unsigned)(__builtin_amdgcn_s_memrealtime() - ti0); pa[1] += 1u; }
#endif
        ATT_LOADK(t + 3, kA, rA); ATT_DMAV(t + 2, vs);
        { const int tmp = ks0; ks0 = ks1; ks1 = ks2; ks2 = tmp; } vs ^= 1;
    };
    for (int t = t_lo; t <= t_hi; t += 2) { iter(t, sa0, sa1, sb0, sb1); if (t + 1 <= t_hi) iter(t + 1, sb0, sb1, sa0, sa1); }
#undef ATT_LOADK
#undef ATT_DMAV
#undef ATT_WRITEK
    const int te_ = ltid(), r32e = te_ & 31, hie = (te_ >> 5) & 1, qwe = q0 + 32 * (te_ >> 6);
    const float ltot = swap_sum(lsum), inv = 1.0f / ltot;
    if (MODE != 3) {
        const size_t tok = (size_t)b * SEQ + qwe + r32e; const int colbase = (MODE == 0 ? 0 : (MODE == 1 ? 256 : 768)) + h * 64 + 4 * hie;
        const bf16_t* G = (const bf16_t*)((const char*)P.out + OOFF_G) + tok * DM + colbase; bf16_t* A2 = (bf16_t*)(P.ws + OFF_H) + tok * DM + colbase;
#pragma unroll
        for (int g = 0; g < 4; ++g) {
            const u32x2 g0 = *(const u32x2*)(G + 8 * g), g1 = *(const u32x2*)(G + 32 + 8 * g); u32x2 w0, w1;
            w0.x = cvt2(o0[4 * g] * inv * bflo(g0.x), o0[4 * g + 1] * inv * bfhi(g0.x)); w0.y = cvt2(o0[4 * g + 2] * inv * bflo(g0.y), o0[4 * g + 3] * inv * bfhi(g0.y));
            w1.x = cvt2(o1[4 * g] * inv * bflo(g1.x), o1[4 * g + 1] * inv * bfhi(g1.x)); w1.y = cvt2(o1[4 * g + 2] * inv * bflo(g1.y), o1[4 * g + 3] * inv * bfhi(g1.y));
            *(u32x2*)(A2 + 8 * g) = w0; *(u32x2*)(A2 + 32 + 8 * g) = w1; }
    } else {
        const size_t tok = (size_t)b * SEQ + (size_t)(qwe + r32e) * dil + res;
        bf16_t* dp = (bf16_t*)(P.ws + OFF_DPART) + ((size_t)pat * NT + tok) * 256 + h * 64 + 4 * hie;
#pragma unroll
        for (int g = 0; g < 4; ++g) { u32x2 w0, w1;
            w0.x = cvt2(o0[4 * g] * inv, o0[4 * g + 1] * inv); w0.y = cvt2(o0[4 * g + 2] * inv, o0[4 * g + 3] * inv);
            w1.x = cvt2(o1[4 * g] * inv, o1[4 * g + 1] * inv); w1.y = cvt2(o1[4 * g + 2] * inv, o1[4 * g + 3] * inv);
            *(u32x2*)(dp + 8 * g) = w0; *(u32x2*)(dp + 32 + 8 * g) = w1; }
        if (hie == 0) ((float*)(P.ws + OFF_DLSE))[((size_t)pat * NT + tok) * 4 + h] = m + __builtin_amdgcn_logf(ltot);
    }
}

DEVINL void dil_unit(const Params& P, int l, int u, char* smem) {
    LAS char* lds = (LAS char*)smem;
    const int tid = ltid(), lane = tid & 63, r32 = lane & 31, hi = lane >> 5; const int wid = __builtin_amdgcn_readfirstlane(tid >> 6);
    const int pat = u >> 8, v = u & 255, bh = v & 15, w = v >> 4, dil = pat == 0 ? 1 : (pat == 1 ? 4 : 16), res = w % dil, q0 = (w / dil) * 256;
    const int t_lo = (q0 >= 128 ? q0 - 128 : 0) >> 6, t_hi = (q0 + 255) >> 6, nt = t_hi - t_lo + 1;
    const int b = bh >> 2, h = bh & 3, rs = 64 * dil;
    const bf16_t* Qg = (const bf16_t*)(P.ws + OFF_QKV + 6 * SZ_HEADBUF) + ((size_t)bh * SEQ + res) * 64; const bf16_t* Kg = Qg + SZ_HEADBUF / 2; const bf16_t* Vg = Kg + SZ_HEADBUF / 2;
    const int qw = q0 + 32 * wid;
    constexpr int D_KB = 0, D_VB = 6 * KSLOT, D_AUX = D_VB + 6 * 8192;
    LAS float* aux = (LAS float*)(lds + D_AUX);
    __syncthreads();
    const unsigned kgo = (unsigned)((tid >> 3) * rs + (tid & 7) * 8), vgo = (unsigned)(((tid >> 2) & 63) * rs + (tid >> 8) * 32 + (tid & 3) * 8);
    u32x4 kr[6], vr[6];
#pragma unroll
    for (int j = 0; j < 6; ++j) if (j < nt) { kr[j] = *(const u32x4*)(Kg + (size_t)(t_lo + j) * 64 * rs + kgo); vr[j] = *(const u32x4*)(Vg + (size_t)(t_lo + j) * 64 * rs + vgo); }
    bf16x8 qf[4];
    { const bf16_t* qp = Qg + (size_t)(qw + r32) * rs + 8 * hi;
#pragma unroll
      for (int d0 = 0; d0 < 4; ++d0) qf[d0] = *(const bf16x8*)(qp + 16 * d0); }
    { const float* lut = (const float*)(P.ws + OFF_LUT) + (size_t)(4 + h) * 4096;
      if (tid < 320) { const int rel = 255 - tid; aux[tid] = (rel >= 0 && rel * dil < 4096) ? lut[rel * dil] : 0.f; } }
    { const int kws = (tid >> 3) * 144 + (tid & 7) * 16;
#pragma unroll
      for (int j = 0; j < 6; ++j) if (j < nt) { *(LAS u32x4*)(lds + D_KB + j * KSLOT + kws) = kr[j]; *(LAS u32x4*)(lds + D_VB + j * 8192 + tid * 16) = vr[j]; } }
    __syncthreads();
    const int kfo = D_KB + r32 * 144 + hi * 16;
    const int vfo = D_VB + ((lane >> 4) & 1) * 32 + (lane & 3) * 8 + (4 * hi + ((lane & 15) >> 2)) * 64;
    f32x16 o0, o1;
#pragma unroll
    for (int r = 0; r < 16; ++r) { o0[r] = 0.f; o1[r] = 0.f; }
    float lsum = 0.f;
    const int hb_hi = qw >> 5, hb_lo = hb_hi >= 4 ? hb_hi - 4 : 0;
    for (int hb = hb_lo; hb <= hb_hi; ++hb) {
        const int kh = hb * 32, jl = (hb >> 1) - t_lo, kb = hb & 1;
        const bool need_mask = (hb == hb_hi) || (kh < qw + 31 - 128);
        const int dl = qw + r32 - kh - 4 * hi;
        f32x16 p;
        { const LAS float* lp = aux + (255 - dl);
#pragma unroll
          for (int r = 0; r < 16; ++r) p[r] = lp[crow(r)]; }
        const LAS char* kb_ = lds + jl * KSLOT + kb * (32 * 144) + kfo;
#pragma unroll
        for (int d0 = 0; d0 < 4; ++d0) p = MFMA32(*(const LAS bf16x8*)(kb_ + d0 * 32), qf[d0], p);
        if (need_mask) {
#pragma unroll
            for (int r = 0; r < 16; ++r) { const int rel = dl - crow(r); p[r] = ((unsigned)rel <= 128u) ? p[r] : -INFINITY; }
        }
        float ps = 0.f;
#pragma unroll
        for (int r = 0; r < 16; ++r) { p[r] = __builtin_amdgcn_exp2f(p[r]); ps += p[r]; }
        lsum += ps;
        u32x4 w0, w1;
        w0.x = cvt2(p[0], p[1]); w0.y = cvt2(p[2], p[3]); w0.z = cvt2(p[4], p[5]); w0.w = cvt2(p[6], p[7]);
        w1.x = cvt2(p[8], p[9]); w1.y = cvt2(p[10], p[11]); w1.z = cvt2(p[12], p[13]); w1.w = cvt2(p[14], p[15]);
        const LAS char* vb_ = lds + jl * 8192 + vfo + kb * 2048;
        { const s16x4 a0 = vtr(vb_), a1 = vtr(vb_ + 512), c0 = vtr(vb_ + 4096), c1 = vtr(vb_ + 4096 + 512);
          o0 = MFMA32(__builtin_shufflevector(a0, a1, 0, 1, 2, 3, 4, 5, 6, 7), __builtin_bit_cast(bf16x8, w0), o0); o1 = MFMA32(__builtin_shufflevector(c0, c1, 0, 1, 2, 3, 4, 5, 6, 7), __builtin_bit_cast(bf16x8, w0), o1); }
        { const s16x4 a0 = vtr(vb_ + 1024), a1 = vtr(vb_ + 1024 + 512), c0 = vtr(vb_ + 4096 + 1024), c1 = vtr(vb_ + 4096 + 1024 + 512);
          o0 = MFMA32(__builtin_shufflevector(a0, a1, 0, 1, 2, 3, 4, 5, 6, 7), __builtin_bit_cast(bf16x8, w1), o0); o1 = MFMA32(__builtin_shufflevector(c0, c1, 0, 1, 2, 3, 4, 5, 6, 7), __builtin_bit_cast(bf16x8, w1), o1); }
    }
    const float ltot = swap_sum(lsum), inv = 1.0f / ltot;
    const size_t tok = (size_t)b * SEQ + (size_t)(qw + r32) * dil + res;
    bf16_t* dp = (bf16_t*)(P.ws + OFF_DPART) + ((size_t)pat * NT + tok) * 256 + h * 64 + 4 * hi;
#pragma unroll
    for (int g = 0; g < 4; ++g) { u32x2 w0, w1;
        w0.x = cvt2(o0[4 * g] * inv, o0[4 * g + 1] * inv); w0.y = cvt2(o0[4 * g + 2] * inv, o0[4 * g + 3] * inv);
        w1.x = cvt2(o1[4 * g] * inv, o1[4 * g + 1] * inv); w1.y = cvt2(o1[4 * g + 2] * inv, o1[4 * g + 3] * inv);
        *(u32x2*)(dp + 8 * g) = w0; *(u32x2*)(dp + 32 + 8 * g) = w1; }
    if (hi == 0) ((float*)(P.ws + OFF_DLSE))[((size_t)pat * NT + tok) * 4 + h] = __builtin_amdgcn_logf(ltot);
}

DEVINL void dilmix_unit(const Params& P, int u) {
    const int e = u * NTHREADS + ltid(), tok = e >> 5, hd = e & 31, h = hd >> 3, d8 = (hd & 7) * 8;
    const float* ls = (const float*)(P.ws + OFF_DLSE); const bf16_t* dp = (const bf16_t*)(P.ws + OFF_DPART);
    const float l0 = ls[(size_t)tok * 4 + h], l1 = ls[((size_t)NT + tok) * 4 + h], l2 = ls[((size_t)2 * NT + tok) * 4 + h];
    const float mx = fmaxf(l0, fmaxf(l1, l2)); float w0 = __builtin_amdgcn_exp2f(l0 - mx), w1 = __builtin_amdgcn_exp2f(l1 - mx), w2 = __builtin_amdgcn_exp2f(l2 - mx);
    const float inv = 1.0f / (w0 + w1 + w2); w0 *= inv; w1 *= inv; w2 *= inv;
    const size_t off = (size_t)tok * 256 + h * 64 + d8;
    const u32x4 a = *(const u32x4*)(dp + off), b = *(const u32x4*)(dp + (size_t)NT * 256 + off), c = *(const u32x4*)(dp + (size_t)2 * NT * 256 + off);
    const u32x4 g = *(const u32x4*)((const bf16_t*)((const char*)P.out + OOFF_G) + (size_t)tok * DM + 512 + h * 64 + d8);
    u32x4 r;
    r.x = cvt2((w0 * bflo(a.x) + w1 * bflo(b.x) + w2 * bflo(c.x)) * bflo(g.x), (w0 * bfhi(a.x) + w1 * bfhi(b.x) + w2 * bfhi(c.x)) * bfhi(g.x));
    r.y = cvt2((w0 * bflo(a.y) + w1 * bflo(b.y) + w2 * bflo(c.y)) * bflo(g.y), (w0 * bfhi(a.y) + w1 * bfhi(b.y) + w2 * bfhi(c.y)) * bfhi(g.y));
    r.z = cvt2((w0 * bflo(a.z) + w1 * bflo(b.z) + w2 * bflo(c.z)) * bflo(g.z), (w0 * bfhi(a.z) + w1 * bfhi(b.z) + w2 * bfhi(c.z)) * bfhi(g.z));
    r.w = cvt2((w0 * bflo(a.w) + w1 * bflo(b.w) + w2 * bflo(c.w)) * bflo(g.w), (w0 * bfhi(a.w) + w1 * bfhi(b.w) + w2 * bfhi(c.w)) * bfhi(g.w));
    *(u32x4*)((bf16_t*)(P.ws + OFF_H) + (size_t)tok * DM + 512 + h * 64 + d8) = r;
}


#define XB_TMO      128
#define XB_XCNT(j)  (256  + 64 * (j))
#define XB_XSUB(j)  (1280 + 64 * (j))
#define XB_XGEN(j)  (2304 + 64 * (j))
#define XB_TOP      3328
#define XB_TOPGEN   3392
#define XCD_BAR_WORDS 3456
#define XB_SPIN_CAP (1u << 20)
DEVINL unsigned xb_ld(unsigned* p) { return __hip_atomic_load(p, __ATOMIC_RELAXED, __HIP_MEMORY_SCOPE_AGENT); }
DEVINL unsigned xb_add(unsigned* p, unsigned v) { return __hip_atomic_fetch_add(p, v, __ATOMIC_RELAXED, __HIP_MEMORY_SCOPE_AGENT); }
DEVINL unsigned xb_xcc_id() { return (unsigned)__builtin_amdgcn_s_getreg((3 << 11) | 20) & 0xFu; }
#define XB_SPIN(cond, bar) do { unsigned _sp = 0; while (cond) { __builtin_amdgcn_s_sleep(1); \
    if ((++_sp & 255u) == 0u) { if (xb_ld(&(bar)[XB_TMO])) break; if (_sp > XB_SPIN_CAP) { atomicAdd(&(bar)[XB_TMO], 1u); break; } } } } while (0)
DEVINL void xcd_barrier_post(unsigned* bar) { if (ltid() == 0) (void)xb_add(&bar[XB_XCNT(xb_xcc_id())], 1u); }
DEVINL void xcd_barrier_complete(unsigned* bar, unsigned x, unsigned& nloc, unsigned& nx) {
    const unsigned G = gridDim.x * gridDim.y * gridDim.z;
    unsigned sum, cnt, mine, sp = 0u;
    for (;;) {
        sum = 0u; cnt = 0u; mine = 0u;
        for (unsigned j = 0; j < 16; ++j) { const unsigned c = xb_ld(&bar[XB_XCNT(j)]); sum += c; cnt += (c > 0u) ? 1u : 0u; mine = (j == x) ? c : mine; }
        if (sum == G) break;
        __builtin_amdgcn_s_sleep(1);
        if ((++sp & 255u) == 0u) { if (xb_ld(&bar[XB_TMO])) break; if (sp > XB_SPIN_CAP) { atomicAdd(&bar[XB_TMO], 1u); break; } }
    }
    nloc = mine > 0u ? mine : 1u; nx = cnt > 0u ? cnt : 1u;
}
DEVINL void xcd_barrier(unsigned* bar_in, volatile LAS unsigned* st) {
    asm volatile("s_waitcnt vmcnt(0)" ::: "memory");
    __syncthreads();
    if (ltid() == 0) {
        unsigned* bar = bar_in;
        const unsigned x = xb_xcc_id();
        __builtin_amdgcn_s_waitcnt(0);
        unsigned nloc = st[0], nx = st[1];
        if (nloc == 0u) { xcd_barrier_complete(bar, x, nloc, nx); st[0] = nloc; st[1] = nx; }
        const unsigned old = xb_add(&bar[XB_XSUB(x)], 1u);
        const unsigned gen = old / nloc;
        if (old + 1u == (gen + 1u) * nloc) {
            __builtin_amdgcn_fence(__ATOMIC_RELEASE, "agent");
            asm volatile("s_waitcnt vmcnt(0)" ::: "memory");
            const unsigned og = xb_add(&bar[XB_TOP], 1u);
            const unsigned tg = og / nx;
            if (og + 1u == (tg + 1u) * nx) xb_add(&bar[XB_TOPGEN], 1u);
            else XB_SPIN(xb_ld(&bar[XB_TOPGEN]) == tg, bar);
            __builtin_amdgcn_fence(__ATOMIC_ACQUIRE, "agent");
            xb_add(&bar[XB_XGEN(x)], 1u);
            asm volatile("s_waitcnt vmcnt(0)" ::: "memory");
        } else {
            XB_SPIN(xb_ld(&bar[XB_XGEN(x)]) == gen, bar);
            __builtin_amdgcn_fence(__ATOMIC_ACQUIRE, "agent");
            asm volatile("s_waitcnt vmcnt(0)" ::: "memory");
        }
    }
    __syncthreads();
}


DEVINL int next_unit(unsigned* ctr, char* smem) {
    int* su = (int*)(smem + L_MISC);
    __syncthreads();
    if (ltid() == 0) *su = (int)atomicAdd(ctr, 1u);
    __syncthreads();
    return *su;
}

template <class Epi> DEVINL void gemm8_sub(const bf16_t* A, const bf16_t* Bt, int M, int N, int K, const Epi& E, char* smem, int G, int c) {
    asm volatile("" : "+s"(G), "+s"(c));
    pg8::Gemm g{A, Bt, M, N, K}; pg8::StaticOrder S; S.init(M, N, G, c);
    pg8::gemm_phase<Epi, pg8::StaticOrder, true, true>((PG8_LAS unsigned char*)smem, g, S, E);
}
DEVINL void phase_pre(const Params& P, int l, char* smem) {
    const int half = (int)gridDim.x >> 1, bid = (int)blockIdx.x;
    if (bid < half) gemm8_sub((const bf16_t*)(P.ws + OFF_CQ), (const bf16_t*)(P.ws + OFF_WT_UQ + l * SZ_WT_UQ), NT, 512, 256, EpiUq8{P, l}, smem, half, bid);
    else gemm8_sub((const bf16_t*)(P.ws + OFF_CKV), (const bf16_t*)(P.ws + OFF_WT_UKV + l * SZ_WT_UKV), NT, 512, 256, EpiUkv8{P, l}, smem, (int)gridDim.x - half, bid - half);
    for (int u = blockIdx.x; u < 256; u += gridDim.x) kmean_unit(P, u, smem);
}
DEVINL void phase_att(const Params& P, int l, char* smem, int rep) {
    unsigned* ctr = (unsigned*)(P.ws + OFF_CTR) + l * 2 + rep * 8;
    constexpr int N_ATT = 384 + 256 + 96 + 768 + 32; const int n_all = N_ATT + (l == 0 ? PREP_PER_LAYER + PREP_P_UNITS / 2 : 0);
    for (;;) { int u = next_unit(ctr, smem); if (u >= n_all) break;
        if (u >= N_ATT) { __syncthreads(); if (u - N_ATT < PREP_PER_LAYER) prep_w_unit(P, 1, u - N_ATT, (float*)smem); else prep_p_unit(P, PREP_P_UNITS / 2 + (u - N_ATT - PREP_PER_LAYER)); continue; }
        if (u >= 384 && u < 640) { attn_unit<0>(P, l, u - 384, smem); continue; }
        if (u >= 736 && u < 736 + 768) { if (((const float*)(P.ws + OFF_BOUND))[l * 4 + 3] < 100.0f) dil_unit(P, l, u - 736, smem); else attn_unit<3>(P, l, u - 736, smem); continue; }
        if (u >= 736 + 768) u -= 768; if (u >= 640) u -= 256;
        const int g = u >> 5, r = u & 31, uu = g * 16 + (r & 15);
        if (r < 16) attn_unit<2>(P, l, uu, smem); else attn_unit<1>(P, l, uu, smem); }
}

template <int PH> DEVINL void run_phase(int l, char* smem, int rep = 0) {
    asm volatile("" : "+s"(l));
    const __attribute__((address_space(4))) Params* kp = (const __attribute__((address_space(4))) Params*)__builtin_amdgcn_kernarg_segment_ptr(); asm volatile("" : "+s"(kp));
    Params P;
    P.x = (const float*)as_global(kp->x); P.p = (const float*)as_global(kp->p); P.ln_g = (const float*)as_global(kp->ln_g); P.w_in = (const float*)as_global(kp->w_in); P.b_forget = (const float*)as_global(kp->b_forget);
    P.qk_gain = (const float*)as_global(kp->qk_gain); P.mla_q_norm = (const float*)as_global(kp->mla_q_norm); P.mla_kv_norm = (const float*)as_global(kp->mla_kv_norm); P.mla_nope_gain = (const float*)as_global(kp->mla_nope_gain);
    P.mla_rope_gain = (const float*)as_global(kp->mla_rope_gain); P.w_uq = (const float*)as_global(kp->w_uq); P.w_ukv = (const float*)as_global(kp->w_ukv); P.w_out = (const float*)as_global(kp->w_out); P.rel_bias = (const float*)as_global(kp->rel_bias);
    P.ple_norm_g = (const float*)as_global(kp->ple_norm_g); P.w_ple_gate = (const float*)as_global(kp->w_ple_gate); P.w_ple_proj = (const float*)as_global(kp->w_ple_proj); P.out = (float*)as_global(kp->out); P.ws = as_global(kp->ws);
    char* ws = P.ws;
    const float* xin = l == 0 ? P.x : (const float*)(ws + OFF_X);
    float* xa = P.out;
    float* xout = l == 0 ? (float*)(ws + OFF_X) : P.out;
    if (PH == 0) phase_prep(P, smem);
    if (PH == 2) { gemm8((const bf16_t*)(ws + OFF_H), (const bf16_t*)(ws + OFF_WT_IN + l * SZ_WT_IN), NT, NP1, 1024, EpiIn8{P, l}, smem);
                   const int G_ = (int)gridDim.x, w0_ = G_ > 192 ? 192 : 0;
                   if (l == 0 && (int)blockIdx.x >= w0_) { __syncthreads(); constexpr int W0 = PREP_T_IN + PREP_T_UQ + PREP_T_UKV, NWL = PREP_PER_LAYER - W0;
                       for (int u = (int)blockIdx.x - w0_; u < NWL + PREP_P_UNITS / 2; u += G_ - w0_) { if (u < NWL) prep_w_unit(P, 0, W0 + u, (float*)smem); else prep_p_unit(P, u - NWL); } } }
    if (PH == 3) phase_pre(P, l, smem);
    if (PH == 4) phase_att(P, l, smem, rep);
    if (PH == 5) { for (int u = blockIdx.x; u < 1024; u += gridDim.x) dilmix_unit(P, u);
                 }
    if (PH == 8) gemm8((const bf16_t*)(ws + OFF_H), (const bf16_t*)(ws + OFF_WT_OUT + l * SZ_WT_SQ), NT, 1024, 1024, EpiResid8{xin, xa, (bf16_t*)(ws + OFF_XABF), (float*)(ws + OFF_SSQA)}, smem);
    if (PH == 7) { gemm8((const bf16_t*)(ws + (l == 0 ? OFF_PB : OFF_PB2)), (const bf16_t*)(ws + OFF_WT_PP + l * SZ_WT_PP), NT, 1024, 256, EpiStoreBf{(bf16_t*)(ws + OFF_QKV)}, smem);
                   __syncthreads();
                   gemm8((const bf16_t*)(ws + OFF_XABF), (const bf16_t*)(ws + OFF_WT_PG + l * SZ_WT_SQ), NT, 1024, 1024, EpiPle8{xa, (const bf16_t*)(ws + OFF_QKV), xout, (const float*)(ws + OFF_SSQA), l == 0 ? (bf16_t*)(ws + OFF_H) : (bf16_t*)nullptr, (float*)(ws + OFF_SSQX)}, smem); }
}

__global__ void __launch_bounds__(NTHREADS) k_mega(Params Parg) {
    char* smem = g_smem;
    { const int t0 = (int)threadIdx.x; if (t0 < 12) ((LAS unsigned*)((LAS char*)smem + L_XB))[t0] = 0u;
      if ((t0 & 63) == 0) *(LAS int*)((LAS char*)smem + L_WTAB + 4u * (unsigned)__builtin_amdgcn_s_getreg(0x2804)) = t0 >> 6; }
    __syncthreads();
    const __attribute__((address_space(4))) Params* kp0 = (const __attribute__((address_space(4))) Params*)__builtin_amdgcn_kernarg_segment_ptr();
    xcd_barrier_post((unsigned*)(as_global(kp0->ws) + OFF_BAR));
#define XBAR() xcd_barrier((unsigned*)(as_global(kp0->ws) + OFF_BAR), (volatile LAS unsigned*)((LAS char*)smem + L_XB))
#ifdef PROBE_IDX
    unsigned long long tA = 0, tB = 0;
#define PT0(i) if (PROBE_IDX == (i)) tA = __builtin_amdgcn_s_memrealtime();
#define PT1(i) if (PROBE_IDX == (i)) tB = __builtin_amdgcn_s_memrealtime();
#else
#define PT0(i)
#define PT1(i)
#endif
    PT0(0) run_phase<0>(0, smem); XBAR(); PT1(0)
    PT0(2) run_phase<2>(0, smem); XBAR(); PT1(2) PT0(3) run_phase<3>(0, smem); XBAR(); PT1(3) PT0(4) run_phase<4>(0, smem); XBAR(); PT1(4)
    PT0(5) run_phase<5>(0, smem); XBAR(); PT1(5) PT0(6) run_phase<8>(0, smem); XBAR(); PT1(6) PT0(8) run_phase<7>(0, smem); XBAR(); PT1(8)
    run_phase<2>(1, smem); XBAR(); run_phase<3>(1, smem); XBAR(); run_phase<4>(1, smem); XBAR(); run_phase<5>(1, smem); XBAR(); run_phase<8>(1, smem); XBAR(); run_phase<7>(1, smem);
#ifdef PROBE_IDX
    if (blockIdx.x == 0) { const unsigned long long t0 = __builtin_amdgcn_s_memrealtime(), want = (tB - tA) * 32ull; while (__builtin_amdgcn_s_memrealtime() - t0 < want) __builtin_amdgcn_s_sleep(32); }
#endif
#undef XBAR
#ifdef PROBE_ATT
    if (blockIdx.x == PROBE_BLK) { __syncthreads(); const LAS unsigned* pa = (const LAS unsigned*)((LAS char*)smem + L_MISC + 32); const unsigned long long tk = pa[0], nt = pa[1] ? pa[1] : 1u;
        const unsigned long long t0 = __builtin_amdgcn_s_memrealtime(), want = tk * 2048ull / nt; while (__builtin_amdgcn_s_memrealtime() - t0 < want) __builtin_amdgcn_s_sleep(32); }
#endif
}
}

extern "C" void kernel_launch(void* const* d_in, const int* in_sizes, int n_in, void* d_out, int out_size, void* d_ws, size_t ws_size, hipStream_t stream) {
    Params P{};
    P.x = (const float*)d_in[0]; P.p = (const float*)d_in[1]; P.ln_g = (const float*)d_in[2]; P.w_in = (const float*)d_in[3]; P.b_forget = (const float*)d_in[4]; P.qk_gain = (const float*)d_in[5];
    P.mla_q_norm = (const float*)d_in[6]; P.mla_kv_norm = (const float*)d_in[7]; P.mla_nope_gain = (const float*)d_in[8]; P.mla_rope_gain = (const float*)d_in[9]; P.w_uq = (const float*)d_in[10];
    P.w_ukv = (const float*)d_in[11]; P.w_out = (const float*)d_in[12]; P.rel_bias = (const float*)d_in[13]; P.ple_norm_g = (const float*)d_in[14]; P.w_ple_gate = (const float*)d_in[15]; P.w_ple_proj = (const float*)d_in[16];
    P.out = (float*)d_out; P.ws = (char*)d_ws;
    if (ws_size < WS_NEED) { fprintf(stderr, "workspace too small: %zu < %zu\n", ws_size, (size_t)WS_NEED); return; }
    static int grid_blocks = 0;
    if (!grid_blocks) {
        int dev = 0, cus = 0, per_cu = 0;
        hipGetDevice(&dev);
        hipDeviceGetAttribute(&cus, hipDeviceAttributeMultiprocessorCount, dev);
        hipOccupancyMaxActiveBlocksPerMultiprocessor(&per_cu, k_mega, NTHREADS, 0);
        if (per_cu > 1) per_cu = 1;
        grid_blocks = cus * per_cu;
    }
    hipMemsetAsync((char*)d_ws + OFF_CTR, 0, 512 + 3456 * 4, stream);
    void* args[] = {&P};
    hipError_t e = hipLaunchCooperativeKernel((void*)k_mega, dim3(grid_blocks), dim3(NTHREADS), args, 0, stream);
    if (e != hipSuccess) fprintf(stderr, "cooperative launch failed: %s (grid %d)\n", hipGetErrorString(e), grid_blocks);
}
```

```cpp
#include <hip/hip_runtime.h>
#include <hip/hip_cooperative_groups.h>
#include <cstdint>
#include <cstdio>

#ifndef ONE_LAUNCH
#define ONE_LAUNCH 1
#endif

namespace {
#define DEVINL __device__ __forceinline__
typedef unsigned short bf16_t;
typedef short bf16x8 __attribute__((ext_vector_type(8)));
typedef float f32x4 __attribute__((ext_vector_type(4)));
typedef unsigned u32x2 __attribute__((ext_vector_type(2)));
typedef unsigned u32x4 __attribute__((ext_vector_type(4)));

constexpr int NB = 4, SEQ = 4096, DM = 1024, NT = NB * SEQ, NH = 4, NBH = NB * NH;
constexpr int INW = 3748, NP1 = 3840;
constexpr float EPS = 1e-6f, LOG2E = 1.4426950408889634f;
constexpr float SC_Q = 0.125f * LOG2E;
constexpr float SC_MLA = 0.10206207261596575f * LOG2E;
constexpr int NTHREADS = 512;

constexpr size_t SZ_WT_IN = (size_t)NP1 * 1024 * 2, SZ_WT_UQ = 512 * 256 * 2  , SZ_WT_UKV = 512 * 256 * 2  , SZ_WT_SQ = 1024 * 1024 * 2, SZ_WT_PP = 1024 * 256 * 2;
constexpr size_t OFF_WT_IN = 0;
constexpr size_t OFF_WT_UQ = OFF_WT_IN + 2 * SZ_WT_IN;
constexpr size_t OFF_WT_UKV = OFF_WT_UQ + 2 * SZ_WT_UQ;
constexpr size_t OFF_WT_OUT = OFF_WT_UKV + 2 * SZ_WT_UKV;
constexpr size_t OFF_WT_PG = OFF_WT_OUT + 2 * SZ_WT_SQ;
constexpr size_t OFF_WT_PP = OFF_WT_PG + 2 * SZ_WT_SQ;
constexpr size_t OFF_LUT = OFF_WT_PP + 2 * SZ_WT_PP;
constexpr size_t OFF_ROPE = OFF_LUT + 8 * 4096 * 4;
constexpr size_t OFF_H = OFF_ROPE + 4096 * 16 * 8;
constexpr size_t SZ_HEADBUF = (size_t)NT * 256 * 2;
constexpr size_t OFF_QKV = OFF_H + (size_t)NT * 1024 * 2;
constexpr size_t OFF_XABF = OFF_QKV + (size_t)NT * 1024 * 2;
constexpr size_t OFF_CQ = OFF_QKV + 9 * SZ_HEADBUF;
constexpr size_t OFF_CKV = OFF_CQ + (size_t)NT * 256 * 2;
constexpr size_t OFF_CQSS = OFF_CKV + (size_t)NT * 256 * 2;
constexpr size_t OFF_CKVSS = OFF_CQSS + (size_t)NT * 4 * 4;
constexpr size_t OFF_LOGF = OFF_CKVSS + (size_t)NT * 2 * 4;
constexpr size_t OFF_KMEAN = OFF_LOGF + (size_t)NBH * SEQ * 4;
constexpr size_t OFF_PB = OFF_KMEAN + (size_t)NBH * 16 * 64 * 4;
constexpr size_t OFF_X = OFF_PB + (size_t)NT * 256 * 2;
constexpr size_t OFF_PB2 = OFF_X + (size_t)NT * 1024 * 4;
constexpr size_t OFF_SSQX = OFF_PB2 + (size_t)NT * 256 * 2;
constexpr size_t OFF_SSQA = OFF_SSQX + (size_t)NT * 16 * 4;
constexpr size_t OFF_DPART = OFF_SSQA + (size_t)NT * 16 * 4;
constexpr size_t OFF_DLSE = OFF_DPART + 3 * (size_t)NT * 256 * 2;
constexpr size_t OFF_CTR = OFF_DLSE + 3 * (size_t)NT * 4 * 4;
constexpr size_t OFF_BOUND = OFF_CTR + 256;
constexpr size_t OFF_BAR = OFF_BOUND + 256;
constexpr size_t WS_NEED = OFF_BAR + 3456 * 4;
constexpr size_t OOFF_G = 0;
constexpr size_t OOFF_QM = (size_t)NT * 1024 * 2;
constexpr size_t OOFF_KM = OOFF_QM + (size_t)NBH * SEQ * 96 * 2;
constexpr size_t OOFF_VM = OOFF_KM + (size_t)NBH * SEQ * 96 * 2;

struct Params {
    const float *x, *p, *ln_g, *w_in, *b_forget, *qk_gain, *mla_q_norm, *mla_kv_norm, *mla_nope_gain, *mla_rope_gain, *w_uq, *w_ukv, *w_out, *rel_bias, *ple_norm_g, *w_ple_gate, *w_ple_proj;
    float* out;
    char* ws;
};

DEVINL char* as_global(const void* p) { __attribute__((address_space(1))) char* g; asm volatile("" : "=s"(g) : "0"(p)); return (char*)g; }
constexpr int L_MISC = 131072;
constexpr int L_XB = L_MISC + 16, L_WTAB = L_MISC + 64, SMEM_BYTES = L_MISC + 64 + 256;
__shared__ __attribute__((aligned(16))) char g_smem[SMEM_BYTES];
DEVINL int ltid() {
    const unsigned hw = (unsigned)__builtin_amdgcn_s_getreg(0x2804);
    const int w = __builtin_amdgcn_readfirstlane(*(const __attribute__((address_space(3))) int*)((__attribute__((address_space(3))) char*)g_smem + L_WTAB + hw * 4));
    int lane; asm volatile("v_mbcnt_lo_u32_b32 %0, -1, 0\n\tv_mbcnt_hi_u32_b32 %0, -1, %0" : "=v"(lane));
    return w * 64 + lane; }
DEVINL float shx(float v, int mask) { return __int_as_float(__builtin_amdgcn_ds_bpermute(((ltid() & 63) ^ mask) << 2, __float_as_int(v))); }
DEVINL float shup(float v, int o) { return __int_as_float(__builtin_amdgcn_ds_bpermute(((ltid() & 63) - o) << 2, __float_as_int(v))); }
DEVINL float sq4(const f32x4& a) { return a[0] * a[0] + a[1] * a[1] + a[2] * a[2] + a[3] * a[3]; }
template <int XM> DEVINL float swz_xor(float v) { return __int_as_float(__builtin_amdgcn_ds_swizzle(__float_as_int(v), (XM << 10) | 0x1F)); }
DEVINL float half_swap_sum(float v) { auto rr = __builtin_amdgcn_permlane32_swap(__float_as_uint(v), __float_as_uint(v), false, false); return __uint_as_float(rr[0]) + __uint_as_float(rr[1]); }
DEVINL float wave_sum(float v) { v += swz_xor<1>(v); v += swz_xor<2>(v); v += swz_xor<4>(v); v += swz_xor<8>(v); v += swz_xor<16>(v); return half_swap_sum(v); }
DEVINL bf16_t f2bf(float f) { unsigned u = __float_as_uint(f); u += 0x7fffu + ((u >> 16) & 1u); return (bf16_t)(u >> 16); }
DEVINL float bf2f(bf16_t h) { return __uint_as_float(((unsigned)h) << 16); }
DEVINL unsigned pack2(float a, float b) { return (unsigned)f2bf(a) | ((unsigned)f2bf(b) << 16); }
typedef __bf16 bf16v2 __attribute__((ext_vector_type(2)));
typedef float f32v2 __attribute__((ext_vector_type(2)));
DEVINL unsigned cvt2(float a, float b) { f32v2 v = {a, b}; return __builtin_bit_cast(unsigned, __builtin_convertvector(v, bf16v2)); }
DEVINL float bflo(unsigned u) { return __uint_as_float(u << 16); }
DEVINL float bfhi(unsigned u) { return __uint_as_float(u & 0xffff0000u); }

__device__ __constant__ float ROPE_INV[16] = {1.0f, 0.5623413251903491f, 0.31622776601683794f, 0.1778279410038923f, 0.1f, 0.05623413251903491f, 0.03162277660168379f, 0.01778279410038923f,
                                              0.01f, 0.005623413251903491f, 0.0031622776601683794f, 0.0017782794100389228f, 0.001f, 0.0005623413251903491f, 0.00031622776601683794f, 0.00017782794100389227f};

DEVINL int t5_bucket(int d) {
    if (d < 16) return d;
    int b = 16;
    b += (d >= 22); b += (d >= 30); b += (d >= 40); b += (d >= 54); b += (d >= 73); b += (d >= 99); b += (d >= 134); b += (d >= 182);
    b += (d >= 246); b += (d >= 332); b += (d >= 450); b += (d >= 609); b += (d >= 825); b += (d >= 1117); b += (d >= 1513);
    return b;
}

DEVINL int map_w_in(int n) { return n < 768 ? n : (n < 2720 ? n + 4 : (n < 2724 ? n - 2720 + 768 : (n < 2816 ? -1 : n - 92))); }
DEVINL int virt_col(int nv) { const int v = nv & 255; return (nv & ~255) + 64 * ((v >> 5) & 3) + 32 * (v >> 7) + (v & 31); }
DEVINL int map_w_in_virt(int nv) { int a = virt_col(nv); const int chunk = a >> 6; int hc = a & 63;
    if (chunk == 42 && hc < 32) hc = 16 * ((hc >> 2) & 1) + 4 * (hc >> 3) + (hc & 3);
    return map_w_in(chunk * 64 + hc); }
DEVINL int map_w_uq_virt(int nv) { const int a = virt_col(nv), chunk = a >> 6; int hc = a & 63; if (chunk >= 6) return -1;
    if (chunk >= 4) { const int e = hc & 31; hc = (hc & 32) + 16 * ((e >> 2) & 1) + 4 * (e >> 3) + (e & 3); }
    const int n = chunk * 64 + hc; if (n < 256) return (n >> 6) * 96 + (n & 63); const int r = n - 256; return (r >> 5) * 96 + 64 + (r & 31); }
DEVINL int map_w_uq(int n) { if (n < 256) return (n >> 6) * 96 + (n & 63); const int r = n - 256; return (r >> 5) * 96 + 64 + (r & 31); }

template <int KT>
DEVINL void transpose_tile(const float* src, int Nsrc, bf16_t* dst, int K, int tn, int tk, int mode, const float* fold, float* tile  ) {
    const int tid = ltid(), c4 = (tid & 15) * 4, kr = tid >> 4  , n0 = tn * 64, k0 = tk * KT;
    const int n = n0 + c4, oc = mode == 1 ? map_w_in_virt(n) : (mode == 2 ? map_w_uq(n) : (mode == 3 ? virt_col(n) : (mode == 4 ? map_w_uq_virt(n) : (mode == 5 ? virt_col(n) : n))));
    f32x4 v[KT / 32];
#pragma unroll
    for (int i = 0; i < KT / 32; ++i) { const int kk = kr + 32 * i; v[i] = (f32x4){0.f, 0.f, 0.f, 0.f}; if (oc >= 0 && !(mode == 5 && k0 + kk >= 128)) { v[i] = __builtin_nontemporal_load((const f32x4*)(src + (size_t)(k0 + kk) * Nsrc + oc)); if (fold) v[i] = v[i] * fold[k0 + kk]; } }
    __syncthreads();
#pragma unroll
    for (int i = 0; i < KT / 32; ++i) *(f32x4*)(tile + (kr + 32 * i) * 68 + c4) = v[i];
    __syncthreads();
#pragma unroll
    for (int h = 0; h < KT / 64; ++h) { const int nn = tid & 63, kc = h * 64 + (tid >> 6) * 8; const float* tp = tile + kc * 68 + nn; u32x4 w;
      w.x = cvt2(tp[0], tp[68]); w.y = cvt2(tp[136], tp[204]); w.z = cvt2(tp[272], tp[340]); w.w = cvt2(tp[408], tp[476]);
      *(u32x4*)(dst + (size_t)(n0 + nn) * K + k0 + kc) = w; }
}

constexpr int PREP_T_IN = 60 * 4, PREP_T_UQ = 8 * 1, PREP_T_UKV = 8 * 1, PREP_T_SQ = 16 * 4, PREP_T_PP = 16 * 1;
constexpr int PREP_PER_LAYER = PREP_T_IN + PREP_T_UQ + PREP_T_UKV + 2 * PREP_T_SQ + PREP_T_PP;
constexpr int PREP_LUT_UNITS = 8 * 4096 / 512, PREP_ROPE_UNITS = 4096 * 16 / 512;
constexpr int PREP_X_UNITS = NT / 32, PREP_P_UNITS = 2 * NT / 64;
constexpr int PREP_UNITS = 2 * PREP_PER_LAYER + PREP_LUT_UNITS + PREP_ROPE_UNITS + PREP_X_UNITS + PREP_P_UNITS;

DEVINL void prep_w_unit(const Params& P, int l, int r, float* tile) {
    if (r < PREP_T_IN) { transpose_tile<256>(P.w_in + (size_t)l * 1024 * INW, INW, (bf16_t*)(P.ws + OFF_WT_IN + l * SZ_WT_IN), 1024, r % 60, r / 60, 1, P.ln_g + l * DM, tile); return; }
    r -= PREP_T_IN;
    if (r < PREP_T_UQ) { transpose_tile<256>(P.w_uq + (size_t)l * 256 * 384, 384, (bf16_t*)(P.ws + OFF_WT_UQ + l * SZ_WT_UQ), 256, r % 8, r / 8, 4, P.mla_q_norm + l * 256, tile); return; }
    r -= PREP_T_UQ;
    if (r < PREP_T_UKV) { transpose_tile<256>(P.w_ukv + (size_t)l * 128 * 512, 512, (bf16_t*)(P.ws + OFF_WT_UKV + l * SZ_WT_UKV), 256, r % 8, r / 8, 5, P.mla_kv_norm + l * 128, tile); return; }
    r -= PREP_T_UKV;
    if (r < PREP_T_SQ) { transpose_tile<256>(P.w_out + (size_t)l * 1024 * 1024, 1024, (bf16_t*)(P.ws + OFF_WT_OUT + l * SZ_WT_SQ), 1024, r % 16, r / 16, 3, nullptr, tile); return; }
    r -= PREP_T_SQ;
    if (r < PREP_T_SQ) { transpose_tile<256>(P.w_ple_gate + (size_t)l * 1024 * 1024, 1024, (bf16_t*)(P.ws + OFF_WT_PG + l * SZ_WT_SQ), 1024, r % 16, r / 16, 3, P.ple_norm_g + l * DM, tile); return; }
    r -= PREP_T_SQ;
    transpose_tile<256>(P.w_ple_proj + (size_t)l * 256 * 1024, 1024, (bf16_t*)(P.ws + OFF_WT_PP + l * SZ_WT_PP), 256, r % 16, r / 16, 3, nullptr, tile);
}
DEVINL void prep_p_unit(const Params& P, int v) {
    const int wid = ltid() >> 6, lane = ltid() & 63; f32x4 a[8];
#pragma unroll
    for (int rr = 0; rr < 8; ++rr) a[rr] = __builtin_nontemporal_load((const f32x4*)(P.p + (size_t)(v * 64 + wid * 8 + rr) * 256 + lane * 4));
#pragma unroll
    for (int rr = 0; rr < 8; ++rr) { const int row = v * 64 + wid * 8 + rr; u32x2 w; w.x = cvt2(a[rr][0], a[rr][1]); w.y = cvt2(a[rr][2], a[rr][3]);
        bf16_t* pb = row < NT ? (bf16_t*)(P.ws + OFF_PB) + (size_t)row * 256 : (bf16_t*)(P.ws + OFF_PB2) + (size_t)(row - NT) * 256; *(u32x2*)(pb + lane * 4) = w; }
}
DEVINL void phase_prep(const Params& P, char* smem) {
    float* tile = (float*)smem;
    if (blockIdx.x == 0 && ltid() < 8) {
        const int l = ltid() >> 2, md = ltid() & 3; float bound;
        auto amax = [](const float* p, int n) { float a = 0.f; for (int i = 0; i < n; ++i) a = fmaxf(a, fabsf(p[i])); return a; };
        if (md == 2) { const float nq = amax(P.mla_nope_gain + (l * 2 + 0) * 64, 64), nk = amax(P.mla_nope_gain + (l * 2 + 1) * 64, 64), rq = amax(P.mla_rope_gain + (l * 2 + 0) * 32, 32), rk = amax(P.mla_rope_gain + (l * 2 + 1) * 32, 32);
            bound = sqrtf(64.f * nq * nq + 32.f * rq * rq) * sqrtf(64.f * nk * nk + 32.f * rk * rk) * SC_MLA; }
        else { const int mix = md == 0 ? 0 : (md == 1 ? 1 : 2); bound = 64.f * amax(P.qk_gain + (l * 6 + 2 * mix) * 64, 64) * amax(P.qk_gain + (l * 6 + 2 * mix + 1) * 64, 64) * SC_Q;
            if (md == 0) bound += 8.f; else bound += amax(P.rel_bias, 256) * LOG2E; }
        ((float*)(P.ws + OFF_BOUND))[l * 4 + md] = bound;
    }
    constexpr int U_W = PREP_PER_LAYER, U_LUT = U_W + PREP_LUT_UNITS, U_ROPE = U_LUT + PREP_ROPE_UNITS, U_X = U_ROPE + PREP_X_UNITS, U_P = U_X + PREP_P_UNITS / 2;
    for (int u = blockIdx.x; u < U_P; u += gridDim.x) {
        if (u < U_W) { if (u < PREP_T_IN + PREP_T_UQ + PREP_T_UKV) prep_w_unit(P, 0, u, tile); }
        else if (u < U_LUT) { const int e = (u - U_W) * 512 + ltid(), hh = e >> 12, d = e & 4095; ((float*)(P.ws + OFF_LUT))[e] = P.rel_bias[t5_bucket(d) * 8 + hh] * LOG2E; }
        else if (u < U_ROPE) { const int e = (u - U_LUT) * 512 + ltid(), pos = e >> 4, i = e & 15;
            const double rev = (double)pos * (double)ROPE_INV[i] * 0.15915494309189535; const float fr = (float)(rev - floor(rev));
            ((float2*)(P.ws + OFF_ROPE))[e] = make_float2(__builtin_amdgcn_cosf(fr), __builtin_amdgcn_sinf(fr)); }
        else if (u < U_X) { const int v = u - U_ROPE, wid = ltid() >> 6, lane = ltid() & 63;
            f32x4 a[4][4];
#pragma unroll
            for (int rr = 0; rr < 4; ++rr)
#pragma unroll
                for (int i = 0; i < 4; ++i) a[rr][i] = __builtin_nontemporal_load((const f32x4*)(P.x + (size_t)(v * 32 + wid * 4 + rr) * DM + i * 256 + lane * 4));
#pragma unroll
            for (int rr = 0; rr < 4; ++rr) { const int row = v * 32 + wid * 4 + rr; float ss = 0.f;
#pragma unroll
                for (int i = 0; i < 4; ++i) { ss += sq4(a[rr][i]); u32x2 w; w.x = cvt2(a[rr][i][0], a[rr][i][1]); w.y = cvt2(a[rr][i][2], a[rr][i][3]); *(u32x2*)((bf16_t*)(P.ws + OFF_H) + (size_t)row * DM + i * 256 + lane * 4) = w; }
                ss = wave_sum(ss); if (lane < 16) ((float*)(P.ws + OFF_SSQX))[(size_t)row * 16 + lane] = lane == 0 ? ss : 0.f;
                if (lane < 16) *(u32x4*)((bf16_t*)(P.ws + OFF_CKV) + (size_t)row * 256 + 128 + lane * 8) = (u32x4){0u, 0u, 0u, 0u}; } }
        else {   }
    }
}

DEVINL void phase_rms(const float* src, const float* g, bf16_t* dst, const float* psrc, bf16_t* pb) {
    const int wid = ltid() >> 6, lane = ltid() & 63;
    for (int u = blockIdx.x; u < NT / 8; u += gridDim.x) {
        const int row = u * 8 + wid; const float* xr = src + (size_t)row * DM;
        f32x4 v[4]; float ss = 0.f;
#pragma unroll
        for (int i = 0; i < 4; ++i) { v[i] = *(const f32x4*)(xr + i * 256 + lane * 4); ss += v[i][0] * v[i][0] + v[i][1] * v[i][1] + v[i][2] * v[i][2] + v[i][3] * v[i][3]; }
        ss = wave_sum(ss); const float r = rsqrtf(ss * (1.0f / DM) + EPS);
#pragma unroll
        for (int i = 0; i < 4; ++i) { const f32x4 gg = *(const f32x4*)(g + i * 256 + lane * 4); u32x2 w; w.x = pack2(v[i][0] * r * gg[0], v[i][1] * r * gg[1]); w.y = pack2(v[i][2] * r * gg[2], v[i][3] * r * gg[3]);
            *(u32x2*)(dst + (size_t)row * DM + i * 256 + lane * 4) = w; }
        if (psrc) { const f32x4 pv = *(const f32x4*)(psrc + (size_t)row * 256 + lane * 4); u32x2 w; w.x = pack2(pv[0], pv[1]); w.y = pack2(pv[2], pv[3]); *(u32x2*)(pb + (size_t)row * 256 + lane * 4) = w; }
    }
}

constexpr int GST = 40;
template <class Epi>
DEVINL void gemm_phase(const bf16_t* A, const bf16_t* Bt, int M, int N, int K, const Epi& epi, char* smem) {
    bf16_t* As = (bf16_t*)smem; bf16_t* Bs = As + 256 * GST;
    const int tid = ltid(), wid = tid >> 6, lane = tid & 63, wr = wid >> 1, wc = wid & 1, fr = lane & 15, fq = lane >> 4;
    const int ntm = M / 256, ntn = N / 128, nk = K / 32;
    const int lr = tid >> 2, lc = (tid & 3) * 8;
    for (int tile = blockIdx.x; tile < ntm * ntn; tile += gridDim.x) {
        const int tm = tile % ntm, tn = tile / ntm;
        const bf16_t* Ag = A + (size_t)(tm * 256 + lr) * K + lc; const bf16_t* Bg = Bt + (size_t)(tn * 128 + lr) * K + lc;
        f32x4 acc[4][4];
#pragma unroll
        for (int m = 0; m < 4; ++m)
#pragma unroll
            for (int n = 0; n < 4; ++n) acc[m][n] = (f32x4){0.f, 0.f, 0.f, 0.f};
        u32x4 ra0 = *(const u32x4*)Ag, ra1 = *(const u32x4*)(Ag + (size_t)128 * K), rb0 = *(const u32x4*)Bg;
        for (int kt = 0; kt < nk; ++kt) {
            __syncthreads();
            *(u32x4*)(As + lr * GST + lc) = ra0; *(u32x4*)(As + (lr + 128) * GST + lc) = ra1; *(u32x4*)(Bs + lr * GST + lc) = rb0;
            __syncthreads();
            if (kt + 1 < nk) { const int ko = (kt + 1) * 32; ra0 = *(const u32x4*)(Ag + ko); ra1 = *(const u32x4*)(Ag + (size_t)128 * K + ko); rb0 = *(const u32x4*)(Bg + ko); }
            bf16x8 af[4], bfr[4];
#pragma unroll
            for (int m = 0; m < 4; ++m) af[m] = *(const bf16x8*)(As + (wr * 64 + m * 16 + fr) * GST + fq * 8);
#pragma unroll
            for (int n = 0; n < 4; ++n) bfr[n] = *(const bf16x8*)(Bs + (wc * 64 + n * 16 + fr) * GST + fq * 8);
#pragma unroll
            for (int m = 0; m < 4; ++m)
#pragma unroll
                for (int n = 0; n < 4; ++n) acc[m][n] = __builtin_amdgcn_mfma_f32_16x16x32_bf16(bfr[n], af[m], acc[m][n], 0, 0, 0);
        }
        epi(acc, tm * 256 + wr * 64, tn * 2 + wc, fr, fq);
    }
    __syncthreads();
}

DEVINL float quad_sum(float v) { v += swz_xor<16>(v); return half_swap_sum(v); }
DEVINL void store4bf(bf16_t* p, float a, float b, float c, float d) { u32x2 w; w.x = pack2(a, b); w.y = pack2(c, d); *(u32x2*)p = w; }
DEVINL float fsigmoid(float z) { return __builtin_amdgcn_rcpf(1.0f + __builtin_amdgcn_exp2f(-LOG2E * z)); }
DEVINL float log_sigmoid(float z) { return fminf(z, 0.f) - log1pf(__expf(-fabsf(z))); }

struct EpiIn {
    Params P; int l;
    DEVINL void operator()(f32x4 (&acc)[4][4], int row0, int chunk, int fr, int fq) const {
        char* ws = P.ws; char* ob = (char*)P.out;
        if (chunk < 36) {
            const int g = chunk >> 2, h = chunk & 3, role = g % 3, mix = g / 3;
            bf16_t* dst = (bf16_t*)(ws + OFF_QKV + (size_t)g * SZ_HEADBUF);
            const float* gain = P.qk_gain + ((size_t)l * 6 + 2 * mix + (role == 1 ? 1 : 0)) * 64;
#pragma unroll
            for (int m = 0; m < 4; ++m) {
                const int t = row0 + 16 * m + fr, b = t >> 12, s = t & 4095; bf16_t* d = dst + ((size_t)(b * 4 + h) * SEQ + s) * 64 + 4 * fq;
                float r = 1.f;
                if (role != 2) { float ss = 0.f;
#pragma unroll
                    for (int n = 0; n < 4; ++n) ss += acc[m][n][0] * acc[m][n][0] + acc[m][n][1] * acc[m][n][1] + acc[m][n][2] * acc[m][n][2] + acc[m][n][3] * acc[m][n][3];
                    ss = quad_sum(ss); r = rsqrtf(ss * (1.0f / 64.0f) + EPS) * (role == 0 ? SC_Q : 1.0f); }
#pragma unroll
                for (int n = 0; n < 4; ++n) { f32x4 gg = (f32x4){1.f, 1.f, 1.f, 1.f}; if (role != 2) gg = *(const f32x4*)(gain + 16 * n + 4 * fq);
                    store4bf(d + 16 * n, acc[m][n][0] * r * gg[0], acc[m][n][1] * r * gg[1], acc[m][n][2] * r * gg[2], acc[m][n][3] * r * gg[3]); }
            }
        } else if (chunk < 42) {
            const bool isq = chunk < 40; const int c = isq ? chunk - 36 : chunk - 40;
            bf16_t* dst = isq ? (bf16_t*)(ws + OFF_CQ) : (bf16_t*)(ws + OFF_CKV); const int ld = isq ? 256 : 128;
            float* ssp = isq ? (float*)(ws + OFF_CQSS) : (float*)(ws + OFF_CKVSS); const int nss = isq ? 4 : 2;
#pragma unroll
            for (int m = 0; m < 4; ++m) {
                const int t = row0 + 16 * m + fr; float ss = 0.f;
#pragma unroll
                for (int n = 0; n < 4; ++n) { ss += acc[m][n][0] * acc[m][n][0] + acc[m][n][1] * acc[m][n][1] + acc[m][n][2] * acc[m][n][2] + acc[m][n][3] * acc[m][n][3];
                    store4bf(dst + (size_t)t * ld + c * 64 + 16 * n + 4 * fq, acc[m][n][0], acc[m][n][1], acc[m][n][2], acc[m][n][3]); }
                ss = quad_sum(ss); if (fq == 0) ssp[(size_t)t * nss + c] = ss;
            }
        } else if (chunk == 42) {
            const float* gr = P.mla_rope_gain + ((size_t)l * 2 + 1) * 32; const float2* rope = (const float2*)(ws + OFF_ROPE);
            bf16_t* km = (bf16_t*)(ob + OOFF_KM); float* logf_ = (float*)(ws + OFF_LOGF);
            const f32x4 g1 = *(const f32x4*)(gr + 4 * fq), g2 = *(const f32x4*)(gr + 16 + 4 * fq); const f32x4 bfv = *(const f32x4*)(P.b_forget + l * 4);
#pragma unroll
            for (int m = 0; m < 4; ++m) {
                const int t = row0 + 16 * m + fr, b = t >> 12, s = t & 4095;
                float ss = 0.f;
#pragma unroll
                for (int n = 0; n < 2; ++n) ss += acc[m][n][0] * acc[m][n][0] + acc[m][n][1] * acc[m][n][1] + acc[m][n][2] * acc[m][n][2] + acc[m][n][3] * acc[m][n][3];
                ss = quad_sum(ss); const float r = rsqrtf(ss * (1.0f / 32.0f) + EPS);
                float o1[4], o2[4];
#pragma unroll
                for (int j = 0; j < 4; ++j) { const float2 cs = rope[s * 16 + 4 * fq + j]; const float x1 = acc[m][0][j] * r * g1[j], x2 = acc[m][1][j] * r * g2[j]; o1[j] = x1 * cs.x - x2 * cs.y; o2[j] = x1 * cs.y + x2 * cs.x; }
#pragma unroll
                for (int h = 0; h < 4; ++h) { bf16_t* d = km + ((size_t)(b * 4 + h) * SEQ + s) * 96 + 64 + 4 * fq; store4bf(d, o1[0], o1[1], o1[2], o1[3]); store4bf(d + 16, o2[0], o2[1], o2[2], o2[3]); }
                if (fq == 0) {
#pragma unroll
                    for (int j = 0; j < 4; ++j) logf_[(size_t)(b * 4 + j) * SEQ + s] = log_sigmoid(acc[m][2][j] + bfv[j]) * LOG2E;
                }
            }
        } else if (chunk >= 44) {
            bf16_t* G = (bf16_t*)(ob + OOFF_G); const int c0 = (chunk - 44) * 64;
#pragma unroll
            for (int m = 0; m < 4; ++m) { const int t = row0 + 16 * m + fr;
#pragma unroll
                for (int n = 0; n < 4; ++n) { float o[4];
#pragma unroll
                    for (int j = 0; j < 4; ++j) { const float z = acc[m][n][j]; o[j] = z / (1.0f + __expf(-z)); }
                    store4bf(G + (size_t)t * DM + c0 + 16 * n + 4 * fq, o[0], o[1], o[2], o[3]); } }
        }
    }
};

struct EpiUq {
    Params P; int l;
    DEVINL void operator()(f32x4 (&acc)[4][4], int row0, int chunk, int fr, int fq) const {
        const float* cqss = (const float*)(P.ws + OFF_CQSS); bf16_t* qm = (bf16_t*)((char*)P.out + OOFF_QM); const float2* rope = (const float2*)(P.ws + OFF_ROPE);
#pragma unroll
        for (int m = 0; m < 4; ++m) {
            const int t = row0 + 16 * m + fr, b = t >> 12, s = t & 4095; const f32x4 pss = *(const f32x4*)(cqss + (size_t)t * 4);
            const float rt = rsqrtf((pss[0] + pss[1] + pss[2] + pss[3]) * (1.0f / 256.0f) + EPS);
            if (chunk < 4) {
                const float* gain = P.mla_nope_gain + ((size_t)l * 2 + 0) * 64; float ss = 0.f;
#pragma unroll
                for (int n = 0; n < 4; ++n) { acc[m][n] = acc[m][n] * rt; ss += acc[m][n][0] * acc[m][n][0] + acc[m][n][1] * acc[m][n][1] + acc[m][n][2] * acc[m][n][2] + acc[m][n][3] * acc[m][n][3]; }
                ss = quad_sum(ss); const float r = rsqrtf(ss * (1.0f / 64.0f) + EPS) * SC_MLA; bf16_t* d = qm + ((size_t)(b * 4 + chunk) * SEQ + s) * 96 + 4 * fq;
#pragma unroll
                for (int n = 0; n < 4; ++n) { const f32x4 gg = *(const f32x4*)(gain + 16 * n + 4 * fq); store4bf(d + 16 * n, acc[m][n][0] * r * gg[0], acc[m][n][1] * r * gg[1], acc[m][n][2] * r * gg[2], acc[m][n][3] * r * gg[3]); }
            } else {
                const float* gr = P.mla_rope_gain + ((size_t)l * 2 + 0) * 32; const f32x4 g1 = *(const f32x4*)(gr + 4 * fq), g2 = *(const f32x4*)(gr + 16 + 4 * fq);
#pragma unroll
                for (int hh = 0; hh < 2; ++hh) {
                    const int h = (chunk - 4) * 2 + hh; float ss = 0.f;
#pragma unroll
                    for (int n = 0; n < 2; ++n) { acc[m][2 * hh + n] = acc[m][2 * hh + n] * rt; const f32x4 a = acc[m][2 * hh + n]; ss += a[0] * a[0] + a[1] * a[1] + a[2] * a[2] + a[3] * a[3]; }
                    ss = quad_sum(ss); const float r = rsqrtf(ss * (1.0f / 32.0f) + EPS);
                    float o1[4], o2[4];
#pragma unroll
                    for (int j = 0; j < 4; ++j) { const float2 cs = rope[s * 16 + 4 * fq + j]; const float x1 = acc[m][2 * hh][j] * r * g1[j], x2 = acc[m][2 * hh + 1][j] * r * g2[j];
                        o1[j] = (x1 * cs.x - x2 * cs.y) * SC_MLA; o2[j] = (x1 * cs.y + x2 * cs.x) * SC_MLA; }
                    bf16_t* d = qm + ((size_t)(b * 4 + h) * SEQ + s) * 96 + 64 + 4 * fq; store4bf(d, o1[0], o1[1], o1[2], o1[3]); store4bf(d + 16, o2[0], o2[1], o2[2], o2[3]);
                }
            }
        }
    }
};
struct EpiUkv {
    Params P; int l;
    DEVINL void operator()(f32x4 (&acc)[4][4], int row0, int chunk, int fr, int fq) const {
        const float* ckvss = (const float*)(P.ws + OFF_CKVSS); bf16_t* km = (bf16_t*)((char*)P.out + OOFF_KM); bf16_t* vm = (bf16_t*)((char*)P.out + OOFF_VM);
        const int h = chunk >> 1; const bool isk = (chunk & 1) == 0; const float* gain = P.mla_nope_gain + ((size_t)l * 2 + 1) * 64;
#pragma unroll
        for (int m = 0; m < 4; ++m) {
            const int t = row0 + 16 * m + fr, b = t >> 12, s = t & 4095; const float rt = rsqrtf((ckvss[(size_t)t * 2] + ckvss[(size_t)t * 2 + 1]) * (1.0f / 128.0f) + EPS);
            float ss = 0.f;
#pragma unroll
            for (int n = 0; n < 4; ++n) { acc[m][n] = acc[m][n] * rt; ss += acc[m][n][0] * acc[m][n][0] + acc[m][n][1] * acc[m][n][1] + acc[m][n][2] * acc[m][n][2] + acc[m][n][3] * acc[m][n][3]; }
            if (isk) { ss = quad_sum(ss); const float r = rsqrtf(ss * (1.0f / 64.0f) + EPS); bf16_t* d = km + ((size_t)(b * 4 + h) * SEQ + s) * 96 + 4 * fq;
#pragma unroll
                for (int n = 0; n < 4; ++n) { const f32x4 gg = *(const f32x4*)(gain + 16 * n + 4 * fq); store4bf(d + 16 * n, acc[m][n][0] * r * gg[0], acc[m][n][1] * r * gg[1], acc[m][n][2] * r * gg[2], acc[m][n][3] * r * gg[3]); }
            } else { bf16_t* d = vm + ((size_t)(b * 4 + h) * SEQ + s) * 64 + 4 * fq;
#pragma unroll
                for (int n = 0; n < 4; ++n) store4bf(d + 16 * n, acc[m][n][0], acc[m][n][1], acc[m][n][2], acc[m][n][3]); }
        }
    }
};
struct EpiResid { const float* base; float* out;
    DEVINL void operator()(f32x4 (&acc)[4][4], int row0, int chunk, int fr, int fq) const {
#pragma unroll
        for (int m = 0; m < 4; ++m) { const size_t o = (size_t)(row0 + 16 * m + fr) * DM + chunk * 64 + 4 * fq;
#pragma unroll
            for (int n = 0; n < 4; ++n) { const f32x4 bv = *(const f32x4*)(base + o + 16 * n); *(f32x4*)(out + o + 16 * n) = bv + acc[m][n]; } } } };
struct EpiStore { float* out;
    DEVINL void operator()(f32x4 (&acc)[4][4], int row0, int chunk, int fr, int fq) const {
#pragma unroll
        for (int m = 0; m < 4; ++m) { const size_t o = (size_t)(row0 + 16 * m + fr) * DM + chunk * 64 + 4 * fq;
#pragma unroll
            for (int n = 0; n < 4; ++n) *(f32x4*)(out + o + 16 * n) = acc[m][n]; } } };
struct EpiPle { const float* xa; const float* pp; float* out;
    DEVINL void operator()(f32x4 (&acc)[4][4], int row0, int chunk, int fr, int fq) const {
#pragma unroll
        for (int m = 0; m < 4; ++m) { const size_t o = (size_t)(row0 + 16 * m + fr) * DM + chunk * 64 + 4 * fq;
#pragma unroll
            for (int n = 0; n < 4; ++n) { const f32x4 xv = *(const f32x4*)(xa + o + 16 * n), pv = *(const f32x4*)(pp + o + 16 * n); f32x4 r;
#pragma unroll
                for (int j = 0; j < 4; ++j) r[j] = xv[j] + pv[j] / (1.0f + __expf(-acc[m][n][j]));
                *(f32x4*)(out + o + 16 * n) = r; } } } };

namespace pg8 {
#define PG8_LAS __attribute__((address_space(3)))
constexpr int BM = 256, BK = 64, HALF = 128, HTB = HALF * BK * 2  , STAGE_BYTES = 8 * HTB, NXCD = 8, WGM = 8;

__host__ __device__ __forceinline__ int lds_byte(int r, int c) { const int st = (r >> 4) * 2 + (c >> 5), rr = r & 15, cc = c & 31, ob = rr * 64 + cc * 2; return st * 1024 + (ob ^ (((ob >> 9) & 1) << 5)); }
__host__ __device__ __forceinline__ void stage_rc(int b, int& R, int& C) { const int st = b / 1024, sb = b % 1024, swz = sb ^ (((sb >> 9) & 1) << 5); R = (st >> 1) * 16 + swz / 64; C = (st & 1) * 32 + (swz % 64) / 2; }
__host__ __device__ __forceinline__ int perm32(int rho) { const int n = rho >> 4, i = rho & 15; return 8 * (i >> 2) + 4 * n + (i & 3); }

struct Unit { int pm, pn; };
struct Gemm { const bf16_t* A; const bf16_t* Bt; int M, N, K; };

struct StaticOrder {
    int nM, nN, nwg, G, c;
    __host__ __device__ void init(int M, int N, int G_, int c_) { nM = M / BM; nN = N / BM; nwg = nM * nN; G = G_; c = c_; }
    __host__ __device__ bool next(int i, Unit& u) const {
        const long L = (long)i * G + c; if (L >= nwg) return false;
        int wgid = (int)L; { const int q = nwg / NXCD, r = nwg % NXCD, xcd = wgid % NXCD, off = wgid / NXCD; wgid = (xcd < r ? xcd * (q + 1) : r * (q + 1) + (xcd - r) * q) + off; }
        const int nig = WGM * nN, gid = wgid / nig, fm = gid * WGM, gsz = (nM - fm) < WGM ? (nM - fm) : WGM;
        u.pm = fm + ((wgid % nig) % gsz); u.pn = (wgid % nig) / gsz; return true;
    }
    __device__ __forceinline__ void a_ready(const Unit&) const {}
    __device__ __forceinline__ void done(const Unit&) const {}
};

template <class Epi, class Sched, bool ALIGN_EPI = false, bool SP2 = false>
__device__ __forceinline__ void gemm_phase(PG8_LAS unsigned char* lds, const Gemm g, const Sched& S, const Epi& E) {
    const int tid = ltid(), wid = __builtin_amdgcn_readfirstlane(tid >> 6), lane = tid & 63, wr = wid >> 2, wc = wid & 3, fr = lane & 15, fq = lane >> 4;
    const int K = g.K, nt = K / BK;
    unsigned voffA[2], voffB[2];
#pragma unroll
    for (int i = 0; i < 2; ++i) { int R, C; stage_rc(tid * 16 + i * 8192, R, C); const int Rb = Epi::PERM ? ((R & ~31) + perm32(R & 31)) : R;
        voffA[i] = (unsigned)(R * K + C) * 2u; voffB[i] = (unsigned)(Rb * K + C) * 2u; }
    const size_t kstep = (size_t)(BK * 2);
    const size_t hstep = (size_t)HALF * K * 2;
    const size_t tstep = 2 * hstep;
    const unsigned ldsw = (unsigned)wid * 1024u;
    const int aoff = lds_byte(wr * 64 + fr, fq * 8), boff = lds_byte(wc * 32 + fr, fq * 8);
    PG8_LAS unsigned char* ldsA = lds + aoff; PG8_LAS unsigned char* ldsB = lds + 65536 + boff; asm volatile("" : "+v"(ldsA), "+v"(ldsB));
#define PG8_SA(b, h) (((b) * 2 + (h)) * HTB)
#define PG8_SB(b, h) ((4 + (b) * 2 + (h)) * HTB)
#define PG8_STAGE(bufoff, gbase, voff) do { _Pragma("unroll") for (int _i = 0; _i < 2; ++_i) \
        __builtin_amdgcn_global_load_lds((const unsigned*)((const char*)(gbase) + (voff)[_i]), (PG8_LAS unsigned*)(lds + (bufoff) + ldsw + _i * 8192), 16, 0, 0); } while (0)
#define PG8_LDA(dst, b, h) do { _Pragma("unroll") for (int m = 0; m < 4; ++m) _Pragma("unroll") for (int k = 0; k < 2; ++k) dst[m][k] = *(const PG8_LAS bf16x8*)(ldsA + PG8_SA(b, h) + m * 2048 + k * 1024); } while (0)
#define PG8_LDB(dst, b, h) do { _Pragma("unroll") for (int n = 0; n < 2; ++n) _Pragma("unroll") for (int k = 0; k < 2; ++k) dst[n][k] = *(const PG8_LAS bf16x8*)(ldsB + (PG8_SB(b, h) - 65536) + n * 2048 + k * 1024); } while (0)
#define PG8_MMA(ai, bj, At, Bt) do { __builtin_amdgcn_s_setprio(1); _Pragma("unroll") for (int m = 0; m < 4; ++m) _Pragma("unroll") for (int n = 0; n < 2; ++n) _Pragma("unroll") for (int k = 0; k < 2; ++k) \
        acc[ai][bj][m][n] = __builtin_amdgcn_mfma_f32_16x16x32_bf16(Bt[n][k], At[m][k], acc[ai][bj][m][n], 0, 0, 0); __builtin_amdgcn_s_setprio(0); } while (0)
#define PG8_WAIT_V(n) asm volatile("s_waitcnt vmcnt(" #n ")" ::: "memory")
#define PG8_WAIT_L(n) asm volatile("s_waitcnt lgkmcnt(" #n ")" ::: "memory")
#define PG8_BAR __builtin_amdgcn_s_barrier()
#define PG8_SCHED __builtin_amdgcn_sched_barrier(0)
    Unit cur, nxt; int ui = 0;
    if (!S.next(0, cur)) return;
    f32x4 acc[2][2][4][2];
#pragma unroll
    for (int a = 0; a < 2; ++a)
#pragma unroll
        for (int b = 0; b < 2; ++b)
#pragma unroll
            for (int m = 0; m < 4; ++m)
#pragma unroll
                for (int n = 0; n < 2; ++n) acc[a][b][m][n] = (f32x4){0.f, 0.f, 0.f, 0.f};
    bf16x8 At[4][2], B0[2][2], B1[2][2];
    const char* cA = (const char*)g.A + (size_t)cur.pm * tstep; const char* cB = (const char*)g.Bt + (size_t)cur.pn * tstep;
    S.a_ready(cur);
    if constexpr (SP2) {
        PG8_STAGE(PG8_SB(0, 0), cB, voffB); PG8_STAGE(PG8_SB(0, 1), cB + hstep, voffB); PG8_STAGE(PG8_SA(0, 0), cA, voffA); PG8_STAGE(PG8_SA(0, 1), cA + hstep, voffA);
        if (wr == 1) PG8_BAR;
        PG8_WAIT_V(2); PG8_BAR;
        PG8_STAGE(PG8_SB(1, 0), cB + kstep, voffB); PG8_STAGE(PG8_SA(1, 0), cA + kstep, voffA); PG8_STAGE(PG8_SB(1, 1), cB + hstep + kstep, voffB);
        PG8_WAIT_V(6); PG8_BAR;
    } else {
        PG8_STAGE(PG8_SB(0, 0), cB, voffB); PG8_STAGE(PG8_SA(0, 0), cA, voffA); PG8_STAGE(PG8_SB(0, 1), cB + hstep, voffB); PG8_STAGE(PG8_SA(0, 1), cA + hstep, voffA);
        if (wr == 1) PG8_BAR;
        PG8_WAIT_V(4); PG8_BAR;
        PG8_STAGE(PG8_SB(1, 0), cB + kstep, voffB); PG8_STAGE(PG8_SA(1, 0), cA + kstep, voffA); PG8_STAGE(PG8_SB(1, 1), cB + hstep + kstep, voffB);
        PG8_WAIT_V(6); PG8_BAR;
    }
    for (;;) {
        const bool has_next = S.next(ui + 1, nxt);
        const char* nA = has_next ? (const char*)g.A + (size_t)nxt.pm * tstep : cA; const char* nB = has_next ? (const char*)g.Bt + (size_t)nxt.pn * tstep : cB;
        for (int t = 0; t < nt; t += 2) {
            const bool last = (t == nt - 2);
            const char* a1 = cA + (size_t)(t + 1) * kstep;
            const char* a2 = last ? nA : cA + (size_t)(t + 2) * kstep; const char* b2 = last ? nB : cB + (size_t)(t + 2) * kstep;
            const char* a3 = a2 + kstep; const char* b3 = b2 + kstep;
            if (last && has_next) S.a_ready(nxt);
            if constexpr (SP2) {
            PG8_LDB(B0, 0, 0); PG8_LDB(B1, 0, 1); PG8_SCHED; PG8_LDA(At, 0, 0); PG8_STAGE(PG8_SA(1, 1), a1 + hstep, voffA);
            PG8_WAIT_V(8); PG8_WAIT_L(0); PG8_BAR; PG8_MMA(0, 0, At, B0); PG8_MMA(0, 1, At, B1); PG8_BAR; PG8_SCHED;
            PG8_LDA(At, 0, 1); PG8_STAGE(PG8_SB(0, 0), b2, voffB); PG8_STAGE(PG8_SB(0, 1), b2 + hstep, voffB); PG8_STAGE(PG8_SA(0, 0), a2, voffA);
            PG8_WAIT_V(8); PG8_WAIT_L(0); PG8_BAR; PG8_MMA(1, 0, At, B0); PG8_MMA(1, 1, At, B1); PG8_BAR; PG8_SCHED;
            PG8_LDB(B0, 1, 0); PG8_LDB(B1, 1, 1); PG8_SCHED; PG8_LDA(At, 1, 0); PG8_STAGE(PG8_SA(0, 1), a2 + hstep, voffA);
            PG8_WAIT_V(8); PG8_WAIT_L(0); PG8_BAR; PG8_MMA(0, 0, At, B0); PG8_MMA(0, 1, At, B1); PG8_BAR; PG8_SCHED;
            PG8_LDA(At, 1, 1); PG8_STAGE(PG8_SB(1, 0), b3, voffB); PG8_STAGE(PG8_SB(1, 1), b3 + hstep, voffB); PG8_STAGE(PG8_SA(1, 0), a3, voffA);
            PG8_WAIT_V(8); PG8_WAIT_L(0); PG8_BAR; PG8_MMA(1, 0, At, B0); PG8_MMA(1, 1, At, B1); PG8_BAR; PG8_SCHED;
            } else {
            PG8_LDB(B0, 0, 0); PG8_SCHED; PG8_LDA(At, 0, 0); PG8_STAGE(PG8_SA(1, 1), a1 + hstep, voffA);
            PG8_WAIT_L(8); PG8_BAR; PG8_WAIT_L(0); PG8_MMA(0, 0, At, B0); PG8_BAR; PG8_SCHED;
            PG8_LDB(B1, 0, 1); PG8_STAGE(PG8_SB(0, 0), b2, voffB);
            PG8_BAR; PG8_WAIT_L(0); PG8_MMA(0, 1, At, B1); PG8_BAR;
            PG8_LDA(At, 0, 1); PG8_STAGE(PG8_SA(0, 0), a2, voffA);
            PG8_BAR; PG8_WAIT_L(0); PG8_MMA(1, 0, At, B0); PG8_BAR; PG8_SCHED;
            PG8_STAGE(PG8_SB(0, 1), b2 + hstep, voffB);
            PG8_WAIT_V(6); PG8_BAR; PG8_MMA(1, 1, At, B1); PG8_BAR;
            PG8_LDB(B0, 1, 0); PG8_SCHED; PG8_LDA(At, 1, 0); PG8_STAGE(PG8_SA(0, 1), a2 + hstep, voffA);
            PG8_WAIT_L(8); PG8_BAR; PG8_WAIT_L(0); PG8_MMA(0, 0, At, B0); PG8_BAR; PG8_SCHED;
            PG8_LDB(B1, 1, 1); PG8_STAGE(PG8_SB(1, 0), b3, voffB);
            PG8_BAR; PG8_WAIT_L(0); PG8_MMA(0, 1, At, B1); PG8_BAR;
            PG8_LDA(At, 1, 1); PG8_STAGE(PG8_SA(1, 0), a3, voffA);
            PG8_BAR; PG8_WAIT_L(0); PG8_MMA(1, 0, At, B0); PG8_BAR; PG8_SCHED;
            PG8_STAGE(PG8_SB(1, 1), b3 + hstep, voffB);
            PG8_WAIT_V(6); PG8_BAR; PG8_MMA(1, 1, At, B1); PG8_BAR;
            }
        }
        if constexpr (ALIGN_EPI) { if (wr == 0) PG8_BAR; }
        if constexpr (!Epi::AFTER_DRAIN) { E(acc, cur, wr, wc, fr, fq); S.done(cur); }
        if (!has_next) break;
#pragma unroll
        for (int a = 0; a < 2; ++a)
#pragma unroll
            for (int b = 0; b < 2; ++b)
#pragma unroll
                for (int m = 0; m < 4; ++m)
#pragma unroll
                    for (int n = 0; n < 2; ++n) acc[a][b][m][n] = (f32x4){0.f, 0.f, 0.f, 0.f};
        cur = nxt; cA = nA; cB = nB; ++ui;
        if constexpr (ALIGN_EPI) { if (wr == 1) PG8_BAR; }
    }
    PG8_WAIT_V(0);
    if constexpr (!ALIGN_EPI) { if (wr == 0) PG8_BAR; }
    PG8_BAR;
    if constexpr (Epi::AFTER_DRAIN) { E.fused(acc, cur, wr, wc, fr, fq, lds, wid, lane); S.done(cur); }
#undef PG8_SA
#undef PG8_SB
#undef PG8_STAGE
#undef PG8_LDA
#undef PG8_LDB
#undef PG8_MMA
#undef PG8_WAIT_V
#undef PG8_WAIT_L
#undef PG8_BAR
#undef PG8_SCHED
}
}


DEVINL u32x4 pack8(const f32x4& a, const f32x4& b) { u32x4 w; w.x = cvt2(a[0], a[1]); w.y = cvt2(a[2], a[3]); w.z = cvt2(b[0], b[1]); w.w = cvt2(b[2], b[3]); return w; }
DEVINL float row_rscale(const float* ssq, int t, int fq) { const f32x4 a = *(const f32x4*)(ssq + (size_t)t * 16 + 4 * fq); return rsqrtf(quad_sum(a[0] + a[1] + a[2] + a[3]) * (1.0f / DM) + EPS); }
struct EpiIn8 {
    static constexpr bool PERM = true, AFTER_DRAIN = false;
    Params P; int l;
    DEVINL void operator()(const f32x4 (&acc0)[2][2][4][2], const pg8::Unit& u, int wr, int wc, int fr, int fq) const {
        { const int t_ = ltid(); fr = t_ & 15; fq = (t_ >> 4) & 3; wc = __builtin_amdgcn_readfirstlane((t_ >> 6) & 3); wr = __builtin_amdgcn_readfirstlane(t_ >> 8); }
        char* ws = P.ws; char* ob = (char*)P.out; const int chunk = u.pn * 4 + wc;
        const float* ssqx = (const float*)(ws + OFF_SSQX);
        if (chunk < 36) {
            const int g = chunk >> 2, h = chunk & 3, role = g % 3, mix = g / 3;
            bf16_t* dst = (bf16_t*)(ws + OFF_QKV + (size_t)g * SZ_HEADBUF);
            const float* gain = P.qk_gain + ((size_t)l * 6 + 2 * mix + (role == 1 ? 1 : 0)) * 64 + 8 * fq;
            f32x4 gg[2][2];
#pragma unroll
            for (int bj = 0; bj < 2; ++bj)
#pragma unroll
                for (int n = 0; n < 2; ++n) gg[bj][n] = role != 2 ? *(const f32x4*)(gain + 32 * bj + 4 * n) : (f32x4){1.f, 1.f, 1.f, 1.f};
#pragma unroll
            for (int ai = 0; ai < 2; ++ai)
#pragma unroll
                for (int m = 0; m < 4; ++m) {
                    const int t = u.pm * 256 + 128 * ai + 64 * wr + 16 * m + fr, b = t >> 12, s = t & 4095; const float rt_ = row_rscale(ssqx, t, fq); const f32x4 a[2][2] = {{acc0[ai][0][m][0] * rt_, acc0[ai][0][m][1] * rt_}, {acc0[ai][1][m][0] * rt_, acc0[ai][1][m][1] * rt_}}; bf16_t* d = dst + ((size_t)(b * 4 + h) * SEQ + s) * 64 + 8 * fq;
                    float r = 1.f;
                    if (role != 2) { float ss = sq4(a[0][0]) + sq4(a[0][1]) + sq4(a[1][0]) + sq4(a[1][1]); ss = quad_sum(ss); r = rsqrtf(ss * (1.0f / 64.0f) + EPS) * (role == 0 ? SC_Q : 1.0f); }
#pragma unroll
                    for (int bj = 0; bj < 2; ++bj) *(u32x4*)(d + 32 * bj) = pack8(a[bj][0] * r * gg[bj][0], a[bj][1] * r * gg[bj][1]);
                }
        } else if (chunk < 42) {
            const bool isq = chunk < 40; const int c = isq ? chunk - 36 : chunk - 40;
            bf16_t* dst = isq ? (bf16_t*)(ws + OFF_CQ) : (bf16_t*)(ws + OFF_CKV); const int ld = 256;
            float* ssp = isq ? (float*)(ws + OFF_CQSS) : (float*)(ws + OFF_CKVSS); const int nss = isq ? 4 : 2;
#pragma unroll
            for (int ai = 0; ai < 2; ++ai)
#pragma unroll
                for (int m = 0; m < 4; ++m) {
                    const int t = u.pm * 256 + 128 * ai + 64 * wr + 16 * m + fr; const float rt_ = row_rscale(ssqx, t, fq); const f32x4 a[2][2] = {{acc0[ai][0][m][0] * rt_, acc0[ai][0][m][1] * rt_}, {acc0[ai][1][m][0] * rt_, acc0[ai][1][m][1] * rt_}};
                    float ss = sq4(a[0][0]) + sq4(a[0][1]) + sq4(a[1][0]) + sq4(a[1][1]); ss = quad_sum(ss);
#pragma unroll
                    for (int bj = 0; bj < 2; ++bj) *(u32x4*)(dst + (size_t)t * ld + c * 64 + 32 * bj + 8 * fq) = pack8(a[bj][0], a[bj][1]);
                    if (fq == 0) ssp[(size_t)t * nss + c] = ss;
                }
        } else if (chunk == 42) {
            const float* gr = P.mla_rope_gain + ((size_t)l * 2 + 1) * 32; const float2* rope = (const float2*)(ws + OFF_ROPE);
            bf16_t* km = (bf16_t*)(ob + OOFF_KM); float* logf_ = (float*)(ws + OFF_LOGF);
            const f32x4 g1 = *(const f32x4*)(gr + 4 * fq), g2 = *(const f32x4*)(gr + 16 + 4 * fq); const f32x4 bfv = *(const f32x4*)(P.b_forget + l * 4);
#pragma unroll
            for (int ai = 0; ai < 2; ++ai)
#pragma unroll
                for (int m = 0; m < 4; ++m) {
                    const int t = u.pm * 256 + 128 * ai + 64 * wr + 16 * m + fr, b = t >> 12, s = t & 4095; const float rt_ = row_rscale(ssqx, t, fq); const f32x4 a[2][2] = {{acc0[ai][0][m][0] * rt_, acc0[ai][0][m][1] * rt_}, {acc0[ai][1][m][0] * rt_, acc0[ai][1][m][1] * rt_}};
                    float ss = sq4(a[0][0]) + sq4(a[0][1]); ss = quad_sum(ss); const float r = rsqrtf(ss * (1.0f / 32.0f) + EPS);
                    float o1[4], o2[4];
#pragma unroll
                    for (int j = 0; j < 4; ++j) { const float2 cs = rope[s * 16 + 4 * fq + j]; const float x1 = a[0][0][j] * r * g1[j], x2 = a[0][1][j] * r * g2[j]; o1[j] = x1 * cs.x - x2 * cs.y; o2[j] = x1 * cs.y + x2 * cs.x; }
#pragma unroll
                    for (int h = 0; h < 4; ++h) { bf16_t* d = km + ((size_t)(b * 4 + h) * SEQ + s) * 96 + 64 + 4 * fq; store4bf(d, o1[0], o1[1], o1[2], o1[3]); store4bf(d + 16, o2[0], o2[1], o2[2], o2[3]); }
                    if (fq == 0) {
#pragma unroll
                        for (int j = 0; j < 4; ++j) logf_[(size_t)(b * 4 + j) * SEQ + s] = log_sigmoid(a[1][0][j] + bfv[j]) * LOG2E;
                    }
                }
        } else if (chunk >= 44) {
            bf16_t* G = (bf16_t*)(ob + OOFF_G); const int c0 = (chunk - 44) * 64 + 8 * fq;
#pragma unroll
            for (int ai = 0; ai < 2; ++ai)
#pragma unroll
                for (int m = 0; m < 4; ++m) {
                    const int t = u.pm * 256 + 128 * ai + 64 * wr + 16 * m + fr; const float rt_ = row_rscale(ssqx, t, fq); const f32x4 a[2][2] = {{acc0[ai][0][m][0] * rt_, acc0[ai][0][m][1] * rt_}, {acc0[ai][1][m][0] * rt_, acc0[ai][1][m][1] * rt_}};
#pragma unroll
                    for (int bj = 0; bj < 2; ++bj) { f32x4 o0, o1;
#pragma unroll
                        for (int j = 0; j < 4; ++j) { const float z0 = a[bj][0][j], z1 = a[bj][1][j]; o0[j] = z0 * fsigmoid(z0); o1[j] = z1 * fsigmoid(z1); }
                        *(u32x4*)(G + (size_t)t * DM + c0 + 32 * bj) = pack8(o0, o1); }
                }
        }
    }
};
struct EpiResid8 { static constexpr bool PERM = true, AFTER_DRAIN = false; const float* base; float* out; bf16_t* obf; float* ssq;
    DEVINL void operator()(const f32x4 (&acc)[2][2][4][2], const pg8::Unit& u, int wr, int wc, int fr, int fq) const {
        { const int t_ = ltid(); fr = t_ & 15; fq = (t_ >> 4) & 3; wc = __builtin_amdgcn_readfirstlane((t_ >> 6) & 3); wr = __builtin_amdgcn_readfirstlane(t_ >> 8); }
#pragma unroll
        for (int ai = 0; ai < 2; ++ai)
#pragma unroll
            for (int m = 0; m < 4; ++m) { const int t = u.pm * 256 + 128 * ai + 64 * wr + 16 * m + fr; const size_t o = (size_t)t * DM + u.pn * 256 + 64 * wc + 8 * fq; float ss = 0.f;
#pragma unroll
                for (int bj = 0; bj < 2; ++bj) { const f32x4 v0 = __builtin_nontemporal_load((const f32x4*)(base + o + 32 * bj)) + acc[ai][bj][m][0], v1 = __builtin_nontemporal_load((const f32x4*)(base + o + 32 * bj + 4)) + acc[ai][bj][m][1];
                    *(f32x4*)(out + o + 32 * bj) = v0; *(f32x4*)(out + o + 32 * bj + 4) = v1; *(u32x4*)(obf + o + 32 * bj) = pack8(v0, v1); ss += sq4(v0) + sq4(v1); }
                ss = quad_sum(ss); if (fq == 0) ssq[(size_t)t * 16 + u.pn * 4 + wc] = ss; } } };
struct EpiStoreBf { static constexpr bool PERM = true, AFTER_DRAIN = false; bf16_t* out;
    DEVINL void operator()(const f32x4 (&acc)[2][2][4][2], const pg8::Unit& u, int wr, int wc, int fr, int fq) const {
        { const int t_ = ltid(); fr = t_ & 15; fq = (t_ >> 4) & 3; wc = __builtin_amdgcn_readfirstlane((t_ >> 6) & 3); wr = __builtin_amdgcn_readfirstlane(t_ >> 8); }
#pragma unroll
        for (int ai = 0; ai < 2; ++ai)
#pragma unroll
            for (int m = 0; m < 4; ++m) { const size_t o = (size_t)(u.pm * 256 + 128 * ai + 64 * wr + 16 * m + fr) * DM + u.pn * 256 + 64 * wc + 8 * fq;
#pragma unroll
                for (int bj = 0; bj < 2; ++bj) *(u32x4*)(out + o + 32 * bj) = pack8(acc[ai][bj][m][0], acc[ai][bj][m][1]); } } };
struct EpiPle8 { static constexpr bool PERM = true, AFTER_DRAIN = false; const float* xa; const bf16_t* pp; float* out; const float* ssq_in; bf16_t* obf; float* ssq_out;
    DEVINL void operator()(const f32x4 (&acc)[2][2][4][2], const pg8::Unit& u, int wr, int wc, int fr, int fq) const {
        { const int t_ = ltid(); fr = t_ & 15; fq = (t_ >> 4) & 3; wc = __builtin_amdgcn_readfirstlane((t_ >> 6) & 3); wr = __builtin_amdgcn_readfirstlane(t_ >> 8); }
#pragma unroll
        for (int ai = 0; ai < 2; ++ai)
#pragma unroll
            for (int m = 0; m < 4; ++m) { const int t = u.pm * 256 + 128 * ai + 64 * wr + 16 * m + fr; const size_t o = (size_t)t * DM + u.pn * 256 + 64 * wc + 8 * fq;
                const float rt = row_rscale(ssq_in, t, fq); float ss = 0.f;
#pragma unroll
                for (int bj = 0; bj < 2; ++bj) { const f32x4 x0 = *(const f32x4*)(xa + o + 32 * bj), x1 = *(const f32x4*)(xa + o + 32 * bj + 4); const u32x4 pw = *(const u32x4*)(pp + o + 32 * bj); f32x4 r0, r1;
                    const float pv[8] = {bflo(pw.x), bfhi(pw.x), bflo(pw.y), bfhi(pw.y), bflo(pw.z), bfhi(pw.z), bflo(pw.w), bfhi(pw.w)};
#pragma unroll
                    for (int jj = 0; jj < 4; ++jj) { r0[jj] = x0[jj] + pv[jj] * fsigmoid(rt * acc[ai][bj][m][0][jj]); r1[jj] = x1[jj] + pv[4 + jj] * fsigmoid(rt * acc[ai][bj][m][1][jj]); }
                    __builtin_nontemporal_store(r0, (f32x4*)(out + o + 32 * bj)); __builtin_nontemporal_store(r1, (f32x4*)(out + o + 32 * bj + 4));
                    if (obf) { *(u32x4*)(obf + o + 32 * bj) = pack8(r0, r1); ss += sq4(r0) + sq4(r1); } }
                if (obf) { ss = quad_sum(ss); if (fq == 0) ssq_out[(size_t)t * 16 + u.pn * 4 + wc] = ss; } } } };
struct EpiUq8 { static constexpr bool PERM = true, AFTER_DRAIN = false; Params P; int l;
    DEVINL void operator()(const f32x4 (&acc)[2][2][4][2], const pg8::Unit& u, int wr, int wc, int fr, int fq) const {
        { const int t_ = ltid(); fr = t_ & 15; fq = (t_ >> 4) & 3; wc = __builtin_amdgcn_readfirstlane((t_ >> 6) & 3); wr = __builtin_amdgcn_readfirstlane(t_ >> 8); }
        const int chunk = u.pn * 4 + wc; if (chunk >= 6) return;
        const float* cqss = (const float*)(P.ws + OFF_CQSS); bf16_t* qm = (bf16_t*)((char*)P.out + OOFF_QM); const float2* rope = (const float2*)(P.ws + OFF_ROPE);
#pragma unroll
        for (int ai = 0; ai < 2; ++ai)
#pragma unroll
            for (int m = 0; m < 4; ++m) {
                const int t = u.pm * 256 + 128 * ai + 64 * wr + 16 * m + fr, b = t >> 12, s = t & 4095;
                const float rt = rsqrtf(quad_sum(cqss[(size_t)t * 4 + fq]) * (1.0f / 256.0f) + EPS);
                const f32x4 a[2][2] = {{acc[ai][0][m][0] * rt, acc[ai][0][m][1] * rt}, {acc[ai][1][m][0] * rt, acc[ai][1][m][1] * rt}};
                if (chunk < 4) {
                    const float* gain = P.mla_nope_gain + ((size_t)l * 2 + 0) * 64 + 8 * fq;
                    float ss = sq4(a[0][0]) + sq4(a[0][1]) + sq4(a[1][0]) + sq4(a[1][1]); ss = quad_sum(ss); const float r = rsqrtf(ss * (1.0f / 64.0f) + EPS) * SC_MLA;
                    bf16_t* d = qm + ((size_t)(b * 4 + chunk) * SEQ + s) * 96 + 8 * fq;
#pragma unroll
                    for (int bj = 0; bj < 2; ++bj) { const f32x4 g0 = *(const f32x4*)(gain + 32 * bj), g1 = *(const f32x4*)(gain + 32 * bj + 4); *(u32x4*)(d + 32 * bj) = pack8(a[bj][0] * r * g0, a[bj][1] * r * g1); }
                } else {
                    const float* gr = P.mla_rope_gain + ((size_t)l * 2 + 0) * 32; const f32x4 g1 = *(const f32x4*)(gr + 4 * fq), g2 = *(const f32x4*)(gr + 16 + 4 * fq);
#pragma unroll
                    for (int bj = 0; bj < 2; ++bj) { const int h = (chunk - 4) * 2 + bj;
                        float ss = sq4(a[bj][0]) + sq4(a[bj][1]); ss = quad_sum(ss); const float r = rsqrtf(ss * (1.0f / 32.0f) + EPS);
                        float o1[4], o2[4];
#pragma unroll
                        for (int j = 0; j < 4; ++j) { const float2 cs = rope[s * 16 + 4 * fq + j]; const float x1 = a[bj][0][j] * r * g1[j], x2 = a[bj][1][j] * r * g2[j]; o1[j] = (x1 * cs.x - x2 * cs.y) * SC_MLA; o2[j] = (x1 * cs.y + x2 * cs.x) * SC_MLA; }
                        bf16_t* d = qm + ((size_t)(b * 4 + h) * SEQ + s) * 96 + 64 + 4 * fq; store4bf(d, o1[0], o1[1], o1[2], o1[3]); store4bf(d + 16, o2[0], o2[1], o2[2], o2[3]); }
                }
            }
    }
};
struct EpiUkv8 { static constexpr bool PERM = true, AFTER_DRAIN = false; Params P; int l;
    DEVINL void operator()(const f32x4 (&acc)[2][2][4][2], const pg8::Unit& u, int wr, int wc, int fr, int fq) const {
        { const int t_ = ltid(); fr = t_ & 15; fq = (t_ >> 4) & 3; wc = __builtin_amdgcn_readfirstlane((t_ >> 6) & 3); wr = __builtin_amdgcn_readfirstlane(t_ >> 8); }
        const int chunk = u.pn * 4 + wc, h = chunk >> 1; const bool isk = (chunk & 1) == 0;
        const float* ckvss = (const float*)(P.ws + OFF_CKVSS); bf16_t* km = (bf16_t*)((char*)P.out + OOFF_KM); bf16_t* vm = (bf16_t*)((char*)P.out + OOFF_VM);
        const float* gain = P.mla_nope_gain + ((size_t)l * 2 + 1) * 64 + 8 * fq;
#pragma unroll
        for (int ai = 0; ai < 2; ++ai)
#pragma unroll
            for (int m = 0; m < 4; ++m) {
                const int t = u.pm * 256 + 128 * ai + 64 * wr + 16 * m + fr, b = t >> 12, s = t & 4095;
                const float rt = rsqrtf(quad_sum(fq < 2 ? ckvss[(size_t)t * 2 + fq] : 0.f) * (1.0f / 128.0f) + EPS);
                const f32x4 a[2][2] = {{acc[ai][0][m][0] * rt, acc[ai][0][m][1] * rt}, {acc[ai][1][m][0] * rt, acc[ai][1][m][1] * rt}};
                if (isk) { float ss = sq4(a[0][0]) + sq4(a[0][1]) + sq4(a[1][0]) + sq4(a[1][1]); ss = quad_sum(ss); const float r = rsqrtf(ss * (1.0f / 64.0f) + EPS);
                    bf16_t* d = km + ((size_t)(b * 4 + h) * SEQ + s) * 96 + 8 * fq;
#pragma unroll
                    for (int bj = 0; bj < 2; ++bj) { const f32x4 g0 = *(const f32x4*)(gain + 32 * bj), g1 = *(const f32x4*)(gain + 32 * bj + 4); *(u32x4*)(d + 32 * bj) = pack8(a[bj][0] * r * g0, a[bj][1] * r * g1); }
                } else { bf16_t* d = vm + ((size_t)(b * 4 + h) * SEQ + s) * 64 + 8 * fq;
#pragma unroll
                    for (int bj = 0; bj < 2; ++bj) *(u32x4*)(d + 32 * bj) = pack8(a[bj][0], a[bj][1]); }
            }
    }
};
template <class Epi> DEVINL void gemm8(const bf16_t* A, const bf16_t* Bt, int M, int N, int K, const Epi& E, char* smem) {
    int G = (int)gridDim.x, c = (int)blockIdx.x; asm volatile("" : "+s"(G), "+s"(c));
    pg8::Gemm g{A, Bt, M, N, K}; pg8::StaticOrder S; S.init(M, N, G, c);
    pg8::gemm_phase<Epi, pg8::StaticOrder, true, true>((PG8_LAS unsigned char*)smem, g, S, E);
}

DEVINL void kmean_unit(const Params& P, int u, char* smem) {
    float* red = (float*)smem; const bf16_t* K = (const bf16_t*)(P.ws + OFF_QKV + 4 * SZ_HEADBUF); float* km = (float*)(P.ws + OFF_KMEAN);
    const int tid = ltid(), dc = tid & 7, rg = tid >> 3;
    const bf16_t* kp = K + ((size_t)(u >> 4) * SEQ + (u & 15) * 256 + rg) * 64 + dc * 8;
    u32x4 w[4];
#pragma unroll
    for (int i = 0; i < 4; ++i) w[i] = *(const u32x4*)(kp + (size_t)i * 64 * 64);
    float s[8] = {0.f, 0.f, 0.f, 0.f, 0.f, 0.f, 0.f, 0.f};
#pragma unroll
    for (int i = 0; i < 4; ++i) { s[0] += bflo(w[i].x); s[1] += bfhi(w[i].x); s[2] += bflo(w[i].y); s[3] += bfhi(w[i].y); s[4] += bflo(w[i].z); s[5] += bfhi(w[i].z); s[6] += bflo(w[i].w); s[7] += bfhi(w[i].w); }
    __syncthreads();
#pragma unroll
    for (int e = 0; e < 8; ++e) red[rg * 65 + dc * 8 + e] = s[e];
    __syncthreads();
    if (tid < 64) { float a = 0.f;
#pragma unroll 8
        for (int i = 0; i < 64; ++i) a += red[i * 65 + tid];
        km[(size_t)u * 64 + tid] = a * (1.0f / 256.0f); }
}

typedef float f32x16 __attribute__((ext_vector_type(16)));
typedef short s16x4 __attribute__((ext_vector_type(4)));
typedef short v4i16_t __attribute__((ext_vector_type(4)));
#define LAS __attribute__((address_space(3)))
#define MFMA32(a, b, c) __builtin_amdgcn_mfma_f32_32x32x16_bf16(a, b, c, 0, 0, 0)
DEVINL s16x4 vtr(const LAS char* p) { return __builtin_bit_cast(s16x4, __builtin_amdgcn_ds_read_tr16_b64_v4i16((LAS v4i16_t*)p)); }
DEVINL float swap_max(float v) { auto rr = __builtin_amdgcn_permlane32_swap(__float_as_uint(v), __float_as_uint(v), false, false); return fmaxf(__uint_as_float(rr[0]), __uint_as_float(rr[1])); }
DEVINL float swap_sum(float v) { auto rr = __builtin_amdgcn_permlane32_swap(__float_as_uint(v), __float_as_uint(v), false, false); return __uint_as_float(rr[0]) + __uint_as_float(rr[1]); }
DEVINL float fadd1(float a, float b) { float r; asm("v_add_f32 %0, %1, %2" : "=v"(r) : "v"(a), "v"(b)); return r; }
DEVINL constexpr int crow(int r) { return (r & 3) + 8 * (r >> 2); }

constexpr int KSLOT = 64 * 144, RSLOT = 64 * 80;
constexpr int L_KB = 0, L_VB = 3 * KSLOT, L_KR = L_VB + 16384, L_AUX = L_KR + 3 * RSLOT, L_SCR = L_AUX + 16640 + 256, L_KMS = L_SCR + 2048, L_ATT_END = L_KMS + 4096;
constexpr float NEGBIG = -3.0e38f, THR = 8.0f;

template <int MODE>
DEVINL void attn_unit(const Params& P, int l, int u, char* smem) {
    constexpr int DK = MODE == 2 ? 96 : 64, ND0 = DK / 16;
    LAS char* lds = (LAS char*)smem;
    const int tid = ltid(), lane = tid & 63, r32 = lane & 31, hi = lane >> 5; const int wid = __builtin_amdgcn_readfirstlane(tid >> 6);
    const bool fast = ((const float*)(P.ws + OFF_BOUND))[l * 4 + MODE] < 100.0f;
    int bh, q0, t_lo, t_hi, dil = 1, res = 0, pat = 0, qb = 0;
    if (MODE != 3) { bh = u & 15; qb = 15 - (u >> 4); q0 = qb * 256; t_lo = 0; t_hi = (q0 + 255) >> 6; }
    else { pat = u >> 8; const int v = u & 255; bh = v & 15; const int w = v >> 4; dil = pat == 0 ? 1 : (pat == 1 ? 4 : 16); res = w % dil; q0 = (w / dil) * 256; t_lo = (q0 >= 128 ? q0 - 128 : 0) >> 6; t_hi = (q0 + 255) >> 6; }
    const int b = bh >> 2, h = bh & 3;
    const bf16_t *Qg, *Kg, *Vg; int rsq, rsk, rsv;
    if (MODE == 0) { Qg = (const bf16_t*)(P.ws + OFF_QKV) + (size_t)bh * SEQ * 64; Kg = Qg + SZ_HEADBUF / 2; Vg = Kg + SZ_HEADBUF / 2; rsq = rsk = rsv = 64; }
    else if (MODE == 1) { Qg = (const bf16_t*)(P.ws + OFF_QKV + 3 * SZ_HEADBUF) + (size_t)bh * SEQ * 64; Kg = Qg + SZ_HEADBUF / 2; Vg = Kg + SZ_HEADBUF / 2; rsq = rsk = rsv = 64; }
    else if (MODE == 2) { Qg = (const bf16_t*)((const char*)P.out + OOFF_QM) + (size_t)bh * SEQ * 96; Kg = (const bf16_t*)((const char*)P.out + OOFF_KM) + (size_t)bh * SEQ * 96; Vg = (const bf16_t*)((const char*)P.out + OOFF_VM) + (size_t)bh * SEQ * 64; rsq = rsk = 96; rsv = 64; }
    else { Qg = (const bf16_t*)(P.ws + OFF_QKV + 6 * SZ_HEADBUF) + ((size_t)bh * SEQ + res) * 64; Kg = Qg + SZ_HEADBUF / 2; Vg = Kg + SZ_HEADBUF / 2; rsq = rsk = rsv = 64 * dil; }
    const int qw = q0 + 32 * wid;

    __syncthreads();
    const unsigned kgo = (unsigned)((tid >> 3) * rsk + (tid & 7) * 8), vgo = (unsigned)(((tid >> 2) & 63) * rsv + (tid >> 8) * 32 + (tid & 3) * 8), rgo = (unsigned)(((tid >> 2) & 63) * rsk + 64 + (tid & 3) * 8);
    const int kws = (tid >> 3) * 144 + (tid & 7) * 16;
    const int rws = ((tid >> 2) & 63) * 80 + (tid & 3) * 16;
    u32x4 kA, rA, kB, rB;
#define ATT_LOADK(j, K_, R_) do { if ((j) <= t_hi) { K_ = *(const u32x4*)(Kg + (size_t)(j) * 64 * rsk + kgo); if (MODE == 2 && tid < 256) R_ = *(const u32x4*)(Kg + (size_t)(j) * 64 * rsk + rgo); } } while (0)
#define ATT_DMAV(j, slot) do { if ((j) <= t_hi) __builtin_amdgcn_global_load_lds((const unsigned*)(Vg + (size_t)(j) * 64 * rsv + vgo), (LAS unsigned*)(lds + L_VB + (slot) * 8192 + wid * 1024), 16, 0, 0); } while (0)
#define ATT_WRITEK(slot, j, K_, R_) do { if ((j) <= t_hi) { *(LAS u32x4*)(lds + L_KB + (slot) * KSLOT + kws) = K_; if (MODE == 2 && tid < 256) *(LAS u32x4*)(lds + L_KR + (slot) * RSLOT + rws) = R_; \
        if (MODE == 0 && tid < 64) { const float bs = aux[(j) * 64 + tid] - auxU; const unsigned hb = cvt2(bs, 0.f) & 0xffffu; const float lo = bs - __uint_as_float(hb << 16); u32x4 w; w.x = hb | (cvt2(lo, 0.f) << 16); w.y = 0x3F80u; w.z = 0u; w.w = 0u; \
            *(LAS u32x4*)(lds + L_KR + (slot) * 1024 + tid * 16) = w; } } } while (0)
    bf16x8 qf[ND0];
    { const bf16_t* qp = Qg + (size_t)(qw + r32) * rsq + 8 * hi;
#pragma unroll
      for (int d0 = 0; d0 < ND0; ++d0) qf[d0] = *(const bf16x8*)(qp + 16 * d0); }
    if (MODE != 0) { ATT_LOADK(t_lo, kA, rA); ATT_LOADK(t_lo + 1, kB, rB); }
    LAS float* aux = (LAS float*)(lds + L_AUX);
    if (MODE == 0) {
        LAS float* tot = (LAS float*)(lds + L_SCR);
        const float* lf = (const float*)(P.ws + OFF_LOGF) + (size_t)bh * SEQ + tid * 8; float v[8]; float run = 0.f;
        { const f32x4 a = *(const f32x4*)lf, c = *(const f32x4*)(lf + 4); v[0] = a[0]; v[1] = a[1]; v[2] = a[2]; v[3] = a[3]; v[4] = c[0]; v[5] = c[1]; v[6] = c[2]; v[7] = c[3]; }
#pragma unroll
        for (int i = 0; i < 8; ++i) { run += v[i]; v[i] = run; }
        tot[tid] = run; __syncthreads();
        if (tid < 64) { float a[8]; float acc = 0.f;
#pragma unroll
            for (int i = 0; i < 8; ++i) { acc += tot[tid * 8 + i]; a[i] = acc; }
            float incl = acc;
#pragma unroll
            for (int o = 1; o < 64; o <<= 1) { const float nb = shup(incl, o); if (tid >= o) incl += nb; }
            const float ex = incl - acc; tot[tid * 8] = ex;
#pragma unroll
            for (int i = 1; i < 8; ++i) tot[tid * 8 + i] = ex + a[i - 1]; }
        __syncthreads();
        const float base = tot[tid];
#pragma unroll
        for (int i = 0; i < 8; ++i) aux[tid * 8 + i] = -(base + v[i]);
        if (tid < 4) ((LAS unsigned*)(lds + L_KR + 3072))[tid] = 0u;
    } else if (MODE == 1) {
        const float* lut = (const float*)(P.ws + OFF_LUT) + (size_t)h * 4096;
        for (int i = ((4095 - (q0 + 255)) & ~3) + 4 * tid; i < 4160; i += 4 * NTHREADS) {
            f32x4 v = (f32x4){0.f, 0.f, 0.f, 0.f}; if (i < 4096) { const f32x4 s = *(const f32x4*)(lut + 4092 - i); v = (f32x4){s[3], s[2], s[1], s[0]}; }
            *(LAS f32x4*)(aux + i) = v; }
        if (tid < 64) aux[4160 + tid] = -INFINITY;
        LAS float* kms = (LAS float*)(lds + L_KMS); const float* km = (const float*)(P.ws + OFF_KMEAN) + (size_t)bh * 1024;
        for (int i = tid; i < 1024; i += NTHREADS) kms[i] = km[i];
    } else if (MODE == 3) {
        const float* lut = (const float*)(P.ws + OFF_LUT) + (size_t)(4 + h) * 4096;
        if (tid < 320) { const int rel = 255 - tid; aux[tid] = (rel >= 0 && rel * dil < 4096) ? lut[rel * dil] : 0.f; }
    }
    if (MODE == 0 && fast) {
        __syncthreads();
        const float bnd = ((const float*)(P.ws + OFF_BOUND))[l * 4 + (tid >> 30)];
        const bool sk = (lane <= t_hi) && ((aux[64 * lane + 63] - aux[q0]) + bnd < -150.0f);
        t_lo = (int)__builtin_popcountll(__ballot(sk));
    }
    __syncthreads();
    bf16x8 qx = {0, 0, 0, 0, 0, 0, 0, 0}; float auxU = 0.f;
    if (MODE == 0) { auxU = aux[q0 + 255]; const float sh = auxU - aux[qw + r32];
        if (hi == 0) { u32x4 w; w.x = 0x3F803F80u; w.y = cvt2(sh, 0.f); w.z = 0u; w.w = 0u; qx = __builtin_bit_cast(bf16x8, w); } }
    unsigned sel = 0;
    if (MODE == 1) {
        const LAS float* kms = (const LAS float*)(lds + L_KMS); float gt[15];
#pragma unroll
        for (int n = 0; n < 15; ++n) { float s = 0.f;
            if (n < qb) {
#pragma unroll
                for (int d0 = 0; d0 < 4; ++d0) { const f32x4 ka = *(const LAS f32x4*)(kms + n * 64 + 16 * d0 + 8 * hi), kb = *(const LAS f32x4*)(kms + n * 64 + 16 * d0 + 8 * hi + 4);
                    const u32x4 w = __builtin_bit_cast(u32x4, qf[d0]);
                    s += bflo(w.x) * ka[0] + bfhi(w.x) * ka[1] + bflo(w.y) * ka[2] + bfhi(w.y) * ka[3] + bflo(w.z) * kb[0] + bfhi(w.z) * kb[1] + bflo(w.w) * kb[2] + bfhi(w.w) * kb[3]; }
                s = swap_sum(s); }
            gt[n] = s; }
#pragma unroll
        for (int k = 0; k < 3; ++k) { float best = NEGBIG; int bi = -1;
#pragma unroll
            for (int n = 0; n < 15; ++n) if (n < qb && !((sel >> n) & 1u) && gt[n] > best) { best = gt[n]; bi = n; }
            if (bi >= 0) sel |= 1u << bi; }
        sel |= 1u << qb;
    }
    const int kfo = L_KB + r32 * 144 + hi * 16, rfo = L_KR + r32 * 80 + hi * 16;
    const int vfo = L_VB + ((lane >> 4) & 1) * 32 + (lane & 3) * 8 + (4 * hi + ((lane & 15) >> 2)) * 64;

    f32x16 o0, o1;
#pragma unroll
    for (int r = 0; r < 16; ++r) { o0[r] = 0.f; o1[r] = 0.f; }
    float m = fast ? 0.f : NEGBIG, lsum = 0.f;

    auto anysel = [&](int j) -> bool { return MODE != 1 || __any((sel >> (j >> 2)) & 1u); };
    auto is_full = [&](int j) -> bool {
        bool f = fast && (64 * j + 63 <= qw) && anysel(j);
        if (MODE == 3) f = f && (64 * j >= qw + 31 - 128);
        return f; };
    auto stage_a = [&](int j, int ks, int kb, f32x16& p) {
        if (MODE == 1 || MODE == 3) { const LAS float* lp = aux + ((MODE == 1 ? 4095 : 255) - (qw + r32 - 64 * j - 4 * hi));
            if (MODE == 1) lp = ((sel >> (j >> 2)) & 1u) ? lp : aux + 4160;
#pragma unroll
            for (int r = 0; r < 16; ++r) p[r] = lp[crow(r) + 32 * kb];
        } else {
#pragma unroll
            for (int r = 0; r < 16; ++r) p[r] = 0.f;
        }
        const LAS char* kb_ = lds + ks * KSLOT + kb * (32 * 144) + kfo;
#pragma unroll
        for (int d0 = 0; d0 < 4; ++d0) p = MFMA32(*(const LAS bf16x8*)(kb_ + d0 * 32), qf[d0], p);
        if (MODE == 2) { const LAS char* rb_ = lds + ks * RSLOT + kb * (32 * 80) + rfo;
#pragma unroll
            for (int d0 = 0; d0 < 2; ++d0) p = MFMA32(*(const LAS bf16x8*)(rb_ + d0 * 32), qf[4 + d0], p); }
        if (MODE == 0) p = MFMA32(*(const LAS bf16x8*)(lds + (hi ? (L_KR + 3072) : (L_KR + ks * 1024 + kb * 512 + r32 * 16))), qx, p);
    };
    auto stage_b = [&](int j, f32x16& p, u32x4& wa, u32x4& wb) {
#pragma unroll
        for (int r = 0; r < 16; ++r) { p[r] = __builtin_amdgcn_exp2f(p[r]); lsum += p[r]; }
        wa.x = cvt2(p[0], p[1]); wa.y = cvt2(p[2], p[3]); wa.z = cvt2(p[4], p[5]); wa.w = cvt2(p[6], p[7]);
        wb.x = cvt2(p[8], p[9]); wb.y = cvt2(p[10], p[11]); wb.z = cvt2(p[12], p[13]); wb.w = cvt2(p[14], p[15]);
        asm volatile("" : "+v"(lsum));
    };
    auto stage_c = [&](int vs, int kb, const u32x4& wa, const u32x4& wb) {
        const LAS char* vb_ = lds + vs * 8192 + vfo + kb * 2048;
        { const s16x4 a0 = vtr(vb_), a1 = vtr(vb_ + 512), c0 = vtr(vb_ + 4096), c1 = vtr(vb_ + 4096 + 512);
          o0 = MFMA32(__builtin_shufflevector(a0, a1, 0, 1, 2, 3, 4, 5, 6, 7), __builtin_bit_cast(bf16x8, wa), o0); o1 = MFMA32(__builtin_shufflevector(c0, c1, 0, 1, 2, 3, 4, 5, 6, 7), __builtin_bit_cast(bf16x8, wa), o1); }
        { const s16x4 a0 = vtr(vb_ + 1024), a1 = vtr(vb_ + 1024 + 512), c0 = vtr(vb_ + 4096 + 1024), c1 = vtr(vb_ + 4096 + 1024 + 512);
          o0 = MFMA32(__builtin_shufflevector(a0, a1, 0, 1, 2, 3, 4, 5, 6, 7), __builtin_bit_cast(bf16x8, wb), o0); o1 = MFMA32(__builtin_shufflevector(c0, c1, 0, 1, 2, 3, 4, 5, 6, 7), __builtin_bit_cast(bf16x8, wb), o1); }
    };
    auto general = [&](int t, int ks, int vs) {
        const int k0 = t * 64; const bool selected = MODE != 1 || ((sel >> (t >> 2)) & 1u); const bool asel = anysel(t);
        int dl = qw + r32 - k0 - 4 * hi; asm volatile("" : "+v"(dl));
#pragma unroll
        for (int kb = 0; kb < 2; ++kb) {
            const int kh = k0 + 32 * kb;
            bool act = kh <= qw + 31 && asel, need_mask = kh + 31 > qw;
            if (MODE == 3) { act = act && (kh + 31 >= qw - 128); need_mask = need_mask || (kh < qw + 31 - 128); }
            if (!act) continue;
            f32x16 p;
            if (MODE == 1 || MODE == 3) { const LAS float* lp = aux + ((MODE == 1 ? 4095 : 255) - dl);
#pragma unroll
                for (int r = 0; r < 16; ++r) p[r] = lp[crow(r) + 32 * kb];
            } else {
#pragma unroll
                for (int r = 0; r < 16; ++r) p[r] = 0.f;
            }
            const LAS char* kb_ = lds + ks * KSLOT + kb * (32 * 144) + kfo;
#pragma unroll
            for (int d0 = 0; d0 < 4; ++d0) p = MFMA32(*(const LAS bf16x8*)(kb_ + d0 * 32), qf[d0], p);
            if (MODE == 2) { const LAS char* rb_ = lds + ks * RSLOT + kb * (32 * 80) + rfo;
#pragma unroll
                for (int d0 = 0; d0 < 2; ++d0) p = MFMA32(*(const LAS bf16x8*)(rb_ + d0 * 32), qf[4 + d0], p); }
            if (MODE == 0) p = MFMA32(*(const LAS bf16x8*)(lds + (hi ? (L_KR + 3072) : (L_KR + ks * 1024 + kb * 512 + r32 * 16))), qx, p);
            if (need_mask) {
#pragma unroll
                for (int r = 0; r < 16; ++r) { const int rel = dl - crow(r) - 32 * kb; const bool v = MODE == 3 ? ((unsigned)rel <= 128u) : (rel >= 0); p[r] = v ? p[r] : -INFINITY; }
            }
            float ps = 0.f;
            if (fast) {
#pragma unroll
                for (int r = 0; r < 16; ++r) { p[r] = __builtin_amdgcn_exp2f(p[r]); ps += p[r]; }
            } else {
                float mx = fmaxf(p[0], p[1]);
#pragma unroll
                for (int r = 2; r < 16; ++r) mx = fmaxf(mx, p[r]);
                mx = swap_max(mx);
                if (MODE == 1) mx = selected ? mx : NEGBIG;
                if (__any(mx > m + THR)) {
                    const float mn = fmaxf(m, mx), alpha = __builtin_amdgcn_exp2f(m - mn); m = mn; lsum *= alpha;
#pragma unroll
                    for (int r = 0; r < 16; ++r) { o0[r] *= alpha; o1[r] *= alpha; }
                }
#pragma unroll
                for (int r = 0; r < 16; ++r) { p[r] = __builtin_amdgcn_exp2f(p[r] - m); ps += p[r]; }
            }
            u32x4 w0, w1;
            w0.x = cvt2(p[0], p[1]); w0.y = cvt2(p[2], p[3]); w0.z = cvt2(p[4], p[5]); w0.w = cvt2(p[6], p[7]);
            w1.x = cvt2(p[8], p[9]); w1.y = cvt2(p[10], p[11]); w1.z = cvt2(p[12], p[13]); w1.w = cvt2(p[14], p[15]);
            if (MODE == 1) { const unsigned mk = selected ? 0xffffffffu : 0u; ps = selected ? ps : 0.f; w0 = w0 & mk; w1 = w1 & mk; }
            lsum += ps;
            const bf16x8 pb0 = __builtin_bit_cast(bf16x8, w0), pb1 = __builtin_bit_cast(bf16x8, w1);
            const LAS char* vb_ = lds + vs * 8192 + vfo + kb * 2048;
            { const s16x4 a0 = vtr(vb_), a1 = vtr(vb_ + 512), c0 = vtr(vb_ + 4096), c1 = vtr(vb_ + 4096 + 512);
              o0 = MFMA32(__builtin_shufflevector(a0, a1, 0, 1, 2, 3, 4, 5, 6, 7), pb0, o0); o1 = MFMA32(__builtin_shufflevector(c0, c1, 0, 1, 2, 3, 4, 5, 6, 7), pb0, o1); }
            { const s16x4 a0 = vtr(vb_ + 1024), a1 = vtr(vb_ + 1024 + 512), c0 = vtr(vb_ + 4096 + 1024), c1 = vtr(vb_ + 4096 + 1024 + 512);
              o0 = MFMA32(__builtin_shufflevector(a0, a1, 0, 1, 2, 3, 4, 5, 6, 7), pb1, o0); o1 = MFMA32(__builtin_shufflevector(c0, c1, 0, 1, 2, 3, 4, 5, 6, 7), pb1, o1); }
        }
    };

    if (MODE == 0) { ATT_LOADK(t_lo, kA, rA); ATT_LOADK(t_lo + 1, kB, rB); }
    ATT_DMAV(t_lo, 0); ATT_DMAV(t_lo + 1, 1);
    ATT_WRITEK(0, t_lo, kA, rA); ATT_WRITEK(1, t_lo + 1, kB, rB);
    __syncthreads();
    ATT_LOADK(t_lo + 2, kA, rA);
    int ks0 = 0, ks1 = 1, ks2 = 2, vs = 0;
    bool pend = is_full(t_lo);
    f32x16 sa0, sa1, sb0, sb1;
    if (pend) { stage_a(t_lo, 0, 0, sa0); stage_a(t_lo, 0, 1, sa1); }
    auto advance = [&](const int t) {
        ATT_WRITEK(ks2, t + 2, kA, rA);
        __syncthreads();
        ATT_DMAV(t + 2, vs); ATT_LOADK(t + 3, kA, rA);
        { const int tmp = ks0; ks0 = ks1; ks1 = ks2; ks2 = tmp; } vs ^= 1;
    };
    auto steady = [&](const int t, f32x16& c0, f32x16& c1, f32x16& n0, f32x16& n1) {
        u32x4 wa, wb, wc, wd;
        stage_a(t + 1, ks1, 0, n0); stage_b(t, c0, wa, wb); __builtin_amdgcn_sched_barrier(0);
        stage_a(t + 1, ks1, 1, n1); stage_c(vs, 0, wa, wb); stage_b(t, c1, wc, wd); __builtin_amdgcn_sched_barrier(0);
        stage_c(vs, 1, wc, wd);
        advance(t);
    };
    int t = t_lo;
    while (t <= t_hi) {
        if (pend) while (t + 2 <= t_hi && is_full(t + 1) && is_full(t + 2)) { steady(t, sa0, sa1, sb0, sb1); steady(t + 1, sb0, sb1, sa0, sa1); t += 2; }
        const bool nxt = (t + 1 <= t_hi) && is_full(t + 1);
        if (pend) { u32x4 wa, wb; stage_b(t, sa0, wa, wb); stage_c(vs, 0, wa, wb); stage_b(t, sa1, wa, wb); stage_c(vs, 1, wa, wb); } else general(t, ks0, vs);
        if (nxt) { stage_a(t + 1, ks1, 0, sa0); stage_a(t + 1, ks1, 1, sa1); }
        pend = nxt;
        advance(t);
        ++t;
    }
#undef ATT_LOADK
#undef ATT_DMAV
#undef ATT_WRITEK
    const int te_ = ltid(), r32e = te_ & 31, hie = (te_ >> 5) & 1, qwe = q0 + 32 * (te_ >> 6);
    const float ltot = swap_sum(lsum), inv = 1.0f / ltot;
    if (MODE != 3) {
        const size_t tok = (size_t)b * SEQ + qwe + r32e; const int colbase = (MODE == 0 ? 0 : (MODE == 1 ? 256 : 768)) + h * 64 + 4 * hie;
        const bf16_t* G = (const bf16_t*)((const char*)P.out + OOFF_G) + tok * DM + colbase; bf16_t* A2 = (bf16_t*)(P.ws + OFF_H) + tok * DM + colbase;
#pragma unroll
        for (int g = 0; g < 4; ++g) {
            const u32x2 g0 = *(const u32x2*)(G + 8 * g), g1 = *(const u32x2*)(G + 32 + 8 * g); u32x2 w0, w1;
            w0.x = cvt2(o0[4 * g] * inv * bflo(g0.x), o0[4 * g + 1] * inv * bfhi(g0.x)); w0.y = cvt2(o0[4 * g + 2] * inv * bflo(g0.y), o0[4 * g + 3] * inv * bfhi(g0.y));
            w1.x = cvt2(o1[4 * g] * inv * bflo(g1.x), o1[4 * g + 1] * inv * bfhi(g1.x)); w1.y = cvt2(o1[4 * g + 2] * inv * bflo(g1.y), o1[4 * g + 3] * inv * bfhi(g1.y));
            *(u32x2*)(A2 + 8 * g) = w0; *(u32x2*)(A2 + 32 + 8 * g) = w1; }
    } else {
        const size_t tok = (size_t)b * SEQ + (size_t)(qwe + r32e) * dil + res;
        bf16_t* dp = (bf16_t*)(P.ws + OFF_DPART) + ((size_t)pat * NT + tok) * 256 + h * 64 + 4 * hie;
#pragma unroll
        for (int g = 0; g < 4; ++g) { u32x2 w0, w1;
            w0.x = cvt2(o0[4 * g] * inv, o0[4 * g + 1] * inv); w0.y = cvt2(o0[4 * g + 2] * inv, o0[4 * g + 3] * inv);
            w1.x = cvt2(o1[4 * g] * inv, o1[4 * g + 1] * inv); w1.y = cvt2(o1[4 * g + 2] * inv, o1[4 * g + 3] * inv);
            *(u32x2*)(dp + 8 * g) = w0; *(u32x2*)(dp + 32 + 8 * g) = w1; }
        if (hie == 0) ((float*)(P.ws + OFF_DLSE))[((size_t)pat * NT + tok) * 4 + h] = m + __builtin_amdgcn_logf(ltot);
    }
}

DEVINL void dil_unit(const Params& P, int l, int u, char* smem) {
    LAS char* lds = (LAS char*)smem;
    const int tid = ltid(), lane = tid & 63, r32 = lane & 31, hi = lane >> 5; const int wid = __builtin_amdgcn_readfirstlane(tid >> 6);
    const int pat = u >> 8, v = u & 255, bh = v & 15, w = v >> 4, dil = pat == 0 ? 1 : (pat == 1 ? 4 : 16), res = w % dil, q0 = (w / dil) * 256;
    const int t_lo = (q0 >= 128 ? q0 - 128 : 0) >> 6, t_hi = (q0 + 255) >> 6, nt = t_hi - t_lo + 1;
    const int b = bh >> 2, h = bh & 3, rs = 64 * dil;
    const bf16_t* Qg = (const bf16_t*)(P.ws + OFF_QKV + 6 * SZ_HEADBUF) + ((size_t)bh * SEQ + res) * 64; const bf16_t* Kg = Qg + SZ_HEADBUF / 2; const bf16_t* Vg = Kg + SZ_HEADBUF / 2;
    const int qw = q0 + 32 * wid;
    constexpr int D_KB = 0, D_VB = 6 * KSLOT, D_AUX = D_VB + 6 * 8192;
    LAS float* aux = (LAS float*)(lds + D_AUX);
    __syncthreads();
    const unsigned kgo = (unsigned)((tid >> 3) * rs + (tid & 7) * 8), vgo = (unsigned)(((tid >> 2) & 63) * rs + (tid >> 8) * 32 + (tid & 3) * 8);
    u32x4 kr[6], vr[6];
#pragma unroll
    for (int j = 0; j < 6; ++j) if (j < nt) { kr[j] = *(const u32x4*)(Kg + (size_t)(t_lo + j) * 64 * rs + kgo); vr[j] = *(const u32x4*)(Vg + (size_t)(t_lo + j) * 64 * rs + vgo); }
    bf16x8 qf[4];
    { const bf16_t* qp = Qg + (size_t)(qw + r32) * rs + 8 * hi;
#pragma unroll
      for (int d0 = 0; d0 < 4; ++d0) qf[d0] = *(const bf16x8*)(qp + 16 * d0); }
    { const float* lut = (const float*)(P.ws + OFF_LUT) + (size_t)(4 + h) * 4096;
      if (tid < 320) { const int rel = 255 - tid; aux[tid] = (rel >= 0 && rel * dil < 4096) ? lut[rel * dil] : 0.f; } }
    { const int kws = (tid >> 3) * 144 + (tid & 7) * 16;
#pragma unroll
      for (int j = 0; j < 6; ++j) if (j < nt) { *(LAS u32x4*)(lds + D_KB + j * KSLOT + kws) = kr[j]; *(LAS u32x4*)(lds + D_VB + j * 8192 + tid * 16) = vr[j]; } }
    __syncthreads();
    const int kfo = D_KB + r32 * 144 + hi * 16;
    const int vfo = D_VB + ((lane >> 4) & 1) * 32 + (lane & 3) * 8 + (4 * hi + ((lane & 15) >> 2)) * 64;
    f32x16 o0, o1;
#pragma unroll
    for (int r = 0; r < 16; ++r) { o0[r] = 0.f; o1[r] = 0.f; }
    float lsum = 0.f;
    const int hb_hi = qw >> 5, hb_lo = hb_hi >= 4 ? hb_hi - 4 : 0;
    for (int hb = hb_lo; hb <= hb_hi; ++hb) {
        const int kh = hb * 32, jl = (hb >> 1) - t_lo, kb = hb & 1;
        const bool need_mask = (hb == hb_hi) || (kh < qw + 31 - 128);
        const int dl = qw + r32 - kh - 4 * hi;
        f32x16 p;
        { const LAS float* lp = aux + (255 - dl);
#pragma unroll
          for (int r = 0; r < 16; ++r) p[r] = lp[crow(r)]; }
        const LAS char* kb_ = lds + jl * KSLOT + kb * (32 * 144) + kfo;
#pragma unroll
        for (int d0 = 0; d0 < 4; ++d0) p = MFMA32(*(const LAS bf16x8*)(kb_ + d0 * 32), qf[d0], p);
        if (need_mask) {
#pragma unroll
            for (int r = 0; r < 16; ++r) { const int rel = dl - crow(r); p[r] = ((unsigned)rel <= 128u) ? p[r] : -INFINITY; }
        }
        float ps = 0.f;
#pragma unroll
        for (int r = 0; r < 16; ++r) { p[r] = __builtin_amdgcn_exp2f(p[r]); ps += p[r]; }
        lsum += ps;
        u32x4 w0, w1;
        w0.x = cvt2(p[0], p[1]); w0.y = cvt2(p[2], p[3]); w0.z = cvt2(p[4], p[5]); w0.w = cvt2(p[6], p[7]);
        w1.x = cvt2(p[8], p[9]); w1.y = cvt2(p[10], p[11]); w1.z = cvt2(p[12], p[13]); w1.w = cvt2(p[14], p[15]);
        const LAS char* vb_ = lds + jl * 8192 + vfo + kb * 2048;
        { const s16x4 a0 = vtr(vb_), a1 = vtr(vb_ + 512), c0 = vtr(vb_ + 4096), c1 = vtr(vb_ + 4096 + 512);
          o0 = MFMA32(__builtin_shufflevector(a0, a1, 0, 1, 2, 3, 4, 5, 6, 7), __builtin_bit_cast(bf16x8, w0), o0); o1 = MFMA32(__builtin_shufflevector(c0, c1, 0, 1, 2, 3, 4, 5, 6, 7), __builtin_bit_cast(bf16x8, w0), o1); }
        { const s16x4 a0 = vtr(vb_ + 1024), a1 = vtr(vb_ + 1024 + 512), c0 = vtr(vb_ + 4096 + 1024), c1 = vtr(vb_ + 4096 + 1024 + 512);
          o0 = MFMA32(__builtin_shufflevector(a0, a1, 0, 1, 2, 3, 4, 5, 6, 7), __builtin_bit_cast(bf16x8, w1), o0); o1 = MFMA32(__builtin_shufflevector(c0, c1, 0, 1, 2, 3, 4, 5, 6, 7), __builtin_bit_cast(bf16x8, w1), o1); }
    }
    const float ltot = swap_sum(lsum), inv = 1.0f / ltot;
    const size_t tok = (size_t)b * SEQ + (size_t)(qw + r32) * dil + res;
    bf16_t* dp = (bf16_t*)(P.ws + OFF_DPART) + ((size_t)pat * NT + tok) * 256 + h * 64 + 4 * hi;
#pragma unroll
    for (int g = 0; g < 4; ++g) { u32x2 w0, w1;
        w0.x = cvt2(o0[4 * g] * inv, o0[4 * g + 1] * inv); w0.y = cvt2(o0[4 * g + 2] * inv, o0[4 * g + 3] * inv);
        w1.x = cvt2(o1[4 * g] * inv, o1[4 * g + 1] * inv); w1.y = cvt2(o1[4 * g + 2] * inv, o1[4 * g + 3] * inv);
        *(u32x2*)(dp + 8 * g) = w0; *(u32x2*)(dp + 32 + 8 * g) = w1; }
    if (hi == 0) ((float*)(P.ws + OFF_DLSE))[((size_t)pat * NT + tok) * 4 + h] = __builtin_amdgcn_logf(ltot);
}

DEVINL void dilmix_unit(const Params& P, int u) {
    const int e = u * NTHREADS + ltid(), tok = e >> 5, hd = e & 31, h = hd >> 3, d8 = (hd & 7) * 8;
    const float* ls = (const float*)(P.ws + OFF_DLSE); const bf16_t* dp = (const bf16_t*)(P.ws + OFF_DPART);
    const float l0 = ls[(size_t)tok * 4 + h], l1 = ls[((size_t)NT + tok) * 4 + h], l2 = ls[((size_t)2 * NT + tok) * 4 + h];
    const float mx = fmaxf(l0, fmaxf(l1, l2)); float w0 = __builtin_amdgcn_exp2f(l0 - mx), w1 = __builtin_amdgcn_exp2f(l1 - mx), w2 = __builtin_amdgcn_exp2f(l2 - mx);
    const float inv = 1.0f / (w0 + w1 + w2); w0 *= inv; w1 *= inv; w2 *= inv;
    const size_t off = (size_t)tok * 256 + h * 64 + d8;
    const u32x4 a = *(const u32x4*)(dp + off), b = *(const u32x4*)(dp + (size_t)NT * 256 + off), c = *(const u32x4*)(dp + (size_t)2 * NT * 256 + off);
    const u32x4 g = *(const u32x4*)((const bf16_t*)((const char*)P.out + OOFF_G) + (size_t)tok * DM + 512 + h * 64 + d8);
    u32x4 r;
    r.x = cvt2((w0 * bflo(a.x) + w1 * bflo(b.x) + w2 * bflo(c.x)) * bflo(g.x), (w0 * bfhi(a.x) + w1 * bfhi(b.x) + w2 * bfhi(c.x)) * bfhi(g.x));
    r.y = cvt2((w0 * bflo(a.y) + w1 * bflo(b.y) + w2 * bflo(c.y)) * bflo(g.y), (w0 * bfhi(a.y) + w1 * bfhi(b.y) + w2 * bfhi(c.y)) * bfhi(g.y));
    r.z = cvt2((w0 * bflo(a.z) + w1 * bflo(b.z) + w2 * bflo(c.z)) * bflo(g.z), (w0 * bfhi(a.z) + w1 * bfhi(b.z) + w2 * bfhi(c.z)) * bfhi(g.z));
    r.w = cvt2((w0 * bflo(a.w) + w1 * bflo(b.w) + w2 * bflo(c.w)) * bflo(g.w), (w0 * bfhi(a.w) + w1 * bfhi(b.w) + w2 * bfhi(c.w)) * bfhi(g.w));
    *(u32x4*)((bf16_t*)(P.ws + OFF_H) + (size_t)tok * DM + 512 + h * 64 + d8) = r;
}


#define XB_TMO      128
#define XB_XCNT(j)  (256  + 64 * (j))
#define XB_XSUB(j)  (1280 + 64 * (j))
#define XB_XGEN(j)  (2304 + 64 * (j))
#define XB_TOP      3328
#define XB_TOPGEN   3392
#define XCD_BAR_WORDS 3456
#define XB_SPIN_CAP (1u << 20)
DEVINL unsigned xb_ld(unsigned* p) { return __hip_atomic_load(p, __ATOMIC_RELAXED, __HIP_MEMORY_SCOPE_AGENT); }
DEVINL unsigned xb_add(unsigned* p, unsigned v) { return __hip_atomic_fetch_add(p, v, __ATOMIC_RELAXED, __HIP_MEMORY_SCOPE_AGENT); }
DEVINL unsigned xb_xcc_id() { return (unsigned)__builtin_amdgcn_s_getreg((3 << 11) | 20) & 0xFu; }
#define XB_SPIN(cond, bar) do { unsigned _sp = 0; while (cond) { __builtin_amdgcn_s_sleep(1); \
    if ((++_sp & 255u) == 0u) { if (xb_ld(&(bar)[XB_TMO])) break; if (_sp > XB_SPIN_CAP) { atomicAdd(&(bar)[XB_TMO], 1u); break; } } } } while (0)
DEVINL void xcd_barrier_post(unsigned* bar) { if (ltid() == 0) (void)xb_add(&bar[XB_XCNT(xb_xcc_id())], 1u); }
DEVINL void xcd_barrier_complete(unsigned* bar, unsigned x, unsigned& nloc, unsigned& nx) {
    const unsigned G = gridDim.x * gridDim.y * gridDim.z;
    unsigned sum, cnt, mine, sp = 0u;
    for (;;) {
        sum = 0u; cnt = 0u; mine = 0u;
        for (unsigned j = 0; j < 16; ++j) { const unsigned c = xb_ld(&bar[XB_XCNT(j)]); sum += c; cnt += (c > 0u) ? 1u : 0u; mine = (j == x) ? c : mine; }
        if (sum == G) break;
        __builtin_amdgcn_s_sleep(1);
        if ((++sp & 255u) == 0u) { if (xb_ld(&bar[XB_TMO])) break; if (sp > XB_SPIN_CAP) { atomicAdd(&bar[XB_TMO], 1u); break; } }
    }
    nloc = mine > 0u ? mine : 1u; nx = cnt > 0u ? cnt : 1u;
}
DEVINL void xcd_barrier(unsigned* bar_in, volatile LAS unsigned* st) {
    asm volatile("s_waitcnt vmcnt(0)" ::: "memory");
    __syncthreads();
    if (ltid() == 0) {
        unsigned* bar = bar_in;
        const unsigned x = xb_xcc_id();
        __builtin_amdgcn_s_waitcnt(0);
        unsigned nloc = st[0], nx = st[1];
        if (nloc == 0u) { xcd_barrier_complete(bar, x, nloc, nx); st[0] = nloc; st[1] = nx; }
        const unsigned old = xb_add(&bar[XB_XSUB(x)], 1u);
        const unsigned gen = old / nloc;
        if (old + 1u == (gen + 1u) * nloc) {
            __builtin_amdgcn_fence(__ATOMIC_RELEASE, "agent");
            asm volatile("s_waitcnt vmcnt(0)" ::: "memory");
            const unsigned og = xb_add(&bar[XB_TOP], 1u);
            const unsigned tg = og / nx;
            if (og + 1u == (tg + 1u) * nx) xb_add(&bar[XB_TOPGEN], 1u);
            else XB_SPIN(xb_ld(&bar[XB_TOPGEN]) == tg, bar);
            __builtin_amdgcn_fence(__ATOMIC_ACQUIRE, "agent");
            xb_add(&bar[XB_XGEN(x)], 1u);
            asm volatile("s_waitcnt vmcnt(0)" ::: "memory");
        } else {
            XB_SPIN(xb_ld(&bar[XB_XGEN(x)]) == gen, bar);
            __builtin_amdgcn_fence(__ATOMIC_ACQUIRE, "agent");
            asm volatile("s_waitcnt vmcnt(0)" ::: "memory");
        }
    }
    __syncthreads();
}


DEVINL int next_unit(unsigned* ctr, char* smem) {
    int* su = (int*)(smem + L_MISC);
    __syncthreads();
    if (ltid() == 0) *su = (int)atomicAdd(ctr, 1u);
    __syncthreads();
    return *su;
}

template <class Epi> DEVINL void gemm8_sub(const bf16_t* A, const bf16_t* Bt, int M, int N, int K, const Epi& E, char* smem, int G, int c) {
    asm volatile("" : "+s"(G), "+s"(c));
    pg8::Gemm g{A, Bt, M, N, K}; pg8::StaticOrder S; S.init(M, N, G, c);
    pg8::gemm_phase<Epi, pg8::StaticOrder, true, true>((PG8_LAS unsigned char*)smem, g, S, E);
}
DEVINL void phase_pre(const Params& P, int l, char* smem) {
    const int half = (int)gridDim.x >> 1, bid = (int)blockIdx.x;
    if (bid < half) gemm8_sub((const bf16_t*)(P.ws + OFF_CQ), (const bf16_t*)(P.ws + OFF_WT_UQ + l * SZ_WT_UQ), NT, 512, 256, EpiUq8{P, l}, smem, half, bid);
    else gemm8_sub((const bf16_t*)(P.ws + OFF_CKV), (const bf16_t*)(P.ws + OFF_WT_UKV + l * SZ_WT_UKV), NT, 512, 256, EpiUkv8{P, l}, smem, (int)gridDim.x - half, bid - half);
    for (int u = blockIdx.x; u < 256; u += gridDim.x) kmean_unit(P, u, smem);
}
DEVINL void phase_att(const Params& P, int l, char* smem, int rep) {
    unsigned* ctr = (unsigned*)(P.ws + OFF_CTR) + l * 2 + rep * 8;
    constexpr int N_ATT = 384 + 256 + 96 + 768 + 32; const int n_all = N_ATT + (l == 0 ? PREP_PER_LAYER + PREP_P_UNITS / 2 : 0);
    for (;;) { int u = next_unit(ctr, smem); if (u >= n_all) break;
        if (u >= N_ATT) { __syncthreads(); if (u - N_ATT < PREP_PER_LAYER) prep_w_unit(P, 1, u - N_ATT, (float*)smem); else prep_p_unit(P, PREP_P_UNITS / 2 + (u - N_ATT - PREP_PER_LAYER)); continue; }
        if (u >= 384 && u < 640) { attn_unit<0>(P, l, u - 384, smem); continue; }
        if (u >= 736 && u < 736 + 768) { if (((const float*)(P.ws + OFF_BOUND))[l * 4 + 3] < 100.0f) dil_unit(P, l, u - 736, smem); else attn_unit<3>(P, l, u - 736, smem); continue; }
        if (u >= 736 + 768) u -= 768; if (u >= 640) u -= 256;
        const int g = u >> 5, r = u & 31, uu = g * 16 + (r & 15);
        if (r < 16) attn_unit<2>(P, l, uu, smem); else attn_unit<1>(P, l, uu, smem); }
}

template <int PH> DEVINL void run_phase(int l, char* smem, int rep = 0) {
    asm volatile("" : "+s"(l));
    const __attribute__((address_space(4))) Params* kp = (const __attribute__((address_space(4))) Params*)__builtin_amdgcn_kernarg_segment_ptr(); asm volatile("" : "+s"(kp));
    Params P;
    P.x = (const float*)as_global(kp->x); P.p = (const float*)as_global(kp->p); P.ln_g = (const float*)as_global(kp->ln_g); P.w_in = (const float*)as_global(kp->w_in); P.b_forget = (const float*)as_global(kp->b_forget);
    P.qk_gain = (const float*)as_global(kp->qk_gain); P.mla_q_norm = (const float*)as_global(kp->mla_q_norm); P.mla_kv_norm = (const float*)as_global(kp->mla_kv_norm); P.mla_nope_gain = (const float*)as_global(kp->mla_nope_gain);
    P.mla_rope_gain = (const float*)as_global(kp->mla_rope_gain); P.w_uq = (const float*)as_global(kp->w_uq); P.w_ukv = (const float*)as_global(kp->w_ukv); P.w_out = (const float*)as_global(kp->w_out); P.rel_bias = (const float*)as_global(kp->rel_bias);
    P.ple_norm_g = (const float*)as_global(kp->ple_norm_g); P.w_ple_gate = (const float*)as_global(kp->w_ple_gate); P.w_ple_proj = (const float*)as_global(kp->w_ple_proj); P.out = (float*)as_global(kp->out); P.ws = as_global(kp->ws);
    char* ws = P.ws;
    const float* xin = l == 0 ? P.x : (const float*)(ws + OFF_X);
    float* xa = P.out;
    float* xout = l == 0 ? (float*)(ws + OFF_X) : P.out;
    if (PH == 0) phase_prep(P, smem);
    if (PH == 2) { gemm8((const bf16_t*)(ws + OFF_H), (const bf16_t*)(ws + OFF_WT_IN + l * SZ_WT_IN), NT, NP1, 1024, EpiIn8{P, l}, smem);
                   const int G_ = (int)gridDim.x, w0_ = G_ > 192 ? 192 : 0;
                   if (l == 0 && (int)blockIdx.x >= w0_) { __syncthreads(); constexpr int W0 = PREP_T_IN + PREP_T_UQ + PREP_T_UKV, NWL = PREP_PER_LAYER - W0;
                       for (int u = (int)blockIdx.x - w0_; u < NWL + PREP_P_UNITS / 2; u += G_ - w0_) { if (u < NWL) prep_w_unit(P, 0, W0 + u, (float*)smem); else prep_p_unit(P, u - NWL); } } }
    if (PH == 3) phase_pre(P, l, smem);
    if (PH == 4) phase_att(P, l, smem, rep);
    if (PH == 5) { for (int u = blockIdx.x; u < 1024; u += gridDim.x) dilmix_unit(P, u);
                 }
    if (PH == 8) gemm8((const bf16_t*)(ws + OFF_H), (const bf16_t*)(ws + OFF_WT_OUT + l * SZ_WT_SQ), NT, 1024, 1024, EpiResid8{xin, xa, (bf16_t*)(ws + OFF_XABF), (float*)(ws + OFF_SSQA)}, smem);
    if (PH == 7) { gemm8((const bf16_t*)(ws + (l == 0 ? OFF_PB : OFF_PB2)), (const bf16_t*)(ws + OFF_WT_PP + l * SZ_WT_PP), NT, 1024, 256, EpiStoreBf{(bf16_t*)(ws + OFF_QKV)}, smem);
                   __syncthreads();
                   gemm8((const bf16_t*)(ws + OFF_XABF), (const bf16_t*)(ws + OFF_WT_PG + l * SZ_WT_SQ), NT, 1024, 1024, EpiPle8{xa, (const bf16_t*)(ws + OFF_QKV), xout, (const float*)(ws + OFF_SSQA), l == 0 ? (bf16_t*)(ws + OFF_H) : (bf16_t*)nullptr, (float*)(ws + OFF_SSQX)}, smem); }
}

__global__ void __launch_bounds__(NTHREADS) k_mega(Params Parg) {
    char* smem = g_smem;
    { const int t0 = (int)threadIdx.x; if (t0 < 12) ((LAS unsigned*)((LAS char*)smem + L_XB))[t0] = 0u;
      if ((t0 & 63) == 0) *(LAS int*)((LAS char*)smem + L_WTAB + 4u * (unsigned)__builtin_amdgcn_s_getreg(0x2804)) = t0 >> 6; }
    __syncthreads();
    const __attribute__((address_space(4))) Params* kp0 = (const __attribute__((address_space(4))) Params*)__builtin_amdgcn_kernarg_segment_ptr();
    xcd_barrier_post((unsigned*)(as_global(kp0->ws) + OFF_BAR));
#define XBAR() xcd_barrier((unsigned*)(as_global(kp0->ws) + OFF_BAR), (volatile LAS unsigned*)((LAS char*)smem + L_XB))
#ifdef PROBE_IDX
    unsigned long long tA = 0, tB = 0;
#define PT0(i) if (PROBE_IDX == (i)) tA = __builtin_amdgcn_s_memrealtime();
#define PT1(i) if (PROBE_IDX == (i)) tB = __builtin_amdgcn_s_memrealtime();
#else
#define PT0(i)
#define PT1(i)
#endif
    PT0(0) run_phase<0>(0, smem); XBAR(); PT1(0)
    PT0(2) run_phase<2>(0, smem); XBAR(); PT1(2) PT0(3) run_phase<3>(0, smem); XBAR(); PT1(3) PT0(4) run_phase<4>(0, smem); XBAR(); PT1(4)
    PT0(5) run_phase<5>(0, smem); XBAR(); PT1(5) PT0(6) run_phase<8>(0, smem); XBAR(); PT1(6) PT0(8) run_phase<7>(0, smem); XBAR(); PT1(8)
    run_phase<2>(1, smem); XBAR(); run_phase<3>(1, smem); XBAR(); run_phase<4>(1, smem); XBAR(); run_phase<5>(1, smem); XBAR(); run_phase<8>(1, smem); XBAR(); run_phase<7>(1, smem);
#ifdef PROBE_IDX
    if (blockIdx.x == 0) { const unsigned long long t0 = __builtin_amdgcn_s_memrealtime(), want = (tB - tA) * 32ull; while (__builtin_amdgcn_s_memrealtime() - t0 < want) __builtin_amdgcn_s_sleep(32); }
#endif
#undef XBAR
#ifdef PROBE_ATT
    if (blockIdx.x == PROBE_BLK) { __syncthreads(); const LAS unsigned* pa = (const LAS unsigned*)((LAS char*)smem + L_MISC + 32); const unsigned long long tk = pa[0], nt = pa[1] ? pa[1] : 1u;
        const unsigned long long t0 = __builtin_amdgcn_s_memrealtime(), want = tk * 2048ull / nt; while (__builtin_amdgcn_s_memrealtime() - t0 < want) __builtin_amdgcn_s_sleep(32); }
#endif
}
}

extern "C" void kernel_launch(void* const* d_in, const int* in_sizes, int n_in, void* d_out, int out_size, void* d_ws, size_t ws_size, hipStream_t stream) {
    Params P{};
    P.x = (const float*)d_in[0]; P.p = (const float*)d_in[1]; P.ln_g = (const float*)d_in[2]; P.w_in = (const float*)d_in[3]; P.b_forget = (const float*)d_in[4]; P.qk_gain = (const float*)d_in[5];
    P.mla_q_norm = (const float*)d_in[6]; P.mla_kv_norm = (const float*)d_in[7]; P.mla_nope_gain = (const float*)d_in[8]; P.mla_rope_gain = (const float*)d_in[9]; P.w_uq = (const float*)d_in[10];
    P.w_ukv = (const float*)d_in[11]; P.w_out = (const float*)d_in[12]; P.rel_bias = (const float*)d_in[13]; P.ple_norm_g = (const float*)d_in[14]; P.w_ple_gate = (const float*)d_in[15]; P.w_ple_proj = (const float*)d_in[16];
    P.out = (float*)d_out; P.ws = (char*)d_ws;
    if (ws_size < WS_NEED) { fprintf(stderr, "workspace too small: %zu < %zu\n", ws_size, (size_t)WS_NEED); return; }
    static int grid_blocks = 0;
    if (!grid_blocks) {
        int dev = 0, cus = 0, per_cu = 0;
        hipGetDevice(&dev);
        hipDeviceGetAttribute(&cus, hipDeviceAttributeMultiprocessorCount, dev);
        hipOccupancyMaxActiveBlocksPerMultiprocessor(&per_cu, k_mega, NTHREADS, 0);
        if (per_cu > 1) per_cu = 1;
        grid_blocks = cus * per_cu;
    }
    hipMemsetAsync((char*)d_ws + OFF_CTR, 0, 512 + 3456 * 4, stream);
    void* args[] = {&P};
    hipError_t e = hipLaunchCooperativeKernel((void*)k_mega, dim3(grid_blocks), dim3(NTHREADS), args, 0, stream);
    if (e != hipSuccess) fprintf(stderr, "cooperative launch failed: %s (grid %d)\n", hipGetErrorString(e), grid_blocks);
}
```

```cpp
#include <hip/hip_runtime.h>
#include <hip/hip_cooperative_groups.h>
#include <cstdint>
#include <cstdio>

#ifndef ONE_LAUNCH
#define ONE_LAUNCH 1
#endif

namespace {
#define DEVINL __device__ __forceinline__
typedef unsigned short bf16_t;
typedef short bf16x8 __attribute__((ext_vector_type(8)));
typedef float f32x4 __attribute__((ext_vector_type(4)));
typedef unsigned u32x2 __attribute__((ext_vector_type(2)));
typedef unsigned u32x4 __attribute__((ext_vector_type(4)));

constexpr int NB = 4, SEQ = 4096, DM = 1024, NT = NB * SEQ, NH = 4, NBH = NB * NH;
constexpr int INW = 3748, NP1 = 3840;
constexpr float EPS = 1e-6f, LOG2E = 1.4426950408889634f;
constexpr float SC_Q = 0.125f * LOG2E;
constexpr float SC_MLA = 0.10206207261596575f * LOG2E;
constexpr int NTHREADS = 512;

constexpr size_t SZ_WT_IN = (size_t)NP1 * 1024 * 2, SZ_WT_UQ = 512 * 256 * 2  , SZ_WT_UKV = 512 * 256 * 2  , SZ_WT_SQ = 1024 * 1024 * 2, SZ_WT_PP = 1024 * 256 * 2;
constexpr size_t OFF_WT_IN = 0;
constexpr size_t OFF_WT_UQ = OFF_WT_IN + 2 * SZ_WT_IN;
constexpr size_t OFF_WT_UKV = OFF_WT_UQ + 2 * SZ_WT_UQ;
constexpr size_t OFF_WT_OUT = OFF_WT_UKV + 2 * SZ_WT_UKV;
constexpr size_t OFF_WT_PG = OFF_WT_OUT + 2 * SZ_WT_SQ;
constexpr size_t OFF_WT_PP = OFF_WT_PG + 2 * SZ_WT_SQ;
constexpr size_t OFF_LUT = OFF_WT_PP + 2 * SZ_WT_PP;
constexpr size_t OFF_ROPE = OFF_LUT + 8 * 4096 * 4;
constexpr size_t OFF_H = OFF_ROPE + 4096 * 16 * 8;
constexpr size_t SZ_HEADBUF = (size_t)NT * 256 * 2;
constexpr size_t OFF_QKV = OFF_H + (size_t)NT * 1024 * 2;
constexpr size_t OFF_XABF = OFF_QKV + (size_t)NT * 1024 * 2;
constexpr size_t OFF_CQ = OFF_QKV + 9 * SZ_HEADBUF;
constexpr size_t OFF_CKV = OFF_CQ + (size_t)NT * 256 * 2;
constexpr size_t OFF_CQSS = OFF_CKV + (size_t)NT * 256 * 2;
constexpr size_t OFF_CKVSS = OFF_CQSS + (size_t)NT * 4 * 4;
constexpr size_t OFF_LOGF = OFF_CKVSS + (size_t)NT * 2 * 4;
constexpr size_t OFF_KMEAN = OFF_LOGF + (size_t)NBH * SEQ * 4;
constexpr size_t OFF_PB = OFF_KMEAN + (size_t)NBH * 16 * 64 * 4;
constexpr size_t OFF_X = OFF_PB + (size_t)NT * 256 * 2;
constexpr size_t OFF_A2 = OFF_X;
constexpr size_t OFF_PB2 = OFF_X + (size_t)NT * 1024 * 4;
constexpr size_t OFF_SSQX = OFF_PB2 + (size_t)NT * 256 * 2;
constexpr size_t OFF_SSQA = OFF_SSQX + (size_t)NT * 16 * 4;
constexpr size_t OFF_DPART = OFF_SSQA + (size_t)NT * 16 * 4;
constexpr size_t OFF_DLSE = OFF_DPART + 3 * (size_t)NT * 256 * 2;
constexpr size_t OFF_CTR = OFF_DLSE + 3 * (size_t)NT * 4 * 4;
constexpr size_t OFF_BOUND = OFF_CTR + 256;
constexpr size_t OFF_BAR = OFF_BOUND + 256;
constexpr size_t WS_NEED = OFF_BAR + 3456 * 4;
constexpr size_t OOFF_G = 0;
constexpr size_t OOFF_QM = (size_t)NT * 1024 * 2;
constexpr size_t OOFF_KM = OOFF_QM + (size_t)NBH * SEQ * 96 * 2;
constexpr size_t OOFF_VM = OOFF_KM + (size_t)NBH * SEQ * 96 * 2;

struct Params {
    const float *x, *p, *ln_g, *w_in, *b_forget, *qk_gain, *mla_q_norm, *mla_kv_norm, *mla_nope_gain, *mla_rope_gain, *w_uq, *w_ukv, *w_out, *rel_bias, *ple_norm_g, *w_ple_gate, *w_ple_proj;
    float* out;
    char* ws;
};

DEVINL char* as_global(const void* p) { __attribute__((address_space(1))) char* g; asm volatile("" : "=s"(g) : "0"(p)); return (char*)g; }
constexpr int L_MISC = 131072;
constexpr int L_XB = L_MISC + 16, L_WTAB = L_MISC + 64, SMEM_BYTES = L_MISC + 64 + 256;
__shared__ __attribute__((aligned(16))) char g_smem[SMEM_BYTES];
DEVINL int ltid() {
    const unsigned hw = (unsigned)__builtin_amdgcn_s_getreg(0x2804);
    const int w = __builtin_amdgcn_readfirstlane(*(const __attribute__((address_space(3))) int*)((__attribute__((address_space(3))) char*)g_smem + L_WTAB + hw * 4));
    int lane; asm volatile("v_mbcnt_lo_u32_b32 %0, -1, 0\n\tv_mbcnt_hi_u32_b32 %0, -1, %0" : "=v"(lane));
    return w * 64 + lane; }
DEVINL float shx(float v, int mask) { return __int_as_float(__builtin_amdgcn_ds_bpermute(((ltid() & 63) ^ mask) << 2, __float_as_int(v))); }
DEVINL float shup(float v, int o) { return __int_as_float(__builtin_amdgcn_ds_bpermute(((ltid() & 63) - o) << 2, __float_as_int(v))); }
DEVINL float sq4(const f32x4& a) { return a[0] * a[0] + a[1] * a[1] + a[2] * a[2] + a[3] * a[3]; }
template <int XM> DEVINL float swz_xor(float v) { return __int_as_float(__builtin_amdgcn_ds_swizzle(__float_as_int(v), (XM << 10) | 0x1F)); }
DEVINL float half_swap_sum(float v) { auto rr = __builtin_amdgcn_permlane32_swap(__float_as_uint(v), __float_as_uint(v), false, false); return __uint_as_float(rr[0]) + __uint_as_float(rr[1]); }
DEVINL float wave_sum(float v) { v += swz_xor<1>(v); v += swz_xor<2>(v); v += swz_xor<4>(v); v += swz_xor<8>(v); v += swz_xor<16>(v); return half_swap_sum(v); }
DEVINL bf16_t f2bf(float f) { unsigned u = __float_as_uint(f); u += 0x7fffu + ((u >> 16) & 1u); return (bf16_t)(u >> 16); }
DEVINL float bf2f(bf16_t h) { return __uint_as_float(((unsigned)h) << 16); }
DEVINL unsigned pack2(float a, float b) { return (unsigned)f2bf(a) | ((unsigned)f2bf(b) << 16); }
typedef __bf16 bf16v2 __attribute__((ext_vector_type(2)));
typedef float f32v2 __attribute__((ext_vector_type(2)));
DEVINL unsigned cvt2(float a, float b) { f32v2 v = {a, b}; return __builtin_bit_cast(unsigned, __builtin_convertvector(v, bf16v2)); }
DEVINL float bflo(unsigned u) { return __uint_as_float(u << 16); }
DEVINL float bfhi(unsigned u) { return __uint_as_float(u & 0xffff0000u); }

__device__ __constant__ float ROPE_INV[16] = {1.0f, 0.5623413251903491f, 0.31622776601683794f, 0.1778279410038923f, 0.1f, 0.05623413251903491f, 0.03162277660168379f, 0.01778279410038923f,
                                              0.01f, 0.005623413251903491f, 0.0031622776601683794f, 0.0017782794100389228f, 0.001f, 0.0005623413251903491f, 0.00031622776601683794f, 0.00017782794100389227f};

DEVINL int t5_bucket(int d) {
    if (d < 16) return d;
    int b = 16;
    b += (d >= 22); b += (d >= 30); b += (d >= 40); b += (d >= 54); b += (d >= 73); b += (d >= 99); b += (d >= 134); b += (d >= 182);
    b += (d >= 246); b += (d >= 332); b += (d >= 450); b += (d >= 609); b += (d >= 825); b += (d >= 1117); b += (d >= 1513);
    return b;
}

DEVINL int map_w_in(int n) { return n < 768 ? n : (n < 2720 ? n + 4 : (n < 2724 ? n - 2720 + 768 : (n < 2816 ? -1 : n - 92))); }
DEVINL int virt_col(int nv) { const int v = nv & 255; return (nv & ~255) + 64 * ((v >> 5) & 3) + 32 * (v >> 7) + (v & 31); }
DEVINL int map_w_in_virt(int nv) { int a = virt_col(nv); const int chunk = a >> 6; int hc = a & 63;
    if (chunk == 42 && hc < 32) hc = 16 * ((hc >> 2) & 1) + 4 * (hc >> 3) + (hc & 3);
    return map_w_in(chunk * 64 + hc); }
DEVINL int map_w_uq_virt(int nv) { const int a = virt_col(nv), chunk = a >> 6; int hc = a & 63; if (chunk >= 6) return -1;
    if (chunk >= 4) { const int e = hc & 31; hc = (hc & 32) + 16 * ((e >> 2) & 1) + 4 * (e >> 3) + (e & 3); }
    const int n = chunk * 64 + hc; if (n < 256) return (n >> 6) * 96 + (n & 63); const int r = n - 256; return (r >> 5) * 96 + 64 + (r & 31); }
DEVINL int map_w_uq(int n) { if (n < 256) return (n >> 6) * 96 + (n & 63); const int r = n - 256; return (r >> 5) * 96 + 64 + (r & 31); }

template <int KT>
DEVINL void transpose_tile(const float* src, int Nsrc, bf16_t* dst, int K, int tn, int tk, int mode, const float* fold, float* tile  ) {
    const int tid = ltid(), c4 = (tid & 15) * 4, kr = tid >> 4  , n0 = tn * 64, k0 = tk * KT;
    const int n = n0 + c4, oc = mode == 1 ? map_w_in_virt(n) : (mode == 2 ? map_w_uq(n) : (mode == 3 ? virt_col(n) : (mode == 4 ? map_w_uq_virt(n) : (mode == 5 ? virt_col(n) : n))));
    f32x4 v[KT / 32];
#pragma unroll
    for (int i = 0; i < KT / 32; ++i) { const int kk = kr + 32 * i; v[i] = (f32x4){0.f, 0.f, 0.f, 0.f}; if (oc >= 0 && !(mode == 5 && k0 + kk >= 128)) { v[i] = __builtin_nontemporal_load((const f32x4*)(src + (size_t)(k0 + kk) * Nsrc + oc)); if (fold) v[i] = v[i] * fold[k0 + kk]; } }
    __syncthreads();
#pragma unroll
    for (int i = 0; i < KT / 32; ++i) *(f32x4*)(tile + (kr + 32 * i) * 68 + c4) = v[i];
    __syncthreads();
#pragma unroll
    for (int h = 0; h < KT / 64; ++h) { const int nn = tid & 63, kc = h * 64 + (tid >> 6) * 8; const float* tp = tile + kc * 68 + nn; u32x4 w;
      w.x = cvt2(tp[0], tp[68]); w.y = cvt2(tp[136], tp[204]); w.z = cvt2(tp[272], tp[340]); w.w = cvt2(tp[408], tp[476]);
      *(u32x4*)(dst + (size_t)(n0 + nn) * K + k0 + kc) = w; }
}

constexpr int PREP_T_IN = 60 * 4, PREP_T_UQ = 8 * 1, PREP_T_UKV = 8 * 1, PREP_T_SQ = 16 * 4, PREP_T_PP = 16 * 1;
constexpr int PREP_PER_LAYER = PREP_T_IN + PREP_T_UQ + PREP_T_UKV + 2 * PREP_T_SQ + PREP_T_PP;
constexpr int PREP_LUT_UNITS = 8 * 4096 / 512, PREP_ROPE_UNITS = 4096 * 16 / 512;
constexpr int PREP_X_UNITS = NT / 32, PREP_P_UNITS = 2 * NT / 64;
constexpr int PREP_UNITS = 2 * PREP_PER_LAYER + PREP_LUT_UNITS + PREP_ROPE_UNITS + PREP_X_UNITS + PREP_P_UNITS;

DEVINL void prep_w_unit(const Params& P, int l, int r, float* tile) {
    if (r < PREP_T_IN) { transpose_tile<256>(P.w_in + (size_t)l * 1024 * INW, INW, (bf16_t*)(P.ws + OFF_WT_IN + l * SZ_WT_IN), 1024, r % 60, r / 60, 1, P.ln_g + l * DM, tile); return; }
    r -= PREP_T_IN;
    if (r < PREP_T_UQ) { transpose_tile<256>(P.w_uq + (size_t)l * 256 * 384, 384, (bf16_t*)(P.ws + OFF_WT_UQ + l * SZ_WT_UQ), 256, r % 8, r / 8, 4, P.mla_q_norm + l * 256, tile); return; }
    r -= PREP_T_UQ;
    if (r < PREP_T_UKV) { transpose_tile<256>(P.w_ukv + (size_t)l * 128 * 512, 512, (bf16_t*)(P.ws + OFF_WT_UKV + l * SZ_WT_UKV), 256, r % 8, r / 8, 5, P.mla_kv_norm + l * 128, tile); return; }
    r -= PREP_T_UKV;
    if (r < PREP_T_SQ) { transpose_tile<256>(P.w_out + (size_t)l * 1024 * 1024, 1024, (bf16_t*)(P.ws + OFF_WT_OUT + l * SZ_WT_SQ), 1024, r % 16, r / 16, 3, nullptr, tile); return; }
    r -= PREP_T_SQ;
    if (r < PREP_T_SQ) { transpose_tile<256>(P.w_ple_gate + (size_t)l * 1024 * 1024, 1024, (bf16_t*)(P.ws + OFF_WT_PG + l * SZ_WT_SQ), 1024, r % 16, r / 16, 3, P.ple_norm_g + l * DM, tile); return; }
    r -= PREP_T_SQ;
    transpose_tile<256>(P.w_ple_proj + (size_t)l * 256 * 1024, 1024, (bf16_t*)(P.ws + OFF_WT_PP + l * SZ_WT_PP), 256, r % 16, r / 16, 3, nullptr, tile);
}
DEVINL void prep_p_unit(const Params& P, int v) {
    const int wid = ltid() >> 6, lane = ltid() & 63; f32x4 a[8];
#pragma unroll
    for (int rr = 0; rr < 8; ++rr) a[rr] = __builtin_nontemporal_load((const f32x4*)(P.p + (size_t)(v * 64 + wid * 8 + rr) * 256 + lane * 4));
#pragma unroll
    for (int rr = 0; rr < 8; ++rr) { const int row = v * 64 + wid * 8 + rr; u32x2 w; w.x = cvt2(a[rr][0], a[rr][1]); w.y = cvt2(a[rr][2], a[rr][3]);
        bf16_t* pb = row < NT ? (bf16_t*)(P.ws + OFF_PB) + (size_t)row * 256 : (bf16_t*)(P.ws + OFF_PB2) + (size_t)(row - NT) * 256; *(u32x2*)(pb + lane * 4) = w; }
}
DEVINL void phase_prep(const Params& P, char* smem) {
    float* tile = (float*)smem;
    if (blockIdx.x == 0 && ltid() < 8) {
        const int l = ltid() >> 2, md = ltid() & 3; float bound;
        auto amax = [](const float* p, int n) { float a = 0.f; for (int i = 0; i < n; ++i) a = fmaxf(a, fabsf(p[i])); return a; };
        if (md == 2) { const float nq = amax(P.mla_nope_gain + (l * 2 + 0) * 64, 64), nk = amax(P.mla_nope_gain + (l * 2 + 1) * 64, 64), rq = amax(P.mla_rope_gain + (l * 2 + 0) * 32, 32), rk = amax(P.mla_rope_gain + (l * 2 + 1) * 32, 32);
            bound = sqrtf(64.f * nq * nq + 32.f * rq * rq) * sqrtf(64.f * nk * nk + 32.f * rk * rk) * SC_MLA; }
        else { const int mix = md == 0 ? 0 : (md == 1 ? 1 : 2); bound = 64.f * amax(P.qk_gain + (l * 6 + 2 * mix) * 64, 64) * amax(P.qk_gain + (l * 6 + 2 * mix + 1) * 64, 64) * SC_Q;
            if (md == 0) bound += 8.f; else bound += amax(P.rel_bias, 256) * LOG2E; }
        ((float*)(P.ws + OFF_BOUND))[l * 4 + md] = bound;
    }
    constexpr int U_W = PREP_PER_LAYER, U_LUT = U_W + PREP_LUT_UNITS, U_ROPE = U_LUT + PREP_ROPE_UNITS, U_X = U_ROPE + PREP_X_UNITS, U_P = U_X + PREP_P_UNITS / 2;
    for (int u = blockIdx.x; u < U_P; u += gridDim.x) {
        if (u < U_W) { if (u < PREP_T_IN + PREP_T_UQ + PREP_T_UKV) prep_w_unit(P, 0, u, tile); }
        else if (u < U_LUT) { const int e = (u - U_W) * 512 + ltid(), hh = e >> 12, d = e & 4095; ((float*)(P.ws + OFF_LUT))[e] = P.rel_bias[t5_bucket(d) * 8 + hh] * LOG2E; }
        else if (u < U_ROPE) { const int e = (u - U_LUT) * 512 + ltid(), pos = e >> 4, i = e & 15;
            const double rev = (double)pos * (double)ROPE_INV[i] * 0.15915494309189535; const float fr = (float)(rev - floor(rev));
            ((float2*)(P.ws + OFF_ROPE))[e] = make_float2(__builtin_amdgcn_cosf(fr), __builtin_amdgcn_sinf(fr)); }
        else if (u < U_X) { const int v = u - U_ROPE, wid = ltid() >> 6, lane = ltid() & 63;
            f32x4 a[4][4];
#pragma unroll
            for (int rr = 0; rr < 4; ++rr)
#pragma unroll
                for (int i = 0; i < 4; ++i) a[rr][i] = __builtin_nontemporal_load((const f32x4*)(P.x + (size_t)(v * 32 + wid * 4 + rr) * DM + i * 256 + lane * 4));
#pragma unroll
            for (int rr = 0; rr < 4; ++rr) { const int row = v * 32 + wid * 4 + rr; float ss = 0.f;
#pragma unroll
                for (int i = 0; i < 4; ++i) { ss += sq4(a[rr][i]); u32x2 w; w.x = cvt2(a[rr][i][0], a[rr][i][1]); w.y = cvt2(a[rr][i][2], a[rr][i][3]); *(u32x2*)((bf16_t*)(P.ws + OFF_H) + (size_t)row * DM + i * 256 + lane * 4) = w; }
                ss = wave_sum(ss); if (lane < 16) ((float*)(P.ws + OFF_SSQX))[(size_t)row * 16 + lane] = lane == 0 ? ss : 0.f;
                if (lane < 16) *(u32x4*)((bf16_t*)(P.ws + OFF_CKV) + (size_t)row * 256 + 128 + lane * 8) = (u32x4){0u, 0u, 0u, 0u}; } }
        else {   }
    }
}

DEVINL void phase_rms(const float* src, const float* g, bf16_t* dst, const float* psrc, bf16_t* pb) {
    const int wid = ltid() >> 6, lane = ltid() & 63;
    for (int u = blockIdx.x; u < NT / 8; u += gridDim.x) {
        const int row = u * 8 + wid; const float* xr = src + (size_t)row * DM;
        f32x4 v[4]; float ss = 0.f;
#pragma unroll
        for (int i = 0; i < 4; ++i) { v[i] = *(const f32x4*)(xr + i * 256 + lane * 4); ss += v[i][0] * v[i][0] + v[i][1] * v[i][1] + v[i][2] * v[i][2] + v[i][3] * v[i][3]; }
        ss = wave_sum(ss); const float r = rsqrtf(ss * (1.0f / DM) + EPS);
#pragma unroll
        for (int i = 0; i < 4; ++i) { const f32x4 gg = *(const f32x4*)(g + i * 256 + lane * 4); u32x2 w; w.x = pack2(v[i][0] * r * gg[0], v[i][1] * r * gg[1]); w.y = pack2(v[i][2] * r * gg[2], v[i][3] * r * gg[3]);
            *(u32x2*)(dst + (size_t)row * DM + i * 256 + lane * 4) = w; }
        if (psrc) { const f32x4 pv = *(const f32x4*)(psrc + (size_t)row * 256 + lane * 4); u32x2 w; w.x = pack2(pv[0], pv[1]); w.y = pack2(pv[2], pv[3]); *(u32x2*)(pb + (size_t)row * 256 + lane * 4) = w; }
    }
}

constexpr int GST = 40;
template <class Epi>
DEVINL void gemm_phase(const bf16_t* A, const bf16_t* Bt, int M, int N, int K, const Epi& epi, char* smem) {
    bf16_t* As = (bf16_t*)smem; bf16_t* Bs = As + 256 * GST;
    const int tid = ltid(), wid = tid >> 6, lane = tid & 63, wr = wid >> 1, wc = wid & 1, fr = lane & 15, fq = lane >> 4;
    const int ntm = M / 256, ntn = N / 128, nk = K / 32;
    const int lr = tid >> 2, lc = (tid & 3) * 8;
    for (int tile = blockIdx.x; tile < ntm * ntn; tile += gridDim.x) {
        const int tm = tile % ntm, tn = tile / ntm;
        const bf16_t* Ag = A + (size_t)(tm * 256 + lr) * K + lc; const bf16_t* Bg = Bt + (size_t)(tn * 128 + lr) * K + lc;
        f32x4 acc[4][4];
#pragma unroll
        for (int m = 0; m < 4; ++m)
#pragma unroll
            for (int n = 0; n < 4; ++n) acc[m][n] = (f32x4){0.f, 0.f, 0.f, 0.f};
        u32x4 ra0 = *(const u32x4*)Ag, ra1 = *(const u32x4*)(Ag + (size_t)128 * K), rb0 = *(const u32x4*)Bg;
        for (int kt = 0; kt < nk; ++kt) {
            __syncthreads();
            *(u32x4*)(As + lr * GST + lc) = ra0; *(u32x4*)(As + (lr + 128) * GST + lc) = ra1; *(u32x4*)(Bs + lr * GST + lc) = rb0;
            __syncthreads();
            if (kt + 1 < nk) { const int ko = (kt + 1) * 32; ra0 = *(const u32x4*)(Ag + ko); ra1 = *(const u32x4*)(Ag + (size_t)128 * K + ko); rb0 = *(const u32x4*)(Bg + ko); }
            bf16x8 af[4], bfr[4];
#pragma unroll
            for (int m = 0; m < 4; ++m) af[m] = *(const bf16x8*)(As + (wr * 64 + m * 16 + fr) * GST + fq * 8);
#pragma unroll
            for (int n = 0; n < 4; ++n) bfr[n] = *(const bf16x8*)(Bs + (wc * 64 + n * 16 + fr) * GST + fq * 8);
#pragma unroll
            for (int m = 0; m < 4; ++m)
#pragma unroll
                for (int n = 0; n < 4; ++n) acc[m][n] = __builtin_amdgcn_mfma_f32_16x16x32_bf16(bfr[n], af[m], acc[m][n], 0, 0, 0);
        }
        epi(acc, tm * 256 + wr * 64, tn * 2 + wc, fr, fq);
    }
    __syncthreads();
}

DEVINL float quad_sum(float v) { v += swz_xor<16>(v); return half_swap_sum(v); }
DEVINL void store4bf(bf16_t* p, float a, float b, float c, float d) { u32x2 w; w.x = pack2(a, b); w.y = pack2(c, d); *(u32x2*)p = w; }
DEVINL float fsigmoid(float z) { return __builtin_amdgcn_rcpf(1.0f + __builtin_amdgcn_exp2f(-LOG2E * z)); }
DEVINL float log_sigmoid(float z) { return fminf(z, 0.f) - log1pf(__expf(-fabsf(z))); }

struct EpiIn {
    Params P; int l;
    DEVINL void operator()(f32x4 (&acc)[4][4], int row0, int chunk, int fr, int fq) const {
        char* ws = P.ws; char* ob = (char*)P.out;
        if (chunk < 36) {
            const int g = chunk >> 2, h = chunk & 3, role = g % 3, mix = g / 3;
            bf16_t* dst = (bf16_t*)(ws + OFF_QKV + (size_t)g * SZ_HEADBUF);
            const float* gain = P.qk_gain + ((size_t)l * 6 + 2 * mix + (role == 1 ? 1 : 0)) * 64;
#pragma unroll
            for (int m = 0; m < 4; ++m) {
                const int t = row0 + 16 * m + fr, b = t >> 12, s = t & 4095; bf16_t* d = dst + ((size_t)(b * 4 + h) * SEQ + s) * 64 + 4 * fq;
                float r = 1.f;
                if (role != 2) { float ss = 0.f;
#pragma unroll
                    for (int n = 0; n < 4; ++n) ss += acc[m][n][0] * acc[m][n][0] + acc[m][n][1] * acc[m][n][1] + acc[m][n][2] * acc[m][n][2] + acc[m][n][3] * acc[m][n][3];
                    ss = quad_sum(ss); r = rsqrtf(ss * (1.0f / 64.0f) + EPS) * (role == 0 ? SC_Q : 1.0f); }
#pragma unroll
                for (int n = 0; n < 4; ++n) { f32x4 gg = (f32x4){1.f, 1.f, 1.f, 1.f}; if (role != 2) gg = *(const f32x4*)(gain + 16 * n + 4 * fq);
                    store4bf(d + 16 * n, acc[m][n][0] * r * gg[0], acc[m][n][1] * r * gg[1], acc[m][n][2] * r * gg[2], acc[m][n][3] * r * gg[3]); }
            }
        } else if (chunk < 42) {
            const bool isq = chunk < 40; const int c = isq ? chunk - 36 : chunk - 40;
            bf16_t* dst = isq ? (bf16_t*)(ws + OFF_CQ) : (bf16_t*)(ws + OFF_CKV); const int ld = isq ? 256 : 128;
            float* ssp = isq ? (float*)(ws + OFF_CQSS) : (float*)(ws + OFF_CKVSS); const int nss = isq ? 4 : 2;
#pragma unroll
            for (int m = 0; m < 4; ++m) {
                const int t = row0 + 16 * m + fr; float ss = 0.f;
#pragma unroll
                for (int n = 0; n < 4; ++n) { ss += acc[m][n][0] * acc[m][n][0] + acc[m][n][1] * acc[m][n][1] + acc[m][n][2] * acc[m][n][2] + acc[m][n][3] * acc[m][n][3];
                    store4bf(dst + (size_t)t * ld + c * 64 + 16 * n + 4 * fq, acc[m][n][0], acc[m][n][1], acc[m][n][2], acc[m][n][3]); }
                ss = quad_sum(ss); if (fq == 0) ssp[(size_t)t * nss + c] = ss;
            }
        } else if (chunk == 42) {
            const float* gr = P.mla_rope_gain + ((size_t)l * 2 + 1) * 32; const float2* rope = (const float2*)(ws + OFF_ROPE);
            bf16_t* km = (bf16_t*)(ob + OOFF_KM); float* logf_ = (float*)(ws + OFF_LOGF);
            const f32x4 g1 = *(const f32x4*)(gr + 4 * fq), g2 = *(const f32x4*)(gr + 16 + 4 * fq); const f32x4 bfv = *(const f32x4*)(P.b_forget + l * 4);
#pragma unroll
            for (int m = 0; m < 4; ++m) {
                const int t = row0 + 16 * m + fr, b = t >> 12, s = t & 4095;
                float ss = 0.f;
#pragma unroll
                for (int n = 0; n < 2; ++n) ss += acc[m][n][0] * acc[m][n][0] + acc[m][n][1] * acc[m][n][1] + acc[m][n][2] * acc[m][n][2] + acc[m][n][3] * acc[m][n][3];
                ss = quad_sum(ss); const float r = rsqrtf(ss * (1.0f / 32.0f) + EPS);
                float o1[4], o2[4];
#pragma unroll
                for (int j = 0; j < 4; ++j) { const float2 cs = rope[s * 16 + 4 * fq + j]; const float x1 = acc[m][0][j] * r * g1[j], x2 = acc[m][1][j] * r * g2[j]; o1[j] = x1 * cs.x - x2 * cs.y; o2[j] = x1 * cs.y + x2 * cs.x; }
#pragma unroll
                for (int h = 0; h < 4; ++h) { bf16_t* d = km + ((size_t)(b * 4 + h) * SEQ + s) * 96 + 64 + 4 * fq; store4bf(d, o1[0], o1[1], o1[2], o1[3]); store4bf(d + 16, o2[0], o2[1], o2[2], o2[3]); }
                if (fq == 0) {
#pragma unroll
                    for (int j = 0; j < 4; ++j) logf_[(size_t)(b * 4 + j) * SEQ + s] = log_sigmoid(acc[m][2][j] + bfv[j]) * LOG2E;
                }
            }
        } else if (chunk >= 44) {
            bf16_t* G = (bf16_t*)(ob + OOFF_G); const int c0 = (chunk - 44) * 64;
#pragma unroll
            for (int m = 0; m < 4; ++m) { const int t = row0 + 16 * m + fr;
#pragma unroll
                for (int n = 0; n < 4; ++n) { float o[4];
#pragma unroll
                    for (int j = 0; j < 4; ++j) { const float z = acc[m][n][j]; o[j] = z / (1.0f + __expf(-z)); }
                    store4bf(G + (size_t)t * DM + c0 + 16 * n + 4 * fq, o[0], o[1], o[2], o[3]); } }
        }
    }
};

struct EpiUq {
    Params P; int l;
    DEVINL void operator()(f32x4 (&acc)[4][4], int row0, int chunk, int fr, int fq) const {
        const float* cqss = (const float*)(P.ws + OFF_CQSS); bf16_t* qm = (bf16_t*)((char*)P.out + OOFF_QM); const float2* rope = (const float2*)(P.ws + OFF_ROPE);
#pragma unroll
        for (int m = 0; m < 4; ++m) {
            const int t = row0 + 16 * m + fr, b = t >> 12, s = t & 4095; const f32x4 pss = *(const f32x4*)(cqss + (size_t)t * 4);
            const float rt = rsqrtf((pss[0] + pss[1] + pss[2] + pss[3]) * (1.0f / 256.0f) + EPS);
            if (chunk < 4) {
                const float* gain = P.mla_nope_gain + ((size_t)l * 2 + 0) * 64; float ss = 0.f;
#pragma unroll
                for (int n = 0; n < 4; ++n) { acc[m][n] = acc[m][n] * rt; ss += acc[m][n][0] * acc[m][n][0] + acc[m][n][1] * acc[m][n][1] + acc[m][n][2] * acc[m][n][2] + acc[m][n][3] * acc[m][n][3]; }
                ss = quad_sum(ss); const float r = rsqrtf(ss * (1.0f / 64.0f) + EPS) * SC_MLA; bf16_t* d = qm + ((size_t)(b * 4 + chunk) * SEQ + s) * 96 + 4 * fq;
#pragma unroll
                for (int n = 0; n < 4; ++n) { const f32x4 gg = *(const f32x4*)(gain + 16 * n + 4 * fq); store4bf(d + 16 * n, acc[m][n][0] * r * gg[0], acc[m][n][1] * r * gg[1], acc[m][n][2] * r * gg[2], acc[m][n][3] * r * gg[3]); }
            } else {
                const float* gr = P.mla_rope_gain + ((size_t)l * 2 + 0) * 32; const f32x4 g1 = *(const f32x4*)(gr + 4 * fq), g2 = *(const f32x4*)(gr + 16 + 4 * fq);
#pragma unroll
                for (int hh = 0; hh < 2; ++hh) {
                    const int h = (chunk - 4) * 2 + hh; float ss = 0.f;
#pragma unroll
                    for (int n = 0; n < 2; ++n) { acc[m][2 * hh + n] = acc[m][2 * hh + n] * rt; const f32x4 a = acc[m][2 * hh + n]; ss += a[0] * a[0] + a[1] * a[1] + a[2] * a[2] + a[3] * a[3]; }
                    ss = quad_sum(ss); const float r = rsqrtf(ss * (1.0f / 32.0f) + EPS);
                    float o1[4], o2[4];
#pragma unroll
                    for (int j = 0; j < 4; ++j) { const float2 cs = rope[s * 16 + 4 * fq + j]; const float x1 = acc[m][2 * hh][j] * r * g1[j], x2 = acc[m][2 * hh + 1][j] * r * g2[j];
                        o1[j] = (x1 * cs.x - x2 * cs.y) * SC_MLA; o2[j] = (x1 * cs.y + x2 * cs.x) * SC_MLA; }
                    bf16_t* d = qm + ((size_t)(b * 4 + h) * SEQ + s) * 96 + 64 + 4 * fq; store4bf(d, o1[0], o1[1], o1[2], o1[3]); store4bf(d + 16, o2[0], o2[1], o2[2], o2[3]);
                }
            }
        }
    }
};
struct EpiUkv {
    Params P; int l;
    DEVINL void operator()(f32x4 (&acc)[4][4], int row0, int chunk, int fr, int fq) const {
        const float* ckvss = (const float*)(P.ws + OFF_CKVSS); bf16_t* km = (bf16_t*)((char*)P.out + OOFF_KM); bf16_t* vm = (bf16_t*)((char*)P.out + OOFF_VM);
        const int h = chunk >> 1; const bool isk = (chunk & 1) == 0; const float* gain = P.mla_nope_gain + ((size_t)l * 2 + 1) * 64;
#pragma unroll
        for (int m = 0; m < 4; ++m) {
            const int t = row0 + 16 * m + fr, b = t >> 12, s = t & 4095; const float rt = rsqrtf((ckvss[(size_t)t * 2] + ckvss[(size_t)t * 2 + 1]) * (1.0f / 128.0f) + EPS);
            float ss = 0.f;
#pragma unroll
            for (int n = 0; n < 4; ++n) { acc[m][n] = acc[m][n] * rt; ss += acc[m][n][0] * acc[m][n][0] + acc[m][n][1] * acc[m][n][1] + acc[m][n][2] * acc[m][n][2] + acc[m][n][3] * acc[m][n][3]; }
            if (isk) { ss = quad_sum(ss); const float r = rsqrtf(ss * (1.0f / 64.0f) + EPS); bf16_t* d = km + ((size_t)(b * 4 + h) * SEQ + s) * 96 + 4 * fq;
#pragma unroll
                for (int n = 0; n < 4; ++n) { const f32x4 gg = *(const f32x4*)(gain + 16 * n + 4 * fq); store4bf(d + 16 * n, acc[m][n][0] * r * gg[0], acc[m][n][1] * r * gg[1], acc[m][n][2] * r * gg[2], acc[m][n][3] * r * gg[3]); }
            } else { bf16_t* d = vm + ((size_t)(b * 4 + h) * SEQ + s) * 64 + 4 * fq;
#pragma unroll
                for (int n = 0; n < 4; ++n) store4bf(d + 16 * n, acc[m][n][0], acc[m][n][1], acc[m][n][2], acc[m][n][3]); }
        }
    }
};
struct EpiResid { const float* base; float* out;
    DEVINL void operator()(f32x4 (&acc)[4][4], int row0, int chunk, int fr, int fq) const {
#pragma unroll
        for (int m = 0; m < 4; ++m) { const size_t o = (size_t)(row0 + 16 * m + fr) * DM + chunk * 64 + 4 * fq;
#pragma unroll
            for (int n = 0; n < 4; ++n) { const f32x4 bv = *(const f32x4*)(base + o + 16 * n); *(f32x4*)(out + o + 16 * n) = bv + acc[m][n]; } } } };
struct EpiStore { float* out;
    DEVINL void operator()(f32x4 (&acc)[4][4], int row0, int chunk, int fr, int fq) const {
#pragma unroll
        for (int m = 0; m < 4; ++m) { const size_t o = (size_t)(row0 + 16 * m + fr) * DM + chunk * 64 + 4 * fq;
#pragma unroll
            for (int n = 0; n < 4; ++n) *(f32x4*)(out + o + 16 * n) = acc[m][n]; } } };
struct EpiPle { const float* xa; const float* pp; float* out;
    DEVINL void operator()(f32x4 (&acc)[4][4], int row0, int chunk, int fr, int fq) const {
#pragma unroll
        for (int m = 0; m < 4; ++m) { const size_t o = (size_t)(row0 + 16 * m + fr) * DM + chunk * 64 + 4 * fq;
#pragma unroll
            for (int n = 0; n < 4; ++n) { const f32x4 xv = *(const f32x4*)(xa + o + 16 * n), pv = *(const f32x4*)(pp + o + 16 * n); f32x4 r;
#pragma unroll
                for (int j = 0; j < 4; ++j) r[j] = xv[j] + pv[j] / (1.0f + __expf(-acc[m][n][j]));
                *(f32x4*)(out + o + 16 * n) = r; } } } };

namespace pg8 {
#define PG8_LAS __attribute__((address_space(3)))
constexpr int BM = 256, BK = 64, HALF = 128, HTB = HALF * BK * 2  , STAGE_BYTES = 8 * HTB, NXCD = 8, WGM = 8;

__host__ __device__ __forceinline__ int lds_byte(int r, int c) { const int st = (r >> 4) * 2 + (c >> 5), rr = r & 15, cc = c & 31, ob = rr * 64 + cc * 2; return st * 1024 + (ob ^ (((ob >> 9) & 1) << 5)); }
__host__ __device__ __forceinline__ void stage_rc(int b, int& R, int& C) { const int st = b / 1024, sb = b % 1024, swz = sb ^ (((sb >> 9) & 1) << 5); R = (st >> 1) * 16 + swz / 64; C = (st & 1) * 32 + (swz % 64) / 2; }
__host__ __device__ __forceinline__ int perm32(int rho) { const int n = rho >> 4, i = rho & 15; return 8 * (i >> 2) + 4 * n + (i & 3); }

struct Unit { int pm, pn; };
struct Gemm { const bf16_t* A; const bf16_t* Bt; int M, N, K; };

struct StaticOrder {
    int nM, nN, nwg, G, c;
    __host__ __device__ void init(int M, int N, int G_, int c_) { nM = M / BM; nN = N / BM; nwg = nM * nN; G = G_; c = c_; }
    __host__ __device__ bool next(int i, Unit& u) const {
        const long L = (long)i * G + c; if (L >= nwg) return false;
        int wgid = (int)L; { const int q = nwg / NXCD, r = nwg % NXCD, xcd = wgid % NXCD, off = wgid / NXCD; wgid = (xcd < r ? xcd * (q + 1) : r * (q + 1) + (xcd - r) * q) + off; }
        const int nig = WGM * nN, gid = wgid / nig, fm = gid * WGM, gsz = (nM - fm) < WGM ? (nM - fm) : WGM;
        u.pm = fm + ((wgid % nig) % gsz); u.pn = (wgid % nig) / gsz; return true;
    }
    __device__ __forceinline__ void a_ready(const Unit&) const {}
    __device__ __forceinline__ void done(const Unit&) const {}
};

template <class Epi, class Sched, bool ALIGN_EPI = false, bool SP2 = false>
__device__ __forceinline__ void gemm_phase(PG8_LAS unsigned char* lds, const Gemm g, const Sched& S, const Epi& E) {
    const int tid = ltid(), wid = __builtin_amdgcn_readfirstlane(tid >> 6), lane = tid & 63, wr = wid >> 2, wc = wid & 3, fr = lane & 15, fq = lane >> 4;
    const int K = g.K, nt = K / BK;
    unsigned voffA[2], voffB[2];
#pragma unroll
    for (int i = 0; i < 2; ++i) { int R, C; stage_rc(tid * 16 + i * 8192, R, C); const int Rb = Epi::PERM ? ((R & ~31) + perm32(R & 31)) : R;
        voffA[i] = (unsigned)(R * K + C) * 2u; voffB[i] = (unsigned)(Rb * K + C) * 2u; }
    const size_t kstep = (size_t)(BK * 2);
    const size_t hstep = (size_t)HALF * K * 2;
    const size_t tstep = 2 * hstep;
    const unsigned ldsw = (unsigned)wid * 1024u;
    const int aoff = lds_byte(wr * 64 + fr, fq * 8), boff = lds_byte(wc * 32 + fr, fq * 8);
    PG8_LAS unsigned char* ldsA = lds + aoff; PG8_LAS unsigned char* ldsB = lds + 65536 + boff; asm volatile("" : "+v"(ldsA), "+v"(ldsB));
#define PG8_SA(b, h) (((b) * 2 + (h)) * HTB)
#define PG8_SB(b, h) ((4 + (b) * 2 + (h)) * HTB)
#define PG8_STAGE(bufoff, gbase, voff) do { _Pragma("unroll") for (int _i = 0; _i < 2; ++_i) \
        __builtin_amdgcn_global_load_lds((const unsigned*)((const char*)(gbase) + (voff)[_i]), (PG8_LAS unsigned*)(lds + (bufoff) + ldsw + _i * 8192), 16, 0, 0); } while (0)
#define PG8_LDA(dst, b, h) do { _Pragma("unroll") for (int m = 0; m < 4; ++m) _Pragma("unroll") for (int k = 0; k < 2; ++k) dst[m][k] = *(const PG8_LAS bf16x8*)(ldsA + PG8_SA(b, h) + m * 2048 + k * 1024); } while (0)
#define PG8_LDB(dst, b, h) do { _Pragma("unroll") for (int n = 0; n < 2; ++n) _Pragma("unroll") for (int k = 0; k < 2; ++k) dst[n][k] = *(const PG8_LAS bf16x8*)(ldsB + (PG8_SB(b, h) - 65536) + n * 2048 + k * 1024); } while (0)
#define PG8_MMA(ai, bj, At, Bt) do { __builtin_amdgcn_s_setprio(1); _Pragma("unroll") for (int m = 0; m < 4; ++m) _Pragma("unroll") for (int n = 0; n < 2; ++n) _Pragma("unroll") for (int k = 0; k < 2; ++k) \
        acc[ai][bj][m][n] = __builtin_amdgcn_mfma_f32_16x16x32_bf16(Bt[n][k], At[m][k], acc[ai][bj][m][n], 0, 0, 0); __builtin_amdgcn_s_setprio(0); } while (0)
#define PG8_WAIT_V(n) asm volatile("s_waitcnt vmcnt(" #n ")" ::: "memory")
#define PG8_WAIT_L(n) asm volatile("s_waitcnt lgkmcnt(" #n ")" ::: "memory")
#define PG8_BAR __builtin_amdgcn_s_barrier()
#define PG8_SCHED __builtin_amdgcn_sched_barrier(0)
    Unit cur, nxt; int ui = 0;
    if (!S.next(0, cur)) return;
    f32x4 acc[2][2][4][2];
#pragma unroll
    for (int a = 0; a < 2; ++a)
#pragma unroll
        for (int b = 0; b < 2; ++b)
#pragma unroll
            for (int m = 0; m < 4; ++m)
#pragma unroll
                for (int n = 0; n < 2; ++n) acc[a][b][m][n] = (f32x4){0.f, 0.f, 0.f, 0.f};
    bf16x8 At[4][2], B0[2][2], B1[2][2];
    const char* cA = (const char*)g.A + (size_t)cur.pm * tstep; const char* cB = (const char*)g.Bt + (size_t)cur.pn * tstep;
    S.a_ready(cur);
    if constexpr (SP2) {
        PG8_STAGE(PG8_SB(0, 0), cB, voffB); PG8_STAGE(PG8_SB(0, 1), cB + hstep, voffB); PG8_STAGE(PG8_SA(0, 0), cA, voffA); PG8_STAGE(PG8_SA(0, 1), cA + hstep, voffA);
        if (wr == 1) PG8_BAR;
        PG8_WAIT_V(2); PG8_BAR;
        PG8_STAGE(PG8_SB(1, 0), cB + kstep, voffB); PG8_STAGE(PG8_SA(1, 0), cA + kstep, voffA); PG8_STAGE(PG8_SB(1, 1), cB + hstep + kstep, voffB);
        PG8_WAIT_V(6); PG8_BAR;
    } else {
        PG8_STAGE(PG8_SB(0, 0), cB, voffB); PG8_STAGE(PG8_SA(0, 0), cA, voffA); PG8_STAGE(PG8_SB(0, 1), cB + hstep, voffB); PG8_STAGE(PG8_SA(0, 1), cA + hstep, voffA);
        if (wr == 1) PG8_BAR;
        PG8_WAIT_V(4); PG8_BAR;
        PG8_STAGE(PG8_SB(1, 0), cB + kstep, voffB); PG8_STAGE(PG8_SA(1, 0), cA + kstep, voffA); PG8_STAGE(PG8_SB(1, 1), cB + hstep + kstep, voffB);
        PG8_WAIT_V(6); PG8_BAR;
    }
    for (;;) {
        const bool has_next = S.next(ui + 1, nxt);
        const char* nA = has_next ? (const char*)g.A + (size_t)nxt.pm * tstep : cA; const char* nB = has_next ? (const char*)g.Bt + (size_t)nxt.pn * tstep : cB;
        for (int t = 0; t < nt; t += 2) {
            const bool last = (t == nt - 2);
            const char* a1 = cA + (size_t)(t + 1) * kstep;
            const char* a2 = last ? nA : cA + (size_t)(t + 2) * kstep; const char* b2 = last ? nB : cB + (size_t)(t + 2) * kstep;
            const char* a3 = a2 + kstep; const char* b3 = b2 + kstep;
            if (last && has_next) S.a_ready(nxt);
            if constexpr (SP2) {
            PG8_LDB(B0, 0, 0); PG8_LDB(B1, 0, 1); PG8_SCHED; PG8_LDA(At, 0, 0); PG8_STAGE(PG8_SA(1, 1), a1 + hstep, voffA);
            PG8_WAIT_V(8); PG8_WAIT_L(0); PG8_BAR; PG8_MMA(0, 0, At, B0); PG8_MMA(0, 1, At, B1); PG8_BAR; PG8_SCHED;
            PG8_LDA(At, 0, 1); PG8_STAGE(PG8_SB(0, 0), b2, voffB); PG8_STAGE(PG8_SB(0, 1), b2 + hstep, voffB); PG8_STAGE(PG8_SA(0, 0), a2, voffA);
            PG8_WAIT_V(8); PG8_WAIT_L(0); PG8_BAR; PG8_MMA(1, 0, At, B0); PG8_MMA(1, 1, At, B1); PG8_BAR; PG8_SCHED;
            PG8_LDB(B0, 1, 0); PG8_LDB(B1, 1, 1); PG8_SCHED; PG8_LDA(At, 1, 0); PG8_STAGE(PG8_SA(0, 1), a2 + hstep, voffA);
            PG8_WAIT_V(8); PG8_WAIT_L(0); PG8_BAR; PG8_MMA(0, 0, At, B0); PG8_MMA(0, 1, At, B1); PG8_BAR; PG8_SCHED;
            PG8_LDA(At, 1, 1); PG8_STAGE(PG8_SB(1, 0), b3, voffB); PG8_STAGE(PG8_SB(1, 1), b3 + hstep, voffB); PG8_STAGE(PG8_SA(1, 0), a3, voffA);
            PG8_WAIT_V(8); PG8_WAIT_L(0); PG8_BAR; PG8_MMA(1, 0, At, B0); PG8_MMA(1, 1, At, B1); PG8_BAR; PG8_SCHED;
            } else {
            PG8_LDB(B0, 0, 0); PG8_SCHED; PG8_LDA(At, 0, 0); PG8_STAGE(PG8_SA(1, 1), a1 + hstep, voffA);
            PG8_WAIT_L(8); PG8_BAR; PG8_WAIT_L(0); PG8_MMA(0, 0, At, B0); PG8_BAR; PG8_SCHED;
            PG8_LDB(B1, 0, 1); PG8_STAGE(PG8_SB(0, 0), b2, voffB);
            PG8_BAR; PG8_WAIT_L(0); PG8_MMA(0, 1, At, B1); PG8_BAR;
            PG8_LDA(At, 0, 1); PG8_STAGE(PG8_SA(0, 0), a2, voffA);
            PG8_BAR; PG8_WAIT_L(0); PG8_MMA(1, 0, At, B0); PG8_BAR; PG8_SCHED;
            PG8_STAGE(PG8_SB(0, 1), b2 + hstep, voffB);
            PG8_WAIT_V(6); PG8_BAR; PG8_MMA(1, 1, At, B1); PG8_BAR;
            PG8_LDB(B0, 1, 0); PG8_SCHED; PG8_LDA(At, 1, 0); PG8_STAGE(PG8_SA(0, 1), a2 + hstep, voffA);
            PG8_WAIT_L(8); PG8_BAR; PG8_WAIT_L(0); PG8_MMA(0, 0, At, B0); PG8_BAR; PG8_SCHED;
            PG8_LDB(B1, 1, 1); PG8_STAGE(PG8_SB(1, 0), b3, voffB);
            PG8_BAR; PG8_WAIT_L(0); PG8_MMA(0, 1, At, B1); PG8_BAR;
            PG8_LDA(At, 1, 1); PG8_STAGE(PG8_SA(1, 0), a3, voffA);
            PG8_BAR; PG8_WAIT_L(0); PG8_MMA(1, 0, At, B0); PG8_BAR; PG8_SCHED;
            PG8_STAGE(PG8_SB(1, 1), b3 + hstep, voffB);
            PG8_WAIT_V(6); PG8_BAR; PG8_MMA(1, 1, At, B1); PG8_BAR;
            }
        }
        if constexpr (ALIGN_EPI) { if (wr == 0) PG8_BAR; }
        if constexpr (!Epi::AFTER_DRAIN) { E(acc, cur, wr, wc, fr, fq); S.done(cur); }
        if (!has_next) break;
#pragma unroll
        for (int a = 0; a < 2; ++a)
#pragma unroll
            for (int b = 0; b < 2; ++b)
#pragma unroll
                for (int m = 0; m < 4; ++m)
#pragma unroll
                    for (int n = 0; n < 2; ++n) acc[a][b][m][n] = (f32x4){0.f, 0.f, 0.f, 0.f};
        cur = nxt; cA = nA; cB = nB; ++ui;
        if constexpr (ALIGN_EPI) { if (wr == 1) PG8_BAR; }
    }
    PG8_WAIT_V(0);
    if constexpr (!ALIGN_EPI) { if (wr == 0) PG8_BAR; }
    PG8_BAR;
    if constexpr (Epi::AFTER_DRAIN) { E.fused(acc, cur, wr, wc, fr, fq, lds, wid, lane); S.done(cur); }
#undef PG8_SA
#undef PG8_SB
#undef PG8_STAGE
#undef PG8_LDA
#undef PG8_LDB
#undef PG8_MMA
#undef PG8_WAIT_V
#undef PG8_WAIT_L
#undef PG8_BAR
#undef PG8_SCHED
}
}


DEVINL u32x4 pack8(const f32x4& a, const f32x4& b) { u32x4 w; w.x = cvt2(a[0], a[1]); w.y = cvt2(a[2], a[3]); w.z = cvt2(b[0], b[1]); w.w = cvt2(b[2], b[3]); return w; }
DEVINL float row_rscale(const float* ssq, int t, int fq) { const f32x4 a = *(const f32x4*)(ssq + (size_t)t * 16 + 4 * fq); return rsqrtf(quad_sum(a[0] + a[1] + a[2] + a[3]) * (1.0f / DM) + EPS); }
struct EpiIn8 {
    static constexpr bool PERM = true, AFTER_DRAIN = false;
    Params P; int l;
    DEVINL void operator()(const f32x4 (&acc0)[2][2][4][2], const pg8::Unit& u, int wr, int wc, int fr, int fq) const {
        { const int t_ = ltid(); fr = t_ & 15; fq = (t_ >> 4) & 3; wc = __builtin_amdgcn_readfirstlane((t_ >> 6) & 3); wr = __builtin_amdgcn_readfirstlane(t_ >> 8); }
        char* ws = P.ws; char* ob = (char*)P.out; const int chunk = u.pn * 4 + wc;
        const float* ssqx = (const float*)(ws + OFF_SSQX);
        if (chunk < 36) {
            const int g = chunk >> 2, h = chunk & 3, role = g % 3, mix = g / 3;
            bf16_t* dst = (bf16_t*)(ws + OFF_QKV + (size_t)g * SZ_HEADBUF);
            const float* gain = P.qk_gain + ((size_t)l * 6 + 2 * mix + (role == 1 ? 1 : 0)) * 64 + 8 * fq;
            f32x4 gg[2][2];
#pragma unroll
            for (int bj = 0; bj < 2; ++bj)
#pragma unroll
                for (int n = 0; n < 2; ++n) gg[bj][n] = role != 2 ? *(const f32x4*)(gain + 32 * bj + 4 * n) : (f32x4){1.f, 1.f, 1.f, 1.f};
#pragma unroll
            for (int ai = 0; ai < 2; ++ai)
#pragma unroll
                for (int m = 0; m < 4; ++m) {
                    const int t = u.pm * 256 + 128 * ai + 64 * wr + 16 * m + fr, b = t >> 12, s = t & 4095; const float rt_ = row_rscale(ssqx, t, fq); const f32x4 a[2][2] = {{acc0[ai][0][m][0] * rt_, acc0[ai][0][m][1] * rt_}, {acc0[ai][1][m][0] * rt_, acc0[ai][1][m][1] * rt_}}; bf16_t* d = dst + ((size_t)(b * 4 + h) * SEQ + s) * 64 + 8 * fq;
                    float r = 1.f;
                    if (role != 2) { float ss = sq4(a[0][0]) + sq4(a[0][1]) + sq4(a[1][0]) + sq4(a[1][1]); ss = quad_sum(ss); r = rsqrtf(ss * (1.0f / 64.0f) + EPS) * (role == 0 ? SC_Q : 1.0f); }
#pragma unroll
                    for (int bj = 0; bj < 2; ++bj) *(u32x4*)(d + 32 * bj) = pack8(a[bj][0] * r * gg[bj][0], a[bj][1] * r * gg[bj][1]);
                }
        } else if (chunk < 42) {
            const bool isq = chunk < 40; const int c = isq ? chunk - 36 : chunk - 40;
            bf16_t* dst = isq ? (bf16_t*)(ws + OFF_CQ) : (bf16_t*)(ws + OFF_CKV); const int ld = 256;
            float* ssp = isq ? (float*)(ws + OFF_CQSS) : (float*)(ws + OFF_CKVSS); const int nss = isq ? 4 : 2;
#pragma unroll
            for (int ai = 0; ai < 2; ++ai)
#pragma unroll
                for (int m = 0; m < 4; ++m) {
                    const int t = u.pm * 256 + 128 * ai + 64 * wr + 16 * m + fr; const float rt_ = row_rscale(ssqx, t, fq); const f32x4 a[2][2] = {{acc0[ai][0][m][0] * rt_, acc0[ai][0][m][1] * rt_}, {acc0[ai][1][m][0] * rt_, acc0[ai][1][m][1] * rt_}};
                    float ss = sq4(a[0][0]) + sq4(a[0][1]) + sq4(a[1][0]) + sq4(a[1][1]); ss = quad_sum(ss);
#pragma unroll
                    for (int bj = 0; bj < 2; ++bj) *(u32x4*)(dst + (size_t)t * ld + c * 64 + 32 * bj + 8 * fq) = pack8(a[bj][0], a[bj][1]);
                    if (fq == 0) ssp[(size_t)t * nss + c] = ss;
                }
        } else if (chunk == 42) {
            const float* gr = P.mla_rope_gain + ((size_t)l * 2 + 1) * 32; const float2* rope = (const float2*)(ws + OFF_ROPE);
            bf16_t* km = (bf16_t*)(ob + OOFF_KM); float* logf_ = (float*)(ws + OFF_LOGF);
            const f32x4 g1 = *(const f32x4*)(gr + 4 * fq), g2 = *(const f32x4*)(gr + 16 + 4 * fq); const f32x4 bfv = *(const f32x4*)(P.b_forget + l * 4);
#pragma unroll
            for (int ai = 0; ai < 2; ++ai)
#pragma unroll
                for (int m = 0; m < 4; ++m) {
                    const int t = u.pm * 256 + 128 * ai + 64 * wr + 16 * m + fr, b = t >> 12, s = t & 4095; const float rt_ = row_rscale(ssqx, t, fq); const f32x4 a[2][2] = {{acc0[ai][0][m][0] * rt_, acc0[ai][0][m][1] * rt_}, {acc0[ai][1][m][0] * rt_, acc0[ai][1][m][1] * rt_}};
                    float ss = sq4(a[0][0]) + sq4(a[0][1]); ss = quad_sum(ss); const float r = rsqrtf(ss * (1.0f / 32.0f) + EPS);
                    float o1[4], o2[4];
#pragma unroll
                    for (int j = 0; j < 4; ++j) { const float2 cs = rope[s * 16 + 4 * fq + j]; const float x1 = a[0][0][j] * r * g1[j], x2 = a[0][1][j] * r * g2[j]; o1[j] = x1 * cs.x - x2 * cs.y; o2[j] = x1 * cs.y + x2 * cs.x; }
#pragma unroll
                    for (int h = 0; h < 4; ++h) { bf16_t* d = km + ((size_t)(b * 4 + h) * SEQ + s) * 96 + 64 + 4 * fq; store4bf(d, o1[0], o1[1], o1[2], o1[3]); store4bf(d + 16, o2[0], o2[1], o2[2], o2[3]); }
                    if (fq == 0) {
#pragma unroll
                        for (int j = 0; j < 4; ++j) logf_[(size_t)(b * 4 + j) * SEQ + s] = log_sigmoid(a[1][0][j] + bfv[j]) * LOG2E;
                    }
                }
        } else if (chunk >= 44) {
            bf16_t* G = (bf16_t*)(ob + OOFF_G); const int c0 = (chunk - 44) * 64 + 8 * fq;
#pragma unroll
            for (int ai = 0; ai < 2; ++ai)
#pragma unroll
                for (int m = 0; m < 4; ++m) {
                    const int t = u.pm * 256 + 128 * ai + 64 * wr + 16 * m + fr; const float rt_ = row_rscale(ssqx, t, fq); const f32x4 a[2][2] = {{acc0[ai][0][m][0] * rt_, acc0[ai][0][m][1] * rt_}, {acc0[ai][1][m][0] * rt_, acc0[ai][1][m][1] * rt_}};
#pragma unroll
                    for (int bj = 0; bj < 2; ++bj) { f32x4 o0, o1;
#pragma unroll
                        for (int j = 0; j < 4; ++j) { const float z0 = a[bj][0][j], z1 = a[bj][1][j]; o0[j] = z0 * fsigmoid(z0); o1[j] = z1 * fsigmoid(z1); }
                        *(u32x4*)(G + (size_t)t * DM + c0 + 32 * bj) = pack8(o0, o1); }
                }
        }
    }
};
struct EpiResid8 { static constexpr bool PERM = true, AFTER_DRAIN = false; const float* base; const bf16_t* bbase; bf16_t* obf; float* ssq;
    DEVINL void operator()(const f32x4 (&acc)[2][2][4][2], const pg8::Unit& u, int wr, int wc, int fr, int fq) const {
        { const int t_ = ltid(); fr = t_ & 15; fq = (t_ >> 4) & 3; wc = __builtin_amdgcn_readfirstlane((t_ >> 6) & 3); wr = __builtin_amdgcn_readfirstlane(t_ >> 8); }
#pragma unroll
        for (int ai = 0; ai < 2; ++ai)
#pragma unroll
            for (int m = 0; m < 4; ++m) { const int t = u.pm * 256 + 128 * ai + 64 * wr + 16 * m + fr; const size_t o = (size_t)t * DM + u.pn * 256 + 64 * wc + 8 * fq; float ss = 0.f;
#pragma unroll
                for (int bj = 0; bj < 2; ++bj) { f32x4 v0, v1;
                    if (bbase) { const u32x4 bw = *(const u32x4*)(bbase + o + 32 * bj); v0 = (f32x4){bflo(bw.x), bfhi(bw.x), bflo(bw.y), bfhi(bw.y)}; v1 = (f32x4){bflo(bw.z), bfhi(bw.z), bflo(bw.w), bfhi(bw.w)}; }
                    else { v0 = __builtin_nontemporal_load((const f32x4*)(base + o + 32 * bj)); v1 = __builtin_nontemporal_load((const f32x4*)(base + o + 32 * bj + 4)); }
                    v0 += acc[ai][bj][m][0]; v1 += acc[ai][bj][m][1];
                    *(u32x4*)(obf + o + 32 * bj) = pack8(v0, v1); ss += sq4(v0) + sq4(v1); }
                ss = quad_sum(ss); if (fq == 0) ssq[(size_t)t * 16 + u.pn * 4 + wc] = ss; } } };
struct EpiStoreBf { static constexpr bool PERM = true, AFTER_DRAIN = false; bf16_t* out;
    DEVINL void operator()(const f32x4 (&acc)[2][2][4][2], const pg8::Unit& u, int wr, int wc, int fr, int fq) const {
        { const int t_ = ltid(); fr = t_ & 15; fq = (t_ >> 4) & 3; wc = __builtin_amdgcn_readfirstlane((t_ >> 6) & 3); wr = __builtin_amdgcn_readfirstlane(t_ >> 8); }
#pragma unroll
        for (int ai = 0; ai < 2; ++ai)
#pragma unroll
            for (int m = 0; m < 4; ++m) { const size_t o = (size_t)(u.pm * 256 + 128 * ai + 64 * wr + 16 * m + fr) * DM + u.pn * 256 + 64 * wc + 8 * fq;
#pragma unroll
                for (int bj = 0; bj < 2; ++bj) *(u32x4*)(out + o + 32 * bj) = pack8(acc[ai][bj][m][0], acc[ai][bj][m][1]); } } };
struct EpiPle8 { static constexpr bool PERM = true, AFTER_DRAIN = false; const bf16_t* xa; const bf16_t* pp; float* out; const float* ssq_in; bf16_t* obf; float* ssq_out;
    DEVINL void operator()(const f32x4 (&acc)[2][2][4][2], const pg8::Unit& u, int wr, int wc, int fr, int fq) const {
        { const int t_ = ltid(); fr = t_ & 15; fq = (t_ >> 4) & 3; wc = __builtin_amdgcn_readfirstlane((t_ >> 6) & 3); wr = __builtin_amdgcn_readfirstlane(t_ >> 8); }
#pragma unroll
        for (int ai = 0; ai < 2; ++ai)
#pragma unroll
            for (int m = 0; m < 4; ++m) { const int t = u.pm * 256 + 128 * ai + 64 * wr + 16 * m + fr; const size_t o = (size_t)t * DM + u.pn * 256 + 64 * wc + 8 * fq;
                const float rt = row_rscale(ssq_in, t, fq); float ss = 0.f;
#pragma unroll
                for (int bj = 0; bj < 2; ++bj) { const u32x4 xw = *(const u32x4*)(xa + o + 32 * bj); const f32x4 x0 = (f32x4){bflo(xw.x), bfhi(xw.x), bflo(xw.y), bfhi(xw.y)}, x1 = (f32x4){bflo(xw.z), bfhi(xw.z), bflo(xw.w), bfhi(xw.w)}; const u32x4 pw = *(const u32x4*)(pp + o + 32 * bj); f32x4 r0, r1;
                    const float pv[8] = {bflo(pw.x), bfhi(pw.x), bflo(pw.y), bfhi(pw.y), bflo(pw.z), bfhi(pw.z), bflo(pw.w), bfhi(pw.w)};
#pragma unroll
                    for (int jj = 0; jj < 4; ++jj) { r0[jj] = x0[jj] + pv[jj] * fsigmoid(rt * acc[ai][bj][m][0][jj]); r1[jj] = x1[jj] + pv[4 + jj] * fsigmoid(rt * acc[ai][bj][m][1][jj]); }
                    if (out) { __builtin_nontemporal_store(r0, (f32x4*)(out + o + 32 * bj)); __builtin_nontemporal_store(r1, (f32x4*)(out + o + 32 * bj + 4)); }
                    if (obf) { *(u32x4*)(obf + o + 32 * bj) = pack8(r0, r1); ss += sq4(r0) + sq4(r1); } }
                if (obf) { ss = quad_sum(ss); if (fq == 0) ssq_out[(size_t)t * 16 + u.pn * 4 + wc] = ss; } } } };
struct EpiUq8 { static constexpr bool PERM = true, AFTER_DRAIN = false; Params P; int l;
    DEVINL void operator()(const f32x4 (&acc)[2][2][4][2], const pg8::Unit& u, int wr, int wc, int fr, int fq) const {
        { const int t_ = ltid(); fr = t_ & 15; fq = (t_ >> 4) & 3; wc = __builtin_amdgcn_readfirstlane((t_ >> 6) & 3); wr = __builtin_amdgcn_readfirstlane(t_ >> 8); }
        const int chunk = u.pn * 4 + wc; if (chunk >= 6) return;
        const float* cqss = (const float*)(P.ws + OFF_CQSS); bf16_t* qm = (bf16_t*)((char*)P.out + OOFF_QM); const float2* rope = (const float2*)(P.ws + OFF_ROPE);
#pragma unroll
        for (int ai = 0; ai < 2; ++ai)
#pragma unroll
            for (int m = 0; m < 4; ++m) {
                const int t = u.pm * 256 + 128 * ai + 64 * wr + 16 * m + fr, b = t >> 12, s = t & 4095;
                const float rt = rsqrtf(quad_sum(cqss[(size_t)t * 4 + fq]) * (1.0f / 256.0f) + EPS);
                const f32x4 a[2][2] = {{acc[ai][0][m][0] * rt, acc[ai][0][m][1] * rt}, {acc[ai][1][m][0] * rt, acc[ai][1][m][1] * rt}};
                if (chunk < 4) {
                    const float* gain = P.mla_nope_gain + ((size_t)l * 2 + 0) * 64 + 8 * fq;
                    float ss = sq4(a[0][0]) + sq4(a[0][1]) + sq4(a[1][0]) + sq4(a[1][1]); ss = quad_sum(ss); const float r = rsqrtf(ss * (1.0f / 64.0f) + EPS) * SC_MLA;
                    bf16_t* d = qm + ((size_t)(b * 4 + chunk) * SEQ + s) * 96 + 8 * fq;
#pragma unroll
                    for (int bj = 0; bj < 2; ++bj) { const f32x4 g0 = *(const f32x4*)(gain + 32 * bj), g1 = *(const f32x4*)(gain + 32 * bj + 4); *(u32x4*)(d + 32 * bj) = pack8(a[bj][0] * r * g0, a[bj][1] * r * g1); }
                } else {
                    const float* gr = P.mla_rope_gain + ((size_t)l * 2 + 0) * 32; const f32x4 g1 = *(const f32x4*)(gr + 4 * fq), g2 = *(const f32x4*)(gr + 16 + 4 * fq);
#pragma unroll
                    for (int bj = 0; bj < 2; ++bj) { const int h = (chunk - 4) * 2 + bj;
                        float ss = sq4(a[bj][0]) + sq4(a[bj][1]); ss = quad_sum(ss); const float r = rsqrtf(ss * (1.0f / 32.0f) + EPS);
                        float o1[4], o2[4];
#pragma unroll
                        for (int j = 0; j < 4; ++j) { const float2 cs = rope[s * 16 + 4 * fq + j]; const float x1 = a[bj][0][j] * r * g1[j], x2 = a[bj][1][j] * r * g2[j]; o1[j] = (x1 * cs.x - x2 * cs.y) * SC_MLA; o2[j] = (x1 * cs.y + x2 * cs.x) * SC_MLA; }
                        bf16_t* d = qm + ((size_t)(b * 4 + h) * SEQ + s) * 96 + 64 + 4 * fq; store4bf(d, o1[0], o1[1], o1[2], o1[3]); store4bf(d + 16, o2[0], o2[1], o2[2], o2[3]); }
                }
            }
    }
};
struct EpiUkv8 { static constexpr bool PERM = true, AFTER_DRAIN = false; Params P; int l;
    DEVINL void operator()(const f32x4 (&acc)[2][2][4][2], const pg8::Unit& u, int wr, int wc, int fr, int fq) const {
        { const int t_ = ltid(); fr = t_ & 15; fq = (t_ >> 4) & 3; wc = __builtin_amdgcn_readfirstlane((t_ >> 6) & 3); wr = __builtin_amdgcn_readfirstlane(t_ >> 8); }
        const int chunk = u.pn * 4 + wc, h = chunk >> 1; const bool isk = (chunk & 1) == 0;
        const float* ckvss = (const float*)(P.ws + OFF_CKVSS); bf16_t* km = (bf16_t*)((char*)P.out + OOFF_KM); bf16_t* vm = (bf16_t*)((char*)P.out + OOFF_VM);
        const float* gain = P.mla_nope_gain + ((size_t)l * 2 + 1) * 64 + 8 * fq;
#pragma unroll
        for (int ai = 0; ai < 2; ++ai)
#pragma unroll
            for (int m = 0; m < 4; ++m) {
                const int t = u.pm * 256 + 128 * ai + 64 * wr + 16 * m + fr, b = t >> 12, s = t & 4095;
                const float rt = rsqrtf(quad_sum(fq < 2 ? ckvss[(size_t)t * 2 + fq] : 0.f) * (1.0f / 128.0f) + EPS);
                const f32x4 a[2][2] = {{acc[ai][0][m][0] * rt, acc[ai][0][m][1] * rt}, {acc[ai][1][m][0] * rt, acc[ai][1][m][1] * rt}};
                if (isk) { float ss = sq4(a[0][0]) + sq4(a[0][1]) + sq4(a[1][0]) + sq4(a[1][1]); ss = quad_sum(ss); const float r = rsqrtf(ss * (1.0f / 64.0f) + EPS);
                    bf16_t* d = km + ((size_t)(b * 4 + h) * SEQ + s) * 96 + 8 * fq;
#pragma unroll
                    for (int bj = 0; bj < 2; ++bj) { const f32x4 g0 = *(const f32x4*)(gain + 32 * bj), g1 = *(const f32x4*)(gain + 32 * bj + 4); *(u32x4*)(d + 32 * bj) = pack8(a[bj][0] * r * g0, a[bj][1] * r * g1); }
                } else { bf16_t* d = vm + ((size_t)(b * 4 + h) * SEQ + s) * 64 + 8 * fq;
#pragma unroll
                    for (int bj = 0; bj < 2; ++bj) *(u32x4*)(d + 32 * bj) = pack8(a[bj][0], a[bj][1]); }
            }
    }
};
template <class Epi> DEVINL void gemm8(const bf16_t* A, const bf16_t* Bt, int M, int N, int K, const Epi& E, char* smem) {
    int G = (int)gridDim.x, c = (int)blockIdx.x; asm volatile("" : "+s"(G), "+s"(c));
    pg8::Gemm g{A, Bt, M, N, K}; pg8::StaticOrder S; S.init(M, N, G, c);
    pg8::gemm_phase<Epi, pg8::StaticOrder, true, true>((PG8_LAS unsigned char*)smem, g, S, E);
}

DEVINL void kmean_unit(const Params& P, int u, char* smem) {
    float* red = (float*)smem; const bf16_t* K = (const bf16_t*)(P.ws + OFF_QKV + 4 * SZ_HEADBUF); float* km = (float*)(P.ws + OFF_KMEAN);
    const int tid = ltid(), dc = tid & 7, rg = tid >> 3;
    const bf16_t* kp = K + ((size_t)(u >> 4) * SEQ + (u & 15) * 256 + rg) * 64 + dc * 8;
    u32x4 w[4];
#pragma unroll
    for (int i = 0; i < 4; ++i) w[i] = *(const u32x4*)(kp + (size_t)i * 64 * 64);
    float s[8] = {0.f, 0.f, 0.f, 0.f, 0.f, 0.f, 0.f, 0.f};
#pragma unroll
    for (int i = 0; i < 4; ++i) { s[0] += bflo(w[i].x); s[1] += bfhi(w[i].x); s[2] += bflo(w[i].y); s[3] += bfhi(w[i].y); s[4] += bflo(w[i].z); s[5] += bfhi(w[i].z); s[6] += bflo(w[i].w); s[7] += bfhi(w[i].w); }
    __syncthreads();
#pragma unroll
    for (int e = 0; e < 8; ++e) red[rg * 65 + dc * 8 + e] = s[e];
    __syncthreads();
    if (tid < 64) { float a = 0.f;
#pragma unroll 8
        for (int i = 0; i < 64; ++i) a += red[i * 65 + tid];
        km[(size_t)u * 64 + tid] = a * (1.0f / 256.0f); }
}

typedef float f32x16 __attribute__((ext_vector_type(16)));
typedef short s16x4 __attribute__((ext_vector_type(4)));
typedef short v4i16_t __attribute__((ext_vector_type(4)));
#define LAS __attribute__((address_space(3)))
#define MFMA32(a, b, c) __builtin_amdgcn_mfma_f32_32x32x16_bf16(a, b, c, 0, 0, 0)
DEVINL s16x4 vtr(const LAS char* p) { return __builtin_bit_cast(s16x4, __builtin_amdgcn_ds_read_tr16_b64_v4i16((LAS v4i16_t*)p)); }
DEVINL float swap_max(float v) { auto rr = __builtin_amdgcn_permlane32_swap(__float_as_uint(v), __float_as_uint(v), false, false); return fmaxf(__uint_as_float(rr[0]), __uint_as_float(rr[1])); }
DEVINL float swap_sum(float v) { auto rr = __builtin_amdgcn_permlane32_swap(__float_as_uint(v), __float_as_uint(v), false, false); return __uint_as_float(rr[0]) + __uint_as_float(rr[1]); }
DEVINL float fadd1(float a, float b) { float r; asm("v_add_f32 %0, %1, %2" : "=v"(r) : "v"(a), "v"(b)); return r; }
DEVINL constexpr int crow(int r) { return (r & 3) + 8 * (r >> 2); }

constexpr int KSLOT = 64 * 144, RSLOT = 64 * 80;
constexpr int L_KB = 0, L_VB = 3 * KSLOT, L_KR = L_VB + 16384, L_AUX = L_KR + 3 * RSLOT, L_SCR = L_AUX + 16640 + 256, L_KMS = L_SCR + 2048, L_ATT_END = L_KMS + 4096;
constexpr float NEGBIG = -3.0e38f, THR = 8.0f;

template <int MODE>
DEVINL void attn_unit(const Params& P, int l, int u, char* smem) {
    constexpr int DK = MODE == 2 ? 96 : 64, ND0 = DK / 16;
    LAS char* lds = (LAS char*)smem;
    const int tid = ltid(), lane = tid & 63, r32 = lane & 31, hi = lane >> 5; const int wid = __builtin_amdgcn_readfirstlane(tid >> 6);
    const bool fast = ((const float*)(P.ws + OFF_BOUND))[l * 4 + MODE] < 100.0f;
    int bh, q0, t_lo, t_hi, dil = 1, res = 0, pat = 0, qb = 0;
    if (MODE != 3) { bh = u & 15; qb = 15 - (u >> 4); q0 = qb * 256; t_lo = 0; t_hi = (q0 + 255) >> 6; }
    else { pat = u >> 8; const int v = u & 255; bh = v & 15; const int w = v >> 4; dil = pat == 0 ? 1 : (pat == 1 ? 4 : 16); res = w % dil; q0 = (w / dil) * 256; t_lo = (q0 >= 128 ? q0 - 128 : 0) >> 6; t_hi = (q0 + 255) >> 6; }
    const int b = bh >> 2, h = bh & 3;
    const bf16_t *Qg, *Kg, *Vg; int rsq, rsk, rsv;
    if (MODE == 0) { Qg = (const bf16_t*)(P.ws + OFF_QKV) + (size_t)bh * SEQ * 64; Kg = Qg + SZ_HEADBUF / 2; Vg = Kg + SZ_HEADBUF / 2; rsq = rsk = rsv = 64; }
    else if (MODE == 1) { Qg = (const bf16_t*)(P.ws + OFF_QKV + 3 * SZ_HEADBUF) + (size_t)bh * SEQ * 64; Kg = Qg + SZ_HEADBUF / 2; Vg = Kg + SZ_HEADBUF / 2; rsq = rsk = rsv = 64; }
    else if (MODE == 2) { Qg = (const bf16_t*)((const char*)P.out + OOFF_QM) + (size_t)bh * SEQ * 96; Kg = (const bf16_t*)((const char*)P.out + OOFF_KM) + (size_t)bh * SEQ * 96; Vg = (const bf16_t*)((const char*)P.out + OOFF_VM) + (size_t)bh * SEQ * 64; rsq = rsk = 96; rsv = 64; }
    else { Qg = (const bf16_t*)(P.ws + OFF_QKV + 6 * SZ_HEADBUF) + ((size_t)bh * SEQ + res) * 64; Kg = Qg + SZ_HEADBUF / 2; Vg = Kg + SZ_HEADBUF / 2; rsq = rsk = rsv = 64 * dil; }
    const int qw = q0 + 32 * wid;

    __syncthreads();
    const unsigned kgo = (unsigned)((tid >> 3) * rsk + (tid & 7) * 8), vgo = (unsigned)(((tid >> 2) & 63) * rsv + (tid >> 8) * 32 + (tid & 3) * 8), rgo = (unsigned)(((tid >> 2) & 63) * rsk + 64 + (tid & 3) * 8);
    const int kws = (tid >> 3) * 144 + (tid & 7) * 16;
    const int rws = ((tid >> 2) & 63) * 80 + (tid & 3) * 16;
    u32x4 kA, rA, kB, rB;
#define ATT_LOADK(j, K_, R_) do { if ((j) <= t_hi) { K_ = *(const u32x4*)(Kg + (size_t)(j) * 64 * rsk + kgo); if (MODE == 2 && tid < 256) R_ = *(const u32x4*)(Kg + (size_t)(j) * 64 * rsk + rgo); } } while (0)
#define ATT_DMAV(j, slot) do { if ((j) <= t_hi) __builtin_amdgcn_global_load_lds((const unsigned*)(Vg + (size_t)(j) * 64 * rsv + vgo), (LAS unsigned*)(lds + L_VB + (slot) * 8192 + wid * 1024), 16, 0, 0); } while (0)
#define ATT_WRITEK(slot, j, K_, R_) do { if ((j) <= t_hi) { *(LAS u32x4*)(lds + L_KB + (slot) * KSLOT + kws) = K_; if (MODE == 2 && tid < 256) *(LAS u32x4*)(lds + L_KR + (slot) * RSLOT + rws) = R_; \
        if (MODE == 0 && tid < 64) { const float bs = aux[(j) * 64 + tid] - auxU; const unsigned hb = cvt2(bs, 0.f) & 0xffffu; const float lo = bs - __uint_as_float(hb << 16); u32x4 w; w.x = hb | (cvt2(lo, 0.f) << 16); w.y = 0x3F80u; w.z = 0u; w.w = 0u; \
            *(LAS u32x4*)(lds + L_KR + (slot) * 1024 + tid * 16) = w; } } } while (0)
    bf16x8 qf[ND0];
    { const bf16_t* qp = Qg + (size_t)(qw + r32) * rsq + 8 * hi;
#pragma unroll
      for (int d0 = 0; d0 < ND0; ++d0) qf[d0] = *(const bf16x8*)(qp + 16 * d0); }
    if (MODE != 0) { ATT_LOADK(t_lo, kA, rA); ATT_LOADK(t_lo + 1, kB, rB); }
    LAS float* aux = (LAS float*)(lds + L_AUX);
    if (MODE == 0) {
        LAS float* tot = (LAS float*)(lds + L_SCR);
        const float* lf = (const float*)(P.ws + OFF_LOGF) + (size_t)bh * SEQ + tid * 8; float v[8]; float run = 0.f;
        { const f32x4 a = *(const f32x4*)lf, c = *(const f32x4*)(lf + 4); v[0] = a[0]; v[1] = a[1]; v[2] = a[2]; v[3] = a[3]; v[4] = c[0]; v[5] = c[1]; v[6] = c[2]; v[7] = c[3]; }
#pragma unroll
        for (int i = 0; i < 8; ++i) { run += v[i]; v[i] = run; }
        tot[tid] = run; __syncthreads();
        if (tid < 64) { float a[8]; float acc = 0.f;
#pragma unroll
            for (int i = 0; i < 8; ++i) { acc += tot[tid * 8 + i]; a[i] = acc; }
            float incl = acc;
#pragma unroll
            for (int o = 1; o < 64; o <<= 1) { const float nb = shup(incl, o); if (tid >= o) incl += nb; }
            const float ex = incl - acc; tot[tid * 8] = ex;
#pragma unroll
            for (int i = 1; i < 8; ++i) tot[tid * 8 + i] = ex + a[i - 1]; }
        __syncthreads();
        const float base = tot[tid];
#pragma unroll
        for (int i = 0; i < 8; ++i) aux[tid * 8 + i] = -(base + v[i]);
        if (tid < 4) ((LAS unsigned*)(lds + L_KR + 3072))[tid] = 0u;
    } else if (MODE == 1) {
        const float* lut = (const float*)(P.ws + OFF_LUT) + (size_t)h * 4096;
        for (int i = ((4095 - (q0 + 255)) & ~3) + 4 * tid; i < 4160; i += 4 * NTHREADS) {
            f32x4 v = (f32x4){0.f, 0.f, 0.f, 0.f}; if (i < 4096) { const f32x4 s = *(const f32x4*)(lut + 4092 - i); v = (f32x4){s[3], s[2], s[1], s[0]}; }
            *(LAS f32x4*)(aux + i) = v; }
        if (tid < 64) aux[4160 + tid] = -INFINITY;
        LAS float* kms = (LAS float*)(lds + L_KMS); const float* km = (const float*)(P.ws + OFF_KMEAN) + (size_t)bh * 1024;
        for (int i = tid; i < 1024; i += NTHREADS) kms[i] = km[i];
    } else if (MODE == 3) {
        const float* lut = (const float*)(P.ws + OFF_LUT) + (size_t)(4 + h) * 4096;
        if (tid < 320) { const int rel = 255 - tid; aux[tid] = (rel >= 0 && rel * dil < 4096) ? lut[rel * dil] : 0.f; }
    }
    if (MODE == 0 && fast) {
        __syncthreads();
        const float bnd = ((const float*)(P.ws + OFF_BOUND))[l * 4 + (tid >> 30)];
        const bool sk = (lane <= t_hi) && ((aux[64 * lane + 63] - aux[q0]) + bnd < -150.0f);
        t_lo = (int)__builtin_popcountll(__ballot(sk));
    }
    __syncthreads();
    bf16x8 qx = {0, 0, 0, 0, 0, 0, 0, 0}; float auxU = 0.f;
    if (MODE == 0) { auxU = aux[q0 + 255]; const float sh = auxU - aux[qw + r32];
        if (hi == 0) { u32x4 w; w.x = 0x3F803F80u; w.y = cvt2(sh, 0.f); w.z = 0u; w.w = 0u; qx = __builtin_bit_cast(bf16x8, w); } }
    unsigned sel = 0;
    if (MODE == 1) {
        const LAS float* kms = (const LAS float*)(lds + L_KMS); float gt[15];
#pragma unroll
        for (int n = 0; n < 15; ++n) { float s = 0.f;
            if (n < qb) {
#pragma unroll
                for (int d0 = 0; d0 < 4; ++d0) { const f32x4 ka = *(const LAS f32x4*)(kms + n * 64 + 16 * d0 + 8 * hi), kb = *(const LAS f32x4*)(kms + n * 64 + 16 * d0 + 8 * hi + 4);
                    const u32x4 w = __builtin_bit_cast(u32x4, qf[d0]);
                    s += bflo(w.x) * ka[0] + bfhi(w.x) * ka[1] + bflo(w.y) * ka[2] + bfhi(w.y) * ka[3] + bflo(w.z) * kb[0] + bfhi(w.z) * kb[1] + bflo(w.w) * kb[2] + bfhi(w.w) * kb[3]; }
                s = swap_sum(s); }
            gt[n] = s; }
#pragma unroll
        for (int k = 0; k < 3; ++k) { float best = NEGBIG; int bi = -1;
#pragma unroll
            for (int n = 0; n < 15; ++n) if (n < qb && !((sel >> n) & 1u) && gt[n] > best) { best = gt[n]; bi = n; }
            if (bi >= 0) sel |= 1u << bi; }
        sel |= 1u << qb;
    }
    const int kfo = L_KB + r32 * 144 + hi * 16, rfo = L_KR + r32 * 80 + hi * 16;
    const int vfo = L_VB + ((lane >> 4) & 1) * 32 + (lane & 3) * 8 + (4 * hi + ((lane & 15) >> 2)) * 64;

    f32x16 o0, o1;
#pragma unroll
    for (int r = 0; r < 16; ++r) { o0[r] = 0.f; o1[r] = 0.f; }
    float m = fast ? 0.f : NEGBIG, lsum = 0.f;

    auto anysel = [&](int j) -> bool { return MODE != 1 || __any((sel >> (j >> 2)) & 1u); };
    auto is_full = [&](int j) -> bool {
        bool f = fast && (64 * j + 63 <= qw) && anysel(j);
        if (MODE == 3) f = f && (64 * j >= qw + 31 - 128);
        return f; };
    auto stage_a = [&](int j, int ks, int kb, f32x16& p) {
        if (MODE == 1 || MODE == 3) { const LAS float* lp = aux + ((MODE == 1 ? 4095 : 255) - (qw + r32 - 64 * j - 4 * hi));
            if (MODE == 1) lp = ((sel >> (j >> 2)) & 1u) ? lp : aux + 4160;
#pragma unroll
            for (int r = 0; r < 16; ++r) p[r] = lp[crow(r) + 32 * kb];
        } else {
#pragma unroll
            for (int r = 0; r < 16; ++r) p[r] = 0.f;
        }
        const LAS char* kb_ = lds + ks * KSLOT + kb * (32 * 144) + kfo;
#pragma unroll
        for (int d0 = 0; d0 < 4; ++d0) p = MFMA32(*(const LAS bf16x8*)(kb_ + d0 * 32), qf[d0], p);
        if (MODE == 2) { const LAS char* rb_ = lds + ks * RSLOT + kb * (32 * 80) + rfo;
#pragma unroll
            for (int d0 = 0; d0 < 2; ++d0) p = MFMA32(*(const LAS bf16x8*)(rb_ + d0 * 32), qf[4 + d0], p); }
        if (MODE == 0) p = MFMA32(*(const LAS bf16x8*)(lds + (hi ? (L_KR + 3072) : (L_KR + ks * 1024 + kb * 512 + r32 * 16))), qx, p);
    };
    auto stage_b = [&](int j, f32x16& p, u32x4& wa, u32x4& wb) {
#pragma unroll
        for (int r = 0; r < 16; ++r) { p[r] = __builtin_amdgcn_exp2f(p[r]); lsum += p[r]; }
        wa.x = cvt2(p[0], p[1]); wa.y = cvt2(p[2], p[3]); wa.z = cvt2(p[4], p[5]); wa.w = cvt2(p[6], p[7]);
        wb.x = cvt2(p[8], p[9]); wb.y = cvt2(p[10], p[11]); wb.z = cvt2(p[12], p[13]); wb.w = cvt2(p[14], p[15]);
        asm volatile("" : "+v"(lsum));
    };
    auto stage_c = [&](int vs, int kb, const u32x4& wa, const u32x4& wb) {
        const LAS char* vb_ = lds + vs * 8192 + vfo + kb * 2048;
        { const s16x4 a0 = vtr(vb_), a1 = vtr(vb_ + 512), c0 = vtr(vb_ + 4096), c1 = vtr(vb_ + 4096 + 512);
          o0 = MFMA32(__builtin_shufflevector(a0, a1, 0, 1, 2, 3, 4, 5, 6, 7), __builtin_bit_cast(bf16x8, wa), o0); o1 = MFMA32(__builtin_shufflevector(c0, c1, 0, 1, 2, 3, 4, 5, 6, 7), __builtin_bit_cast(bf16x8, wa), o1); }
        { const s16x4 a0 = vtr(vb_ + 1024), a1 = vtr(vb_ + 1024 + 512), c0 = vtr(vb_ + 4096 + 1024), c1 = vtr(vb_ + 4096 + 1024 + 512);
          o0 = MFMA32(__builtin_shufflevector(a0, a1, 0, 1, 2, 3, 4, 5, 6, 7), __builtin_bit_cast(bf16x8, wb), o0); o1 = MFMA32(__builtin_shufflevector(c0, c1, 0, 1, 2, 3, 4, 5, 6, 7), __builtin_bit_cast(bf16x8, wb), o1); }
    };
    auto general = [&](int t, int ks, int vs) {
        const int k0 = t * 64; const bool selected = MODE != 1 || ((sel >> (t >> 2)) & 1u); const bool asel = anysel(t);
        int dl = qw + r32 - k0 - 4 * hi; asm volatile("" : "+v"(dl));
#pragma unroll
        for (int kb = 0; kb < 2; ++kb) {
            const int kh = k0 + 32 * kb;
            bool act = kh <= qw + 31 && asel, need_mask = kh + 31 > qw;
            if (MODE == 3) { act = act && (kh + 31 >= qw - 128); need_mask = need_mask || (kh < qw + 31 - 128); }
            if (!act) continue;
            f32x16 p;
            if (MODE == 1 || MODE == 3) { const LAS float* lp = aux + ((MODE == 1 ? 4095 : 255) - dl);
#pragma unroll
                for (int r = 0; r < 16; ++r) p[r] = lp[crow(r) + 32 * kb];
            } else {
#pragma unroll
                for (int r = 0; r < 16; ++r) p[r] = 0.f;
            }
            const LAS char* kb_ = lds + ks * KSLOT + kb * (32 * 144) + kfo;
#pragma unroll
            for (int d0 = 0; d0 < 4; ++d0) p = MFMA32(*(const LAS bf16x8*)(kb_ + d0 * 32), qf[d0], p);
            if (MODE == 2) { const LAS char* rb_ = lds + ks * RSLOT + kb * (32 * 80) + rfo;
#pragma unroll
                for (int d0 = 0; d0 < 2; ++d0) p = MFMA32(*(const LAS bf16x8*)(rb_ + d0 * 32), qf[4 + d0], p); }
            if (MODE == 0) p = MFMA32(*(const LAS bf16x8*)(lds + (hi ? (L_KR + 3072) : (L_KR + ks * 1024 + kb * 512 + r32 * 16))), qx, p);
            if (need_mask) {
#pragma unroll
                for (int r = 0; r < 16; ++r) { const int rel = dl - crow(r) - 32 * kb; const bool v = MODE == 3 ? ((unsigned)rel <= 128u) : (rel >= 0); p[r] = v ? p[r] : -INFINITY; }
            }
            float ps = 0.f;
            if (fast) {
#pragma unroll
                for (int r = 0; r < 16; ++r) { p[r] = __builtin_amdgcn_exp2f(p[r]); ps += p[r]; }
            } else {
                float mx = fmaxf(p[0], p[1]);
#pragma unroll
                for (int r = 2; r < 16; ++r) mx = fmaxf(mx, p[r]);
                mx = swap_max(mx);
                if (MODE == 1) mx = selected ? mx : NEGBIG;
                if (__any(mx > m + THR)) {
                    const float mn = fmaxf(m, mx), alpha = __builtin_amdgcn_exp2f(m - mn); m = mn; lsum *= alpha;
#pragma unroll
                    for (int r = 0; r < 16; ++r) { o0[r] *= alpha; o1[r] *= alpha; }
                }
#pragma unroll
                for (int r = 0; r < 16; ++r) { p[r] = __builtin_amdgcn_exp2f(p[r] - m); ps += p[r]; }
            }
            u32x4 w0, w1;
            w0.x = cvt2(p[0], p[1]); w0.y = cvt2(p[2], p[3]); w0.z = cvt2(p[4], p[5]); w0.w = cvt2(p[6], p[7]);
            w1.x = cvt2(p[8], p[9]); w1.y = cvt2(p[10], p[11]); w1.z = cvt2(p[12], p[13]); w1.w = cvt2(p[14], p[15]);
            if (MODE == 1) { const unsigned mk = selected ? 0xffffffffu : 0u; ps = selected ? ps : 0.f; w0 = w0 & mk; w1 = w1 & mk; }
            lsum += ps;
            const bf16x8 pb0 = __builtin_bit_cast(bf16x8, w0), pb1 = __builtin_bit_cast(bf16x8, w1);
            const LAS char* vb_ = lds + vs * 8192 + vfo + kb * 2048;
            { const s16x4 a0 = vtr(vb_), a1 = vtr(vb_ + 512), c0 = vtr(vb_ + 4096), c1 = vtr(vb_ + 4096 + 512);
              o0 = MFMA32(__builtin_shufflevector(a0, a1, 0, 1, 2, 3, 4, 5, 6, 7), pb0, o0); o1 = MFMA32(__builtin_shufflevector(c0, c1, 0, 1, 2, 3, 4, 5, 6, 7), pb0, o1); }
            { const s16x4 a0 = vtr(vb_ + 1024), a1 = vtr(vb_ + 1024 + 512), c0 = vtr(vb_ + 4096 + 1024), c1 = vtr(vb_ + 4096 + 1024 + 512);
              o0 = MFMA32(__builtin_shufflevector(a0, a1, 0, 1, 2, 3, 4, 5, 6, 7), pb1, o0); o1 = MFMA32(__builtin_shufflevector(c0, c1, 0, 1, 2, 3, 4, 5, 6, 7), pb1, o1); }
        }
    };

    if (MODE == 0) { ATT_LOADK(t_lo, kA, rA); ATT_LOADK(t_lo + 1, kB, rB); }
    ATT_DMAV(t_lo, 0); ATT_DMAV(t_lo + 1, 1);
    ATT_WRITEK(0, t_lo, kA, rA); ATT_WRITEK(1, t_lo + 1, kB, rB);
    __syncthreads();
    ATT_LOADK(t_lo + 2, kA, rA);
    int ks0 = 0, ks1 = 1, ks2 = 2, vs = 0;
    bool pend = is_full(t_lo);
    f32x16 sa0, sa1, sb0, sb1;
    if (pend) { stage_a(t_lo, 0, 0, sa0); stage_a(t_lo, 0, 1, sa1); }
    auto advance = [&](const int t) {
        ATT_WRITEK(ks2, t + 2, kA, rA);
        __syncthreads();
        ATT_DMAV(t + 2, vs); ATT_LOADK(t + 3, kA, rA);
        { const int tmp = ks0; ks0 = ks1; ks1 = ks2; ks2 = tmp; } vs ^= 1;
    };
    auto steady = [&](const int t, f32x16& c0, f32x16& c1, f32x16& n0, f32x16& n1) {
        u32x4 wa, wb, wc, wd;
        stage_a(t + 1, ks1, 0, n0); stage_b(t, c0, wa, wb); __builtin_amdgcn_sched_barrier(0);
        stage_a(t + 1, ks1, 1, n1); stage_c(vs, 0, wa, wb); stage_b(t, c1, wc, wd); __builtin_amdgcn_sched_barrier(0);
        stage_c(vs, 1, wc, wd);
        advance(t);
    };
    int t = t_lo;
    while (t <= t_hi) {
        if (pend) while (t + 2 <= t_hi && is_full(t + 1) && is_full(t + 2)) { steady(t, sa0, sa1, sb0, sb1); steady(t + 1, sb0, sb1, sa0, sa1); t += 2; }
        const bool nxt = (t + 1 <= t_hi) && is_full(t + 1);
        if (pend) { u32x4 wa, wb; stage_b(t, sa0, wa, wb); stage_c(vs, 0, wa, wb); stage_b(t, sa1, wa, wb); stage_c(vs, 1, wa, wb); } else general(t, ks0, vs);
        if (nxt) { stage_a(t + 1, ks1, 0, sa0); stage_a(t + 1, ks1, 1, sa1); }
        pend = nxt;
        advance(t);
        ++t;
    }
#undef ATT_LOADK
#undef ATT_DMAV
#undef ATT_WRITEK
    const int te_ = ltid(), r32e = te_ & 31, hie = (te_ >> 5) & 1, qwe = q0 + 32 * (te_ >> 6);
    const float ltot = swap_sum(lsum), inv = 1.0f / ltot;
    if (MODE != 3) {
        const size_t tok = (size_t)b * SEQ + qwe + r32e; const int colbase = (MODE == 0 ? 0 : (MODE == 1 ? 256 : 768)) + h * 64 + 4 * hie;
        const bf16_t* G = (const bf16_t*)((const char*)P.out + OOFF_G) + tok * DM + colbase; bf16_t* A2 = (bf16_t*)(P.ws + OFF_A2) + tok * DM + colbase;
#pragma unroll
        for (int g = 0; g < 4; ++g) {
            const u32x2 g0 = *(const u32x2*)(G + 8 * g), g1 = *(const u32x2*)(G + 32 + 8 * g); u32x2 w0, w1;
            w0.x = cvt2(o0[4 * g] * inv * bflo(g0.x), o0[4 * g + 1] * inv * bfhi(g0.x)); w0.y = cvt2(o0[4 * g + 2] * inv * bflo(g0.y), o0[4 * g + 3] * inv * bfhi(g0.y));
            w1.x = cvt2(o1[4 * g] * inv * bflo(g1.x), o1[4 * g + 1] * inv * bfhi(g1.x)); w1.y = cvt2(o1[4 * g + 2] * inv * bflo(g1.y), o1[4 * g + 3] * inv * bfhi(g1.y));
            *(u32x2*)(A2 + 8 * g) = w0; *(u32x2*)(A2 + 32 + 8 * g) = w1; }
    } else {
        const size_t tok = (size_t)b * SEQ + (size_t)(qwe + r32e) * dil + res;
        bf16_t* dp = (bf16_t*)(P.ws + OFF_DPART) + ((size_t)pat * NT + tok) * 256 + h * 64 + 4 * hie;
#pragma unroll
        for (int g = 0; g < 4; ++g) { u32x2 w0, w1;
            w0.x = cvt2(o0[4 * g] * inv, o0[4 * g + 1] * inv); w0.y = cvt2(o0[4 * g + 2] * inv, o0[4 * g + 3] * inv);
            w1.x = cvt2(o1[4 * g] * inv, o1[4 * g + 1] * inv); w1.y = cvt2(o1[4 * g + 2] * inv, o1[4 * g + 3] * inv);
            *(u32x2*)(dp + 8 * g) = w0; *(u32x2*)(dp + 32 + 8 * g) = w1; }
        if (hie == 0) ((float*)(P.ws + OFF_DLSE))[((size_t)pat * NT + tok) * 4 + h] = m + __builtin_amdgcn_logf(ltot);
    }
}

DEVINL void dil_unit(const Params& P, int l, int u, char* smem) {
    LAS char* lds = (LAS char*)smem;
    const int tid = ltid(), lane = tid & 63, r32 = lane & 31, hi = lane >> 5; const int wid = __builtin_amdgcn_readfirstlane(tid >> 6);
    const int pat = u >> 8, v = u & 255, bh = v & 15, w = v >> 4, dil = pat == 0 ? 1 : (pat == 1 ? 4 : 16), res = w % dil, q0 = (w / dil) * 256;
    const int t_lo = (q0 >= 128 ? q0 - 128 : 0) >> 6, t_hi = (q0 + 255) >> 6, nt = t_hi - t_lo + 1;
    const int b = bh >> 2, h = bh & 3, rs = 64 * dil;
    const bf16_t* Qg = (const bf16_t*)(P.ws + OFF_QKV + 6 * SZ_HEADBUF) + ((size_t)bh * SEQ + res) * 64; const bf16_t* Kg = Qg + SZ_HEADBUF / 2; const bf16_t* Vg = Kg + SZ_HEADBUF / 2;
    const int qw = q0 + 32 * wid;
    constexpr int D_KB = 0, D_VB = 6 * KSLOT, D_AUX = D_VB + 6 * 8192;
    LAS float* aux = (LAS float*)(lds + D_AUX);
    __syncthreads();
    const unsigned kgo = (unsigned)((tid >> 3) * rs + (tid & 7) * 8), vgo = (unsigned)(((tid >> 2) & 63) * rs + (tid >> 8) * 32 + (tid & 3) * 8);
    u32x4 kr[6], vr[6];
#pragma unroll
    for (int j = 0; j < 6; ++j) if (j < nt) { kr[j] = *(const u32x4*)(Kg + (size_t)(t_lo + j) * 64 * rs + kgo); vr[j] = *(const u32x4*)(Vg + (size_t)(t_lo + j) * 64 * rs + vgo); }
    bf16x8 qf[4];
    { const bf16_t* qp = Qg + (size_t)(qw + r32) * rs + 8 * hi;
#pragma unroll
      for (int d0 = 0; d0 < 4; ++d0) qf[d0] = *(const bf16x8*)(qp + 16 * d0); }
    { const float* lut = (const float*)(P.ws + OFF_LUT) + (size_t)(4 + h) * 4096;
      if (tid < 320) { const int rel = 255 - tid; aux[tid] = (rel >= 0 && rel * dil < 4096) ? lut[rel * dil] : 0.f; } }
    { const int kws = (tid >> 3) * 144 + (tid & 7) * 16;
#pragma unroll
      for (int j = 0; j < 6; ++j) if (j < nt) { *(LAS u32x4*)(lds + D_KB + j * KSLOT + kws) = kr[j]; *(LAS u32x4*)(lds + D_VB + j * 8192 + tid * 16) = vr[j]; } }
    __syncthreads();
    const int kfo = D_KB + r32 * 144 + hi * 16;
    const int vfo = D_VB + ((lane >> 4) & 1) * 32 + (lane & 3) * 8 + (4 * hi + ((lane & 15) >> 2)) * 64;
    f32x16 o0, o1;
#pragma unroll
    for (int r = 0; r < 16; ++r) { o0[r] = 0.f; o1[r] = 0.f; }
    float lsum = 0.f;
    const int hb_hi = qw >> 5, hb_lo = hb_hi >= 4 ? hb_hi - 4 : 0;
    for (int hb = hb_lo; hb <= hb_hi; ++hb) {
        const int kh = hb * 32, jl = (hb >> 1) - t_lo, kb = hb & 1;
        const bool need_mask = (hb == hb_hi) || (kh < qw + 31 - 128);
        const int dl = qw + r32 - kh - 4 * hi;
        f32x16 p;
        { const LAS float* lp = aux + (255 - dl);
#pragma unroll
          for (int r = 0; r < 16; ++r) p[r] = lp[crow(r)]; }
        const LAS char* kb_ = lds + jl * KSLOT + kb * (32 * 144) + kfo;
#pragma unroll
        for (int d0 = 0; d0 < 4; ++d0) p = MFMA32(*(const LAS bf16x8*)(kb_ + d0 * 32), qf[d0], p);
        if (need_mask) {
#pragma unroll
            for (int r = 0; r < 16; ++r) { const int rel = dl - crow(r); p[r] = ((unsigned)rel <= 128u) ? p[r] : -INFINITY; }
        }
        float ps = 0.f;
#pragma unroll
        for (int r = 0; r < 16; ++r) { p[r] = __builtin_amdgcn_exp2f(p[r]); ps += p[r]; }
        lsum += ps;
        u32x4 w0, w1;
        w0.x = cvt2(p[0], p[1]); w0.y = cvt2(p[2], p[3]); w0.z = cvt2(p[4], p[5]); w0.w = cvt2(p[6], p[7]);
        w1.x = cvt2(p[8], p[9]); w1.y = cvt2(p[10], p[11]); w1.z = cvt2(p[12], p[13]); w1.w = cvt2(p[14], p[15]);
        const LAS char* vb_ = lds + jl * 8192 + vfo + kb * 2048;
        { const s16x4 a0 = vtr(vb_), a1 = vtr(vb_ + 512), c0 = vtr(vb_ + 4096), c1 = vtr(vb_ + 4096 + 512);
          o0 = MFMA32(__builtin_shufflevector(a0, a1, 0, 1, 2, 3, 4, 5, 6, 7), __builtin_bit_cast(bf16x8, w0), o0); o1 = MFMA32(__builtin_shufflevector(c0, c1, 0, 1, 2, 3, 4, 5, 6, 7), __builtin_bit_cast(bf16x8, w0), o1); }
        { const s16x4 a0 = vtr(vb_ + 1024), a1 = vtr(vb_ + 1024 + 512), c0 = vtr(vb_ + 4096 + 1024), c1 = vtr(vb_ + 4096 + 1024 + 512);
          o0 = MFMA32(__builtin_shufflevector(a0, a1, 0, 1, 2, 3, 4, 5, 6, 7), __builtin_bit_cast(bf16x8, w1), o0); o1 = MFMA32(__builtin_shufflevector(c0, c1, 0, 1, 2, 3, 4, 5, 6, 7), __builtin_bit_cast(bf16x8, w1), o1); }
    }
    const float ltot = swap_sum(lsum), inv = 1.0f / ltot;
    const size_t tok = (size_t)b * SEQ + (size_t)(qw + r32) * dil + res;
    bf16_t* dp = (bf16_t*)(P.ws + OFF_DPART) + ((size_t)pat * NT + tok) * 256 + h * 64 + 4 * hi;
#pragma unroll
    for (int g = 0; g < 4; ++g) { u32x2 w0, w1;
        w0.x = cvt2(o0[4 * g] * inv, o0[4 * g + 1] * inv); w0.y = cvt2(o0[4 * g + 2] * inv, o0[4 * g + 3] * inv);
        w1.x = cvt2(o1[4 * g] * inv, o1[4 * g + 1] * inv); w1.y = cvt2(o1[4 * g + 2] * inv, o1[4 * g + 3] * inv);
        *(u32x2*)(dp + 8 * g) = w0; *(u32x2*)(dp + 32 + 8 * g) = w1; }
    if (hi == 0) ((float*)(P.ws + OFF_DLSE))[((size_t)pat * NT + tok) * 4 + h] = __builtin_amdgcn_logf(ltot);
}

DEVINL void dilmix_unit(const Params& P, int u) {
    const int e = u * NTHREADS + ltid(), tok = e >> 5, hd = e & 31, h = hd >> 3, d8 = (hd & 7) * 8;
    const float* ls = (const float*)(P.ws + OFF_DLSE); const bf16_t* dp = (const bf16_t*)(P.ws + OFF_DPART);
    const float l0 = ls[(size_t)tok * 4 + h], l1 = ls[((size_t)NT + tok) * 4 + h], l2 = ls[((size_t)2 * NT + tok) * 4 + h];
    const float mx = fmaxf(l0, fmaxf(l1, l2)); float w0 = __builtin_amdgcn_exp2f(l0 - mx), w1 = __builtin_amdgcn_exp2f(l1 - mx), w2 = __builtin_amdgcn_exp2f(l2 - mx);
    const float inv = 1.0f / (w0 + w1 + w2); w0 *= inv; w1 *= inv; w2 *= inv;
    const size_t off = (size_t)tok * 256 + h * 64 + d8;
    const u32x4 a = *(const u32x4*)(dp + off), b = *(const u32x4*)(dp + (size_t)NT * 256 + off), c = *(const u32x4*)(dp + (size_t)2 * NT * 256 + off);
    const u32x4 g = *(const u32x4*)((const bf16_t*)((const char*)P.out + OOFF_G) + (size_t)tok * DM + 512 + h * 64 + d8);
    u32x4 r;
    r.x = cvt2((w0 * bflo(a.x) + w1 * bflo(b.x) + w2 * bflo(c.x)) * bflo(g.x), (w0 * bfhi(a.x) + w1 * bfhi(b.x) + w2 * bfhi(c.x)) * bfhi(g.x));
    r.y = cvt2((w0 * bflo(a.y) + w1 * bflo(b.y) + w2 * bflo(c.y)) * bflo(g.y), (w0 * bfhi(a.y) + w1 * bfhi(b.y) + w2 * bfhi(c.y)) * bfhi(g.y));
    r.z = cvt2((w0 * bflo(a.z) + w1 * bflo(b.z) + w2 * bflo(c.z)) * bflo(g.z), (w0 * bfhi(a.z) + w1 * bfhi(b.z) + w2 * bfhi(c.z)) * bfhi(g.z));
    r.w = cvt2((w0 * bflo(a.w) + w1 * bflo(b.w) + w2 * bflo(c.w)) * bflo(g.w), (w0 * bfhi(a.w) + w1 * bfhi(b.w) + w2 * bfhi(c.w)) * bfhi(g.w));
    *(u32x4*)((bf16_t*)(P.ws + OFF_A2) + (size_t)tok * DM + 512 + h * 64 + d8) = r;
}


#define XB_TMO      128
#define XB_XCNT(j)  (256  + 64 * (j))
#define XB_XSUB(j)  (1280 + 64 * (j))
#define XB_XGEN(j)  (2304 + 64 * (j))
#define XB_TOP      3328
#define XB_TOPGEN   3392
#define XCD_BAR_WORDS 3456
#define XB_SPIN_CAP (1u << 20)
DEVINL unsigned xb_ld(unsigned* p) { return __hip_atomic_load(p, __ATOMIC_RELAXED, __HIP_MEMORY_SCOPE_AGENT); }
DEVINL unsigned xb_add(unsigned* p, unsigned v) { return __hip_atomic_fetch_add(p, v, __ATOMIC_RELAXED, __HIP_MEMORY_SCOPE_AGENT); }
DEVINL unsigned xb_xcc_id() { return (unsigned)__builtin_amdgcn_s_getreg((3 << 11) | 20) & 0xFu; }
#define XB_SPIN(cond, bar) do { unsigned _sp = 0; while (cond) { __builtin_amdgcn_s_sleep(1); \
    if ((++_sp & 255u) == 0u) { if (xb_ld(&(bar)[XB_TMO])) break; if (_sp > XB_SPIN_CAP) { atomicAdd(&(bar)[XB_TMO], 1u); break; } } } } while (0)
DEVINL void xcd_barrier_post(unsigned* bar) { if (ltid() == 0) (void)xb_add(&bar[XB_XCNT(xb_xcc_id())], 1u); }
DEVINL void xcd_barrier_complete(unsigned* bar, unsigned x, unsigned& nloc, unsigned& nx) {
    const unsigned G = gridDim.x * gridDim.y * gridDim.z;
    unsigned sum, cnt, mine, sp = 0u;
    for (;;) {
        sum = 0u; cnt = 0u; mine = 0u;
        for (unsigned j = 0; j < 16; ++j) { const unsigned c = xb_ld(&bar[XB_XCNT(j)]); sum += c; cnt += (c > 0u) ? 1u : 0u; mine = (j == x) ? c : mine; }
        if (sum == G) break;
        __builtin_amdgcn_s_sleep(1);
        if ((++sp & 255u) == 0u) { if (xb_ld(&bar[XB_TMO])) break; if (sp > XB_SPIN_CAP) { atomicAdd(&bar[XB_TMO], 1u); break; } }
    }
    nloc = mine > 0u ? mine : 1u; nx = cnt > 0u ? cnt : 1u;
}
DEVINL void xcd_barrier(unsigned* bar_in, volatile LAS unsigned* st) {
    asm volatile("s_waitcnt vmcnt(0)" ::: "memory");
    __syncthreads();
    if (ltid() == 0) {
        unsigned* bar = bar_in;
        const unsigned x = xb_xcc_id();
        __builtin_amdgcn_s_waitcnt(0);
        unsigned nloc = st[0], nx = st[1];
        if (nloc == 0u) { xcd_barrier_complete(bar, x, nloc, nx); st[0] = nloc; st[1] = nx; }
        const unsigned old = xb_add(&bar[XB_XSUB(x)], 1u);
        const unsigned gen = old / nloc;
        if (old + 1u == (gen + 1u) * nloc) {
            __builtin_amdgcn_fence(__ATOMIC_RELEASE, "agent");
            asm volatile("s_waitcnt vmcnt(0)" ::: "memory");
            const unsigned og = xb_add(&bar[XB_TOP], 1u);
            const unsigned tg = og / nx;
            if (og + 1u == (tg + 1u) * nx) xb_add(&bar[XB_TOPGEN], 1u);
            else XB_SPIN(xb_ld(&bar[XB_TOPGEN]) == tg, bar);
            __builtin_amdgcn_fence(__ATOMIC_ACQUIRE, "agent");
            xb_add(&bar[XB_XGEN(x)], 1u);
            asm volatile("s_waitcnt vmcnt(0)" ::: "memory");
        } else {
            XB_SPIN(xb_ld(&bar[XB_XGEN(x)]) == gen, bar);
            __builtin_amdgcn_fence(__ATOMIC_ACQUIRE, "agent");
            asm volatile("s_waitcnt vmcnt(0)" ::: "memory");
        }
    }
    __syncthreads();
}


DEVINL int next_unit(unsigned* ctr, char* smem) {
    int* su = (int*)(smem + L_MISC);
    __syncthreads();
    if (ltid() == 0) *su = (int)atomicAdd(ctr, 1u);
    __syncthreads();
    return *su;
}

template <class Epi> DEVINL void gemm8_sub(const bf16_t* A, const bf16_t* Bt, int M, int N, int K, const Epi& E, char* smem, int G, int c) {
    asm volatile("" : "+s"(G), "+s"(c));
    pg8::Gemm g{A, Bt, M, N, K}; pg8::StaticOrder S; S.init(M, N, G, c);
    pg8::gemm_phase<Epi, pg8::StaticOrder, true, true>((PG8_LAS unsigned char*)smem, g, S, E);
}
DEVINL void phase_pre(const Params& P, int l, char* smem) {
    const int half = (int)gridDim.x >> 1, bid = (int)blockIdx.x;
    if (bid < half) gemm8_sub((const bf16_t*)(P.ws + OFF_CQ), (const bf16_t*)(P.ws + OFF_WT_UQ + l * SZ_WT_UQ), NT, 512, 256, EpiUq8{P, l}, smem, half, bid);
    else gemm8_sub((const bf16_t*)(P.ws + OFF_CKV), (const bf16_t*)(P.ws + OFF_WT_UKV + l * SZ_WT_UKV), NT, 512, 256, EpiUkv8{P, l}, smem, (int)gridDim.x - half, bid - half);
    for (int u = blockIdx.x; u < 256; u += gridDim.x) kmean_unit(P, u, smem);
}
DEVINL void phase_att(const Params& P, int l, char* smem, int rep) {
    unsigned* ctr = (unsigned*)(P.ws + OFF_CTR) + l * 2 + rep * 8;
    constexpr int N_ATT = 384 + 256 + 96 + 768 + 32; const int n_all = N_ATT + (l == 0 ? PREP_PER_LAYER + PREP_P_UNITS / 2 : 0);
    for (;;) { int u = next_unit(ctr, smem); if (u >= n_all) break;
        if (u >= N_ATT) { __syncthreads(); if (u - N_ATT < PREP_PER_LAYER) prep_w_unit(P, 1, u - N_ATT, (float*)smem); else prep_p_unit(P, PREP_P_UNITS / 2 + (u - N_ATT - PREP_PER_LAYER)); continue; }
        if (u >= 384 && u < 640) { attn_unit<0>(P, l, u - 384, smem); continue; }
        if (u >= 736 && u < 736 + 768) { if (((const float*)(P.ws + OFF_BOUND))[l * 4 + 3] < 100.0f) dil_unit(P, l, u - 736, smem); else attn_unit<3>(P, l, u - 736, smem); continue; }
        if (u >= 736 + 768) u -= 768; if (u >= 640) u -= 256;
        const int g = u >> 5, r = u & 31, uu = g * 16 + (r & 15);
        if (r < 16) attn_unit<2>(P, l, uu, smem); else attn_unit<1>(P, l, uu, smem); }
}

template <int PH> DEVINL void run_phase(int l, char* smem, int rep = 0) {
    asm volatile("" : "+s"(l));
    const __attribute__((address_space(4))) Params* kp = (const __attribute__((address_space(4))) Params*)__builtin_amdgcn_kernarg_segment_ptr(); asm volatile("" : "+s"(kp));
    Params P;
    P.x = (const float*)as_global(kp->x); P.p = (const float*)as_global(kp->p); P.ln_g = (const float*)as_global(kp->ln_g); P.w_in = (const float*)as_global(kp->w_in); P.b_forget = (const float*)as_global(kp->b_forget);
    P.qk_gain = (const float*)as_global(kp->qk_gain); P.mla_q_norm = (const float*)as_global(kp->mla_q_norm); P.mla_kv_norm = (const float*)as_global(kp->mla_kv_norm); P.mla_nope_gain = (const float*)as_global(kp->mla_nope_gain);
    P.mla_rope_gain = (const float*)as_global(kp->mla_rope_gain); P.w_uq = (const float*)as_global(kp->w_uq); P.w_ukv = (const float*)as_global(kp->w_ukv); P.w_out = (const float*)as_global(kp->w_out); P.rel_bias = (const float*)as_global(kp->rel_bias);
    P.ple_norm_g = (const float*)as_global(kp->ple_norm_g); P.w_ple_gate = (const float*)as_global(kp->w_ple_gate); P.w_ple_proj = (const float*)as_global(kp->w_ple_proj); P.out = (float*)as_global(kp->out); P.ws = as_global(kp->ws);
    char* ws = P.ws;
    const bf16_t* xbase = l == 0 ? (const bf16_t*)nullptr : (const bf16_t*)(ws + OFF_H);
    float* xout = l == 0 ? (float*)nullptr : P.out;
    if (PH == 0) phase_prep(P, smem);
    if (PH == 2) { gemm8((const bf16_t*)(ws + OFF_H), (const bf16_t*)(ws + OFF_WT_IN + l * SZ_WT_IN), NT, NP1, 1024, EpiIn8{P, l}, smem);
                   const int G_ = (int)gridDim.x, w0_ = G_ > 192 ? 192 : 0;
                   if (l == 0 && (int)blockIdx.x >= w0_) { __syncthreads(); constexpr int W0 = PREP_T_IN + PREP_T_UQ + PREP_T_UKV, NWL = PREP_PER_LAYER - W0;
                       for (int u = (int)blockIdx.x - w0_; u < NWL + PREP_P_UNITS / 2; u += G_ - w0_) { if (u < NWL) prep_w_unit(P, 0, W0 + u, (float*)smem); else prep_p_unit(P, u - NWL); } } }
    if (PH == 3) phase_pre(P, l, smem);
    if (PH == 4) phase_att(P, l, smem, rep);
    if (PH == 5) { for (int u = blockIdx.x; u < 1024; u += gridDim.x) dilmix_unit(P, u);
                 }
    if (PH == 8) gemm8((const bf16_t*)(ws + OFF_A2), (const bf16_t*)(ws + OFF_WT_OUT + l * SZ_WT_SQ), NT, 1024, 1024, EpiResid8{P.x, xbase, (bf16_t*)(ws + OFF_XABF), (float*)(ws + OFF_SSQA)}, smem);
    if (PH == 7) { gemm8((const bf16_t*)(ws + (l == 0 ? OFF_PB : OFF_PB2)), (const bf16_t*)(ws + OFF_WT_PP + l * SZ_WT_PP), NT, 1024, 256, EpiStoreBf{(bf16_t*)(ws + OFF_QKV)}, smem);
                   __syncthreads();
                   gemm8((const bf16_t*)(ws + OFF_XABF), (const bf16_t*)(ws + OFF_WT_PG + l * SZ_WT_SQ), NT, 1024, 1024, EpiPle8{(const bf16_t*)(ws + OFF_XABF), (const bf16_t*)(ws + OFF_QKV), xout, (const float*)(ws + OFF_SSQA), l == 0 ? (bf16_t*)(ws + OFF_H) : (bf16_t*)nullptr, (float*)(ws + OFF_SSQX)}, smem); }
}

__global__ void __launch_bounds__(NTHREADS) k_mega(Params Parg) {
    char* smem = g_smem;
    { const int t0 = (int)threadIdx.x; if (t0 < 12) ((LAS unsigned*)((LAS char*)smem + L_XB))[t0] = 0u;
      if ((t0 & 63) == 0) *(LAS int*)((LAS char*)smem + L_WTAB + 4u * (unsigned)__builtin_amdgcn_s_getreg(0x2804)) = t0 >> 6; }
    __syncthreads();
    const __attribute__((address_space(4))) Params* kp0 = (const __attribute__((address_space(4))) Params*)__builtin_amdgcn_kernarg_segment_ptr();
    xcd_barrier_post((unsigned*)(as_global(kp0->ws) + OFF_BAR));
#define XBAR() xcd_barrier((unsigned*)(as_global(kp0->ws) + OFF_BAR), (volatile LAS unsigned*)((LAS char*)smem + L_XB))
#ifdef PROBE_IDX
    unsigned long long tA = 0, tB = 0;
#define PT0(i) if (PROBE_IDX == (i)) tA = __builtin_amdgcn_s_memrealtime();
#define PT1(i) if (PROBE_IDX == (i)) tB = __builtin_amdgcn_s_memrealtime();
#else
#define PT0(i)
#define PT1(i)
#endif
    PT0(0) run_phase<0>(0, smem); XBAR(); PT1(0)
    PT0(2) run_phase<2>(0, smem); XBAR(); PT1(2) PT0(3) run_phase<3>(0, smem); XBAR(); PT1(3) PT0(4) run_phase<4>(0, smem); XBAR(); PT1(4)
    PT0(5) run_phase<5>(0, smem); XBAR(); PT1(5) PT0(6) run_phase<8>(0, smem); XBAR(); PT1(6) PT0(8) run_phase<7>(0, smem); XBAR(); PT1(8)
    run_phase<2>(1, smem); XBAR(); run_phase<3>(1, smem); XBAR(); run_phase<4>(1, smem); XBAR(); run_phase<5>(1, smem); XBAR(); run_phase<8>(1, smem); XBAR(); run_phase<7>(1, smem);
#ifdef PROBE_IDX
    if (blockIdx.x == 0) { const unsigned long long t0 = __builtin_amdgcn_s_memrealtime(), want = (tB - tA) * 32ull; while (__builtin_amdgcn_s_memrealtime() - t0 < want) __builtin_amdgcn_s_sleep(32); }
#endif
#undef XBAR
#ifdef PROBE_ATT
    if (blockIdx.x == PROBE_BLK) { __syncthreads(); const LAS unsigned* pa = (const LAS unsigned*)((LAS char*)smem + L_MISC + 32); const unsigned long long tk = pa[0], nt = pa[1] ? pa[1] : 1u;
        const unsigned long long t0 = __builtin_amdgcn_s_memrealtime(), want = tk * 2048ull / nt; while (__builtin_amdgcn_s_memrealtime() - t0 < want) __builtin_amdgcn_s_sleep(32); }
#endif
}
}

extern "C" void kernel_launch(void* const* d_in, const int* in_sizes, int n_in, void* d_out, int out_size, void* d_ws, size_t ws_size, hipStream_t stream) {
    Params P{};
    P.x = (const float*)d_in[0]; P.p = (const float*)d_in[1]; P.ln_g = (const float*)d_in[2]; P.w_in = (const float*)d_in[3]; P.b_forget = (const float*)d_in[4]; P.qk_gain = (const float*)d_in[5];
    P.mla_q_norm = (const float*)d_in[6]; P.mla_kv_norm = (const float*)d_in[7]; P.mla_nope_gain = (const float*)d_in[8]; P.mla_rope_gain = (const float*)d_in[9]; P.w_uq = (const float*)d_in[10];
    P.w_ukv = (const float*)d_in[11]; P.w_out = (const float*)d_in[12]; P.rel_bias = (const float*)d_in[13]; P.ple_norm_g = (const float*)d_in[14]; P.w_ple_gate = (const float*)d_in[15]; P.w_ple_proj = (const float*)d_in[16];
    P.out = (float*)d_out; P.ws = (char*)d_ws;
    if (ws_size < WS_NEED) { fprintf(stderr, "workspace too small: %zu < %zu\n", ws_size, (size_t)WS_NEED); return; }
    static int grid_blocks = 0;
    if (!grid_blocks) {
        int dev = 0, cus = 0, per_cu = 0;
        hipGetDevice(&dev);
        hipDeviceGetAttribute(&cus, hipDeviceAttributeMultiprocessorCount, dev);
        hipOccupancyMaxActiveBlocksPerMultiprocessor(&per_cu, k_mega, NTHREADS, 0);
        if (per_cu > 1) per_cu = 1;
        grid_blocks = cus * per_cu;
    }
    hipMemsetAsync((char*)d_ws + OFF_CTR, 0, 512 + 3456 * 4, stream);
    void* args[] = {&P};
    hipError_t e = hipLaunchCooperativeKernel((void*)k_mega, dim3(grid_blocks), dim3(NTHREADS), args, 0, stream);
    if (e != hipSuccess) fprintf(stderr, "cooperative launch failed: %s (grid %d)\n", hipGetErrorString(e), grid_blocks);
}
```

```cpp
#include <hip/hip_runtime.h>
#include <hip/hip_cooperative_groups.h>
#include <cstdint>
#include <cstdio>

#ifndef ONE_LAUNCH
#define ONE_LAUNCH 1
#endif

namespace {
#define DEVINL __device__ __forceinline__
typedef unsigned short bf16_t;
typedef short bf16x8 __attribute__((ext_vector_type(8)));
typedef float f32x4 __attribute__((ext_vector_type(4)));
typedef unsigned u32x2 __attribute__((ext_vector_type(2)));
typedef unsigned u32x4 __attribute__((ext_vector_type(4)));

constexpr int NB = 4, SEQ = 4096, DM = 1024, NT = NB * SEQ, NH = 4, NBH = NB * NH;
constexpr int INW = 3748, NP1 = 3840;
constexpr float EPS = 1e-6f, LOG2E = 1.4426950408889634f;
constexpr float SC_Q = 0.125f * LOG2E;
constexpr float SC_MLA = 0.10206207261596575f * LOG2E;
constexpr int NTHREADS = 512;

constexpr size_t SZ_WT_IN = (size_t)NP1 * 1024 * 2, SZ_WT_UQ = 512 * 256 * 2  , SZ_WT_UKV = 512 * 256 * 2  , SZ_WT_SQ = 1024 * 1024 * 2, SZ_WT_PP = 1024 * 256 * 2;
constexpr size_t OFF_WT_IN = 0;
constexpr size_t OFF_WT_UQ = OFF_WT_IN + 2 * SZ_WT_IN;
constexpr size_t OFF_WT_UKV = OFF_WT_UQ + 2 * SZ_WT_UQ;
constexpr size_t OFF_WT_OUT = OFF_WT_UKV + 2 * SZ_WT_UKV;
constexpr size_t OFF_WT_PG = OFF_WT_OUT + 2 * SZ_WT_SQ;
constexpr size_t OFF_WT_PP = OFF_WT_PG + 2 * SZ_WT_SQ;
constexpr size_t OFF_LUT = OFF_WT_PP + 2 * SZ_WT_PP;
constexpr size_t OFF_ROPE = OFF_LUT + 8 * 4096 * 4;
constexpr size_t OFF_H = OFF_ROPE + 4096 * 16 * 8;
constexpr size_t SZ_HEADBUF = (size_t)NT * 256 * 2;
constexpr size_t OFF_QKV = OFF_H + (size_t)NT * 1024 * 2;
constexpr size_t OFF_XABF = OFF_QKV + (size_t)NT * 1024 * 2;
constexpr size_t OFF_CQ = OFF_QKV + 9 * SZ_HEADBUF;
constexpr size_t OFF_CKV = OFF_CQ + (size_t)NT * 256 * 2;
constexpr size_t OFF_CQSS = OFF_CKV + (size_t)NT * 256 * 2;
constexpr size_t OFF_CKVSS = OFF_CQSS + (size_t)NT * 4 * 4;
constexpr size_t OFF_LOGF = OFF_CKVSS + (size_t)NT * 2 * 4;
constexpr size_t OFF_KMEAN = OFF_LOGF + (size_t)NBH * SEQ * 4;
constexpr size_t OFF_PB = OFF_KMEAN + (size_t)NBH * 16 * 64 * 4;
constexpr size_t OFF_X = OFF_PB + (size_t)NT * 256 * 2;
constexpr size_t OFF_A2 = OFF_X;
constexpr size_t OFF_PB2 = OFF_X + (size_t)NT * 1024 * 4;
constexpr size_t OFF_SSQX = OFF_PB2 + (size_t)NT * 256 * 2;
constexpr size_t OFF_SSQA = OFF_SSQX + (size_t)NT * 16 * 4;
constexpr size_t OFF_DPART = OFF_SSQA + (size_t)NT * 16 * 4;
constexpr size_t OFF_DLSE = OFF_DPART + 3 * (size_t)NT * 256 * 2;
constexpr size_t OFF_CTR = OFF_DLSE + 3 * (size_t)NT * 4 * 4;
constexpr size_t OFF_BOUND = OFF_CTR + 256;
constexpr size_t OFF_BAR = OFF_BOUND + 256;
constexpr size_t WS_NEED = OFF_BAR + 3456 * 4;
constexpr size_t OOFF_G = 0;
constexpr size_t OOFF_QM = (size_t)NT * 1024 * 2;
constexpr size_t OOFF_KM = OOFF_QM + (size_t)NBH * SEQ * 96 * 2;
constexpr size_t OOFF_VM = OOFF_KM + (size_t)NBH * SEQ * 96 * 2;

struct Params {
    const float *x, *p, *ln_g, *w_in, *b_forget, *qk_gain, *mla_q_norm, *mla_kv_norm, *mla_nope_gain, *mla_rope_gain, *w_uq, *w_ukv, *w_out, *rel_bias, *ple_norm_g, *w_ple_gate, *w_ple_proj;
    float* out;
    char* ws;
};

DEVINL char* as_global(const void* p) { __attribute__((address_space(1))) char* g; asm volatile("" : "=s"(g) : "0"(p)); return (char*)g; }
constexpr int L_MISC = 131072;
constexpr int L_XB = L_MISC + 16, L_WTAB = L_MISC + 64, SMEM_BYTES = L_MISC + 64 + 256;
__shared__ __attribute__((aligned(16))) char g_smem[SMEM_BYTES];
DEVINL int ltid() {
    const unsigned hw = (unsigned)__builtin_amdgcn_s_getreg(0x2804);
    const int w = __builtin_amdgcn_readfirstlane(*(const __attribute__((address_space(3))) int*)((__attribute__((address_space(3))) char*)g_smem + L_WTAB + hw * 4));
    int lane; asm volatile("v_mbcnt_lo_u32_b32 %0, -1, 0\n\tv_mbcnt_hi_u32_b32 %0, -1, %0" : "=v"(lane));
    return w * 64 + lane; }
DEVINL float shx(float v, int mask) { return __int_as_float(__builtin_amdgcn_ds_bpermute(((ltid() & 63) ^ mask) << 2, __float_as_int(v))); }
DEVINL float shup(float v, int o) { return __int_as_float(__builtin_amdgcn_ds_bpermute(((ltid() & 63) - o) << 2, __float_as_int(v))); }
DEVINL float sq4(const f32x4& a) { return a[0] * a[0] + a[1] * a[1] + a[2] * a[2] + a[3] * a[3]; }
template <int XM> DEVINL float swz_xor(float v) { return __int_as_float(__builtin_amdgcn_ds_swizzle(__float_as_int(v), (XM << 10) | 0x1F)); }
DEVINL float half_swap_sum(float v) { auto rr = __builtin_amdgcn_permlane32_swap(__float_as_uint(v), __float_as_uint(v), false, false); return __uint_as_float(rr[0]) + __uint_as_float(rr[1]); }
DEVINL float wave_sum(float v) { v += swz_xor<1>(v); v += swz_xor<2>(v); v += swz_xor<4>(v); v += swz_xor<8>(v); v += swz_xor<16>(v); return half_swap_sum(v); }
DEVINL bf16_t f2bf(float f) { unsigned u = __float_as_uint(f); u += 0x7fffu + ((u >> 16) & 1u); return (bf16_t)(u >> 16); }
DEVINL float bf2f(bf16_t h) { return __uint_as_float(((unsigned)h) << 16); }
DEVINL unsigned pack2(float a, float b) { return (unsigned)f2bf(a) | ((unsigned)f2bf(b) << 16); }
typedef __bf16 bf16v2 __attribute__((ext_vector_type(2)));
typedef float f32v2 __attribute__((ext_vector_type(2)));
DEVINL unsigned cvt2(float a, float b) { f32v2 v = {a, b}; return __builtin_bit_cast(unsigned, __builtin_convertvector(v, bf16v2)); }
DEVINL float bflo(unsigned u) { return __uint_as_float(u << 16); }
DEVINL float bfhi(unsigned u) { return __uint_as_float(u & 0xffff0000u); }

__device__ __constant__ float ROPE_INV[16] = {1.0f, 0.5623413251903491f, 0.31622776601683794f, 0.1778279410038923f, 0.1f, 0.05623413251903491f, 0.03162277660168379f, 0.01778279410038923f,
                                              0.01f, 0.005623413251903491f, 0.0031622776601683794f, 0.0017782794100389228f, 0.001f, 0.0005623413251903491f, 0.00031622776601683794f, 0.00017782794100389227f};

DEVINL int t5_bucket(int d) {
    if (d < 16) return d;
    int b = 16;
    b += (d >= 22); b += (d >= 30); b += (d >= 40); b += (d >= 54); b += (d >= 73); b += (d >= 99); b += (d >= 134); b += (d >= 182);
    b += (d >= 246); b += (d >= 332); b += (d >= 450); b += (d >= 609); b += (d >= 825); b += (d >= 1117); b += (d >= 1513);
    return b;
}

DEVINL int map_w_in(int n) { return n < 768 ? n : (n < 2720 ? n + 4 : (n < 2724 ? n - 2720 + 768 : (n < 2816 ? -1 : n - 92))); }
DEVINL int virt_col(int nv) { const int v = nv & 255; return (nv & ~255) + 64 * ((v >> 5) & 3) + 32 * (v >> 7) + (v & 31); }
DEVINL int map_w_in_virt(int nv) { int a = virt_col(nv); const int chunk = a >> 6; int hc = a & 63;
    if (chunk == 42 && hc < 32) hc = 16 * ((hc >> 2) & 1) + 4 * (hc >> 3) + (hc & 3);
    return map_w_in(chunk * 64 + hc); }
DEVINL int map_w_uq_virt(int nv) { const int a = virt_col(nv), chunk = a >> 6; int hc = a & 63; if (chunk >= 6) return -1;
    if (chunk >= 4) { const int e = hc & 31; hc = (hc & 32) + 16 * ((e >> 2) & 1) + 4 * (e >> 3) + (e & 3); }
    const int n = chunk * 64 + hc; if (n < 256) return (n >> 6) * 96 + (n & 63); const int r = n - 256; return (r >> 5) * 96 + 64 + (r & 31); }
DEVINL int map_w_uq(int n) { if (n < 256) return (n >> 6) * 96 + (n & 63); const int r = n - 256; return (r >> 5) * 96 + 64 + (r & 31); }

template <int KT>
DEVINL void transpose_tile(const float* src, int Nsrc, bf16_t* dst, int K, int tn, int tk, int mode, const float* fold, float* tile  ) {
    const int tid = ltid(), c4 = (tid & 15) * 4, kr = tid >> 4  , n0 = tn * 64, k0 = tk * KT;
    const int n = n0 + c4, oc = mode == 1 ? map_w_in_virt(n) : (mode == 2 ? map_w_uq(n) : (mode == 3 ? virt_col(n) : (mode == 4 ? map_w_uq_virt(n) : (mode == 5 ? virt_col(n) : n))));
    f32x4 v[KT / 32];
#pragma unroll
    for (int i = 0; i < KT / 32; ++i) { const int kk = kr + 32 * i; v[i] = (f32x4){0.f, 0.f, 0.f, 0.f}; if (oc >= 0 && !(mode == 5 && k0 + kk >= 128)) { v[i] = __builtin_nontemporal_load((const f32x4*)(src + (size_t)(k0 + kk) * Nsrc + oc)); if (fold) v[i] = v[i] * fold[k0 + kk]; } }
    __syncthreads();
#pragma unroll
    for (int i = 0; i < KT / 32; ++i) *(f32x4*)(tile + (kr + 32 * i) * 68 + c4) = v[i];
    __syncthreads();
#pragma unroll
    for (int h = 0; h < KT / 64; ++h) { const int nn = tid & 63, kc = h * 64 + (tid >> 6) * 8; const float* tp = tile + kc * 68 + nn; u32x4 w;
      w.x = cvt2(tp[0], tp[68]); w.y = cvt2(tp[136], tp[204]); w.z = cvt2(tp[272], tp[340]); w.w = cvt2(tp[408], tp[476]);
      *(u32x4*)(dst + (size_t)(n0 + nn) * K + k0 + kc) = w; }
}

constexpr int PREP_T_IN = 60 * 4, PREP_T_UQ = 8 * 1, PREP_T_UKV = 8 * 1, PREP_T_SQ = 16 * 4, PREP_T_PP = 16 * 1;
constexpr int PREP_PER_LAYER = PREP_T_IN + PREP_T_UQ + PREP_T_UKV + 2 * PREP_T_SQ + PREP_T_PP;
constexpr int PREP_LUT_UNITS = 8 * 4096 / 512, PREP_ROPE_UNITS = 4096 * 16 / 512;
constexpr int PREP_X_UNITS = NT / 32, PREP_P_UNITS = 2 * NT / 64;
constexpr int PREP_UNITS = 2 * PREP_PER_LAYER + PREP_LUT_UNITS + PREP_ROPE_UNITS + PREP_X_UNITS + PREP_P_UNITS;

DEVINL void prep_w_unit(const Params& P, int l, int r, float* tile) {
    if (r < PREP_T_IN) { transpose_tile<256>(P.w_in + (size_t)l * 1024 * INW, INW, (bf16_t*)(P.ws + OFF_WT_IN + l * SZ_WT_IN), 1024, r % 60, r / 60, 1, P.ln_g + l * DM, tile); return; }
    r -= PREP_T_IN;
    if (r < PREP_T_UQ) { transpose_tile<256>(P.w_uq + (size_t)l * 256 * 384, 384, (bf16_t*)(P.ws + OFF_WT_UQ + l * SZ_WT_UQ), 256, r % 8, r / 8, 4, P.mla_q_norm + l * 256, tile); return; }
    r -= PREP_T_UQ;
    if (r < PREP_T_UKV) { transpose_tile<256>(P.w_ukv + (size_t)l * 128 * 512, 512, (bf16_t*)(P.ws + OFF_WT_UKV + l * SZ_WT_UKV), 256, r % 8, r / 8, 5, P.mla_kv_norm + l * 128, tile); return; }
    r -= PREP_T_UKV;
    if (r < PREP_T_SQ) { transpose_tile<256>(P.w_out + (size_t)l * 1024 * 1024, 1024, (bf16_t*)(P.ws + OFF_WT_OUT + l * SZ_WT_SQ), 1024, r % 16, r / 16, 3, nullptr, tile); return; }
    r -= PREP_T_SQ;
    if (r < PREP_T_SQ) { transpose_tile<256>(P.w_ple_gate + (size_t)l * 1024 * 1024, 1024, (bf16_t*)(P.ws + OFF_WT_PG + l * SZ_WT_SQ), 1024, r % 16, r / 16, 3, P.ple_norm_g + l * DM, tile); return; }
    r -= PREP_T_SQ;
    transpose_tile<256>(P.w_ple_proj + (size_t)l * 256 * 1024, 1024, (bf16_t*)(P.ws + OFF_WT_PP + l * SZ_WT_PP), 256, r % 16, r / 16, 3, nullptr, tile);
}
DEVINL void prep_p_unit(const Params& P, int v) {
    const int wid = ltid() >> 6, lane = ltid() & 63; f32x4 a[8];
#pragma unroll
    for (int rr = 0; rr < 8; ++rr) a[rr] = __builtin_nontemporal_load((const f32x4*)(P.p + (size_t)(v * 64 + wid * 8 + rr) * 256 + lane * 4));
#pragma unroll
    for (int rr = 0; rr < 8; ++rr) { const int row = v * 64 + wid * 8 + rr; u32x2 w; w.x = cvt2(a[rr][0], a[rr][1]); w.y = cvt2(a[rr][2], a[rr][3]);
        bf16_t* pb = row < NT ? (bf16_t*)(P.ws + OFF_PB) + (size_t)row * 256 : (bf16_t*)(P.ws + OFF_PB2) + (size_t)(row - NT) * 256; *(u32x2*)(pb + lane * 4) = w; }
}
DEVINL void phase_prep(const Params& P, char* smem) {
    float* tile = (float*)smem;
    if (blockIdx.x == 0) {
        const int w_ = ltid() >> 6, ln_ = ltid() & 63, l = w_ >> 2, md = w_ & 3; float bound;
        auto amax = [&](const float* p, int n) { float a = 0.f; for (int i = ln_; i < n; i += 64) a = fmaxf(a, fabsf(p[i]));
            a = fmaxf(a, swz_xor<1>(a)); a = fmaxf(a, swz_xor<2>(a)); a = fmaxf(a, swz_xor<4>(a)); a = fmaxf(a, swz_xor<8>(a)); a = fmaxf(a, swz_xor<16>(a));
            auto rr = __builtin_amdgcn_permlane32_swap(__float_as_uint(a), __float_as_uint(a), false, false); return fmaxf(__uint_as_float(rr[0]), __uint_as_float(rr[1])); };
        if (md == 2) { const float nq = amax(P.mla_nope_gain + (l * 2 + 0) * 64, 64), nk = amax(P.mla_nope_gain + (l * 2 + 1) * 64, 64), rq = amax(P.mla_rope_gain + (l * 2 + 0) * 32, 32), rk = amax(P.mla_rope_gain + (l * 2 + 1) * 32, 32);
            bound = sqrtf(64.f * nq * nq + 32.f * rq * rq) * sqrtf(64.f * nk * nk + 32.f * rk * rk) * SC_MLA; }
        else { const int mix = md == 0 ? 0 : (md == 1 ? 1 : 2); bound = 64.f * amax(P.qk_gain + (l * 6 + 2 * mix) * 64, 64) * amax(P.qk_gain + (l * 6 + 2 * mix + 1) * 64, 64) * SC_Q;
            if (md == 0) bound += 8.f; else bound += amax(P.rel_bias, 256) * LOG2E; }
        if (ln_ == 0) ((float*)(P.ws + OFF_BOUND))[l * 4 + md] = bound;
    }
    constexpr int U_W = PREP_PER_LAYER, U_LUT = U_W + PREP_LUT_UNITS, U_ROPE = U_LUT + PREP_ROPE_UNITS, U_X = U_ROPE + PREP_X_UNITS, U_P = U_X + PREP_P_UNITS / 2;
    for (int u = blockIdx.x; u < U_P; u += gridDim.x) {
        if (u < U_W) { if (u < PREP_T_IN + PREP_T_UQ + PREP_T_UKV) prep_w_unit(P, 0, u, tile); }
        else if (u < U_LUT) { const int e = (u - U_W) * 512 + ltid(), hh = e >> 12, d = e & 4095; ((float*)(P.ws + OFF_LUT))[e] = P.rel_bias[t5_bucket(d) * 8 + hh] * LOG2E; }
        else if (u < U_ROPE) { const int e = (u - U_LUT) * 512 + ltid(), pos = e >> 4, i = e & 15;
            const double rev = (double)pos * (double)ROPE_INV[i] * 0.15915494309189535; const float fr = (float)(rev - floor(rev));
            ((float2*)(P.ws + OFF_ROPE))[e] = make_float2(__builtin_amdgcn_cosf(fr), __builtin_amdgcn_sinf(fr)); }
        else if (u < U_X) { const int v = u - U_ROPE, wid = ltid() >> 6, lane = ltid() & 63;
            f32x4 a[4][4];
#pragma unroll
            for (int rr = 0; rr < 4; ++rr)
#pragma unroll
                for (int i = 0; i < 4; ++i) a[rr][i] = __builtin_nontemporal_load((const f32x4*)(P.x + (size_t)(v * 32 + wid * 4 + rr) * DM + i * 256 + lane * 4));
#pragma unroll
            for (int rr = 0; rr < 4; ++rr) { const int row = v * 32 + wid * 4 + rr; float ss = 0.f;
#pragma unroll
                for (int i = 0; i < 4; ++i) { ss += sq4(a[rr][i]); u32x2 w; w.x = cvt2(a[rr][i][0], a[rr][i][1]); w.y = cvt2(a[rr][i][2], a[rr][i][3]); *(u32x2*)((bf16_t*)(P.ws + OFF_H) + (size_t)row * DM + i * 256 + lane * 4) = w; }
                ss = wave_sum(ss); if (lane < 16) ((float*)(P.ws + OFF_SSQX))[(size_t)row * 16 + lane] = lane == 0 ? ss : 0.f;
                if (lane < 16) *(u32x4*)((bf16_t*)(P.ws + OFF_CKV) + (size_t)row * 256 + 128 + lane * 8) = (u32x4){0u, 0u, 0u, 0u}; } }
        else {   }
    }
}

DEVINL void phase_rms(const float* src, const float* g, bf16_t* dst, const float* psrc, bf16_t* pb) {
    const int wid = ltid() >> 6, lane = ltid() & 63;
    for (int u = blockIdx.x; u < NT / 8; u += gridDim.x) {
        const int row = u * 8 + wid; const float* xr = src + (size_t)row * DM;
        f32x4 v[4]; float ss = 0.f;
#pragma unroll
        for (int i = 0; i < 4; ++i) { v[i] = *(const f32x4*)(xr + i * 256 + lane * 4); ss += v[i][0] * v[i][0] + v[i][1] * v[i][1] + v[i][2] * v[i][2] + v[i][3] * v[i][3]; }
        ss = wave_sum(ss); const float r = rsqrtf(ss * (1.0f / DM) + EPS);
#pragma unroll
        for (int i = 0; i < 4; ++i) { const f32x4 gg = *(const f32x4*)(g + i * 256 + lane * 4); u32x2 w; w.x = pack2(v[i][0] * r * gg[0], v[i][1] * r * gg[1]); w.y = pack2(v[i][2] * r * gg[2], v[i][3] * r * gg[3]);
            *(u32x2*)(dst + (size_t)row * DM + i * 256 + lane * 4) = w; }
        if (psrc) { const f32x4 pv = *(const f32x4*)(psrc + (size_t)row * 256 + lane * 4); u32x2 w; w.x = pack2(pv[0], pv[1]); w.y = pack2(pv[2], pv[3]); *(u32x2*)(pb + (size_t)row * 256 + lane * 4) = w; }
    }
}

constexpr int GST = 40;
template <class Epi>
DEVINL void gemm_phase(const bf16_t* A, const bf16_t* Bt, int M, int N, int K, const Epi& epi, char* smem) {
    bf16_t* As = (bf16_t*)smem; bf16_t* Bs = As + 256 * GST;
    const int tid = ltid(), wid = tid >> 6, lane = tid & 63, wr = wid >> 1, wc = wid & 1, fr = lane & 15, fq = lane >> 4;
    const int ntm = M / 256, ntn = N / 128, nk = K / 32;
    const int lr = tid >> 2, lc = (tid & 3) * 8;
    for (int tile = blockIdx.x; tile < ntm * ntn; tile += gridDim.x) {
        const int tm = tile % ntm, tn = tile / ntm;
        const bf16_t* Ag = A + (size_t)(tm * 256 + lr) * K + lc; const bf16_t* Bg = Bt + (size_t)(tn * 128 + lr) * K + lc;
        f32x4 acc[4][4];
#pragma unroll
        for (int m = 0; m < 4; ++m)
#pragma unroll
            for (int n = 0; n < 4; ++n) acc[m][n] = (f32x4){0.f, 0.f, 0.f, 0.f};
        u32x4 ra0 = *(const u32x4*)Ag, ra1 = *(const u32x4*)(Ag + (size_t)128 * K), rb0 = *(const u32x4*)Bg;
        for (int kt = 0; kt < nk; ++kt) {
            __syncthreads();
            *(u32x4*)(As + lr * GST + lc) = ra0; *(u32x4*)(As + (lr + 128) * GST + lc) = ra1; *(u32x4*)(Bs + lr * GST + lc) = rb0;
            __syncthreads();
            if (kt + 1 < nk) { const int ko = (kt + 1) * 32; ra0 = *(const u32x4*)(Ag + ko); ra1 = *(const u32x4*)(Ag + (size_t)128 * K + ko); rb0 = *(const u32x4*)(Bg + ko); }
            bf16x8 af[4], bfr[4];
#pragma unroll
            for (int m = 0; m < 4; ++m) af[m] = *(const bf16x8*)(As + (wr * 64 + m * 16 + fr) * GST + fq * 8);
#pragma unroll
            for (int n = 0; n < 4; ++n) bfr[n] = *(const bf16x8*)(Bs + (wc * 64 + n * 16 + fr) * GST + fq * 8);
#pragma unroll
            for (int m = 0; m < 4; ++m)
#pragma unroll
                for (int n = 0; n < 4; ++n) acc[m][n] = __builtin_amdgcn_mfma_f32_16x16x32_bf16(bfr[n], af[m], acc[m][n], 0, 0, 0);
        }
        epi(acc, tm * 256 + wr * 64, tn * 2 + wc, fr, fq);
    }
    __syncthreads();
}

DEVINL float quad_sum(float v) { v += swz_xor<16>(v); return half_swap_sum(v); }
DEVINL void store4bf(bf16_t* p, float a, float b, float c, float d) { u32x2 w; w.x = pack2(a, b); w.y = pack2(c, d); *(u32x2*)p = w; }
DEVINL float fsigmoid(float z) { return __builtin_amdgcn_rcpf(1.0f + __builtin_amdgcn_exp2f(-LOG2E * z)); }
DEVINL float log_sigmoid(float z) { return fminf(z, 0.f) - log1pf(__expf(-fabsf(z))); }

struct EpiIn {
    Params P; int l;
    DEVINL void operator()(f32x4 (&acc)[4][4], int row0, int chunk, int fr, int fq) const {
        char* ws = P.ws; char* ob = (char*)P.out;
        if (chunk < 36) {
            const int g = chunk >> 2, h = chunk & 3, role = g % 3, mix = g / 3;
            bf16_t* dst = (bf16_t*)(ws + OFF_QKV + (size_t)g * SZ_HEADBUF);
            const float* gain = P.qk_gain + ((size_t)l * 6 + 2 * mix + (role == 1 ? 1 : 0)) * 64;
#pragma unroll
            for (int m = 0; m < 4; ++m) {
                const int t = row0 + 16 * m + fr, b = t >> 12, s = t & 4095; bf16_t* d = dst + ((size_t)(b * 4 + h) * SEQ + s) * 64 + 4 * fq;
                float r = 1.f;
                if (role != 2) { float ss = 0.f;
#pragma unroll
                    for (int n = 0; n < 4; ++n) ss += acc[m][n][0] * acc[m][n][0] + acc[m][n][1] * acc[m][n][1] + acc[m][n][2] * acc[m][n][2] + acc[m][n][3] * acc[m][n][3];
                    ss = quad_sum(ss); r = rsqrtf(ss * (1.0f / 64.0f) + EPS) * (role == 0 ? SC_Q : 1.0f); }
#pragma unroll
                for (int n = 0; n < 4; ++n) { f32x4 gg = (f32x4){1.f, 1.f, 1.f, 1.f}; if (role != 2) gg = *(const f32x4*)(gain + 16 * n + 4 * fq);
                    store4bf(d + 16 * n, acc[m][n][0] * r * gg[0], acc[m][n][1] * r * gg[1], acc[m][n][2] * r * gg[2], acc[m][n][3] * r * gg[3]); }
            }
        } else if (chunk < 42) {
            const bool isq = chunk < 40; const int c = isq ? chunk - 36 : chunk - 40;
            bf16_t* dst = isq ? (bf16_t*)(ws + OFF_CQ) : (bf16_t*)(ws + OFF_CKV); const int ld = isq ? 256 : 128;
            float* ssp = isq ? (float*)(ws + OFF_CQSS) : (float*)(ws + OFF_CKVSS); const int nss = isq ? 4 : 2;
#pragma unroll
            for (int m = 0; m < 4; ++m) {
                const int t = row0 + 16 * m + fr; float ss = 0.f;
#pragma unroll
                for (int n = 0; n < 4; ++n) { ss += acc[m][n][0] * acc[m][n][0] + acc[m][n][1] * acc[m][n][1] + acc[m][n][2] * acc[m][n][2] + acc[m][n][3] * acc[m][n][3];
                    store4bf(dst + (size_t)t * ld + c * 64 + 16 * n + 4 * fq, acc[m][n][0], acc[m][n][1], acc[m][n][2], acc[m][n][3]); }
                ss = quad_sum(ss); if (fq == 0) ssp[(size_t)t * nss + c] = ss;
            }
        } else if (chunk == 42) {
            const float* gr = P.mla_rope_gain + ((size_t)l * 2 + 1) * 32; const float2* rope = (const float2*)(ws + OFF_ROPE);
            bf16_t* km = (bf16_t*)(ob + OOFF_KM); float* logf_ = (float*)(ws + OFF_LOGF);
            const f32x4 g1 = *(const f32x4*)(gr + 4 * fq), g2 = *(const f32x4*)(gr + 16 + 4 * fq); const f32x4 bfv = *(const f32x4*)(P.b_forget + l * 4);
#pragma unroll
            for (int m = 0; m < 4; ++m) {
                const int t = row0 + 16 * m + fr, b = t >> 12, s = t & 4095;
                float ss = 0.f;
#pragma unroll
                for (int n = 0; n < 2; ++n) ss += acc[m][n][0] * acc[m][n][0] + acc[m][n][1] * acc[m][n][1] + acc[m][n][2] * acc[m][n][2] + acc[m][n][3] * acc[m][n][3];
                ss = quad_sum(ss); const float r = rsqrtf(ss * (1.0f / 32.0f) + EPS);
                float o1[4], o2[4];
#pragma unroll
                for (int j = 0; j < 4; ++j) { const float2 cs = rope[s * 16 + 4 * fq + j]; const float x1 = acc[m][0][j] * r * g1[j], x2 = acc[m][1][j] * r * g2[j]; o1[j] = x1 * cs.x - x2 * cs.y; o2[j] = x1 * cs.y + x2 * cs.x; }
#pragma unroll
                for (int h = 0; h < 4; ++h) { bf16_t* d = km + ((size_t)(b * 4 + h) * SEQ + s) * 96 + 64 + 4 * fq; store4bf(d, o1[0], o1[1], o1[2], o1[3]); store4bf(d + 16, o2[0], o2[1], o2[2], o2[3]); }
                if (fq == 0) {
#pragma unroll
                    for (int j = 0; j < 4; ++j) logf_[(size_t)(b * 4 + j) * SEQ + s] = log_sigmoid(acc[m][2][j] + bfv[j]) * LOG2E;
                }
            }
        } else if (chunk >= 44) {
            bf16_t* G = (bf16_t*)(ob + OOFF_G); const int c0 = (chunk - 44) * 64;
#pragma unroll
            for (int m = 0; m < 4; ++m) { const int t = row0 + 16 * m + fr;
#pragma unroll
                for (int n = 0; n < 4; ++n) { float o[4];
#pragma unroll
                    for (int j = 0; j < 4; ++j) { const float z = acc[m][n][j]; o[j] = z / (1.0f + __expf(-z)); }
                    store4bf(G + (size_t)t * DM + c0 + 16 * n + 4 * fq, o[0], o[1], o[2], o[3]); } }
        }
    }
};

struct EpiUq {
    Params P; int l;
    DEVINL void operator()(f32x4 (&acc)[4][4], int row0, int chunk, int fr, int fq) const {
        const float* cqss = (const float*)(P.ws + OFF_CQSS); bf16_t* qm = (bf16_t*)((char*)P.out + OOFF_QM); const float2* rope = (const float2*)(P.ws + OFF_ROPE);
#pragma unroll
        for (int m = 0; m < 4; ++m) {
            const int t = row0 + 16 * m + fr, b = t >> 12, s = t & 4095; const f32x4 pss = *(const f32x4*)(cqss + (size_t)t * 4);
            const float rt = rsqrtf((pss[0] + pss[1] + pss[2] + pss[3]) * (1.0f / 256.0f) + EPS);
            if (chunk < 4) {
                const float* gain = P.mla_nope_gain + ((size_t)l * 2 + 0) * 64; float ss = 0.f;
#pragma unroll
                for (int n = 0; n < 4; ++n) { acc[m][n] = acc[m][n] * rt; ss += acc[m][n][0] * acc[m][n][0] + acc[m][n][1] * acc[m][n][1] + acc[m][n][2] * acc[m][n][2] + acc[m][n][3] * acc[m][n][3]; }
                ss = quad_sum(ss); const float r = rsqrtf(ss * (1.0f / 64.0f) + EPS) * SC_MLA; bf16_t* d = qm + ((size_t)(b * 4 + chunk) * SEQ + s) * 96 + 4 * fq;
#pragma unroll
                for (int n = 0; n < 4; ++n) { const f32x4 gg = *(const f32x4*)(gain + 16 * n + 4 * fq); store4bf(d + 16 * n, acc[m][n][0] * r * gg[0], acc[m][n][1] * r * gg[1], acc[m][n][2] * r * gg[2], acc[m][n][3] * r * gg[3]); }
            } else {
                const float* gr = P.mla_rope_gain + ((size_t)l * 2 + 0) * 32; const f32x4 g1 = *(const f32x4*)(gr + 4 * fq), g2 = *(const f32x4*)(gr + 16 + 4 * fq);
#pragma unroll
                for (int hh = 0; hh < 2; ++hh) {
                    const int h = (chunk - 4) * 2 + hh; float ss = 0.f;
#pragma unroll
                    for (int n = 0; n < 2; ++n) { acc[m][2 * hh + n] = acc[m][2 * hh + n] * rt; const f32x4 a = acc[m][2 * hh + n]; ss += a[0] * a[0] + a[1] * a[1] + a[2] * a[2] + a[3] * a[3]; }
                    ss = quad_sum(ss); const float r = rsqrtf(ss * (1.0f / 32.0f) + EPS);
                    float o1[4], o2[4];
#pragma unroll
                    for (int j = 0; j < 4; ++j) { const float2 cs = rope[s * 16 + 4 * fq + j]; const float x1 = acc[m][2 * hh][j] * r * g1[j], x2 = acc[m][2 * hh + 1][j] * r * g2[j];
                        o1[j] = (x1 * cs.x - x2 * cs.y) * SC_MLA; o2[j] = (x1 * cs.y + x2 * cs.x) * SC_MLA; }
                    bf16_t* d = qm + ((size_t)(b * 4 + h) * SEQ + s) * 96 + 64 + 4 * fq; store4bf(d, o1[0], o1[1], o1[2], o1[3]); store4bf(d + 16, o2[0], o2[1], o2[2], o2[3]);
                }
            }
        }
    }
};
struct EpiUkv {
    Params P; int l;
    DEVINL void operator()(f32x4 (&acc)[4][4], int row0, int chunk, int fr, int fq) const {
        const float* ckvss = (const float*)(P.ws + OFF_CKVSS); bf16_t* km = (bf16_t*)((char*)P.out + OOFF_KM); bf16_t* vm = (bf16_t*)((char*)P.out + OOFF_VM);
        const int h = chunk >> 1; const bool isk = (chunk & 1) == 0; const float* gain = P.mla_nope_gain + ((size_t)l * 2 + 1) * 64;
#pragma unroll
        for (int m = 0; m < 4; ++m) {
            const int t = row0 + 16 * m + fr, b = t >> 12, s = t & 4095; const float rt = rsqrtf((ckvss[(size_t)t * 2] + ckvss[(size_t)t * 2 + 1]) * (1.0f / 128.0f) + EPS);
            float ss = 0.f;
#pragma unroll
            for (int n = 0; n < 4; ++n) { acc[m][n] = acc[m][n] * rt; ss += acc[m][n][0] * acc[m][n][0] + acc[m][n][1] * acc[m][n][1] + acc[m][n][2] * acc[m][n][2] + acc[m][n][3] * acc[m][n][3]; }
            if (isk) { ss = quad_sum(ss); const float r = rsqrtf(ss * (1.0f / 64.0f) + EPS); bf16_t* d = km + ((size_t)(b * 4 + h) * SEQ + s) * 96 + 4 * fq;
#pragma unroll
                for (int n = 0; n < 4; ++n) { const f32x4 gg = *(const f32x4*)(gain + 16 * n + 4 * fq); store4bf(d + 16 * n, acc[m][n][0] * r * gg[0], acc[m][n][1] * r * gg[1], acc[m][n][2] * r * gg[2], acc[m][n][3] * r * gg[3]); }
            } else { bf16_t* d = vm + ((size_t)(b * 4 + h) * SEQ + s) * 64 + 4 * fq;
#pragma unroll
                for (int n = 0; n < 4; ++n) store4bf(d + 16 * n, acc[m][n][0], acc[m][n][1], acc[m][n][2], acc[m][n][3]); }
        }
    }
};
struct EpiResid { const float* base; float* out;
    DEVINL void operator()(f32x4 (&acc)[4][4], int row0, int chunk, int fr, int fq) const {
#pragma unroll
        for (int m = 0; m < 4; ++m) { const size_t o = (size_t)(row0 + 16 * m + fr) * DM + chunk * 64 + 4 * fq;
#pragma unroll
            for (int n = 0; n < 4; ++n) { const f32x4 bv = *(const f32x4*)(base + o + 16 * n); *(f32x4*)(out + o + 16 * n) = bv + acc[m][n]; } } } };
struct EpiStore { float* out;
    DEVINL void operator()(f32x4 (&acc)[4][4], int row0, int chunk, int fr, int fq) const {
#pragma unroll
        for (int m = 0; m < 4; ++m) { const size_t o = (size_t)(row0 + 16 * m + fr) * DM + chunk * 64 + 4 * fq;
#pragma unroll
            for (int n = 0; n < 4; ++n) *(f32x4*)(out + o + 16 * n) = acc[m][n]; } } };
struct EpiPle { const float* xa; const float* pp; float* out;
    DEVINL void operator()(f32x4 (&acc)[4][4], int row0, int chunk, int fr, int fq) const {
#pragma unroll
        for (int m = 0; m < 4; ++m) { const size_t o = (size_t)(row0 + 16 * m + fr) * DM + chunk * 64 + 4 * fq;
#pragma unroll
            for (int n = 0; n < 4; ++n) { const f32x4 xv = *(const f32x4*)(xa + o + 16 * n), pv = *(const f32x4*)(pp + o + 16 * n); f32x4 r;
#pragma unroll
                for (int j = 0; j < 4; ++j) r[j] = xv[j] + pv[j] / (1.0f + __expf(-acc[m][n][j]));
                *(f32x4*)(out + o + 16 * n) = r; } } } };

namespace pg8 {
#define PG8_LAS __attribute__((address_space(3)))
constexpr int BM = 256, BK = 64, HALF = 128, HTB = HALF * BK * 2  , STAGE_BYTES = 8 * HTB, NXCD = 8, WGM = 8;

__host__ __device__ __forceinline__ int lds_byte(int r, int c) { const int st = (r >> 4) * 2 + (c >> 5), rr = r & 15, cc = c & 31, ob = rr * 64 + cc * 2; return st * 1024 + (ob ^ (((ob >> 9) & 1) << 5)); }
__host__ __device__ __forceinline__ void stage_rc(int b, int& R, int& C) { const int st = b / 1024, sb = b % 1024, swz = sb ^ (((sb >> 9) & 1) << 5); R = (st >> 1) * 16 + swz / 64; C = (st & 1) * 32 + (swz % 64) / 2; }
__host__ __device__ __forceinline__ int perm32(int rho) { const int n = rho >> 4, i = rho & 15; return 8 * (i >> 2) + 4 * n + (i & 3); }

struct Unit { int pm, pn; };
struct Gemm { const bf16_t* A; const bf16_t* Bt; int M, N, K; };

struct StaticOrder {
    int nM, nN, nwg, G, c;
    __host__ __device__ void init(int M, int N, int G_, int c_) { nM = M / BM; nN = N / BM; nwg = nM * nN; G = G_; c = c_; }
    __host__ __device__ bool next(int i, Unit& u) const {
        const long L = (long)i * G + c; if (L >= nwg) return false;
        int wgid = (int)L; { const int q = nwg / NXCD, r = nwg % NXCD, xcd = wgid % NXCD, off = wgid / NXCD; wgid = (xcd < r ? xcd * (q + 1) : r * (q + 1) + (xcd - r) * q) + off; }
        const int nig = WGM * nN, gid = wgid / nig, fm = gid * WGM, gsz = (nM - fm) < WGM ? (nM - fm) : WGM;
        u.pm = fm + ((wgid % nig) % gsz); u.pn = (wgid % nig) / gsz; return true;
    }
    __device__ __forceinline__ void a_ready(const Unit&) const {}
    __device__ __forceinline__ void done(const Unit&) const {}
};

template <class Epi, class Sched, bool ALIGN_EPI = false, bool SP2 = false>
__device__ __forceinline__ void gemm_phase(PG8_LAS unsigned char* lds, const Gemm g, const Sched& S, const Epi& E) {
    const int tid = ltid(), wid = __builtin_amdgcn_readfirstlane(tid >> 6), lane = tid & 63, wr = wid >> 2, wc = wid & 3, fr = lane & 15, fq = lane >> 4;
    const int K = g.K, nt = K / BK;
    unsigned voffA[2], voffB[2];
#pragma unroll
    for (int i = 0; i < 2; ++i) { int R, C; stage_rc(tid * 16 + i * 8192, R, C); const int Rb = Epi::PERM ? ((R & ~31) + perm32(R & 31)) : R;
        voffA[i] = (unsigned)(R * K + C) * 2u; voffB[i] = (unsigned)(Rb * K + C) * 2u; }
    const size_t kstep = (size_t)(BK * 2);
    const size_t hstep = (size_t)HALF * K * 2;
    const size_t tstep = 2 * hstep;
    const unsigned ldsw = (unsigned)wid * 1024u;
    const int aoff = lds_byte(wr * 64 + fr, fq * 8), boff = lds_byte(wc * 32 + fr, fq * 8);
    PG8_LAS unsigned char* ldsA = lds + aoff; PG8_LAS unsigned char* ldsB = lds + 65536 + boff; asm volatile("" : "+v"(ldsA), "+v"(ldsB));
#define PG8_SA(b, h) (((b) * 2 + (h)) * HTB)
#define PG8_SB(b, h) ((4 + (b) * 2 + (h)) * HTB)
#define PG8_STAGE(bufoff, gbase, voff) do { _Pragma("unroll") for (int _i = 0; _i < 2; ++_i) \
        __builtin_amdgcn_global_load_lds((const unsigned*)((const char*)(gbase) + (voff)[_i]), (PG8_LAS unsigned*)(lds + (bufoff) + ldsw + _i * 8192), 16, 0, 0); } while (0)
#define PG8_LDA(dst, b, h) do { _Pragma("unroll") for (int m = 0; m < 4; ++m) _Pragma("unroll") for (int k = 0; k < 2; ++k) dst[m][k] = *(const PG8_LAS bf16x8*)(ldsA + PG8_SA(b, h) + m * 2048 + k * 1024); } while (0)
#define PG8_LDB(dst, b, h) do { _Pragma("unroll") for (int n = 0; n < 2; ++n) _Pragma("unroll") for (int k = 0; k < 2; ++k) dst[n][k] = *(const PG8_LAS bf16x8*)(ldsB + (PG8_SB(b, h) - 65536) + n * 2048 + k * 1024); } while (0)
#define PG8_MMA(ai, bj, At, Bt) do { __builtin_amdgcn_s_setprio(1); _Pragma("unroll") for (int m = 0; m < 4; ++m) _Pragma("unroll") for (int n = 0; n < 2; ++n) _Pragma("unroll") for (int k = 0; k < 2; ++k) \
        acc[ai][bj][m][n] = __builtin_amdgcn_mfma_f32_16x16x32_bf16(Bt[n][k], At[m][k], acc[ai][bj][m][n], 0, 0, 0); __builtin_amdgcn_s_setprio(0); } while (0)
#define PG8_WAIT_V(n) asm volatile("s_waitcnt vmcnt(" #n ")" ::: "memory")
#define PG8_WAIT_L(n) asm volatile("s_waitcnt lgkmcnt(" #n ")" ::: "memory")
#define PG8_BAR __builtin_amdgcn_s_barrier()
#define PG8_SCHED __builtin_amdgcn_sched_barrier(0)
    Unit cur, nxt; int ui = 0;
    if (!S.next(0, cur)) return;
    f32x4 acc[2][2][4][2];
#pragma unroll
    for (int a = 0; a < 2; ++a)
#pragma unroll
        for (int b = 0; b < 2; ++b)
#pragma unroll
            for (int m = 0; m < 4; ++m)
#pragma unroll
                for (int n = 0; n < 2; ++n) acc[a][b][m][n] = (f32x4){0.f, 0.f, 0.f, 0.f};
    bf16x8 At[4][2], B0[2][2], B1[2][2];
    const char* cA = (const char*)g.A + (size_t)cur.pm * tstep; const char* cB = (const char*)g.Bt + (size_t)cur.pn * tstep;
    S.a_ready(cur);
    if constexpr (SP2) {
        PG8_STAGE(PG8_SB(0, 0), cB, voffB); PG8_STAGE(PG8_SB(0, 1), cB + hstep, voffB); PG8_STAGE(PG8_SA(0, 0), cA, voffA); PG8_STAGE(PG8_SA(0, 1), cA + hstep, voffA);
        if (wr == 1) PG8_BAR;
        PG8_WAIT_V(2); PG8_BAR;
        PG8_STAGE(PG8_SB(1, 0), cB + kstep, voffB); PG8_STAGE(PG8_SA(1, 0), cA + kstep, voffA); PG8_STAGE(PG8_SB(1, 1), cB + hstep + kstep, voffB);
        PG8_WAIT_V(6); PG8_BAR;
    } else {
        PG8_STAGE(PG8_SB(0, 0), cB, voffB); PG8_STAGE(PG8_SA(0, 0), cA, voffA); PG8_STAGE(PG8_SB(0, 1), cB + hstep, voffB); PG8_STAGE(PG8_SA(0, 1), cA + hstep, voffA);
        if (wr == 1) PG8_BAR;
        PG8_WAIT_V(4); PG8_BAR;
        PG8_STAGE(PG8_SB(1, 0), cB + kstep, voffB); PG8_STAGE(PG8_SA(1, 0), cA + kstep, voffA); PG8_STAGE(PG8_SB(1, 1), cB + hstep + kstep, voffB);
        PG8_WAIT_V(6); PG8_BAR;
    }
    for (;;) {
        const bool has_next = S.next(ui + 1, nxt);
        const char* nA = has_next ? (const char*)g.A + (size_t)nxt.pm * tstep : cA; const char* nB = has_next ? (const char*)g.Bt + (size_t)nxt.pn * tstep : cB;
        for (int t = 0; t < nt; t += 2) {
            const bool last = (t == nt - 2);
            const char* a1 = cA + (size_t)(t + 1) * kstep;
            const char* a2 = last ? nA : cA + (size_t)(t + 2) * kstep; const char* b2 = last ? nB : cB + (size_t)(t + 2) * kstep;
            const char* a3 = a2 + kstep; const char* b3 = b2 + kstep;
            if (last && has_next) S.a_ready(nxt);
            if constexpr (SP2) {
            PG8_LDB(B0, 0, 0); PG8_LDB(B1, 0, 1); PG8_SCHED; PG8_LDA(At, 0, 0); PG8_STAGE(PG8_SA(1, 1), a1 + hstep, voffA);
            PG8_WAIT_V(8); PG8_WAIT_L(0); PG8_BAR; PG8_MMA(0, 0, At, B0); PG8_MMA(0, 1, At, B1); PG8_BAR; PG8_SCHED;
            PG8_LDA(At, 0, 1); PG8_STAGE(PG8_SB(0, 0), b2, voffB); PG8_STAGE(PG8_SB(0, 1), b2 + hstep, voffB); PG8_STAGE(PG8_SA(0, 0), a2, voffA);
            PG8_WAIT_V(8); PG8_WAIT_L(0); PG8_BAR; PG8_MMA(1, 0, At, B0); PG8_MMA(1, 1, At, B1); PG8_BAR; PG8_SCHED;
            PG8_LDB(B0, 1, 0); PG8_LDB(B1, 1, 1); PG8_SCHED; PG8_LDA(At, 1, 0); PG8_STAGE(PG8_SA(0, 1), a2 + hstep, voffA);
            PG8_WAIT_V(8); PG8_WAIT_L(0); PG8_BAR; PG8_MMA(0, 0, At, B0); PG8_MMA(0, 1, At, B1); PG8_BAR; PG8_SCHED;
            PG8_LDA(At, 1, 1); PG8_STAGE(PG8_SB(1, 0), b3, voffB); PG8_STAGE(PG8_SB(1, 1), b3 + hstep, voffB); PG8_STAGE(PG8_SA(1, 0), a3, voffA);
            PG8_WAIT_V(8); PG8_WAIT_L(0); PG8_BAR; PG8_MMA(1, 0, At, B0); PG8_MMA(1, 1, At, B1); PG8_BAR; PG8_SCHED;
            } else {
            PG8_LDB(B0, 0, 0); PG8_SCHED; PG8_LDA(At, 0, 0); PG8_STAGE(PG8_SA(1, 1), a1 + hstep, voffA);
            PG8_WAIT_L(8); PG8_BAR; PG8_WAIT_L(0); PG8_MMA(0, 0, At, B0); PG8_BAR; PG8_SCHED;
            PG8_LDB(B1, 0, 1); PG8_STAGE(PG8_SB(0, 0), b2, voffB);
            PG8_BAR; PG8_WAIT_L(0); PG8_MMA(0, 1, At, B1); PG8_BAR;
            PG8_LDA(At, 0, 1); PG8_STAGE(PG8_SA(0, 0), a2, voffA);
            PG8_BAR; PG8_WAIT_L(0); PG8_MMA(1, 0, At, B0); PG8_BAR; PG8_SCHED;
            PG8_STAGE(PG8_SB(0, 1), b2 + hstep, voffB);
            PG8_WAIT_V(6); PG8_BAR; PG8_MMA(1, 1, At, B1); PG8_BAR;
            PG8_LDB(B0, 1, 0); PG8_SCHED; PG8_LDA(At, 1, 0); PG8_STAGE(PG8_SA(0, 1), a2 + hstep, voffA);
            PG8_WAIT_L(8); PG8_BAR; PG8_WAIT_L(0); PG8_MMA(0, 0, At, B0); PG8_BAR; PG8_SCHED;
            PG8_LDB(B1, 1, 1); PG8_STAGE(PG8_SB(1, 0), b3, voffB);
            PG8_BAR; PG8_WAIT_L(0); PG8_MMA(0, 1, At, B1); PG8_BAR;
            PG8_LDA(At, 1, 1); PG8_STAGE(PG8_SA(1, 0), a3, voffA);
            PG8_BAR; PG8_WAIT_L(0); PG8_MMA(1, 0, At, B0); PG8_BAR; PG8_SCHED;
            PG8_STAGE(PG8_SB(1, 1), b3 + hstep, voffB);
            PG8_WAIT_V(6); PG8_BAR; PG8_MMA(1, 1, At, B1); PG8_BAR;
            }
        }
        if constexpr (ALIGN_EPI) { if (wr == 0) PG8_BAR; }
        if constexpr (!Epi::AFTER_DRAIN) { E(acc, cur, wr, wc, fr, fq); S.done(cur); }
        if (!has_next) break;
#pragma unroll
        for (int a = 0; a < 2; ++a)
#pragma unroll
            for (int b = 0; b < 2; ++b)
#pragma unroll
                for (int m = 0; m < 4; ++m)
#pragma unroll
                    for (int n = 0; n < 2; ++n) acc[a][b][m][n] = (f32x4){0.f, 0.f, 0.f, 0.f};
        cur = nxt; cA = nA; cB = nB; ++ui;
        if constexpr (ALIGN_EPI) { if (wr == 1) PG8_BAR; }
    }
    PG8_WAIT_V(0);
    if constexpr (!ALIGN_EPI) { if (wr == 0) PG8_BAR; }
    PG8_BAR;
    if constexpr (Epi::AFTER_DRAIN) { E.fused(acc, cur, wr, wc, fr, fq, lds, wid, lane); S.done(cur); }
#undef PG8_SA
#undef PG8_SB
#undef PG8_STAGE
#undef PG8_LDA
#undef PG8_LDB
#undef PG8_MMA
#undef PG8_WAIT_V
#undef PG8_WAIT_L
#undef PG8_BAR
#undef PG8_SCHED
}
}


DEVINL u32x4 pack8(const f32x4& a, const f32x4& b) { u32x4 w; w.x = cvt2(a[0], a[1]); w.y = cvt2(a[2], a[3]); w.z = cvt2(b[0], b[1]); w.w = cvt2(b[2], b[3]); return w; }
DEVINL float row_rscale(const float* ssq, int t, int fq) { const f32x4 a = *(const f32x4*)(ssq + (size_t)t * 16 + 4 * fq); return rsqrtf(quad_sum(a[0] + a[1] + a[2] + a[3]) * (1.0f / DM) + EPS); }
struct EpiIn8 {
    static constexpr bool PERM = true, AFTER_DRAIN = false;
    Params P; int l;
    DEVINL void operator()(const f32x4 (&acc0)[2][2][4][2], const pg8::Unit& u, int wr, int wc, int fr, int fq) const {
        { const int t_ = ltid(); fr = t_ & 15; fq = (t_ >> 4) & 3; wc = __builtin_amdgcn_readfirstlane((t_ >> 6) & 3); wr = __builtin_amdgcn_readfirstlane(t_ >> 8); }
        char* ws = P.ws; char* ob = (char*)P.out; const int chunk = u.pn * 4 + wc;
        const float* ssqx = (const float*)(ws + OFF_SSQX);
        if (chunk < 36) {
            const int g = chunk >> 2, h = chunk & 3, role = g % 3, mix = g / 3;
            bf16_t* dst = (bf16_t*)(ws + OFF_QKV + (size_t)g * SZ_HEADBUF);
            const float* gain = P.qk_gain + ((size_t)l * 6 + 2 * mix + (role == 1 ? 1 : 0)) * 64 + 8 * fq;
            f32x4 gg[2][2];
#pragma unroll
            for (int bj = 0; bj < 2; ++bj)
#pragma unroll
                for (int n = 0; n < 2; ++n) gg[bj][n] = role != 2 ? *(const f32x4*)(gain + 32 * bj + 4 * n) : (f32x4){1.f, 1.f, 1.f, 1.f};
#pragma unroll
            for (int ai = 0; ai < 2; ++ai)
#pragma unroll
                for (int m = 0; m < 4; ++m) {
                    const int t = u.pm * 256 + 128 * ai + 64 * wr + 16 * m + fr, b = t >> 12, s = t & 4095; const float rt_ = row_rscale(ssqx, t, fq); const f32x4 a[2][2] = {{acc0[ai][0][m][0] * rt_, acc0[ai][0][m][1] * rt_}, {acc0[ai][1][m][0] * rt_, acc0[ai][1][m][1] * rt_}}; bf16_t* d = dst + ((size_t)(b * 4 + h) * SEQ + s) * 64 + 8 * fq;
                    float r = 1.f;
                    if (role != 2) { float ss = sq4(a[0][0]) + sq4(a[0][1]) + sq4(a[1][0]) + sq4(a[1][1]); ss = quad_sum(ss); r = rsqrtf(ss * (1.0f / 64.0f) + EPS) * (role == 0 ? SC_Q : 1.0f); }
#pragma unroll
                    for (int bj = 0; bj < 2; ++bj) *(u32x4*)(d + 32 * bj) = pack8(a[bj][0] * r * gg[bj][0], a[bj][1] * r * gg[bj][1]);
                }
        } else if (chunk < 42) {
            const bool isq = chunk < 40; const int c = isq ? chunk - 36 : chunk - 40;
            bf16_t* dst = isq ? (bf16_t*)(ws + OFF_CQ) : (bf16_t*)(ws + OFF_CKV); const int ld = 256;
            float* ssp = isq ? (float*)(ws + OFF_CQSS) : (float*)(ws + OFF_CKVSS); const int nss = isq ? 4 : 2;
#pragma unroll
            for (int ai = 0; ai < 2; ++ai)
#pragma unroll
                for (int m = 0; m < 4; ++m) {
                    const int t = u.pm * 256 + 128 * ai + 64 * wr + 16 * m + fr; const float rt_ = row_rscale(ssqx, t, fq); const f32x4 a[2][2] = {{acc0[ai][0][m][0] * rt_, acc0[ai][0][m][1] * rt_}, {acc0[ai][1][m][0] * rt_, acc0[ai][1][m][1] * rt_}};
                    float ss = sq4(a[0][0]) + sq4(a[0][1]) + sq4(a[1][0]) + sq4(a[1][1]); ss = quad_sum(ss);
#pragma unroll
                    for (int bj = 0; bj < 2; ++bj) *(u32x4*)(dst + (size_t)t * ld + c * 64 + 32 * bj + 8 * fq) = pack8(a[bj][0], a[bj][1]);
                    if (fq == 0) ssp[(size_t)t * nss + c] = ss;
                }
        } else if (chunk == 42) {
            const float* gr = P.mla_rope_gain + ((size_t)l * 2 + 1) * 32; const float2* rope = (const float2*)(ws + OFF_ROPE);
            bf16_t* km = (bf16_t*)(ob + OOFF_KM); float* logf_ = (float*)(ws + OFF_LOGF);
            const f32x4 g1 = *(const f32x4*)(gr + 4 * fq), g2 = *(const f32x4*)(gr + 16 + 4 * fq); const f32x4 bfv = *(const f32x4*)(P.b_forget + l * 4);
#pragma unroll
            for (int ai = 0; ai < 2; ++ai)
#pragma unroll
                for (int m = 0; m < 4; ++m) {
                    const int t = u.pm * 256 + 128 * ai + 64 * wr + 16 * m + fr, b = t >> 12, s = t & 4095; const float rt_ = row_rscale(ssqx, t, fq); const f32x4 a[2][2] = {{acc0[ai][0][m][0] * rt_, acc0[ai][0][m][1] * rt_}, {acc0[ai][1][m][0] * rt_, acc0[ai][1][m][1] * rt_}};
                    float ss = sq4(a[0][0]) + sq4(a[0][1]); ss = quad_sum(ss); const float r = rsqrtf(ss * (1.0f / 32.0f) + EPS);
                    float o1[4], o2[4];
#pragma unroll
                    for (int j = 0; j < 4; ++j) { const float2 cs = rope[s * 16 + 4 * fq + j]; const float x1 = a[0][0][j] * r * g1[j], x2 = a[0][1][j] * r * g2[j]; o1[j] = x1 * cs.x - x2 * cs.y; o2[j] = x1 * cs.y + x2 * cs.x; }
#pragma unroll
                    for (int h = 0; h < 4; ++h) { bf16_t* d = km + ((size_t)(b * 4 + h) * SEQ + s) * 96 + 64 + 4 * fq; store4bf(d, o1[0], o1[1], o1[2], o1[3]); store4bf(d + 16, o2[0], o2[1], o2[2], o2[3]); }
                    if (fq == 0) {
#pragma unroll
                        for (int j = 0; j < 4; ++j) logf_[(size_t)(b * 4 + j) * SEQ + s] = log_sigmoid(a[1][0][j] + bfv[j]) * LOG2E;
                    }
                }
        } else if (chunk >= 44) {
            bf16_t* G = (bf16_t*)(ob + OOFF_G); const int c0 = (chunk - 44) * 64 + 8 * fq;
#pragma unroll
            for (int ai = 0; ai < 2; ++ai)
#pragma unroll
                for (int m = 0; m < 4; ++m) {
                    const int t = u.pm * 256 + 128 * ai + 64 * wr + 16 * m + fr; const float rt_ = row_rscale(ssqx, t, fq); const f32x4 a[2][2] = {{acc0[ai][0][m][0] * rt_, acc0[ai][0][m][1] * rt_}, {acc0[ai][1][m][0] * rt_, acc0[ai][1][m][1] * rt_}};
#pragma unroll
                    for (int bj = 0; bj < 2; ++bj) { f32x4 o0, o1;
#pragma unroll
                        for (int j = 0; j < 4; ++j) { const float z0 = a[bj][0][j], z1 = a[bj][1][j]; o0[j] = z0 * fsigmoid(z0); o1[j] = z1 * fsigmoid(z1); }
                        *(u32x4*)(G + (size_t)t * DM + c0 + 32 * bj) = pack8(o0, o1); }
                }
        }
    }
};
struct EpiResid8 { static constexpr bool PERM = true, AFTER_DRAIN = false; const float* base; const bf16_t* bbase; bf16_t* obf; float* ssq;
    DEVINL void operator()(const f32x4 (&acc)[2][2][4][2], const pg8::Unit& u, int wr, int wc, int fr, int fq) const {
        { const int t_ = ltid(); fr = t_ & 15; fq = (t_ >> 4) & 3; wc = __builtin_amdgcn_readfirstlane((t_ >> 6) & 3); wr = __builtin_amdgcn_readfirstlane(t_ >> 8); }
#pragma unroll
        for (int ai = 0; ai < 2; ++ai)
#pragma unroll
            for (int m = 0; m < 4; ++m) { const int t = u.pm * 256 + 128 * ai + 64 * wr + 16 * m + fr; const size_t o = (size_t)t * DM + u.pn * 256 + 64 * wc + 8 * fq; float ss = 0.f;
#pragma unroll
                for (int bj = 0; bj < 2; ++bj) { f32x4 v0, v1;
                    if (bbase) { const u32x4 bw = *(const u32x4*)(bbase + o + 32 * bj); v0 = (f32x4){bflo(bw.x), bfhi(bw.x), bflo(bw.y), bfhi(bw.y)}; v1 = (f32x4){bflo(bw.z), bfhi(bw.z), bflo(bw.w), bfhi(bw.w)}; }
                    else { v0 = __builtin_nontemporal_load((const f32x4*)(base + o + 32 * bj)); v1 = __builtin_nontemporal_load((const f32x4*)(base + o + 32 * bj + 4)); }
                    v0 += acc[ai][bj][m][0]; v1 += acc[ai][bj][m][1];
                    *(u32x4*)(obf + o + 32 * bj) = pack8(v0, v1); ss += sq4(v0) + sq4(v1); }
                ss = quad_sum(ss); if (fq == 0) ssq[(size_t)t * 16 + u.pn * 4 + wc] = ss; } } };
struct EpiStoreBf { static constexpr bool PERM = true, AFTER_DRAIN = false; bf16_t* out;
    DEVINL void operator()(const f32x4 (&acc)[2][2][4][2], const pg8::Unit& u, int wr, int wc, int fr, int fq) const {
        { const int t_ = ltid(); fr = t_ & 15; fq = (t_ >> 4) & 3; wc = __builtin_amdgcn_readfirstlane((t_ >> 6) & 3); wr = __builtin_amdgcn_readfirstlane(t_ >> 8); }
#pragma unroll
        for (int ai = 0; ai < 2; ++ai)
#pragma unroll
            for (int m = 0; m < 4; ++m) { const size_t o = (size_t)(u.pm * 256 + 128 * ai + 64 * wr + 16 * m + fr) * DM + u.pn * 256 + 64 * wc + 8 * fq;
#pragma unroll
                for (int bj = 0; bj < 2; ++bj) *(u32x4*)(out + o + 32 * bj) = pack8(acc[ai][bj][m][0], acc[ai][bj][m][1]); } } };
struct EpiPle8 { static constexpr bool PERM = true, AFTER_DRAIN = false; const bf16_t* xa; const bf16_t* pp; float* out; const float* ssq_in; bf16_t* obf; float* ssq_out;
    DEVINL void operator()(const f32x4 (&acc)[2][2][4][2], const pg8::Unit& u, int wr, int wc, int fr, int fq) const {
        { const int t_ = ltid(); fr = t_ & 15; fq = (t_ >> 4) & 3; wc = __builtin_amdgcn_readfirstlane((t_ >> 6) & 3); wr = __builtin_amdgcn_readfirstlane(t_ >> 8); }
#pragma unroll
        for (int ai = 0; ai < 2; ++ai)
#pragma unroll
            for (int m = 0; m < 4; ++m) { const int t = u.pm * 256 + 128 * ai + 64 * wr + 16 * m + fr; const size_t o = (size_t)t * DM + u.pn * 256 + 64 * wc + 8 * fq;
                const float rt = row_rscale(ssq_in, t, fq); float ss = 0.f;
#pragma unroll
                for (int bj = 0; bj < 2; ++bj) { const u32x4 xw = *(const u32x4*)(xa + o + 32 * bj); const f32x4 x0 = (f32x4){bflo(xw.x), bfhi(xw.x), bflo(xw.y), bfhi(xw.y)}, x1 = (f32x4){bflo(xw.z), bfhi(xw.z), bflo(xw.w), bfhi(xw.w)}; const u32x4 pw = *(const u32x4*)(pp + o + 32 * bj); f32x4 r0, r1;
                    const float pv[8] = {bflo(pw.x), bfhi(pw.x), bflo(pw.y), bfhi(pw.y), bflo(pw.z), bfhi(pw.z), bflo(pw.w), bfhi(pw.w)};
#pragma unroll
                    for (int jj = 0; jj < 4; ++jj) { r0[jj] = x0[jj] + pv[jj] * fsigmoid(rt * acc[ai][bj][m][0][jj]); r1[jj] = x1[jj] + pv[4 + jj] * fsigmoid(rt * acc[ai][bj][m][1][jj]); }
                    if (out) { __builtin_nontemporal_store(r0, (f32x4*)(out + o + 32 * bj)); __builtin_nontemporal_store(r1, (f32x4*)(out + o + 32 * bj + 4)); }
                    if (obf) { *(u32x4*)(obf + o + 32 * bj) = pack8(r0, r1); ss += sq4(r0) + sq4(r1); } }
                if (obf) { ss = quad_sum(ss); if (fq == 0) ssq_out[(size_t)t * 16 + u.pn * 4 + wc] = ss; } } } };
struct EpiUq8 { static constexpr bool PERM = true, AFTER_DRAIN = false; Params P; int l;
    DEVINL void operator()(const f32x4 (&acc)[2][2][4][2], const pg8::Unit& u, int wr, int wc, int fr, int fq) const {
        { const int t_ = ltid(); fr = t_ & 15; fq = (t_ >> 4) & 3; wc = __builtin_amdgcn_readfirstlane((t_ >> 6) & 3); wr = __builtin_amdgcn_readfirstlane(t_ >> 8); }
        const int chunk = u.pn * 4 + wc; if (chunk >= 6) return;
        const float* cqss = (const float*)(P.ws + OFF_CQSS); bf16_t* qm = (bf16_t*)((char*)P.out + OOFF_QM); const float2* rope = (const float2*)(P.ws + OFF_ROPE);
#pragma unroll
        for (int ai = 0; ai < 2; ++ai)
#pragma unroll
            for (int m = 0; m < 4; ++m) {
                const int t = u.pm * 256 + 128 * ai + 64 * wr + 16 * m + fr, b = t >> 12, s = t & 4095;
                const float rt = rsqrtf(quad_sum(cqss[(size_t)t * 4 + fq]) * (1.0f / 256.0f) + EPS);
                const f32x4 a[2][2] = {{acc[ai][0][m][0] * rt, acc[ai][0][m][1] * rt}, {acc[ai][1][m][0] * rt, acc[ai][1][m][1] * rt}};
                if (chunk < 4) {
                    const float* gain = P.mla_nope_gain + ((size_t)l * 2 + 0) * 64 + 8 * fq;
                    float ss = sq4(a[0][0]) + sq4(a[0][1]) + sq4(a[1][0]) + sq4(a[1][1]); ss = quad_sum(ss); const float r = rsqrtf(ss * (1.0f / 64.0f) + EPS) * SC_MLA;
                    bf16_t* d = qm + ((size_t)(b * 4 + chunk) * SEQ + s) * 96 + 8 * fq;
#pragma unroll
                    for (int bj = 0; bj < 2; ++bj) { const f32x4 g0 = *(const f32x4*)(gain + 32 * bj), g1 = *(const f32x4*)(gain + 32 * bj + 4); *(u32x4*)(d + 32 * bj) = pack8(a[bj][0] * r * g0, a[bj][1] * r * g1); }
                } else {
                    const float* gr = P.mla_rope_gain + ((size_t)l * 2 + 0) * 32; const f32x4 g1 = *(const f32x4*)(gr + 4 * fq), g2 = *(const f32x4*)(gr + 16 + 4 * fq);
#pragma unroll
                    for (int bj = 0; bj < 2; ++bj) { const int h = (chunk - 4) * 2 + bj;
                        float ss = sq4(a[bj][0]) + sq4(a[bj][1]); ss = quad_sum(ss); const float r = rsqrtf(ss * (1.0f / 32.0f) + EPS);
                        float o1[4], o2[4];
#pragma unroll
                        for (int j = 0; j < 4; ++j) { const float2 cs = rope[s * 16 + 4 * fq + j]; const float x1 = a[bj][0][j] * r * g1[j], x2 = a[bj][1][j] * r * g2[j]; o1[j] = (x1 * cs.x - x2 * cs.y) * SC_MLA; o2[j] = (x1 * cs.y + x2 * cs.x) * SC_MLA; }
                        bf16_t* d = qm + ((size_t)(b * 4 + h) * SEQ + s) * 96 + 64 + 4 * fq; store4bf(d, o1[0], o1[1], o1[2], o1[3]); store4bf(d + 16, o2[0], o2[1], o2[2], o2[3]); }
                }
            }
    }
};
struct EpiUkv8 { static constexpr bool PERM = true, AFTER_DRAIN = false; Params P; int l;
    DEVINL void operator()(const f32x4 (&acc)[2][2][4][2], const pg8::Unit& u, int wr, int wc, int fr, int fq) const {
        { const int t_ = ltid(); fr = t_ & 15; fq = (t_ >> 4) & 3; wc = __builtin_amdgcn_readfirstlane((t_ >> 6) & 3); wr = __builtin_amdgcn_readfirstlane(t_ >> 8); }
        const int chunk = u.pn * 4 + wc, h = chunk >> 1; const bool isk = (chunk & 1) == 0;
        const float* ckvss = (const float*)(P.ws + OFF_CKVSS); bf16_t* km = (bf16_t*)((char*)P.out + OOFF_KM); bf16_t* vm = (bf16_t*)((char*)P.out + OOFF_VM);
        const float* gain = P.mla_nope_gain + ((size_t)l * 2 + 1) * 64 + 8 * fq;
#pragma unroll
        for (int ai = 0; ai < 2; ++ai)
#pragma unroll
            for (int m = 0; m < 4; ++m) {
                const int t = u.pm * 256 + 128 * ai + 64 * wr + 16 * m + fr, b = t >> 12, s = t & 4095;
                const float rt = rsqrtf(quad_sum(fq < 2 ? ckvss[(size_t)t * 2 + fq] : 0.f) * (1.0f / 128.0f) + EPS);
                const f32x4 a[2][2] = {{acc[ai][0][m][0] * rt, acc[ai][0][m][1] * rt}, {acc[ai][1][m][0] * rt, acc[ai][1][m][1] * rt}};
                if (isk) { float ss = sq4(a[0][0]) + sq4(a[0][1]) + sq4(a[1][0]) + sq4(a[1][1]); ss = quad_sum(ss); const float r = rsqrtf(ss * (1.0f / 64.0f) + EPS);
                    bf16_t* d = km + ((size_t)(b * 4 + h) * SEQ + s) * 96 + 8 * fq;
#pragma unroll
                    for (int bj = 0; bj < 2; ++bj) { const f32x4 g0 = *(const f32x4*)(gain + 32 * bj), g1 = *(const f32x4*)(gain + 32 * bj + 4); *(u32x4*)(d + 32 * bj) = pack8(a[bj][0] * r * g0, a[bj][1] * r * g1); }
                } else { bf16_t* d = vm + ((size_t)(b * 4 + h) * SEQ + s) * 64 + 8 * fq;
#pragma unroll
                    for (int bj = 0; bj < 2; ++bj) *(u32x4*)(d + 32 * bj) = pack8(a[bj][0], a[bj][1]); }
            }
    }
};
template <class Epi> DEVINL void gemm8(const bf16_t* A, const bf16_t* Bt, int M, int N, int K, const Epi& E, char* smem) {
    int G = (int)gridDim.x, c = (int)blockIdx.x; asm volatile("" : "+s"(G), "+s"(c));
    pg8::Gemm g{A, Bt, M, N, K}; pg8::StaticOrder S; S.init(M, N, G, c);
    pg8::gemm_phase<Epi, pg8::StaticOrder, true, true>((PG8_LAS unsigned char*)smem, g, S, E);
}

DEVINL void kmean_unit(const Params& P, int u, char* smem) {
    float* red = (float*)smem; const bf16_t* K = (const bf16_t*)(P.ws + OFF_QKV + 4 * SZ_HEADBUF); float* km = (float*)(P.ws + OFF_KMEAN);
    const int tid = ltid(), dc = tid & 7, rg = tid >> 3;
    const bf16_t* kp = K + ((size_t)(u >> 4) * SEQ + (u & 15) * 256 + rg) * 64 + dc * 8;
    u32x4 w[4];
#pragma unroll
    for (int i = 0; i < 4; ++i) w[i] = *(const u32x4*)(kp + (size_t)i * 64 * 64);
    float s[8] = {0.f, 0.f, 0.f, 0.f, 0.f, 0.f, 0.f, 0.f};
#pragma unroll
    for (int i = 0; i < 4; ++i) { s[0] += bflo(w[i].x); s[1] += bfhi(w[i].x); s[2] += bflo(w[i].y); s[3] += bfhi(w[i].y); s[4] += bflo(w[i].z); s[5] += bfhi(w[i].z); s[6] += bflo(w[i].w); s[7] += bfhi(w[i].w); }
    __syncthreads();
#pragma unroll
    for (int e = 0; e < 8; ++e) red[rg * 65 + dc * 8 + e] = s[e];
    __syncthreads();
    if (tid < 64) { float a = 0.f;
#pragma unroll 8
        for (int i = 0; i < 64; ++i) a += red[i * 65 + tid];
        km[(size_t)u * 64 + tid] = a * (1.0f / 256.0f); }
}

typedef float f32x16 __attribute__((ext_vector_type(16)));
typedef short s16x4 __attribute__((ext_vector_type(4)));
typedef short v4i16_t __attribute__((ext_vector_type(4)));
#define LAS __attribute__((address_space(3)))
#define MFMA32(a, b, c) __builtin_amdgcn_mfma_f32_32x32x16_bf16(a, b, c, 0, 0, 0)
DEVINL s16x4 vtr(const LAS char* p) { return __builtin_bit_cast(s16x4, __builtin_amdgcn_ds_read_tr16_b64_v4i16((LAS v4i16_t*)p)); }
DEVINL float swap_max(float v) { auto rr = __builtin_amdgcn_permlane32_swap(__float_as_uint(v), __float_as_uint(v), false, false); return fmaxf(__uint_as_float(rr[0]), __uint_as_float(rr[1])); }
DEVINL float swap_sum(float v) { auto rr = __builtin_amdgcn_permlane32_swap(__float_as_uint(v), __float_as_uint(v), false, false); return __uint_as_float(rr[0]) + __uint_as_float(rr[1]); }
DEVINL float fadd1(float a, float b) { float r; asm("v_add_f32 %0, %1, %2" : "=v"(r) : "v"(a), "v"(b)); return r; }
DEVINL constexpr int crow(int r) { return (r & 3) + 8 * (r >> 2); }

constexpr int KSLOT = 64 * 144, RSLOT = 64 * 80;
constexpr int L_KB = 0, L_VB = 3 * KSLOT, L_KR = L_VB + 16384, L_AUX = L_KR + 3 * RSLOT, L_SCR = L_AUX + 16640 + 256, L_KMS = L_SCR + 2048, L_ATT_END = L_KMS + 4096;
constexpr float NEGBIG = -3.0e38f, THR = 8.0f;

template <int MODE>
DEVINL void attn_unit(const Params& P, int l, int u, char* smem) {
    constexpr int DK = MODE == 2 ? 96 : 64, ND0 = DK / 16;
    LAS char* lds = (LAS char*)smem;
    const int tid = ltid(), lane = tid & 63, r32 = lane & 31, hi = lane >> 5; const int wid = __builtin_amdgcn_readfirstlane(tid >> 6);
    const bool fast = ((const float*)(P.ws + OFF_BOUND))[l * 4 + MODE] < 100.0f;
    int bh, q0, t_lo, t_hi, dil = 1, res = 0, pat = 0, qb = 0;
    if (MODE != 3) { bh = u & 15; qb = 15 - (u >> 4); q0 = qb * 256; t_lo = 0; t_hi = (q0 + 255) >> 6; }
    else { pat = u >> 8; const int v = u & 255; bh = v & 15; const int w = v >> 4; dil = pat == 0 ? 1 : (pat == 1 ? 4 : 16); res = w % dil; q0 = (w / dil) * 256; t_lo = (q0 >= 128 ? q0 - 128 : 0) >> 6; t_hi = (q0 + 255) >> 6; }
    const int b = bh >> 2, h = bh & 3;
    const bf16_t *Qg, *Kg, *Vg; int rsq, rsk, rsv;
    if (MODE == 0) { Qg = (const bf16_t*)(P.ws + OFF_QKV) + (size_t)bh * SEQ * 64; Kg = Qg + SZ_HEADBUF / 2; Vg = Kg + SZ_HEADBUF / 2; rsq = rsk = rsv = 64; }
    else if (MODE == 1) { Qg = (const bf16_t*)(P.ws + OFF_QKV + 3 * SZ_HEADBUF) + (size_t)bh * SEQ * 64; Kg = Qg + SZ_HEADBUF / 2; Vg = Kg + SZ_HEADBUF / 2; rsq = rsk = rsv = 64; }
    else if (MODE == 2) { Qg = (const bf16_t*)((const char*)P.out + OOFF_QM) + (size_t)bh * SEQ * 96; Kg = (const bf16_t*)((const char*)P.out + OOFF_KM) + (size_t)bh * SEQ * 96; Vg = (const bf16_t*)((const char*)P.out + OOFF_VM) + (size_t)bh * SEQ * 64; rsq = rsk = 96; rsv = 64; }
    else { Qg = (const bf16_t*)(P.ws + OFF_QKV + 6 * SZ_HEADBUF) + ((size_t)bh * SEQ + res) * 64; Kg = Qg + SZ_HEADBUF / 2; Vg = Kg + SZ_HEADBUF / 2; rsq = rsk = rsv = 64 * dil; }
    const int qw = q0 + 32 * wid;

    __syncthreads();
    const unsigned kgo = (unsigned)((tid >> 3) * rsk + (tid & 7) * 8), vgo = (unsigned)(((tid >> 2) & 63) * rsv + (tid >> 8) * 32 + (tid & 3) * 8), rgo = (unsigned)(((tid >> 2) & 63) * rsk + 64 + (tid & 3) * 8);
    const int kws = (tid >> 3) * 144 + (tid & 7) * 16;
    const int rws = ((tid >> 2) & 63) * 80 + (tid & 3) * 16;
    u32x4 kA, rA, kB, rB;
#define ATT_LOADK(j, K_, R_) do { if ((j) <= t_hi) { K_ = *(const u32x4*)(Kg + (size_t)(j) * 64 * rsk + kgo); if (MODE == 2 && tid < 256) R_ = *(const u32x4*)(Kg + (size_t)(j) * 64 * rsk + rgo); } } while (0)
#define ATT_DMAV(j, slot) do { if ((j) <= t_hi) __builtin_amdgcn_global_load_lds((const unsigned*)(Vg + (size_t)(j) * 64 * rsv + vgo), (LAS unsigned*)(lds + L_VB + (slot) * 8192 + wid * 1024), 16, 0, 0); } while (0)
#define ATT_WRITEK(slot, j, K_, R_) do { if ((j) <= t_hi) { *(LAS u32x4*)(lds + L_KB + (slot) * KSLOT + kws) = K_; if (MODE == 2 && tid < 256) *(LAS u32x4*)(lds + L_KR + (slot) * RSLOT + rws) = R_; \
        if (MODE == 0 && tid < 64) { const float bs = aux[(j) * 64 + tid] - auxU; const unsigned hb = cvt2(bs, 0.f) & 0xffffu; const float lo = bs - __uint_as_float(hb << 16); u32x4 w; w.x = hb | (cvt2(lo, 0.f) << 16); w.y = 0x3F80u; w.z = 0u; w.w = 0u; \
            *(LAS u32x4*)(lds + L_KR + (slot) * 1024 + tid * 16) = w; } } } while (0)
    bf16x8 qf[ND0];
    { const bf16_t* qp = Qg + (size_t)(qw + r32) * rsq + 8 * hi;
#pragma unroll
      for (int d0 = 0; d0 < ND0; ++d0) qf[d0] = *(const bf16x8*)(qp + 16 * d0); }
    if (MODE != 0) { ATT_LOADK(t_lo, kA, rA); ATT_LOADK(t_lo + 1, kB, rB); }
    LAS float* aux = (LAS float*)(lds + L_AUX);
    if (MODE == 0) {
        LAS float* tot = (LAS float*)(lds + L_SCR);
        const float* lf = (const float*)(P.ws + OFF_LOGF) + (size_t)bh * SEQ + tid * 8; float v[8]; float run = 0.f;
        { const f32x4 a = *(const f32x4*)lf, c = *(const f32x4*)(lf + 4); v[0] = a[0]; v[1] = a[1]; v[2] = a[2]; v[3] = a[3]; v[4] = c[0]; v[5] = c[1]; v[6] = c[2]; v[7] = c[3]; }
#pragma unroll
        for (int i = 0; i < 8; ++i) { run += v[i]; v[i] = run; }
        tot[tid] = run; __syncthreads();
        if (tid < 64) { float a[8]; float acc = 0.f;
#pragma unroll
            for (int i = 0; i < 8; ++i) { acc += tot[tid * 8 + i]; a[i] = acc; }
            float incl = acc;
#pragma unroll
            for (int o = 1; o < 64; o <<= 1) { const float nb = shup(incl, o); if (tid >= o) incl += nb; }
            const float ex = incl - acc; tot[tid * 8] = ex;
#pragma unroll
            for (int i = 1; i < 8; ++i) tot[tid * 8 + i] = ex + a[i - 1]; }
        __syncthreads();
        const float base = tot[tid];
#pragma unroll
        for (int i = 0; i < 8; ++i) aux[tid * 8 + i] = -(base + v[i]);
        if (tid < 4) ((LAS unsigned*)(lds + L_KR + 3072))[tid] = 0u;
    } else if (MODE == 1) {
        const float* lut = (const float*)(P.ws + OFF_LUT) + (size_t)h * 4096;
        for (int i = ((4095 - (q0 + 255)) & ~3) + 4 * tid; i < 4160; i += 4 * NTHREADS) {
            f32x4 v = (f32x4){0.f, 0.f, 0.f, 0.f}; if (i < 4096) { const f32x4 s = *(const f32x4*)(lut + 4092 - i); v = (f32x4){s[3], s[2], s[1], s[0]}; }
            *(LAS f32x4*)(aux + i) = v; }
        if (tid < 64) aux[4160 + tid] = -INFINITY;
        LAS float* kms = (LAS float*)(lds + L_KMS); const float* km = (const float*)(P.ws + OFF_KMEAN) + (size_t)bh * 1024;
        for (int i = tid; i < 1024; i += NTHREADS) kms[i] = km[i];
    } else if (MODE == 3) {
        const float* lut = (const float*)(P.ws + OFF_LUT) + (size_t)(4 + h) * 4096;
        if (tid < 320) { const int rel = 255 - tid; aux[tid] = (rel >= 0 && rel * dil < 4096) ? lut[rel * dil] : 0.f; }
    }
    if (MODE == 0 && fast) {
        __syncthreads();
        const float bnd = ((const float*)(P.ws + OFF_BOUND))[l * 4 + (tid >> 30)];
        const bool sk = (lane <= t_hi) && ((aux[64 * lane + 63] - aux[q0]) + bnd < -150.0f);
        t_lo = (int)__builtin_popcountll(__ballot(sk));
    }
    __syncthreads();
    bf16x8 qx = {0, 0, 0, 0, 0, 0, 0, 0}; float auxU = 0.f;
    if (MODE == 0) { auxU = aux[q0 + 255]; const float sh = auxU - aux[qw + r32];
        if (hi == 0) { u32x4 w; w.x = 0x3F803F80u; w.y = cvt2(sh, 0.f); w.z = 0u; w.w = 0u; qx = __builtin_bit_cast(bf16x8, w); } }
    unsigned sel = 0;
    if (MODE == 1) {
        const LAS float* kms = (const LAS float*)(lds + L_KMS); float gt[15];
#pragma unroll
        for (int n = 0; n < 15; ++n) { float s = 0.f;
            if (n < qb) {
#pragma unroll
                for (int d0 = 0; d0 < 4; ++d0) { const f32x4 ka = *(const LAS f32x4*)(kms + n * 64 + 16 * d0 + 8 * hi), kb = *(const LAS f32x4*)(kms + n * 64 + 16 * d0 + 8 * hi + 4);
                    const u32x4 w = __builtin_bit_cast(u32x4, qf[d0]);
                    s += bflo(w.x) * ka[0] + bfhi(w.x) * ka[1] + bflo(w.y) * ka[2] + bfhi(w.y) * ka[3] + bflo(w.z) * kb[0] + bfhi(w.z) * kb[1] + bflo(w.w) * kb[2] + bfhi(w.w) * kb[3]; }
                s = swap_sum(s); }
            gt[n] = s; }
#pragma unroll
        for (int k = 0; k < 3; ++k) { float best = NEGBIG; int bi = -1;
#pragma unroll
            for (int n = 0; n < 15; ++n) if (n < qb && !((sel >> n) & 1u) && gt[n] > best) { best = gt[n]; bi = n; }
            if (bi >= 0) sel |= 1u << bi; }
        sel |= 1u << qb;
    }
    const int kfo = L_KB + r32 * 144 + hi * 16, rfo = L_KR + r32 * 80 + hi * 16;
    const int vfo = L_VB + ((lane >> 4) & 1) * 32 + (lane & 3) * 8 + (4 * hi + ((lane & 15) >> 2)) * 64;

    f32x16 o0, o1;
#pragma unroll
    for (int r = 0; r < 16; ++r) { o0[r] = 0.f; o1[r] = 0.f; }
    float m = fast ? 0.f : NEGBIG, lsum = 0.f;

    auto anysel = [&](int j) -> bool { return MODE != 1 || __any((sel >> (j >> 2)) & 1u); };
    auto is_full = [&](int j) -> bool {
        bool f = fast && (64 * j + 63 <= qw) && anysel(j);
        if (MODE == 3) f = f && (64 * j >= qw + 31 - 128);
        return f; };
    auto stage_a = [&](int j, int ks, int kb, f32x16& p) {
        if (MODE == 1 || MODE == 3) { const LAS float* lp = aux + ((MODE == 1 ? 4095 : 255) - (qw + r32 - 64 * j - 4 * hi));
            if (MODE == 1) lp = ((sel >> (j >> 2)) & 1u) ? lp : aux + 4160;
#pragma unroll
            for (int r = 0; r < 16; ++r) p[r] = lp[crow(r) + 32 * kb];
        } else {
#pragma unroll
            for (int r = 0; r < 16; ++r) p[r] = 0.f;
        }
        const LAS char* kb_ = lds + ks * KSLOT + kb * (32 * 144) + kfo;
#pragma unroll
        for (int d0 = 0; d0 < 4; ++d0) p = MFMA32(*(const LAS bf16x8*)(kb_ + d0 * 32), qf[d0], p);
        if (MODE == 2) { const LAS char* rb_ = lds + ks * RSLOT + kb * (32 * 80) + rfo;
#pragma unroll
            for (int d0 = 0; d0 < 2; ++d0) p = MFMA32(*(const LAS bf16x8*)(rb_ + d0 * 32), qf[4 + d0], p); }
        if (MODE == 0) p = MFMA32(*(const LAS bf16x8*)(lds + (hi ? (L_KR + 3072) : (L_KR + ks * 1024 + kb * 512 + r32 * 16))), qx, p);
    };
    auto stage_b = [&](int j, f32x16& p, u32x4& wa, u32x4& wb) {
#pragma unroll
        for (int r = 0; r < 16; ++r) { p[r] = __builtin_amdgcn_exp2f(p[r]); lsum += p[r]; }
        wa.x = cvt2(p[0], p[1]); wa.y = cvt2(p[2], p[3]); wa.z = cvt2(p[4], p[5]); wa.w = cvt2(p[6], p[7]);
        wb.x = cvt2(p[8], p[9]); wb.y = cvt2(p[10], p[11]); wb.z = cvt2(p[12], p[13]); wb.w = cvt2(p[14], p[15]);
        asm volatile("" : "+v"(lsum));
    };
    auto stage_c = [&](int vs, int kb, const u32x4& wa, const u32x4& wb) {
        const LAS char* vb_ = lds + vs * 8192 + vfo + kb * 2048;
        { const s16x4 a0 = vtr(vb_), a1 = vtr(vb_ + 512), c0 = vtr(vb_ + 4096), c1 = vtr(vb_ + 4096 + 512);
          o0 = MFMA32(__builtin_shufflevector(a0, a1, 0, 1, 2, 3, 4, 5, 6, 7), __builtin_bit_cast(bf16x8, wa), o0); o1 = MFMA32(__builtin_shufflevector(c0, c1, 0, 1, 2, 3, 4, 5, 6, 7), __builtin_bit_cast(bf16x8, wa), o1); }
        { const s16x4 a0 = vtr(vb_ + 1024), a1 = vtr(vb_ + 1024 + 512), c0 = vtr(vb_ + 4096 + 1024), c1 = vtr(vb_ + 4096 + 1024 + 512);
          o0 = MFMA32(__builtin_shufflevector(a0, a1, 0, 1, 2, 3, 4, 5, 6, 7), __builtin_bit_cast(bf16x8, wb), o0); o1 = MFMA32(__builtin_shufflevector(c0, c1, 0, 1, 2, 3, 4, 5, 6, 7), __builtin_bit_cast(bf16x8, wb), o1); }
    };
    auto general = [&](int t, int ks, int vs) {
        const int k0 = t * 64; const bool selected = MODE != 1 || ((sel >> (t >> 2)) & 1u); const bool asel = anysel(t);
        int dl = qw + r32 - k0 - 4 * hi; asm volatile("" : "+v"(dl));
#pragma unroll
        for (int kb = 0; kb < 2; ++kb) {
            const int kh = k0 + 32 * kb;
            bool act = kh <= qw + 31 && asel, need_mask = kh + 31 > qw;
            if (MODE == 3) { act = act && (kh + 31 >= qw - 128); need_mask = need_mask || (kh < qw + 31 - 128); }
            if (!act) continue;
            f32x16 p;
            if (MODE == 1 || MODE == 3) { const LAS float* lp = aux + ((MODE == 1 ? 4095 : 255) - dl);
#pragma unroll
                for (int r = 0; r < 16; ++r) p[r] = lp[crow(r) + 32 * kb];
            } else {
#pragma unroll
                for (int r = 0; r < 16; ++r) p[r] = 0.f;
            }
            const LAS char* kb_ = lds + ks * KSLOT + kb * (32 * 144) + kfo;
#pragma unroll
            for (int d0 = 0; d0 < 4; ++d0) p = MFMA32(*(const LAS bf16x8*)(kb_ + d0 * 32), qf[d0], p);
            if (MODE == 2) { const LAS char* rb_ = lds + ks * RSLOT + kb * (32 * 80) + rfo;
#pragma unroll
                for (int d0 = 0; d0 < 2; ++d0) p = MFMA32(*(const LAS bf16x8*)(rb_ + d0 * 32), qf[4 + d0], p); }
            if (MODE == 0) p = MFMA32(*(const LAS bf16x8*)(lds + (hi ? (L_KR + 3072) : (L_KR + ks * 1024 + kb * 512 + r32 * 16))), qx, p);
            if (need_mask) {
#pragma unroll
                for (int r = 0; r < 16; ++r) { const int rel = dl - crow(r) - 32 * kb; const bool v = MODE == 3 ? ((unsigned)rel <= 128u) : (rel >= 0); p[r] = v ? p[r] : -INFINITY; }
            }
            float ps = 0.f;
            if (fast) {
#pragma unroll
                for (int r = 0; r < 16; ++r) { p[r] = __builtin_amdgcn_exp2f(p[r]); ps += p[r]; }
            } else {
                float mx = fmaxf(p[0], p[1]);
#pragma unroll
                for (int r = 2; r < 16; ++r) mx = fmaxf(mx, p[r]);
                mx = swap_max(mx);
                if (MODE == 1) mx = selected ? mx : NEGBIG;
                if (__any(mx > m + THR)) {
                    const float mn = fmaxf(m, mx), alpha = __builtin_amdgcn_exp2f(m - mn); m = mn; lsum *= alpha;
#pragma unroll
                    for (int r = 0; r < 16; ++r) { o0[r] *= alpha; o1[r] *= alpha; }
                }
#pragma unroll
                for (int r = 0; r < 16; ++r) { p[r] = __builtin_amdgcn_exp2f(p[r] - m); ps += p[r]; }
            }
            u32x4 w0, w1;
            w0.x = cvt2(p[0], p[1]); w0.y = cvt2(p[2], p[3]); w0.z = cvt2(p[4], p[5]); w0.w = cvt2(p[6], p[7]);
            w1.x = cvt2(p[8], p[9]); w1.y = cvt2(p[10], p[11]); w1.z = cvt2(p[12], p[13]); w1.w = cvt2(p[14], p[15]);
            if (MODE == 1) { const unsigned mk = selected ? 0xffffffffu : 0u; ps = selected ? ps : 0.f; w0 = w0 & mk; w1 = w1 & mk; }
            lsum += ps;
            const bf16x8 pb0 = __builtin_bit_cast(bf16x8, w0), pb1 = __builtin_bit_cast(bf16x8, w1);
            const LAS char* vb_ = lds + vs * 8192 + vfo + kb * 2048;
            { const s16x4 a0 = vtr(vb_), a1 = vtr(vb_ + 512), c0 = vtr(vb_ + 4096), c1 = vtr(vb_ + 4096 + 512);
              o0 = MFMA32(__builtin_shufflevector(a0, a1, 0, 1, 2, 3, 4, 5, 6, 7), pb0, o0); o1 = MFMA32(__builtin_shufflevector(c0, c1, 0, 1, 2, 3, 4, 5, 6, 7), pb0, o1); }
            { const s16x4 a0 = vtr(vb_ + 1024), a1 = vtr(vb_ + 1024 + 512), c0 = vtr(vb_ + 4096 + 1024), c1 = vtr(vb_ + 4096 + 1024 + 512);
              o0 = MFMA32(__builtin_shufflevector(a0, a1, 0, 1, 2, 3, 4, 5, 6, 7), pb1, o0); o1 = MFMA32(__builtin_shufflevector(c0, c1, 0, 1, 2, 3, 4, 5, 6, 7), pb1, o1); }
        }
    };

    if (MODE == 0) { ATT_LOADK(t_lo, kA, rA); ATT_LOADK(t_lo + 1, kB, rB); }
    ATT_DMAV(t_lo, 0); ATT_DMAV(t_lo + 1, 1);
    ATT_WRITEK(0, t_lo, kA, rA); ATT_WRITEK(1, t_lo + 1, kB, rB);
    __syncthreads();
    ATT_LOADK(t_lo + 2, kA, rA);
    int ks0 = 0, ks1 = 1, ks2 = 2, vs = 0;
    bool pend = is_full(t_lo);
    f32x16 sa0, sa1, sb0, sb1;
    if (pend) { stage_a(t_lo, 0, 0, sa0); stage_a(t_lo, 0, 1, sa1); }
    auto advance = [&](const int t) {
        ATT_WRITEK(ks2, t + 2, kA, rA);
        __syncthreads();
        ATT_DMAV(t + 2, vs); ATT_LOADK(t + 3, kA, rA);
        { const int tmp = ks0; ks0 = ks1; ks1 = ks2; ks2 = tmp; } vs ^= 1;
    };
    auto steady = [&](const int t, f32x16& c0, f32x16& c1, f32x16& n0, f32x16& n1) {
        u32x4 wa, wb, wc, wd;
        stage_a(t + 1, ks1, 0, n0); stage_b(t, c0, wa, wb); __builtin_amdgcn_sched_barrier(0);
        stage_a(t + 1, ks1, 1, n1); stage_c(vs, 0, wa, wb); stage_b(t, c1, wc, wd); __builtin_amdgcn_sched_barrier(0);
        stage_c(vs, 1, wc, wd);
        advance(t);
    };
    int t = t_lo;
    while (t <= t_hi) {
        if (pend) while (t + 2 <= t_hi && is_full(t + 1) && is_full(t + 2)) { steady(t, sa0, sa1, sb0, sb1); steady(t + 1, sb0, sb1, sa0, sa1); t += 2; }
        const bool nxt = (t + 1 <= t_hi) && is_full(t + 1);
        if (pend) { u32x4 wa, wb; stage_b(t, sa0, wa, wb); stage_c(vs, 0, wa, wb); stage_b(t, sa1, wa, wb); stage_c(vs, 1, wa, wb); } else general(t, ks0, vs);
        if (nxt) { stage_a(t + 1, ks1, 0, sa0); stage_a(t + 1, ks1, 1, sa1); }
        pend = nxt;
        advance(t);
        ++t;
    }
#undef ATT_LOADK
#undef ATT_DMAV
#undef ATT_WRITEK
    const int te_ = ltid(), r32e = te_ & 31, hie = (te_ >> 5) & 1, qwe = q0 + 32 * (te_ >> 6);
    const float ltot = swap_sum(lsum), inv = 1.0f / ltot;
    if (MODE != 3) {
        const size_t tok = (size_t)b * SEQ + qwe + r32e; const int colbase = (MODE == 0 ? 0 : (MODE == 1 ? 256 : 768)) + h * 64 + 4 * hie;
        const bf16_t* G = (const bf16_t*)((const char*)P.out + OOFF_G) + tok * DM + colbase; bf16_t* A2 = (bf16_t*)(P.ws + OFF_A2) + tok * DM + colbase;
#pragma unroll
        for (int g = 0; g < 4; ++g) {
            const u32x2 g0 = *(const u32x2*)(G + 8 * g), g1 = *(const u32x2*)(G + 32 + 8 * g); u32x2 w0, w1;
            w0.x = cvt2(o0[4 * g] * inv * bflo(g0.x), o0[4 * g + 1] * inv * bfhi(g0.x)); w0.y = cvt2(o0[4 * g + 2] * inv * bflo(g0.y), o0[4 * g + 3] * inv * bfhi(g0.y));
            w1.x = cvt2(o1[4 * g] * inv * bflo(g1.x), o1[4 * g + 1] * inv * bfhi(g1.x)); w1.y = cvt2(o1[4 * g + 2] * inv * bflo(g1.y), o1[4 * g + 3] * inv * bfhi(g1.y));
            *(u32x2*)(A2 + 8 * g) = w0; *(u32x2*)(A2 + 32 + 8 * g) = w1; }
    } else {
        const size_t tok = (size_t)b * SEQ + (size_t)(qwe + r32e) * dil + res;
        bf16_t* dp = (bf16_t*)(P.ws + OFF_DPART) + ((size_t)pat * NT + tok) * 256 + h * 64 + 4 * hie;
#pragma unroll
        for (int g = 0; g < 4; ++g) { u32x2 w0, w1;
            w0.x = cvt2(o0[4 * g] * inv, o0[4 * g + 1] * inv); w0.y = cvt2(o0[4 * g + 2] * inv, o0[4 * g + 3] * inv);
            w1.x = cvt2(o1[4 * g] * inv, o1[4 * g + 1] * inv); w1.y = cvt2(o1[4 * g + 2] * inv, o1[4 * g + 3] * inv);
            *(u32x2*)(dp + 8 * g) = w0; *(u32x2*)(dp + 32 + 8 * g) = w1; }
        if (hie == 0) ((float*)(P.ws + OFF_DLSE))[((size_t)pat * NT + tok) * 4 + h] = m + __builtin_amdgcn_logf(ltot);
    }
}

DEVINL void dil_unit(const Params& P, int l, int u, char* smem) {
    LAS char* lds = (LAS char*)smem;
    const int tid = ltid(), lane = tid & 63, r32 = lane & 31, hi = lane >> 5; const int wid = __builtin_amdgcn_readfirstlane(tid >> 6);
    const int pat = u >> 8, v = u & 255, bh = v & 15, w = v >> 4, dil = pat == 0 ? 1 : (pat == 1 ? 4 : 16), res = w % dil, q0 = (w / dil) * 256;
    const int t_lo = (q0 >= 128 ? q0 - 128 : 0) >> 6, t_hi = (q0 + 255) >> 6, nt = t_hi - t_lo + 1;
    const int b = bh >> 2, h = bh & 3, rs = 64 * dil;
    const bf16_t* Qg = (const bf16_t*)(P.ws + OFF_QKV + 6 * SZ_HEADBUF) + ((size_t)bh * SEQ + res) * 64; const bf16_t* Kg = Qg + SZ_HEADBUF / 2; const bf16_t* Vg = Kg + SZ_HEADBUF / 2;
    const int qw = q0 + 32 * wid;
    constexpr int D_KB = 0, D_VB = 6 * KSLOT, D_AUX = D_VB + 6 * 8192;
    LAS float* aux = (LAS float*)(lds + D_AUX);
    __syncthreads();
    const unsigned kgo = (unsigned)((tid >> 3) * rs + (tid & 7) * 8), vgo = (unsigned)(((tid >> 2) & 63) * rs + (tid >> 8) * 32 + (tid & 3) * 8);
    u32x4 kr[6], vr[6];
#pragma unroll
    for (int j = 0; j < 6; ++j) if (j < nt) { kr[j] = *(const u32x4*)(Kg + (size_t)(t_lo + j) * 64 * rs + kgo); vr[j] = *(const u32x4*)(Vg + (size_t)(t_lo + j) * 64 * rs + vgo); }
    bf16x8 qf[4];
    { const bf16_t* qp = Qg + (size_t)(qw + r32) * rs + 8 * hi;
#pragma unroll
      for (int d0 = 0; d0 < 4; ++d0) qf[d0] = *(const bf16x8*)(qp + 16 * d0); }
    { const float* lut = (const float*)(P.ws + OFF_LUT) + (size_t)(4 + h) * 4096;
      if (tid < 320) { const int rel = 255 - tid; aux[tid] = (rel >= 0 && rel * dil < 4096) ? lut[rel * dil] : 0.f; } }
    { const int kws = (tid >> 3) * 144 + (tid & 7) * 16;
#pragma unroll
      for (int j = 0; j < 6; ++j) if (j < nt) { *(LAS u32x4*)(lds + D_KB + j * KSLOT + kws) = kr[j]; *(LAS u32x4*)(lds + D_VB + j * 8192 + tid * 16) = vr[j]; } }
    __syncthreads();
    const int kfo = D_KB + r32 * 144 + hi * 16;
    const int vfo = D_VB + ((lane >> 4) & 1) * 32 + (lane & 3) * 8 + (4 * hi + ((lane & 15) >> 2)) * 64;
    f32x16 o0, o1;
#pragma unroll
    for (int r = 0; r < 16; ++r) { o0[r] = 0.f; o1[r] = 0.f; }
    float lsum = 0.f;
    const int hb_hi = qw >> 5, hb_lo = hb_hi >= 4 ? hb_hi - 4 : 0;
    for (int hb = hb_lo; hb <= hb_hi; ++hb) {
        const int kh = hb * 32, jl = (hb >> 1) - t_lo, kb = hb & 1;
        const bool need_mask = (hb == hb_hi) || (kh < qw + 31 - 128);
        const int dl = qw + r32 - kh - 4 * hi;
        f32x16 p;
        { const LAS float* lp = aux + (255 - dl);
#pragma unroll
          for (int r = 0; r < 16; ++r) p[r] = lp[crow(r)]; }
        const LAS char* kb_ = lds + jl * KSLOT + kb * (32 * 144) + kfo;
#pragma unroll
        for (int d0 = 0; d0 < 4; ++d0) p = MFMA32(*(const LAS bf16x8*)(kb_ + d0 * 32), qf[d0], p);
        if (need_mask) {
#pragma unroll
            for (int r = 0; r < 16; ++r) { const int rel = dl - crow(r); p[r] = ((unsigned)rel <= 128u) ? p[r] : -INFINITY; }
        }
        float ps = 0.f;
#pragma unroll
        for (int r = 0; r < 16; ++r) { p[r] = __builtin_amdgcn_exp2f(p[r]); ps += p[r]; }
        lsum += ps;
        u32x4 w0, w1;
        w0.x = cvt2(p[0], p[1]); w0.y = cvt2(p[2], p[3]); w0.z = cvt2(p[4], p[5]); w0.w = cvt2(p[6], p[7]);
        w1.x = cvt2(p[8], p[9]); w1.y = cvt2(p[10], p[11]); w1.z = cvt2(p[12], p[13]); w1.w = cvt2(p[14], p[15]);
        const LAS char* vb_ = lds + jl * 8192 + vfo + kb * 2048;
        { const s16x4 a0 = vtr(vb_), a1 = vtr(vb_ + 512), c0 = vtr(vb_ + 4096), c1 = vtr(vb_ + 4096 + 512);
          o0 = MFMA32(__builtin_shufflevector(a0, a1, 0, 1, 2, 3, 4, 5, 6, 7), __builtin_bit_cast(bf16x8, w0), o0); o1 = MFMA32(__builtin_shufflevector(c0, c1, 0, 1, 2, 3, 4, 5, 6, 7), __builtin_bit_cast(bf16x8, w0), o1); }
        { const s16x4 a0 = vtr(vb_ + 1024), a1 = vtr(vb_ + 1024 + 512), c0 = vtr(vb_ + 4096 + 1024), c1 = vtr(vb_ + 4096 + 1024 + 512);
          o0 = MFMA32(__builtin_shufflevector(a0, a1, 0, 1, 2, 3, 4, 5, 6, 7), __builtin_bit_cast(bf16x8, w1), o0); o1 = MFMA32(__builtin_shufflevector(c0, c1, 0, 1, 2, 3, 4, 5, 6, 7), __builtin_bit_cast(bf16x8, w1), o1); }
    }
    const float ltot = swap_sum(lsum), inv = 1.0f / ltot;
    const size_t tok = (size_t)b * SEQ + (size_t)(qw + r32) * dil + res;
    bf16_t* dp = (bf16_t*)(P.ws + OFF_DPART) + ((size_t)pat * NT + tok) * 256 + h * 64 + 4 * hi;
#pragma unroll
    for (int g = 0; g < 4; ++g) { u32x2 w0, w1;
        w0.x = cvt2(o0[4 * g] * inv, o0[4 * g + 1] * inv); w0.y = cvt2(o0[4 * g + 2] * inv, o0[4 * g + 3] * inv);
        w1.x = cvt2(o1[4 * g] * inv, o1[4 * g + 1] * inv); w1.y = cvt2(o1[4 * g + 2] * inv, o1[4 * g + 3] * inv);
        *(u32x2*)(dp + 8 * g) = w0; *(u32x2*)(dp + 32 + 8 * g) = w1; }
    if (hi == 0) ((float*)(P.ws + OFF_DLSE))[((size_t)pat * NT + tok) * 4 + h] = __builtin_amdgcn_logf(ltot);
}

DEVINL void dilmix_unit(const Params& P, int u) {
    const int e = u * NTHREADS + ltid(), tok = e >> 5, hd = e & 31, h = hd >> 3, d8 = (hd & 7) * 8;
    const float* ls = (const float*)(P.ws + OFF_DLSE); const bf16_t* dp = (const bf16_t*)(P.ws + OFF_DPART);
    const float l0 = ls[(size_t)tok * 4 + h], l1 = ls[((size_t)NT + tok) * 4 + h], l2 = ls[((size_t)2 * NT + tok) * 4 + h];
    const float mx = fmaxf(l0, fmaxf(l1, l2)); float w0 = __builtin_amdgcn_exp2f(l0 - mx), w1 = __builtin_amdgcn_exp2f(l1 - mx), w2 = __builtin_amdgcn_exp2f(l2 - mx);
    const float inv = 1.0f / (w0 + w1 + w2); w0 *= inv; w1 *= inv; w2 *= inv;
    const size_t off = (size_t)tok * 256 + h * 64 + d8;
    const u32x4 a = *(const u32x4*)(dp + off), b = *(const u32x4*)(dp + (size_t)NT * 256 + off), c = *(const u32x4*)(dp + (size_t)2 * NT * 256 + off);
    const u32x4 g = *(const u32x4*)((const bf16_t*)((const char*)P.out + OOFF_G) + (size_t)tok * DM + 512 + h * 64 + d8);
    u32x4 r;
    r.x = cvt2((w0 * bflo(a.x) + w1 * bflo(b.x) + w2 * bflo(c.x)) * bflo(g.x), (w0 * bfhi(a.x) + w1 * bfhi(b.x) + w2 * bfhi(c.x)) * bfhi(g.x));
    r.y = cvt2((w0 * bflo(a.y) + w1 * bflo(b.y) + w2 * bflo(c.y)) * bflo(g.y), (w0 * bfhi(a.y) + w1 * bfhi(b.y) + w2 * bfhi(c.y)) * bfhi(g.y));
    r.z = cvt2((w0 * bflo(a.z) + w1 * bflo(b.z) + w2 * bflo(c.z)) * bflo(g.z), (w0 * bfhi(a.z) + w1 * bfhi(b.z) + w2 * bfhi(c.z)) * bfhi(g.z));
    r.w = cvt2((w0 * bflo(a.w) + w1 * bflo(b.w) + w2 * bflo(c.w)) * bflo(g.w), (w0 * bfhi(a.w) + w1 * bfhi(b.w) + w2 * bfhi(c.w)) * bfhi(g.w));
    *(u32x4*)((bf16_t*)(P.ws + OFF_A2) + (size_t)tok * DM + 512 + h * 64 + d8) = r;
}


#define XB_TMO      128
#define XB_XCNT(j)  (256  + 64 * (j))
#define XB_XSUB(j)  (1280 + 64 * (j))
#define XB_XGEN(j)  (2304 + 64 * (j))
#define XB_TOP      3328
#define XB_TOPGEN   3392
#define XCD_BAR_WORDS 3456
#define XB_SPIN_CAP (1u << 20)
DEVINL unsigned xb_ld(unsigned* p) { return __hip_atomic_load(p, __ATOMIC_RELAXED, __HIP_MEMORY_SCOPE_AGENT); }
DEVINL unsigned xb_add(unsigned* p, unsigned v) { return __hip_atomic_fetch_add(p, v, __ATOMIC_RELAXED, __HIP_MEMORY_SCOPE_AGENT); }
DEVINL unsigned xb_xcc_id() { return (unsigned)__builtin_amdgcn_s_getreg((3 << 11) | 20) & 0xFu; }
#define XB_SPIN(cond, bar) do { unsigned _sp = 0; while (cond) { __builtin_amdgcn_s_sleep(1); \
    if ((++_sp & 255u) == 0u) { if (xb_ld(&(bar)[XB_TMO])) break; if (_sp > XB_SPIN_CAP) { atomicAdd(&(bar)[XB_TMO], 1u); break; } } } } while (0)
DEVINL void xcd_barrier_post(unsigned* bar) { if (ltid() == 0) (void)xb_add(&bar[XB_XCNT(xb_xcc_id())], 1u); }
DEVINL void xcd_barrier_complete(unsigned* bar, unsigned x, unsigned& nloc, unsigned& nx) {
    const unsigned G = gridDim.x * gridDim.y * gridDim.z;
    unsigned sum, cnt, mine, sp = 0u;
    for (;;) {
        sum = 0u; cnt = 0u; mine = 0u;
        for (unsigned j = 0; j < 16; ++j) { const unsigned c = xb_ld(&bar[XB_XCNT(j)]); sum += c; cnt += (c > 0u) ? 1u : 0u; mine = (j == x) ? c : mine; }
        if (sum == G) break;
        __builtin_amdgcn_s_sleep(1);
        if ((++sp & 255u) == 0u) { if (xb_ld(&bar[XB_TMO])) break; if (sp > XB_SPIN_CAP) { atomicAdd(&bar[XB_TMO], 1u); break; } }
    }
    nloc = mine > 0u ? mine : 1u; nx = cnt > 0u ? cnt : 1u;
}
DEVINL void xcd_barrier(unsigned* bar_in, volatile LAS unsigned* st) {
    asm volatile("s_waitcnt vmcnt(0)" ::: "memory");
    __syncthreads();
    if (ltid() == 0) {
        unsigned* bar = bar_in;
        const unsigned x = xb_xcc_id();
        __builtin_amdgcn_s_waitcnt(0);
        unsigned nloc = st[0], nx = st[1];
        if (nloc == 0u) { xcd_barrier_complete(bar, x, nloc, nx); st[0] = nloc; st[1] = nx; }
        const unsigned old = xb_add(&bar[XB_XSUB(x)], 1u);
        const unsigned gen = old / nloc;
        if (old + 1u == (gen + 1u) * nloc) {
            __builtin_amdgcn_fence(__ATOMIC_RELEASE, "agent");
            asm volatile("s_waitcnt vmcnt(0)" ::: "memory");
            const unsigned og = xb_add(&bar[XB_TOP], 1u);
            const unsigned tg = og / nx;
            if (og + 1u == (tg + 1u) * nx) xb_add(&bar[XB_TOPGEN], 1u);
            else XB_SPIN(xb_ld(&bar[XB_TOPGEN]) == tg, bar);
            __builtin_amdgcn_fence(__ATOMIC_ACQUIRE, "agent");
            xb_add(&bar[XB_XGEN(x)], 1u);
            asm volatile("s_waitcnt vmcnt(0)" ::: "memory");
        } else {
            XB_SPIN(xb_ld(&bar[XB_XGEN(x)]) == gen, bar);
            __builtin_amdgcn_fence(__ATOMIC_ACQUIRE, "agent");
            asm volatile("s_waitcnt vmcnt(0)" ::: "memory");
        }
    }
    __syncthreads();
}


DEVINL int next_unit(unsigned* ctr, char* smem) {
    int* su = (int*)(smem + L_MISC);
    __syncthreads();
    if (ltid() == 0) *su = (int)atomicAdd(ctr, 1u);
    __syncthreads();
    return *su;
}

template <class Epi> DEVINL void gemm8_sub(const bf16_t* A, const bf16_t* Bt, int M, int N, int K, const Epi& E, char* smem, int G, int c) {
    asm volatile("" : "+s"(G), "+s"(c));
    pg8::Gemm g{A, Bt, M, N, K}; pg8::StaticOrder S; S.init(M, N, G, c);
    pg8::gemm_phase<Epi, pg8::StaticOrder, true, true>((PG8_LAS unsigned char*)smem, g, S, E);
}
DEVINL void phase_pre(const Params& P, int l, char* smem) {
    const int half = (int)gridDim.x >> 1, bid = (int)blockIdx.x;
    if (bid < half) gemm8_sub((const bf16_t*)(P.ws + OFF_CQ), (const bf16_t*)(P.ws + OFF_WT_UQ + l * SZ_WT_UQ), NT, 512, 256, EpiUq8{P, l}, smem, half, bid);
    else gemm8_sub((const bf16_t*)(P.ws + OFF_CKV), (const bf16_t*)(P.ws + OFF_WT_UKV + l * SZ_WT_UKV), NT, 512, 256, EpiUkv8{P, l}, smem, (int)gridDim.x - half, bid - half);
    for (int u = blockIdx.x; u < 256; u += gridDim.x) kmean_unit(P, u, smem);
}
DEVINL void phase_att(const Params& P, int l, char* smem, int rep) {
    unsigned* ctr = (unsigned*)(P.ws + OFF_CTR) + l * 2 + rep * 8;
    constexpr int N_ATT = 384 + 256 + 96 + 768 + 32; const int n_all = N_ATT + (l == 0 ? PREP_PER_LAYER + PREP_P_UNITS / 2 : 0);
    for (;;) {
#ifdef PROBE_CLS
        const unsigned long long tq0 = __builtin_amdgcn_s_memrealtime(); int cls = 4;
#define PCLS(c) cls = (c);
#else
#define PCLS(c)
#endif
        int u = next_unit(ctr, smem); if (u >= n_all) break;
        if (u >= N_ATT) { __syncthreads(); if (u - N_ATT < PREP_PER_LAYER) prep_w_unit(P, 1, u - N_ATT, (float*)smem); else prep_p_unit(P, PREP_P_UNITS / 2 + (u - N_ATT - PREP_PER_LAYER)); }
        else if (u >= 384 && u < 640) { PCLS(0) attn_unit<0>(P, l, u - 384, smem); }
        else if (u >= 736 && u < 736 + 768) { PCLS(3) if (((const float*)(P.ws + OFF_BOUND))[l * 4 + 3] < 100.0f) dil_unit(P, l, u - 736, smem); else attn_unit<3>(P, l, u - 736, smem); }
        else {
            if (u >= 736 + 768) u -= 768; if (u >= 640) u -= 256;
            const int g = u >> 5, r = u & 31, uu = g * 16 + (r & 15);
            if (r < 16) { PCLS(2) attn_unit<2>(P, l, uu, smem); } else { PCLS(1) attn_unit<1>(P, l, uu, smem); } }
#ifdef PROBE_CLS
        if (blockIdx.x == PROBE_BLK && cls == PROBE_CLS && ltid() == 0) { LAS unsigned* pa = (LAS unsigned*)((LAS char*)smem + L_MISC + 32); pa[0] += (unsigned)(__builtin_amdgcn_s_memrealtime() - tq0); pa[1] += 1u; }
#endif
#undef PCLS
    }
}

template <int PH> DEVINL void run_phase(int l, char* smem, int rep = 0) {
    asm volatile("" : "+s"(l));
    const __attribute__((address_space(4))) Params* kp = (const __attribute__((address_space(4))) Params*)__builtin_amdgcn_kernarg_segment_ptr(); asm volatile("" : "+s"(kp));
    Params P;
    P.x = (const float*)as_global(kp->x); P.p = (const float*)as_global(kp->p); P.ln_g = (const float*)as_global(kp->ln_g); P.w_in = (const float*)as_global(kp->w_in); P.b_forget = (const float*)as_global(kp->b_forget);
    P.qk_gain = (const float*)as_global(kp->qk_gain); P.mla_q_norm = (const float*)as_global(kp->mla_q_norm); P.mla_kv_norm = (const float*)as_global(kp->mla_kv_norm); P.mla_nope_gain = (const float*)as_global(kp->mla_nope_gain);
    P.mla_rope_gain = (const float*)as_global(kp->mla_rope_gain); P.w_uq = (const float*)as_global(kp->w_uq); P.w_ukv = (const float*)as_global(kp->w_ukv); P.w_out = (const float*)as_global(kp->w_out); P.rel_bias = (const float*)as_global(kp->rel_bias);
    P.ple_norm_g = (const float*)as_global(kp->ple_norm_g); P.w_ple_gate = (const float*)as_global(kp->w_ple_gate); P.w_ple_proj = (const float*)as_global(kp->w_ple_proj); P.out = (float*)as_global(kp->out); P.ws = as_global(kp->ws);
    char* ws = P.ws;
    const bf16_t* xbase = l == 0 ? (const bf16_t*)nullptr : (const bf16_t*)(ws + OFF_H);
    float* xout = l == 0 ? (float*)nullptr : P.out;
    if (PH == 0) phase_prep(P, smem);
    if (PH == 2) { gemm8((const bf16_t*)(ws + OFF_H), (const bf16_t*)(ws + OFF_WT_IN + l * SZ_WT_IN), NT, NP1, 1024, EpiIn8{P, l}, smem);
                   const int G_ = (int)gridDim.x, w0_ = G_ > 192 ? 192 : 0;
                   if (l == 0 && (int)blockIdx.x >= w0_) { __syncthreads(); constexpr int W0 = PREP_T_IN + PREP_T_UQ + PREP_T_UKV, NWL = PREP_PER_LAYER - W0;
                       for (int u = (int)blockIdx.x - w0_; u < NWL + PREP_P_UNITS / 2; u += G_ - w0_) { if (u < NWL) prep_w_unit(P, 0, W0 + u, (float*)smem); else prep_p_unit(P, u - NWL); } } }
    if (PH == 3) phase_pre(P, l, smem);
    if (PH == 4) phase_att(P, l, smem, rep);
    if (PH == 5) { for (int u = blockIdx.x; u < 1024; u += gridDim.x) dilmix_unit(P, u);
                 }
    if (PH == 8) gemm8((const bf16_t*)(ws + OFF_A2), (const bf16_t*)(ws + OFF_WT_OUT + l * SZ_WT_SQ), NT, 1024, 1024, EpiResid8{P.x, xbase, (bf16_t*)(ws + OFF_XABF), (float*)(ws + OFF_SSQA)}, smem);
    if (PH == 7) { gemm8((const bf16_t*)(ws + (l == 0 ? OFF_PB : OFF_PB2)), (const bf16_t*)(ws + OFF_WT_PP + l * SZ_WT_PP), NT, 1024, 256, EpiStoreBf{(bf16_t*)(ws + OFF_QKV)}, smem);
                   __syncthreads();
                   gemm8((const bf16_t*)(ws + OFF_XABF), (const bf16_t*)(ws + OFF_WT_PG + l * SZ_WT_SQ), NT, 1024, 1024, EpiPle8{(const bf16_t*)(ws + OFF_XABF), (const bf16_t*)(ws + OFF_QKV), xout, (const float*)(ws + OFF_SSQA), l == 0 ? (bf16_t*)(ws + OFF_H) : (bf16_t*)nullptr, (float*)(ws + OFF_SSQX)}, smem); }
}

__global__ void __launch_bounds__(NTHREADS) k_mega(Params Parg) {
    char* smem = g_smem;
    { const int t0 = (int)threadIdx.x; if (t0 < 12) ((LAS unsigned*)((LAS char*)smem + L_XB))[t0] = 0u;
      if ((t0 & 63) == 0) *(LAS int*)((LAS char*)smem + L_WTAB + 4u * (unsigned)__builtin_amdgcn_s_getreg(0x2804)) = t0 >> 6; }
    __syncthreads();
    const __attribute__((address_space(4))) Params* kp0 = (const __attribute__((address_space(4))) Params*)__builtin_amdgcn_kernarg_segment_ptr();
    xcd_barrier_post((unsigned*)(as_global(kp0->ws) + OFF_BAR));
#define XBAR() xcd_barrier((unsigned*)(as_global(kp0->ws) + OFF_BAR), (volatile LAS unsigned*)((LAS char*)smem + L_XB))
#ifdef PROBE_IDX
    unsigned long long tA = 0, tB = 0;
#define PT0(i) if (PROBE_IDX == (i)) tA = __builtin_amdgcn_s_memrealtime();
#define PT1(i) if (PROBE_IDX == (i)) tB = __builtin_amdgcn_s_memrealtime();
#else
#define PT0(i)
#define PT1(i)
#endif
    PT0(0) run_phase<0>(0, smem); XBAR(); PT1(0)
    PT0(2) run_phase<2>(0, smem); XBAR(); PT1(2) PT0(3) run_phase<3>(0, smem); XBAR(); PT1(3) PT0(4) run_phase<4>(0, smem); XBAR(); PT1(4)
    PT0(5) run_phase<5>(0, smem); XBAR(); PT1(5) PT0(6) run_phase<8>(0, smem); XBAR(); PT1(6) PT0(8) run_phase<7>(0, smem); XBAR(); PT1(8)
    run_phase<2>(1, smem); XBAR(); run_phase<3>(1, smem); XBAR(); run_phase<4>(1, smem); XBAR(); run_phase<5>(1, smem); XBAR(); run_phase<8>(1, smem); XBAR(); run_phase<7>(1, smem);
#ifdef PROBE_IDX
    if (blockIdx.x == 0) { const unsigned long long t0 = __builtin_amdgcn_s_memrealtime(), want = (tB - tA) * 32ull; while (__builtin_amdgcn_s_memrealtime() - t0 < want) __builtin_amdgcn_s_sleep(32); }
#endif
#undef XBAR
#ifdef PROBE_CLS
    if (blockIdx.x == PROBE_BLK) { __syncthreads(); const LAS unsigned* pa = (const LAS unsigned*)((LAS char*)smem + L_MISC + 32); const unsigned long long tk = pa[0], nt = pa[1] ? pa[1] : 1u;
        const unsigned long long t0 = __builtin_amdgcn_s_memrealtime(), want = tk * 128ull / nt; while (__builtin_amdgcn_s_memrealtime() - t0 < want) __builtin_amdgcn_s_sleep(32); }
#endif
}
}

extern "C" void kernel_launch(void* const* d_in, const int* in_sizes, int n_in, void* d_out, int out_size, void* d_ws, size_t ws_size, hipStream_t stream) {
    Params P{};
    P.x = (const float*)d_in[0]; P.p = (const float*)d_in[1]; P.ln_g = (const float*)d_in[2]; P.w_in = (const float*)d_in[3]; P.b_forget = (const float*)d_in[4]; P.qk_gain = (const float*)d_in[5];
    P.mla_q_norm = (const float*)d_in[6]; P.mla_kv_norm = (const float*)d_in[7]; P.mla_nope_gain = (const float*)d_in[8]; P.mla_rope_gain = (const float*)d_in[9]; P.w_uq = (const float*)d_in[10];
    P.w_ukv = (const float*)d_in[11]; P.w_out = (const float*)d_in[12]; P.rel_bias = (const float*)d_in[13]; P.ple_norm_g = (const float*)d_in[14]; P.w_ple_gate = (const float*)d_in[15]; P.w_ple_proj = (const float*)d_in[16];
    P.out = (float*)d_out; P.ws = (char*)d_ws;
    if (ws_size < WS_NEED) { fprintf(stderr, "workspace too small: %zu < %zu\n", ws_size, (size_t)WS_NEED); return; }
    static int grid_blocks = 0;
    if (!grid_blocks) {
        int dev = 0, cus = 0, per_cu = 0;
        hipGetDevice(&dev);
        hipDeviceGetAttribute(&cus, hipDeviceAttributeMultiprocessorCount, dev);
        hipOccupancyMaxActiveBlocksPerMultiprocessor(&per_cu, k_mega, NTHREADS, 0);
        if (per_cu > 1) per_cu = 1;
        grid_blocks = cus * per_cu;
    }
    hipMemsetAsync((char*)d_ws + OFF_CTR, 0, 512 + 3456 * 4, stream);
    void* args[] = {&P};
    hipError_t e = hipLaunchCooperativeKernel((void*)k_mega, dim3(grid_blocks), dim3(NTHREADS), args, 0, stream);
    if (e != hipSuccess) fprintf(stderr, "cooperative launch failed: %s (grid %d)\n", hipGetErrorString(e), grid_blocks);
}
```

```cpp
#include <hip/hip_runtime.h>
#include <hip/hip_cooperative_groups.h>
#include <cstdint>
#include <cstdio>

#ifndef ONE_LAUNCH
#define ONE_LAUNCH 1
#endif

namespace {
#define DEVINL __device__ __forceinline__
typedef unsigned short bf16_t;
typedef short bf16x8 __attribute__((ext_vector_type(8)));
typedef float f32x4 __attribute__((ext_vector_type(4)));
typedef unsigned u32x2 __attribute__((ext_vector_type(2)));
typedef unsigned u32x4 __attribute__((ext_vector_type(4)));

constexpr int NB = 4, SEQ = 4096, DM = 1024, NT = NB * SEQ, NH = 4, NBH = NB * NH;
constexpr int INW = 3748, NP1 = 3840;
constexpr float EPS = 1e-6f, LOG2E = 1.4426950408889634f;
constexpr float SC_Q = 0.125f * LOG2E;
constexpr float SC_MLA = 0.10206207261596575f * LOG2E;
constexpr int NTHREADS = 512;

constexpr size_t SZ_WT_IN = (size_t)NP1 * 1024 * 2, SZ_WT_UQ = 512 * 256 * 2  , SZ_WT_UKV = 512 * 256 * 2  , SZ_WT_SQ = 1024 * 1024 * 2, SZ_WT_PP = 1024 * 256 * 2;
constexpr size_t OFF_WT_IN = 0;
constexpr size_t OFF_WT_UQ = OFF_WT_IN + 2 * SZ_WT_IN;
constexpr size_t OFF_WT_UKV = OFF_WT_UQ + 2 * SZ_WT_UQ;
constexpr size_t OFF_WT_OUT = OFF_WT_UKV + 2 * SZ_WT_UKV;
constexpr size_t OFF_WT_PG = OFF_WT_OUT + 2 * SZ_WT_SQ;
constexpr size_t OFF_WT_PP = OFF_WT_PG + 2 * SZ_WT_SQ;
constexpr size_t OFF_LUT = OFF_WT_PP + 2 * SZ_WT_PP;
constexpr size_t OFF_ROPE = OFF_LUT + 8 * 4096 * 4;
constexpr size_t OFF_H = OFF_ROPE + 4096 * 16 * 8;
constexpr size_t SZ_HEADBUF = (size_t)NT * 256 * 2;
constexpr size_t OFF_QKV = OFF_H + (size_t)NT * 1024 * 2;
constexpr size_t OFF_XABF = OFF_QKV + (size_t)NT * 1024 * 2;
constexpr size_t OFF_CQ = OFF_QKV + 9 * SZ_HEADBUF;
constexpr size_t OFF_CKV = OFF_CQ + (size_t)NT * 256 * 2;
constexpr size_t OFF_CQSS = OFF_CKV + (size_t)NT * 256 * 2;
constexpr size_t OFF_CKVSS = OFF_CQSS + (size_t)NT * 4 * 4;
constexpr size_t OFF_LOGF = OFF_CKVSS + (size_t)NT * 2 * 4;
constexpr size_t OFF_KMEAN = OFF_LOGF + (size_t)NBH * SEQ * 4;
constexpr size_t OFF_PB = OFF_KMEAN + (size_t)NBH * 16 * 64 * 4;
constexpr size_t OFF_X = OFF_PB + (size_t)NT * 256 * 2;
constexpr size_t OFF_A2 = OFF_X;
constexpr size_t OFF_PB2 = OFF_X + (size_t)NT * 1024 * 4;
constexpr size_t OFF_SSQX = OFF_PB2 + (size_t)NT * 256 * 2;
constexpr size_t OFF_SSQA = OFF_SSQX + (size_t)NT * 16 * 4;
constexpr size_t OFF_DPART = OFF_SSQA + (size_t)NT * 16 * 4;
constexpr size_t OFF_DLSE = OFF_DPART + 3 * (size_t)NT * 256 * 2;
constexpr size_t OFF_CTR = OFF_DLSE + 3 * (size_t)NT * 4 * 4;
constexpr size_t OFF_BOUND = OFF_CTR + 256;
constexpr size_t OFF_BAR = OFF_BOUND + 256;
constexpr size_t WS_NEED = OFF_BAR + 3456 * 4;
constexpr size_t OOFF_G = 0;
constexpr size_t OOFF_QM = (size_t)NT * 1024 * 2;
constexpr size_t OOFF_KM = OOFF_QM + (size_t)NBH * SEQ * 96 * 2;
constexpr size_t OOFF_VM = OOFF_KM + (size_t)NBH * SEQ * 96 * 2;

struct Params {
    const float *x, *p, *ln_g, *w_in, *b_forget, *qk_gain, *mla_q_norm, *mla_kv_norm, *mla_nope_gain, *mla_rope_gain, *w_uq, *w_ukv, *w_out, *rel_bias, *ple_norm_g, *w_ple_gate, *w_ple_proj;
    float* out;
    char* ws;
};

DEVINL char* as_global(const void* p) { __attribute__((address_space(1))) char* g; asm volatile("" : "=s"(g) : "0"(p)); return (char*)g; }
constexpr int L_MISC = 131072;
constexpr int L_XB = L_MISC + 16, L_WTAB = L_MISC + 64, SMEM_BYTES = L_MISC + 64 + 256;
__shared__ __attribute__((aligned(16))) char g_smem[SMEM_BYTES];
DEVINL int ltid() {
    const unsigned hw = (unsigned)__builtin_amdgcn_s_getreg(0x2804);
    const int w = __builtin_amdgcn_readfirstlane(*(const __attribute__((address_space(3))) int*)((__attribute__((address_space(3))) char*)g_smem + L_WTAB + hw * 4));
    int lane; asm volatile("v_mbcnt_lo_u32_b32 %0, -1, 0\n\tv_mbcnt_hi_u32_b32 %0, -1, %0" : "=v"(lane));
    return w * 64 + lane; }
DEVINL float shx(float v, int mask) { return __int_as_float(__builtin_amdgcn_ds_bpermute(((ltid() & 63) ^ mask) << 2, __float_as_int(v))); }
DEVINL float shup(float v, int o) { return __int_as_float(__builtin_amdgcn_ds_bpermute(((ltid() & 63) - o) << 2, __float_as_int(v))); }
DEVINL float sq4(const f32x4& a) { return a[0] * a[0] + a[1] * a[1] + a[2] * a[2] + a[3] * a[3]; }
template <int XM> DEVINL float swz_xor(float v) { return __int_as_float(__builtin_amdgcn_ds_swizzle(__float_as_int(v), (XM << 10) | 0x1F)); }
DEVINL float half_swap_sum(float v) { auto rr = __builtin_amdgcn_permlane32_swap(__float_as_uint(v), __float_as_uint(v), false, false); return __uint_as_float(rr[0]) + __uint_as_float(rr[1]); }
DEVINL float wave_sum(float v) { v += swz_xor<1>(v); v += swz_xor<2>(v); v += swz_xor<4>(v); v += swz_xor<8>(v); v += swz_xor<16>(v); return half_swap_sum(v); }
DEVINL bf16_t f2bf(float f) { unsigned u = __float_as_uint(f); u += 0x7fffu + ((u >> 16) & 1u); return (bf16_t)(u >> 16); }
DEVINL float bf2f(bf16_t h) { return __uint_as_float(((unsigned)h) << 16); }
DEVINL unsigned pack2(float a, float b) { return (unsigned)f2bf(a) | ((unsigned)f2bf(b) << 16); }
typedef __bf16 bf16v2 __attribute__((ext_vector_type(2)));
typedef float f32v2 __attribute__((ext_vector_type(2)));
DEVINL unsigned cvt2(float a, float b) { f32v2 v = {a, b}; return __builtin_bit_cast(unsigned, __builtin_convertvector(v, bf16v2)); }
DEVINL float bflo(unsigned u) { return __uint_as_float(u << 16); }
DEVINL float bfhi(unsigned u) { return __uint_as_float(u & 0xffff0000u); }

__device__ __constant__ float ROPE_INV[16] = {1.0f, 0.5623413251903491f, 0.31622776601683794f, 0.1778279410038923f, 0.1f, 0.05623413251903491f, 0.03162277660168379f, 0.01778279410038923f,
                                              0.01f, 0.005623413251903491f, 0.0031622776601683794f, 0.0017782794100389228f, 0.001f, 0.0005623413251903491f, 0.00031622776601683794f, 0.00017782794100389227f};

DEVINL int t5_bucket(int d) {
    if (d < 16) return d;
    int b = 16;
    b += (d >= 22); b += (d >= 30); b += (d >= 40); b += (d >= 54); b += (d >= 73); b += (d >= 99); b += (d >= 134); b += (d >= 182);
    b += (d >= 246); b += (d >= 332); b += (d >= 450); b += (d >= 609); b += (d >= 825); b += (d >= 1117); b += (d >= 1513);
    return b;
}

DEVINL int map_w_in(int n) { return n < 768 ? n : (n < 2720 ? n + 4 : (n < 2724 ? n - 2720 + 768 : (n < 2816 ? -1 : n - 92))); }
DEVINL int virt_col(int nv) { const int v = nv & 255; return (nv & ~255) + 64 * ((v >> 5) & 3) + 32 * (v >> 7) + (v & 31); }
DEVINL int map_w_in_virt(int nv) { int a = virt_col(nv); const int chunk = a >> 6; int hc = a & 63;
    if (chunk == 42 && hc < 32) hc = 16 * ((hc >> 2) & 1) + 4 * (hc >> 3) + (hc & 3);
    return map_w_in(chunk * 64 + hc); }
DEVINL int map_w_uq_virt(int nv) { const int a = virt_col(nv), chunk = a >> 6; int hc = a & 63; if (chunk >= 6) return -1;
    if (chunk >= 4) { const int e = hc & 31; hc = (hc & 32) + 16 * ((e >> 2) & 1) + 4 * (e >> 3) + (e & 3); }
    const int n = chunk * 64 + hc; if (n < 256) return (n >> 6) * 96 + (n & 63); const int r = n - 256; return (r >> 5) * 96 + 64 + (r & 31); }
DEVINL int map_w_uq(int n) { if (n < 256) return (n >> 6) * 96 + (n & 63); const int r = n - 256; return (r >> 5) * 96 + 64 + (r & 31); }

template <int KT>
DEVINL void transpose_tile(const float* src, int Nsrc, bf16_t* dst, int K, int tn, int tk, int mode, const float* fold, float* tile  ) {
    const int tid = ltid(), c4 = (tid & 15) * 4, kr = tid >> 4  , n0 = tn * 64, k0 = tk * KT;
    const int n = n0 + c4, oc = mode == 1 ? map_w_in_virt(n) : (mode == 2 ? map_w_uq(n) : (mode == 3 ? virt_col(n) : (mode == 4 ? map_w_uq_virt(n) : (mode == 5 ? virt_col(n) : n))));
    f32x4 v[KT / 32];
#pragma unroll
    for (int i = 0; i < KT / 32; ++i) { const int kk = kr + 32 * i; v[i] = (f32x4){0.f, 0.f, 0.f, 0.f}; if (oc >= 0 && !(mode == 5 && k0 + kk >= 128)) { v[i] = __builtin_nontemporal_load((const f32x4*)(src + (size_t)(k0 + kk) * Nsrc + oc)); if (fold) v[i] = v[i] * fold[k0 + kk]; } }
    __syncthreads();
#pragma unroll
    for (int i = 0; i < KT / 32; ++i) *(f32x4*)(tile + (kr + 32 * i) * 68 + c4) = v[i];
    __syncthreads();
#pragma unroll
    for (int h = 0; h < KT / 64; ++h) { const int nn = tid & 63, kc = h * 64 + (tid >> 6) * 8; const float* tp = tile + kc * 68 + nn; u32x4 w;
      w.x = cvt2(tp[0], tp[68]); w.y = cvt2(tp[136], tp[204]); w.z = cvt2(tp[272], tp[340]); w.w = cvt2(tp[408], tp[476]);
      *(u32x4*)(dst + (size_t)(n0 + nn) * K + k0 + kc) = w; }
}

constexpr int PREP_T_IN = 60 * 4, PREP_T_UQ = 8 * 1, PREP_T_UKV = 8 * 1, PREP_T_SQ = 16 * 4, PREP_T_PP = 16 * 1;
constexpr int PREP_PER_LAYER = PREP_T_IN + PREP_T_UQ + PREP_T_UKV + 2 * PREP_T_SQ + PREP_T_PP;
constexpr int PREP_LUT_UNITS = 8 * 4096 / 512, PREP_ROPE_UNITS = 4096 * 16 / 512;
constexpr int PREP_X_UNITS = NT / 32, PREP_P_UNITS = 2 * NT / 64;
constexpr int PREP_UNITS = 2 * PREP_PER_LAYER + PREP_LUT_UNITS + PREP_ROPE_UNITS + PREP_X_UNITS + PREP_P_UNITS;

DEVINL void prep_w_unit(const Params& P, int l, int r, float* tile) {
    if (r < PREP_T_IN) { transpose_tile<256>(P.w_in + (size_t)l * 1024 * INW, INW, (bf16_t*)(P.ws + OFF_WT_IN + l * SZ_WT_IN), 1024, r % 60, r / 60, 1, P.ln_g + l * DM, tile); return; }
    r -= PREP_T_IN;
    if (r < PREP_T_UQ) { transpose_tile<256>(P.w_uq + (size_t)l * 256 * 384, 384, (bf16_t*)(P.ws + OFF_WT_UQ + l * SZ_WT_UQ), 256, r % 8, r / 8, 4, P.mla_q_norm + l * 256, tile); return; }
    r -= PREP_T_UQ;
    if (r < PREP_T_UKV) { transpose_tile<256>(P.w_ukv + (size_t)l * 128 * 512, 512, (bf16_t*)(P.ws + OFF_WT_UKV + l * SZ_WT_UKV), 256, r % 8, r / 8, 5, P.mla_kv_norm + l * 128, tile); return; }
    r -= PREP_T_UKV;
    if (r < PREP_T_SQ) { transpose_tile<256>(P.w_out + (size_t)l * 1024 * 1024, 1024, (bf16_t*)(P.ws + OFF_WT_OUT + l * SZ_WT_SQ), 1024, r % 16, r / 16, 3, nullptr, tile); return; }
    r -= PREP_T_SQ;
    if (r < PREP_T_SQ) { transpose_tile<256>(P.w_ple_gate + (size_t)l * 1024 * 1024, 1024, (bf16_t*)(P.ws + OFF_WT_PG + l * SZ_WT_SQ), 1024, r % 16, r / 16, 3, P.ple_norm_g + l * DM, tile); return; }
    r -= PREP_T_SQ;
    transpose_tile<256>(P.w_ple_proj + (size_t)l * 256 * 1024, 1024, (bf16_t*)(P.ws + OFF_WT_PP + l * SZ_WT_PP), 256, r % 16, r / 16, 3, nullptr, tile);
}
DEVINL void prep_p_unit(const Params& P, int v) {
    const int wid = ltid() >> 6, lane = ltid() & 63; f32x4 a[8];
#pragma unroll
    for (int rr = 0; rr < 8; ++rr) a[rr] = __builtin_nontemporal_load((const f32x4*)(P.p + (size_t)(v * 64 + wid * 8 + rr) * 256 + lane * 4));
#pragma unroll
    for (int rr = 0; rr < 8; ++rr) { const int row = v * 64 + wid * 8 + rr; u32x2 w; w.x = cvt2(a[rr][0], a[rr][1]); w.y = cvt2(a[rr][2], a[rr][3]);
        bf16_t* pb = row < NT ? (bf16_t*)(P.ws + OFF_PB) + (size_t)row * 256 : (bf16_t*)(P.ws + OFF_PB2) + (size_t)(row - NT) * 256; *(u32x2*)(pb + lane * 4) = w; }
}
DEVINL void phase_prep(const Params& P, char* smem) {
    float* tile = (float*)smem;
    if (blockIdx.x == 0) {
        const int w_ = ltid() >> 6, ln_ = ltid() & 63, l = w_ >> 2, md = w_ & 3; float bound;
        auto amax = [&](const float* p, int n) { float a = 0.f; for (int i = ln_; i < n; i += 64) a = fmaxf(a, fabsf(p[i]));
            a = fmaxf(a, swz_xor<1>(a)); a = fmaxf(a, swz_xor<2>(a)); a = fmaxf(a, swz_xor<4>(a)); a = fmaxf(a, swz_xor<8>(a)); a = fmaxf(a, swz_xor<16>(a));
            auto rr = __builtin_amdgcn_permlane32_swap(__float_as_uint(a), __float_as_uint(a), false, false); return fmaxf(__uint_as_float(rr[0]), __uint_as_float(rr[1])); };
        if (md == 2) { const float nq = amax(P.mla_nope_gain + (l * 2 + 0) * 64, 64), nk = amax(P.mla_nope_gain + (l * 2 + 1) * 64, 64), rq = amax(P.mla_rope_gain + (l * 2 + 0) * 32, 32), rk = amax(P.mla_rope_gain + (l * 2 + 1) * 32, 32);
            bound = sqrtf(64.f * nq * nq + 32.f * rq * rq) * sqrtf(64.f * nk * nk + 32.f * rk * rk) * SC_MLA; }
        else { const int mix = md == 0 ? 0 : (md == 1 ? 1 : 2); bound = 64.f * amax(P.qk_gain + (l * 6 + 2 * mix) * 64, 64) * amax(P.qk_gain + (l * 6 + 2 * mix + 1) * 64, 64) * SC_Q;
            if (md == 0) bound += 8.f; else bound += amax(P.rel_bias, 256) * LOG2E; }
        if (ln_ == 0) ((float*)(P.ws + OFF_BOUND))[l * 4 + md] = bound;
    }
    constexpr int U_W = PREP_PER_LAYER, U_LUT = U_W + PREP_LUT_UNITS, U_ROPE = U_LUT + PREP_ROPE_UNITS, U_X = U_ROPE + PREP_X_UNITS, U_P = U_X + PREP_P_UNITS / 2;
    for (int u = blockIdx.x; u < U_P; u += gridDim.x) {
        if (u < U_W) { if (u < PREP_T_IN + PREP_T_UQ + PREP_T_UKV) prep_w_unit(P, 0, u, tile); }
        else if (u < U_LUT) { const int e = (u - U_W) * 512 + ltid(), hh = e >> 12, d = e & 4095; ((float*)(P.ws + OFF_LUT))[e] = P.rel_bias[t5_bucket(d) * 8 + hh] * LOG2E; }
        else if (u < U_ROPE) { const int e = (u - U_LUT) * 512 + ltid(), pos = e >> 4, i = e & 15;
            const double rev = (double)pos * (double)ROPE_INV[i] * 0.15915494309189535; const float fr = (float)(rev - floor(rev));
            ((float2*)(P.ws + OFF_ROPE))[e] = make_float2(__builtin_amdgcn_cosf(fr), __builtin_amdgcn_sinf(fr)); }
        else if (u < U_X) { const int v = u - U_ROPE, wid = ltid() >> 6, lane = ltid() & 63;
            f32x4 a[4][4];
#pragma unroll
            for (int rr = 0; rr < 4; ++rr)
#pragma unroll
                for (int i = 0; i < 4; ++i) a[rr][i] = __builtin_nontemporal_load((const f32x4*)(P.x + (size_t)(v * 32 + wid * 4 + rr) * DM + i * 256 + lane * 4));
#pragma unroll
            for (int rr = 0; rr < 4; ++rr) { const int row = v * 32 + wid * 4 + rr; float ss = 0.f;
#pragma unroll
                for (int i = 0; i < 4; ++i) { ss += sq4(a[rr][i]); u32x2 w; w.x = cvt2(a[rr][i][0], a[rr][i][1]); w.y = cvt2(a[rr][i][2], a[rr][i][3]); *(u32x2*)((bf16_t*)(P.ws + OFF_H) + (size_t)row * DM + i * 256 + lane * 4) = w; }
                ss = wave_sum(ss); if (lane < 16) ((float*)(P.ws + OFF_SSQX))[(size_t)row * 16 + lane] = lane == 0 ? ss : 0.f;
                if (lane < 16) *(u32x4*)((bf16_t*)(P.ws + OFF_CKV) + (size_t)row * 256 + 128 + lane * 8) = (u32x4){0u, 0u, 0u, 0u}; } }
        else {   }
    }
}

DEVINL void phase_rms(const float* src, const float* g, bf16_t* dst, const float* psrc, bf16_t* pb) {
    const int wid = ltid() >> 6, lane = ltid() & 63;
    for (int u = blockIdx.x; u < NT / 8; u += gridDim.x) {
        const int row = u * 8 + wid; const float* xr = src + (size_t)row * DM;
        f32x4 v[4]; float ss = 0.f;
#pragma unroll
        for (int i = 0; i < 4; ++i) { v[i] = *(const f32x4*)(xr + i * 256 + lane * 4); ss += v[i][0] * v[i][0] + v[i][1] * v[i][1] + v[i][2] * v[i][2] + v[i][3] * v[i][3]; }
        ss = wave_sum(ss); const float r = rsqrtf(ss * (1.0f / DM) + EPS);
#pragma unroll
        for (int i = 0; i < 4; ++i) { const f32x4 gg = *(const f32x4*)(g + i * 256 + lane * 4); u32x2 w; w.x = pack2(v[i][0] * r * gg[0], v[i][1] * r * gg[1]); w.y = pack2(v[i][2] * r * gg[2], v[i][3] * r * gg[3]);
            *(u32x2*)(dst + (size_t)row * DM + i * 256 + lane * 4) = w; }
        if (psrc) { const f32x4 pv = *(const f32x4*)(psrc + (size_t)row * 256 + lane * 4); u32x2 w; w.x = pack2(pv[0], pv[1]); w.y = pack2(pv[2], pv[3]); *(u32x2*)(pb + (size_t)row * 256 + lane * 4) = w; }
    }
}

constexpr int GST = 40;
template <class Epi>
DEVINL void gemm_phase(const bf16_t* A, const bf16_t* Bt, int M, int N, int K, const Epi& epi, char* smem) {
    bf16_t* As = (bf16_t*)smem; bf16_t* Bs = As + 256 * GST;
    const int tid = ltid(), wid = tid >> 6, lane = tid & 63, wr = wid >> 1, wc = wid & 1, fr = lane & 15, fq = lane >> 4;
    const int ntm = M / 256, ntn = N / 128, nk = K / 32;
    const int lr = tid >> 2, lc = (tid & 3) * 8;
    for (int tile = blockIdx.x; tile < ntm * ntn; tile += gridDim.x) {
        const int tm = tile % ntm, tn = tile / ntm;
        const bf16_t* Ag = A + (size_t)(tm * 256 + lr) * K + lc; const bf16_t* Bg = Bt + (size_t)(tn * 128 + lr) * K + lc;
        f32x4 acc[4][4];
#pragma unroll
        for (int m = 0; m < 4; ++m)
#pragma unroll
            for (int n = 0; n < 4; ++n) acc[m][n] = (f32x4){0.f, 0.f, 0.f, 0.f};
        u32x4 ra0 = *(const u32x4*)Ag, ra1 = *(const u32x4*)(Ag + (size_t)128 * K), rb0 = *(const u32x4*)Bg;
        for (int kt = 0; kt < nk; ++kt) {
            __syncthreads();
            *(u32x4*)(As + lr * GST + lc) = ra0; *(u32x4*)(As + (lr + 128) * GST + lc) = ra1; *(u32x4*)(Bs + lr * GST + lc) = rb0;
            __syncthreads();
            if (kt + 1 < nk) { const int ko = (kt + 1) * 32; ra0 = *(const u32x4*)(Ag + ko); ra1 = *(const u32x4*)(Ag + (size_t)128 * K + ko); rb0 = *(const u32x4*)(Bg + ko); }
            bf16x8 af[4], bfr[4];
#pragma unroll
            for (int m = 0; m < 4; ++m) af[m] = *(const bf16x8*)(As + (wr * 64 + m * 16 + fr) * GST + fq * 8);
#pragma unroll
            for (int n = 0; n < 4; ++n) bfr[n] = *(const bf16x8*)(Bs + (wc * 64 + n * 16 + fr) * GST + fq * 8);
#pragma unroll
            for (int m = 0; m < 4; ++m)
#pragma unroll
                for (int n = 0; n < 4; ++n) acc[m][n] = __builtin_amdgcn_mfma_f32_16x16x32_bf16(bfr[n], af[m], acc[m][n], 0, 0, 0);
        }
        epi(acc, tm * 256 + wr * 64, tn * 2 + wc, fr, fq);
    }
    __syncthreads();
}

DEVINL float quad_sum(float v) { v += swz_xor<16>(v); return half_swap_sum(v); }
DEVINL void store4bf(bf16_t* p, float a, float b, float c, float d) { u32x2 w; w.x = pack2(a, b); w.y = pack2(c, d); *(u32x2*)p = w; }
DEVINL float fsigmoid(float z) { return __builtin_amdgcn_rcpf(1.0f + __builtin_amdgcn_exp2f(-LOG2E * z)); }
DEVINL float log_sigmoid(float z) { return fminf(z, 0.f) - log1pf(__expf(-fabsf(z))); }

struct EpiIn {
    Params P; int l;
    DEVINL void operator()(f32x4 (&acc)[4][4], int row0, int chunk, int fr, int fq) const {
        char* ws = P.ws; char* ob = (char*)P.out;
        if (chunk < 36) {
            const int g = chunk >> 2, h = chunk & 3, role = g % 3, mix = g / 3;
            bf16_t* dst = (bf16_t*)(ws + OFF_QKV + (size_t)g * SZ_HEADBUF);
            const float* gain = P.qk_gain + ((size_t)l * 6 + 2 * mix + (role == 1 ? 1 : 0)) * 64;
#pragma unroll
            for (int m = 0; m < 4; ++m) {
                const int t = row0 + 16 * m + fr, b = t >> 12, s = t & 4095; bf16_t* d = dst + ((size_t)(b * 4 + h) * SEQ + s) * 64 + 4 * fq;
                float r = 1.f;
                if (role != 2) { float ss = 0.f;
#pragma unroll
                    for (int n = 0; n < 4; ++n) ss += acc[m][n][0] * acc[m][n][0] + acc[m][n][1] * acc[m][n][1] + acc[m][n][2] * acc[m][n][2] + acc[m][n][3] * acc[m][n][3];
                    ss = quad_sum(ss); r = rsqrtf(ss * (1.0f / 64.0f) + EPS) * (role == 0 ? SC_Q : 1.0f); }
#pragma unroll
                for (int n = 0; n < 4; ++n) { f32x4 gg = (f32x4){1.f, 1.f, 1.f, 1.f}; if (role != 2) gg = *(const f32x4*)(gain + 16 * n + 4 * fq);
                    store4bf(d + 16 * n, acc[m][n][0] * r * gg[0], acc[m][n][1] * r * gg[1], acc[m][n][2] * r * gg[2], acc[m][n][3] * r * gg[3]); }
            }
        } else if (chunk < 42) {
            const bool isq = chunk < 40; const int c = isq ? chunk - 36 : chunk - 40;
            bf16_t* dst = isq ? (bf16_t*)(ws + OFF_CQ) : (bf16_t*)(ws + OFF_CKV); const int ld = isq ? 256 : 128;
            float* ssp = isq ? (float*)(ws + OFF_CQSS) : (float*)(ws + OFF_CKVSS); const int nss = isq ? 4 : 2;
#pragma unroll
            for (int m = 0; m < 4; ++m) {
                const int t = row0 + 16 * m + fr; float ss = 0.f;
#pragma unroll
                for (int n = 0; n < 4; ++n) { ss += acc[m][n][0] * acc[m][n][0] + acc[m][n][1] * acc[m][n][1] + acc[m][n][2] * acc[m][n][2] + acc[m][n][3] * acc[m][n][3];
                    store4bf(dst + (size_t)t * ld + c * 64 + 16 * n + 4 * fq, acc[m][n][0], acc[m][n][1], acc[m][n][2], acc[m][n][3]); }
                ss = quad_sum(ss); if (fq == 0) ssp[(size_t)t * nss + c] = ss;
            }
        } else if (chunk == 42) {
            const float* gr = P.mla_rope_gain + ((size_t)l * 2 + 1) * 32; const float2* rope = (const float2*)(ws + OFF_ROPE);
            bf16_t* km = (bf16_t*)(ob + OOFF_KM); float* logf_ = (float*)(ws + OFF_LOGF);
            const f32x4 g1 = *(const f32x4*)(gr + 4 * fq), g2 = *(const f32x4*)(gr + 16 + 4 * fq); const f32x4 bfv = *(const f32x4*)(P.b_forget + l * 4);
#pragma unroll
            for (int m = 0; m < 4; ++m) {
                const int t = row0 + 16 * m + fr, b = t >> 12, s = t & 4095;
                float ss = 0.f;
#pragma unroll
                for (int n = 0; n < 2; ++n) ss += acc[m][n][0] * acc[m][n][0] + acc[m][n][1] * acc[m][n][1] + acc[m][n][2] * acc[m][n][2] + acc[m][n][3] * acc[m][n][3];
                ss = quad_sum(ss); const float r = rsqrtf(ss * (1.0f / 32.0f) + EPS);
                float o1[4], o2[4];
#pragma unroll
                for (int j = 0; j < 4; ++j) { const float2 cs = rope[s * 16 + 4 * fq + j]; const float x1 = acc[m][0][j] * r * g1[j], x2 = acc[m][1][j] * r * g2[j]; o1[j] = x1 * cs.x - x2 * cs.y; o2[j] = x1 * cs.y + x2 * cs.x; }
#pragma unroll
                for (int h = 0; h < 4; ++h) { bf16_t* d = km + ((size_t)(b * 4 + h) * SEQ + s) * 96 + 64 + 4 * fq; store4bf(d, o1[0], o1[1], o1[2], o1[3]); store4bf(d + 16, o2[0], o2[1], o2[2], o2[3]); }
                if (fq == 0) {
#pragma unroll
                    for (int j = 0; j < 4; ++j) logf_[(size_t)(b * 4 + j) * SEQ + s] = log_sigmoid(acc[m][2][j] + bfv[j]) * LOG2E;
                }
            }
        } else if (chunk >= 44) {
            bf16_t* G = (bf16_t*)(ob + OOFF_G); const int c0 = (chunk - 44) * 64;
#pragma unroll
            for (int m = 0; m < 4; ++m) { const int t = row0 + 16 * m + fr;
#pragma unroll
                for (int n = 0; n < 4; ++n) { float o[4];
#pragma unroll
                    for (int j = 0; j < 4; ++j) { const float z = acc[m][n][j]; o[j] = z / (1.0f + __expf(-z)); }
                    store4bf(G + (size_t)t * DM + c0 + 16 * n + 4 * fq, o[0], o[1], o[2], o[3]); } }
        }
    }
};

struct EpiUq {
    Params P; int l;
    DEVINL void operator()(f32x4 (&acc)[4][4], int row0, int chunk, int fr, int fq) const {
        const float* cqss = (const float*)(P.ws + OFF_CQSS); bf16_t* qm = (bf16_t*)((char*)P.out + OOFF_QM); const float2* rope = (const float2*)(P.ws + OFF_ROPE);
#pragma unroll
        for (int m = 0; m < 4; ++m) {
            const int t = row0 + 16 * m + fr, b = t >> 12, s = t & 4095; const f32x4 pss = *(const f32x4*)(cqss + (size_t)t * 4);
            const float rt = rsqrtf((pss[0] + pss[1] + pss[2] + pss[3]) * (1.0f / 256.0f) + EPS);
            if (chunk < 4) {
                const float* gain = P.mla_nope_gain + ((size_t)l * 2 + 0) * 64; float ss = 0.f;
#pragma unroll
                for (int n = 0; n < 4; ++n) { acc[m][n] = acc[m][n] * rt; ss += acc[m][n][0] * acc[m][n][0] + acc[m][n][1] * acc[m][n][1] + acc[m][n][2] * acc[m][n][2] + acc[m][n][3] * acc[m][n][3]; }
                ss = quad_sum(ss); const float r = rsqrtf(ss * (1.0f / 64.0f) + EPS) * SC_MLA; bf16_t* d = qm + ((size_t)(b * 4 + chunk) * SEQ + s) * 96 + 4 * fq;
#pragma unroll
                for (int n = 0; n < 4; ++n) { const f32x4 gg = *(const f32x4*)(gain + 16 * n + 4 * fq); store4bf(d + 16 * n, acc[m][n][0] * r * gg[0], acc[m][n][1] * r * gg[1], acc[m][n][2] * r * gg[2], acc[m][n][3] * r * gg[3]); }
            } else {
                const float* gr = P.mla_rope_gain + ((size_t)l * 2 + 0) * 32; const f32x4 g1 = *(const f32x4*)(gr + 4 * fq), g2 = *(const f32x4*)(gr + 16 + 4 * fq);
#pragma unroll
                for (int hh = 0; hh < 2; ++hh) {
                    const int h = (chunk - 4) * 2 + hh; float ss = 0.f;
#pragma unroll
                    for (int n = 0; n < 2; ++n) { acc[m][2 * hh + n] = acc[m][2 * hh + n] * rt; const f32x4 a = acc[m][2 * hh + n]; ss += a[0] * a[0] + a[1] * a[1] + a[2] * a[2] + a[3] * a[3]; }
                    ss = quad_sum(ss); const float r = rsqrtf(ss * (1.0f / 32.0f) + EPS);
                    float o1[4], o2[4];
#pragma unroll
                    for (int j = 0; j < 4; ++j) { const float2 cs = rope[s * 16 + 4 * fq + j]; const float x1 = acc[m][2 * hh][j] * r * g1[j], x2 = acc[m][2 * hh + 1][j] * r * g2[j];
                        o1[j] = (x1 * cs.x - x2 * cs.y) * SC_MLA; o2[j] = (x1 * cs.y + x2 * cs.x) * SC_MLA; }
                    bf16_t* d = qm + ((size_t)(b * 4 + h) * SEQ + s) * 96 + 64 + 4 * fq; store4bf(d, o1[0], o1[1], o1[2], o1[3]); store4bf(d + 16, o2[0], o2[1], o2[2], o2[3]);
                }
            }
        }
    }
};
struct EpiUkv {
    Params P; int l;
    DEVINL void operator()(f32x4 (&acc)[4][4], int row0, int chunk, int fr, int fq) const {
        const float* ckvss = (const float*)(P.ws + OFF_CKVSS); bf16_t* km = (bf16_t*)((char*)P.out + OOFF_KM); bf16_t* vm = (bf16_t*)((char*)P.out + OOFF_VM);
        const int h = chunk >> 1; const bool isk = (chunk & 1) == 0; const float* gain = P.mla_nope_gain + ((size_t)l * 2 + 1) * 64;
#pragma unroll
        for (int m = 0; m < 4; ++m) {
            const int t = row0 + 16 * m + fr, b = t >> 12, s = t & 4095; const float rt = rsqrtf((ckvss[(size_t)t * 2] + ckvss[(size_t)t * 2 + 1]) * (1.0f / 128.0f) + EPS);
            float ss = 0.f;
#pragma unroll
            for (int n = 0; n < 4; ++n) { acc[m][n] = acc[m][n] * rt; ss += acc[m][n][0] * acc[m][n][0] + acc[m][n][1] * acc[m][n][1] + acc[m][n][2] * acc[m][n][2] + acc[m][n][3] * acc[m][n][3]; }
            if (isk) { ss = quad_sum(ss); const float r = rsqrtf(ss * (1.0f / 64.0f) + EPS); bf16_t* d = km + ((size_t)(b * 4 + h) * SEQ + s) * 96 + 4 * fq;
#pragma unroll
                for (int n = 0; n < 4; ++n) { const f32x4 gg = *(const f32x4*)(gain + 16 * n + 4 * fq); store4bf(d + 16 * n, acc[m][n][0] * r * gg[0], acc[m][n][1] * r * gg[1], acc[m][n][2] * r * gg[2], acc[m][n][3] * r * gg[3]); }
            } else { bf16_t* d = vm + ((size_t)(b * 4 + h) * SEQ + s) * 64 + 4 * fq;
#pragma unroll
                for (int n = 0; n < 4; ++n) store4bf(d + 16 * n, acc[m][n][0], acc[m][n][1], acc[m][n][2], acc[m][n][3]); }
        }
    }
};
struct EpiResid { const float* base; float* out;
    DEVINL void operator()(f32x4 (&acc)[4][4], int row0, int chunk, int fr, int fq) const {
#pragma unroll
        for (int m = 0; m < 4; ++m) { const size_t o = (size_t)(row0 + 16 * m + fr) * DM + chunk * 64 + 4 * fq;
#pragma unroll
            for (int n = 0; n < 4; ++n) { const f32x4 bv = *(const f32x4*)(base + o + 16 * n); *(f32x4*)(out + o + 16 * n) = bv + acc[m][n]; } } } };
struct EpiStore { float* out;
    DEVINL void operator()(f32x4 (&acc)[4][4], int row0, int chunk, int fr, int fq) const {
#pragma unroll
        for (int m = 0; m < 4; ++m) { const size_t o = (size_t)(row0 + 16 * m + fr) * DM + chunk * 64 + 4 * fq;
#pragma unroll
            for (int n = 0; n < 4; ++n) *(f32x4*)(out + o + 16 * n) = acc[m][n]; } } };
struct EpiPle { const float* xa; const float* pp; float* out;
    DEVINL void operator()(f32x4 (&acc)[4][4], int row0, int chunk, int fr, int fq) const {
#pragma unroll
        for (int m = 0; m < 4; ++m) { const size_t o = (size_t)(row0 + 16 * m + fr) * DM + chunk * 64 + 4 * fq;
#pragma unroll
            for (int n = 0; n < 4; ++n) { const f32x4 xv = *(const f32x4*)(xa + o + 16 * n), pv = *(const f32x4*)(pp + o + 16 * n); f32x4 r;
#pragma unroll
                for (int j = 0; j < 4; ++j) r[j] = xv[j] + pv[j] / (1.0f + __expf(-acc[m][n][j]));
                *(f32x4*)(out + o + 16 * n) = r; } } } };

namespace pg8 {
#define PG8_LAS __attribute__((address_space(3)))
constexpr int BM = 256, BK = 64, HALF = 128, HTB = HALF * BK * 2  , STAGE_BYTES = 8 * HTB, NXCD = 8, WGM = 8;

__host__ __device__ __forceinline__ int lds_byte(int r, int c) { const int st = (r >> 4) * 2 + (c >> 5), rr = r & 15, cc = c & 31, ob = rr * 64 + cc * 2; return st * 1024 + (ob ^ (((ob >> 9) & 1) << 5)); }
__host__ __device__ __forceinline__ void stage_rc(int b, int& R, int& C) { const int st = b / 1024, sb = b % 1024, swz = sb ^ (((sb >> 9) & 1) << 5); R = (st >> 1) * 16 + swz / 64; C = (st & 1) * 32 + (swz % 64) / 2; }
__host__ __device__ __forceinline__ int perm32(int rho) { const int n = rho >> 4, i = rho & 15; return 8 * (i >> 2) + 4 * n + (i & 3); }

struct Unit { int pm, pn; };
struct Gemm { const bf16_t* A; const bf16_t* Bt; int M, N, K; };

struct StaticOrder {
    int nM, nN, nwg, G, c;
    __host__ __device__ void init(int M, int N, int G_, int c_) { nM = M / BM; nN = N / BM; nwg = nM * nN; G = G_; c = c_; }
    __host__ __device__ bool next(int i, Unit& u) const {
        const long L = (long)i * G + c; if (L >= nwg) return false;
        int wgid = (int)L; { const int q = nwg / NXCD, r = nwg % NXCD, xcd = wgid % NXCD, off = wgid / NXCD; wgid = (xcd < r ? xcd * (q + 1) : r * (q + 1) + (xcd - r) * q) + off; }
        const int nig = WGM * nN, gid = wgid / nig, fm = gid * WGM, gsz = (nM - fm) < WGM ? (nM - fm) : WGM;
        u.pm = fm + ((wgid % nig) % gsz); u.pn = (wgid % nig) / gsz; return true;
    }
    __device__ __forceinline__ void a_ready(const Unit&) const {}
    __device__ __forceinline__ void done(const Unit&) const {}
};

template <class Epi, class Sched, bool ALIGN_EPI = false, bool SP2 = false>
__device__ __forceinline__ void gemm_phase(PG8_LAS unsigned char* lds, const Gemm g, const Sched& S, const Epi& E) {
    const int tid = ltid(), wid = __builtin_amdgcn_readfirstlane(tid >> 6), lane = tid & 63, wr = wid >> 2, wc = wid & 3, fr = lane & 15, fq = lane >> 4;
    const int K = g.K, nt = K / BK;
    unsigned voffA[2], voffB[2];
#pragma unroll
    for (int i = 0; i < 2; ++i) { int R, C; stage_rc(tid * 16 + i * 8192, R, C); const int Rb = Epi::PERM ? ((R & ~31) + perm32(R & 31)) : R;
        voffA[i] = (unsigned)(R * K + C) * 2u; voffB[i] = (unsigned)(Rb * K + C) * 2u; }
    const size_t kstep = (size_t)(BK * 2);
    const size_t hstep = (size_t)HALF * K * 2;
    const size_t tstep = 2 * hstep;
    const unsigned ldsw = (unsigned)wid * 1024u;
    const int aoff = lds_byte(wr * 64 + fr, fq * 8), boff = lds_byte(wc * 32 + fr, fq * 8);
    PG8_LAS unsigned char* ldsA = lds + aoff; PG8_LAS unsigned char* ldsB = lds + 65536 + boff; asm volatile("" : "+v"(ldsA), "+v"(ldsB));
#define PG8_SA(b, h) (((b) * 2 + (h)) * HTB)
#define PG8_SB(b, h) ((4 + (b) * 2 + (h)) * HTB)
#define PG8_STAGE(bufoff, gbase, voff) do { _Pragma("unroll") for (int _i = 0; _i < 2; ++_i) \
        __builtin_amdgcn_global_load_lds((const unsigned*)((const char*)(gbase) + (voff)[_i]), (PG8_LAS unsigned*)(lds + (bufoff) + ldsw + _i * 8192), 16, 0, 0); } while (0)
#define PG8_LDA(dst, b, h) do { _Pragma("unroll") for (int m = 0; m < 4; ++m) _Pragma("unroll") for (int k = 0; k < 2; ++k) dst[m][k] = *(const PG8_LAS bf16x8*)(ldsA + PG8_SA(b, h) + m * 2048 + k * 1024); } while (0)
#define PG8_LDB(dst, b, h) do { _Pragma("unroll") for (int n = 0; n < 2; ++n) _Pragma("unroll") for (int k = 0; k < 2; ++k) dst[n][k] = *(const PG8_LAS bf16x8*)(ldsB + (PG8_SB(b, h) - 65536) + n * 2048 + k * 1024); } while (0)
#define PG8_MMA(ai, bj, At, Bt) do { __builtin_amdgcn_s_setprio(1); _Pragma("unroll") for (int m = 0; m < 4; ++m) _Pragma("unroll") for (int n = 0; n < 2; ++n) _Pragma("unroll") for (int k = 0; k < 2; ++k) \
        acc[ai][bj][m][n] = __builtin_amdgcn_mfma_f32_16x16x32_bf16(Bt[n][k], At[m][k], acc[ai][bj][m][n], 0, 0, 0); __builtin_amdgcn_s_setprio(0); } while (0)
#define PG8_WAIT_V(n) asm volatile("s_waitcnt vmcnt(" #n ")" ::: "memory")
#define PG8_WAIT_L(n) asm volatile("s_waitcnt lgkmcnt(" #n ")" ::: "memory")
#define PG8_BAR __builtin_amdgcn_s_barrier()
#define PG8_SCHED __builtin_amdgcn_sched_barrier(0)
    Unit cur, nxt; int ui = 0;
    if (!S.next(0, cur)) return;
    f32x4 acc[2][2][4][2];
#pragma unroll
    for (int a = 0; a < 2; ++a)
#pragma unroll
        for (int b = 0; b < 2; ++b)
#pragma unroll
            for (int m = 0; m < 4; ++m)
#pragma unroll
                for (int n = 0; n < 2; ++n) acc[a][b][m][n] = (f32x4){0.f, 0.f, 0.f, 0.f};
    bf16x8 At[4][2], B0[2][2], B1[2][2];
    const char* cA = (const char*)g.A + (size_t)cur.pm * tstep; const char* cB = (const char*)g.Bt + (size_t)cur.pn * tstep;
    S.a_ready(cur);
    if constexpr (SP2) {
        PG8_STAGE(PG8_SB(0, 0), cB, voffB); PG8_STAGE(PG8_SB(0, 1), cB + hstep, voffB); PG8_STAGE(PG8_SA(0, 0), cA, voffA); PG8_STAGE(PG8_SA(0, 1), cA + hstep, voffA);
        if (wr == 1) PG8_BAR;
        PG8_WAIT_V(2); PG8_BAR;
        PG8_STAGE(PG8_SB(1, 0), cB + kstep, voffB); PG8_STAGE(PG8_SA(1, 0), cA + kstep, voffA); PG8_STAGE(PG8_SB(1, 1), cB + hstep + kstep, voffB);
        PG8_WAIT_V(6); PG8_BAR;
    } else {
        PG8_STAGE(PG8_SB(0, 0), cB, voffB); PG8_STAGE(PG8_SA(0, 0), cA, voffA); PG8_STAGE(PG8_SB(0, 1), cB + hstep, voffB); PG8_STAGE(PG8_SA(0, 1), cA + hstep, voffA);
        if (wr == 1) PG8_BAR;
        PG8_WAIT_V(4); PG8_BAR;
        PG8_STAGE(PG8_SB(1, 0), cB + kstep, voffB); PG8_STAGE(PG8_SA(1, 0), cA + kstep, voffA); PG8_STAGE(PG8_SB(1, 1), cB + hstep + kstep, voffB);
        PG8_WAIT_V(6); PG8_BAR;
    }
    for (;;) {
        const bool has_next = S.next(ui + 1, nxt);
        const char* nA = has_next ? (const char*)g.A + (size_t)nxt.pm * tstep : cA; const char* nB = has_next ? (const char*)g.Bt + (size_t)nxt.pn * tstep : cB;
        for (int t = 0; t < nt; t += 2) {
            const bool last = (t == nt - 2);
            const char* a1 = cA + (size_t)(t + 1) * kstep;
            const char* a2 = last ? nA : cA + (size_t)(t + 2) * kstep; const char* b2 = last ? nB : cB + (size_t)(t + 2) * kstep;
            const char* a3 = a2 + kstep; const char* b3 = b2 + kstep;
            if (last && has_next) S.a_ready(nxt);
            if constexpr (SP2) {
            PG8_LDB(B0, 0, 0); PG8_LDB(B1, 0, 1); PG8_SCHED; PG8_LDA(At, 0, 0); PG8_STAGE(PG8_SA(1, 1), a1 + hstep, voffA);
            PG8_WAIT_V(8); PG8_WAIT_L(0); PG8_BAR; PG8_MMA(0, 0, At, B0); PG8_MMA(0, 1, At, B1); PG8_BAR; PG8_SCHED;
            PG8_LDA(At, 0, 1); PG8_STAGE(PG8_SB(0, 0), b2, voffB); PG8_STAGE(PG8_SB(0, 1), b2 + hstep, voffB); PG8_STAGE(PG8_SA(0, 0), a2, voffA);
            PG8_WAIT_V(8); PG8_WAIT_L(0); PG8_BAR; PG8_MMA(1, 0, At, B0); PG8_MMA(1, 1, At, B1); PG8_BAR; PG8_SCHED;
            PG8_LDB(B0, 1, 0); PG8_LDB(B1, 1, 1); PG8_SCHED; PG8_LDA(At, 1, 0); PG8_STAGE(PG8_SA(0, 1), a2 + hstep, voffA);
            PG8_WAIT_V(8); PG8_WAIT_L(0); PG8_BAR; PG8_MMA(0, 0, At, B0); PG8_MMA(0, 1, At, B1); PG8_BAR; PG8_SCHED;
            PG8_LDA(At, 1, 1); PG8_STAGE(PG8_SB(1, 0), b3, voffB); PG8_STAGE(PG8_SB(1, 1), b3 + hstep, voffB); PG8_STAGE(PG8_SA(1, 0), a3, voffA);
            PG8_WAIT_V(8); PG8_WAIT_L(0); PG8_BAR; PG8_MMA(1, 0, At, B0); PG8_MMA(1, 1, At, B1); PG8_BAR; PG8_SCHED;
            } else {
            PG8_LDB(B0, 0, 0); PG8_SCHED; PG8_LDA(At, 0, 0); PG8_STAGE(PG8_SA(1, 1), a1 + hstep, voffA);
            PG8_WAIT_L(8); PG8_BAR; PG8_WAIT_L(0); PG8_MMA(0, 0, At, B0); PG8_BAR; PG8_SCHED;
            PG8_LDB(B1, 0, 1); PG8_STAGE(PG8_SB(0, 0), b2, voffB);
            PG8_BAR; PG8_WAIT_L(0); PG8_MMA(0, 1, At, B1); PG8_BAR;
            PG8_LDA(At, 0, 1); PG8_STAGE(PG8_SA(0, 0), a2, voffA);
            PG8_BAR; PG8_WAIT_L(0); PG8_MMA(1, 0, At, B0); PG8_BAR; PG8_SCHED;
            PG8_STAGE(PG8_SB(0, 1), b2 + hstep, voffB);
            PG8_WAIT_V(6); PG8_BAR; PG8_MMA(1, 1, At, B1); PG8_BAR;
            PG8_LDB(B0, 1, 0); PG8_SCHED; PG8_LDA(At, 1, 0); PG8_STAGE(PG8_SA(0, 1), a2 + hstep, voffA);
            PG8_WAIT_L(8); PG8_BAR; PG8_WAIT_L(0); PG8_MMA(0, 0, At, B0); PG8_BAR; PG8_SCHED;
            PG8_LDB(B1, 1, 1); PG8_STAGE(PG8_SB(1, 0), b3, voffB);
            PG8_BAR; PG8_WAIT_L(0); PG8_MMA(0, 1, At, B1); PG8_BAR;
            PG8_LDA(At, 1, 1); PG8_STAGE(PG8_SA(1, 0), a3, voffA);
            PG8_BAR; PG8_WAIT_L(0); PG8_MMA(1, 0, At, B0); PG8_BAR; PG8_SCHED;
            PG8_STAGE(PG8_SB(1, 1), b3 + hstep, voffB);
            PG8_WAIT_V(6); PG8_BAR; PG8_MMA(1, 1, At, B1); PG8_BAR;
            }
        }
        if constexpr (ALIGN_EPI) { if (wr == 0) PG8_BAR; }
        if constexpr (!Epi::AFTER_DRAIN) { E(acc, cur, wr, wc, fr, fq); S.done(cur); }
        if (!has_next) break;
#pragma unroll
        for (int a = 0; a < 2; ++a)
#pragma unroll
            for (int b = 0; b < 2; ++b)
#pragma unroll
                for (int m = 0; m < 4; ++m)
#pragma unroll
                    for (int n = 0; n < 2; ++n) acc[a][b][m][n] = (f32x4){0.f, 0.f, 0.f, 0.f};
        cur = nxt; cA = nA; cB = nB; ++ui;
        if constexpr (ALIGN_EPI) { if (wr == 1) PG8_BAR; }
    }
    PG8_WAIT_V(0);
    if constexpr (!ALIGN_EPI) { if (wr == 0) PG8_BAR; }
    PG8_BAR;
    if constexpr (Epi::AFTER_DRAIN) { E.fused(acc, cur, wr, wc, fr, fq, lds, wid, lane); S.done(cur); }
#undef PG8_SA
#undef PG8_SB
#undef PG8_STAGE
#undef PG8_LDA
#undef PG8_LDB
#undef PG8_MMA
#undef PG8_WAIT_V
#undef PG8_WAIT_L
#undef PG8_BAR
#undef PG8_SCHED
}
}


DEVINL u32x4 pack8(const f32x4& a, const f32x4& b) { u32x4 w; w.x = cvt2(a[0], a[1]); w.y = cvt2(a[2], a[3]); w.z = cvt2(b[0], b[1]); w.w = cvt2(b[2], b[3]); return w; }
DEVINL float row_rscale(const float* ssq, int t, int fq) { const f32x4 a = *(const f32x4*)(ssq + (size_t)t * 16 + 4 * fq); return rsqrtf(quad_sum(a[0] + a[1] + a[2] + a[3]) * (1.0f / DM) + EPS); }
#define EPI_ROW(i) (u.pm * 256 + 128 * ((i) >> 2) + 64 * wr + 16 * ((i) & 3) + fr)
struct EpiIn8 {
    static constexpr bool PERM = true, AFTER_DRAIN = false;
    Params P; int l;
    DEVINL void operator()(const f32x4 (&acc0)[2][2][4][2], const pg8::Unit& u, int wr, int wc, int fr, int fq) const {
        { const int t_ = ltid(); fr = t_ & 15; fq = (t_ >> 4) & 3; wc = __builtin_amdgcn_readfirstlane((t_ >> 6) & 3); wr = __builtin_amdgcn_readfirstlane(t_ >> 8); }
        char* ws = P.ws; char* ob = (char*)P.out; const int chunk = u.pn * 4 + wc;
        const float* ssqx = (const float*)(ws + OFF_SSQX);
        float rt8[8];
        { f32x4 sq[8];
#pragma unroll
          for (int i = 0; i < 8; ++i) sq[i] = *(const f32x4*)(ssqx + (size_t)EPI_ROW(i) * 16 + 4 * fq);
#pragma unroll
          for (int i = 0; i < 8; ++i) rt8[i] = rsqrtf(quad_sum(sq[i][0] + sq[i][1] + sq[i][2] + sq[i][3]) * (1.0f / DM) + EPS); }
        if (chunk < 36) {
            const int g = chunk >> 2, h = chunk & 3, role = g % 3, mix = g / 3;
            bf16_t* dst = (bf16_t*)(ws + OFF_QKV + (size_t)g * SZ_HEADBUF);
            const float* gain = P.qk_gain + ((size_t)l * 6 + 2 * mix + (role == 1 ? 1 : 0)) * 64 + 8 * fq;
            f32x4 gg[2][2];
#pragma unroll
            for (int bj = 0; bj < 2; ++bj)
#pragma unroll
                for (int n = 0; n < 2; ++n) gg[bj][n] = role != 2 ? *(const f32x4*)(gain + 32 * bj + 4 * n) : (f32x4){1.f, 1.f, 1.f, 1.f};
#pragma unroll
            for (int ai = 0; ai < 2; ++ai)
#pragma unroll
                for (int m = 0; m < 4; ++m) {
                    const int t = u.pm * 256 + 128 * ai + 64 * wr + 16 * m + fr, b = t >> 12, s = t & 4095; const float rt_ = rt8[ai * 4 + m]; const f32x4 a[2][2] = {{acc0[ai][0][m][0] * rt_, acc0[ai][0][m][1] * rt_}, {acc0[ai][1][m][0] * rt_, acc0[ai][1][m][1] * rt_}}; bf16_t* d = dst + ((size_t)(b * 4 + h) * SEQ + s) * 64 + 8 * fq;
                    float r = 1.f;
                    if (role != 2) { float ss = sq4(a[0][0]) + sq4(a[0][1]) + sq4(a[1][0]) + sq4(a[1][1]); ss = quad_sum(ss); r = rsqrtf(ss * (1.0f / 64.0f) + EPS) * (role == 0 ? SC_Q : 1.0f); }
#pragma unroll
                    for (int bj = 0; bj < 2; ++bj) *(u32x4*)(d + 32 * bj) = pack8(a[bj][0] * r * gg[bj][0], a[bj][1] * r * gg[bj][1]);
                }
        } else if (chunk < 42) {
            const bool isq = chunk < 40; const int c = isq ? chunk - 36 : chunk - 40;
            bf16_t* dst = isq ? (bf16_t*)(ws + OFF_CQ) : (bf16_t*)(ws + OFF_CKV); const int ld = 256;
            float* ssp = isq ? (float*)(ws + OFF_CQSS) : (float*)(ws + OFF_CKVSS); const int nss = isq ? 4 : 2;
#pragma unroll
            for (int ai = 0; ai < 2; ++ai)
#pragma unroll
                for (int m = 0; m < 4; ++m) {
                    const int t = u.pm * 256 + 128 * ai + 64 * wr + 16 * m + fr; const float rt_ = rt8[ai * 4 + m]; const f32x4 a[2][2] = {{acc0[ai][0][m][0] * rt_, acc0[ai][0][m][1] * rt_}, {acc0[ai][1][m][0] * rt_, acc0[ai][1][m][1] * rt_}};
                    float ss = sq4(a[0][0]) + sq4(a[0][1]) + sq4(a[1][0]) + sq4(a[1][1]); ss = quad_sum(ss);
#pragma unroll
                    for (int bj = 0; bj < 2; ++bj) *(u32x4*)(dst + (size_t)t * ld + c * 64 + 32 * bj + 8 * fq) = pack8(a[bj][0], a[bj][1]);
                    if (fq == 0) ssp[(size_t)t * nss + c] = ss;
                }
        } else if (chunk == 42) {
            const float* gr = P.mla_rope_gain + ((size_t)l * 2 + 1) * 32; const float2* rope = (const float2*)(ws + OFF_ROPE);
            bf16_t* km = (bf16_t*)(ob + OOFF_KM); float* logf_ = (float*)(ws + OFF_LOGF);
            const f32x4 g1 = *(const f32x4*)(gr + 4 * fq), g2 = *(const f32x4*)(gr + 16 + 4 * fq); const f32x4 bfv = *(const f32x4*)(P.b_forget + l * 4);
#pragma unroll
            for (int ai = 0; ai < 2; ++ai) {
                f32x4 cs4[4][2];
#pragma unroll
                for (int m = 0; m < 4; ++m) { const f32x4* rp = (const f32x4*)(rope + (EPI_ROW(ai * 4 + m) & 4095) * 16 + 4 * fq); cs4[m][0] = rp[0]; cs4[m][1] = rp[1]; }
#pragma unroll
                for (int m = 0; m < 4; ++m) {
                    const int t = u.pm * 256 + 128 * ai + 64 * wr + 16 * m + fr, b = t >> 12, s = t & 4095; const float rt_ = rt8[ai * 4 + m]; const f32x4 a[2][2] = {{acc0[ai][0][m][0] * rt_, acc0[ai][0][m][1] * rt_}, {acc0[ai][1][m][0] * rt_, acc0[ai][1][m][1] * rt_}};
                    float ss = sq4(a[0][0]) + sq4(a[0][1]); ss = quad_sum(ss); const float r = rsqrtf(ss * (1.0f / 32.0f) + EPS);
                    float o1[4], o2[4];
#pragma unroll
                    for (int j = 0; j < 4; ++j) { const float cx = cs4[m][j >> 1][2 * (j & 1)], sy = cs4[m][j >> 1][2 * (j & 1) + 1]; const float x1 = a[0][0][j] * r * g1[j], x2 = a[0][1][j] * r * g2[j]; o1[j] = x1 * cx - x2 * sy; o2[j] = x1 * sy + x2 * cx; }
#pragma unroll
                    for (int h = 0; h < 4; ++h) { bf16_t* d = km + ((size_t)(b * 4 + h) * SEQ + s) * 96 + 64 + 4 * fq; store4bf(d, o1[0], o1[1], o1[2], o1[3]); store4bf(d + 16, o2[0], o2[1], o2[2], o2[3]); }
                    if (fq == 0) {
#pragma unroll
                        for (int j = 0; j < 4; ++j) logf_[(size_t)(b * 4 + j) * SEQ + s] = log_sigmoid(a[1][0][j] + bfv[j]) * LOG2E;
                    }
                } }
        } else if (chunk >= 44) {
            bf16_t* G = (bf16_t*)(ob + OOFF_G); const int c0 = (chunk - 44) * 64 + 8 * fq;
#pragma unroll
            for (int ai = 0; ai < 2; ++ai)
#pragma unroll
                for (int m = 0; m < 4; ++m) {
                    const int t = u.pm * 256 + 128 * ai + 64 * wr + 16 * m + fr; const float rt_ = rt8[ai * 4 + m]; const f32x4 a[2][2] = {{acc0[ai][0][m][0] * rt_, acc0[ai][0][m][1] * rt_}, {acc0[ai][1][m][0] * rt_, acc0[ai][1][m][1] * rt_}};
#pragma unroll
                    for (int bj = 0; bj < 2; ++bj) { f32x4 o0, o1;
#pragma unroll
                        for (int j = 0; j < 4; ++j) { const float z0 = a[bj][0][j], z1 = a[bj][1][j]; o0[j] = z0 * fsigmoid(z0); o1[j] = z1 * fsigmoid(z1); }
                        *(u32x4*)(G + (size_t)t * DM + c0 + 32 * bj) = pack8(o0, o1); }
                }
        }
    }
};
struct EpiResid8 { static constexpr bool PERM = true, AFTER_DRAIN = false; const float* base; const bf16_t* bbase; bf16_t* obf; float* ssq;
    DEVINL void operator()(const f32x4 (&acc)[2][2][4][2], const pg8::Unit& u, int wr, int wc, int fr, int fq) const {
        { const int t_ = ltid(); fr = t_ & 15; fq = (t_ >> 4) & 3; wc = __builtin_amdgcn_readfirstlane((t_ >> 6) & 3); wr = __builtin_amdgcn_readfirstlane(t_ >> 8); }
        const size_t cb = (size_t)u.pn * 256 + 64 * wc + 8 * fq;
        if (bbase) {
            u32x4 bw[8][2];
#pragma unroll
            for (int i = 0; i < 8; ++i)
#pragma unroll
                for (int bj = 0; bj < 2; ++bj) bw[i][bj] = *(const u32x4*)(bbase + (size_t)EPI_ROW(i) * DM + cb + 32 * bj);
#pragma unroll
            for (int i = 0; i < 8; ++i) { const int t = EPI_ROW(i); const size_t o = (size_t)t * DM + cb; float ss = 0.f;
#pragma unroll
                for (int bj = 0; bj < 2; ++bj) { const u32x4 w = bw[i][bj];
                    const f32x4 v0 = (f32x4){bflo(w.x), bfhi(w.x), bflo(w.y), bfhi(w.y)} + acc[i >> 2][bj][i & 3][0], v1 = (f32x4){bflo(w.z), bfhi(w.z), bflo(w.w), bfhi(w.w)} + acc[i >> 2][bj][i & 3][1];
                    *(u32x4*)(obf + o + 32 * bj) = pack8(v0, v1); ss += sq4(v0) + sq4(v1); }
                ss = quad_sum(ss); if (fq == 0) ssq[(size_t)t * 16 + u.pn * 4 + wc] = ss; }
        } else {
#pragma unroll
            for (int ai = 0; ai < 2; ++ai) {
                f32x4 bv[4][2][2];
#pragma unroll
                for (int m = 0; m < 4; ++m)
#pragma unroll
                    for (int bj = 0; bj < 2; ++bj) { const float* bp = base + (size_t)EPI_ROW(ai * 4 + m) * DM + cb + 32 * bj; bv[m][bj][0] = __builtin_nontemporal_load((const f32x4*)bp); bv[m][bj][1] = __builtin_nontemporal_load((const f32x4*)(bp + 4)); }
#pragma unroll
                for (int m = 0; m < 4; ++m) { const int t = EPI_ROW(ai * 4 + m); const size_t o = (size_t)t * DM + cb; float ss = 0.f;
#pragma unroll
                    for (int bj = 0; bj < 2; ++bj) { const f32x4 v0 = bv[m][bj][0] + acc[ai][bj][m][0], v1 = bv[m][bj][1] + acc[ai][bj][m][1];
                        *(u32x4*)(obf + o + 32 * bj) = pack8(v0, v1); ss += sq4(v0) + sq4(v1); }
                    ss = quad_sum(ss); if (fq == 0) ssq[(size_t)t * 16 + u.pn * 4 + wc] = ss; } }
        } } };
struct EpiStoreBf { static constexpr bool PERM = true, AFTER_DRAIN = false; bf16_t* out;
    DEVINL void operator()(const f32x4 (&acc)[2][2][4][2], const pg8::Unit& u, int wr, int wc, int fr, int fq) const {
        { const int t_ = ltid(); fr = t_ & 15; fq = (t_ >> 4) & 3; wc = __builtin_amdgcn_readfirstlane((t_ >> 6) & 3); wr = __builtin_amdgcn_readfirstlane(t_ >> 8); }
#pragma unroll
        for (int ai = 0; ai < 2; ++ai)
#pragma unroll
            for (int m = 0; m < 4; ++m) { const size_t o = (size_t)(u.pm * 256 + 128 * ai + 64 * wr + 16 * m + fr) * DM + u.pn * 256 + 64 * wc + 8 * fq;
#pragma unroll
                for (int bj = 0; bj < 2; ++bj) *(u32x4*)(out + o + 32 * bj) = pack8(acc[ai][bj][m][0], acc[ai][bj][m][1]); } } };
struct EpiPle8 { static constexpr bool PERM = true, AFTER_DRAIN = false; const bf16_t* xa; const bf16_t* pp; float* out; const float* ssq_in; bf16_t* obf; float* ssq_out;
    DEVINL void operator()(const f32x4 (&acc)[2][2][4][2], const pg8::Unit& u, int wr, int wc, int fr, int fq) const {
        { const int t_ = ltid(); fr = t_ & 15; fq = (t_ >> 4) & 3; wc = __builtin_amdgcn_readfirstlane((t_ >> 6) & 3); wr = __builtin_amdgcn_readfirstlane(t_ >> 8); }
        const size_t cb = (size_t)u.pn * 256 + 64 * wc + 8 * fq;
        float rt8[8];
        { f32x4 sq[8];
#pragma unroll
          for (int i = 0; i < 8; ++i) sq[i] = *(const f32x4*)(ssq_in + (size_t)EPI_ROW(i) * 16 + 4 * fq);
#pragma unroll
          for (int i = 0; i < 8; ++i) rt8[i] = rsqrtf(quad_sum(sq[i][0] + sq[i][1] + sq[i][2] + sq[i][3]) * (1.0f / DM) + EPS); }
#pragma unroll
        for (int qi = 0; qi < 4; ++qi) {
            const int ai = qi >> 1; u32x4 xw[4][2], pw[4][2];
#pragma unroll
            for (int m = 2 * (qi & 1); m < 2 * (qi & 1) + 2; ++m)
#pragma unroll
                for (int bj = 0; bj < 2; ++bj) { const size_t o = (size_t)EPI_ROW(ai * 4 + m) * DM + cb + 32 * bj; xw[m][bj] = *(const u32x4*)(xa + o); pw[m][bj] = *(const u32x4*)(pp + o); }
#pragma unroll
            for (int m = 2 * (qi & 1); m < 2 * (qi & 1) + 2; ++m) { const int t = EPI_ROW(ai * 4 + m); const size_t o = (size_t)t * DM + cb;
                const float rt = rt8[ai * 4 + m]; float ss = 0.f;
#pragma unroll
                for (int bj = 0; bj < 2; ++bj) { const u32x4 xv = xw[m][bj], pq = pw[m][bj]; const f32x4 x0 = (f32x4){bflo(xv.x), bfhi(xv.x), bflo(xv.y), bfhi(xv.y)}, x1 = (f32x4){bflo(xv.z), bfhi(xv.z), bflo(xv.w), bfhi(xv.w)}; f32x4 r0, r1;
                    const float pv[8] = {bflo(pq.x), bfhi(pq.x), bflo(pq.y), bfhi(pq.y), bflo(pq.z), bfhi(pq.z), bflo(pq.w), bfhi(pq.w)};
#pragma unroll
                    for (int jj = 0; jj < 4; ++jj) { r0[jj] = x0[jj] + pv[jj] * fsigmoid(rt * acc[ai][bj][m][0][jj]); r1[jj] = x1[jj] + pv[4 + jj] * fsigmoid(rt * acc[ai][bj][m][1][jj]); }
                    if (out) { __builtin_nontemporal_store(r0, (f32x4*)(out + o + 32 * bj)); __builtin_nontemporal_store(r1, (f32x4*)(out + o + 32 * bj + 4)); }
                    if (obf) { *(u32x4*)(obf + o + 32 * bj) = pack8(r0, r1); ss += sq4(r0) + sq4(r1); } }
                if (obf) { ss = quad_sum(ss); if (fq == 0) ssq_out[(size_t)t * 16 + u.pn * 4 + wc] = ss; } } } } };
struct EpiUq8 { static constexpr bool PERM = true, AFTER_DRAIN = false; Params P; int l;
    DEVINL void operator()(const f32x4 (&acc)[2][2][4][2], const pg8::Unit& u, int wr, int wc, int fr, int fq) const {
        { const int t_ = ltid(); fr = t_ & 15; fq = (t_ >> 4) & 3; wc = __builtin_amdgcn_readfirstlane((t_ >> 6) & 3); wr = __builtin_amdgcn_readfirstlane(t_ >> 8); }
        const int chunk = u.pn * 4 + wc; if (chunk >= 6) return;
        const float* cqss = (const float*)(P.ws + OFF_CQSS); bf16_t* qm = (bf16_t*)((char*)P.out + OOFF_QM); const float2* rope = (const float2*)(P.ws + OFF_ROPE);
        float rt8[8];
        { float sq[8];
#pragma unroll
          for (int i = 0; i < 8; ++i) sq[i] = cqss[(size_t)EPI_ROW(i) * 4 + fq];
#pragma unroll
          for (int i = 0; i < 8; ++i) rt8[i] = rsqrtf(quad_sum(sq[i]) * (1.0f / 256.0f) + EPS); }
        if (chunk < 4) {
            const float* gain = P.mla_nope_gain + ((size_t)l * 2 + 0) * 64 + 8 * fq;
            f32x4 gg[2][2];
#pragma unroll
            for (int bj = 0; bj < 2; ++bj) { gg[bj][0] = *(const f32x4*)(gain + 32 * bj); gg[bj][1] = *(const f32x4*)(gain + 32 * bj + 4); }
#pragma unroll
            for (int i = 0; i < 8; ++i) { const int ai = i >> 2, m = i & 3, t = EPI_ROW(i), b = t >> 12, s = t & 4095; const float rt = rt8[i];
                const f32x4 a[2][2] = {{acc[ai][0][m][0] * rt, acc[ai][0][m][1] * rt}, {acc[ai][1][m][0] * rt, acc[ai][1][m][1] * rt}};
                float ss = sq4(a[0][0]) + sq4(a[0][1]) + sq4(a[1][0]) + sq4(a[1][1]); ss = quad_sum(ss); const float r = rsqrtf(ss * (1.0f / 64.0f) + EPS) * SC_MLA;
                bf16_t* d = qm + ((size_t)(b * 4 + chunk) * SEQ + s) * 96 + 8 * fq;
#pragma unroll
                for (int bj = 0; bj < 2; ++bj) *(u32x4*)(d + 32 * bj) = pack8(a[bj][0] * r * gg[bj][0], a[bj][1] * r * gg[bj][1]); }
        } else {
            const float* gr = P.mla_rope_gain + ((size_t)l * 2 + 0) * 32; const f32x4 g1 = *(const f32x4*)(gr + 4 * fq), g2 = *(const f32x4*)(gr + 16 + 4 * fq);
#pragma unroll
            for (int hf = 0; hf < 2; ++hf) {
            f32x4 cs4[4][2];
#pragma unroll
            for (int m = 0; m < 4; ++m) { const f32x4* rp = (const f32x4*)(rope + (EPI_ROW(hf * 4 + m) & 4095) * 16 + 4 * fq); cs4[m][0] = rp[0]; cs4[m][1] = rp[1]; }
#pragma unroll
            for (int i = hf * 4; i < hf * 4 + 4; ++i) { const int ai = i >> 2, m = i & 3, t = EPI_ROW(i), b = t >> 12, s = t & 4095; const float rt = rt8[i];
                const f32x4 a[2][2] = {{acc[ai][0][m][0] * rt, acc[ai][0][m][1] * rt}, {acc[ai][1][m][0] * rt, acc[ai][1][m][1] * rt}};
#pragma unroll
                for (int bj = 0; bj < 2; ++bj) { const int h = (chunk - 4) * 2 + bj;
                    float ss = sq4(a[bj][0]) + sq4(a[bj][1]); ss = quad_sum(ss); const float r = rsqrtf(ss * (1.0f / 32.0f) + EPS);
                    float o1[4], o2[4];
#pragma unroll
                    for (int j = 0; j < 4; ++j) { const float cx = cs4[m][j >> 1][2 * (j & 1)], sy = cs4[m][j >> 1][2 * (j & 1) + 1]; const float x1 = a[bj][0][j] * r * g1[j], x2 = a[bj][1][j] * r * g2[j]; o1[j] = (x1 * cx - x2 * sy) * SC_MLA; o2[j] = (x1 * sy + x2 * cx) * SC_MLA; }
                    bf16_t* d = qm + ((size_t)(b * 4 + h) * SEQ + s) * 96 + 64 + 4 * fq; store4bf(d, o1[0], o1[1], o1[2], o1[3]); store4bf(d + 16, o2[0], o2[1], o2[2], o2[3]); } } }
        }
    }
};
struct EpiUkv8 { static constexpr bool PERM = true, AFTER_DRAIN = false; Params P; int l;
    DEVINL void operator()(const f32x4 (&acc)[2][2][4][2], const pg8::Unit& u, int wr, int wc, int fr, int fq) const {
        { const int t_ = ltid(); fr = t_ & 15; fq = (t_ >> 4) & 3; wc = __builtin_amdgcn_readfirstlane((t_ >> 6) & 3); wr = __builtin_amdgcn_readfirstlane(t_ >> 8); }
        const int chunk = u.pn * 4 + wc, h = chunk >> 1; const bool isk = (chunk & 1) == 0;
        const float* ckvss = (const float*)(P.ws + OFF_CKVSS); bf16_t* km = (bf16_t*)((char*)P.out + OOFF_KM); bf16_t* vm = (bf16_t*)((char*)P.out + OOFF_VM);
        const float* gain = P.mla_nope_gain + ((size_t)l * 2 + 1) * 64 + 8 * fq;
        float rt8[8];
        { float sq[8];
#pragma unroll
          for (int i = 0; i < 8; ++i) sq[i] = fq < 2 ? ckvss[(size_t)EPI_ROW(i) * 2 + fq] : 0.f;
#pragma unroll
          for (int i = 0; i < 8; ++i) rt8[i] = rsqrtf(quad_sum(sq[i]) * (1.0f / 128.0f) + EPS); }
        f32x4 gg[2][2];
#pragma unroll
        for (int bj = 0; bj < 2; ++bj) { gg[bj][0] = *(const f32x4*)(gain + 32 * bj); gg[bj][1] = *(const f32x4*)(gain + 32 * bj + 4); }
#pragma unroll
        for (int i = 0; i < 8; ++i) { const int ai = i >> 2, m = i & 3, t = EPI_ROW(i), b = t >> 12, s = t & 4095; const float rt = rt8[i];
            const f32x4 a[2][2] = {{acc[ai][0][m][0] * rt, acc[ai][0][m][1] * rt}, {acc[ai][1][m][0] * rt, acc[ai][1][m][1] * rt}};
            if (isk) { float ss = sq4(a[0][0]) + sq4(a[0][1]) + sq4(a[1][0]) + sq4(a[1][1]); ss = quad_sum(ss); const float r = rsqrtf(ss * (1.0f / 64.0f) + EPS);
                bf16_t* d = km + ((size_t)(b * 4 + h) * SEQ + s) * 96 + 8 * fq;
#pragma unroll
                for (int bj = 0; bj < 2; ++bj) *(u32x4*)(d + 32 * bj) = pack8(a[bj][0] * r * gg[bj][0], a[bj][1] * r * gg[bj][1]);
            } else { bf16_t* d = vm + ((size_t)(b * 4 + h) * SEQ + s) * 64 + 8 * fq;
#pragma unroll
                for (int bj = 0; bj < 2; ++bj) *(u32x4*)(d + 32 * bj) = pack8(a[bj][0], a[bj][1]); }
        }
    }
};
template <class Epi> DEVINL void gemm8(const bf16_t* A, const bf16_t* Bt, int M, int N, int K, const Epi& E, char* smem) {
    int G = (int)gridDim.x, c = (int)blockIdx.x; asm volatile("" : "+s"(G), "+s"(c));
    pg8::Gemm g{A, Bt, M, N, K}; pg8::StaticOrder S; S.init(M, N, G, c);
    pg8::gemm_phase<Epi, pg8::StaticOrder, true, true>((PG8_LAS unsigned char*)smem, g, S, E);
}

DEVINL void kmean_unit(const Params& P, int u, char* smem) {
    float* red = (float*)smem; const bf16_t* K = (const bf16_t*)(P.ws + OFF_QKV + 4 * SZ_HEADBUF); float* km = (float*)(P.ws + OFF_KMEAN);
    const int tid = ltid(), dc = tid & 7, rg = tid >> 3;
    const bf16_t* kp = K + ((size_t)(u >> 4) * SEQ + (u & 15) * 256 + rg) * 64 + dc * 8;
    u32x4 w[4];
#pragma unroll
    for (int i = 0; i < 4; ++i) w[i] = *(const u32x4*)(kp + (size_t)i * 64 * 64);
    float s[8] = {0.f, 0.f, 0.f, 0.f, 0.f, 0.f, 0.f, 0.f};
#pragma unroll
    for (int i = 0; i < 4; ++i) { s[0] += bflo(w[i].x); s[1] += bfhi(w[i].x); s[2] += bflo(w[i].y); s[3] += bfhi(w[i].y); s[4] += bflo(w[i].z); s[5] += bfhi(w[i].z); s[6] += bflo(w[i].w); s[7] += bfhi(w[i].w); }
    __syncthreads();
#pragma unroll
    for (int e = 0; e < 8; ++e) red[rg * 65 + dc * 8 + e] = s[e];
    __syncthreads();
    if (tid < 64) { float a = 0.f;
#pragma unroll 8
        for (int i = 0; i < 64; ++i) a += red[i * 65 + tid];
        km[(size_t)u * 64 + tid] = a * (1.0f / 256.0f); }
}

typedef float f32x16 __attribute__((ext_vector_type(16)));
typedef short s16x4 __attribute__((ext_vector_type(4)));
typedef short v4i16_t __attribute__((ext_vector_type(4)));
#define LAS __attribute__((address_space(3)))
#define MFMA32(a, b, c) __builtin_amdgcn_mfma_f32_32x32x16_bf16(a, b, c, 0, 0, 0)
DEVINL s16x4 vtr(const LAS char* p) { return __builtin_bit_cast(s16x4, __builtin_amdgcn_ds_read_tr16_b64_v4i16((LAS v4i16_t*)p)); }
DEVINL float swap_max(float v) { auto rr = __builtin_amdgcn_permlane32_swap(__float_as_uint(v), __float_as_uint(v), false, false); return fmaxf(__uint_as_float(rr[0]), __uint_as_float(rr[1])); }
DEVINL float swap_sum(float v) { auto rr = __builtin_amdgcn_permlane32_swap(__float_as_uint(v), __float_as_uint(v), false, false); return __uint_as_float(rr[0]) + __uint_as_float(rr[1]); }
DEVINL float fadd1(float a, float b) { float r; asm("v_add_f32 %0, %1, %2" : "=v"(r) : "v"(a), "v"(b)); return r; }
DEVINL constexpr int crow(int r) { return (r & 3) + 8 * (r >> 2); }

constexpr int KSLOT = 64 * 144, RSLOT = 64 * 80;
constexpr int L_KB = 0, L_VB = 3 * KSLOT, L_KR = L_VB + 16384, L_AUX = L_KR + 3 * RSLOT, L_SCR = L_AUX + 16640 + 256, L_KMS = L_SCR + 2048, L_ATT_END = L_KMS + 4096;
constexpr float NEGBIG = -3.0e38f, THR = 8.0f;

template <int MODE>
DEVINL void attn_unit(const Params& P, int l, int u, char* smem) {
    constexpr int DK = MODE == 2 ? 96 : 64, ND0 = DK / 16;
    LAS char* lds = (LAS char*)smem;
    const int tid = ltid(), lane = tid & 63, r32 = lane & 31, hi = lane >> 5; const int wid = __builtin_amdgcn_readfirstlane(tid >> 6);
    const bool fast = ((const float*)(P.ws + OFF_BOUND))[l * 4 + MODE] < 100.0f;
    int bh, q0, t_lo, t_hi, dil = 1, res = 0, pat = 0, qb = 0;
    if (MODE != 3) { bh = u & 15; qb = 15 - (u >> 4); q0 = qb * 256; t_lo = 0; t_hi = (q0 + 255) >> 6; }
    else { pat = u >> 8; const int v = u & 255; bh = v & 15; const int w = v >> 4; dil = pat == 0 ? 1 : (pat == 1 ? 4 : 16); res = w % dil; q0 = (w / dil) * 256; t_lo = (q0 >= 128 ? q0 - 128 : 0) >> 6; t_hi = (q0 + 255) >> 6; }
    const int b = bh >> 2, h = bh & 3;
    const bf16_t *Qg, *Kg, *Vg; int rsq, rsk, rsv;
    if (MODE == 0) { Qg = (const bf16_t*)(P.ws + OFF_QKV) + (size_t)bh * SEQ * 64; Kg = Qg + SZ_HEADBUF / 2; Vg = Kg + SZ_HEADBUF / 2; rsq = rsk = rsv = 64; }
    else if (MODE == 1) { Qg = (const bf16_t*)(P.ws + OFF_QKV + 3 * SZ_HEADBUF) + (size_t)bh * SEQ * 64; Kg = Qg + SZ_HEADBUF / 2; Vg = Kg + SZ_HEADBUF / 2; rsq = rsk = rsv = 64; }
    else if (MODE == 2) { Qg = (const bf16_t*)((const char*)P.out + OOFF_QM) + (size_t)bh * SEQ * 96; Kg = (const bf16_t*)((const char*)P.out + OOFF_KM) + (size_t)bh * SEQ * 96; Vg = (const bf16_t*)((const char*)P.out + OOFF_VM) + (size_t)bh * SEQ * 64; rsq = rsk = 96; rsv = 64; }
    else { Qg = (const bf16_t*)(P.ws + OFF_QKV + 6 * SZ_HEADBUF) + ((size_t)bh * SEQ + res) * 64; Kg = Qg + SZ_HEADBUF / 2; Vg = Kg + SZ_HEADBUF / 2; rsq = rsk = rsv = 64 * dil; }
    const int qw = q0 + 32 * wid;

    __syncthreads();
    const unsigned kgo = (unsigned)((tid >> 3) * rsk + (tid & 7) * 8), vgo = (unsigned)(((tid >> 2) & 63) * rsv + (tid >> 8) * 32 + (tid & 3) * 8), rgo = (unsigned)(((tid >> 2) & 63) * rsk + 64 + (tid & 3) * 8);
    const int kws = (tid >> 3) * 144 + (tid & 7) * 16;
    const int rws = ((tid >> 2) & 63) * 80 + (tid & 3) * 16;
    u32x4 kA, rA, kB, rB;
#define ATT_LOADK(j, K_, R_) do { if ((j) <= t_hi) { K_ = *(const u32x4*)(Kg + (size_t)(j) * 64 * rsk + kgo); if (MODE == 2 && tid < 256) R_ = *(const u32x4*)(Kg + (size_t)(j) * 64 * rsk + rgo); } } while (0)
#define ATT_DMAV(j, slot) do { if ((j) <= t_hi) __builtin_amdgcn_global_load_lds((const unsigned*)(Vg + (size_t)(j) * 64 * rsv + vgo), (LAS unsigned*)(lds + L_VB + (slot) * 8192 + wid * 1024), 16, 0, 0); } while (0)
#define ATT_WRITEK(slot, j, K_, R_) do { if ((j) <= t_hi) { *(LAS u32x4*)(lds + L_KB + (slot) * KSLOT + kws) = K_; if (MODE == 2 && tid < 256) *(LAS u32x4*)(lds + L_KR + (slot) * RSLOT + rws) = R_; \
        if (MODE == 0 && tid < 64) { const float bs = aux[(j) * 64 + tid] - auxU; const unsigned hb = cvt2(bs, 0.f) & 0xffffu; const float lo = bs - __uint_as_float(hb << 16); u32x4 w; w.x = hb | (cvt2(lo, 0.f) << 16); w.y = 0x3F80u; w.z = 0u; w.w = 0u; \
            *(LAS u32x4*)(lds + L_KR + (slot) * 1024 + tid * 16) = w; } } } while (0)
    bf16x8 qf[ND0];
    { const bf16_t* qp = Qg + (size_t)(qw + r32) * rsq + 8 * hi;
#pragma unroll
      for (int d0 = 0; d0 < ND0; ++d0) qf[d0] = *(const bf16x8*)(qp + 16 * d0); }
    if (MODE != 0) { ATT_LOADK(t_lo, kA, rA); ATT_LOADK(t_lo + 1, kB, rB); }
    LAS float* aux = (LAS float*)(lds + L_AUX);
    if (MODE == 0) {
        LAS float* tot = (LAS float*)(lds + L_SCR);
        const float* lf = (const float*)(P.ws + OFF_LOGF) + (size_t)bh * SEQ + tid * 8; float v[8]; float run = 0.f;
        { const f32x4 a = *(const f32x4*)lf, c = *(const f32x4*)(lf + 4); v[0] = a[0]; v[1] = a[1]; v[2] = a[2]; v[3] = a[3]; v[4] = c[0]; v[5] = c[1]; v[6] = c[2]; v[7] = c[3]; }
#pragma unroll
        for (int i = 0; i < 8; ++i) { run += v[i]; v[i] = run; }
        tot[tid] = run; __syncthreads();
        if (tid < 64) { float a[8]; float acc = 0.f;
#pragma unroll
            for (int i = 0; i < 8; ++i) { acc += tot[tid * 8 + i]; a[i] = acc; }
            float incl = acc;
#pragma unroll
            for (int o = 1; o < 64; o <<= 1) { const float nb = shup(incl, o); if (tid >= o) incl += nb; }
            const float ex = incl - acc; tot[tid * 8] = ex;
#pragma unroll
            for (int i = 1; i < 8; ++i) tot[tid * 8 + i] = ex + a[i - 1]; }
        __syncthreads();
        const float base = tot[tid];
#pragma unroll
        for (int i = 0; i < 8; ++i) aux[tid * 8 + i] = -(base + v[i]);
        if (tid < 4) ((LAS unsigned*)(lds + L_KR + 3072))[tid] = 0u;
    } else if (MODE == 1) {
        const float* lut = (const float*)(P.ws + OFF_LUT) + (size_t)h * 4096;
        for (int i = ((4095 - (q0 + 255)) & ~3) + 4 * tid; i < 4160; i += 4 * NTHREADS) {
            f32x4 v = (f32x4){0.f, 0.f, 0.f, 0.f}; if (i < 4096) { const f32x4 s = *(const f32x4*)(lut + 4092 - i); v = (f32x4){s[3], s[2], s[1], s[0]}; }
            *(LAS f32x4*)(aux + i) = v; }
        if (tid < 64) aux[4160 + tid] = -INFINITY;
        LAS float* kms = (LAS float*)(lds + L_KMS); const float* km = (const float*)(P.ws + OFF_KMEAN) + (size_t)bh * 1024;
        for (int i = tid; i < 1024; i += NTHREADS) kms[i] = km[i];
    } else if (MODE == 3) {
        const float* lut = (const float*)(P.ws + OFF_LUT) + (size_t)(4 + h) * 4096;
        if (tid < 320) { const int rel = 255 - tid; aux[tid] = (rel >= 0 && rel * dil < 4096) ? lut[rel * dil] : 0.f; }
    }
    if (MODE == 0 && fast) {
        __syncthreads();
        const float bnd = ((const float*)(P.ws + OFF_BOUND))[l * 4 + (tid >> 30)];
        const bool sk = (lane <= t_hi) && ((aux[64 * lane + 63] - aux[q0]) + bnd < -150.0f);
        t_lo = (int)__builtin_popcountll(__ballot(sk));
    }
    __syncthreads();
    bf16x8 qx = {0, 0, 0, 0, 0, 0, 0, 0}; float auxU = 0.f;
    if (MODE == 0) { auxU = aux[q0 + 255]; const float sh = auxU - aux[qw + r32];
        if (hi == 0) { u32x4 w; w.x = 0x3F803F80u; w.y = cvt2(sh, 0.f); w.z = 0u; w.w = 0u; qx = __builtin_bit_cast(bf16x8, w); } }
    unsigned sel = 0;
    if (MODE == 1) {
        const LAS float* kms = (const LAS float*)(lds + L_KMS); float gt[15];
#pragma unroll
        for (int n = 0; n < 15; ++n) { float s = 0.f;
            if (n < qb) {
#pragma unroll
                for (int d0 = 0; d0 < 4; ++d0) { const f32x4 ka = *(const LAS f32x4*)(kms + n * 64 + 16 * d0 + 8 * hi), kb = *(const LAS f32x4*)(kms + n * 64 + 16 * d0 + 8 * hi + 4);
                    const u32x4 w = __builtin_bit_cast(u32x4, qf[d0]);
                    s += bflo(w.x) * ka[0] + bfhi(w.x) * ka[1] + bflo(w.y) * ka[2] + bfhi(w.y) * ka[3] + bflo(w.z) * kb[0] + bfhi(w.z) * kb[1] + bflo(w.w) * kb[2] + bfhi(w.w) * kb[3]; }
                s = swap_sum(s); }
            gt[n] = s; }
#pragma unroll
        for (int k = 0; k < 3; ++k) { float best = NEGBIG; int bi = -1;
#pragma unroll
            for (int n = 0; n < 15; ++n) if (n < qb && !((sel >> n) & 1u) && gt[n] > best) { best = gt[n]; bi = n; }
            if (bi >= 0) sel |= 1u << bi; }
        sel |= 1u << qb;
    }
    const int kfo = L_KB + r32 * 144 + hi * 16, rfo = L_KR + r32 * 80 + hi * 16;
    const int vfo = L_VB + ((lane >> 4) & 1) * 32 + (lane & 3) * 8 + (4 * hi + ((lane & 15) >> 2)) * 64;

    f32x16 o0, o1;
#pragma unroll
    for (int r = 0; r < 16; ++r) { o0[r] = 0.f; o1[r] = 0.f; }
    float m = fast ? 0.f : NEGBIG, lsum = 0.f;

    auto anysel = [&](int j) -> bool { return MODE != 1 || __any((sel >> (j >> 2)) & 1u); };
    auto is_full = [&](int j) -> bool {
        bool f = fast && (64 * j + 63 <= qw) && anysel(j);
        if (MODE == 3) f = f && (64 * j >= qw + 31 - 128);
        return f; };
    auto stage_a = [&](int j, int ks, int kb, f32x16& p) {
        if (MODE == 1 || MODE == 3) { const LAS float* lp = aux + ((MODE == 1 ? 4095 : 255) - (qw + r32 - 64 * j - 4 * hi));
            if (MODE == 1) lp = ((sel >> (j >> 2)) & 1u) ? lp : aux + 4160;
#pragma unroll
            for (int r = 0; r < 16; ++r) p[r] = lp[crow(r) + 32 * kb];
        } else {
#pragma unroll
            for (int r = 0; r < 16; ++r) p[r] = 0.f;
        }
        const LAS char* kb_ = lds + ks * KSLOT + kb * (32 * 144) + kfo;
#pragma unroll
        for (int d0 = 0; d0 < 4; ++d0) p = MFMA32(*(const LAS bf16x8*)(kb_ + d0 * 32), qf[d0], p);
        if (MODE == 2) { const LAS char* rb_ = lds + ks * RSLOT + kb * (32 * 80) + rfo;
#pragma unroll
            for (int d0 = 0; d0 < 2; ++d0) p = MFMA32(*(const LAS bf16x8*)(rb_ + d0 * 32), qf[4 + d0], p); }
        if (MODE == 0) p = MFMA32(*(const LAS bf16x8*)(lds + (hi ? (L_KR + 3072) : (L_KR + ks * 1024 + kb * 512 + r32 * 16))), qx, p);
    };
    auto stage_b = [&](int j, f32x16& p, u32x4& wa, u32x4& wb) {
#pragma unroll
        for (int r = 0; r < 16; ++r) { p[r] = __builtin_amdgcn_exp2f(p[r]); lsum += p[r]; }
        wa.x = cvt2(p[0], p[1]); wa.y = cvt2(p[2], p[3]); wa.z = cvt2(p[4], p[5]); wa.w = cvt2(p[6], p[7]);
        wb.x = cvt2(p[8], p[9]); wb.y = cvt2(p[10], p[11]); wb.z = cvt2(p[12], p[13]); wb.w = cvt2(p[14], p[15]);
        asm volatile("" : "+v"(lsum));
    };
    auto stage_c = [&](int vs, int kb, const u32x4& wa, const u32x4& wb) {
        const LAS char* vb_ = lds + vs * 8192 + vfo + kb * 2048;
        { const s16x4 a0 = vtr(vb_), a1 = vtr(vb_ + 512), c0 = vtr(vb_ + 4096), c1 = vtr(vb_ + 4096 + 512);
          o0 = MFMA32(__builtin_shufflevector(a0, a1, 0, 1, 2, 3, 4, 5, 6, 7), __builtin_bit_cast(bf16x8, wa), o0); o1 = MFMA32(__builtin_shufflevector(c0, c1, 0, 1, 2, 3, 4, 5, 6, 7), __builtin_bit_cast(bf16x8, wa), o1); }
        { const s16x4 a0 = vtr(vb_ + 1024), a1 = vtr(vb_ + 1024 + 512), c0 = vtr(vb_ + 4096 + 1024), c1 = vtr(vb_ + 4096 + 1024 + 512);
          o0 = MFMA32(__builtin_shufflevector(a0, a1, 0, 1, 2, 3, 4, 5, 6, 7), __builtin_bit_cast(bf16x8, wb), o0); o1 = MFMA32(__builtin_shufflevector(c0, c1, 0, 1, 2, 3, 4, 5, 6, 7), __builtin_bit_cast(bf16x8, wb), o1); }
    };
    auto general = [&](int t, int ks, int vs) {
        const int k0 = t * 64; const bool selected = MODE != 1 || ((sel >> (t >> 2)) & 1u); const bool asel = anysel(t);
        int dl = qw + r32 - k0 - 4 * hi; asm volatile("" : "+v"(dl));
#pragma unroll
        for (int kb = 0; kb < 2; ++kb) {
            const int kh = k0 + 32 * kb;
            bool act = kh <= qw + 31 && asel, need_mask = kh + 31 > qw;
            if (MODE == 3) { act = act && (kh + 31 >= qw - 128); need_mask = need_mask || (kh < qw + 31 - 128); }
            if (!act) continue;
            f32x16 p;
            if (MODE == 1 || MODE == 3) { const LAS float* lp = aux + ((MODE == 1 ? 4095 : 255) - dl);
#pragma unroll
                for (int r = 0; r < 16; ++r) p[r] = lp[crow(r) + 32 * kb];
            } else {
#pragma unroll
                for (int r = 0; r < 16; ++r) p[r] = 0.f;
            }
            const LAS char* kb_ = lds + ks * KSLOT + kb * (32 * 144) + kfo;
#pragma unroll
            for (int d0 = 0; d0 < 4; ++d0) p = MFMA32(*(const LAS bf16x8*)(kb_ + d0 * 32), qf[d0], p);
            if (MODE == 2) { const LAS char* rb_ = lds + ks * RSLOT + kb * (32 * 80) + rfo;
#pragma unroll
                for (int d0 = 0; d0 < 2; ++d0) p = MFMA32(*(const LAS bf16x8*)(rb_ + d0 * 32), qf[4 + d0], p); }
            if (MODE == 0) p = MFMA32(*(const LAS bf16x8*)(lds + (hi ? (L_KR + 3072) : (L_KR + ks * 1024 + kb * 512 + r32 * 16))), qx, p);
            if (need_mask) {
#pragma unroll
                for (int r = 0; r < 16; ++r) { const int rel = dl - crow(r) - 32 * kb; const bool v = MODE == 3 ? ((unsigned)rel <= 128u) : (rel >= 0); p[r] = v ? p[r] : -INFINITY; }
            }
            float ps = 0.f;
            if (fast) {
#pragma unroll
                for (int r = 0; r < 16; ++r) { p[r] = __builtin_amdgcn_exp2f(p[r]); ps += p[r]; }
            } else {
                float mx = fmaxf(p[0], p[1]);
#pragma unroll
                for (int r = 2; r < 16; ++r) mx = fmaxf(mx, p[r]);
                mx = swap_max(mx);
                if (MODE == 1) mx = selected ? mx : NEGBIG;
                if (__any(mx > m + THR)) {
                    const float mn = fmaxf(m, mx), alpha = __builtin_amdgcn_exp2f(m - mn); m = mn; lsum *= alpha;
#pragma unroll
                    for (int r = 0; r < 16; ++r) { o0[r] *= alpha; o1[r] *= alpha; }
                }
#pragma unroll
                for (int r = 0; r < 16; ++r) { p[r] = __builtin_amdgcn_exp2f(p[r] - m); ps += p[r]; }
            }
            u32x4 w0, w1;
            w0.x = cvt2(p[0], p[1]); w0.y = cvt2(p[2], p[3]); w0.z = cvt2(p[4], p[5]); w0.w = cvt2(p[6], p[7]);
            w1.x = cvt2(p[8], p[9]); w1.y = cvt2(p[10], p[11]); w1.z = cvt2(p[12], p[13]); w1.w = cvt2(p[14], p[15]);
            if (MODE == 1) { const unsigned mk = selected ? 0xffffffffu : 0u; ps = selected ? ps : 0.f; w0 = w0 & mk; w1 = w1 & mk; }
            lsum += ps;
            const bf16x8 pb0 = __builtin_bit_cast(bf16x8, w0), pb1 = __builtin_bit_cast(bf16x8, w1);
            const LAS char* vb_ = lds + vs * 8192 + vfo + kb * 2048;
            { const s16x4 a0 = vtr(vb_), a1 = vtr(vb_ + 512), c0 = vtr(vb_ + 4096), c1 = vtr(vb_ + 4096 + 512);
              o0 = MFMA32(__builtin_shufflevector(a0, a1, 0, 1, 2, 3, 4, 5, 6, 7), pb0, o0); o1 = MFMA32(__builtin_shufflevector(c0, c1, 0, 1, 2, 3, 4, 5, 6, 7), pb0, o1); }
            { const s16x4 a0 = vtr(vb_ + 1024), a1 = vtr(vb_ + 1024 + 512), c0 = vtr(vb_ + 4096 + 1024), c1 = vtr(vb_ + 4096 + 1024 + 512);
              o0 = MFMA32(__builtin_shufflevector(a0, a1, 0, 1, 2, 3, 4, 5, 6, 7), pb1, o0); o1 = MFMA32(__builtin_shufflevector(c0, c1, 0, 1, 2, 3, 4, 5, 6, 7), pb1, o1); }
        }
    };

    if (MODE == 0) { ATT_LOADK(t_lo, kA, rA); ATT_LOADK(t_lo + 1, kB, rB); }
    ATT_DMAV(t_lo, 0); ATT_DMAV(t_lo + 1, 1);
    ATT_WRITEK(0, t_lo, kA, rA); ATT_WRITEK(1, t_lo + 1, kB, rB);
    __syncthreads();
    ATT_LOADK(t_lo + 2, kA, rA);
    int ks0 = 0, ks1 = 1, ks2 = 2, vs = 0;
    bool pend = is_full(t_lo);
    f32x16 sa0, sa1, sb0, sb1;
    if (pend) { stage_a(t_lo, 0, 0, sa0); stage_a(t_lo, 0, 1, sa1); }
    auto advance = [&](const int t) {
        ATT_WRITEK(ks2, t + 2, kA, rA);
        __syncthreads();
        ATT_DMAV(t + 2, vs); ATT_LOADK(t + 3, kA, rA);
        { const int tmp = ks0; ks0 = ks1; ks1 = ks2; ks2 = tmp; } vs ^= 1;
    };
    auto steady = [&](const int t, f32x16& c0, f32x16& c1, f32x16& n0, f32x16& n1) {
        u32x4 wa, wb, wc, wd;
        stage_a(t + 1, ks1, 0, n0); stage_b(t, c0, wa, wb); __builtin_amdgcn_sched_barrier(0);
        stage_a(t + 1, ks1, 1, n1); stage_c(vs, 0, wa, wb); stage_b(t, c1, wc, wd); __builtin_amdgcn_sched_barrier(0);
        stage_c(vs, 1, wc, wd);
        advance(t);
    };
    int t = t_lo;
    while (t <= t_hi) {
        if (pend) while (t + 2 <= t_hi && is_full(t + 1) && is_full(t + 2)) { steady(t, sa0, sa1, sb0, sb1); steady(t + 1, sb0, sb1, sa0, sa1); t += 2; }
        const bool nxt = (t + 1 <= t_hi) && is_full(t + 1);
        if (pend) { u32x4 wa, wb; stage_b(t, sa0, wa, wb); stage_c(vs, 0, wa, wb); stage_b(t, sa1, wa, wb); stage_c(vs, 1, wa, wb); } else general(t, ks0, vs);
        if (nxt) { stage_a(t + 1, ks1, 0, sa0); stage_a(t + 1, ks1, 1, sa1); }
        pend = nxt;
        advance(t);
        ++t;
    }
#undef ATT_LOADK
#undef ATT_DMAV
#undef ATT_WRITEK
    const int te_ = ltid(), r32e = te_ & 31, hie = (te_ >> 5) & 1, qwe = q0 + 32 * (te_ >> 6);
    const float ltot = swap_sum(lsum), inv = 1.0f / ltot;
    if (MODE != 3) {
        const size_t tok = (size_t)b * SEQ + qwe + r32e; const int colbase = (MODE == 0 ? 0 : (MODE == 1 ? 256 : 768)) + h * 64 + 4 * hie;
        const bf16_t* G = (const bf16_t*)((const char*)P.out + OOFF_G) + tok * DM + colbase; bf16_t* A2 = (bf16_t*)(P.ws + OFF_A2) + tok * DM + colbase;
#pragma unroll
        for (int g = 0; g < 4; ++g) {
            const u32x2 g0 = *(const u32x2*)(G + 8 * g), g1 = *(const u32x2*)(G + 32 + 8 * g); u32x2 w0, w1;
            w0.x = cvt2(o0[4 * g] * inv * bflo(g0.x), o0[4 * g + 1] * inv * bfhi(g0.x)); w0.y = cvt2(o0[4 * g + 2] * inv * bflo(g0.y), o0[4 * g + 3] * inv * bfhi(g0.y));
            w1.x = cvt2(o1[4 * g] * inv * bflo(g1.x), o1[4 * g + 1] * inv * bfhi(g1.x)); w1.y = cvt2(o1[4 * g + 2] * inv * bflo(g1.y), o1[4 * g + 3] * inv * bfhi(g1.y));
            *(u32x2*)(A2 + 8 * g) = w0; *(u32x2*)(A2 + 32 + 8 * g) = w1; }
    } else {
        const size_t tok = (size_t)b * SEQ + (size_t)(qwe + r32e) * dil + res;
        bf16_t* dp = (bf16_t*)(P.ws + OFF_DPART) + ((size_t)pat * NT + tok) * 256 + h * 64 + 4 * hie;
#pragma unroll
        for (int g = 0; g < 4; ++g) { u32x2 w0, w1;
            w0.x = cvt2(o0[4 * g] * inv, o0[4 * g + 1] * inv); w0.y = cvt2(o0[4 * g + 2] * inv, o0[4 * g + 3] * inv);
            w1.x = cvt2(o1[4 * g] * inv, o1[4 * g + 1] * inv); w1.y = cvt2(o1[4 * g + 2] * inv, o1[4 * g + 3] * inv);
            *(u32x2*)(dp + 8 * g) = w0; *(u32x2*)(dp + 32 + 8 * g) = w1; }
        if (hie == 0) ((float*)(P.ws + OFF_DLSE))[((size_t)pat * NT + tok) * 4 + h] = m + __builtin_amdgcn_logf(ltot);
    }
}

DEVINL void dil_unit(const Params& P, int l, int u, char* smem) {
    LAS char* lds = (LAS char*)smem;
    const int tid = ltid(), lane = tid & 63, r32 = lane & 31, hi = lane >> 5; const int wid = __builtin_amdgcn_readfirstlane(tid >> 6);
    const int pat = u >> 8, v = u & 255, bh = v & 15, w = v >> 4, dil = pat == 0 ? 1 : (pat == 1 ? 4 : 16), res = w % dil, q0 = (w / dil) * 256;
    const int t_lo = (q0 >= 128 ? q0 - 128 : 0) >> 6, t_hi = (q0 + 255) >> 6, nt = t_hi - t_lo + 1;
    const int b = bh >> 2, h = bh & 3, rs = 64 * dil;
    const bf16_t* Qg = (const bf16_t*)(P.ws + OFF_QKV + 6 * SZ_HEADBUF) + ((size_t)bh * SEQ + res) * 64; const bf16_t* Kg = Qg + SZ_HEADBUF / 2; const bf16_t* Vg = Kg + SZ_HEADBUF / 2;
    const int qw = q0 + 32 * wid;
    constexpr int D_KB = 0, D_VB = 6 * KSLOT, D_AUX = D_VB + 6 * 8192;
    LAS float* aux = (LAS float*)(lds + D_AUX);
    __syncthreads();
    const unsigned kgo = (unsigned)((tid >> 3) * rs + (tid & 7) * 8), vgo = (unsigned)(((tid >> 2) & 63) * rs + (tid >> 8) * 32 + (tid & 3) * 8);
    u32x4 kr[6], vr[6];
#pragma unroll
    for (int j = 0; j < 6; ++j) if (j < nt) { kr[j] = *(const u32x4*)(Kg + (size_t)(t_lo + j) * 64 * rs + kgo); vr[j] = *(const u32x4*)(Vg + (size_t)(t_lo + j) * 64 * rs + vgo); }
    bf16x8 qf[4];
    { const bf16_t* qp = Qg + (size_t)(qw + r32) * rs + 8 * hi;
#pragma unroll
      for (int d0 = 0; d0 < 4; ++d0) qf[d0] = *(const bf16x8*)(qp + 16 * d0); }
    { const float* lut = (const float*)(P.ws + OFF_LUT) + (size_t)(4 + h) * 4096;
      if (tid < 320) { const int rel = 255 - tid; aux[tid] = (rel >= 0 && rel * dil < 4096) ? lut[rel * dil] : 0.f; } }
    { const int kws = (tid >> 3) * 144 + (tid & 7) * 16;
#pragma unroll
      for (int j = 0; j < 6; ++j) if (j < nt) { *(LAS u32x4*)(lds + D_KB + j * KSLOT + kws) = kr[j]; *(LAS u32x4*)(lds + D_VB + j * 8192 + tid * 16) = vr[j]; } }
    __syncthreads();
    const int kfo = D_KB + r32 * 144 + hi * 16;
    const int vfo = D_VB + ((lane >> 4) & 1) * 32 + (lane & 3) * 8 + (4 * hi + ((lane & 15) >> 2)) * 64;
    f32x16 o0, o1;
#pragma unroll
    for (int r = 0; r < 16; ++r) { o0[r] = 0.f; o1[r] = 0.f; }
    float lsum = 0.f;
    const int hb_hi = qw >> 5, hb_lo = hb_hi >= 4 ? hb_hi - 4 : 0;
    for (int hb = hb_lo; hb <= hb_hi; ++hb) {
        const int kh = hb * 32, jl = (hb >> 1) - t_lo, kb = hb & 1;
        const bool need_mask = (hb == hb_hi) || (kh < qw + 31 - 128);
        const int dl = qw + r32 - kh - 4 * hi;
        f32x16 p;
        { const LAS float* lp = aux + (255 - dl);
#pragma unroll
          for (int r = 0; r < 16; ++r) p[r] = lp[crow(r)]; }
        const LAS char* kb_ = lds + jl * KSLOT + kb * (32 * 144) + kfo;
#pragma unroll
        for (int d0 = 0; d0 < 4; ++d0) p = MFMA32(*(const LAS bf16x8*)(kb_ + d0 * 32), qf[d0], p);
        if (need_mask) {
#pragma unroll
            for (int r = 0; r < 16; ++r) { const int rel = dl - crow(r); p[r] = ((unsigned)rel <= 128u) ? p[r] : -INFINITY; }
        }
        float ps = 0.f;
#pragma unroll
        for (int r = 0; r < 16; ++r) { p[r] = __builtin_amdgcn_exp2f(p[r]); ps += p[r]; }
        lsum += ps;
        u32x4 w0, w1;
        w0.x = cvt2(p[0], p[1]); w0.y = cvt2(p[2], p[3]); w0.z = cvt2(p[4], p[5]); w0.w = cvt2(p[6], p[7]);
        w1.x = cvt2(p[8], p[9]); w1.y = cvt2(p[10], p[11]); w1.z = cvt2(p[12], p[13]); w1.w = cvt2(p[14], p[15]);
        const LAS char* vb_ = lds + jl * 8192 + vfo + kb * 2048;
        { const s16x4 a0 = vtr(vb_), a1 = vtr(vb_ + 512), c0 = vtr(vb_ + 4096), c1 = vtr(vb_ + 4096 + 512);
          o0 = MFMA32(__builtin_shufflevector(a0, a1, 0, 1, 2, 3, 4, 5, 6, 7), __builtin_bit_cast(bf16x8, w0), o0); o1 = MFMA32(__builtin_shufflevector(c0, c1, 0, 1, 2, 3, 4, 5, 6, 7), __builtin_bit_cast(bf16x8, w0), o1); }
        { const s16x4 a0 = vtr(vb_ + 1024), a1 = vtr(vb_ + 1024 + 512), c0 = vtr(vb_ + 4096 + 1024), c1 = vtr(vb_ + 4096 + 1024 + 512);
          o0 = MFMA32(__builtin_shufflevector(a0, a1, 0, 1, 2, 3, 4, 5, 6, 7), __builtin_bit_cast(bf16x8, w1), o0); o1 = MFMA32(__builtin_shufflevector(c0, c1, 0, 1, 2, 3, 4, 5, 6, 7), __builtin_bit_cast(bf16x8, w1), o1); }
    }
    const float ltot = swap_sum(lsum), inv = 1.0f / ltot;
    const size_t tok = (size_t)b * SEQ + (size_t)(qw + r32) * dil + res;
    bf16_t* dp = (bf16_t*)(P.ws + OFF_DPART) + ((size_t)pat * NT + tok) * 256 + h * 64 + 4 * hi;
#pragma unroll
    for (int g = 0; g < 4; ++g) { u32x2 w0, w1;
        w0.x = cvt2(o0[4 * g] * inv, o0[4 * g + 1] * inv); w0.y = cvt2(o0[4 * g + 2] * inv, o0[4 * g + 3] * inv);
        w1.x = cvt2(o1[4 * g] * inv, o1[4 * g + 1] * inv); w1.y = cvt2(o1[4 * g + 2] * inv, o1[4 * g + 3] * inv);
        *(u32x2*)(dp + 8 * g) = w0; *(u32x2*)(dp + 32 + 8 * g) = w1; }
    if (hi == 0) ((float*)(P.ws + OFF_DLSE))[((size_t)pat * NT + tok) * 4 + h] = __builtin_amdgcn_logf(ltot);
}

DEVINL void dilmix_unit(const Params& P, int u) {
    const int e = u * NTHREADS + ltid(), tok = e >> 5, hd = e & 31, h = hd >> 3, d8 = (hd & 7) * 8;
    const float* ls = (const float*)(P.ws + OFF_DLSE); const bf16_t* dp = (const bf16_t*)(P.ws + OFF_DPART);
    const float l0 = ls[(size_t)tok * 4 + h], l1 = ls[((size_t)NT + tok) * 4 + h], l2 = ls[((size_t)2 * NT + tok) * 4 + h];
    const float mx = fmaxf(l0, fmaxf(l1, l2)); float w0 = __builtin_amdgcn_exp2f(l0 - mx), w1 = __builtin_amdgcn_exp2f(l1 - mx), w2 = __builtin_amdgcn_exp2f(l2 - mx);
    const float inv = 1.0f / (w0 + w1 + w2); w0 *= inv; w1 *= inv; w2 *= inv;
    const size_t off = (size_t)tok * 256 + h * 64 + d8;
    const u32x4 a = *(const u32x4*)(dp + off), b = *(const u32x4*)(dp + (size_t)NT * 256 + off), c = *(const u32x4*)(dp + (size_t)2 * NT * 256 + off);
    const u32x4 g = *(const u32x4*)((const bf16_t*)((const char*)P.out + OOFF_G) + (size_t)tok * DM + 512 + h * 64 + d8);
    u32x4 r;
    r.x = cvt2((w0 * bflo(a.x) + w1 * bflo(b.x) + w2 * bflo(c.x)) * bflo(g.x), (w0 * bfhi(a.x) + w1 * bfhi(b.x) + w2 * bfhi(c.x)) * bfhi(g.x));
    r.y = cvt2((w0 * bflo(a.y) + w1 * bflo(b.y) + w2 * bflo(c.y)) * bflo(g.y), (w0 * bfhi(a.y) + w1 * bfhi(b.y) + w2 * bfhi(c.y)) * bfhi(g.y));
    r.z = cvt2((w0 * bflo(a.z) + w1 * bflo(b.z) + w2 * bflo(c.z)) * bflo(g.z), (w0 * bfhi(a.z) + w1 * bfhi(b.z) + w2 * bfhi(c.z)) * bfhi(g.z));
    r.w = cvt2((w0 * bflo(a.w) + w1 * bflo(b.w) + w2 * bflo(c.w)) * bflo(g.w), (w0 * bfhi(a.w) + w1 * bfhi(b.w) + w2 * bfhi(c.w)) * bfhi(g.w));
    *(u32x4*)((bf16_t*)(P.ws + OFF_A2) + (size_t)tok * DM + 512 + h * 64 + d8) = r;
}


#define XB_TMO      128
#define XB_XCNT(j)  (256  + 64 * (j))
#define XB_XSUB(j)  (1280 + 64 * (j))
#define XB_XGEN(j)  (2304 + 64 * (j))
#define XB_TOP      3328
#define XB_TOPGEN   3392
#define XCD_BAR_WORDS 3456
#define XB_SPIN_CAP (1u << 20)
DEVINL unsigned xb_ld(unsigned* p) { return __hip_atomic_load(p, __ATOMIC_RELAXED, __HIP_MEMORY_SCOPE_AGENT); }
DEVINL unsigned xb_add(unsigned* p, unsigned v) { return __hip_atomic_fetch_add(p, v, __ATOMIC_RELAXED, __HIP_MEMORY_SCOPE_AGENT); }
DEVINL unsigned xb_xcc_id() { return (unsigned)__builtin_amdgcn_s_getreg((3 << 11) | 20) & 0xFu; }
#define XB_SPIN(cond, bar) do { unsigned _sp = 0; while (cond) { __builtin_amdgcn_s_sleep(1); \
    if ((++_sp & 255u) == 0u) { if (xb_ld(&(bar)[XB_TMO])) break; if (_sp > XB_SPIN_CAP) { atomicAdd(&(bar)[XB_TMO], 1u); break; } } } } while (0)
DEVINL void xcd_barrier_post(unsigned* bar) { if (ltid() == 0) (void)xb_add(&bar[XB_XCNT(xb_xcc_id())], 1u); }
DEVINL void xcd_barrier_complete(unsigned* bar, unsigned x, unsigned& nloc, unsigned& nx) {
    const unsigned G = gridDim.x * gridDim.y * gridDim.z;
    unsigned sum, cnt, mine, sp = 0u;
    for (;;) {
        sum = 0u; cnt = 0u; mine = 0u;
        for (unsigned j = 0; j < 16; ++j) { const unsigned c = xb_ld(&bar[XB_XCNT(j)]); sum += c; cnt += (c > 0u) ? 1u : 0u; mine = (j == x) ? c : mine; }
        if (sum == G) break;
        __builtin_amdgcn_s_sleep(1);
        if ((++sp & 255u) == 0u) { if (xb_ld(&bar[XB_TMO])) break; if (sp > XB_SPIN_CAP) { atomicAdd(&bar[XB_TMO], 1u); break; } }
    }
    nloc = mine > 0u ? mine : 1u; nx = cnt > 0u ? cnt : 1u;
}
DEVINL void xcd_barrier(unsigned* bar_in, volatile LAS unsigned* st) {
    asm volatile("s_waitcnt vmcnt(0)" ::: "memory");
    __syncthreads();
    if (ltid() == 0) {
        unsigned* bar = bar_in;
        const unsigned x = xb_xcc_id();
        __builtin_amdgcn_s_waitcnt(0);
        unsigned nloc = st[0], nx = st[1];
        if (nloc == 0u) { xcd_barrier_complete(bar, x, nloc, nx); st[0] = nloc; st[1] = nx; }
        const unsigned old = xb_add(&bar[XB_XSUB(x)], 1u);
        const unsigned gen = old / nloc;
        if (old + 1u == (gen + 1u) * nloc) {
            __builtin_amdgcn_fence(__ATOMIC_RELEASE, "agent");
            asm volatile("s_waitcnt vmcnt(0)" ::: "memory");
            const unsigned og = xb_add(&bar[XB_TOP], 1u);
            const unsigned tg = og / nx;
            if (og + 1u == (tg + 1u) * nx) xb_add(&bar[XB_TOPGEN], 1u);
            else XB_SPIN(xb_ld(&bar[XB_TOPGEN]) == tg, bar);
            __builtin_amdgcn_fence(__ATOMIC_ACQUIRE, "agent");
            xb_add(&bar[XB_XGEN(x)], 1u);
            asm volatile("s_waitcnt vmcnt(0)" ::: "memory");
        } else {
            XB_SPIN(xb_ld(&bar[XB_XGEN(x)]) == gen, bar);
            __builtin_amdgcn_fence(__ATOMIC_ACQUIRE, "agent");
            asm volatile("s_waitcnt vmcnt(0)" ::: "memory");
        }
    }
    __syncthreads();
}


DEVINL int next_unit(unsigned* ctr, char* smem) {
    int* su = (int*)(smem + L_MISC);
    __syncthreads();
    if (ltid() == 0) *su = (int)atomicAdd(ctr, 1u);
    __syncthreads();
    return *su;
}

template <class Epi> DEVINL void gemm8_sub(const bf16_t* A, const bf16_t* Bt, int M, int N, int K, const Epi& E, char* smem, int G, int c) {
    asm volatile("" : "+s"(G), "+s"(c));
    pg8::Gemm g{A, Bt, M, N, K}; pg8::StaticOrder S; S.init(M, N, G, c);
    pg8::gemm_phase<Epi, pg8::StaticOrder, true, true>((PG8_LAS unsigned char*)smem, g, S, E);
}
DEVINL void phase_pre(const Params& P, int l, char* smem) {
    const int half = (int)gridDim.x >> 1, bid = (int)blockIdx.x;
    if (bid < half) gemm8_sub((const bf16_t*)(P.ws + OFF_CQ), (const bf16_t*)(P.ws + OFF_WT_UQ + l * SZ_WT_UQ), NT, 512, 256, EpiUq8{P, l}, smem, half, bid);
    else gemm8_sub((const bf16_t*)(P.ws + OFF_CKV), (const bf16_t*)(P.ws + OFF_WT_UKV + l * SZ_WT_UKV), NT, 512, 256, EpiUkv8{P, l}, smem, (int)gridDim.x - half, bid - half);
    for (int u = blockIdx.x; u < 256; u += gridDim.x) kmean_unit(P, u, smem);
}
DEVINL void phase_att(const Params& P, int l, char* smem, int rep) {
    unsigned* ctr = (unsigned*)(P.ws + OFF_CTR) + l * 2 + rep * 8;
    constexpr int N_ATT = 384 + 256 + 96 + 768 + 32; const int n_all = N_ATT + (l == 0 ? PREP_PER_LAYER + PREP_P_UNITS / 2 : 0);
    for (;;) {
#ifdef PROBE_CLS
        const unsigned long long tq0 = __builtin_amdgcn_s_memrealtime(); int cls = 4;
#define PCLS(c) cls = (c);
#else
#define PCLS(c)
#endif
        int u = next_unit(ctr, smem); if (u >= n_all) break;
        if (u >= N_ATT) { __syncthreads(); if (u - N_ATT < PREP_PER_LAYER) prep_w_unit(P, 1, u - N_ATT, (float*)smem); else prep_p_unit(P, PREP_P_UNITS / 2 + (u - N_ATT - PREP_PER_LAYER)); }
        else if (u >= 384 && u < 640) { PCLS(0) attn_unit<0>(P, l, u - 384, smem); }
        else if (u >= 736 && u < 736 + 768) { PCLS(3) if (((const float*)(P.ws + OFF_BOUND))[l * 4 + 3] < 100.0f) dil_unit(P, l, u - 736, smem); else attn_unit<3>(P, l, u - 736, smem); }
        else {
            if (u >= 736 + 768) u -= 768; if (u >= 640) u -= 256;
            const int g = u >> 5, r = u & 31, uu = g * 16 + (r & 15);
            if (r < 16) { PCLS(2) attn_unit<2>(P, l, uu, smem); } else { PCLS(1) attn_unit<1>(P, l, uu, smem); } }
#ifdef PROBE_CLS
        if (blockIdx.x == PROBE_BLK && cls == PROBE_CLS && ltid() == 0) { LAS unsigned* pa = (LAS unsigned*)((LAS char*)smem + L_MISC + 32); pa[0] += (unsigned)(__builtin_amdgcn_s_memrealtime() - tq0); pa[1] += 1u; }
#endif
#undef PCLS
    }
}

template <int PH> DEVINL void run_phase(int l, char* smem, int rep = 0) {
    asm volatile("" : "+s"(l));
    const __attribute__((address_space(4))) Params* kp = (const __attribute__((address_space(4))) Params*)__builtin_amdgcn_kernarg_segment_ptr(); asm volatile("" : "+s"(kp));
    Params P;
    P.x = (const float*)as_global(kp->x); P.p = (const float*)as_global(kp->p); P.ln_g = (const float*)as_global(kp->ln_g); P.w_in = (const float*)as_global(kp->w_in); P.b_forget = (const float*)as_global(kp->b_forget);
    P.qk_gain = (const float*)as_global(kp->qk_gain); P.mla_q_norm = (const float*)as_global(kp->mla_q_norm); P.mla_kv_norm = (const float*)as_global(kp->mla_kv_norm); P.mla_nope_gain = (const float*)as_global(kp->mla_nope_gain);
    P.mla_rope_gain = (const float*)as_global(kp->mla_rope_gain); P.w_uq = (const float*)as_global(kp->w_uq); P.w_ukv = (const float*)as_global(kp->w_ukv); P.w_out = (const float*)as_global(kp->w_out); P.rel_bias = (const float*)as_global(kp->rel_bias);
    P.ple_norm_g = (const float*)as_global(kp->ple_norm_g); P.w_ple_gate = (const float*)as_global(kp->w_ple_gate); P.w_ple_proj = (const float*)as_global(kp->w_ple_proj); P.out = (float*)as_global(kp->out); P.ws = as_global(kp->ws);
    char* ws = P.ws;
    const bf16_t* xbase = l == 0 ? (const bf16_t*)nullptr : (const bf16_t*)(ws + OFF_H);
    float* xout = l == 0 ? (float*)nullptr : P.out;
    if (PH == 0) phase_prep(P, smem);
    if (PH == 2) { gemm8((const bf16_t*)(ws + OFF_H), (const bf16_t*)(ws + OFF_WT_IN + l * SZ_WT_IN), NT, NP1, 1024, EpiIn8{P, l}, smem);
                   const int G_ = (int)gridDim.x, w0_ = G_ > 192 ? 192 : 0;
                   if (l == 0 && (int)blockIdx.x >= w0_) { __syncthreads(); constexpr int W0 = PREP_T_IN + PREP_T_UQ + PREP_T_UKV, NWL = PREP_PER_LAYER - W0;
                       for (int u = (int)blockIdx.x - w0_; u < NWL + PREP_P_UNITS / 2; u += G_ - w0_) { if (u < NWL) prep_w_unit(P, 0, W0 + u, (float*)smem); else prep_p_unit(P, u - NWL); } } }
    if (PH == 3) phase_pre(P, l, smem);
    if (PH == 4) phase_att(P, l, smem, rep);
    if (PH == 5) { for (int u = blockIdx.x; u < 1024; u += gridDim.x) dilmix_unit(P, u);
                 }
    if (PH == 8) gemm8((const bf16_t*)(ws + OFF_A2), (const bf16_t*)(ws + OFF_WT_OUT + l * SZ_WT_SQ), NT, 1024, 1024, EpiResid8{P.x, xbase, (bf16_t*)(ws + OFF_XABF), (float*)(ws + OFF_SSQA)}, smem);
    if (PH == 7) { gemm8((const bf16_t*)(ws + (l == 0 ? OFF_PB : OFF_PB2)), (const bf16_t*)(ws + OFF_WT_PP + l * SZ_WT_PP), NT, 1024, 256, EpiStoreBf{(bf16_t*)(ws + OFF_QKV)}, smem);
                   __syncthreads();
                   gemm8((const bf16_t*)(ws + OFF_XABF), (const bf16_t*)(ws + OFF_WT_PG + l * SZ_WT_SQ), NT, 1024, 1024, EpiPle8{(const bf16_t*)(ws + OFF_XABF), (const bf16_t*)(ws + OFF_QKV), xout, (const float*)(ws + OFF_SSQA), l == 0 ? (bf16_t*)(ws + OFF_H) : (bf16_t*)nullptr, (float*)(ws + OFF_SSQX)}, smem); }
}

__global__ void __launch_bounds__(NTHREADS) k_mega(Params Parg) {
    char* smem = g_smem;
    { const int t0 = (int)threadIdx.x; if (t0 < 12) ((LAS unsigned*)((LAS char*)smem + L_XB))[t0] = 0u;
      if ((t0 & 63) == 0) *(LAS int*)((LAS char*)smem + L_WTAB + 4u * (unsigned)__builtin_amdgcn_s_getreg(0x2804)) = t0 >> 6; }
    __syncthreads();
    const __attribute__((address_space(4))) Params* kp0 = (const __attribute__((address_space(4))) Params*)__builtin_amdgcn_kernarg_segment_ptr();
    xcd_barrier_post((unsigned*)(as_global(kp0->ws) + OFF_BAR));
#define XBAR() xcd_barrier((unsigned*)(as_global(kp0->ws) + OFF_BAR), (volatile LAS unsigned*)((LAS char*)smem + L_XB))
#ifdef PROBE_IDX
    unsigned long long tA = 0, tB = 0;
#define PT0(i) if (PROBE_IDX == (i)) tA = __builtin_amdgcn_s_memrealtime();
#define PT1(i) if (PROBE_IDX == (i)) tB = __builtin_amdgcn_s_memrealtime();
#else
#define PT0(i)
#define PT1(i)
#endif
    PT0(0) run_phase<0>(0, smem); XBAR(); PT1(0)
    PT0(2) run_phase<2>(0, smem); XBAR(); PT1(2) PT0(3) run_phase<3>(0, smem); XBAR(); PT1(3) PT0(4) run_phase<4>(0, smem); XBAR(); PT1(4)
    PT0(5) run_phase<5>(0, smem); XBAR(); PT1(5) PT0(6) run_phase<8>(0, smem); XBAR(); PT1(6) PT0(8) run_phase<7>(0, smem); XBAR(); PT1(8)
    run_phase<2>(1, smem); XBAR(); run_phase<3>(1, smem); XBAR(); run_phase<4>(1, smem); XBAR(); run_phase<5>(1, smem); XBAR(); run_phase<8>(1, smem); XBAR(); run_phase<7>(1, smem);
#ifdef PROBE_IDX
    if (blockIdx.x == 0) { const unsigned long long t0 = __builtin_amdgcn_s_memrealtime(), want = (tB - tA) * 32ull; while (__builtin_amdgcn_s_memrealtime() - t0 < want) __builtin_amdgcn_s_sleep(32); }
#endif
#undef XBAR
#ifdef PROBE_CLS
    if (blockIdx.x == PROBE_BLK) { __syncthreads(); const LAS unsigned* pa = (const LAS unsigned*)((LAS char*)smem + L_MISC + 32); const unsigned long long tk = pa[0], nt = pa[1] ? pa[1] : 1u;
        const unsigned long long t0 = __builtin_amdgcn_s_memrealtime(), want = tk * 128ull / nt; while (__builtin_amdgcn_s_memrealtime() - t0 < want) __builtin_amdgcn_s_sleep(32); }
#endif
}
}

extern "C" void kernel_launch(void* const* d_in, const int* in_sizes, int n_in, void* d_out, int out_size, void* d_ws, size_t ws_size, hipStream_t stream) {
    Params P{};
    P.x = (const float*)d_in[0]; P.p = (const float*)d_in[1]; P.ln_g = (const float*)d_in[2]; P.w_in = (const float*)d_in[3]; P.b_forget = (const float*)d_in[4]; P.qk_gain = (const float*)d_in[5];
    P.mla_q_norm = (const float*)d_in[6]; P.mla_kv_norm = (const float*)d_in[7]; P.mla_nope_gain = (const float*)d_in[8]; P.mla_rope_gain = (const float*)d_in[9]; P.w_uq = (const float*)d_in[10];
    P.w_ukv = (const float*)d_in[11]; P.w_out = (const float*)d_in[12]; P.rel_bias = (const float*)d_in[13]; P.ple_norm_g = (const float*)d_in[14]; P.w_ple_gate = (const float*)d_in[15]; P.w_ple_proj = (const float*)d_in[16];
    P.out = (float*)d_out; P.ws = (char*)d_ws;
    if (ws_size < WS_NEED) { fprintf(stderr, "workspace too small: %zu < %zu\n", ws_size, (size_t)WS_NEED); return; }
    static int grid_blocks = 0;
    if (!grid_blocks) {
        int dev = 0, cus = 0, per_cu = 0;
        hipGetDevice(&dev);
        hipDeviceGetAttribute(&cus, hipDeviceAttributeMultiprocessorCount, dev);
        hipOccupancyMaxActiveBlocksPerMultiprocessor(&per_cu, k_mega, NTHREADS, 0);
        if (per_cu > 1) per_cu = 1;
        grid_blocks = cus * per_cu;
    }
    hipMemsetAsync((char*)d_ws + OFF_CTR, 0, 512 + 3456 * 4, stream);
    void* args[] = {&P};
    hipError_t e = hipLaunchCooperativeKernel((void*)k_mega, dim3(grid_blocks), dim3(NTHREADS), args, 0, stream);
    if (e != hipSuccess) fprintf(stderr, "cooperative launch failed: %s (grid %d)\n", hipGetErrorString(e), grid_blocks);
}
```

```cpp
#include <hip/hip_runtime.h>
#include <hip/hip_cooperative_groups.h>
#include <cstdint>
#include <cstdio>

#ifndef ONE_LAUNCH
#define ONE_LAUNCH 1
#endif

namespace {
#define DEVINL __device__ __forceinline__
typedef unsigned short bf16_t;
typedef short bf16x8 __attribute__((ext_vector_type(8)));
typedef float f32x4 __attribute__((ext_vector_type(4)));
typedef unsigned u32x2 __attribute__((ext_vector_type(2)));
typedef unsigned u32x4 __attribute__((ext_vector_type(4)));

constexpr int NB = 4, SEQ = 4096, DM = 1024, NT = NB * SEQ, NH = 4, NBH = NB * NH;
constexpr int INW = 3748, NP1 = 3840;
constexpr float EPS = 1e-6f, LOG2E = 1.4426950408889634f;
constexpr float SC_Q = 0.125f * LOG2E;
constexpr float SC_MLA = 0.10206207261596575f * LOG2E;
constexpr int NTHREADS = 512;

constexpr size_t SZ_WT_IN = (size_t)NP1 * 1024 * 2, SZ_WT_UQ = 512 * 256 * 2  , SZ_WT_UKV = 512 * 256 * 2  , SZ_WT_SQ = 1024 * 1024 * 2, SZ_WT_PP = 1024 * 256 * 2;
constexpr size_t OFF_WT_IN = 0;
constexpr size_t OFF_WT_UQ = OFF_WT_IN + 2 * SZ_WT_IN;
constexpr size_t OFF_WT_UKV = OFF_WT_UQ + 2 * SZ_WT_UQ;
constexpr size_t OFF_WT_OUT = OFF_WT_UKV + 2 * SZ_WT_UKV;
constexpr size_t OFF_WT_PG = OFF_WT_OUT + 2 * SZ_WT_SQ;
constexpr size_t OFF_WT_PP = OFF_WT_PG + 2 * SZ_WT_SQ;
constexpr size_t OFF_LUT = OFF_WT_PP + 2 * SZ_WT_PP;
constexpr size_t OFF_ROPE = OFF_LUT + 8 * 4096 * 4;
constexpr size_t OFF_H = OFF_ROPE + 4096 * 16 * 8;
constexpr size_t SZ_HEADBUF = (size_t)NT * 256 * 2;
constexpr size_t OFF_QKV = OFF_H + (size_t)NT * 1024 * 2;
constexpr size_t OFF_XABF = OFF_QKV + (size_t)NT * 1024 * 2;
constexpr size_t OFF_CQ = OFF_QKV + 9 * SZ_HEADBUF;
constexpr size_t OFF_CKV = OFF_CQ + (size_t)NT * 256 * 2;
constexpr size_t OFF_CQSS = OFF_CKV + (size_t)NT * 256 * 2;
constexpr size_t OFF_CKVSS = OFF_CQSS + (size_t)NT * 4 * 4;
constexpr size_t OFF_LOGF = OFF_CKVSS + (size_t)NT * 2 * 4;
constexpr size_t OFF_KMEAN = OFF_LOGF + (size_t)NBH * SEQ * 4;
constexpr size_t OFF_PB = OFF_KMEAN + (size_t)NBH * 16 * 64 * 4;
constexpr size_t OFF_X = OFF_PB + (size_t)NT * 256 * 2;
constexpr size_t OFF_A2 = OFF_X;
constexpr size_t OFF_PB2 = OFF_X + (size_t)NT * 1024 * 4;
constexpr size_t OFF_SSQX = OFF_PB2 + (size_t)NT * 256 * 2;
constexpr size_t OFF_SSQA = OFF_SSQX + (size_t)NT * 16 * 4;
constexpr size_t OFF_DPART = OFF_SSQA + (size_t)NT * 16 * 4;
constexpr size_t OFF_DLSE = OFF_DPART + 3 * (size_t)NT * 256 * 2;
constexpr size_t OFF_CTR = OFF_DLSE + 3 * (size_t)NT * 4 * 4;
constexpr size_t OFF_BOUND = OFF_CTR + 256;
constexpr size_t OFF_BAR = OFF_BOUND + 256;
constexpr size_t WS_NEED = OFF_BAR + 3456 * 4;
constexpr size_t OOFF_G = 0;
constexpr size_t OOFF_QM = (size_t)NT * 1024 * 2;
constexpr size_t OOFF_KM = OOFF_QM + (size_t)NBH * SEQ * 96 * 2;
constexpr size_t OOFF_VM = OOFF_KM + (size_t)NBH * SEQ * 96 * 2;

struct Params {
    const float *x, *p, *ln_g, *w_in, *b_forget, *qk_gain, *mla_q_norm, *mla_kv_norm, *mla_nope_gain, *mla_rope_gain, *w_uq, *w_ukv, *w_out, *rel_bias, *ple_norm_g, *w_ple_gate, *w_ple_proj;
    float* out;
    char* ws;
};

DEVINL char* as_global(const void* p) { __attribute__((address_space(1))) char* g; asm volatile("" : "=s"(g) : "0"(p)); return (char*)g; }
constexpr int L_MISC = 131072;
constexpr int L_XB = L_MISC + 16, L_WTAB = L_MISC + 64, SMEM_BYTES = L_MISC + 64 + 256;
__shared__ __attribute__((aligned(16))) char g_smem[SMEM_BYTES];
DEVINL int ltid() {
    const unsigned hw = (unsigned)__builtin_amdgcn_s_getreg(0x2804);
    const int w = __builtin_amdgcn_readfirstlane(*(const __attribute__((address_space(3))) int*)((__attribute__((address_space(3))) char*)g_smem + L_WTAB + hw * 4));
    int lane; asm volatile("v_mbcnt_lo_u32_b32 %0, -1, 0\n\tv_mbcnt_hi_u32_b32 %0, -1, %0" : "=v"(lane));
    return w * 64 + lane; }
DEVINL float shx(float v, int mask) { return __int_as_float(__builtin_amdgcn_ds_bpermute(((ltid() & 63) ^ mask) << 2, __float_as_int(v))); }
DEVINL float shup(float v, int o) { return __int_as_float(__builtin_amdgcn_ds_bpermute(((ltid() & 63) - o) << 2, __float_as_int(v))); }
DEVINL float sq4(const f32x4& a) { return a[0] * a[0] + a[1] * a[1] + a[2] * a[2] + a[3] * a[3]; }
template <int XM> DEVINL float swz_xor(float v) { return __int_as_float(__builtin_amdgcn_ds_swizzle(__float_as_int(v), (XM << 10) | 0x1F)); }
DEVINL float half_swap_sum(float v) { auto rr = __builtin_amdgcn_permlane32_swap(__float_as_uint(v), __float_as_uint(v), false, false); return __uint_as_float(rr[0]) + __uint_as_float(rr[1]); }
DEVINL float wave_sum(float v) { v += swz_xor<1>(v); v += swz_xor<2>(v); v += swz_xor<4>(v); v += swz_xor<8>(v); v += swz_xor<16>(v); return half_swap_sum(v); }
DEVINL bf16_t f2bf(float f) { unsigned u = __float_as_uint(f); u += 0x7fffu + ((u >> 16) & 1u); return (bf16_t)(u >> 16); }
DEVINL float bf2f(bf16_t h) { return __uint_as_float(((unsigned)h) << 16); }
DEVINL unsigned pack2(float a, float b) { return (unsigned)f2bf(a) | ((unsigned)f2bf(b) << 16); }
typedef __bf16 bf16v2 __attribute__((ext_vector_type(2)));
typedef float f32v2 __attribute__((ext_vector_type(2)));
DEVINL unsigned cvt2(float a, float b) { f32v2 v = {a, b}; return __builtin_bit_cast(unsigned, __builtin_convertvector(v, bf16v2)); }
DEVINL float bflo(unsigned u) { return __uint_as_float(u << 16); }
DEVINL float bfhi(unsigned u) { return __uint_as_float(u & 0xffff0000u); }

__device__ __constant__ float ROPE_INV[16] = {1.0f, 0.5623413251903491f, 0.31622776601683794f, 0.1778279410038923f, 0.1f, 0.05623413251903491f, 0.03162277660168379f, 0.01778279410038923f,
                                              0.01f, 0.005623413251903491f, 0.0031622776601683794f, 0.0017782794100389228f, 0.001f, 0.0005623413251903491f, 0.00031622776601683794f, 0.00017782794100389227f};

DEVINL int t5_bucket(int d) {
    if (d < 16) return d;
    int b = 16;
    b += (d >= 22); b += (d >= 30); b += (d >= 40); b += (d >= 54); b += (d >= 73); b += (d >= 99); b += (d >= 134); b += (d >= 182);
    b += (d >= 246); b += (d >= 332); b += (d >= 450); b += (d >= 609); b += (d >= 825); b += (d >= 1117); b += (d >= 1513);
    return b;
}

DEVINL int map_w_in(int n) { return n < 768 ? n : (n < 2720 ? n + 4 : (n < 2724 ? n - 2720 + 768 : (n < 2816 ? -1 : n - 92))); }
DEVINL int virt_col(int nv) { const int v = nv & 255; return (nv & ~255) + 64 * ((v >> 5) & 3) + 32 * (v >> 7) + (v & 31); }
DEVINL int map_w_in_virt(int nv) { int a = virt_col(nv); const int chunk = a >> 6; int hc = a & 63;
    if (chunk == 42 && hc < 32) hc = 16 * ((hc >> 2) & 1) + 4 * (hc >> 3) + (hc & 3);
    return map_w_in(chunk * 64 + hc); }
DEVINL int map_w_uq_virt(int nv) { const int a = virt_col(nv), chunk = a >> 6; int hc = a & 63; if (chunk >= 6) return -1;
    if (chunk >= 4) { const int e = hc & 31; hc = (hc & 32) + 16 * ((e >> 2) & 1) + 4 * (e >> 3) + (e & 3); }
    const int n = chunk * 64 + hc; if (n < 256) return (n >> 6) * 96 + (n & 63); const int r = n - 256; return (r >> 5) * 96 + 64 + (r & 31); }
DEVINL int map_w_uq(int n) { if (n < 256) return (n >> 6) * 96 + (n & 63); const int r = n - 256; return (r >> 5) * 96 + 64 + (r & 31); }

template <int KT>
DEVINL void transpose_tile(const float* src, int Nsrc, bf16_t* dst, int K, int tn, int tk, int mode, const float* fold, float* tile  ) {
    const int tid = ltid(), c4 = (tid & 15) * 4, kr = tid >> 4  , n0 = tn * 64, k0 = tk * KT;
    const int n = n0 + c4, oc = mode == 1 ? map_w_in_virt(n) : (mode == 2 ? map_w_uq(n) : (mode == 3 ? virt_col(n) : (mode == 4 ? map_w_uq_virt(n) : (mode == 5 ? virt_col(n) : n))));
    f32x4 v[KT / 32];
#pragma unroll
    for (int i = 0; i < KT / 32; ++i) { const int kk = kr + 32 * i; v[i] = (f32x4){0.f, 0.f, 0.f, 0.f}; if (oc >= 0 && !(mode == 5 && k0 + kk >= 128)) { v[i] = __builtin_nontemporal_load((const f32x4*)(src + (size_t)(k0 + kk) * Nsrc + oc)); if (fold) v[i] = v[i] * fold[k0 + kk]; } }
    __syncthreads();
#pragma unroll
    for (int i = 0; i < KT / 32; ++i) *(f32x4*)(tile + (kr + 32 * i) * 68 + c4) = v[i];
    __syncthreads();
#pragma unroll
    for (int h = 0; h < KT / 64; ++h) { const int nn = tid & 63, kc = h * 64 + (tid >> 6) * 8; const float* tp = tile + kc * 68 + nn; u32x4 w;
      w.x = cvt2(tp[0], tp[68]); w.y = cvt2(tp[136], tp[204]); w.z = cvt2(tp[272], tp[340]); w.w = cvt2(tp[408], tp[476]);
      *(u32x4*)(dst + (size_t)(n0 + nn) * K + k0 + kc) = w; }
}

constexpr int PREP_T_IN = 60 * 4, PREP_T_UQ = 8 * 1, PREP_T_UKV = 8 * 1, PREP_T_SQ = 16 * 4, PREP_T_PP = 16 * 1;
constexpr int PREP_PER_LAYER = PREP_T_IN + PREP_T_UQ + PREP_T_UKV + 2 * PREP_T_SQ + PREP_T_PP;
constexpr int PREP_LUT_UNITS = 8 * 4096 / 512, PREP_ROPE_UNITS = 4096 * 16 / 512;
constexpr int PREP_X_UNITS = NT / 32, PREP_P_UNITS = 2 * NT / 64;
constexpr int PREP_UNITS = 2 * PREP_PER_LAYER + PREP_LUT_UNITS + PREP_ROPE_UNITS + PREP_X_UNITS + PREP_P_UNITS;

DEVINL void prep_w_unit(const Params& P, int l, int r, float* tile) {
    if (r < PREP_T_IN) { transpose_tile<256>(P.w_in + (size_t)l * 1024 * INW, INW, (bf16_t*)(P.ws + OFF_WT_IN + l * SZ_WT_IN), 1024, r % 60, r / 60, 1, P.ln_g + l * DM, tile); return; }
    r -= PREP_T_IN;
    if (r < PREP_T_UQ) { transpose_tile<256>(P.w_uq + (size_t)l * 256 * 384, 384, (bf16_t*)(P.ws + OFF_WT_UQ + l * SZ_WT_UQ), 256, r % 8, r / 8, 4, P.mla_q_norm + l * 256, tile); return; }
    r -= PREP_T_UQ;
    if (r < PREP_T_UKV) { transpose_tile<256>(P.w_ukv + (size_t)l * 128 * 512, 512, (bf16_t*)(P.ws + OFF_WT_UKV + l * SZ_WT_UKV), 256, r % 8, r / 8, 5, P.mla_kv_norm + l * 128, tile); return; }
    r -= PREP_T_UKV;
    if (r < PREP_T_SQ) { transpose_tile<256>(P.w_out + (size_t)l * 1024 * 1024, 1024, (bf16_t*)(P.ws + OFF_WT_OUT + l * SZ_WT_SQ), 1024, r % 16, r / 16, 3, nullptr, tile); return; }
    r -= PREP_T_SQ;
    if (r < PREP_T_SQ) { transpose_tile<256>(P.w_ple_gate + (size_t)l * 1024 * 1024, 1024, (bf16_t*)(P.ws + OFF_WT_PG + l * SZ_WT_SQ), 1024, r % 16, r / 16, 3, P.ple_norm_g + l * DM, tile); return; }
    r -= PREP_T_SQ;
    transpose_tile<256>(P.w_ple_proj + (size_t)l * 256 * 1024, 1024, (bf16_t*)(P.ws + OFF_WT_PP + l * SZ_WT_PP), 256, r % 16, r / 16, 3, nullptr, tile);
}
DEVINL void prep_p_unit(const Params& P, int v) {
    const int wid = ltid() >> 6, lane = ltid() & 63; f32x4 a[8];
#pragma unroll
    for (int rr = 0; rr < 8; ++rr) a[rr] = __builtin_nontemporal_load((const f32x4*)(P.p + (size_t)(v * 64 + wid * 8 + rr) * 256 + lane * 4));
#pragma unroll
    for (int rr = 0; rr < 8; ++rr) { const int row = v * 64 + wid * 8 + rr; u32x2 w; w.x = cvt2(a[rr][0], a[rr][1]); w.y = cvt2(a[rr][2], a[rr][3]);
        bf16_t* pb = row < NT ? (bf16_t*)(P.ws + OFF_PB) + (size_t)row * 256 : (bf16_t*)(P.ws + OFF_PB2) + (size_t)(row - NT) * 256; *(u32x2*)(pb + lane * 4) = w; }
}
DEVINL void phase_prep(const Params& P, char* smem) {
    float* tile = (float*)smem;
    if (blockIdx.x == 0) {
        const int w_ = ltid() >> 6, ln_ = ltid() & 63, l = w_ >> 2, md = w_ & 3; float bound;
        auto amax = [&](const float* p, int n) { float a = 0.f; for (int i = ln_; i < n; i += 64) a = fmaxf(a, fabsf(p[i]));
            a = fmaxf(a, swz_xor<1>(a)); a = fmaxf(a, swz_xor<2>(a)); a = fmaxf(a, swz_xor<4>(a)); a = fmaxf(a, swz_xor<8>(a)); a = fmaxf(a, swz_xor<16>(a));
            auto rr = __builtin_amdgcn_permlane32_swap(__float_as_uint(a), __float_as_uint(a), false, false); return fmaxf(__uint_as_float(rr[0]), __uint_as_float(rr[1])); };
        if (md == 2) { const float nq = amax(P.mla_nope_gain + (l * 2 + 0) * 64, 64), nk = amax(P.mla_nope_gain + (l * 2 + 1) * 64, 64), rq = amax(P.mla_rope_gain + (l * 2 + 0) * 32, 32), rk = amax(P.mla_rope_gain + (l * 2 + 1) * 32, 32);
            bound = sqrtf(64.f * nq * nq + 32.f * rq * rq) * sqrtf(64.f * nk * nk + 32.f * rk * rk) * SC_MLA; }
        else { const int mix = md == 0 ? 0 : (md == 1 ? 1 : 2); bound = 64.f * amax(P.qk_gain + (l * 6 + 2 * mix) * 64, 64) * amax(P.qk_gain + (l * 6 + 2 * mix + 1) * 64, 64) * SC_Q;
            if (md == 0) bound += 8.f; else bound += amax(P.rel_bias, 256) * LOG2E; }
        if (ln_ == 0) ((float*)(P.ws + OFF_BOUND))[l * 4 + md] = bound;
    }
    constexpr int U_W = PREP_PER_LAYER, U_LUT = U_W + PREP_LUT_UNITS, U_ROPE = U_LUT + PREP_ROPE_UNITS, U_X = U_ROPE + PREP_X_UNITS, U_P = U_X + PREP_P_UNITS / 2;
    for (int u = blockIdx.x; u < U_P; u += gridDim.x) {
        if (u < U_W) { if (u < PREP_T_IN + PREP_T_UQ + PREP_T_UKV) prep_w_unit(P, 0, u, tile); }
        else if (u < U_LUT) { const int e = (u - U_W) * 512 + ltid(), hh = e >> 12, d = e & 4095; ((float*)(P.ws + OFF_LUT))[e] = P.rel_bias[t5_bucket(d) * 8 + hh] * LOG2E; }
        else if (u < U_ROPE) { const int e = (u - U_LUT) * 512 + ltid(), pos = e >> 4, i = e & 15;
            const double rev = (double)pos * (double)ROPE_INV[i] * 0.15915494309189535; const float fr = (float)(rev - floor(rev));
            ((float2*)(P.ws + OFF_ROPE))[e] = make_float2(__builtin_amdgcn_cosf(fr), __builtin_amdgcn_sinf(fr)); }
        else if (u < U_X) { const int v = u - U_ROPE, wid = ltid() >> 6, lane = ltid() & 63;
            f32x4 a[4][4];
#pragma unroll
            for (int rr = 0; rr < 4; ++rr)
#pragma unroll
                for (int i = 0; i < 4; ++i) a[rr][i] = __builtin_nontemporal_load((const f32x4*)(P.x + (size_t)(v * 32 + wid * 4 + rr) * DM + i * 256 + lane * 4));
#pragma unroll
            for (int rr = 0; rr < 4; ++rr) { const int row = v * 32 + wid * 4 + rr; float ss = 0.f;
#pragma unroll
                for (int i = 0; i < 4; ++i) { ss += sq4(a[rr][i]); u32x2 w; w.x = cvt2(a[rr][i][0], a[rr][i][1]); w.y = cvt2(a[rr][i][2], a[rr][i][3]); *(u32x2*)((bf16_t*)(P.ws + OFF_H) + (size_t)row * DM + i * 256 + lane * 4) = w; }
                ss = wave_sum(ss); if (lane < 16) ((float*)(P.ws + OFF_SSQX))[(size_t)row * 16 + lane] = lane == 0 ? ss : 0.f;
                if (lane < 16) *(u32x4*)((bf16_t*)(P.ws + OFF_CKV) + (size_t)row * 256 + 128 + lane * 8) = (u32x4){0u, 0u, 0u, 0u}; } }
        else {   }
    }
}

DEVINL void phase_rms(const float* src, const float* g, bf16_t* dst, const float* psrc, bf16_t* pb) {
    const int wid = ltid() >> 6, lane = ltid() & 63;
    for (int u = blockIdx.x; u < NT / 8; u += gridDim.x) {
        const int row = u * 8 + wid; const float* xr = src + (size_t)row * DM;
        f32x4 v[4]; float ss = 0.f;
#pragma unroll
        for (int i = 0; i < 4; ++i) { v[i] = *(const f32x4*)(xr + i * 256 + lane * 4); ss += v[i][0] * v[i][0] + v[i][1] * v[i][1] + v[i][2] * v[i][2] + v[i][3] * v[i][3]; }
        ss = wave_sum(ss); const float r = rsqrtf(ss * (1.0f / DM) + EPS);
#pragma unroll
        for (int i = 0; i < 4; ++i) { const f32x4 gg = *(const f32x4*)(g + i * 256 + lane * 4); u32x2 w; w.x = pack2(v[i][0] * r * gg[0], v[i][1] * r * gg[1]); w.y = pack2(v[i][2] * r * gg[2], v[i][3] * r * gg[3]);
            *(u32x2*)(dst + (size_t)row * DM + i * 256 + lane * 4) = w; }
        if (psrc) { const f32x4 pv = *(const f32x4*)(psrc + (size_t)row * 256 + lane * 4); u32x2 w; w.x = pack2(pv[0], pv[1]); w.y = pack2(pv[2], pv[3]); *(u32x2*)(pb + (size_t)row * 256 + lane * 4) = w; }
    }
}

constexpr int GST = 40;
template <class Epi>
DEVINL void gemm_phase(const bf16_t* A, const bf16_t* Bt, int M, int N, int K, const Epi& epi, char* smem) {
    bf16_t* As = (bf16_t*)smem; bf16_t* Bs = As + 256 * GST;
    const int tid = ltid(), wid = tid >> 6, lane = tid & 63, wr = wid >> 1, wc = wid & 1, fr = lane & 15, fq = lane >> 4;
    const int ntm = M / 256, ntn = N / 128, nk = K / 32;
    const int lr = tid >> 2, lc = (tid & 3) * 8;
    for (int tile = blockIdx.x; tile < ntm * ntn; tile += gridDim.x) {
        const int tm = tile % ntm, tn = tile / ntm;
        const bf16_t* Ag = A + (size_t)(tm * 256 + lr) * K + lc; const bf16_t* Bg = Bt + (size_t)(tn * 128 + lr) * K + lc;
        f32x4 acc[4][4];
#pragma unroll
        for (int m = 0; m < 4; ++m)
#pragma unroll
            for (int n = 0; n < 4; ++n) acc[m][n] = (f32x4){0.f, 0.f, 0.f, 0.f};
        u32x4 ra0 = *(const u32x4*)Ag, ra1 = *(const u32x4*)(Ag + (size_t)128 * K), rb0 = *(const u32x4*)Bg;
        for (int kt = 0; kt < nk; ++kt) {
            __syncthreads();
            *(u32x4*)(As + lr * GST + lc) = ra0; *(u32x4*)(As + (lr + 128) * GST + lc) = ra1; *(u32x4*)(Bs + lr * GST + lc) = rb0;
            __syncthreads();
            if (kt + 1 < nk) { const int ko = (kt + 1) * 32; ra0 = *(const u32x4*)(Ag + ko); ra1 = *(const u32x4*)(Ag + (size_t)128 * K + ko); rb0 = *(const u32x4*)(Bg + ko); }
            bf16x8 af[4], bfr[4];
#pragma unroll
            for (int m = 0; m < 4; ++m) af[m] = *(const bf16x8*)(As + (wr * 64 + m * 16 + fr) * GST + fq * 8);
#pragma unroll
            for (int n = 0; n < 4; ++n) bfr[n] = *(const bf16x8*)(Bs + (wc * 64 + n * 16 + fr) * GST + fq * 8);
#pragma unroll
            for (int m = 0; m < 4; ++m)
#pragma unroll
                for (int n = 0; n < 4; ++n) acc[m][n] = __builtin_amdgcn_mfma_f32_16x16x32_bf16(bfr[n], af[m], acc[m][n], 0, 0, 0);
        }
        epi(acc, tm * 256 + wr * 64, tn * 2 + wc, fr, fq);
    }
    __syncthreads();
}

DEVINL float quad_sum(float v) { v += swz_xor<16>(v); return half_swap_sum(v); }
DEVINL void store4bf(bf16_t* p, float a, float b, float c, float d) { u32x2 w; w.x = pack2(a, b); w.y = pack2(c, d); *(u32x2*)p = w; }
DEVINL float fsigmoid(float z) { return __builtin_amdgcn_rcpf(1.0f + __builtin_amdgcn_exp2f(-LOG2E * z)); }
DEVINL float log_sigmoid(float z) { return fminf(z, 0.f) - log1pf(__expf(-fabsf(z))); }

struct EpiIn {
    Params P; int l;
    DEVINL void operator()(f32x4 (&acc)[4][4], int row0, int chunk, int fr, int fq) const {
        char* ws = P.ws; char* ob = (char*)P.out;
        if (chunk < 36) {
            const int g = chunk >> 2, h = chunk & 3, role = g % 3, mix = g / 3;
            bf16_t* dst = (bf16_t*)(ws + OFF_QKV + (size_t)g * SZ_HEADBUF);
            const float* gain = P.qk_gain + ((size_t)l * 6 + 2 * mix + (role == 1 ? 1 : 0)) * 64;
#pragma unroll
            for (int m = 0; m < 4; ++m) {
                const int t = row0 + 16 * m + fr, b = t >> 12, s = t & 4095; bf16_t* d = dst + ((size_t)(b * 4 + h) * SEQ + s) * 64 + 4 * fq;
                float r = 1.f;
                if (role != 2) { float ss = 0.f;
#pragma unroll
                    for (int n = 0; n < 4; ++n) ss += acc[m][n][0] * acc[m][n][0] + acc[m][n][1] * acc[m][n][1] + acc[m][n][2] * acc[m][n][2] + acc[m][n][3] * acc[m][n][3];
                    ss = quad_sum(ss); r = rsqrtf(ss * (1.0f / 64.0f) + EPS) * (role == 0 ? SC_Q : 1.0f); }
#pragma unroll
                for (int n = 0; n < 4; ++n) { f32x4 gg = (f32x4){1.f, 1.f, 1.f, 1.f}; if (role != 2) gg = *(const f32x4*)(gain + 16 * n + 4 * fq);
                    store4bf(d + 16 * n, acc[m][n][0] * r * gg[0], acc[m][n][1] * r * gg[1], acc[m][n][2] * r * gg[2], acc[m][n][3] * r * gg[3]); }
            }
        } else if (chunk < 42) {
            const bool isq = chunk < 40; const int c = isq ? chunk - 36 : chunk - 40;
            bf16_t* dst = isq ? (bf16_t*)(ws + OFF_CQ) : (bf16_t*)(ws + OFF_CKV); const int ld = isq ? 256 : 128;
            float* ssp = isq ? (float*)(ws + OFF_CQSS) : (float*)(ws + OFF_CKVSS); const int nss = isq ? 4 : 2;
#pragma unroll
            for (int m = 0; m < 4; ++m) {
                const int t = row0 + 16 * m + fr; float ss = 0.f;
#pragma unroll
                for (int n = 0; n < 4; ++n) { ss += acc[m][n][0] * acc[m][n][0] + acc[m][n][1] * acc[m][n][1] + acc[m][n][2] * acc[m][n][2] + acc[m][n][3] * acc[m][n][3];
                    store4bf(dst + (size_t)t * ld + c * 64 + 16 * n + 4 * fq, acc[m][n][0], acc[m][n][1], acc[m][n][2], acc[m][n][3]); }
                ss = quad_sum(ss); if (fq == 0) ssp[(size_t)t * nss + c] = ss;
            }
        } else if (chunk == 42) {
            const float* gr = P.mla_rope_gain + ((size_t)l * 2 + 1) * 32; const float2* rope = (const float2*)(ws + OFF_ROPE);
            bf16_t* km = (bf16_t*)(ob + OOFF_KM); float* logf_ = (float*)(ws + OFF_LOGF);
            const f32x4 g1 = *(const f32x4*)(gr + 4 * fq), g2 = *(const f32x4*)(gr + 16 + 4 * fq); const f32x4 bfv = *(const f32x4*)(P.b_forget + l * 4);
#pragma unroll
            for (int m = 0; m < 4; ++m) {
                const int t = row0 + 16 * m + fr, b = t >> 12, s = t & 4095;
                float ss = 0.f;
#pragma unroll
                for (int n = 0; n < 2; ++n) ss += acc[m][n][0] * acc[m][n][0] + acc[m][n][1] * acc[m][n][1] + acc[m][n][2] * acc[m][n][2] + acc[m][n][3] * acc[m][n][3];
                ss = quad_sum(ss); const float r = rsqrtf(ss * (1.0f / 32.0f) + EPS);
                float o1[4], o2[4];
#pragma unroll
                for (int j = 0; j < 4; ++j) { const float2 cs = rope[s * 16 + 4 * fq + j]; const float x1 = acc[m][0][j] * r * g1[j], x2 = acc[m][1][j] * r * g2[j]; o1[j] = x1 * cs.x - x2 * cs.y; o2[j] = x1 * cs.y + x2 * cs.x; }
#pragma unroll
                for (int h = 0; h < 4; ++h) { bf16_t* d = km + ((size_t)(b * 4 + h) * SEQ + s) * 96 + 64 + 4 * fq; store4bf(d, o1[0], o1[1], o1[2], o1[3]); store4bf(d + 16, o2[0], o2[1], o2[2], o2[3]); }
                if (fq == 0) {
#pragma unroll
                    for (int j = 0; j < 4; ++j) logf_[(size_t)(b * 4 + j) * SEQ + s] = log_sigmoid(acc[m][2][j] + bfv[j]) * LOG2E;
                }
            }
        } else if (chunk >= 44) {
            bf16_t* G = (bf16_t*)(ob + OOFF_G); const int c0 = (chunk - 44) * 64;
#pragma unroll
            for (int m = 0; m < 4; ++m) { const int t = row0 + 16 * m + fr;
#pragma unroll
                for (int n = 0; n < 4; ++n) { float o[4];
#pragma unroll
                    for (int j = 0; j < 4; ++j) { const float z = acc[m][n][j]; o[j] = z / (1.0f + __expf(-z)); }
                    store4bf(G + (size_t)t * DM + c0 + 16 * n + 4 * fq, o[0], o[1], o[2], o[3]); } }
        }
    }
};

struct EpiUq {
    Params P; int l;
    DEVINL void operator()(f32x4 (&acc)[4][4], int row0, int chunk, int fr, int fq) const {
        const float* cqss = (const float*)(P.ws + OFF_CQSS); bf16_t* qm = (bf16_t*)((char*)P.out + OOFF_QM); const float2* rope = (const float2*)(P.ws + OFF_ROPE);
#pragma unroll
        for (int m = 0; m < 4; ++m) {
            const int t = row0 + 16 * m + fr, b = t >> 12, s = t & 4095; const f32x4 pss = *(const f32x4*)(cqss + (size_t)t * 4);
            const float rt = rsqrtf((pss[0] + pss[1] + pss[2] + pss[3]) * (1.0f / 256.0f) + EPS);
            if (chunk < 4) {
                const float* gain = P.mla_nope_gain + ((size_t)l * 2 + 0) * 64; float ss = 0.f;
#pragma unroll
                for (int n = 0; n < 4; ++n) { acc[m][n] = acc[m][n] * rt; ss += acc[m][n][0] * acc[m][n][0] + acc[m][n][1] * acc[m][n][1] + acc[m][n][2] * acc[m][n][2] + acc[m][n][3] * acc[m][n][3]; }
                ss = quad_sum(ss); const float r = rsqrtf(ss * (1.0f / 64.0f) + EPS) * SC_MLA; bf16_t* d = qm + ((size_t)(b * 4 + chunk) * SEQ + s) * 96 + 4 * fq;
#pragma unroll
                for (int n = 0; n < 4; ++n) { const f32x4 gg = *(const f32x4*)(gain + 16 * n + 4 * fq); store4bf(d + 16 * n, acc[m][n][0] * r * gg[0], acc[m][n][1] * r * gg[1], acc[m][n][2] * r * gg[2], acc[m][n][3] * r * gg[3]); }
            } else {
                const float* gr = P.mla_rope_gain + ((size_t)l * 2 + 0) * 32; const f32x4 g1 = *(const f32x4*)(gr + 4 * fq), g2 = *(const f32x4*)(gr + 16 + 4 * fq);
#pragma unroll
                for (int hh = 0; hh < 2; ++hh) {
                    const int h = (chunk - 4) * 2 + hh; float ss = 0.f;
#pragma unroll
                    for (int n = 0; n < 2; ++n) { acc[m][2 * hh + n] = acc[m][2 * hh + n] * rt; const f32x4 a = acc[m][2 * hh + n]; ss += a[0] * a[0] + a[1] * a[1] + a[2] * a[2] + a[3] * a[3]; }
                    ss = quad_sum(ss); const float r = rsqrtf(ss * (1.0f / 32.0f) + EPS);
                    float o1[4], o2[4];
#pragma unroll
                    for (int j = 0; j < 4; ++j) { const float2 cs = rope[s * 16 + 4 * fq + j]; const float x1 = acc[m][2 * hh][j] * r * g1[j], x2 = acc[m][2 * hh + 1][j] * r * g2[j];
                        o1[j] = (x1 * cs.x - x2 * cs.y) * SC_MLA; o2[j] = (x1 * cs.y + x2 * cs.x) * SC_MLA; }
                    bf16_t* d = qm + ((size_t)(b * 4 + h) * SEQ + s) * 96 + 64 + 4 * fq; store4bf(d, o1[0], o1[1], o1[2], o1[3]); store4bf(d + 16, o2[0], o2[1], o2[2], o2[3]);
                }
            }
        }
    }
};
struct EpiUkv {
    Params P; int l;
    DEVINL void operator()(f32x4 (&acc)[4][4], int row0, int chunk, int fr, int fq) const {
        const float* ckvss = (const float*)(P.ws + OFF_CKVSS); bf16_t* km = (bf16_t*)((char*)P.out + OOFF_KM); bf16_t* vm = (bf16_t*)((char*)P.out + OOFF_VM);
        const int h = chunk >> 1; const bool isk = (chunk & 1) == 0; const float* gain = P.mla_nope_gain + ((size_t)l * 2 + 1) * 64;
#pragma unroll
        for (int m = 0; m < 4; ++m) {
            const int t = row0 + 16 * m + fr, b = t >> 12, s = t & 4095; const float rt = rsqrtf((ckvss[(size_t)t * 2] + ckvss[(size_t)t * 2 + 1]) * (1.0f / 128.0f) + EPS);
            float ss = 0.f;
#pragma unroll
            for (int n = 0; n < 4; ++n) { acc[m][n] = acc[m][n] * rt; ss += acc[m][n][0] * acc[m][n][0] + acc[m][n][1] * acc[m][n][1] + acc[m][n][2] * acc[m][n][2] + acc[m][n][3] * acc[m][n][3]; }
            if (isk) { ss = quad_sum(ss); const float r = rsqrtf(ss * (1.0f / 64.0f) + EPS); bf16_t* d = km + ((size_t)(b * 4 + h) * SEQ + s) * 96 + 4 * fq;
#pragma unroll
                for (int n = 0; n < 4; ++n) { const f32x4 gg = *(const f32x4*)(gain + 16 * n + 4 * fq); store4bf(d + 16 * n, acc[m][n][0] * r * gg[0], acc[m][n][1] * r * gg[1], acc[m][n][2] * r * gg[2], acc[m][n][3] * r * gg[3]); }
            } else { bf16_t* d = vm + ((size_t)(b * 4 + h) * SEQ + s) * 64 + 4 * fq;
#pragma unroll
                for (int n = 0; n < 4; ++n) store4bf(d + 16 * n, acc[m][n][0], acc[m][n][1], acc[m][n][2], acc[m][n][3]); }
        }
    }
};
struct EpiResid { const float* base; float* out;
    DEVINL void operator()(f32x4 (&acc)[4][4], int row0, int chunk, int fr, int fq) const {
#pragma unroll
        for (int m = 0; m < 4; ++m) { const size_t o = (size_t)(row0 + 16 * m + fr) * DM + chunk * 64 + 4 * fq;
#pragma unroll
            for (int n = 0; n < 4; ++n) { const f32x4 bv = *(const f32x4*)(base + o + 16 * n); *(f32x4*)(out + o + 16 * n) = bv + acc[m][n]; } } } };
struct EpiStore { float* out;
    DEVINL void operator()(f32x4 (&acc)[4][4], int row0, int chunk, int fr, int fq) const {
#pragma unroll
        for (int m = 0; m < 4; ++m) { const size_t o = (size_t)(row0 + 16 * m + fr) * DM + chunk * 64 + 4 * fq;
#pragma unroll
            for (int n = 0; n < 4; ++n) *(f32x4*)(out + o + 16 * n) = acc[m][n]; } } };
struct EpiPle { const float* xa; const float* pp; float* out;
    DEVINL void operator()(f32x4 (&acc)[4][4], int row0, int chunk, int fr, int fq) const {
#pragma unroll
        for (int m = 0; m < 4; ++m) { const size_t o = (size_t)(row0 + 16 * m + fr) * DM + chunk * 64 + 4 * fq;
#pragma unroll
            for (int n = 0; n < 4; ++n) { const f32x4 xv = *(const f32x4*)(xa + o + 16 * n), pv = *(const f32x4*)(pp + o + 16 * n); f32x4 r;
#pragma unroll
                for (int j = 0; j < 4; ++j) r[j] = xv[j] + pv[j] / (1.0f + __expf(-acc[m][n][j]));
                *(f32x4*)(out + o + 16 * n) = r; } } } };

namespace pg8 {
#define PG8_LAS __attribute__((address_space(3)))
constexpr int BM = 256, BK = 64, HALF = 128, HTB = HALF * BK * 2  , STAGE_BYTES = 8 * HTB, NXCD = 8, WGM = 8;

__host__ __device__ __forceinline__ int lds_byte(int r, int c) { const int st = (r >> 4) * 2 + (c >> 5), rr = r & 15, cc = c & 31, ob = rr * 64 + cc * 2; return st * 1024 + (ob ^ (((ob >> 9) & 1) << 5)); }
__host__ __device__ __forceinline__ void stage_rc(int b, int& R, int& C) { const int st = b / 1024, sb = b % 1024, swz = sb ^ (((sb >> 9) & 1) << 5); R = (st >> 1) * 16 + swz / 64; C = (st & 1) * 32 + (swz % 64) / 2; }
__host__ __device__ __forceinline__ int perm32(int rho) { const int n = rho >> 4, i = rho & 15; return 8 * (i >> 2) + 4 * n + (i & 3); }

struct Unit { int pm, pn; };
struct Gemm { const bf16_t* A; const bf16_t* Bt; int M, N, K; };

struct StaticOrder {
    int nM, nN, nwg, G, c;
    __host__ __device__ void init(int M, int N, int G_, int c_) { nM = M / BM; nN = N / BM; nwg = nM * nN; G = G_; c = c_; }
    __host__ __device__ bool next(int i, Unit& u) const {
        const long L = (long)i * G + c; if (L >= nwg) return false;
        int wgid = (int)L; { const int q = nwg / NXCD, r = nwg % NXCD, xcd = wgid % NXCD, off = wgid / NXCD; wgid = (xcd < r ? xcd * (q + 1) : r * (q + 1) + (xcd - r) * q) + off; }
        const int nig = WGM * nN, gid = wgid / nig, fm = gid * WGM, gsz = (nM - fm) < WGM ? (nM - fm) : WGM;
        u.pm = fm + ((wgid % nig) % gsz); u.pn = (wgid % nig) / gsz; return true;
    }
    __device__ __forceinline__ void a_ready(const Unit&) const {}
    __device__ __forceinline__ void done(const Unit&) const {}
};

template <class Epi, class Sched, bool ALIGN_EPI = false, bool SP2 = false>
__device__ __forceinline__ void gemm_phase(PG8_LAS unsigned char* lds, const Gemm g, const Sched& S, const Epi& E) {
    const int tid = ltid(), wid = __builtin_amdgcn_readfirstlane(tid >> 6), lane = tid & 63, wr = wid >> 2, wc = wid & 3, fr = lane & 15, fq = lane >> 4;
    const int K = g.K, nt = K / BK;
    unsigned voffA[2], voffB[2];
#pragma unroll
    for (int i = 0; i < 2; ++i) { int R, C; stage_rc(tid * 16 + i * 8192, R, C); const int Rb = Epi::PERM ? ((R & ~31) + perm32(R & 31)) : R;
        voffA[i] = (unsigned)(R * K + C) * 2u; voffB[i] = (unsigned)(Rb * K + C) * 2u; }
    const size_t kstep = (size_t)(BK * 2);
    const size_t hstep = (size_t)HALF * K * 2;
    const size_t tstep = 2 * hstep;
    const unsigned ldsw = (unsigned)wid * 1024u;
    const int aoff = lds_byte(wr * 64 + fr, fq * 8), boff = lds_byte(wc * 32 + fr, fq * 8);
    PG8_LAS unsigned char* ldsA = lds + aoff; PG8_LAS unsigned char* ldsB = lds + 65536 + boff; asm volatile("" : "+v"(ldsA), "+v"(ldsB));
#define PG8_SA(b, h) (((b) * 2 + (h)) * HTB)
#define PG8_SB(b, h) ((4 + (b) * 2 + (h)) * HTB)
#define PG8_STAGE(bufoff, gbase, voff) do { _Pragma("unroll") for (int _i = 0; _i < 2; ++_i) \
        __builtin_amdgcn_global_load_lds((const unsigned*)((const char*)(gbase) + (voff)[_i]), (PG8_LAS unsigned*)(lds + (bufoff) + ldsw + _i * 8192), 16, 0, 0); } while (0)
#define PG8_LDA(dst, b, h) do { _Pragma("unroll") for (int m = 0; m < 4; ++m) _Pragma("unroll") for (int k = 0; k < 2; ++k) dst[m][k] = *(const PG8_LAS bf16x8*)(ldsA + PG8_SA(b, h) + m * 2048 + k * 1024); } while (0)
#define PG8_LDB(dst, b, h) do { _Pragma("unroll") for (int n = 0; n < 2; ++n) _Pragma("unroll") for (int k = 0; k < 2; ++k) dst[n][k] = *(const PG8_LAS bf16x8*)(ldsB + (PG8_SB(b, h) - 65536) + n * 2048 + k * 1024); } while (0)
#define PG8_MMA(ai, bj, At, Bt) do { __builtin_amdgcn_s_setprio(1); _Pragma("unroll") for (int m = 0; m < 4; ++m) _Pragma("unroll") for (int n = 0; n < 2; ++n) _Pragma("unroll") for (int k = 0; k < 2; ++k) \
        acc[ai][bj][m][n] = __builtin_amdgcn_mfma_f32_16x16x32_bf16(Bt[n][k], At[m][k], acc[ai][bj][m][n], 0, 0, 0); __builtin_amdgcn_s_setprio(0); } while (0)
#define PG8_WAIT_V(n) asm volatile("s_waitcnt vmcnt(" #n ")" ::: "memory")
#define PG8_WAIT_L(n) asm volatile("s_waitcnt lgkmcnt(" #n ")" ::: "memory")
#define PG8_BAR __builtin_amdgcn_s_barrier()
#define PG8_SCHED __builtin_amdgcn_sched_barrier(0)
    Unit cur, nxt; int ui = 0;
    if (!S.next(0, cur)) return;
    f32x4 acc[2][2][4][2];
#pragma unroll
    for (int a = 0; a < 2; ++a)
#pragma unroll
        for (int b = 0; b < 2; ++b)
#pragma unroll
            for (int m = 0; m < 4; ++m)
#pragma unroll
                for (int n = 0; n < 2; ++n) acc[a][b][m][n] = (f32x4){0.f, 0.f, 0.f, 0.f};
    bf16x8 At[4][2], B0[2][2], B1[2][2];
    const char* cA = (const char*)g.A + (size_t)cur.pm * tstep; const char* cB = (const char*)g.Bt + (size_t)cur.pn * tstep;
    S.a_ready(cur);
    if constexpr (SP2) {
        PG8_STAGE(PG8_SB(0, 0), cB, voffB); PG8_STAGE(PG8_SB(0, 1), cB + hstep, voffB); PG8_STAGE(PG8_SA(0, 0), cA, voffA); PG8_STAGE(PG8_SA(0, 1), cA + hstep, voffA);
        if (wr == 1) PG8_BAR;
        PG8_WAIT_V(2); PG8_BAR;
        PG8_STAGE(PG8_SB(1, 0), cB + kstep, voffB); PG8_STAGE(PG8_SA(1, 0), cA + kstep, voffA); PG8_STAGE(PG8_SB(1, 1), cB + hstep + kstep, voffB);
        PG8_WAIT_V(6); PG8_BAR;
    } else {
        PG8_STAGE(PG8_SB(0, 0), cB, voffB); PG8_STAGE(PG8_SA(0, 0), cA, voffA); PG8_STAGE(PG8_SB(0, 1), cB + hstep, voffB); PG8_STAGE(PG8_SA(0, 1), cA + hstep, voffA);
        if (wr == 1) PG8_BAR;
        PG8_WAIT_V(4); PG8_BAR;
        PG8_STAGE(PG8_SB(1, 0), cB + kstep, voffB); PG8_STAGE(PG8_SA(1, 0), cA + kstep, voffA); PG8_STAGE(PG8_SB(1, 1), cB + hstep + kstep, voffB);
        PG8_WAIT_V(6); PG8_BAR;
    }
    for (;;) {
        const bool has_next = S.next(ui + 1, nxt);
        const char* nA = has_next ? (const char*)g.A + (size_t)nxt.pm * tstep : cA; const char* nB = has_next ? (const char*)g.Bt + (size_t)nxt.pn * tstep : cB;
        for (int t = 0; t < nt; t += 2) {
            const bool last = (t == nt - 2);
            const char* a1 = cA + (size_t)(t + 1) * kstep;
            const char* a2 = last ? nA : cA + (size_t)(t + 2) * kstep; const char* b2 = last ? nB : cB + (size_t)(t + 2) * kstep;
            const char* a3 = a2 + kstep; const char* b3 = b2 + kstep;
            if (last && has_next) S.a_ready(nxt);
            if constexpr (SP2) {
            PG8_LDB(B0, 0, 0); PG8_LDB(B1, 0, 1); PG8_SCHED; PG8_LDA(At, 0, 0); PG8_STAGE(PG8_SA(1, 1), a1 + hstep, voffA);
            PG8_WAIT_V(8); PG8_WAIT_L(0); PG8_BAR; PG8_MMA(0, 0, At, B0); PG8_MMA(0, 1, At, B1); PG8_BAR; PG8_SCHED;
            PG8_LDA(At, 0, 1); PG8_STAGE(PG8_SB(0, 0), b2, voffB); PG8_STAGE(PG8_SB(0, 1), b2 + hstep, voffB); PG8_STAGE(PG8_SA(0, 0), a2, voffA);
            PG8_WAIT_V(8); PG8_WAIT_L(0); PG8_BAR; PG8_MMA(1, 0, At, B0); PG8_MMA(1, 1, At, B1); PG8_BAR; PG8_SCHED;
            PG8_LDB(B0, 1, 0); PG8_LDB(B1, 1, 1); PG8_SCHED; PG8_LDA(At, 1, 0); PG8_STAGE(PG8_SA(0, 1), a2 + hstep, voffA);
            PG8_WAIT_V(8); PG8_WAIT_L(0); PG8_BAR; PG8_MMA(0, 0, At, B0); PG8_MMA(0, 1, At, B1); PG8_BAR; PG8_SCHED;
            PG8_LDA(At, 1, 1); PG8_STAGE(PG8_SB(1, 0), b3, voffB); PG8_STAGE(PG8_SB(1, 1), b3 + hstep, voffB); PG8_STAGE(PG8_SA(1, 0), a3, voffA);
            PG8_WAIT_V(8); PG8_WAIT_L(0); PG8_BAR; PG8_MMA(1, 0, At, B0); PG8_MMA(1, 1, At, B1); PG8_BAR; PG8_SCHED;
            } else {
            PG8_LDB(B0, 0, 0); PG8_SCHED; PG8_LDA(At, 0, 0); PG8_STAGE(PG8_SA(1, 1), a1 + hstep, voffA);
            PG8_WAIT_L(8); PG8_BAR; PG8_WAIT_L(0); PG8_MMA(0, 0, At, B0); PG8_BAR; PG8_SCHED;
            PG8_LDB(B1, 0, 1); PG8_STAGE(PG8_SB(0, 0), b2, voffB);
            PG8_BAR; PG8_WAIT_L(0); PG8_MMA(0, 1, At, B1); PG8_BAR;
            PG8_LDA(At, 0, 1); PG8_STAGE(PG8_SA(0, 0), a2, voffA);
            PG8_BAR; PG8_WAIT_L(0); PG8_MMA(1, 0, At, B0); PG8_BAR; PG8_SCHED;
            PG8_STAGE(PG8_SB(0, 1), b2 + hstep, voffB);
            PG8_WAIT_V(6); PG8_BAR; PG8_MMA(1, 1, At, B1); PG8_BAR;
            PG8_LDB(B0, 1, 0); PG8_SCHED; PG8_LDA(At, 1, 0); PG8_STAGE(PG8_SA(0, 1), a2 + hstep, voffA);
            PG8_WAIT_L(8); PG8_BAR; PG8_WAIT_L(0); PG8_MMA(0, 0, At, B0); PG8_BAR; PG8_SCHED;
            PG8_LDB(B1, 1, 1); PG8_STAGE(PG8_SB(1, 0), b3, voffB);
            PG8_BAR; PG8_WAIT_L(0); PG8_MMA(0, 1, At, B1); PG8_BAR;
            PG8_LDA(At, 1, 1); PG8_STAGE(PG8_SA(1, 0), a3, voffA);
            PG8_BAR; PG8_WAIT_L(0); PG8_MMA(1, 0, At, B0); PG8_BAR; PG8_SCHED;
            PG8_STAGE(PG8_SB(1, 1), b3 + hstep, voffB);
            PG8_WAIT_V(6); PG8_BAR; PG8_MMA(1, 1, At, B1); PG8_BAR;
            }
        }
        if constexpr (ALIGN_EPI) { if (wr == 0) PG8_BAR; }
        if constexpr (!Epi::AFTER_DRAIN) { E(acc, cur, wr, wc, fr, fq); S.done(cur); }
        if (!has_next) break;
#pragma unroll
        for (int a = 0; a < 2; ++a)
#pragma unroll
            for (int b = 0; b < 2; ++b)
#pragma unroll
                for (int m = 0; m < 4; ++m)
#pragma unroll
                    for (int n = 0; n < 2; ++n) acc[a][b][m][n] = (f32x4){0.f, 0.f, 0.f, 0.f};
        cur = nxt; cA = nA; cB = nB; ++ui;
        if constexpr (ALIGN_EPI) { if (wr == 1) PG8_BAR; }
    }
    PG8_WAIT_V(0);
    if constexpr (!ALIGN_EPI) { if (wr == 0) PG8_BAR; }
    PG8_BAR;
    if constexpr (Epi::AFTER_DRAIN) { E.fused(acc, cur, wr, wc, fr, fq, lds, wid, lane); S.done(cur); }
#undef PG8_SA
#undef PG8_SB
#undef PG8_STAGE
#undef PG8_LDA
#undef PG8_LDB
#undef PG8_MMA
#undef PG8_WAIT_V
#undef PG8_WAIT_L
#undef PG8_BAR
#undef PG8_SCHED
}
}


DEVINL u32x4 pack8(const f32x4& a, const f32x4& b) { u32x4 w; w.x = cvt2(a[0], a[1]); w.y = cvt2(a[2], a[3]); w.z = cvt2(b[0], b[1]); w.w = cvt2(b[2], b[3]); return w; }
DEVINL float row_rscale(const float* ssq, int t, int fq) { const f32x4 a = *(const f32x4*)(ssq + (size_t)t * 16 + 4 * fq); return rsqrtf(quad_sum(a[0] + a[1] + a[2] + a[3]) * (1.0f / DM) + EPS); }
#define EPI_ROW(i) (u.pm * 256 + 128 * ((i) >> 2) + 64 * wr + 16 * ((i) & 3) + fr)
struct EpiIn8 {
    static constexpr bool PERM = true, AFTER_DRAIN = false;
    Params P; int l;
    DEVINL void operator()(const f32x4 (&acc0)[2][2][4][2], const pg8::Unit& u, int wr, int wc, int fr, int fq) const {
        { const int t_ = ltid(); fr = t_ & 15; fq = (t_ >> 4) & 3; wc = __builtin_amdgcn_readfirstlane((t_ >> 6) & 3); wr = __builtin_amdgcn_readfirstlane(t_ >> 8); }
        char* ws = P.ws; char* ob = (char*)P.out; const int chunk = u.pn * 4 + wc;
        const float* ssqx = (const float*)(ws + OFF_SSQX);
        float rt8[8];
        { f32x4 sq[8];
#pragma unroll
          for (int i = 0; i < 8; ++i) sq[i] = *(const f32x4*)(ssqx + (size_t)EPI_ROW(i) * 16 + 4 * fq);
#pragma unroll
          for (int i = 0; i < 8; ++i) rt8[i] = rsqrtf(quad_sum(sq[i][0] + sq[i][1] + sq[i][2] + sq[i][3]) * (1.0f / DM) + EPS); }
        if (chunk < 36) {
            const int g = chunk >> 2, h = chunk & 3, role = g % 3, mix = g / 3;
            bf16_t* dst = (bf16_t*)(ws + OFF_QKV + (size_t)g * SZ_HEADBUF);
            const float* gain = P.qk_gain + ((size_t)l * 6 + 2 * mix + (role == 1 ? 1 : 0)) * 64 + 8 * fq;
            f32x4 gg[2][2];
#pragma unroll
            for (int bj = 0; bj < 2; ++bj)
#pragma unroll
                for (int n = 0; n < 2; ++n) gg[bj][n] = role != 2 ? *(const f32x4*)(gain + 32 * bj + 4 * n) : (f32x4){1.f, 1.f, 1.f, 1.f};
#pragma unroll
            for (int ai = 0; ai < 2; ++ai)
#pragma unroll
                for (int m = 0; m < 4; ++m) {
                    const int t = u.pm * 256 + 128 * ai + 64 * wr + 16 * m + fr, b = t >> 12, s = t & 4095; const float rt_ = rt8[ai * 4 + m]; const f32x4 a[2][2] = {{acc0[ai][0][m][0] * rt_, acc0[ai][0][m][1] * rt_}, {acc0[ai][1][m][0] * rt_, acc0[ai][1][m][1] * rt_}}; bf16_t* d = dst + ((size_t)(b * 4 + h) * SEQ + s) * 64 + 8 * fq;
                    float r = 1.f;
                    if (role != 2) { float ss = sq4(a[0][0]) + sq4(a[0][1]) + sq4(a[1][0]) + sq4(a[1][1]); ss = quad_sum(ss); r = rsqrtf(ss * (1.0f / 64.0f) + EPS) * (role == 0 ? SC_Q : 1.0f); }
#pragma unroll
                    for (int bj = 0; bj < 2; ++bj) *(u32x4*)(d + 32 * bj) = pack8(a[bj][0] * r * gg[bj][0], a[bj][1] * r * gg[bj][1]);
                }
        } else if (chunk < 42) {
            const bool isq = chunk < 40; const int c = isq ? chunk - 36 : chunk - 40;
            bf16_t* dst = isq ? (bf16_t*)(ws + OFF_CQ) : (bf16_t*)(ws + OFF_CKV); const int ld = 256;
            float* ssp = isq ? (float*)(ws + OFF_CQSS) : (float*)(ws + OFF_CKVSS); const int nss = isq ? 4 : 2;
#pragma unroll
            for (int ai = 0; ai < 2; ++ai)
#pragma unroll
                for (int m = 0; m < 4; ++m) {
                    const int t = u.pm * 256 + 128 * ai + 64 * wr + 16 * m + fr; const float rt_ = rt8[ai * 4 + m]; const f32x4 a[2][2] = {{acc0[ai][0][m][0] * rt_, acc0[ai][0][m][1] * rt_}, {acc0[ai][1][m][0] * rt_, acc0[ai][1][m][1] * rt_}};
                    float ss = sq4(a[0][0]) + sq4(a[0][1]) + sq4(a[1][0]) + sq4(a[1][1]); ss = quad_sum(ss);
#pragma unroll
                    for (int bj = 0; bj < 2; ++bj) *(u32x4*)(dst + (size_t)t * ld + c * 64 + 32 * bj + 8 * fq) = pack8(a[bj][0], a[bj][1]);
                    if (fq == 0) ssp[(size_t)t * nss + c] = ss;
                }
        } else if (chunk == 42) {
            const float* gr = P.mla_rope_gain + ((size_t)l * 2 + 1) * 32; const float2* rope = (const float2*)(ws + OFF_ROPE);
            bf16_t* km = (bf16_t*)(ob + OOFF_KM); float* logf_ = (float*)(ws + OFF_LOGF);
            const f32x4 g1 = *(const f32x4*)(gr + 4 * fq), g2 = *(const f32x4*)(gr + 16 + 4 * fq); const f32x4 bfv = *(const f32x4*)(P.b_forget + l * 4);
#pragma unroll
            for (int ai = 0; ai < 2; ++ai) {
                f32x4 cs4[4][2];
#pragma unroll
                for (int m = 0; m < 4; ++m) { const f32x4* rp = (const f32x4*)(rope + (EPI_ROW(ai * 4 + m) & 4095) * 16 + 4 * fq); cs4[m][0] = rp[0]; cs4[m][1] = rp[1]; }
#pragma unroll
                for (int m = 0; m < 4; ++m) {
                    const int t = u.pm * 256 + 128 * ai + 64 * wr + 16 * m + fr, b = t >> 12, s = t & 4095; const float rt_ = rt8[ai * 4 + m]; const f32x4 a[2][2] = {{acc0[ai][0][m][0] * rt_, acc0[ai][0][m][1] * rt_}, {acc0[ai][1][m][0] * rt_, acc0[ai][1][m][1] * rt_}};
                    float ss = sq4(a[0][0]) + sq4(a[0][1]); ss = quad_sum(ss); const float r = rsqrtf(ss * (1.0f / 32.0f) + EPS);
                    float o1[4], o2[4];
#pragma unroll
                    for (int j = 0; j < 4; ++j) { const float cx = cs4[m][j >> 1][2 * (j & 1)], sy = cs4[m][j >> 1][2 * (j & 1) + 1]; const float x1 = a[0][0][j] * r * g1[j], x2 = a[0][1][j] * r * g2[j]; o1[j] = x1 * cx - x2 * sy; o2[j] = x1 * sy + x2 * cx; }
#pragma unroll
                    for (int h = 0; h < 4; ++h) { bf16_t* d = km + ((size_t)(b * 4 + h) * SEQ + s) * 96 + 64 + 4 * fq; store4bf(d, o1[0], o1[1], o1[2], o1[3]); store4bf(d + 16, o2[0], o2[1], o2[2], o2[3]); }
                    if (fq == 0) {
#pragma unroll
                        for (int j = 0; j < 4; ++j) logf_[(size_t)(b * 4 + j) * SEQ + s] = log_sigmoid(a[1][0][j] + bfv[j]) * LOG2E;
                    }
                } }
        } else if (chunk >= 44) {
            bf16_t* G = (bf16_t*)(ob + OOFF_G); const int c0 = (chunk - 44) * 64 + 8 * fq;
#pragma unroll
            for (int ai = 0; ai < 2; ++ai)
#pragma unroll
                for (int m = 0; m < 4; ++m) {
                    const int t = u.pm * 256 + 128 * ai + 64 * wr + 16 * m + fr; const float rt_ = rt8[ai * 4 + m]; const f32x4 a[2][2] = {{acc0[ai][0][m][0] * rt_, acc0[ai][0][m][1] * rt_}, {acc0[ai][1][m][0] * rt_, acc0[ai][1][m][1] * rt_}};
#pragma unroll
                    for (int bj = 0; bj < 2; ++bj) { f32x4 o0, o1;
#pragma unroll
                        for (int j = 0; j < 4; ++j) { const float z0 = a[bj][0][j], z1 = a[bj][1][j]; o0[j] = z0 * fsigmoid(z0); o1[j] = z1 * fsigmoid(z1); }
                        *(u32x4*)(G + (size_t)t * DM + c0 + 32 * bj) = pack8(o0, o1); }
                }
        }
    }
};
struct EpiResid8 { static constexpr bool PERM = true, AFTER_DRAIN = false; const float* base; const bf16_t* bbase; bf16_t* obf; float* ssq;
    DEVINL void operator()(const f32x4 (&acc)[2][2][4][2], const pg8::Unit& u, int wr, int wc, int fr, int fq) const {
        { const int t_ = ltid(); fr = t_ & 15; fq = (t_ >> 4) & 3; wc = __builtin_amdgcn_readfirstlane((t_ >> 6) & 3); wr = __builtin_amdgcn_readfirstlane(t_ >> 8); }
        const size_t cb = (size_t)u.pn * 256 + 64 * wc + 8 * fq;
        if (bbase) {
            u32x4 bw[8][2];
#pragma unroll
            for (int i = 0; i < 8; ++i)
#pragma unroll
                for (int bj = 0; bj < 2; ++bj) bw[i][bj] = *(const u32x4*)(bbase + (size_t)EPI_ROW(i) * DM + cb + 32 * bj);
#pragma unroll
            for (int i = 0; i < 8; ++i) { const int t = EPI_ROW(i); const size_t o = (size_t)t * DM + cb; float ss = 0.f;
#pragma unroll
                for (int bj = 0; bj < 2; ++bj) { const u32x4 w = bw[i][bj];
                    const f32x4 v0 = (f32x4){bflo(w.x), bfhi(w.x), bflo(w.y), bfhi(w.y)} + acc[i >> 2][bj][i & 3][0], v1 = (f32x4){bflo(w.z), bfhi(w.z), bflo(w.w), bfhi(w.w)} + acc[i >> 2][bj][i & 3][1];
                    *(u32x4*)(obf + o + 32 * bj) = pack8(v0, v1); ss += sq4(v0) + sq4(v1); }
                ss = quad_sum(ss); if (fq == 0) ssq[(size_t)t * 16 + u.pn * 4 + wc] = ss; }
        } else {
#pragma unroll
            for (int ai = 0; ai < 2; ++ai) {
                f32x4 bv[4][2][2];
#pragma unroll
                for (int m = 0; m < 4; ++m)
#pragma unroll
                    for (int bj = 0; bj < 2; ++bj) { const float* bp = base + (size_t)EPI_ROW(ai * 4 + m) * DM + cb + 32 * bj; bv[m][bj][0] = __builtin_nontemporal_load((const f32x4*)bp); bv[m][bj][1] = __builtin_nontemporal_load((const f32x4*)(bp + 4)); }
#pragma unroll
                for (int m = 0; m < 4; ++m) { const int t = EPI_ROW(ai * 4 + m); const size_t o = (size_t)t * DM + cb; float ss = 0.f;
#pragma unroll
                    for (int bj = 0; bj < 2; ++bj) { const f32x4 v0 = bv[m][bj][0] + acc[ai][bj][m][0], v1 = bv[m][bj][1] + acc[ai][bj][m][1];
                        *(u32x4*)(obf + o + 32 * bj) = pack8(v0, v1); ss += sq4(v0) + sq4(v1); }
                    ss = quad_sum(ss); if (fq == 0) ssq[(size_t)t * 16 + u.pn * 4 + wc] = ss; } }
        } } };
struct EpiStoreBf { static constexpr bool PERM = true, AFTER_DRAIN = false; bf16_t* out;
    DEVINL void operator()(const f32x4 (&acc)[2][2][4][2], const pg8::Unit& u, int wr, int wc, int fr, int fq) const {
        { const int t_ = ltid(); fr = t_ & 15; fq = (t_ >> 4) & 3; wc = __builtin_amdgcn_readfirstlane((t_ >> 6) & 3); wr = __builtin_amdgcn_readfirstlane(t_ >> 8); }
#pragma unroll
        for (int ai = 0; ai < 2; ++ai)
#pragma unroll
            for (int m = 0; m < 4; ++m) { const size_t o = (size_t)(u.pm * 256 + 128 * ai + 64 * wr + 16 * m + fr) * DM + u.pn * 256 + 64 * wc + 8 * fq;
#pragma unroll
                for (int bj = 0; bj < 2; ++bj) *(u32x4*)(out + o + 32 * bj) = pack8(acc[ai][bj][m][0], acc[ai][bj][m][1]); } } };
struct EpiPle8 { static constexpr bool PERM = true, AFTER_DRAIN = false; const bf16_t* xa; const bf16_t* pp; float* out; const float* ssq_in; bf16_t* obf; float* ssq_out;
    DEVINL void operator()(const f32x4 (&acc)[2][2][4][2], const pg8::Unit& u, int wr, int wc, int fr, int fq) const {
        { const int t_ = ltid(); fr = t_ & 15; fq = (t_ >> 4) & 3; wc = __builtin_amdgcn_readfirstlane((t_ >> 6) & 3); wr = __builtin_amdgcn_readfirstlane(t_ >> 8); }
        const size_t cb = (size_t)u.pn * 256 + 64 * wc + 8 * fq;
        float rt8[8];
        { f32x4 sq[8];
#pragma unroll
          for (int i = 0; i < 8; ++i) sq[i] = *(const f32x4*)(ssq_in + (size_t)EPI_ROW(i) * 16 + 4 * fq);
#pragma unroll
          for (int i = 0; i < 8; ++i) rt8[i] = rsqrtf(quad_sum(sq[i][0] + sq[i][1] + sq[i][2] + sq[i][3]) * (1.0f / DM) + EPS); }
#pragma unroll
        for (int qi = 0; qi < 4; ++qi) {
            const int ai = qi >> 1; u32x4 xw[4][2], pw[4][2];
#pragma unroll
            for (int m = 2 * (qi & 1); m < 2 * (qi & 1) + 2; ++m)
#pragma unroll
                for (int bj = 0; bj < 2; ++bj) { const size_t o = (size_t)EPI_ROW(ai * 4 + m) * DM + cb + 32 * bj; xw[m][bj] = *(const u32x4*)(xa + o); pw[m][bj] = *(const u32x4*)(pp + o); }
#pragma unroll
            for (int m = 2 * (qi & 1); m < 2 * (qi & 1) + 2; ++m) { const int t = EPI_ROW(ai * 4 + m); const size_t o = (size_t)t * DM + cb;
                const float rt = rt8[ai * 4 + m]; float ss = 0.f;
#pragma unroll
                for (int bj = 0; bj < 2; ++bj) { const u32x4 xv = xw[m][bj], pq = pw[m][bj]; const f32x4 x0 = (f32x4){bflo(xv.x), bfhi(xv.x), bflo(xv.y), bfhi(xv.y)}, x1 = (f32x4){bflo(xv.z), bfhi(xv.z), bflo(xv.w), bfhi(xv.w)}; f32x4 r0, r1;
                    const float pv[8] = {bflo(pq.x), bfhi(pq.x), bflo(pq.y), bfhi(pq.y), bflo(pq.z), bfhi(pq.z), bflo(pq.w), bfhi(pq.w)};
#pragma unroll
                    for (int jj = 0; jj < 4; ++jj) { r0[jj] = x0[jj] + pv[jj] * fsigmoid(rt * acc[ai][bj][m][0][jj]); r1[jj] = x1[jj] + pv[4 + jj] * fsigmoid(rt * acc[ai][bj][m][1][jj]); }
                    if (out) { __builtin_nontemporal_store(r0, (f32x4*)(out + o + 32 * bj)); __builtin_nontemporal_store(r1, (f32x4*)(out + o + 32 * bj + 4)); }
                    if (obf) { *(u32x4*)(obf + o + 32 * bj) = pack8(r0, r1); ss += sq4(r0) + sq4(r1); } }
                if (obf) { ss = quad_sum(ss); if (fq == 0) ssq_out[(size_t)t * 16 + u.pn * 4 + wc] = ss; } } } } };
struct EpiUq8 { static constexpr bool PERM = true, AFTER_DRAIN = false; Params P; int l;
    DEVINL void operator()(const f32x4 (&acc)[2][2][4][2], const pg8::Unit& u, int wr, int wc, int fr, int fq) const {
        { const int t_ = ltid(); fr = t_ & 15; fq = (t_ >> 4) & 3; wc = __builtin_amdgcn_readfirstlane((t_ >> 6) & 3); wr = __builtin_amdgcn_readfirstlane(t_ >> 8); }
        const int chunk = u.pn * 4 + wc; if (chunk >= 6) return;
        const float* cqss = (const float*)(P.ws + OFF_CQSS); bf16_t* qm = (bf16_t*)((char*)P.out + OOFF_QM); const float2* rope = (const float2*)(P.ws + OFF_ROPE);
        float rt8[8];
        { float sq[8];
#pragma unroll
          for (int i = 0; i < 8; ++i) sq[i] = cqss[(size_t)EPI_ROW(i) * 4 + fq];
#pragma unroll
          for (int i = 0; i < 8; ++i) rt8[i] = rsqrtf(quad_sum(sq[i]) * (1.0f / 256.0f) + EPS); }
        if (chunk < 4) {
            const float* gain = P.mla_nope_gain + ((size_t)l * 2 + 0) * 64 + 8 * fq;
            f32x4 gg[2][2];
#pragma unroll
            for (int bj = 0; bj < 2; ++bj) { gg[bj][0] = *(const f32x4*)(gain + 32 * bj); gg[bj][1] = *(const f32x4*)(gain + 32 * bj + 4); }
#pragma unroll
            for (int i = 0; i < 8; ++i) { const int ai = i >> 2, m = i & 3, t = EPI_ROW(i), b = t >> 12, s = t & 4095; const float rt = rt8[i];
                const f32x4 a[2][2] = {{acc[ai][0][m][0] * rt, acc[ai][0][m][1] * rt}, {acc[ai][1][m][0] * rt, acc[ai][1][m][1] * rt}};
                float ss = sq4(a[0][0]) + sq4(a[0][1]) + sq4(a[1][0]) + sq4(a[1][1]); ss = quad_sum(ss); const float r = rsqrtf(ss * (1.0f / 64.0f) + EPS) * SC_MLA;
                bf16_t* d = qm + ((size_t)(b * 4 + chunk) * SEQ + s) * 96 + 8 * fq;
#pragma unroll
                for (int bj = 0; bj < 2; ++bj) *(u32x4*)(d + 32 * bj) = pack8(a[bj][0] * r * gg[bj][0], a[bj][1] * r * gg[bj][1]); }
        } else {
            const float* gr = P.mla_rope_gain + ((size_t)l * 2 + 0) * 32; const f32x4 g1 = *(const f32x4*)(gr + 4 * fq), g2 = *(const f32x4*)(gr + 16 + 4 * fq);
#pragma unroll
            for (int hf = 0; hf < 2; ++hf) {
            f32x4 cs4[4][2];
#pragma unroll
            for (int m = 0; m < 4; ++m) { const f32x4* rp = (const f32x4*)(rope + (EPI_ROW(hf * 4 + m) & 4095) * 16 + 4 * fq); cs4[m][0] = rp[0]; cs4[m][1] = rp[1]; }
#pragma unroll
            for (int i = hf * 4; i < hf * 4 + 4; ++i) { const int ai = i >> 2, m = i & 3, t = EPI_ROW(i), b = t >> 12, s = t & 4095; const float rt = rt8[i];
                const f32x4 a[2][2] = {{acc[ai][0][m][0] * rt, acc[ai][0][m][1] * rt}, {acc[ai][1][m][0] * rt, acc[ai][1][m][1] * rt}};
#pragma unroll
                for (int bj = 0; bj < 2; ++bj) { const int h = (chunk - 4) * 2 + bj;
                    float ss = sq4(a[bj][0]) + sq4(a[bj][1]); ss = quad_sum(ss); const float r = rsqrtf(ss * (1.0f / 32.0f) + EPS);
                    float o1[4], o2[4];
#pragma unroll
                    for (int j = 0; j < 4; ++j) { const float cx = cs4[m][j >> 1][2 * (j & 1)], sy = cs4[m][j >> 1][2 * (j & 1) + 1]; const float x1 = a[bj][0][j] * r * g1[j], x2 = a[bj][1][j] * r * g2[j]; o1[j] = (x1 * cx - x2 * sy) * SC_MLA; o2[j] = (x1 * sy + x2 * cx) * SC_MLA; }
                    bf16_t* d = qm + ((size_t)(b * 4 + h) * SEQ + s) * 96 + 64 + 4 * fq; store4bf(d, o1[0], o1[1], o1[2], o1[3]); store4bf(d + 16, o2[0], o2[1], o2[2], o2[3]); } } }
        }
    }
};
struct EpiUkv8 { static constexpr bool PERM = true, AFTER_DRAIN = false; Params P; int l;
    DEVINL void operator()(const f32x4 (&acc)[2][2][4][2], const pg8::Unit& u, int wr, int wc, int fr, int fq) const {
        { const int t_ = ltid(); fr = t_ & 15; fq = (t_ >> 4) & 3; wc = __builtin_amdgcn_readfirstlane((t_ >> 6) & 3); wr = __builtin_amdgcn_readfirstlane(t_ >> 8); }
        const int chunk = u.pn * 4 + wc, h = chunk >> 1; const bool isk = (chunk & 1) == 0;
        const float* ckvss = (const float*)(P.ws + OFF_CKVSS); bf16_t* km = (bf16_t*)((char*)P.out + OOFF_KM); bf16_t* vm = (bf16_t*)((char*)P.out + OOFF_VM);
        const float* gain = P.mla_nope_gain + ((size_t)l * 2 + 1) * 64 + 8 * fq;
        float rt8[8];
        { float sq[8];
#pragma unroll
          for (int i = 0; i < 8; ++i) sq[i] = fq < 2 ? ckvss[(size_t)EPI_ROW(i) * 2 + fq] : 0.f;
#pragma unroll
          for (int i = 0; i < 8; ++i) rt8[i] = rsqrtf(quad_sum(sq[i]) * (1.0f / 128.0f) + EPS); }
        f32x4 gg[2][2];
#pragma unroll
        for (int bj = 0; bj < 2; ++bj) { gg[bj][0] = *(const f32x4*)(gain + 32 * bj); gg[bj][1] = *(const f32x4*)(gain + 32 * bj + 4); }
#pragma unroll
        for (int i = 0; i < 8; ++i) { const int ai = i >> 2, m = i & 3, t = EPI_ROW(i), b = t >> 12, s = t & 4095; const float rt = rt8[i];
            const f32x4 a[2][2] = {{acc[ai][0][m][0] * rt, acc[ai][0][m][1] * rt}, {acc[ai][1][m][0] * rt, acc[ai][1][m][1] * rt}};
            if (isk) { float ss = sq4(a[0][0]) + sq4(a[0][1]) + sq4(a[1][0]) + sq4(a[1][1]); ss = quad_sum(ss); const float r = rsqrtf(ss * (1.0f / 64.0f) + EPS);
                bf16_t* d = km + ((size_t)(b * 4 + h) * SEQ + s) * 96 + 8 * fq;
#pragma unroll
                for (int bj = 0; bj < 2; ++bj) *(u32x4*)(d + 32 * bj) = pack8(a[bj][0] * r * gg[bj][0], a[bj][1] * r * gg[bj][1]);
            } else { bf16_t* d = vm + ((size_t)(b * 4 + h) * SEQ + s) * 64 + 8 * fq;
#pragma unroll
                for (int bj = 0; bj < 2; ++bj) *(u32x4*)(d + 32 * bj) = pack8(a[bj][0], a[bj][1]); }
        }
    }
};
template <class Epi> DEVINL void gemm8(const bf16_t* A, const bf16_t* Bt, int M, int N, int K, const Epi& E, char* smem) {
    int G = (int)gridDim.x, c = (int)blockIdx.x; asm volatile("" : "+s"(G), "+s"(c));
    pg8::Gemm g{A, Bt, M, N, K}; pg8::StaticOrder S; S.init(M, N, G, c);
    pg8::gemm_phase<Epi, pg8::StaticOrder, true, true>((PG8_LAS unsigned char*)smem, g, S, E);
}

DEVINL void kmean_unit(const Params& P, int u, char* smem) {
    float* red = (float*)smem; const bf16_t* K = (const bf16_t*)(P.ws + OFF_QKV + 4 * SZ_HEADBUF); float* km = (float*)(P.ws + OFF_KMEAN);
    const int tid = ltid(), dc = tid & 7, rg = tid >> 3;
    const bf16_t* kp = K + ((size_t)(u >> 4) * SEQ + (u & 15) * 256 + rg) * 64 + dc * 8;
    u32x4 w[4];
#pragma unroll
    for (int i = 0; i < 4; ++i) w[i] = *(const u32x4*)(kp + (size_t)i * 64 * 64);
    float s[8] = {0.f, 0.f, 0.f, 0.f, 0.f, 0.f, 0.f, 0.f};
#pragma unroll
    for (int i = 0; i < 4; ++i) { s[0] += bflo(w[i].x); s[1] += bfhi(w[i].x); s[2] += bflo(w[i].y); s[3] += bfhi(w[i].y); s[4] += bflo(w[i].z); s[5] += bfhi(w[i].z); s[6] += bflo(w[i].w); s[7] += bfhi(w[i].w); }
    __syncthreads();
#pragma unroll
    for (int e = 0; e < 8; ++e) red[rg * 65 + dc * 8 + e] = s[e];
    __syncthreads();
    if (tid < 64) { float a = 0.f;
#pragma unroll 8
        for (int i = 0; i < 64; ++i) a += red[i * 65 + tid];
        km[(size_t)u * 64 + tid] = a * (1.0f / 256.0f); }
}

typedef float f32x16 __attribute__((ext_vector_type(16)));
typedef short s16x4 __attribute__((ext_vector_type(4)));
typedef short v4i16_t __attribute__((ext_vector_type(4)));
#define LAS __attribute__((address_space(3)))
#define MFMA32(a, b, c) __builtin_amdgcn_mfma_f32_32x32x16_bf16(a, b, c, 0, 0, 0)
DEVINL s16x4 vtr(const LAS char* p) { return __builtin_bit_cast(s16x4, __builtin_amdgcn_ds_read_tr16_b64_v4i16((LAS v4i16_t*)p)); }
DEVINL float swap_max(float v) { auto rr = __builtin_amdgcn_permlane32_swap(__float_as_uint(v), __float_as_uint(v), false, false); return fmaxf(__uint_as_float(rr[0]), __uint_as_float(rr[1])); }
DEVINL float swap_sum(float v) { auto rr = __builtin_amdgcn_permlane32_swap(__float_as_uint(v), __float_as_uint(v), false, false); return __uint_as_float(rr[0]) + __uint_as_float(rr[1]); }
DEVINL float fadd1(float a, float b) { float r; asm("v_add_f32 %0, %1, %2" : "=v"(r) : "v"(a), "v"(b)); return r; }
DEVINL constexpr int crow(int r) { return (r & 3) + 8 * (r >> 2); }

constexpr int KSLOT = 64 * 144, RSLOT = 64 * 80;
constexpr int L_KB = 0, L_VB = 3 * KSLOT, L_KR = L_VB + 16384, L_AUX = L_KR + 3 * RSLOT, L_SCR = L_AUX + 16640 + 256, L_KMS = L_SCR + 2048, L_ATT_END = L_KMS + 4096;
constexpr float NEGBIG = -3.0e38f, THR = 8.0f;

template <int MODE>
DEVINL void attn_unit(const Params& P, int l, int u, char* smem) {
    constexpr int DK = MODE == 2 ? 96 : 64, ND0 = DK / 16;
    LAS char* lds = (LAS char*)smem;
    const int tid = ltid(), lane = tid & 63, r32 = lane & 31, hi = lane >> 5; const int wid = __builtin_amdgcn_readfirstlane(tid >> 6);
    const bool fast = ((const float*)(P.ws + OFF_BOUND))[l * 4 + MODE] < 100.0f;
    int bh, q0, t_lo, t_hi, dil = 1, res = 0, pat = 0, qb = 0;
    if (MODE != 3) { bh = u & 15; qb = 15 - (u >> 4); q0 = qb * 256; t_lo = 0; t_hi = (q0 + 255) >> 6; }
    else { pat = u >> 8; const int v = u & 255; bh = v & 15; const int w = v >> 4; dil = pat == 0 ? 1 : (pat == 1 ? 4 : 16); res = w % dil; q0 = (w / dil) * 256; t_lo = (q0 >= 128 ? q0 - 128 : 0) >> 6; t_hi = (q0 + 255) >> 6; }
    const int b = bh >> 2, h = bh & 3;
    const bf16_t *Qg, *Kg, *Vg; int rsq, rsk, rsv;
    if (MODE == 0) { Qg = (const bf16_t*)(P.ws + OFF_QKV) + (size_t)bh * SEQ * 64; Kg = Qg + SZ_HEADBUF / 2; Vg = Kg + SZ_HEADBUF / 2; rsq = rsk = rsv = 64; }
    else if (MODE == 1) { Qg = (const bf16_t*)(P.ws + OFF_QKV + 3 * SZ_HEADBUF) + (size_t)bh * SEQ * 64; Kg = Qg + SZ_HEADBUF / 2; Vg = Kg + SZ_HEADBUF / 2; rsq = rsk = rsv = 64; }
    else if (MODE == 2) { Qg = (const bf16_t*)((const char*)P.out + OOFF_QM) + (size_t)bh * SEQ * 96; Kg = (const bf16_t*)((const char*)P.out + OOFF_KM) + (size_t)bh * SEQ * 96; Vg = (const bf16_t*)((const char*)P.out + OOFF_VM) + (size_t)bh * SEQ * 64; rsq = rsk = 96; rsv = 64; }
    else { Qg = (const bf16_t*)(P.ws + OFF_QKV + 6 * SZ_HEADBUF) + ((size_t)bh * SEQ + res) * 64; Kg = Qg + SZ_HEADBUF / 2; Vg = Kg + SZ_HEADBUF / 2; rsq = rsk = rsv = 64 * dil; }
    const int qw = q0 + 32 * wid;

    __syncthreads();
    const unsigned kgo = (unsigned)((tid >> 3) * rsk + (tid & 7) * 8), vgo = (unsigned)(((tid >> 2) & 63) * rsv + (tid >> 8) * 32 + (tid & 3) * 8), rgo = (unsigned)(((tid >> 2) & 63) * rsk + 64 + (tid & 3) * 8);
    const int kws = (tid >> 3) * 144 + (tid & 7) * 16;
    const int rws = ((tid >> 2) & 63) * 80 + (tid & 3) * 16;
    u32x4 kA, rA, kB, rB;
#define ATT_LOADK(j, K_, R_) do { if ((j) <= t_hi) { K_ = *(const u32x4*)(Kg + (size_t)(j) * 64 * rsk + kgo); if (MODE == 2 && tid < 256) R_ = *(const u32x4*)(Kg + (size_t)(j) * 64 * rsk + rgo); } } while (0)
#define ATT_DMAV(j, slot) do { if ((j) <= t_hi) __builtin_amdgcn_global_load_lds((const unsigned*)(Vg + (size_t)(j) * 64 * rsv + vgo), (LAS unsigned*)(lds + L_VB + (slot) * 8192 + wid * 1024), 16, 0, 0); } while (0)
#define ATT_WRITEK(slot, j, K_, R_) do { if ((j) <= t_hi) { *(LAS u32x4*)(lds + L_KB + (slot) * KSLOT + kws) = K_; if (MODE == 2 && tid < 256) *(LAS u32x4*)(lds + L_KR + (slot) * RSLOT + rws) = R_; \
        if (MODE == 0 && tid < 64) { const float bs = aux[(j) * 64 + tid] - auxU; const unsigned hb = cvt2(bs, 0.f) & 0xffffu; const float lo = bs - __uint_as_float(hb << 16); u32x4 w; w.x = hb | (cvt2(lo, 0.f) << 16); w.y = 0x3F80u; w.z = 0u; w.w = 0u; \
            *(LAS u32x4*)(lds + L_KR + (slot) * 1024 + tid * 16) = w; } } } while (0)
    bf16x8 qf[ND0];
    { const bf16_t* qp = Qg + (size_t)(qw + r32) * rsq + 8 * hi;
#pragma unroll
      for (int d0 = 0; d0 < ND0; ++d0) qf[d0] = *(const bf16x8*)(qp + 16 * d0); }
    if (MODE != 0) { ATT_LOADK(t_lo, kA, rA); ATT_LOADK(t_lo + 1, kB, rB); }
    LAS float* aux = (LAS float*)(lds + L_AUX);
    if (MODE == 0) {
        LAS float* tot = (LAS float*)(lds + L_SCR);
        const float* lf = (const float*)(P.ws + OFF_LOGF) + (size_t)bh * SEQ + tid * 8; float v[8]; float run = 0.f;
        { const f32x4 a = *(const f32x4*)lf, c = *(const f32x4*)(lf + 4); v[0] = a[0]; v[1] = a[1]; v[2] = a[2]; v[3] = a[3]; v[4] = c[0]; v[5] = c[1]; v[6] = c[2]; v[7] = c[3]; }
#pragma unroll
        for (int i = 0; i < 8; ++i) { run += v[i]; v[i] = run; }
        tot[tid] = run; __syncthreads();
        if (tid < 64) { float a[8]; float acc = 0.f;
#pragma unroll
            for (int i = 0; i < 8; ++i) { acc += tot[tid * 8 + i]; a[i] = acc; }
            float incl = acc;
#pragma unroll
            for (int o = 1; o < 64; o <<= 1) { const float nb = shup(incl, o); if (tid >= o) incl += nb; }
            const float ex = incl - acc; tot[tid * 8] = ex;
#pragma unroll
            for (int i = 1; i < 8; ++i) tot[tid * 8 + i] = ex + a[i - 1]; }
        __syncthreads();
        const float base = tot[tid];
#pragma unroll
        for (int i = 0; i < 8; ++i) aux[tid * 8 + i] = -(base + v[i]);
        if (tid < 4) ((LAS unsigned*)(lds + L_KR + 3072))[tid] = 0u;
    } else if (MODE == 1) {
        const float* lut = (const float*)(P.ws + OFF_LUT) + (size_t)h * 4096;
        for (int i = ((4095 - (q0 + 255)) & ~3) + 4 * tid; i < 4160; i += 4 * NTHREADS) {
            f32x4 v = (f32x4){0.f, 0.f, 0.f, 0.f}; if (i < 4096) { const f32x4 s = *(const f32x4*)(lut + 4092 - i); v = (f32x4){s[3], s[2], s[1], s[0]}; }
            *(LAS f32x4*)(aux + i) = v; }
        if (tid < 64) aux[4160 + tid] = -INFINITY;
        LAS float* kms = (LAS float*)(lds + L_KMS); const float* km = (const float*)(P.ws + OFF_KMEAN) + (size_t)bh * 1024;
        for (int i = tid; i < 1024; i += NTHREADS) kms[i] = km[i];
    } else if (MODE == 3) {
        const float* lut = (const float*)(P.ws + OFF_LUT) + (size_t)(4 + h) * 4096;
        if (tid < 320) { const int rel = 255 - tid; aux[tid] = (rel >= 0 && rel * dil < 4096) ? lut[rel * dil] : 0.f; }
    }
    if (MODE == 0 && fast) {
        __syncthreads();
        const float bnd = ((const float*)(P.ws + OFF_BOUND))[l * 4 + (tid >> 30)];
        const bool sk = (lane <= t_hi) && ((aux[64 * lane + 63] - aux[q0]) + bnd < -150.0f);
        t_lo = (int)__builtin_popcountll(__ballot(sk));
    }
    __syncthreads();
    bf16x8 qx = {0, 0, 0, 0, 0, 0, 0, 0}; float auxU = 0.f;
    if (MODE == 0) { auxU = aux[q0 + 255]; const float sh = auxU - aux[qw + r32];
        if (hi == 0) { u32x4 w; w.x = 0x3F803F80u; w.y = cvt2(sh, 0.f); w.z = 0u; w.w = 0u; qx = __builtin_bit_cast(bf16x8, w); } }
    unsigned sel = 0;
    if (MODE == 1) {
        const LAS float* kms = (const LAS float*)(lds + L_KMS); float gt[15];
#pragma unroll
        for (int n = 0; n < 15; ++n) { float s = 0.f;
            if (n < qb) {
#pragma unroll
                for (int d0 = 0; d0 < 4; ++d0) { const f32x4 ka = *(const LAS f32x4*)(kms + n * 64 + 16 * d0 + 8 * hi), kb = *(const LAS f32x4*)(kms + n * 64 + 16 * d0 + 8 * hi + 4);
                    const u32x4 w = __builtin_bit_cast(u32x4, qf[d0]);
                    s += bflo(w.x) * ka[0] + bfhi(w.x) * ka[1] + bflo(w.y) * ka[2] + bfhi(w.y) * ka[3] + bflo(w.z) * kb[0] + bfhi(w.z) * kb[1] + bflo(w.w) * kb[2] + bfhi(w.w) * kb[3]; }
                s = swap_sum(s); }
            gt[n] = s; }
#pragma unroll
        for (int k = 0; k < 3; ++k) { float best = NEGBIG; int bi = -1;
#pragma unroll
            for (int n = 0; n < 15; ++n) if (n < qb && !((sel >> n) & 1u) && gt[n] > best) { best = gt[n]; bi = n; }
            if (bi >= 0) sel |= 1u << bi; }
        sel |= 1u << qb;
    }
    const int kfo = L_KB + r32 * 144 + hi * 16, rfo = L_KR + r32 * 80 + hi * 16;
    const int vfo = L_VB + ((lane >> 4) & 1) * 32 + (lane & 3) * 8 + (4 * hi + ((lane & 15) >> 2)) * 64;

    f32x16 o0, o1;
#pragma unroll
    for (int r = 0; r < 16; ++r) { o0[r] = 0.f; o1[r] = 0.f; }
    float m = fast ? 0.f : NEGBIG, lsum = 0.f;

    auto anysel = [&](int j) -> bool { return MODE != 1 || __any((sel >> (j >> 2)) & 1u); };
    auto is_full = [&](int j) -> bool {
        bool f = fast && (64 * j + 63 <= qw) && anysel(j);
        if (MODE == 3) f = f && (64 * j >= qw + 31 - 128);
        return f; };
    auto stage_a = [&](int j, int ks, int kb, f32x16& p) {
        if (MODE == 1 || MODE == 3) { const LAS float* lp = aux + ((MODE == 1 ? 4095 : 255) - (qw + r32 - 64 * j - 4 * hi));
            if (MODE == 1) lp = ((sel >> (j >> 2)) & 1u) ? lp : aux + 4160;
#pragma unroll
            for (int r = 0; r < 16; ++r) p[r] = lp[crow(r) + 32 * kb];
        } else {
#pragma unroll
            for (int r = 0; r < 16; ++r) p[r] = 0.f;
        }
        const LAS char* kb_ = lds + ks * KSLOT + kb * (32 * 144) + kfo;
#pragma unroll
        for (int d0 = 0; d0 < 4; ++d0) p = MFMA32(*(const LAS bf16x8*)(kb_ + d0 * 32), qf[d0], p);
        if (MODE == 2) { const LAS char* rb_ = lds + ks * RSLOT + kb * (32 * 80) + rfo;
#pragma unroll
            for (int d0 = 0; d0 < 2; ++d0) p = MFMA32(*(const LAS bf16x8*)(rb_ + d0 * 32), qf[4 + d0], p); }
        if (MODE == 0) p = MFMA32(*(const LAS bf16x8*)(lds + (hi ? (L_KR + 3072) : (L_KR + ks * 1024 + kb * 512 + r32 * 16))), qx, p);
    };
    auto stage_b = [&](int j, f32x16& p, u32x4& wa, u32x4& wb) {
#pragma unroll
        for (int r = 0; r < 16; ++r) { p[r] = __builtin_amdgcn_exp2f(p[r]); lsum += p[r]; }
        wa.x = cvt2(p[0], p[1]); wa.y = cvt2(p[2], p[3]); wa.z = cvt2(p[4], p[5]); wa.w = cvt2(p[6], p[7]);
        wb.x = cvt2(p[8], p[9]); wb.y = cvt2(p[10], p[11]); wb.z = cvt2(p[12], p[13]); wb.w = cvt2(p[14], p[15]);
        asm volatile("" : "+v"(lsum));
    };
    auto stage_c = [&](int vs, int kb, const u32x4& wa, const u32x4& wb) {
        const LAS char* vb_ = lds + vs * 8192 + vfo + kb * 2048;
        { const s16x4 a0 = vtr(vb_), a1 = vtr(vb_ + 512), c0 = vtr(vb_ + 4096), c1 = vtr(vb_ + 4096 + 512);
          o0 = MFMA32(__builtin_shufflevector(a0, a1, 0, 1, 2, 3, 4, 5, 6, 7), __builtin_bit_cast(bf16x8, wa), o0); o1 = MFMA32(__builtin_shufflevector(c0, c1, 0, 1, 2, 3, 4, 5, 6, 7), __builtin_bit_cast(bf16x8, wa), o1); }
        { const s16x4 a0 = vtr(vb_ + 1024), a1 = vtr(vb_ + 1024 + 512), c0 = vtr(vb_ + 4096 + 1024), c1 = vtr(vb_ + 4096 + 1024 + 512);
          o0 = MFMA32(__builtin_shufflevector(a0, a1, 0, 1, 2, 3, 4, 5, 6, 7), __builtin_bit_cast(bf16x8, wb), o0); o1 = MFMA32(__builtin_shufflevector(c0, c1, 0, 1, 2, 3, 4, 5, 6, 7), __builtin_bit_cast(bf16x8, wb), o1); }
    };
    auto general = [&](int t, int ks, int vs) {
        const int k0 = t * 64; const bool selected = MODE != 1 || ((sel >> (t >> 2)) & 1u); const bool asel = anysel(t);
        int dl = qw + r32 - k0 - 4 * hi; asm volatile("" : "+v"(dl));
#pragma unroll
        for (int kb = 0; kb < 2; ++kb) {
            const int kh = k0 + 32 * kb;
            bool act = kh <= qw + 31 && asel, need_mask = kh + 31 > qw;
            if (MODE == 3) { act = act && (kh + 31 >= qw - 128); need_mask = need_mask || (kh < qw + 31 - 128); }
            if (!act) continue;
            f32x16 p;
            if (MODE == 1 || MODE == 3) { const LAS float* lp = aux + ((MODE == 1 ? 4095 : 255) - dl);
#pragma unroll
                for (int r = 0; r < 16; ++r) p[r] = lp[crow(r) + 32 * kb];
            } else {
#pragma unroll
                for (int r = 0; r < 16; ++r) p[r] = 0.f;
            }
            const LAS char* kb_ = lds + ks * KSLOT + kb * (32 * 144) + kfo;
#pragma unroll
            for (int d0 = 0; d0 < 4; ++d0) p = MFMA32(*(const LAS bf16x8*)(kb_ + d0 * 32), qf[d0], p);
            if (MODE == 2) { const LAS char* rb_ = lds + ks * RSLOT + kb * (32 * 80) + rfo;
#pragma unroll
                for (int d0 = 0; d0 < 2; ++d0) p = MFMA32(*(const LAS bf16x8*)(rb_ + d0 * 32), qf[4 + d0], p); }
            if (MODE == 0) p = MFMA32(*(const LAS bf16x8*)(lds + (hi ? (L_KR + 3072) : (L_KR + ks * 1024 + kb * 512 + r32 * 16))), qx, p);
            if (need_mask) {
#pragma unroll
                for (int r = 0; r < 16; ++r) { const int rel = dl - crow(r) - 32 * kb; const bool v = MODE == 3 ? ((unsigned)rel <= 128u) : (rel >= 0); p[r] = v ? p[r] : -INFINITY; }
            }
            float ps = 0.f;
            if (fast) {
#pragma unroll
                for (int r = 0; r < 16; ++r) { p[r] = __builtin_amdgcn_exp2f(p[r]); ps += p[r]; }
            } else {
                float mx = fmaxf(p[0], p[1]);
#pragma unroll
                for (int r = 2; r < 16; ++r) mx = fmaxf(mx, p[r]);
                mx = swap_max(mx);
                if (MODE == 1) mx = selected ? mx : NEGBIG;
                if (__any(mx > m + THR)) {
                    const float mn = fmaxf(m, mx), alpha = __builtin_amdgcn_exp2f(m - mn); m = mn; lsum *= alpha;
#pragma unroll
                    for (int r = 0; r < 16; ++r) { o0[r] *= alpha; o1[r] *= alpha; }
                }
#pragma unroll
                for (int r = 0; r < 16; ++r) { p[r] = __builtin_amdgcn_exp2f(p[r] - m); ps += p[r]; }
            }
            u32x4 w0, w1;
            w0.x = cvt2(p[0], p[1]); w0.y = cvt2(p[2], p[3]); w0.z = cvt2(p[4], p[5]); w0.w = cvt2(p[6], p[7]);
            w1.x = cvt2(p[8], p[9]); w1.y = cvt2(p[10], p[11]); w1.z = cvt2(p[12], p[13]); w1.w = cvt2(p[14], p[15]);
            if (MODE == 1) { const unsigned mk = selected ? 0xffffffffu : 0u; ps = selected ? ps : 0.f; w0 = w0 & mk; w1 = w1 & mk; }
            lsum += ps;
            const bf16x8 pb0 = __builtin_bit_cast(bf16x8, w0), pb1 = __builtin_bit_cast(bf16x8, w1);
            const LAS char* vb_ = lds + vs * 8192 + vfo + kb * 2048;
            { const s16x4 a0 = vtr(vb_), a1 = vtr(vb_ + 512), c0 = vtr(vb_ + 4096), c1 = vtr(vb_ + 4096 + 512);
              o0 = MFMA32(__builtin_shufflevector(a0, a1, 0, 1, 2, 3, 4, 5, 6, 7), pb0, o0); o1 = MFMA32(__builtin_shufflevector(c0, c1, 0, 1, 2, 3, 4, 5, 6, 7), pb0, o1); }
            { const s16x4 a0 = vtr(vb_ + 1024), a1 = vtr(vb_ + 1024 + 512), c0 = vtr(vb_ + 4096 + 1024), c1 = vtr(vb_ + 4096 + 1024 + 512);
              o0 = MFMA32(__builtin_shufflevector(a0, a1, 0, 1, 2, 3, 4, 5, 6, 7), pb1, o0); o1 = MFMA32(__builtin_shufflevector(c0, c1, 0, 1, 2, 3, 4, 5, 6, 7), pb1, o1); }
        }
    };

    if (MODE == 0) { ATT_LOADK(t_lo, kA, rA); ATT_LOADK(t_lo + 1, kB, rB); }
    ATT_DMAV(t_lo, 0); ATT_DMAV(t_lo + 1, 1);
    ATT_WRITEK(0, t_lo, kA, rA); ATT_WRITEK(1, t_lo + 1, kB, rB);
    __syncthreads();
    ATT_LOADK(t_lo + 2, kA, rA);
    int ks0 = 0, ks1 = 1, ks2 = 2, vs = 0;
    bool pend = is_full(t_lo);
    f32x16 sa0, sa1, sb0, sb1;
    if (pend) { stage_a(t_lo, 0, 0, sa0); stage_a(t_lo, 0, 1, sa1); }
    auto advance = [&](const int t) {
        ATT_WRITEK(ks2, t + 2, kA, rA);
        __syncthreads();
        ATT_DMAV(t + 2, vs); ATT_LOADK(t + 3, kA, rA);
        { const int tmp = ks0; ks0 = ks1; ks1 = ks2; ks2 = tmp; } vs ^= 1;
    };
    auto steady = [&](const int t, f32x16& c0, f32x16& c1, f32x16& n0, f32x16& n1) {
        u32x4 wa, wb, wc, wd;
        stage_a(t + 1, ks1, 0, n0); stage_b(t, c0, wa, wb); __builtin_amdgcn_sched_barrier(0);
        stage_a(t + 1, ks1, 1, n1); stage_c(vs, 0, wa, wb); stage_b(t, c1, wc, wd); __builtin_amdgcn_sched_barrier(0);
        stage_c(vs, 1, wc, wd);
        advance(t);
    };
    int t = t_lo;
    while (t <= t_hi) {
        if (pend) while (t + 2 <= t_hi && is_full(t + 1) && is_full(t + 2)) { steady(t, sa0, sa1, sb0, sb1); steady(t + 1, sb0, sb1, sa0, sa1); t += 2; }
        const bool nxt = (t + 1 <= t_hi) && is_full(t + 1);
        if (pend) { u32x4 wa, wb; stage_b(t, sa0, wa, wb); stage_c(vs, 0, wa, wb); stage_b(t, sa1, wa, wb); stage_c(vs, 1, wa, wb); } else general(t, ks0, vs);
        if (nxt) { stage_a(t + 1, ks1, 0, sa0); stage_a(t + 1, ks1, 1, sa1); }
        pend = nxt;
        advance(t);
        ++t;
    }
#undef ATT_LOADK
#undef ATT_DMAV
#undef ATT_WRITEK
    const int te_ = ltid(), r32e = te_ & 31, hie = (te_ >> 5) & 1, qwe = q0 + 32 * (te_ >> 6);
    const float ltot = swap_sum(lsum), inv = 1.0f / ltot;
    if (MODE != 3) {
        const size_t tok = (size_t)b * SEQ + qwe + r32e; const int colbase = (MODE == 0 ? 0 : (MODE == 1 ? 256 : 768)) + h * 64 + 4 * hie;
        const bf16_t* G = (const bf16_t*)((const char*)P.out + OOFF_G) + tok * DM + colbase; bf16_t* A2 = (bf16_t*)(P.ws + OFF_A2) + tok * DM + colbase;
#pragma unroll
        for (int g = 0; g < 4; ++g) {
            const u32x2 g0 = *(const u32x2*)(G + 8 * g), g1 = *(const u32x2*)(G + 32 + 8 * g); u32x2 w0, w1;
            w0.x = cvt2(o0[4 * g] * inv * bflo(g0.x), o0[4 * g + 1] * inv * bfhi(g0.x)); w0.y = cvt2(o0[4 * g + 2] * inv * bflo(g0.y), o0[4 * g + 3] * inv * bfhi(g0.y));
            w1.x = cvt2(o1[4 * g] * inv * bflo(g1.x), o1[4 * g + 1] * inv * bfhi(g1.x)); w1.y = cvt2(o1[4 * g + 2] * inv * bflo(g1.y), o1[4 * g + 3] * inv * bfhi(g1.y));
            *(u32x2*)(A2 + 8 * g) = w0; *(u32x2*)(A2 + 32 + 8 * g) = w1; }
    } else {
        const size_t tok = (size_t)b * SEQ + (size_t)(qwe + r32e) * dil + res;
        bf16_t* dp = (bf16_t*)(P.ws + OFF_DPART) + ((size_t)pat * NT + tok) * 256 + h * 64 + 4 * hie;
#pragma unroll
        for (int g = 0; g < 4; ++g) { u32x2 w0, w1;
            w0.x = cvt2(o0[4 * g] * inv, o0[4 * g + 1] * inv); w0.y = cvt2(o0[4 * g + 2] * inv, o0[4 * g + 3] * inv);
            w1.x = cvt2(o1[4 * g] * inv, o1[4 * g + 1] * inv); w1.y = cvt2(o1[4 * g + 2] * inv, o1[4 * g + 3] * inv);
            *(u32x2*)(dp + 8 * g) = w0; *(u32x2*)(dp + 32 + 8 * g) = w1; }
        if (hie == 0) ((float*)(P.ws + OFF_DLSE))[((size_t)pat * NT + tok) * 4 + h] = m + __builtin_amdgcn_logf(ltot);
    }
}

DEVINL void dil_unit(const Params& P, int l, int u, char* smem) {
    LAS char* lds = (LAS char*)smem;
    const int tid = ltid(), lane = tid & 63, r32 = lane & 31, hi = lane >> 5; const int wid = __builtin_amdgcn_readfirstlane(tid >> 6);
    const int pat = u >> 8, v = u & 255, bh = v & 15, w = v >> 4, dil = pat == 0 ? 1 : (pat == 1 ? 4 : 16), res = w % dil, q0 = (w / dil) * 256;
    const int t_lo = (q0 >= 128 ? q0 - 128 : 0) >> 6, t_hi = (q0 + 255) >> 6, nt = t_hi - t_lo + 1;
    const int b = bh >> 2, h = bh & 3, rs = 64 * dil;
    const bf16_t* Qg = (const bf16_t*)(P.ws + OFF_QKV + 6 * SZ_HEADBUF) + ((size_t)bh * SEQ + res) * 64; const bf16_t* Kg = Qg + SZ_HEADBUF / 2; const bf16_t* Vg = Kg + SZ_HEADBUF / 2;
    const int qw = q0 + 32 * wid;
    constexpr int D_KB = 0, D_VB = 6 * KSLOT, D_AUX = D_VB + 6 * 8192;
    LAS float* aux = (LAS float*)(lds + D_AUX);
    __syncthreads();
    const unsigned kgo = (unsigned)((tid >> 3) * rs + (tid & 7) * 8), vgo = (unsigned)(((tid >> 2) & 63) * rs + (tid >> 8) * 32 + (tid & 3) * 8);
    u32x4 kr[6], vr[6];
#pragma unroll
    for (int j = 0; j < 6; ++j) if (j < nt) { kr[j] = *(const u32x4*)(Kg + (size_t)(t_lo + j) * 64 * rs + kgo); vr[j] = *(const u32x4*)(Vg + (size_t)(t_lo + j) * 64 * rs + vgo); }
    bf16x8 qf[4];
    { const bf16_t* qp = Qg + (size_t)(qw + r32) * rs + 8 * hi;
#pragma unroll
      for (int d0 = 0; d0 < 4; ++d0) qf[d0] = *(const bf16x8*)(qp + 16 * d0); }
    { const float* lut = (const float*)(P.ws + OFF_LUT) + (size_t)(4 + h) * 4096;
      if (tid < 320) { const int rel = 255 - tid; aux[tid] = (rel >= 0 && rel * dil < 4096) ? lut[rel * dil] : 0.f; } }
    { const int kws = (tid >> 3) * 144 + (tid & 7) * 16;
#pragma unroll
      for (int j = 0; j < 6; ++j) if (j < nt) { *(LAS u32x4*)(lds + D_KB + j * KSLOT + kws) = kr[j]; *(LAS u32x4*)(lds + D_VB + j * 8192 + tid * 16) = vr[j]; } }
    __syncthreads();
    const int kfo = D_KB + r32 * 144 + hi * 16;
    const int vfo = D_VB + ((lane >> 4) & 1) * 32 + (lane & 3) * 8 + (4 * hi + ((lane & 15) >> 2)) * 64;
    f32x16 o0, o1;
#pragma unroll
    for (int r = 0; r < 16; ++r) { o0[r] = 0.f; o1[r] = 0.f; }
    float lsum = 0.f;
    const int hb_hi = qw >> 5, hb_lo = hb_hi >= 4 ? hb_hi - 4 : 0;
    for (int hb = hb_lo; hb <= hb_hi; ++hb) {
        const int kh = hb * 32, jl = (hb >> 1) - t_lo, kb = hb & 1;
        const bool need_mask = (hb == hb_hi) || (kh < qw + 31 - 128);
        const int dl = qw + r32 - kh - 4 * hi;
        f32x16 p;
        { const LAS float* lp = aux + (255 - dl);
#pragma unroll
          for (int r = 0; r < 16; ++r) p[r] = lp[crow(r)]; }
        const LAS char* kb_ = lds + jl * KSLOT + kb * (32 * 144) + kfo;
#pragma unroll
        for (int d0 = 0; d0 < 4; ++d0) p = MFMA32(*(const LAS bf16x8*)(kb_ + d0 * 32), qf[d0], p);
        if (need_mask) {
#pragma unroll
            for (int r = 0; r < 16; ++r) { const int rel = dl - crow(r); p[r] = ((unsigned)rel <= 128u) ? p[r] : -INFINITY; }
        }
        float ps = 0.f;
#pragma unroll
        for (int r = 0; r < 16; ++r) { p[r] = __builtin_amdgcn_exp2f(p[r]); ps += p[r]; }
        lsum += ps;
        u32x4 w0, w1;
        w0.x = cvt2(p[0], p[1]); w0.y = cvt2(p[2], p[3]); w0.z = cvt2(p[4], p[5]); w0.w = cvt2(p[6], p[7]);
        w1.x = cvt2(p[8], p[9]); w1.y = cvt2(p[10], p[11]); w1.z = cvt2(p[12], p[13]); w1.w = cvt2(p[14], p[15]);
        const LAS char* vb_ = lds + jl * 8192 + vfo + kb * 2048;
        { const s16x4 a0 = vtr(vb_), a1 = vtr(vb_ + 512), c0 = vtr(vb_ + 4096), c1 = vtr(vb_ + 4096 + 512);
          o0 = MFMA32(__builtin_shufflevector(a0, a1, 0, 1, 2, 3, 4, 5, 6, 7), __builtin_bit_cast(bf16x8, w0), o0); o1 = MFMA32(__builtin_shufflevector(c0, c1, 0, 1, 2, 3, 4, 5, 6, 7), __builtin_bit_cast(bf16x8, w0), o1); }
        { const s16x4 a0 = vtr(vb_ + 1024), a1 = vtr(vb_ + 1024 + 512), c0 = vtr(vb_ + 4096 + 1024), c1 = vtr(vb_ + 4096 + 1024 + 512);
          o0 = MFMA32(__builtin_shufflevector(a0, a1, 0, 1, 2, 3, 4, 5, 6, 7), __builtin_bit_cast(bf16x8, w1), o0); o1 = MFMA32(__builtin_shufflevector(c0, c1, 0, 1, 2, 3, 4, 5, 6, 7), __builtin_bit_cast(bf16x8, w1), o1); }
    }
    const float ltot = swap_sum(lsum), inv = 1.0f / ltot;
    const size_t tok = (size_t)b * SEQ + (size_t)(qw + r32) * dil + res;
    bf16_t* dp = (bf16_t*)(P.ws + OFF_DPART) + ((size_t)pat * NT + tok) * 256 + h * 64 + 4 * hi;
#pragma unroll
    for (int g = 0; g < 4; ++g) { u32x2 w0, w1;
        w0.x = cvt2(o0[4 * g] * inv, o0[4 * g + 1] * inv); w0.y = cvt2(o0[4 * g + 2] * inv, o0[4 * g + 3] * inv);
        w1.x = cvt2(o1[4 * g] * inv, o1[4 * g + 1] * inv); w1.y = cvt2(o1[4 * g + 2] * inv, o1[4 * g + 3] * inv);
        *(u32x2*)(dp + 8 * g) = w0; *(u32x2*)(dp + 32 + 8 * g) = w1; }
    if (hi == 0) ((float*)(P.ws + OFF_DLSE))[((size_t)pat * NT + tok) * 4 + h] = __builtin_amdgcn_logf(ltot);
}

DEVINL void dilmix_unit(const Params& P, int u) {
    const int e = u * NTHREADS + ltid(), tok = e >> 5, hd = e & 31, h = hd >> 3, d8 = (hd & 7) * 8;
    const float* ls = (const float*)(P.ws + OFF_DLSE); const bf16_t* dp = (const bf16_t*)(P.ws + OFF_DPART);
    const float l0 = ls[(size_t)tok * 4 + h], l1 = ls[((size_t)NT + tok) * 4 + h], l2 = ls[((size_t)2 * NT + tok) * 4 + h];
    const float mx = fmaxf(l0, fmaxf(l1, l2)); float w0 = __builtin_amdgcn_exp2f(l0 - mx), w1 = __builtin_amdgcn_exp2f(l1 - mx), w2 = __builtin_amdgcn_exp2f(l2 - mx);
    const float inv = 1.0f / (w0 + w1 + w2); w0 *= inv; w1 *= inv; w2 *= inv;
    const size_t off = (size_t)tok * 256 + h * 64 + d8;
    const u32x4 a = *(const u32x4*)(dp + off), b = *(const u32x4*)(dp + (size_t)NT * 256 + off), c = *(const u32x4*)(dp + (size_t)2 * NT * 256 + off);
    const u32x4 g = *(const u32x4*)((const bf16_t*)((const char*)P.out + OOFF_G) + (size_t)tok * DM + 512 + h * 64 + d8);
    u32x4 r;
    r.x = cvt2((w0 * bflo(a.x) + w1 * bflo(b.x) + w2 * bflo(c.x)) * bflo(g.x), (w0 * bfhi(a.x) + w1 * bfhi(b.x) + w2 * bfhi(c.x)) * bfhi(g.x));
    r.y = cvt2((w0 * bflo(a.y) + w1 * bflo(b.y) + w2 * bflo(c.y)) * bflo(g.y), (w0 * bfhi(a.y) + w1 * bfhi(b.y) + w2 * bfhi(c.y)) * bfhi(g.y));
    r.z = cvt2((w0 * bflo(a.z) + w1 * bflo(b.z) + w2 * bflo(c.z)) * bflo(g.z), (w0 * bfhi(a.z) + w1 * bfhi(b.z) + w2 * bfhi(c.z)) * bfhi(g.z));
    r.w = cvt2((w0 * bflo(a.w) + w1 * bflo(b.w) + w2 * bflo(c.w)) * bflo(g.w), (w0 * bfhi(a.w) + w1 * bfhi(b.w) + w2 * bfhi(c.w)) * bfhi(g.w));
    *(u32x4*)((bf16_t*)(P.ws + OFF_A2) + (size_t)tok * DM + 512 + h * 64 + d8) = r;
}


#define XB_TMO      128
#define XB_XCNT(j)  (256  + 64 * (j))
#define XB_XSUB(j)  (1280 + 64 * (j))
#define XB_XGEN(j)  (2304 + 64 * (j))
#define XB_TOP      3328
#define XB_TOPGEN   3392
#define XCD_BAR_WORDS 3456
#define XB_SPIN_CAP (1u << 20)
DEVINL unsigned xb_ld(unsigned* p) { return __hip_atomic_load(p, __ATOMIC_RELAXED, __HIP_MEMORY_SCOPE_AGENT); }
DEVINL unsigned xb_add(unsigned* p, unsigned v) { return __hip_atomic_fetch_add(p, v, __ATOMIC_RELAXED, __HIP_MEMORY_SCOPE_AGENT); }
DEVINL unsigned xb_xcc_id() { return (unsigned)__builtin_amdgcn_s_getreg((3 << 11) | 20) & 0xFu; }
#define XB_SPIN(cond, bar) do { unsigned _sp = 0; while (cond) { __builtin_amdgcn_s_sleep(1); \
    if ((++_sp & 255u) == 0u) { if (xb_ld(&(bar)[XB_TMO])) break; if (_sp > XB_SPIN_CAP) { atomicAdd(&(bar)[XB_TMO], 1u); break; } } } } while (0)
DEVINL void xcd_barrier_post(unsigned* bar) { if (ltid() == 0) (void)xb_add(&bar[XB_XCNT(xb_xcc_id())], 1u); }
DEVINL void xcd_barrier_complete(unsigned* bar, unsigned x, unsigned& nloc, unsigned& nx) {
    const unsigned G = gridDim.x * gridDim.y * gridDim.z;
    unsigned sum, cnt, mine, sp = 0u;
    for (;;) {
        sum = 0u; cnt = 0u; mine = 0u;
        for (unsigned j = 0; j < 16; ++j) { const unsigned c = xb_ld(&bar[XB_XCNT(j)]); sum += c; cnt += (c > 0u) ? 1u : 0u; mine = (j == x) ? c : mine; }
        if (sum == G) break;
        __builtin_amdgcn_s_sleep(1);
        if ((++sp & 255u) == 0u) { if (xb_ld(&bar[XB_TMO])) break; if (sp > XB_SPIN_CAP) { atomicAdd(&bar[XB_TMO], 1u); break; } }
    }
    nloc = mine > 0u ? mine : 1u; nx = cnt > 0u ? cnt : 1u;
}
DEVINL void xcd_barrier(unsigned* bar_in, volatile LAS unsigned* st) {
    asm volatile("s_waitcnt vmcnt(0)" ::: "memory");
    __syncthreads();
    if (ltid() == 0) {
        unsigned* bar = bar_in;
        const unsigned x = xb_xcc_id();
        __builtin_amdgcn_s_waitcnt(0);
        unsigned nloc = st[0], nx = st[1];
        if (nloc == 0u) { xcd_barrier_complete(bar, x, nloc, nx); st[0] = nloc; st[1] = nx; }
        const unsigned old = xb_add(&bar[XB_XSUB(x)], 1u);
        const unsigned gen = old / nloc;
        if (old + 1u == (gen + 1u) * nloc) {
            __builtin_amdgcn_fence(__ATOMIC_RELEASE, "agent");
            asm volatile("s_waitcnt vmcnt(0)" ::: "memory");
            const unsigned og = xb_add(&bar[XB_TOP], 1u);
            const unsigned tg = og / nx;
            if (og + 1u == (tg + 1u) * nx) xb_add(&bar[XB_TOPGEN], 1u);
            else XB_SPIN(xb_ld(&bar[XB_TOPGEN]) == tg, bar);
            __builtin_amdgcn_fence(__ATOMIC_ACQUIRE, "agent");
            asm volatile("s_waitcnt vmcnt(0)" ::: "memory");
        } else {
            XB_SPIN(xb_ld(&bar[XB_TOPGEN]) == gen, bar);
            __builtin_amdgcn_fence(__ATOMIC_ACQUIRE, "agent");
            asm volatile("s_waitcnt vmcnt(0)" ::: "memory");
        }
    }
    __syncthreads();
}


DEVINL int next_unit(unsigned* ctr, char* smem) {
    int* su = (int*)(smem + L_MISC);
    __syncthreads();
    if (ltid() == 0) *su = (int)atomicAdd(ctr, 1u);
    __syncthreads();
    return *su;
}

template <class Epi> DEVINL void gemm8_sub(const bf16_t* A, const bf16_t* Bt, int M, int N, int K, const Epi& E, char* smem, int G, int c) {
    asm volatile("" : "+s"(G), "+s"(c));
    pg8::Gemm g{A, Bt, M, N, K}; pg8::StaticOrder S; S.init(M, N, G, c);
    pg8::gemm_phase<Epi, pg8::StaticOrder, true, true>((PG8_LAS unsigned char*)smem, g, S, E);
}
DEVINL void phase_pre(const Params& P, int l, char* smem) {
    const int half = (int)gridDim.x >> 1, bid = (int)blockIdx.x;
    if (bid < half) gemm8_sub((const bf16_t*)(P.ws + OFF_CQ), (const bf16_t*)(P.ws + OFF_WT_UQ + l * SZ_WT_UQ), NT, 512, 256, EpiUq8{P, l}, smem, half, bid);
    else gemm8_sub((const bf16_t*)(P.ws + OFF_CKV), (const bf16_t*)(P.ws + OFF_WT_UKV + l * SZ_WT_UKV), NT, 512, 256, EpiUkv8{P, l}, smem, (int)gridDim.x - half, bid - half);
    for (int u = blockIdx.x; u < 256; u += gridDim.x) kmean_unit(P, u, smem);
}
DEVINL void phase_att(const Params& P, int l, char* smem, int rep) {
    unsigned* ctr = (unsigned*)(P.ws + OFF_CTR) + l * 2 + rep * 8;
    constexpr int N_ATT = 384 + 256 + 96 + 768 + 32; const int n_all = N_ATT + (l == 0 ? PREP_PER_LAYER + PREP_P_UNITS / 2 : 0);
    for (;;) {
#ifdef PROBE_CLS
        const unsigned long long tq0 = __builtin_amdgcn_s_memrealtime(); int cls = 4;
#define PCLS(c) cls = (c);
#else
#define PCLS(c)
#endif
        int u = next_unit(ctr, smem); if (u >= n_all) break;
        if (u >= N_ATT) { __syncthreads(); if (u - N_ATT < PREP_PER_LAYER) prep_w_unit(P, 1, u - N_ATT, (float*)smem); else prep_p_unit(P, PREP_P_UNITS / 2 + (u - N_ATT - PREP_PER_LAYER)); }
        else if (u >= 384 && u < 640) { PCLS(0) attn_unit<0>(P, l, u - 384, smem); }
        else if (u >= 736 && u < 736 + 768) { PCLS(3) if (((const float*)(P.ws + OFF_BOUND))[l * 4 + 3] < 100.0f) dil_unit(P, l, u - 736, smem); else attn_unit<3>(P, l, u - 736, smem); }
        else {
            if (u >= 736 + 768) u -= 768; if (u >= 640) u -= 256;
            const int g = u >> 5, r = u & 31, uu = g * 16 + (r & 15);
            if (r < 16) { PCLS(2) attn_unit<2>(P, l, uu, smem); } else { PCLS(1) attn_unit<1>(P, l, uu, smem); } }
#ifdef PROBE_CLS
        if (blockIdx.x == PROBE_BLK && cls == PROBE_CLS && ltid() == 0) { LAS unsigned* pa = (LAS unsigned*)((LAS char*)smem + L_MISC + 32); pa[0] += (unsigned)(__builtin_amdgcn_s_memrealtime() - tq0); pa[1] += 1u; }
#endif
#undef PCLS
    }
}

template <int PH> DEVINL void run_phase(int l, char* smem, int rep = 0) {
    asm volatile("" : "+s"(l));
    const __attribute__((address_space(4))) Params* kp = (const __attribute__((address_space(4))) Params*)__builtin_amdgcn_kernarg_segment_ptr(); asm volatile("" : "+s"(kp));
    Params P;
    P.x = (const float*)as_global(kp->x); P.p = (const float*)as_global(kp->p); P.ln_g = (const float*)as_global(kp->ln_g); P.w_in = (const float*)as_global(kp->w_in); P.b_forget = (const float*)as_global(kp->b_forget);
    P.qk_gain = (const float*)as_global(kp->qk_gain); P.mla_q_norm = (const float*)as_global(kp->mla_q_norm); P.mla_kv_norm = (const float*)as_global(kp->mla_kv_norm); P.mla_nope_gain = (const float*)as_global(kp->mla_nope_gain);
    P.mla_rope_gain = (const float*)as_global(kp->mla_rope_gain); P.w_uq = (const float*)as_global(kp->w_uq); P.w_ukv = (const float*)as_global(kp->w_ukv); P.w_out = (const float*)as_global(kp->w_out); P.rel_bias = (const float*)as_global(kp->rel_bias);
    P.ple_norm_g = (const float*)as_global(kp->ple_norm_g); P.w_ple_gate = (const float*)as_global(kp->w_ple_gate); P.w_ple_proj = (const float*)as_global(kp->w_ple_proj); P.out = (float*)as_global(kp->out); P.ws = as_global(kp->ws);
    char* ws = P.ws;
    const bf16_t* xbase = l == 0 ? (const bf16_t*)nullptr : (const bf16_t*)(ws + OFF_H);
    float* xout = l == 0 ? (float*)nullptr : P.out;
    if (PH == 0) phase_prep(P, smem);
    if (PH == 2) { gemm8((const bf16_t*)(ws + OFF_H), (const bf16_t*)(ws + OFF_WT_IN + l * SZ_WT_IN), NT, NP1, 1024, EpiIn8{P, l}, smem);
                   const int G_ = (int)gridDim.x, w0_ = G_ > 192 ? 192 : 0;
                   if (l == 0 && (int)blockIdx.x >= w0_) { __syncthreads(); constexpr int W0 = PREP_T_IN + PREP_T_UQ + PREP_T_UKV, NWL = PREP_PER_LAYER - W0;
                       for (int u = (int)blockIdx.x - w0_; u < NWL + PREP_P_UNITS / 2; u += G_ - w0_) { if (u < NWL) prep_w_unit(P, 0, W0 + u, (float*)smem); else prep_p_unit(P, u - NWL); } } }
    if (PH == 3) phase_pre(P, l, smem);
    if (PH == 4) phase_att(P, l, smem, rep);
    if (PH == 5) { for (int u = blockIdx.x; u < 1024; u += gridDim.x) dilmix_unit(P, u);
                 }
    if (PH == 8) gemm8((const bf16_t*)(ws + OFF_A2), (const bf16_t*)(ws + OFF_WT_OUT + l * SZ_WT_SQ), NT, 1024, 1024, EpiResid8{P.x, xbase, (bf16_t*)(ws + OFF_XABF), (float*)(ws + OFF_SSQA)}, smem);
    if (PH == 7) { gemm8((const bf16_t*)(ws + (l == 0 ? OFF_PB : OFF_PB2)), (const bf16_t*)(ws + OFF_WT_PP + l * SZ_WT_PP), NT, 1024, 256, EpiStoreBf{(bf16_t*)(ws + OFF_QKV)}, smem);
                   __syncthreads();
                   gemm8((const bf16_t*)(ws + OFF_XABF), (const bf16_t*)(ws + OFF_WT_PG + l * SZ_WT_SQ), NT, 1024, 1024, EpiPle8{(const bf16_t*)(ws + OFF_XABF), (const bf16_t*)(ws + OFF_QKV), xout, (const float*)(ws + OFF_SSQA), l == 0 ? (bf16_t*)(ws + OFF_H) : (bf16_t*)nullptr, (float*)(ws + OFF_SSQX)}, smem); }
}

__global__ void __launch_bounds__(NTHREADS) k_mega(Params Parg) {
    char* smem = g_smem;
    { const int t0 = (int)threadIdx.x; if (t0 < 12) ((LAS unsigned*)((LAS char*)smem + L_XB))[t0] = 0u;
      if ((t0 & 63) == 0) *(LAS int*)((LAS char*)smem + L_WTAB + 4u * (unsigned)__builtin_amdgcn_s_getreg(0x2804)) = t0 >> 6; }
    __syncthreads();
    const __attribute__((address_space(4))) Params* kp0 = (const __attribute__((address_space(4))) Params*)__builtin_amdgcn_kernarg_segment_ptr();
    xcd_barrier_post((unsigned*)(as_global(kp0->ws) + OFF_BAR));
#define XBAR() xcd_barrier((unsigned*)(as_global(kp0->ws) + OFF_BAR), (volatile LAS unsigned*)((LAS char*)smem + L_XB))
#ifdef PROBE_IDX
    unsigned long long tA = 0, tB = 0;
#define PT0(i) if (PROBE_IDX == (i)) tA = __builtin_amdgcn_s_memrealtime();
#define PT1(i) if (PROBE_IDX == (i)) tB = __builtin_amdgcn_s_memrealtime();
#else
#define PT0(i)
#define PT1(i)
#endif
    PT0(0) run_phase<0>(0, smem); XBAR(); PT1(0)
    PT0(2) run_phase<2>(0, smem); XBAR(); PT1(2) PT0(3) run_phase<3>(0, smem); XBAR(); PT1(3) PT0(4) run_phase<4>(0, smem); XBAR(); PT1(4)
    PT0(5) run_phase<5>(0, smem); XBAR(); PT1(5) PT0(6) run_phase<8>(0, smem); XBAR(); PT1(6) PT0(8) run_phase<7>(0, smem); XBAR(); PT1(8)
    run_phase<2>(1, smem); XBAR(); run_phase<3>(1, smem); XBAR(); run_phase<4>(1, smem); XBAR(); run_phase<5>(1, smem); XBAR(); run_phase<8>(1, smem); XBAR(); run_phase<7>(1, smem);
#ifdef PROBE_IDX
    if (blockIdx.x == 0) { const unsigned long long t0 = __builtin_amdgcn_s_memrealtime(), want = (tB - tA) * 32ull; while (__builtin_amdgcn_s_memrealtime() - t0 < want) __builtin_amdgcn_s_sleep(32); }
#endif
#undef XBAR
#ifdef PROBE_CLS
    if (blockIdx.x == PROBE_BLK) { __syncthreads(); const LAS unsigned* pa = (const LAS unsigned*)((LAS char*)smem + L_MISC + 32); const unsigned long long tk = pa[0], nt = pa[1] ? pa[1] : 1u;
        const unsigned long long t0 = __builtin_amdgcn_s_memrealtime(), want = tk * 128ull / nt; while (__builtin_amdgcn_s_memrealtime() - t0 < want) __builtin_amdgcn_s_sleep(32); }
#endif
}
}

extern "C" void kernel_launch(void* const* d_in, const int* in_sizes, int n_in, void* d_out, int out_size, void* d_ws, size_t ws_size, hipStream_t stream) {
    Params P{};
    P.x = (const float*)d_in[0]; P.p = (const float*)d_in[1]; P.ln_g = (const float*)d_in[2]; P.w_in = (const float*)d_in[3]; P.b_forget = (const float*)d_in[4]; P.qk_gain = (const float*)d_in[5];
    P.mla_q_norm = (const float*)d_in[6]; P.mla_kv_norm = (const float*)d_in[7]; P.mla_nope_gain = (const float*)d_in[8]; P.mla_rope_gain = (const float*)d_in[9]; P.w_uq = (const float*)d_in[10];
    P.w_ukv = (const float*)d_in[11]; P.w_out = (const float*)d_in[12]; P.rel_bias = (const float*)d_in[13]; P.ple_norm_g = (const float*)d_in[14]; P.w_ple_gate = (const float*)d_in[15]; P.w_ple_proj = (const float*)d_in[16];
    P.out = (float*)d_out; P.ws = (char*)d_ws;
    if (ws_size < WS_NEED) { fprintf(stderr, "workspace too small: %zu < %zu\n", ws_size, (size_t)WS_NEED); return; }
    static int grid_blocks = 0;
    if (!grid_blocks) {
        int dev = 0, cus = 0, per_cu = 0;
        hipGetDevice(&dev);
        hipDeviceGetAttribute(&cus, hipDeviceAttributeMultiprocessorCount, dev);
        hipOccupancyMaxActiveBlocksPerMultiprocessor(&per_cu, k_mega, NTHREADS, 0);
        if (per_cu > 1) per_cu = 1;
        grid_blocks = cus * per_cu;
    }
    hipMemsetAsync((char*)d_ws + OFF_CTR, 0, 512 + 3456 * 4, stream);
    void* args[] = {&P};
    hipError_t e = hipLaunchCooperativeKernel((void*)k_mega, dim3(grid_blocks), dim3(NTHREADS), args, 0, stream);
    if (e != hipSuccess) fprintf(stderr, "cooperative launch failed: %s (grid %d)\n", hipGetErrorString(e), grid_blocks);
}
```

```cpp
#include <hip/hip_runtime.h>
#include <hip/hip_cooperative_groups.h>
#include <cstdint>
#include <cstdio>

#ifndef ONE_LAUNCH
#define ONE_LAUNCH 1
#endif

namespace {
#define DEVINL __device__ __forceinline__
typedef unsigned short bf16_t;
typedef short bf16x8 __attribute__((ext_vector_type(8)));
typedef float f32x4 __attribute__((ext_vector_type(4)));
typedef unsigned u32x2 __attribute__((ext_vector_type(2)));
typedef unsigned u32x4 __attribute__((ext_vector_type(4)));

constexpr int NB = 4, SEQ = 4096, DM = 1024, NT = NB * SEQ, NH = 4, NBH = NB * NH;
constexpr int INW = 3748, NP1 = 3840;
constexpr float EPS = 1e-6f, LOG2E = 1.4426950408889634f;
constexpr float SC_Q = 0.125f * LOG2E;
constexpr float SC_MLA = 0.10206207261596575f * LOG2E;
constexpr int NTHREADS = 512;

constexpr size_t SZ_WT_IN = (size_t)NP1 * 1024 * 2, SZ_WT_UQ = 512 * 256 * 2  , SZ_WT_UKV = 512 * 256 * 2  , SZ_WT_SQ = 1024 * 1024 * 2, SZ_WT_PP = 1024 * 256 * 2;
constexpr size_t OFF_WT_IN = 0;
constexpr size_t OFF_WT_UQ = OFF_WT_IN + 2 * SZ_WT_IN;
constexpr size_t OFF_WT_UKV = OFF_WT_UQ + 2 * SZ_WT_UQ;
constexpr size_t OFF_WT_OUT = OFF_WT_UKV + 2 * SZ_WT_UKV;
constexpr size_t OFF_WT_PG = OFF_WT_OUT + 2 * SZ_WT_SQ;
constexpr size_t OFF_WT_PP = OFF_WT_PG + 2 * SZ_WT_SQ;
constexpr size_t OFF_LUT = OFF_WT_PP + 2 * SZ_WT_PP;
constexpr size_t OFF_ROPE = OFF_LUT + 8 * 4096 * 4;
constexpr size_t OFF_H = OFF_ROPE + 4096 * 16 * 8;
constexpr size_t SZ_HEADBUF = (size_t)NT * 256 * 2;
constexpr size_t OFF_QKV = OFF_H + (size_t)NT * 1024 * 2;
constexpr size_t OFF_XABF = OFF_QKV + (size_t)NT * 1024 * 2;
constexpr size_t OFF_CQ = OFF_QKV + 9 * SZ_HEADBUF;
constexpr size_t OFF_CKV = OFF_CQ + (size_t)NT * 256 * 2;
constexpr size_t OFF_CQSS = OFF_CKV + (size_t)NT * 256 * 2;
constexpr size_t OFF_CKVSS = OFF_CQSS + (size_t)NT * 4 * 4;
constexpr size_t OFF_LOGF = OFF_CKVSS + (size_t)NT * 2 * 4;
constexpr size_t OFF_KMEAN = OFF_LOGF + (size_t)NBH * SEQ * 4;
constexpr size_t OFF_PB = OFF_KMEAN + (size_t)NBH * 16 * 64 * 4;
constexpr size_t OFF_X = OFF_PB + (size_t)NT * 256 * 2;
constexpr size_t OFF_A2 = OFF_X;
constexpr size_t OFF_PB2 = OFF_X + (size_t)NT * 1024 * 4;
constexpr size_t OFF_SSQX = OFF_PB2 + (size_t)NT * 256 * 2;
constexpr size_t OFF_SSQA = OFF_SSQX + (size_t)NT * 16 * 4;
constexpr size_t OFF_DPART = OFF_SSQA + (size_t)NT * 16 * 4;
constexpr size_t OFF_DLSE = OFF_DPART + 3 * (size_t)NT * 256 * 2;
constexpr size_t OFF_CTR = OFF_DLSE + 3 * (size_t)NT * 4 * 4;
constexpr size_t OFF_BOUND = OFF_CTR + 256;
constexpr size_t OFF_BAR = OFF_BOUND + 256;
constexpr size_t WS_NEED = OFF_BAR + 3456 * 4;
constexpr size_t OOFF_G = 0;
constexpr size_t OOFF_QM = (size_t)NT * 1024 * 2;
constexpr size_t OOFF_KM = OOFF_QM + (size_t)NBH * SEQ * 96 * 2;
constexpr size_t OOFF_VM = OOFF_KM + (size_t)NBH * SEQ * 96 * 2;

struct Params {
    const float *x, *p, *ln_g, *w_in, *b_forget, *qk_gain, *mla_q_norm, *mla_kv_norm, *mla_nope_gain, *mla_rope_gain, *w_uq, *w_ukv, *w_out, *rel_bias, *ple_norm_g, *w_ple_gate, *w_ple_proj;
    float* out;
    char* ws;
};

DEVINL char* as_global(const void* p) { __attribute__((address_space(1))) char* g; asm volatile("" : "=s"(g) : "0"(p)); return (char*)g; }
constexpr int L_MISC = 131072;
constexpr int L_XB = L_MISC + 16, L_WTAB = L_MISC + 64, SMEM_BYTES = L_MISC + 64 + 256;
__shared__ __attribute__((aligned(16))) char g_smem[SMEM_BYTES];
DEVINL int ltid() {
    const unsigned hw = (unsigned)__builtin_amdgcn_s_getreg(0x2804);
    const int w = __builtin_amdgcn_readfirstlane(*(const __attribute__((address_space(3))) int*)((__attribute__((address_space(3))) char*)g_smem + L_WTAB + hw * 4));
    int lane; asm volatile("v_mbcnt_lo_u32_b32 %0, -1, 0\n\tv_mbcnt_hi_u32_b32 %0, -1, %0" : "=v"(lane));
    return w * 64 + lane; }
DEVINL float shx(float v, int mask) { return __int_as_float(__builtin_amdgcn_ds_bpermute(((ltid() & 63) ^ mask) << 2, __float_as_int(v))); }
DEVINL float shup(float v, int o) { return __int_as_float(__builtin_amdgcn_ds_bpermute(((ltid() & 63) - o) << 2, __float_as_int(v))); }
DEVINL float sq4(const f32x4& a) { return a[0] * a[0] + a[1] * a[1] + a[2] * a[2] + a[3] * a[3]; }
template <int XM> DEVINL float swz_xor(float v) { return __int_as_float(__builtin_amdgcn_ds_swizzle(__float_as_int(v), (XM << 10) | 0x1F)); }
DEVINL float half_swap_sum(float v) { auto rr = __builtin_amdgcn_permlane32_swap(__float_as_uint(v), __float_as_uint(v), false, false); return __uint_as_float(rr[0]) + __uint_as_float(rr[1]); }
DEVINL float wave_sum(float v) { v += swz_xor<1>(v); v += swz_xor<2>(v); v += swz_xor<4>(v); v += swz_xor<8>(v); v += swz_xor<16>(v); return half_swap_sum(v); }
DEVINL bf16_t f2bf(float f) { unsigned u = __float_as_uint(f); u += 0x7fffu + ((u >> 16) & 1u); return (bf16_t)(u >> 16); }
DEVINL float bf2f(bf16_t h) { return __uint_as_float(((unsigned)h) << 16); }
DEVINL unsigned pack2(float a, float b) { return (unsigned)f2bf(a) | ((unsigned)f2bf(b) << 16); }
typedef __bf16 bf16v2 __attribute__((ext_vector_type(2)));
typedef float f32v2 __attribute__((ext_vector_type(2)));
DEVINL unsigned cvt2(float a, float b) { f32v2 v = {a, b}; return __builtin_bit_cast(unsigned, __builtin_convertvector(v, bf16v2)); }
DEVINL float bflo(unsigned u) { return __uint_as_float(u << 16); }
DEVINL float bfhi(unsigned u) { return __uint_as_float(u & 0xffff0000u); }

__device__ __constant__ float ROPE_INV[16] = {1.0f, 0.5623413251903491f, 0.31622776601683794f, 0.1778279410038923f, 0.1f, 0.05623413251903491f, 0.03162277660168379f, 0.01778279410038923f,
                                              0.01f, 0.005623413251903491f, 0.0031622776601683794f, 0.0017782794100389228f, 0.001f, 0.0005623413251903491f, 0.00031622776601683794f, 0.00017782794100389227f};

DEVINL int t5_bucket(int d) {
    if (d < 16) return d;
    int b = 16;
    b += (d >= 22); b += (d >= 30); b += (d >= 40); b += (d >= 54); b += (d >= 73); b += (d >= 99); b += (d >= 134); b += (d >= 182);
    b += (d >= 246); b += (d >= 332); b += (d >= 450); b += (d >= 609); b += (d >= 825); b += (d >= 1117); b += (d >= 1513);
    return b;
}

DEVINL int map_w_in(int n) { return n < 768 ? n : (n < 2720 ? n + 4 : (n < 2724 ? n - 2720 + 768 : (n < 2816 ? -1 : n - 92))); }
DEVINL int virt_col(int nv) { const int v = nv & 255; return (nv & ~255) + 64 * ((v >> 5) & 3) + 32 * (v >> 7) + (v & 31); }
DEVINL int map_w_in_virt(int nv) { int a = virt_col(nv); const int chunk = a >> 6; int hc = a & 63;
    if (chunk == 42 && hc < 32) hc = 16 * ((hc >> 2) & 1) + 4 * (hc >> 3) + (hc & 3);
    return map_w_in(chunk * 64 + hc); }
DEVINL int map_w_uq_virt(int nv) { const int a = virt_col(nv), chunk = a >> 6; int hc = a & 63; if (chunk >= 6) return -1;
    if (chunk >= 4) { const int e = hc & 31; hc = (hc & 32) + 16 * ((e >> 2) & 1) + 4 * (e >> 3) + (e & 3); }
    const int n = chunk * 64 + hc; if (n < 256) return (n >> 6) * 96 + (n & 63); const int r = n - 256; return (r >> 5) * 96 + 64 + (r & 31); }
DEVINL int map_w_uq(int n) { if (n < 256) return (n >> 6) * 96 + (n & 63); const int r = n - 256; return (r >> 5) * 96 + 64 + (r & 31); }

template <int KT>
DEVINL void transpose_tile(const float* src, int Nsrc, bf16_t* dst, int K, int tn, int tk, int mode, const float* fold, float* tile  ) {
    const int tid = ltid(), c4 = (tid & 15) * 4, kr = tid >> 4  , n0 = tn * 64, k0 = tk * KT;
    const int n = n0 + c4, oc = mode == 1 ? map_w_in_virt(n) : (mode == 2 ? map_w_uq(n) : (mode == 3 ? virt_col(n) : (mode == 4 ? map_w_uq_virt(n) : (mode == 5 ? virt_col(n) : n))));
    f32x4 v[KT / 32];
#pragma unroll
    for (int i = 0; i < KT / 32; ++i) { const int kk = kr + 32 * i; v[i] = (f32x4){0.f, 0.f, 0.f, 0.f}; if (oc >= 0 && !(mode == 5 && k0 + kk >= 128)) { v[i] = __builtin_nontemporal_load((const f32x4*)(src + (size_t)(k0 + kk) * Nsrc + oc)); if (fold) v[i] = v[i] * fold[k0 + kk]; } }
    __syncthreads();
#pragma unroll
    for (int i = 0; i < KT / 32; ++i) *(f32x4*)(tile + (kr + 32 * i) * 68 + c4) = v[i];
    __syncthreads();
#pragma unroll
    for (int h = 0; h < KT / 64; ++h) { const int nn = tid & 63, kc = h * 64 + (tid >> 6) * 8; const float* tp = tile + kc * 68 + nn; u32x4 w;
      w.x = cvt2(tp[0], tp[68]); w.y = cvt2(tp[136], tp[204]); w.z = cvt2(tp[272], tp[340]); w.w = cvt2(tp[408], tp[476]);
      *(u32x4*)(dst + (size_t)(n0 + nn) * K + k0 + kc) = w; }
}

constexpr int PREP_T_IN = 60 * 4, PREP_T_UQ = 8 * 1, PREP_T_UKV = 8 * 1, PREP_T_SQ = 16 * 4, PREP_T_PP = 16 * 1;
constexpr int PREP_PER_LAYER = PREP_T_IN + PREP_T_UQ + PREP_T_UKV + 2 * PREP_T_SQ + PREP_T_PP;
constexpr int PREP_LUT_UNITS = 8 * 4096 / 512, PREP_ROPE_UNITS = 4096 * 16 / 512;
constexpr int PREP_X_UNITS = NT / 32, PREP_P_UNITS = 2 * NT / 64;
constexpr int PREP_UNITS = 2 * PREP_PER_LAYER + PREP_LUT_UNITS + PREP_ROPE_UNITS + PREP_X_UNITS + PREP_P_UNITS;

DEVINL void prep_w_unit(const Params& P, int l, int r, float* tile) {
    if (r < PREP_T_IN) { transpose_tile<256>(P.w_in + (size_t)l * 1024 * INW, INW, (bf16_t*)(P.ws + OFF_WT_IN + l * SZ_WT_IN), 1024, r % 60, r / 60, 1, P.ln_g + l * DM, tile); return; }
    r -= PREP_T_IN;
    if (r < PREP_T_UQ) { transpose_tile<256>(P.w_uq + (size_t)l * 256 * 384, 384, (bf16_t*)(P.ws + OFF_WT_UQ + l * SZ_WT_UQ), 256, r % 8, r / 8, 4, P.mla_q_norm + l * 256, tile); return; }
    r -= PREP_T_UQ;
    if (r < PREP_T_UKV) { transpose_tile<256>(P.w_ukv + (size_t)l * 128 * 512, 512, (bf16_t*)(P.ws + OFF_WT_UKV + l * SZ_WT_UKV), 256, r % 8, r / 8, 5, P.mla_kv_norm + l * 128, tile); return; }
    r -= PREP_T_UKV;
    if (r < PREP_T_SQ) { transpose_tile<256>(P.w_out + (size_t)l * 1024 * 1024, 1024, (bf16_t*)(P.ws + OFF_WT_OUT + l * SZ_WT_SQ), 1024, r % 16, r / 16, 3, nullptr, tile); return; }
    r -= PREP_T_SQ;
    if (r < PREP_T_SQ) { transpose_tile<256>(P.w_ple_gate + (size_t)l * 1024 * 1024, 1024, (bf16_t*)(P.ws + OFF_WT_PG + l * SZ_WT_SQ), 1024, r % 16, r / 16, 3, P.ple_norm_g + l * DM, tile); return; }
    r -= PREP_T_SQ;
    transpose_tile<256>(P.w_ple_proj + (size_t)l * 256 * 1024, 1024, (bf16_t*)(P.ws + OFF_WT_PP + l * SZ_WT_PP), 256, r % 16, r / 16, 3, nullptr, tile);
}
DEVINL void prep_p_unit(const Params& P, int v) {
    const int wid = ltid() >> 6, lane = ltid() & 63; f32x4 a[8];
#pragma unroll
    for (int rr = 0; rr < 8; ++rr) a[rr] = __builtin_nontemporal_load((const f32x4*)(P.p + (size_t)(v * 64 + wid * 8 + rr) * 256 + lane * 4));
#pragma unroll
    for (int rr = 0; rr < 8; ++rr) { const int row = v * 64 + wid * 8 + rr; u32x2 w; w.x = cvt2(a[rr][0], a[rr][1]); w.y = cvt2(a[rr][2], a[rr][3]);
        bf16_t* pb = row < NT ? (bf16_t*)(P.ws + OFF_PB) + (size_t)row * 256 : (bf16_t*)(P.ws + OFF_PB2) + (size_t)(row - NT) * 256; *(u32x2*)(pb + lane * 4) = w; }
}
DEVINL void phase_prep(const Params& P, char* smem) {
    float* tile = (float*)smem;
    if (blockIdx.x == 0) {
        const int w_ = ltid() >> 6, ln_ = ltid() & 63, l = w_ >> 2, md = w_ & 3; float bound;
        auto amax = [&](const float* p, int n) { float a = 0.f; for (int i = ln_; i < n; i += 64) a = fmaxf(a, fabsf(p[i]));
            a = fmaxf(a, swz_xor<1>(a)); a = fmaxf(a, swz_xor<2>(a)); a = fmaxf(a, swz_xor<4>(a)); a = fmaxf(a, swz_xor<8>(a)); a = fmaxf(a, swz_xor<16>(a));
            auto rr = __builtin_amdgcn_permlane32_swap(__float_as_uint(a), __float_as_uint(a), false, false); return fmaxf(__uint_as_float(rr[0]), __uint_as_float(rr[1])); };
        if (md == 2) { const float nq = amax(P.mla_nope_gain + (l * 2 + 0) * 64, 64), nk = amax(P.mla_nope_gain + (l * 2 + 1) * 64, 64), rq = amax(P.mla_rope_gain + (l * 2 + 0) * 32, 32), rk = amax(P.mla_rope_gain + (l * 2 + 1) * 32, 32);
            bound = sqrtf(64.f * nq * nq + 32.f * rq * rq) * sqrtf(64.f * nk * nk + 32.f * rk * rk) * SC_MLA; }
        else { const int mix = md == 0 ? 0 : (md == 1 ? 1 : 2); bound = 64.f * amax(P.qk_gain + (l * 6 + 2 * mix) * 64, 64) * amax(P.qk_gain + (l * 6 + 2 * mix + 1) * 64, 64) * SC_Q;
            if (md == 0) bound += 8.f; else bound += amax(P.rel_bias, 256) * LOG2E; }
        if (ln_ == 0) ((float*)(P.ws + OFF_BOUND))[l * 4 + md] = bound;
    }
    constexpr int U_W = PREP_PER_LAYER, U_LUT = U_W + PREP_LUT_UNITS, U_ROPE = U_LUT + PREP_ROPE_UNITS, U_X = U_ROPE + PREP_X_UNITS, U_P = U_X + PREP_P_UNITS / 2;
    for (int u = blockIdx.x; u < U_P; u += gridDim.x) {
        if (u < U_W) { if (u < PREP_T_IN + PREP_T_UQ + PREP_T_UKV) prep_w_unit(P, 0, u, tile); }
        else if (u < U_LUT) { const int e = (u - U_W) * 512 + ltid(), hh = e >> 12, d = e & 4095; ((float*)(P.ws + OFF_LUT))[e] = P.rel_bias[t5_bucket(d) * 8 + hh] * LOG2E; }
        else if (u < U_ROPE) { const int e = (u - U_LUT) * 512 + ltid(), pos = e >> 4, i = e & 15;
            const double rev = (double)pos * (double)ROPE_INV[i] * 0.15915494309189535; const float fr = (float)(rev - floor(rev));
            ((float2*)(P.ws + OFF_ROPE))[e] = make_float2(__builtin_amdgcn_cosf(fr), __builtin_amdgcn_sinf(fr)); }
        else if (u < U_X) { const int v = u - U_ROPE, wid = ltid() >> 6, lane = ltid() & 63;
            f32x4 a[4][4];
#pragma unroll
            for (int rr = 0; rr < 4; ++rr)
#pragma unroll
                for (int i = 0; i < 4; ++i) a[rr][i] = __builtin_nontemporal_load((const f32x4*)(P.x + (size_t)(v * 32 + wid * 4 + rr) * DM + i * 256 + lane * 4));
#pragma unroll
            for (int rr = 0; rr < 4; ++rr) { const int row = v * 32 + wid * 4 + rr; float ss = 0.f;
#pragma unroll
                for (int i = 0; i < 4; ++i) { ss += sq4(a[rr][i]); u32x2 w; w.x = cvt2(a[rr][i][0], a[rr][i][1]); w.y = cvt2(a[rr][i][2], a[rr][i][3]); *(u32x2*)((bf16_t*)(P.ws + OFF_H) + (size_t)row * DM + i * 256 + lane * 4) = w; }
                ss = wave_sum(ss); if (lane < 16) ((float*)(P.ws + OFF_SSQX))[(size_t)row * 16 + lane] = lane == 0 ? ss : 0.f;
                if (lane < 16) *(u32x4*)((bf16_t*)(P.ws + OFF_CKV) + (size_t)row * 256 + 128 + lane * 8) = (u32x4){0u, 0u, 0u, 0u}; } }
        else {   }
    }
}

DEVINL void phase_rms(const float* src, const float* g, bf16_t* dst, const float* psrc, bf16_t* pb) {
    const int wid = ltid() >> 6, lane = ltid() & 63;
    for (int u = blockIdx.x; u < NT / 8; u += gridDim.x) {
        const int row = u * 8 + wid; const float* xr = src + (size_t)row * DM;
        f32x4 v[4]; float ss = 0.f;
#pragma unroll
        for (int i = 0; i < 4; ++i) { v[i] = *(const f32x4*)(xr + i * 256 + lane * 4); ss += v[i][0] * v[i][0] + v[i][1] * v[i][1] + v[i][2] * v[i][2] + v[i][3] * v[i][3]; }
        ss = wave_sum(ss); const float r = rsqrtf(ss * (1.0f / DM) + EPS);
#pragma unroll
        for (int i = 0; i < 4; ++i) { const f32x4 gg = *(const f32x4*)(g + i * 256 + lane * 4); u32x2 w; w.x = pack2(v[i][0] * r * gg[0], v[i][1] * r * gg[1]); w.y = pack2(v[i][2] * r * gg[2], v[i][3] * r * gg[3]);
            *(u32x2*)(dst + (size_t)row * DM + i * 256 + lane * 4) = w; }
        if (psrc) { const f32x4 pv = *(const f32x4*)(psrc + (size_t)row * 256 + lane * 4); u32x2 w; w.x = pack2(pv[0], pv[1]); w.y = pack2(pv[2], pv[3]); *(u32x2*)(pb + (size_t)row * 256 + lane * 4) = w; }
    }
}

constexpr int GST = 40;
template <class Epi>
DEVINL void gemm_phase(const bf16_t* A, const bf16_t* Bt, int M, int N, int K, const Epi& epi, char* smem) {
    bf16_t* As = (bf16_t*)smem; bf16_t* Bs = As + 256 * GST;
    const int tid = ltid(), wid = tid >> 6, lane = tid & 63, wr = wid >> 1, wc = wid & 1, fr = lane & 15, fq = lane >> 4;
    const int ntm = M / 256, ntn = N / 128, nk = K / 32;
    const int lr = tid >> 2, lc = (tid & 3) * 8;
    for (int tile = blockIdx.x; tile < ntm * ntn; tile += gridDim.x) {
        const int tm = tile % ntm, tn = tile / ntm;
        const bf16_t* Ag = A + (size_t)(tm * 256 + lr) * K + lc; const bf16_t* Bg = Bt + (size_t)(tn * 128 + lr) * K + lc;
        f32x4 acc[4][4];
#pragma unroll
        for (int m = 0; m < 4; ++m)
#pragma unroll
            for (int n = 0; n < 4; ++n) acc[m][n] = (f32x4){0.f, 0.f, 0.f, 0.f};
        u32x4 ra0 = *(const u32x4*)Ag, ra1 = *(const u32x4*)(Ag + (size_t)128 * K), rb0 = *(const u32x4*)Bg;
        for (int kt = 0; kt < nk; ++kt) {
            __syncthreads();
            *(u32x4*)(As + lr * GST + lc) = ra0; *(u32x4*)(As + (lr + 128) * GST + lc) = ra1; *(u32x4*)(Bs + lr * GST + lc) = rb0;
            __syncthreads();
            if (kt + 1 < nk) { const int ko = (kt + 1) * 32; ra0 = *(const u32x4*)(Ag + ko); ra1 = *(const u32x4*)(Ag + (size_t)128 * K + ko); rb0 = *(const u32x4*)(Bg + ko); }
            bf16x8 af[4], bfr[4];
#pragma unroll
            for (int m = 0; m < 4; ++m) af[m] = *(const bf16x8*)(As + (wr * 64 + m * 16 + fr) * GST + fq * 8);
#pragma unroll
            for (int n = 0; n < 4; ++n) bfr[n] = *(const bf16x8*)(Bs + (wc * 64 + n * 16 + fr) * GST + fq * 8);
#pragma unroll
            for (int m = 0; m < 4; ++m)
#pragma unroll
                for (int n = 0; n < 4; ++n) acc[m][n] = __builtin_amdgcn_mfma_f32_16x16x32_bf16(bfr[n], af[m], acc[m][n], 0, 0, 0);
        }
        epi(acc, tm * 256 + wr * 64, tn * 2 + wc, fr, fq);
    }
    __syncthreads();
}

DEVINL float quad_sum(float v) { v += swz_xor<16>(v); return half_swap_sum(v); }
DEVINL void store4bf(bf16_t* p, float a, float b, float c, float d) { u32x2 w; w.x = pack2(a, b); w.y = pack2(c, d); *(u32x2*)p = w; }
DEVINL float fsigmoid(float z) { return __builtin_amdgcn_rcpf(1.0f + __builtin_amdgcn_exp2f(-LOG2E * z)); }
DEVINL float log_sigmoid(float z) { return fminf(z, 0.f) - log1pf(__expf(-fabsf(z))); }

struct EpiIn {
    Params P; int l;
    DEVINL void operator()(f32x4 (&acc)[4][4], int row0, int chunk, int fr, int fq) const {
        char* ws = P.ws; char* ob = (char*)P.out;
        if (chunk < 36) {
            const int g = chunk >> 2, h = chunk & 3, role = g % 3, mix = g / 3;
            bf16_t* dst = (bf16_t*)(ws + OFF_QKV + (size_t)g * SZ_HEADBUF);
            const float* gain = P.qk_gain + ((size_t)l * 6 + 2 * mix + (role == 1 ? 1 : 0)) * 64;
#pragma unroll
            for (int m = 0; m < 4; ++m) {
                const int t = row0 + 16 * m + fr, b = t >> 12, s = t & 4095; bf16_t* d = dst + ((size_t)(b * 4 + h) * SEQ + s) * 64 + 4 * fq;
                float r = 1.f;
                if (role != 2) { float ss = 0.f;
#pragma unroll
                    for (int n = 0; n < 4; ++n) ss += acc[m][n][0] * acc[m][n][0] + acc[m][n][1] * acc[m][n][1] + acc[m][n][2] * acc[m][n][2] + acc[m][n][3] * acc[m][n][3];
                    ss = quad_sum(ss); r = rsqrtf(ss * (1.0f / 64.0f) + EPS) * (role == 0 ? SC_Q : 1.0f); }
#pragma unroll
                for (int n = 0; n < 4; ++n) { f32x4 gg = (f32x4){1.f, 1.f, 1.f, 1.f}; if (role != 2) gg = *(const f32x4*)(gain + 16 * n + 4 * fq);
                    store4bf(d + 16 * n, acc[m][n][0] * r * gg[0], acc[m][n][1] * r * gg[1], acc[m][n][2] * r * gg[2], acc[m][n][3] * r * gg[3]); }
            }
        } else if (chunk < 42) {
            const bool isq = chunk < 40; const int c = isq ? chunk - 36 : chunk - 40;
            bf16_t* dst = isq ? (bf16_t*)(ws + OFF_CQ) : (bf16_t*)(ws + OFF_CKV); const int ld = isq ? 256 : 128;
            float* ssp = isq ? (float*)(ws + OFF_CQSS) : (float*)(ws + OFF_CKVSS); const int nss = isq ? 4 : 2;
#pragma unroll
            for (int m = 0; m < 4; ++m) {
                const int t = row0 + 16 * m + fr; float ss = 0.f;
#pragma unroll
                for (int n = 0; n < 4; ++n) { ss += acc[m][n][0] * acc[m][n][0] + acc[m][n][1] * acc[m][n][1] + acc[m][n][2] * acc[m][n][2] + acc[m][n][3] * acc[m][n][3];
                    store4bf(dst + (size_t)t * ld + c * 64 + 16 * n + 4 * fq, acc[m][n][0], acc[m][n][1], acc[m][n][2], acc[m][n][3]); }
                ss = quad_sum(ss); if (fq == 0) ssp[(size_t)t * nss + c] = ss;
            }
        } else if (chunk == 42) {
            const float* gr = P.mla_rope_gain + ((size_t)l * 2 + 1) * 32; const float2* rope = (const float2*)(ws + OFF_ROPE);
            bf16_t* km = (bf16_t*)(ob + OOFF_KM); float* logf_ = (float*)(ws + OFF_LOGF);
            const f32x4 g1 = *(const f32x4*)(gr + 4 * fq), g2 = *(const f32x4*)(gr + 16 + 4 * fq); const f32x4 bfv = *(const f32x4*)(P.b_forget + l * 4);
#pragma unroll
            for (int m = 0; m < 4; ++m) {
                const int t = row0 + 16 * m + fr, b = t >> 12, s = t & 4095;
                float ss = 0.f;
#pragma unroll
                for (int n = 0; n < 2; ++n) ss += acc[m][n][0] * acc[m][n][0] + acc[m][n][1] * acc[m][n][1] + acc[m][n][2] * acc[m][n][2] + acc[m][n][3] * acc[m][n][3];
                ss = quad_sum(ss); const float r = rsqrtf(ss * (1.0f / 32.0f) + EPS);
                float o1[4], o2[4];
#pragma unroll
                for (int j = 0; j < 4; ++j) { const float2 cs = rope[s * 16 + 4 * fq + j]; const float x1 = acc[m][0][j] * r * g1[j], x2 = acc[m][1][j] * r * g2[j]; o1[j] = x1 * cs.x - x2 * cs.y; o2[j] = x1 * cs.y + x2 * cs.x; }
#pragma unroll
                for (int h = 0; h < 4; ++h) { bf16_t* d = km + ((size_t)(b * 4 + h) * SEQ + s) * 96 + 64 + 4 * fq; store4bf(d, o1[0], o1[1], o1[2], o1[3]); store4bf(d + 16, o2[0], o2[1], o2[2], o2[3]); }
                if (fq == 0) {
#pragma unroll
                    for (int j = 0; j < 4; ++j) logf_[(size_t)(b * 4 + j) * SEQ + s] = log_sigmoid(acc[m][2][j] + bfv[j]) * LOG2E;
                }
            }
        } else if (chunk >= 44) {
            bf16_t* G = (bf16_t*)(ob + OOFF_G); const int c0 = (chunk - 44) * 64;
#pragma unroll
            for (int m = 0; m < 4; ++m) { const int t = row0 + 16 * m + fr;
#pragma unroll
                for (int n = 0; n < 4; ++n) { float o[4];
#pragma unroll
                    for (int j = 0; j < 4; ++j) { const float z = acc[m][n][j]; o[j] = z / (1.0f + __expf(-z)); }
                    store4bf(G + (size_t)t * DM + c0 + 16 * n + 4 * fq, o[0], o[1], o[2], o[3]); } }
        }
    }
};

struct EpiUq {
    Params P; int l;
    DEVINL void operator()(f32x4 (&acc)[4][4], int row0, int chunk, int fr, int fq) const {
        const float* cqss = (const float*)(P.ws + OFF_CQSS); bf16_t* qm = (bf16_t*)((char*)P.out + OOFF_QM); const float2* rope = (const float2*)(P.ws + OFF_ROPE);
#pragma unroll
        for (int m = 0; m < 4; ++m) {
            const int t = row0 + 16 * m + fr, b = t >> 12, s = t & 4095; const f32x4 pss = *(const f32x4*)(cqss + (size_t)t * 4);
            const float rt = rsqrtf((pss[0] + pss[1] + pss[2] + pss[3]) * (1.0f / 256.0f) + EPS);
            if (chunk < 4) {
                const float* gain = P.mla_nope_gain + ((size_t)l * 2 + 0) * 64; float ss = 0.f;
#pragma unroll
                for (int n = 0; n < 4; ++n) { acc[m][n] = acc[m][n] * rt; ss += acc[m][n][0] * acc[m][n][0] + acc[m][n][1] * acc[m][n][1] + acc[m][n][2] * acc[m][n][2] + acc[m][n][3] * acc[m][n][3]; }
                ss = quad_sum(ss); const float r = rsqrtf(ss * (1.0f / 64.0f) + EPS) * SC_MLA; bf16_t* d = qm + ((size_t)(b * 4 + chunk) * SEQ + s) * 96 + 4 * fq;
#pragma unroll
                for (int n = 0; n < 4; ++n) { const f32x4 gg = *(const f32x4*)(gain + 16 * n + 4 * fq); store4bf(d + 16 * n, acc[m][n][0] * r * gg[0], acc[m][n][1] * r * gg[1], acc[m][n][2] * r * gg[2], acc[m][n][3] * r * gg[3]); }
            } else {
                const float* gr = P.mla_rope_gain + ((size_t)l * 2 + 0) * 32; const f32x4 g1 = *(const f32x4*)(gr + 4 * fq), g2 = *(const f32x4*)(gr + 16 + 4 * fq);
#pragma unroll
                for (int hh = 0; hh < 2; ++hh) {
                    const int h = (chunk - 4) * 2 + hh; float ss = 0.f;
#pragma unroll
                    for (int n = 0; n < 2; ++n) { acc[m][2 * hh + n] = acc[m][2 * hh + n] * rt; const f32x4 a = acc[m][2 * hh + n]; ss += a[0] * a[0] + a[1] * a[1] + a[2] * a[2] + a[3] * a[3]; }
                    ss = quad_sum(ss); const float r = rsqrtf(ss * (1.0f / 32.0f) + EPS);
                    float o1[4], o2[4];
#pragma unroll
                    for (int j = 0; j < 4; ++j) { const float2 cs = rope[s * 16 + 4 * fq + j]; const float x1 = acc[m][2 * hh][j] * r * g1[j], x2 = acc[m][2 * hh + 1][j] * r * g2[j];
                        o1[j] = (x1 * cs.x - x2 * cs.y) * SC_MLA; o2[j] = (x1 * cs.y + x2 * cs.x) * SC_MLA; }
                    bf16_t* d = qm + ((size_t)(b * 4 + h) * SEQ + s) * 96 + 64 + 4 * fq; store4bf(d, o1[0], o1[1], o1[2], o1[3]); store4bf(d + 16, o2[0], o2[1], o2[2], o2[3]);
                }
            }
        }
    }
};
struct EpiUkv {
    Params P; int l;
    DEVINL void operator()(f32x4 (&acc)[4][4], int row0, int chunk, int fr, int fq) const {
        const float* ckvss = (const float*)(P.ws + OFF_CKVSS); bf16_t* km = (bf16_t*)((char*)P.out + OOFF_KM); bf16_t* vm = (bf16_t*)((char*)P.out + OOFF_VM);
        const int h = chunk >> 1; const bool isk = (chunk & 1) == 0; const float* gain = P.mla_nope_gain + ((size_t)l * 2 + 1) * 64;
#pragma unroll
        for (int m = 0; m < 4; ++m) {
            const int t = row0 + 16 * m + fr, b = t >> 12, s = t & 4095; const float rt = rsqrtf((ckvss[(size_t)t * 2] + ckvss[(size_t)t * 2 + 1]) * (1.0f / 128.0f) + EPS);
            float ss = 0.f;
#pragma unroll
            for (int n = 0; n < 4; ++n) { acc[m][n] = acc[m][n] * rt; ss += acc[m][n][0] * acc[m][n][0] + acc[m][n][1] * acc[m][n][1] + acc[m][n][2] * acc[m][n][2] + acc[m][n][3] * acc[m][n][3]; }
            if (isk) { ss = quad_sum(ss); const float r = rsqrtf(ss * (1.0f / 64.0f) + EPS); bf16_t* d = km + ((size_t)(b * 4 + h) * SEQ + s) * 96 + 4 * fq;
#pragma unroll
                for (int n = 0; n < 4; ++n) { const f32x4 gg = *(const f32x4*)(gain + 16 * n + 4 * fq); store4bf(d + 16 * n, acc[m][n][0] * r * gg[0], acc[m][n][1] * r * gg[1], acc[m][n][2] * r * gg[2], acc[m][n][3] * r * gg[3]); }
            } else { bf16_t* d = vm + ((size_t)(b * 4 + h) * SEQ + s) * 64 + 4 * fq;
#pragma unroll
                for (int n = 0; n < 4; ++n) store4bf(d + 16 * n, acc[m][n][0], acc[m][n][1], acc[m][n][2], acc[m][n][3]); }
        }
    }
};
struct EpiResid { const float* base; float* out;
    DEVINL void operator()(f32x4 (&acc)[4][4], int row0, int chunk, int fr, int fq) const {
#pragma unroll
        for (int m = 0; m < 4; ++m) { const size_t o = (size_t)(row0 + 16 * m + fr) * DM + chunk * 64 + 4 * fq;
#pragma unroll
            for (int n = 0; n < 4; ++n) { const f32x4 bv = *(const f32x4*)(base + o + 16 * n); *(f32x4*)(out + o + 16 * n) = bv + acc[m][n]; } } } };
struct EpiStore { float* out;
    DEVINL void operator()(f32x4 (&acc)[4][4], int row0, int chunk, int fr, int fq) const {
#pragma unroll
        for (int m = 0; m < 4; ++m) { const size_t o = (size_t)(row0 + 16 * m + fr) * DM + chunk * 64 + 4 * fq;
#pragma unroll
            for (int n = 0; n < 4; ++n) *(f32x4*)(out + o + 16 * n) = acc[m][n]; } } };
struct EpiPle { const float* xa; const float* pp; float* out;
    DEVINL void operator()(f32x4 (&acc)[4][4], int row0, int chunk, int fr, int fq) const {
#pragma unroll
        for (int m = 0; m < 4; ++m) { const size_t o = (size_t)(row0 + 16 * m + fr) * DM + chunk * 64 + 4 * fq;
#pragma unroll
            for (int n = 0; n < 4; ++n) { const f32x4 xv = *(const f32x4*)(xa + o + 16 * n), pv = *(const f32x4*)(pp + o + 16 * n); f32x4 r;
#pragma unroll
                for (int j = 0; j < 4; ++j) r[j] = xv[j] + pv[j] / (1.0f + __expf(-acc[m][n][j]));
                *(f32x4*)(out + o + 16 * n) = r; } } } };

namespace pg8 {
#define PG8_LAS __attribute__((address_space(3)))
constexpr int BM = 256, BK = 64, HALF = 128, HTB = HALF * BK * 2  , STAGE_BYTES = 8 * HTB, NXCD = 8, WGM = 8;

__host__ __device__ __forceinline__ int lds_byte(int r, int c) { const int st = (r >> 4) * 2 + (c >> 5), rr = r & 15, cc = c & 31, ob = rr * 64 + cc * 2; return st * 1024 + (ob ^ (((ob >> 9) & 1) << 5)); }
__host__ __device__ __forceinline__ void stage_rc(int b, int& R, int& C) { const int st = b / 1024, sb = b % 1024, swz = sb ^ (((sb >> 9) & 1) << 5); R = (st >> 1) * 16 + swz / 64; C = (st & 1) * 32 + (swz % 64) / 2; }
__host__ __device__ __forceinline__ int perm32(int rho) { const int n = rho >> 4, i = rho & 15; return 8 * (i >> 2) + 4 * n + (i & 3); }

struct Unit { int pm, pn; };
struct Gemm { const bf16_t* A; const bf16_t* Bt; int M, N, K; };

struct StaticOrder {
    int nM, nN, nwg, G, c;
    __host__ __device__ void init(int M, int N, int G_, int c_) { nM = M / BM; nN = N / BM; nwg = nM * nN; G = G_; c = c_; }
    __host__ __device__ bool next(int i, Unit& u) const {
        const long L = (long)i * G + c; if (L >= nwg) return false;
        int wgid = (int)L; { const int q = nwg / NXCD, r = nwg % NXCD, xcd = wgid % NXCD, off = wgid / NXCD; wgid = (xcd < r ? xcd * (q + 1) : r * (q + 1) + (xcd - r) * q) + off; }
        const int nig = WGM * nN, gid = wgid / nig, fm = gid * WGM, gsz = (nM - fm) < WGM ? (nM - fm) : WGM;
        u.pm = fm + ((wgid % nig) % gsz); u.pn = (wgid % nig) / gsz; return true;
    }
    __device__ __forceinline__ void a_ready(const Unit&) const {}
    __device__ __forceinline__ void done(const Unit&) const {}
};

template <class Epi, class Sched, bool ALIGN_EPI = false, bool SP2 = false>
__device__ __forceinline__ void gemm_phase(PG8_LAS unsigned char* lds, const Gemm g, const Sched& S, const Epi& E) {
    const int tid = ltid(), wid = __builtin_amdgcn_readfirstlane(tid >> 6), lane = tid & 63, wr = wid >> 2, wc = wid & 3, fr = lane & 15, fq = lane >> 4;
    const int K = g.K, nt = K / BK;
    unsigned voffA[2], voffB[2];
#pragma unroll
    for (int i = 0; i < 2; ++i) { int R, C; stage_rc(tid * 16 + i * 8192, R, C); const int Rb = Epi::PERM ? ((R & ~31) + perm32(R & 31)) : R;
        voffA[i] = (unsigned)(R * K + C) * 2u; voffB[i] = (unsigned)(Rb * K + C) * 2u; }
    const size_t kstep = (size_t)(BK * 2);
    const size_t hstep = (size_t)HALF * K * 2;
    const size_t tstep = 2 * hstep;
    const unsigned ldsw = (unsigned)wid * 1024u;
    const int aoff = lds_byte(wr * 64 + fr, fq * 8), boff = lds_byte(wc * 32 + fr, fq * 8);
    PG8_LAS unsigned char* ldsA = lds + aoff; PG8_LAS unsigned char* ldsB = lds + 65536 + boff; asm volatile("" : "+v"(ldsA), "+v"(ldsB));
#define PG8_SA(b, h) (((b) * 2 + (h)) * HTB)
#define PG8_SB(b, h) ((4 + (b) * 2 + (h)) * HTB)
#define PG8_STAGE(bufoff, gbase, voff) do { _Pragma("unroll") for (int _i = 0; _i < 2; ++_i) \
        __builtin_amdgcn_global_load_lds((const unsigned*)((const char*)(gbase) + (voff)[_i]), (PG8_LAS unsigned*)(lds + (bufoff) + ldsw + _i * 8192), 16, 0, 0); } while (0)
#define PG8_LDA(dst, b, h) do { _Pragma("unroll") for (int m = 0; m < 4; ++m) _Pragma("unroll") for (int k = 0; k < 2; ++k) dst[m][k] = *(const PG8_LAS bf16x8*)(ldsA + PG8_SA(b, h) + m * 2048 + k * 1024); } while (0)
#define PG8_LDB(dst, b, h) do { _Pragma("unroll") for (int n = 0; n < 2; ++n) _Pragma("unroll") for (int k = 0; k < 2; ++k) dst[n][k] = *(const PG8_LAS bf16x8*)(ldsB + (PG8_SB(b, h) - 65536) + n * 2048 + k * 1024); } while (0)
#define PG8_MMA(ai, bj, At, Bt) do { __builtin_amdgcn_s_setprio(1); _Pragma("unroll") for (int m = 0; m < 4; ++m) _Pragma("unroll") for (int n = 0; n < 2; ++n) _Pragma("unroll") for (int k = 0; k < 2; ++k) \
        acc[ai][bj][m][n] = __builtin_amdgcn_mfma_f32_16x16x32_bf16(Bt[n][k], At[m][k], acc[ai][bj][m][n], 0, 0, 0); __builtin_amdgcn_s_setprio(0); } while (0)
#define PG8_WAIT_V(n) asm volatile("s_waitcnt vmcnt(" #n ")" ::: "memory")
#define PG8_WAIT_L(n) asm volatile("s_waitcnt lgkmcnt(" #n ")" ::: "memory")
#define PG8_BAR __builtin_amdgcn_s_barrier()
#define PG8_SCHED __builtin_amdgcn_sched_barrier(0)
    Unit cur, nxt; int ui = 0;
    if (!S.next(0, cur)) return;
    f32x4 acc[2][2][4][2];
#pragma unroll
    for (int a = 0; a < 2; ++a)
#pragma unroll
        for (int b = 0; b < 2; ++b)
#pragma unroll
            for (int m = 0; m < 4; ++m)
#pragma unroll
                for (int n = 0; n < 2; ++n) acc[a][b][m][n] = (f32x4){0.f, 0.f, 0.f, 0.f};
    bf16x8 At[4][2], B0[2][2], B1[2][2];
    const char* cA = (const char*)g.A + (size_t)cur.pm * tstep; const char* cB = (const char*)g.Bt + (size_t)cur.pn * tstep;
    S.a_ready(cur);
    if constexpr (SP2) {
        PG8_STAGE(PG8_SB(0, 0), cB, voffB); PG8_STAGE(PG8_SB(0, 1), cB + hstep, voffB); PG8_STAGE(PG8_SA(0, 0), cA, voffA); PG8_STAGE(PG8_SA(0, 1), cA + hstep, voffA);
        if (wr == 1) PG8_BAR;
        PG8_WAIT_V(2); PG8_BAR;
        PG8_STAGE(PG8_SB(1, 0), cB + kstep, voffB); PG8_STAGE(PG8_SA(1, 0), cA + kstep, voffA); PG8_STAGE(PG8_SB(1, 1), cB + hstep + kstep, voffB);
        PG8_WAIT_V(6); PG8_BAR;
    } else {
        PG8_STAGE(PG8_SB(0, 0), cB, voffB); PG8_STAGE(PG8_SA(0, 0), cA, voffA); PG8_STAGE(PG8_SB(0, 1), cB + hstep, voffB); PG8_STAGE(PG8_SA(0, 1), cA + hstep, voffA);
        if (wr == 1) PG8_BAR;
        PG8_WAIT_V(4); PG8_BAR;
        PG8_STAGE(PG8_SB(1, 0), cB + kstep, voffB); PG8_STAGE(PG8_SA(1, 0), cA + kstep, voffA); PG8_STAGE(PG8_SB(1, 1), cB + hstep + kstep, voffB);
        PG8_WAIT_V(6); PG8_BAR;
    }
    for (;;) {
        const bool has_next = S.next(ui + 1, nxt);
        const char* nA = has_next ? (const char*)g.A + (size_t)nxt.pm * tstep : cA; const char* nB = has_next ? (const char*)g.Bt + (size_t)nxt.pn * tstep : cB;
        for (int t = 0; t < nt; t += 2) {
            const bool last = (t == nt - 2);
            const char* a1 = cA + (size_t)(t + 1) * kstep;
            const char* a2 = last ? nA : cA + (size_t)(t + 2) * kstep; const char* b2 = last ? nB : cB + (size_t)(t + 2) * kstep;
            const char* a3 = a2 + kstep; const char* b3 = b2 + kstep;
            if (last && has_next) S.a_ready(nxt);
            if constexpr (SP2) {
            PG8_LDB(B0, 0, 0); PG8_LDB(B1, 0, 1); PG8_SCHED; PG8_LDA(At, 0, 0); PG8_STAGE(PG8_SA(1, 1), a1 + hstep, voffA);
            PG8_WAIT_V(8); PG8_WAIT_L(0); PG8_BAR; PG8_MMA(0, 0, At, B0); PG8_MMA(0, 1, At, B1); PG8_BAR; PG8_SCHED;
            PG8_LDA(At, 0, 1); PG8_STAGE(PG8_SB(0, 0), b2, voffB); PG8_STAGE(PG8_SB(0, 1), b2 + hstep, voffB); PG8_STAGE(PG8_SA(0, 0), a2, voffA);
            PG8_WAIT_V(8); PG8_WAIT_L(0); PG8_BAR; PG8_MMA(1, 0, At, B0); PG8_MMA(1, 1, At, B1); PG8_BAR; PG8_SCHED;
            PG8_LDB(B0, 1, 0); PG8_LDB(B1, 1, 1); PG8_SCHED; PG8_LDA(At, 1, 0); PG8_STAGE(PG8_SA(0, 1), a2 + hstep, voffA);
            PG8_WAIT_V(8); PG8_WAIT_L(0); PG8_BAR; PG8_MMA(0, 0, At, B0); PG8_MMA(0, 1, At, B1); PG8_BAR; PG8_SCHED;
            PG8_LDA(At, 1, 1); PG8_STAGE(PG8_SB(1, 0), b3, voffB); PG8_STAGE(PG8_SB(1, 1), b3 + hstep, voffB); PG8_STAGE(PG8_SA(1, 0), a3, voffA);
            PG8_WAIT_V(8); PG8_WAIT_L(0); PG8_BAR; PG8_MMA(1, 0, At, B0); PG8_MMA(1, 1, At, B1); PG8_BAR; PG8_SCHED;
            } else {
            PG8_LDB(B0, 0, 0); PG8_SCHED; PG8_LDA(At, 0, 0); PG8_STAGE(PG8_SA(1, 1), a1 + hstep, voffA);
            PG8_WAIT_L(8); PG8_BAR; PG8_WAIT_L(0); PG8_MMA(0, 0, At, B0); PG8_BAR; PG8_SCHED;
            PG8_LDB(B1, 0, 1); PG8_STAGE(PG8_SB(0, 0), b2, voffB);
            PG8_BAR; PG8_WAIT_L(0); PG8_MMA(0, 1, At, B1); PG8_BAR;
            PG8_LDA(At, 0, 1); PG8_STAGE(PG8_SA(0, 0), a2, voffA);
            PG8_BAR; PG8_WAIT_L(0); PG8_MMA(1, 0, At, B0); PG8_BAR; PG8_SCHED;
            PG8_STAGE(PG8_SB(0, 1), b2 + hstep, voffB);
            PG8_WAIT_V(6); PG8_BAR; PG8_MMA(1, 1, At, B1); PG8_BAR;
            PG8_LDB(B0, 1, 0); PG8_SCHED; PG8_LDA(At, 1, 0); PG8_STAGE(PG8_SA(0, 1), a2 + hstep, voffA);
            PG8_WAIT_L(8); PG8_BAR; PG8_WAIT_L(0); PG8_MMA(0, 0, At, B0); PG8_BAR; PG8_SCHED;
            PG8_LDB(B1, 1, 1); PG8_STAGE(PG8_SB(1, 0), b3, voffB);
            PG8_BAR; PG8_WAIT_L(0); PG8_MMA(0, 1, At, B1); PG8_BAR;
            PG8_LDA(At, 1, 1); PG8_STAGE(PG8_SA(1, 0), a3, voffA);
            PG8_BAR; PG8_WAIT_L(0); PG8_MMA(1, 0, At, B0); PG8_BAR; PG8_SCHED;
            PG8_STAGE(PG8_SB(1, 1), b3 + hstep, voffB);
            PG8_WAIT_V(6); PG8_BAR; PG8_MMA(1, 1, At, B1); PG8_BAR;
            }
        }
        if constexpr (ALIGN_EPI) { if (wr == 0) PG8_BAR; }
        if constexpr (!Epi::AFTER_DRAIN) { E(acc, cur, wr, wc, fr, fq); S.done(cur); }
        if (!has_next) break;
#pragma unroll
        for (int a = 0; a < 2; ++a)
#pragma unroll
            for (int b = 0; b < 2; ++b)
#pragma unroll
                for (int m = 0; m < 4; ++m)
#pragma unroll
                    for (int n = 0; n < 2; ++n) acc[a][b][m][n] = (f32x4){0.f, 0.f, 0.f, 0.f};
        cur = nxt; cA = nA; cB = nB; ++ui;
        if constexpr (ALIGN_EPI) { if (wr == 1) PG8_BAR; }
    }
    PG8_WAIT_V(0);
    if constexpr (!ALIGN_EPI) { if (wr == 0) PG8_BAR; }
    PG8_BAR;
    if constexpr (Epi::AFTER_DRAIN) { E.fused(acc, cur, wr, wc, fr, fq, lds, wid, lane); S.done(cur); }
#undef PG8_SA
#undef PG8_SB
#undef PG8_STAGE
#undef PG8_LDA
#undef PG8_LDB
#undef PG8_MMA
#undef PG8_WAIT_V
#undef PG8_WAIT_L
#undef PG8_BAR
#undef PG8_SCHED
}
}


DEVINL u32x4 pack8(const f32x4& a, const f32x4& b) { u32x4 w; w.x = cvt2(a[0], a[1]); w.y = cvt2(a[2], a[3]); w.z = cvt2(b[0], b[1]); w.w = cvt2(b[2], b[3]); return w; }
DEVINL float row_rscale(const float* ssq, int t, int fq) { const f32x4 a = *(const f32x4*)(ssq + (size_t)t * 16 + 4 * fq); return rsqrtf(quad_sum(a[0] + a[1] + a[2] + a[3]) * (1.0f / DM) + EPS); }
#define EPI_ROW(i) (u.pm * 256 + 128 * ((i) >> 2) + 64 * wr + 16 * ((i) & 3) + fr)
struct EpiIn8 {
    static constexpr bool PERM = true, AFTER_DRAIN = false;
    Params P; int l;
    DEVINL void operator()(const f32x4 (&acc0)[2][2][4][2], const pg8::Unit& u, int wr, int wc, int fr, int fq) const {
        { const int t_ = ltid(); fr = t_ & 15; fq = (t_ >> 4) & 3; wc = __builtin_amdgcn_readfirstlane((t_ >> 6) & 3); wr = __builtin_amdgcn_readfirstlane(t_ >> 8); }
        char* ws = P.ws; char* ob = (char*)P.out; const int chunk = u.pn * 4 + wc;
        const float* ssqx = (const float*)(ws + OFF_SSQX);
        float rt8[8];
        { f32x4 sq[8];
#pragma unroll
          for (int i = 0; i < 8; ++i) sq[i] = *(const f32x4*)(ssqx + (size_t)EPI_ROW(i) * 16 + 4 * fq);
#pragma unroll
          for (int i = 0; i < 8; ++i) rt8[i] = rsqrtf(quad_sum(sq[i][0] + sq[i][1] + sq[i][2] + sq[i][3]) * (1.0f / DM) + EPS); }
        if (chunk < 36) {
            const int g = chunk >> 2, h = chunk & 3, role = g % 3, mix = g / 3;
            bf16_t* dst = (bf16_t*)(ws + OFF_QKV + (size_t)g * SZ_HEADBUF);
            const float* gain = P.qk_gain + ((size_t)l * 6 + 2 * mix + (role == 1 ? 1 : 0)) * 64 + 8 * fq;
            f32x4 gg[2][2];
#pragma unroll
            for (int bj = 0; bj < 2; ++bj)
#pragma unroll
                for (int n = 0; n < 2; ++n) gg[bj][n] = role != 2 ? *(const f32x4*)(gain + 32 * bj + 4 * n) : (f32x4){1.f, 1.f, 1.f, 1.f};
#pragma unroll
            for (int ai = 0; ai < 2; ++ai)
#pragma unroll
                for (int m = 0; m < 4; ++m) {
                    const int t = u.pm * 256 + 128 * ai + 64 * wr + 16 * m + fr, b = t >> 12, s = t & 4095; const float rt_ = rt8[ai * 4 + m]; const f32x4 a[2][2] = {{acc0[ai][0][m][0] * rt_, acc0[ai][0][m][1] * rt_}, {acc0[ai][1][m][0] * rt_, acc0[ai][1][m][1] * rt_}}; bf16_t* d = dst + ((size_t)(b * 4 + h) * SEQ + s) * 64 + 8 * fq;
                    float r = 1.f;
                    if (role != 2) { float ss = sq4(a[0][0]) + sq4(a[0][1]) + sq4(a[1][0]) + sq4(a[1][1]); ss = quad_sum(ss); r = rsqrtf(ss * (1.0f / 64.0f) + EPS) * (role == 0 ? SC_Q : 1.0f); }
#pragma unroll
                    for (int bj = 0; bj < 2; ++bj) *(u32x4*)(d + 32 * bj) = pack8(a[bj][0] * r * gg[bj][0], a[bj][1] * r * gg[bj][1]);
                }
        } else if (chunk < 42) {
            const bool isq = chunk < 40; const int c = isq ? chunk - 36 : chunk - 40;
            bf16_t* dst = isq ? (bf16_t*)(ws + OFF_CQ) : (bf16_t*)(ws + OFF_CKV); const int ld = 256;
            float* ssp = isq ? (float*)(ws + OFF_CQSS) : (float*)(ws + OFF_CKVSS); const int nss = isq ? 4 : 2;
#pragma unroll
            for (int ai = 0; ai < 2; ++ai)
#pragma unroll
                for (int m = 0; m < 4; ++m) {
                    const int t = u.pm * 256 + 128 * ai + 64 * wr + 16 * m + fr; const float rt_ = rt8[ai * 4 + m]; const f32x4 a[2][2] = {{acc0[ai][0][m][0] * rt_, acc0[ai][0][m][1] * rt_}, {acc0[ai][1][m][0] * rt_, acc0[ai][1][m][1] * rt_}};
                    float ss = sq4(a[0][0]) + sq4(a[0][1]) + sq4(a[1][0]) + sq4(a[1][1]); ss = quad_sum(ss);
#pragma unroll
                    for (int bj = 0; bj < 2; ++bj) *(u32x4*)(dst + (size_t)t * ld + c * 64 + 32 * bj + 8 * fq) = pack8(a[bj][0], a[bj][1]);
                    if (fq == 0) ssp[(size_t)t * nss + c] = ss;
                }
        } else if (chunk == 42) {
            const float* gr = P.mla_rope_gain + ((size_t)l * 2 + 1) * 32; const float2* rope = (const float2*)(ws + OFF_ROPE);
            bf16_t* km = (bf16_t*)(ob + OOFF_KM); float* logf_ = (float*)(ws + OFF_LOGF);
            const f32x4 g1 = *(const f32x4*)(gr + 4 * fq), g2 = *(const f32x4*)(gr + 16 + 4 * fq); const f32x4 bfv = *(const f32x4*)(P.b_forget + l * 4);
#pragma unroll
            for (int ai = 0; ai < 2; ++ai) {
                f32x4 cs4[4][2];
#pragma unroll
                for (int m = 0; m < 4; ++m) { const f32x4* rp = (const f32x4*)(rope + (EPI_ROW(ai * 4 + m) & 4095) * 16 + 4 * fq); cs4[m][0] = rp[0]; cs4[m][1] = rp[1]; }
#pragma unroll
                for (int m = 0; m < 4; ++m) {
                    const int t = u.pm * 256 + 128 * ai + 64 * wr + 16 * m + fr, b = t >> 12, s = t & 4095; const float rt_ = rt8[ai * 4 + m]; const f32x4 a[2][2] = {{acc0[ai][0][m][0] * rt_, acc0[ai][0][m][1] * rt_}, {acc0[ai][1][m][0] * rt_, acc0[ai][1][m][1] * rt_}};
                    float ss = sq4(a[0][0]) + sq4(a[0][1]); ss = quad_sum(ss); const float r = rsqrtf(ss * (1.0f / 32.0f) + EPS);
                    float o1[4], o2[4];
#pragma unroll
                    for (int j = 0; j < 4; ++j) { const float cx = cs4[m][j >> 1][2 * (j & 1)], sy = cs4[m][j >> 1][2 * (j & 1) + 1]; const float x1 = a[0][0][j] * r * g1[j], x2 = a[0][1][j] * r * g2[j]; o1[j] = x1 * cx - x2 * sy; o2[j] = x1 * sy + x2 * cx; }
#pragma unroll
                    for (int h = 0; h < 4; ++h) { bf16_t* d = km + ((size_t)(b * 4 + h) * SEQ + s) * 96 + 64 + 4 * fq; store4bf(d, o1[0], o1[1], o1[2], o1[3]); store4bf(d + 16, o2[0], o2[1], o2[2], o2[3]); }
                    if (fq == 0) {
#pragma unroll
                        for (int j = 0; j < 4; ++j) logf_[(size_t)(b * 4 + j) * SEQ + s] = log_sigmoid(a[1][0][j] + bfv[j]) * LOG2E;
                    }
                } }
        } else if (chunk >= 44) {
            bf16_t* G = (bf16_t*)(ob + OOFF_G); const int c0 = (chunk - 44) * 64 + 8 * fq;
#pragma unroll
            for (int ai = 0; ai < 2; ++ai)
#pragma unroll
                for (int m = 0; m < 4; ++m) {
                    const int t = u.pm * 256 + 128 * ai + 64 * wr + 16 * m + fr; const float rt_ = rt8[ai * 4 + m]; const f32x4 a[2][2] = {{acc0[ai][0][m][0] * rt_, acc0[ai][0][m][1] * rt_}, {acc0[ai][1][m][0] * rt_, acc0[ai][1][m][1] * rt_}};
#pragma unroll
                    for (int bj = 0; bj < 2; ++bj) { f32x4 o0, o1;
#pragma unroll
                        for (int j = 0; j < 4; ++j) { const float z0 = a[bj][0][j], z1 = a[bj][1][j]; o0[j] = z0 * fsigmoid(z0); o1[j] = z1 * fsigmoid(z1); }
                        *(u32x4*)(G + (size_t)t * DM + c0 + 32 * bj) = pack8(o0, o1); }
                }
        }
    }
};
struct EpiResid8 { static constexpr bool PERM = true, AFTER_DRAIN = false; const float* base; const bf16_t* bbase; bf16_t* obf; float* ssq;
    DEVINL void operator()(const f32x4 (&acc)[2][2][4][2], const pg8::Unit& u, int wr, int wc, int fr, int fq) const {
        { const int t_ = ltid(); fr = t_ & 15; fq = (t_ >> 4) & 3; wc = __builtin_amdgcn_readfirstlane((t_ >> 6) & 3); wr = __builtin_amdgcn_readfirstlane(t_ >> 8); }
        const size_t cb = (size_t)u.pn * 256 + 64 * wc + 8 * fq;
        if (bbase) {
            u32x4 bw[8][2];
#pragma unroll
            for (int i = 0; i < 8; ++i)
#pragma unroll
                for (int bj = 0; bj < 2; ++bj) bw[i][bj] = *(const u32x4*)(bbase + (size_t)EPI_ROW(i) * DM + cb + 32 * bj);
#pragma unroll
            for (int i = 0; i < 8; ++i) { const int t = EPI_ROW(i); const size_t o = (size_t)t * DM + cb; float ss = 0.f;
#pragma unroll
                for (int bj = 0; bj < 2; ++bj) { const u32x4 w = bw[i][bj];
                    const f32x4 v0 = (f32x4){bflo(w.x), bfhi(w.x), bflo(w.y), bfhi(w.y)} + acc[i >> 2][bj][i & 3][0], v1 = (f32x4){bflo(w.z), bfhi(w.z), bflo(w.w), bfhi(w.w)} + acc[i >> 2][bj][i & 3][1];
                    *(u32x4*)(obf + o + 32 * bj) = pack8(v0, v1); ss += sq4(v0) + sq4(v1); }
                ss = quad_sum(ss); if (fq == 0) ssq[(size_t)t * 16 + u.pn * 4 + wc] = ss; }
        } else {
#pragma unroll
            for (int ai = 0; ai < 2; ++ai) {
                f32x4 bv[4][2][2];
#pragma unroll
                for (int m = 0; m < 4; ++m)
#pragma unroll
                    for (int bj = 0; bj < 2; ++bj) { const float* bp = base + (size_t)EPI_ROW(ai * 4 + m) * DM + cb + 32 * bj; bv[m][bj][0] = __builtin_nontemporal_load((const f32x4*)bp); bv[m][bj][1] = __builtin_nontemporal_load((const f32x4*)(bp + 4)); }
#pragma unroll
                for (int m = 0; m < 4; ++m) { const int t = EPI_ROW(ai * 4 + m); const size_t o = (size_t)t * DM + cb; float ss = 0.f;
#pragma unroll
                    for (int bj = 0; bj < 2; ++bj) { const f32x4 v0 = bv[m][bj][0] + acc[ai][bj][m][0], v1 = bv[m][bj][1] + acc[ai][bj][m][1];
                        *(u32x4*)(obf + o + 32 * bj) = pack8(v0, v1); ss += sq4(v0) + sq4(v1); }
                    ss = quad_sum(ss); if (fq == 0) ssq[(size_t)t * 16 + u.pn * 4 + wc] = ss; } }
        } } };
struct EpiStoreBf { static constexpr bool PERM = true, AFTER_DRAIN = false; bf16_t* out;
    DEVINL void operator()(const f32x4 (&acc)[2][2][4][2], const pg8::Unit& u, int wr, int wc, int fr, int fq) const {
        { const int t_ = ltid(); fr = t_ & 15; fq = (t_ >> 4) & 3; wc = __builtin_amdgcn_readfirstlane((t_ >> 6) & 3); wr = __builtin_amdgcn_readfirstlane(t_ >> 8); }
#pragma unroll
        for (int ai = 0; ai < 2; ++ai)
#pragma unroll
            for (int m = 0; m < 4; ++m) { const size_t o = (size_t)(u.pm * 256 + 128 * ai + 64 * wr + 16 * m + fr) * DM + u.pn * 256 + 64 * wc + 8 * fq;
#pragma unroll
                for (int bj = 0; bj < 2; ++bj) *(u32x4*)(out + o + 32 * bj) = pack8(acc[ai][bj][m][0], acc[ai][bj][m][1]); } } };
struct EpiPle8 { static constexpr bool PERM = true, AFTER_DRAIN = false; const bf16_t* xa; const bf16_t* pp; float* out; const float* ssq_in; bf16_t* obf; float* ssq_out;
    DEVINL void operator()(const f32x4 (&acc)[2][2][4][2], const pg8::Unit& u, int wr, int wc, int fr, int fq) const {
        { const int t_ = ltid(); fr = t_ & 15; fq = (t_ >> 4) & 3; wc = __builtin_amdgcn_readfirstlane((t_ >> 6) & 3); wr = __builtin_amdgcn_readfirstlane(t_ >> 8); }
        const size_t cb = (size_t)u.pn * 256 + 64 * wc + 8 * fq;
        float rt8[8];
        { f32x4 sq[8];
#pragma unroll
          for (int i = 0; i < 8; ++i) sq[i] = *(const f32x4*)(ssq_in + (size_t)EPI_ROW(i) * 16 + 4 * fq);
#pragma unroll
          for (int i = 0; i < 8; ++i) rt8[i] = rsqrtf(quad_sum(sq[i][0] + sq[i][1] + sq[i][2] + sq[i][3]) * (1.0f / DM) + EPS); }
#pragma unroll
        for (int qi = 0; qi < 4; ++qi) {
            const int ai = qi >> 1; u32x4 xw[4][2], pw[4][2];
#pragma unroll
            for (int m = 2 * (qi & 1); m < 2 * (qi & 1) + 2; ++m)
#pragma unroll
                for (int bj = 0; bj < 2; ++bj) { const size_t o = (size_t)EPI_ROW(ai * 4 + m) * DM + cb + 32 * bj; xw[m][bj] = *(const u32x4*)(xa + o); pw[m][bj] = *(const u32x4*)(pp + o); }
#pragma unroll
            for (int m = 2 * (qi & 1); m < 2 * (qi & 1) + 2; ++m) { const int t = EPI_ROW(ai * 4 + m); const size_t o = (size_t)t * DM + cb;
                const float rt = rt8[ai * 4 + m]; float ss = 0.f;
#pragma unroll
                for (int bj = 0; bj < 2; ++bj) { const u32x4 xv = xw[m][bj], pq = pw[m][bj]; const f32x4 x0 = (f32x4){bflo(xv.x), bfhi(xv.x), bflo(xv.y), bfhi(xv.y)}, x1 = (f32x4){bflo(xv.z), bfhi(xv.z), bflo(xv.w), bfhi(xv.w)}; f32x4 r0, r1;
                    const float pv[8] = {bflo(pq.x), bfhi(pq.x), bflo(pq.y), bfhi(pq.y), bflo(pq.z), bfhi(pq.z), bflo(pq.w), bfhi(pq.w)};
#pragma unroll
                    for (int jj = 0; jj < 4; ++jj) { r0[jj] = x0[jj] + pv[jj] * fsigmoid(rt * acc[ai][bj][m][0][jj]); r1[jj] = x1[jj] + pv[4 + jj] * fsigmoid(rt * acc[ai][bj][m][1][jj]); }
                    if (out) { __builtin_nontemporal_store(r0, (f32x4*)(out + o + 32 * bj)); __builtin_nontemporal_store(r1, (f32x4*)(out + o + 32 * bj + 4)); }
                    if (obf) { *(u32x4*)(obf + o + 32 * bj) = pack8(r0, r1); ss += sq4(r0) + sq4(r1); } }
                if (obf) { ss = quad_sum(ss); if (fq == 0) ssq_out[(size_t)t * 16 + u.pn * 4 + wc] = ss; } } } } };
struct EpiUq8 { static constexpr bool PERM = true, AFTER_DRAIN = false; Params P; int l;
    DEVINL void operator()(const f32x4 (&acc)[2][2][4][2], const pg8::Unit& u, int wr, int wc, int fr, int fq) const {
        { const int t_ = ltid(); fr = t_ & 15; fq = (t_ >> 4) & 3; wc = __builtin_amdgcn_readfirstlane((t_ >> 6) & 3); wr = __builtin_amdgcn_readfirstlane(t_ >> 8); }
        const int chunk = u.pn * 4 + wc; if (chunk >= 6) return;
        const float* cqss = (const float*)(P.ws + OFF_CQSS); bf16_t* qm = (bf16_t*)((char*)P.out + OOFF_QM); const float2* rope = (const float2*)(P.ws + OFF_ROPE);
        float rt8[8];
        { float sq[8];
#pragma unroll
          for (int i = 0; i < 8; ++i) sq[i] = cqss[(size_t)EPI_ROW(i) * 4 + fq];
#pragma unroll
          for (int i = 0; i < 8; ++i) rt8[i] = rsqrtf(quad_sum(sq[i]) * (1.0f / 256.0f) + EPS); }
        if (chunk < 4) {
            const float* gain = P.mla_nope_gain + ((size_t)l * 2 + 0) * 64 + 8 * fq;
            f32x4 gg[2][2];
#pragma unroll
            for (int bj = 0; bj < 2; ++bj) { gg[bj][0] = *(const f32x4*)(gain + 32 * bj); gg[bj][1] = *(const f32x4*)(gain + 32 * bj + 4); }
#pragma unroll
            for (int i = 0; i < 8; ++i) { const int ai = i >> 2, m = i & 3, t = EPI_ROW(i), b = t >> 12, s = t & 4095; const float rt = rt8[i];
                const f32x4 a[2][2] = {{acc[ai][0][m][0] * rt, acc[ai][0][m][1] * rt}, {acc[ai][1][m][0] * rt, acc[ai][1][m][1] * rt}};
                float ss = sq4(a[0][0]) + sq4(a[0][1]) + sq4(a[1][0]) + sq4(a[1][1]); ss = quad_sum(ss); const float r = rsqrtf(ss * (1.0f / 64.0f) + EPS) * SC_MLA;
                bf16_t* d = qm + ((size_t)(b * 4 + chunk) * SEQ + s) * 96 + 8 * fq;
#pragma unroll
                for (int bj = 0; bj < 2; ++bj) *(u32x4*)(d + 32 * bj) = pack8(a[bj][0] * r * gg[bj][0], a[bj][1] * r * gg[bj][1]); }
        } else {
            const float* gr = P.mla_rope_gain + ((size_t)l * 2 + 0) * 32; const f32x4 g1 = *(const f32x4*)(gr + 4 * fq), g2 = *(const f32x4*)(gr + 16 + 4 * fq);
#pragma unroll
            for (int hf = 0; hf < 2; ++hf) {
            f32x4 cs4[4][2];
#pragma unroll
            for (int m = 0; m < 4; ++m) { const f32x4* rp = (const f32x4*)(rope + (EPI_ROW(hf * 4 + m) & 4095) * 16 + 4 * fq); cs4[m][0] = rp[0]; cs4[m][1] = rp[1]; }
#pragma unroll
            for (int i = hf * 4; i < hf * 4 + 4; ++i) { const int ai = i >> 2, m = i & 3, t = EPI_ROW(i), b = t >> 12, s = t & 4095; const float rt = rt8[i];
                const f32x4 a[2][2] = {{acc[ai][0][m][0] * rt, acc[ai][0][m][1] * rt}, {acc[ai][1][m][0] * rt, acc[ai][1][m][1] * rt}};
#pragma unroll
                for (int bj = 0; bj < 2; ++bj) { const int h = (chunk - 4) * 2 + bj;
                    float ss = sq4(a[bj][0]) + sq4(a[bj][1]); ss = quad_sum(ss); const float r = rsqrtf(ss * (1.0f / 32.0f) + EPS);
                    float o1[4], o2[4];
#pragma unroll
                    for (int j = 0; j < 4; ++j) { const float cx = cs4[m][j >> 1][2 * (j & 1)], sy = cs4[m][j >> 1][2 * (j & 1) + 1]; const float x1 = a[bj][0][j] * r * g1[j], x2 = a[bj][1][j] * r * g2[j]; o1[j] = (x1 * cx - x2 * sy) * SC_MLA; o2[j] = (x1 * sy + x2 * cx) * SC_MLA; }
                    bf16_t* d = qm + ((size_t)(b * 4 + h) * SEQ + s) * 96 + 64 + 4 * fq; store4bf(d, o1[0], o1[1], o1[2], o1[3]); store4bf(d + 16, o2[0], o2[1], o2[2], o2[3]); } } }
        }
    }
};
struct EpiUkv8 { static constexpr bool PERM = true, AFTER_DRAIN = false; Params P; int l;
    DEVINL void operator()(const f32x4 (&acc)[2][2][4][2], const pg8::Unit& u, int wr, int wc, int fr, int fq) const {
        { const int t_ = ltid(); fr = t_ & 15; fq = (t_ >> 4) & 3; wc = __builtin_amdgcn_readfirstlane((t_ >> 6) & 3); wr = __builtin_amdgcn_readfirstlane(t_ >> 8); }
        const int chunk = u.pn * 4 + wc, h = chunk >> 1; const bool isk = (chunk & 1) == 0;
        const float* ckvss = (const float*)(P.ws + OFF_CKVSS); bf16_t* km = (bf16_t*)((char*)P.out + OOFF_KM); bf16_t* vm = (bf16_t*)((char*)P.out + OOFF_VM);
        const float* gain = P.mla_nope_gain + ((size_t)l * 2 + 1) * 64 + 8 * fq;
        float rt8[8];
        { float sq[8];
#pragma unroll
          for (int i = 0; i < 8; ++i) sq[i] = fq < 2 ? ckvss[(size_t)EPI_ROW(i) * 2 + fq] : 0.f;
#pragma unroll
          for (int i = 0; i < 8; ++i) rt8[i] = rsqrtf(quad_sum(sq[i]) * (1.0f / 128.0f) + EPS); }
        f32x4 gg[2][2];
#pragma unroll
        for (int bj = 0; bj < 2; ++bj) { gg[bj][0] = *(const f32x4*)(gain + 32 * bj); gg[bj][1] = *(const f32x4*)(gain + 32 * bj + 4); }
#pragma unroll
        for (int i = 0; i < 8; ++i) { const int ai = i >> 2, m = i & 3, t = EPI_ROW(i), b = t >> 12, s = t & 4095; const float rt = rt8[i];
            const f32x4 a[2][2] = {{acc[ai][0][m][0] * rt, acc[ai][0][m][1] * rt}, {acc[ai][1][m][0] * rt, acc[ai][1][m][1] * rt}};
            if (isk) { float ss = sq4(a[0][0]) + sq4(a[0][1]) + sq4(a[1][0]) + sq4(a[1][1]); ss = quad_sum(ss); const float r = rsqrtf(ss * (1.0f / 64.0f) + EPS);
                bf16_t* d = km + ((size_t)(b * 4 + h) * SEQ + s) * 96 + 8 * fq;
#pragma unroll
                for (int bj = 0; bj < 2; ++bj) *(u32x4*)(d + 32 * bj) = pack8(a[bj][0] * r * gg[bj][0], a[bj][1] * r * gg[bj][1]);
            } else { bf16_t* d = vm + ((size_t)(b * 4 + h) * SEQ + s) * 64 + 8 * fq;
#pragma unroll
                for (int bj = 0; bj < 2; ++bj) *(u32x4*)(d + 32 * bj) = pack8(a[bj][0], a[bj][1]); }
        }
    }
};
template <class Epi> DEVINL void gemm8(const bf16_t* A, const bf16_t* Bt, int M, int N, int K, const Epi& E, char* smem) {
    int G = (int)gridDim.x, c = (int)blockIdx.x; asm volatile("" : "+s"(G), "+s"(c));
    pg8::Gemm g{A, Bt, M, N, K}; pg8::StaticOrder S; S.init(M, N, G, c);
    pg8::gemm_phase<Epi, pg8::StaticOrder, true, true>((PG8_LAS unsigned char*)smem, g, S, E);
}

DEVINL void kmean_unit(const Params& P, int u, char* smem) {
    float* red = (float*)smem; const bf16_t* K = (const bf16_t*)(P.ws + OFF_QKV + 4 * SZ_HEADBUF); float* km = (float*)(P.ws + OFF_KMEAN);
    const int tid = ltid(), dc = tid & 7, rg = tid >> 3;
    const bf16_t* kp = K + ((size_t)(u >> 4) * SEQ + (u & 15) * 256 + rg) * 64 + dc * 8;
    u32x4 w[4];
#pragma unroll
    for (int i = 0; i < 4; ++i) w[i] = *(const u32x4*)(kp + (size_t)i * 64 * 64);
    float s[8] = {0.f, 0.f, 0.f, 0.f, 0.f, 0.f, 0.f, 0.f};
#pragma unroll
    for (int i = 0; i < 4; ++i) { s[0] += bflo(w[i].x); s[1] += bfhi(w[i].x); s[2] += bflo(w[i].y); s[3] += bfhi(w[i].y); s[4] += bflo(w[i].z); s[5] += bfhi(w[i].z); s[6] += bflo(w[i].w); s[7] += bfhi(w[i].w); }
    __syncthreads();
#pragma unroll
    for (int e = 0; e < 8; ++e) red[rg * 65 + dc * 8 + e] = s[e];
    __syncthreads();
    if (tid < 64) { float a = 0.f;
#pragma unroll 8
        for (int i = 0; i < 64; ++i) a += red[i * 65 + tid];
        km[(size_t)u * 64 + tid] = a * (1.0f / 256.0f); }
}

typedef float f32x16 __attribute__((ext_vector_type(16)));
typedef short s16x4 __attribute__((ext_vector_type(4)));
typedef short v4i16_t __attribute__((ext_vector_type(4)));
#define LAS __attribute__((address_space(3)))
#define MFMA32(a, b, c) __builtin_amdgcn_mfma_f32_32x32x16_bf16(a, b, c, 0, 0, 0)
DEVINL s16x4 vtr(const LAS char* p) { return __builtin_bit_cast(s16x4, __builtin_amdgcn_ds_read_tr16_b64_v4i16((LAS v4i16_t*)p)); }
DEVINL float swap_max(float v) { auto rr = __builtin_amdgcn_permlane32_swap(__float_as_uint(v), __float_as_uint(v), false, false); return fmaxf(__uint_as_float(rr[0]), __uint_as_float(rr[1])); }
DEVINL float swap_sum(float v) { auto rr = __builtin_amdgcn_permlane32_swap(__float_as_uint(v), __float_as_uint(v), false, false); return __uint_as_float(rr[0]) + __uint_as_float(rr[1]); }
DEVINL float fadd1(float a, float b) { float r; asm("v_add_f32 %0, %1, %2" : "=v"(r) : "v"(a), "v"(b)); return r; }
DEVINL constexpr int crow(int r) { return (r & 3) + 8 * (r >> 2); }

constexpr int KSLOT = 64 * 144, RSLOT = 64 * 80;
constexpr int L_KB = 0, L_VB = 3 * KSLOT, L_KR = L_VB + 16384, L_AUX = L_KR + 3 * RSLOT, L_SCR = L_AUX + 16640 + 256, L_KMS = L_SCR + 2048, L_ATT_END = L_KMS + 4096;
constexpr float NEGBIG = -3.0e38f, THR = 8.0f;

template <int MODE>
DEVINL void attn_unit(const Params& P, int l, int u, char* smem) {
    constexpr int DK = MODE == 2 ? 96 : 64, ND0 = DK / 16;
    LAS char* lds = (LAS char*)smem;
    const int tid = ltid(), lane = tid & 63, r32 = lane & 31, hi = lane >> 5; const int wid = __builtin_amdgcn_readfirstlane(tid >> 6);
    const bool fast = ((const float*)(P.ws + OFF_BOUND))[l * 4 + MODE] < 100.0f;
    int bh, q0, t_lo, t_hi, dil = 1, res = 0, pat = 0, qb = 0;
    if (MODE != 3) { bh = u & 15; qb = 15 - (u >> 4); q0 = qb * 256; t_lo = 0; t_hi = (q0 + 255) >> 6; }
    else { pat = u >> 8; const int v = u & 255; bh = v & 15; const int w = v >> 4; dil = pat == 0 ? 1 : (pat == 1 ? 4 : 16); res = w % dil; q0 = (w / dil) * 256; t_lo = (q0 >= 128 ? q0 - 128 : 0) >> 6; t_hi = (q0 + 255) >> 6; }
    const int b = bh >> 2, h = bh & 3;
    const bf16_t *Qg, *Kg, *Vg; int rsq, rsk, rsv;
    if (MODE == 0) { Qg = (const bf16_t*)(P.ws + OFF_QKV) + (size_t)bh * SEQ * 64; Kg = Qg + SZ_HEADBUF / 2; Vg = Kg + SZ_HEADBUF / 2; rsq = rsk = rsv = 64; }
    else if (MODE == 1) { Qg = (const bf16_t*)(P.ws + OFF_QKV + 3 * SZ_HEADBUF) + (size_t)bh * SEQ * 64; Kg = Qg + SZ_HEADBUF / 2; Vg = Kg + SZ_HEADBUF / 2; rsq = rsk = rsv = 64; }
    else if (MODE == 2) { Qg = (const bf16_t*)((const char*)P.out + OOFF_QM) + (size_t)bh * SEQ * 96; Kg = (const bf16_t*)((const char*)P.out + OOFF_KM) + (size_t)bh * SEQ * 96; Vg = (const bf16_t*)((const char*)P.out + OOFF_VM) + (size_t)bh * SEQ * 64; rsq = rsk = 96; rsv = 64; }
    else { Qg = (const bf16_t*)(P.ws + OFF_QKV + 6 * SZ_HEADBUF) + ((size_t)bh * SEQ + res) * 64; Kg = Qg + SZ_HEADBUF / 2; Vg = Kg + SZ_HEADBUF / 2; rsq = rsk = rsv = 64 * dil; }
    const int qw = q0 + 32 * wid;

    __syncthreads();
    const unsigned kgo = (unsigned)((tid >> 3) * rsk + (tid & 7) * 8), vgo = (unsigned)(((tid >> 2) & 63) * rsv + (tid >> 8) * 32 + (tid & 3) * 8), rgo = (unsigned)(((tid >> 2) & 63) * rsk + 64 + (tid & 3) * 8);
    const int kws = (tid >> 3) * 144 + (tid & 7) * 16;
    const int rws = ((tid >> 2) & 63) * 80 + (tid & 3) * 16;
    u32x4 kA, rA, kB, rB;
#define ATT_LOADK(j, K_, R_) do { if ((j) <= t_hi) { K_ = *(const u32x4*)(Kg + (size_t)(j) * 64 * rsk + kgo); if (MODE == 2 && tid < 256) R_ = *(const u32x4*)(Kg + (size_t)(j) * 64 * rsk + rgo); } } while (0)
#define ATT_DMAV(j, slot) do { if ((j) <= t_hi) __builtin_amdgcn_global_load_lds((const unsigned*)(Vg + (size_t)(j) * 64 * rsv + vgo), (LAS unsigned*)(lds + L_VB + (slot) * 8192 + wid * 1024), 16, 0, 0); } while (0)
#define ATT_WRITEK(slot, j, K_, R_) do { if ((j) <= t_hi) { *(LAS u32x4*)(lds + L_KB + (slot) * KSLOT + kws) = K_; if (MODE == 2 && tid < 256) *(LAS u32x4*)(lds + L_KR + (slot) * RSLOT + rws) = R_; \
        if (MODE == 0 && tid < 64) { const float bs = aux[(j) * 64 + tid] - auxU; const unsigned hb = cvt2(bs, 0.f) & 0xffffu; const float lo = bs - __uint_as_float(hb << 16); u32x4 w; w.x = hb | (cvt2(lo, 0.f) << 16); w.y = 0x3F80u; w.z = 0u; w.w = 0u; \
            *(LAS u32x4*)(lds + L_KR + (slot) * 1024 + tid * 16) = w; } } } while (0)
    bf16x8 qf[ND0];
    { const bf16_t* qp = Qg + (size_t)(qw + r32) * rsq + 8 * hi;
#pragma unroll
      for (int d0 = 0; d0 < ND0; ++d0) qf[d0] = *(const bf16x8*)(qp + 16 * d0); }
    if (MODE != 0) { ATT_LOADK(t_lo, kA, rA); ATT_LOADK(t_lo + 1, kB, rB); }
    LAS float* aux = (LAS float*)(lds + L_AUX);
    if (MODE == 0) {
        LAS float* tot = (LAS float*)(lds + L_SCR);
        const float* lf = (const float*)(P.ws + OFF_LOGF) + (size_t)bh * SEQ + tid * 8; float v[8]; float run = 0.f;
        { const f32x4 a = *(const f32x4*)lf, c = *(const f32x4*)(lf + 4); v[0] = a[0]; v[1] = a[1]; v[2] = a[2]; v[3] = a[3]; v[4] = c[0]; v[5] = c[1]; v[6] = c[2]; v[7] = c[3]; }
#pragma unroll
        for (int i = 0; i < 8; ++i) { run += v[i]; v[i] = run; }
        tot[tid] = run; __syncthreads();
        if (tid < 64) { float a[8]; float acc = 0.f;
#pragma unroll
            for (int i = 0; i < 8; ++i) { acc += tot[tid * 8 + i]; a[i] = acc; }
            float incl = acc;
#pragma unroll
            for (int o = 1; o < 64; o <<= 1) { const float nb = shup(incl, o); if (tid >= o) incl += nb; }
            const float ex = incl - acc; tot[tid * 8] = ex;
#pragma unroll
            for (int i = 1; i < 8; ++i) tot[tid * 8 + i] = ex + a[i - 1]; }
        __syncthreads();
        const float base = tot[tid];
#pragma unroll
        for (int i = 0; i < 8; ++i) aux[tid * 8 + i] = -(base + v[i]);
        if (tid < 4) ((LAS unsigned*)(lds + L_KR + 3072))[tid] = 0u;
    } else if (MODE == 1) {
        const float* lut = (const float*)(P.ws + OFF_LUT) + (size_t)h * 4096;
        for (int i = ((4095 - (q0 + 255)) & ~3) + 4 * tid; i < 4160; i += 4 * NTHREADS) {
            f32x4 v = (f32x4){0.f, 0.f, 0.f, 0.f}; if (i < 4096) { const f32x4 s = *(const f32x4*)(lut + 4092 - i); v = (f32x4){s[3], s[2], s[1], s[0]}; }
            *(LAS f32x4*)(aux + i) = v; }
        if (tid < 64) aux[4160 + tid] = -INFINITY;
        LAS float* kms = (LAS float*)(lds + L_KMS); const float* km = (const float*)(P.ws + OFF_KMEAN) + (size_t)bh * 1024;
        for (int i = tid; i < 1024; i += NTHREADS) kms[i] = km[i];
    } else if (MODE == 3) {
        const float* lut = (const float*)(P.ws + OFF_LUT) + (size_t)(4 + h) * 4096;
        if (tid < 320) { const int rel = 255 - tid; aux[tid] = (rel >= 0 && rel * dil < 4096) ? lut[rel * dil] : 0.f; }
    }
    if (MODE == 0 && fast) {
        __syncthreads();
        const float bnd = ((const float*)(P.ws + OFF_BOUND))[l * 4 + (tid >> 30)];
        const bool sk = (lane <= t_hi) && ((aux[64 * lane + 63] - aux[q0]) + bnd < -150.0f);
        t_lo = (int)__builtin_popcountll(__ballot(sk));
    }
    __syncthreads();
    bf16x8 qx = {0, 0, 0, 0, 0, 0, 0, 0}; float auxU = 0.f;
    if (MODE == 0) { auxU = aux[q0 + 255]; const float sh = auxU - aux[qw + r32];
        if (hi == 0) { u32x4 w; w.x = 0x3F803F80u; w.y = cvt2(sh, 0.f); w.z = 0u; w.w = 0u; qx = __builtin_bit_cast(bf16x8, w); } }
    unsigned sel = 0;
    if (MODE == 1) {
        const LAS float* kms = (const LAS float*)(lds + L_KMS); float gt[15];
#pragma unroll
        for (int n = 0; n < 15; ++n) { float s = 0.f;
            if (n < qb) {
#pragma unroll
                for (int d0 = 0; d0 < 4; ++d0) { const f32x4 ka = *(const LAS f32x4*)(kms + n * 64 + 16 * d0 + 8 * hi), kb = *(const LAS f32x4*)(kms + n * 64 + 16 * d0 + 8 * hi + 4);
                    const u32x4 w = __builtin_bit_cast(u32x4, qf[d0]);
                    s += bflo(w.x) * ka[0] + bfhi(w.x) * ka[1] + bflo(w.y) * ka[2] + bfhi(w.y) * ka[3] + bflo(w.z) * kb[0] + bfhi(w.z) * kb[1] + bflo(w.w) * kb[2] + bfhi(w.w) * kb[3]; }
                s = swap_sum(s); }
            gt[n] = s; }
#pragma unroll
        for (int k = 0; k < 3; ++k) { float best = NEGBIG; int bi = -1;
#pragma unroll
            for (int n = 0; n < 15; ++n) if (n < qb && !((sel >> n) & 1u) && gt[n] > best) { best = gt[n]; bi = n; }
            if (bi >= 0) sel |= 1u << bi; }
        sel |= 1u << qb;
    }
    const int kfo = L_KB + r32 * 144 + hi * 16, rfo = L_KR + r32 * 80 + hi * 16;
    const int vfo = L_VB + ((lane >> 4) & 1) * 32 + (lane & 3) * 8 + (4 * hi + ((lane & 15) >> 2)) * 64;

    f32x16 o0, o1;
#pragma unroll
    for (int r = 0; r < 16; ++r) { o0[r] = 0.f; o1[r] = 0.f; }
    float m = fast ? 0.f : NEGBIG, lsum = 0.f;

    auto anysel = [&](int j) -> bool { return MODE != 1 || __any((sel >> (j >> 2)) & 1u); };
    auto is_full = [&](int j) -> bool {
        bool f = fast && (64 * j + 63 <= qw) && anysel(j);
        if (MODE == 3) f = f && (64 * j >= qw + 31 - 128);
        return f; };
    auto stage_a = [&](int j, int ks, int kb, f32x16& p) {
        if (MODE == 1 || MODE == 3) { const LAS float* lp = aux + ((MODE == 1 ? 4095 : 255) - (qw + r32 - 64 * j - 4 * hi));
            if (MODE == 1) lp = ((sel >> (j >> 2)) & 1u) ? lp : aux + 4160;
#pragma unroll
            for (int r = 0; r < 16; ++r) p[r] = lp[crow(r) + 32 * kb];
        } else {
#pragma unroll
            for (int r = 0; r < 16; ++r) p[r] = 0.f;
        }
        const LAS char* kb_ = lds + ks * KSLOT + kb * (32 * 144) + kfo;
#pragma unroll
        for (int d0 = 0; d0 < 4; ++d0) p = MFMA32(*(const LAS bf16x8*)(kb_ + d0 * 32), qf[d0], p);
        if (MODE == 2) { const LAS char* rb_ = lds + ks * RSLOT + kb * (32 * 80) + rfo;
#pragma unroll
            for (int d0 = 0; d0 < 2; ++d0) p = MFMA32(*(const LAS bf16x8*)(rb_ + d0 * 32), qf[4 + d0], p); }
        if (MODE == 0) p = MFMA32(*(const LAS bf16x8*)(lds + (hi ? (L_KR + 3072) : (L_KR + ks * 1024 + kb * 512 + r32 * 16))), qx, p);
    };
    auto stage_b = [&](int j, f32x16& p, u32x4& wa, u32x4& wb) {
#pragma unroll
        for (int r = 0; r < 16; ++r) { p[r] = __builtin_amdgcn_exp2f(p[r]); lsum += p[r]; }
        wa.x = cvt2(p[0], p[1]); wa.y = cvt2(p[2], p[3]); wa.z = cvt2(p[4], p[5]); wa.w = cvt2(p[6], p[7]);
        wb.x = cvt2(p[8], p[9]); wb.y = cvt2(p[10], p[11]); wb.z = cvt2(p[12], p[13]); wb.w = cvt2(p[14], p[15]);
        asm volatile("" : "+v"(lsum));
    };
    auto stage_c = [&](int vs, int kb, const u32x4& wa, const u32x4& wb) {
        const LAS char* vb_ = lds + vs * 8192 + vfo + kb * 2048;
        { const s16x4 a0 = vtr(vb_), a1 = vtr(vb_ + 512), c0 = vtr(vb_ + 4096), c1 = vtr(vb_ + 4096 + 512);
          o0 = MFMA32(__builtin_shufflevector(a0, a1, 0, 1, 2, 3, 4, 5, 6, 7), __builtin_bit_cast(bf16x8, wa), o0); o1 = MFMA32(__builtin_shufflevector(c0, c1, 0, 1, 2, 3, 4, 5, 6, 7), __builtin_bit_cast(bf16x8, wa), o1); }
        { const s16x4 a0 = vtr(vb_ + 1024), a1 = vtr(vb_ + 1024 + 512), c0 = vtr(vb_ + 4096 + 1024), c1 = vtr(vb_ + 4096 + 1024 + 512);
          o0 = MFMA32(__builtin_shufflevector(a0, a1, 0, 1, 2, 3, 4, 5, 6, 7), __builtin_bit_cast(bf16x8, wb), o0); o1 = MFMA32(__builtin_shufflevector(c0, c1, 0, 1, 2, 3, 4, 5, 6, 7), __builtin_bit_cast(bf16x8, wb), o1); }
    };
    auto general = [&](int t, int ks, int vs) {
        const int k0 = t * 64; const bool selected = MODE != 1 || ((sel >> (t >> 2)) & 1u); const bool asel = anysel(t);
        int dl = qw + r32 - k0 - 4 * hi; asm volatile("" : "+v"(dl));
#pragma unroll
        for (int kb = 0; kb < 2; ++kb) {
            const int kh = k0 + 32 * kb;
            bool act = kh <= qw + 31 && asel, need_mask = kh + 31 > qw;
            if (MODE == 3) { act = act && (kh + 31 >= qw - 128); need_mask = need_mask || (kh < qw + 31 - 128); }
            if (!act) continue;
            f32x16 p;
            if (MODE == 1 || MODE == 3) { const LAS float* lp = aux + ((MODE == 1 ? 4095 : 255) - dl);
#pragma unroll
                for (int r = 0; r < 16; ++r) p[r] = lp[crow(r) + 32 * kb];
            } else {
#pragma unroll
                for (int r = 0; r < 16; ++r) p[r] = 0.f;
            }
            const LAS char* kb_ = lds + ks * KSLOT + kb * (32 * 144) + kfo;
#pragma unroll
            for (int d0 = 0; d0 < 4; ++d0) p = MFMA32(*(const LAS bf16x8*)(kb_ + d0 * 32), qf[d0], p);
            if (MODE == 2) { const LAS char* rb_ = lds + ks * RSLOT + kb * (32 * 80) + rfo;
#pragma unroll
                for (int d0 = 0; d0 < 2; ++d0) p = MFMA32(*(const LAS bf16x8*)(rb_ + d0 * 32), qf[4 + d0], p); }
            if (MODE == 0) p = MFMA32(*(const LAS bf16x8*)(lds + (hi ? (L_KR + 3072) : (L_KR + ks * 1024 + kb * 512 + r32 * 16))), qx, p);
            if (need_mask) {
#pragma unroll
                for (int r = 0; r < 16; ++r) { const int rel = dl - crow(r) - 32 * kb; const bool v = MODE == 3 ? ((unsigned)rel <= 128u) : (rel >= 0); p[r] = v ? p[r] : -INFINITY; }
            }
            float ps = 0.f;
            if (fast) {
#pragma unroll
                for (int r = 0; r < 16; ++r) { p[r] = __builtin_amdgcn_exp2f(p[r]); ps += p[r]; }
            } else {
                float mx = fmaxf(p[0], p[1]);
#pragma unroll
                for (int r = 2; r < 16; ++r) mx = fmaxf(mx, p[r]);
                mx = swap_max(mx);
                if (MODE == 1) mx = selected ? mx : NEGBIG;
                if (__any(mx > m + THR)) {
                    const float mn = fmaxf(m, mx), alpha = __builtin_amdgcn_exp2f(m - mn); m = mn; lsum *= alpha;
#pragma unroll
                    for (int r = 0; r < 16; ++r) { o0[r] *= alpha; o1[r] *= alpha; }
                }
#pragma unroll
                for (int r = 0; r < 16; ++r) { p[r] = __builtin_amdgcn_exp2f(p[r] - m); ps += p[r]; }
            }
            u32x4 w0, w1;
            w0.x = cvt2(p[0], p[1]); w0.y = cvt2(p[2], p[3]); w0.z = cvt2(p[4], p[5]); w0.w = cvt2(p[6], p[7]);
            w1.x = cvt2(p[8], p[9]); w1.y = cvt2(p[10], p[11]); w1.z = cvt2(p[12], p[13]); w1.w = cvt2(p[14], p[15]);
            if (MODE == 1) { const unsigned mk = selected ? 0xffffffffu : 0u; ps = selected ? ps : 0.f; w0 = w0 & mk; w1 = w1 & mk; }
            lsum += ps;
            const bf16x8 pb0 = __builtin_bit_cast(bf16x8, w0), pb1 = __builtin_bit_cast(bf16x8, w1);
            const LAS char* vb_ = lds + vs * 8192 + vfo + kb * 2048;
            { const s16x4 a0 = vtr(vb_), a1 = vtr(vb_ + 512), c0 = vtr(vb_ + 4096), c1 = vtr(vb_ + 4096 + 512);
              o0 = MFMA32(__builtin_shufflevector(a0, a1, 0, 1, 2, 3, 4, 5, 6, 7), pb0, o0); o1 = MFMA32(__builtin_shufflevector(c0, c1, 0, 1, 2, 3, 4, 5, 6, 7), pb0, o1); }
            { const s16x4 a0 = vtr(vb_ + 1024), a1 = vtr(vb_ + 1024 + 512), c0 = vtr(vb_ + 4096 + 1024), c1 = vtr(vb_ + 4096 + 1024 + 512);
              o0 = MFMA32(__builtin_shufflevector(a0, a1, 0, 1, 2, 3, 4, 5, 6, 7), pb1, o0); o1 = MFMA32(__builtin_shufflevector(c0, c1, 0, 1, 2, 3, 4, 5, 6, 7), pb1, o1); }
        }
    };

    if (MODE == 0) { ATT_LOADK(t_lo, kA, rA); ATT_LOADK(t_lo + 1, kB, rB); }
    ATT_DMAV(t_lo, 0); ATT_DMAV(t_lo + 1, 1);
    ATT_WRITEK(0, t_lo, kA, rA); ATT_WRITEK(1, t_lo + 1, kB, rB);
    __syncthreads();
    ATT_LOADK(t_lo + 2, kA, rA);
    int ks0 = 0, ks1 = 1, ks2 = 2, vs = 0;
    bool pend = is_full(t_lo);
    f32x16 sa0, sa1, sb0, sb1;
    if (pend) { stage_a(t_lo, 0, 0, sa0); stage_a(t_lo, 0, 1, sa1); }
    auto advance = [&](const int t) {
        ATT_WRITEK(ks2, t + 2, kA, rA);
        __syncthreads();
        ATT_DMAV(t + 2, vs); ATT_LOADK(t + 3, kA, rA);
        { const int tmp = ks0; ks0 = ks1; ks1 = ks2; ks2 = tmp; } vs ^= 1;
    };
    auto steady = [&](const int t, f32x16& c0, f32x16& c1, f32x16& n0, f32x16& n1) {
        u32x4 wa, wb, wc, wd;
        stage_a(t + 1, ks1, 0, n0); stage_b(t, c0, wa, wb); __builtin_amdgcn_sched_barrier(0);
        stage_a(t + 1, ks1, 1, n1); stage_c(vs, 0, wa, wb); stage_b(t, c1, wc, wd); __builtin_amdgcn_sched_barrier(0);
        stage_c(vs, 1, wc, wd);
        advance(t);
    };
    int t = t_lo;
    while (t <= t_hi) {
        if (pend) while (t + 2 <= t_hi && is_full(t + 1) && is_full(t + 2)) { steady(t, sa0, sa1, sb0, sb1); steady(t + 1, sb0, sb1, sa0, sa1); t += 2; }
        const bool nxt = (t + 1 <= t_hi) && is_full(t + 1);
        if (pend) { u32x4 wa, wb; stage_b(t, sa0, wa, wb); stage_c(vs, 0, wa, wb); stage_b(t, sa1, wa, wb); stage_c(vs, 1, wa, wb); } else general(t, ks0, vs);
        if (nxt) { stage_a(t + 1, ks1, 0, sa0); stage_a(t + 1, ks1, 1, sa1); }
        pend = nxt;
        advance(t);
        ++t;
    }
#undef ATT_LOADK
#undef ATT_DMAV
#undef ATT_WRITEK
    const int te_ = ltid(), r32e = te_ & 31, hie = (te_ >> 5) & 1, qwe = q0 + 32 * (te_ >> 6);
    const float ltot = swap_sum(lsum), inv = 1.0f / ltot;
    if (MODE != 3) {
        const size_t tok = (size_t)b * SEQ + qwe + r32e; const int colbase = (MODE == 0 ? 0 : (MODE == 1 ? 256 : 768)) + h * 64 + 4 * hie;
        const bf16_t* G = (const bf16_t*)((const char*)P.out + OOFF_G) + tok * DM + colbase; bf16_t* A2 = (bf16_t*)(P.ws + OFF_A2) + tok * DM + colbase;
#pragma unroll
        for (int g = 0; g < 4; ++g) {
            const u32x2 g0 = *(const u32x2*)(G + 8 * g), g1 = *(const u32x2*)(G + 32 + 8 * g); u32x2 w0, w1;
            w0.x = cvt2(o0[4 * g] * inv * bflo(g0.x), o0[4 * g + 1] * inv * bfhi(g0.x)); w0.y = cvt2(o0[4 * g + 2] * inv * bflo(g0.y), o0[4 * g + 3] * inv * bfhi(g0.y));
            w1.x = cvt2(o1[4 * g] * inv * bflo(g1.x), o1[4 * g + 1] * inv * bfhi(g1.x)); w1.y = cvt2(o1[4 * g + 2] * inv * bflo(g1.y), o1[4 * g + 3] * inv * bfhi(g1.y));
            *(u32x2*)(A2 + 8 * g) = w0; *(u32x2*)(A2 + 32 + 8 * g) = w1; }
    } else {
        const size_t tok = (size_t)b * SEQ + (size_t)(qwe + r32e) * dil + res;
        bf16_t* dp = (bf16_t*)(P.ws + OFF_DPART) + ((size_t)pat * NT + tok) * 256 + h * 64 + 4 * hie;
#pragma unroll
        for (int g = 0; g < 4; ++g) { u32x2 w0, w1;
            w0.x = cvt2(o0[4 * g] * inv, o0[4 * g + 1] * inv); w0.y = cvt2(o0[4 * g + 2] * inv, o0[4 * g + 3] * inv);
            w1.x = cvt2(o1[4 * g] * inv, o1[4 * g + 1] * inv); w1.y = cvt2(o1[4 * g + 2] * inv, o1[4 * g + 3] * inv);
            *(u32x2*)(dp + 8 * g) = w0; *(u32x2*)(dp + 32 + 8 * g) = w1; }
        if (hie == 0) ((float*)(P.ws + OFF_DLSE))[((size_t)pat * NT + tok) * 4 + h] = m + __builtin_amdgcn_logf(ltot);
    }
}

DEVINL void dil_unit(const Params& P, int l, int u, char* smem) {
    LAS char* lds = (LAS char*)smem;
    const int tid = ltid(), lane = tid & 63, r32 = lane & 31, hi = lane >> 5; const int wid = __builtin_amdgcn_readfirstlane(tid >> 6);
    const int pat = u >> 8, v = u & 255, bh = v & 15, w = v >> 4, dil = pat == 0 ? 1 : (pat == 1 ? 4 : 16), res = w % dil, q0 = (w / dil) * 256;
    const int t_lo = (q0 >= 128 ? q0 - 128 : 0) >> 6, t_hi = (q0 + 255) >> 6, nt = t_hi - t_lo + 1;
    const int b = bh >> 2, h = bh & 3, rs = 64 * dil;
    const bf16_t* Qg = (const bf16_t*)(P.ws + OFF_QKV + 6 * SZ_HEADBUF) + ((size_t)bh * SEQ + res) * 64; const bf16_t* Kg = Qg + SZ_HEADBUF / 2; const bf16_t* Vg = Kg + SZ_HEADBUF / 2;
    const int qw = q0 + 32 * wid;
    constexpr int D_KB = 0, D_VB = 6 * KSLOT, D_AUX = D_VB + 6 * 8192;
    LAS float* aux = (LAS float*)(lds + D_AUX);
    __syncthreads();
    const unsigned kgo = (unsigned)((tid >> 3) * rs + (tid & 7) * 8), vgo = (unsigned)(((tid >> 2) & 63) * rs + (tid >> 8) * 32 + (tid & 3) * 8);
    u32x4 kr[6], vr[6];
#pragma unroll
    for (int j = 0; j < 6; ++j) if (j < nt) { kr[j] = *(const u32x4*)(Kg + (size_t)(t_lo + j) * 64 * rs + kgo); vr[j] = *(const u32x4*)(Vg + (size_t)(t_lo + j) * 64 * rs + vgo); }
    bf16x8 qf[4];
    { const bf16_t* qp = Qg + (size_t)(qw + r32) * rs + 8 * hi;
#pragma unroll
      for (int d0 = 0; d0 < 4; ++d0) qf[d0] = *(const bf16x8*)(qp + 16 * d0); }
    { const float* lut = (const float*)(P.ws + OFF_LUT) + (size_t)(4 + h) * 4096;
      if (tid < 320) { const int rel = 255 - tid; aux[tid] = (rel >= 0 && rel * dil < 4096) ? lut[rel * dil] : 0.f; } }
    { const int kws = (tid >> 3) * 144 + (tid & 7) * 16;
#pragma unroll
      for (int j = 0; j < 6; ++j) if (j < nt) { *(LAS u32x4*)(lds + D_KB + j * KSLOT + kws) = kr[j]; *(LAS u32x4*)(lds + D_VB + j * 8192 + tid * 16) = vr[j]; } }
    __syncthreads();
    const int kfo = D_KB + r32 * 144 + hi * 16;
    const int vfo = D_VB + ((lane >> 4) & 1) * 32 + (lane & 3) * 8 + (4 * hi + ((lane & 15) >> 2)) * 64;
    f32x16 o0, o1;
#pragma unroll
    for (int r = 0; r < 16; ++r) { o0[r] = 0.f; o1[r] = 0.f; }
    float lsum = 0.f;
    const int hb_hi = qw >> 5, hb_lo = hb_hi >= 4 ? hb_hi - 4 : 0;
    for (int hb = hb_lo; hb <= hb_hi; ++hb) {
        const int kh = hb * 32, jl = (hb >> 1) - t_lo, kb = hb & 1;
        const bool need_mask = (hb == hb_hi) || (kh < qw + 31 - 128);
        const int dl = qw + r32 - kh - 4 * hi;
        f32x16 p;
        { const LAS float* lp = aux + (255 - dl);
#pragma unroll
          for (int r = 0; r < 16; ++r) p[r] = lp[crow(r)]; }
        const LAS char* kb_ = lds + jl * KSLOT + kb * (32 * 144) + kfo;
#pragma unroll
        for (int d0 = 0; d0 < 4; ++d0) p = MFMA32(*(const LAS bf16x8*)(kb_ + d0 * 32), qf[d0], p);
        if (need_mask) {
#pragma unroll
            for (int r = 0; r < 16; ++r) { const int rel = dl - crow(r); p[r] = ((unsigned)rel <= 128u) ? p[r] : -INFINITY; }
        }
        float ps = 0.f;
#pragma unroll
        for (int r = 0; r < 16; ++r) { p[r] = __builtin_amdgcn_exp2f(p[r]); ps += p[r]; }
        lsum += ps;
        u32x4 w0, w1;
        w0.x = cvt2(p[0], p[1]); w0.y = cvt2(p[2], p[3]); w0.z = cvt2(p[4], p[5]); w0.w = cvt2(p[6], p[7]);
        w1.x = cvt2(p[8], p[9]); w1.y = cvt2(p[10], p[11]); w1.z = cvt2(p[12], p[13]); w1.w = cvt2(p[14], p[15]);
        const LAS char* vb_ = lds + jl * 8192 + vfo + kb * 2048;
        { const s16x4 a0 = vtr(vb_), a1 = vtr(vb_ + 512), c0 = vtr(vb_ + 4096), c1 = vtr(vb_ + 4096 + 512);
          o0 = MFMA32(__builtin_shufflevector(a0, a1, 0, 1, 2, 3, 4, 5, 6, 7), __builtin_bit_cast(bf16x8, w0), o0); o1 = MFMA32(__builtin_shufflevector(c0, c1, 0, 1, 2, 3, 4, 5, 6, 7), __builtin_bit_cast(bf16x8, w0), o1); }
        { const s16x4 a0 = vtr(vb_ + 1024), a1 = vtr(vb_ + 1024 + 512), c0 = vtr(vb_ + 4096 + 1024), c1 = vtr(vb_ + 4096 + 1024 + 512);
          o0 = MFMA32(__builtin_shufflevector(a0, a1, 0, 1, 2, 3, 4, 5, 6, 7), __builtin_bit_cast(bf16x8, w1), o0); o1 = MFMA32(__builtin_shufflevector(c0, c1, 0, 1, 2, 3, 4, 5, 6, 7), __builtin_bit_cast(bf16x8, w1), o1); }
    }
    const float ltot = swap_sum(lsum), inv = 1.0f / ltot;
    const size_t tok = (size_t)b * SEQ + (size_t)(qw + r32) * dil + res;
    bf16_t* dp = (bf16_t*)(P.ws + OFF_DPART) + ((size_t)pat * NT + tok) * 256 + h * 64 + 4 * hi;
#pragma unroll
    for (int g = 0; g < 4; ++g) { u32x2 w0, w1;
        w0.x = cvt2(o0[4 * g] * inv, o0[4 * g + 1] * inv); w0.y = cvt2(o0[4 * g + 2] * inv, o0[4 * g + 3] * inv);
        w1.x = cvt2(o1[4 * g] * inv, o1[4 * g + 1] * inv); w1.y = cvt2(o1[4 * g + 2] * inv, o1[4 * g + 3] * inv);
        *(u32x2*)(dp + 8 * g) = w0; *(u32x2*)(dp + 32 + 8 * g) = w1; }
    if (hi == 0) ((float*)(P.ws + OFF_DLSE))[((size_t)pat * NT + tok) * 4 + h] = __builtin_amdgcn_logf(ltot);
}

DEVINL void dilmix_unit(const Params& P, int u) {
    const int e = u * NTHREADS + ltid(), tok = e >> 5, hd = e & 31, h = hd >> 3, d8 = (hd & 7) * 8;
    const float* ls = (const float*)(P.ws + OFF_DLSE); const bf16_t* dp = (const bf16_t*)(P.ws + OFF_DPART);
    const float l0 = ls[(size_t)tok * 4 + h], l1 = ls[((size_t)NT + tok) * 4 + h], l2 = ls[((size_t)2 * NT + tok) * 4 + h];
    const float mx = fmaxf(l0, fmaxf(l1, l2)); float w0 = __builtin_amdgcn_exp2f(l0 - mx), w1 = __builtin_amdgcn_exp2f(l1 - mx), w2 = __builtin_amdgcn_exp2f(l2 - mx);
    const float inv = 1.0f / (w0 + w1 + w2); w0 *= inv; w1 *= inv; w2 *= inv;
    const size_t off = (size_t)tok * 256 + h * 64 + d8;
    const u32x4 a = *(const u32x4*)(dp + off), b = *(const u32x4*)(dp + (size_t)NT * 256 + off), c = *(const u32x4*)(dp + (size_t)2 * NT * 256 + off);
    const u32x4 g = *(const u32x4*)((const bf16_t*)((const char*)P.out + OOFF_G) + (size_t)tok * DM + 512 + h * 64 + d8);
    u32x4 r;
    r.x = cvt2((w0 * bflo(a.x) + w1 * bflo(b.x) + w2 * bflo(c.x)) * bflo(g.x), (w0 * bfhi(a.x) + w1 * bfhi(b.x) + w2 * bfhi(c.x)) * bfhi(g.x));
    r.y = cvt2((w0 * bflo(a.y) + w1 * bflo(b.y) + w2 * bflo(c.y)) * bflo(g.y), (w0 * bfhi(a.y) + w1 * bfhi(b.y) + w2 * bfhi(c.y)) * bfhi(g.y));
    r.z = cvt2((w0 * bflo(a.z) + w1 * bflo(b.z) + w2 * bflo(c.z)) * bflo(g.z), (w0 * bfhi(a.z) + w1 * bfhi(b.z) + w2 * bfhi(c.z)) * bfhi(g.z));
    r.w = cvt2((w0 * bflo(a.w) + w1 * bflo(b.w) + w2 * bflo(c.w)) * bflo(g.w), (w0 * bfhi(a.w) + w1 * bfhi(b.w) + w2 * bfhi(c.w)) * bfhi(g.w));
    *(u32x4*)((bf16_t*)(P.ws + OFF_A2) + (size_t)tok * DM + 512 + h * 64 + d8) = r;
}


#define XB_TMO      128
#define XB_XCNT(j)  (256  + 64 * (j))
#define XB_XSUB(j)  (1280 + 64 * (j))
#define XB_XGEN(j)  (2304 + 64 * (j))
#define XB_TOP      3328
#define XB_TOPGEN   3392
#define XCD_BAR_WORDS 3456
#define XB_SPIN_CAP (1u << 20)
DEVINL unsigned xb_ld(unsigned* p) { return __hip_atomic_load(p, __ATOMIC_RELAXED, __HIP_MEMORY_SCOPE_AGENT); }
DEVINL unsigned xb_add(unsigned* p, unsigned v) { return __hip_atomic_fetch_add(p, v, __ATOMIC_RELAXED, __HIP_MEMORY_SCOPE_AGENT); }
DEVINL unsigned xb_xcc_id() { return (unsigned)__builtin_amdgcn_s_getreg((3 << 11) | 20) & 0xFu; }
#define XB_SPIN(cond, bar) do { unsigned _sp = 0; while (cond) { __builtin_amdgcn_s_sleep(1); \
    if ((++_sp & 255u) == 0u) { if (xb_ld(&(bar)[XB_TMO])) break; if (_sp > XB_SPIN_CAP) { atomicAdd(&(bar)[XB_TMO], 1u); break; } } } } while (0)
DEVINL void xcd_barrier_post(unsigned* bar) { if (ltid() == 0) (void)xb_add(&bar[XB_XCNT(xb_xcc_id())], 1u); }
DEVINL void xcd_barrier_complete(unsigned* bar, unsigned x, unsigned& nloc, unsigned& nx) {
    const unsigned G = gridDim.x * gridDim.y * gridDim.z;
    unsigned sum, cnt, mine, sp = 0u;
    for (;;) {
        sum = 0u; cnt = 0u; mine = 0u;
        for (unsigned j = 0; j < 16; ++j) { const unsigned c = xb_ld(&bar[XB_XCNT(j)]); sum += c; cnt += (c > 0u) ? 1u : 0u; mine = (j == x) ? c : mine; }
        if (sum == G) break;
        __builtin_amdgcn_s_sleep(1);
        if ((++sp & 255u) == 0u) { if (xb_ld(&bar[XB_TMO])) break; if (sp > XB_SPIN_CAP) { atomicAdd(&bar[XB_TMO], 1u); break; } }
    }
    nloc = mine > 0u ? mine : 1u; nx = cnt > 0u ? cnt : 1u;
}
DEVINL void xcd_barrier(unsigned* bar_in, volatile LAS unsigned* st) {
    asm volatile("s_waitcnt vmcnt(0)" ::: "memory");
    __syncthreads();
    if (ltid() == 0) {
        unsigned* bar = bar_in;
        const unsigned x = xb_xcc_id();
        __builtin_amdgcn_s_waitcnt(0);
        unsigned nloc = st[0], nx = st[1];
        if (nloc == 0u) { xcd_barrier_complete(bar, x, nloc, nx); st[0] = nloc; st[1] = nx; }
        const unsigned old = xb_add(&bar[XB_XSUB(x)], 1u);
        const unsigned gen = old / nloc;
        if (old + 1u == (gen + 1u) * nloc) {
            __builtin_amdgcn_fence(__ATOMIC_RELEASE, "agent");
            asm volatile("s_waitcnt vmcnt(0)" ::: "memory");
            const unsigned og = xb_add(&bar[XB_TOP], 1u);
            const unsigned tg = og / nx;
            if (og + 1u == (tg + 1u) * nx) xb_add(&bar[XB_TOPGEN], 1u);
            else XB_SPIN(xb_ld(&bar[XB_TOPGEN]) == tg, bar);
            __builtin_amdgcn_fence(__ATOMIC_ACQUIRE, "agent");
            asm volatile("s_waitcnt vmcnt(0)" ::: "memory");
        } else {
            XB_SPIN(xb_ld(&bar[XB_TOPGEN]) == gen, bar);
            __builtin_amdgcn_fence(__ATOMIC_ACQUIRE, "agent");
            asm volatile("s_waitcnt vmcnt(0)" ::: "memory");
        }
    }
    __syncthreads();
}


DEVINL int next_unit(unsigned* ctr, char* smem) {
    int* su = (int*)(smem + L_MISC);
    __syncthreads();
    if (ltid() == 0) *su = (int)atomicAdd(ctr, 1u);
    __syncthreads();
    return *su;
}

template <class Epi> DEVINL void gemm8_sub(const bf16_t* A, const bf16_t* Bt, int M, int N, int K, const Epi& E, char* smem, int G, int c) {
    asm volatile("" : "+s"(G), "+s"(c));
    pg8::Gemm g{A, Bt, M, N, K}; pg8::StaticOrder S; S.init(M, N, G, c);
    pg8::gemm_phase<Epi, pg8::StaticOrder, true, true>((PG8_LAS unsigned char*)smem, g, S, E);
}
DEVINL void phase_pre(const Params& P, int l, char* smem) {
    const int half = (int)gridDim.x >> 1, bid = (int)blockIdx.x;
    if (bid < half) gemm8_sub((const bf16_t*)(P.ws + OFF_CQ), (const bf16_t*)(P.ws + OFF_WT_UQ + l * SZ_WT_UQ), NT, 512, 256, EpiUq8{P, l}, smem, half, bid);
    else gemm8_sub((const bf16_t*)(P.ws + OFF_CKV), (const bf16_t*)(P.ws + OFF_WT_UKV + l * SZ_WT_UKV), NT, 512, 256, EpiUkv8{P, l}, smem, (int)gridDim.x - half, bid - half);
    for (int u = blockIdx.x; u < 256; u += gridDim.x) kmean_unit(P, u, smem);
}
DEVINL void phase_att(const Params& P, int l, char* smem, int rep) {
    unsigned* ctr = (unsigned*)(P.ws + OFF_CTR) + l * 2 + rep * 8;
    constexpr int N_ATT = 384 + 256 + 96 + 768 + 32; const int n_all = N_ATT + (l == 0 ? PREP_PER_LAYER + PREP_P_UNITS / 2 : 0);
    for (;;) {
#ifdef PROBE_CLS
        const unsigned long long tq0 = __builtin_amdgcn_s_memrealtime(); int cls = 4;
#define PCLS(c) cls = (c);
#else
#define PCLS(c)
#endif
        int u = next_unit(ctr, smem); if (u >= n_all) break;
        if (u >= N_ATT) { __syncthreads(); if (u - N_ATT < PREP_PER_LAYER) prep_w_unit(P, 1, u - N_ATT, (float*)smem); else prep_p_unit(P, PREP_P_UNITS / 2 + (u - N_ATT - PREP_PER_LAYER)); }
        else if (u >= 384 && u < 640) { PCLS(0) attn_unit<0>(P, l, u - 384, smem); }
        else if (u >= 736 && u < 736 + 768) { PCLS(3) if (((const float*)(P.ws + OFF_BOUND))[l * 4 + 3] < 100.0f) dil_unit(P, l, u - 736, smem); else attn_unit<3>(P, l, u - 736, smem); }
        else {
            if (u >= 736 + 768) u -= 768; if (u >= 640) u -= 256;
            const int g = u >> 5, r = u & 31, uu = g * 16 + (r & 15);
            if (r < 16) { PCLS(2) attn_unit<2>(P, l, uu, smem); } else { PCLS(1) attn_unit<1>(P, l, uu, smem); } }
#ifdef PROBE_CLS
        if (blockIdx.x == PROBE_BLK && cls == PROBE_CLS && ltid() == 0) { LAS unsigned* pa = (LAS unsigned*)((LAS char*)smem + L_MISC + 32); pa[0] += (unsigned)(__builtin_amdgcn_s_memrealtime() - tq0); pa[1] += 1u; }
#endif
#undef PCLS
    }
}

template <int PH> DEVINL void run_phase(int l, char* smem, int rep = 0) {
    asm volatile("" : "+s"(l));
    const __attribute__((address_space(4))) Params* kp = (const __attribute__((address_space(4))) Params*)__builtin_amdgcn_kernarg_segment_ptr(); asm volatile("" : "+s"(kp));
    Params P;
    P.x = (const float*)as_global(kp->x); P.p = (const float*)as_global(kp->p); P.ln_g = (const float*)as_global(kp->ln_g); P.w_in = (const float*)as_global(kp->w_in); P.b_forget = (const float*)as_global(kp->b_forget);
    P.qk_gain = (const float*)as_global(kp->qk_gain); P.mla_q_norm = (const float*)as_global(kp->mla_q_norm); P.mla_kv_norm = (const float*)as_global(kp->mla_kv_norm); P.mla_nope_gain = (const float*)as_global(kp->mla_nope_gain);
    P.mla_rope_gain = (const float*)as_global(kp->mla_rope_gain); P.w_uq = (const float*)as_global(kp->w_uq); P.w_ukv = (const float*)as_global(kp->w_ukv); P.w_out = (const float*)as_global(kp->w_out); P.rel_bias = (const float*)as_global(kp->rel_bias);
    P.ple_norm_g = (const float*)as_global(kp->ple_norm_g); P.w_ple_gate = (const float*)as_global(kp->w_ple_gate); P.w_ple_proj = (const float*)as_global(kp->w_ple_proj); P.out = (float*)as_global(kp->out); P.ws = as_global(kp->ws);
    char* ws = P.ws;
    const bf16_t* xbase = (const bf16_t*)(ws + OFF_H);
    float* xout = l == 0 ? (float*)nullptr : P.out;
    if (PH == 0) phase_prep(P, smem);
    if (PH == 2) { gemm8((const bf16_t*)(ws + OFF_H), (const bf16_t*)(ws + OFF_WT_IN + l * SZ_WT_IN), NT, NP1, 1024, EpiIn8{P, l}, smem);
                   const int G_ = (int)gridDim.x, w0_ = G_ > 192 ? 192 : 0;
                   if (l == 0 && (int)blockIdx.x >= w0_) { __syncthreads(); constexpr int W0 = PREP_T_IN + PREP_T_UQ + PREP_T_UKV, NWL = PREP_PER_LAYER - W0;
                       for (int u = (int)blockIdx.x - w0_; u < NWL + PREP_P_UNITS / 2; u += G_ - w0_) { if (u < NWL) prep_w_unit(P, 0, W0 + u, (float*)smem); else prep_p_unit(P, u - NWL); } } }
    if (PH == 3) phase_pre(P, l, smem);
    if (PH == 4) phase_att(P, l, smem, rep);
    if (PH == 5) { for (int u = blockIdx.x; u < 1024; u += gridDim.x) dilmix_unit(P, u);
                 }
    if (PH == 8) gemm8((const bf16_t*)(ws + OFF_A2), (const bf16_t*)(ws + OFF_WT_OUT + l * SZ_WT_SQ), NT, 1024, 1024, EpiResid8{P.x, xbase, (bf16_t*)(ws + OFF_XABF), (float*)(ws + OFF_SSQA)}, smem);
    if (PH == 7) { gemm8((const bf16_t*)(ws + (l == 0 ? OFF_PB : OFF_PB2)), (const bf16_t*)(ws + OFF_WT_PP + l * SZ_WT_PP), NT, 1024, 256, EpiStoreBf{(bf16_t*)(ws + OFF_QKV)}, smem);
                   __syncthreads();
                   gemm8((const bf16_t*)(ws + OFF_XABF), (const bf16_t*)(ws + OFF_WT_PG + l * SZ_WT_SQ), NT, 1024, 1024, EpiPle8{(const bf16_t*)(ws + OFF_XABF), (const bf16_t*)(ws + OFF_QKV), xout, (const float*)(ws + OFF_SSQA), l == 0 ? (bf16_t*)(ws + OFF_H) : (bf16_t*)nullptr, (float*)(ws + OFF_SSQX)}, smem); }
}

__global__ void __launch_bounds__(NTHREADS) k_mega(Params Parg) {
    char* smem = g_smem;
    { const int t0 = (int)threadIdx.x; if (t0 < 12) ((LAS unsigned*)((LAS char*)smem + L_XB))[t0] = 0u;
      if ((t0 & 63) == 0) *(LAS int*)((LAS char*)smem + L_WTAB + 4u * (unsigned)__builtin_amdgcn_s_getreg(0x2804)) = t0 >> 6; }
    __syncthreads();
    const __attribute__((address_space(4))) Params* kp0 = (const __attribute__((address_space(4))) Params*)__builtin_amdgcn_kernarg_segment_ptr();
    xcd_barrier_post((unsigned*)(as_global(kp0->ws) + OFF_BAR));
#define XBAR() xcd_barrier((unsigned*)(as_global(kp0->ws) + OFF_BAR), (volatile LAS unsigned*)((LAS char*)smem + L_XB))
#ifdef PROBE_IDX
    unsigned long long tA = 0, tB = 0;
#define PT0(i) if (PROBE_IDX == (i)) tA = __builtin_amdgcn_s_memrealtime();
#define PT1(i) if (PROBE_IDX == (i)) tB = __builtin_amdgcn_s_memrealtime();
#else
#define PT0(i)
#define PT1(i)
#endif
    PT0(0) run_phase<0>(0, smem); XBAR(); PT1(0)
    PT0(2) run_phase<2>(0, smem); XBAR(); PT1(2) PT0(3) run_phase<3>(0, smem); XBAR(); PT1(3) PT0(4) run_phase<4>(0, smem); XBAR(); PT1(4)
    PT0(5) run_phase<5>(0, smem); XBAR(); PT1(5) PT0(6) run_phase<8>(0, smem); XBAR(); PT1(6) PT0(8) run_phase<7>(0, smem); XBAR(); PT1(8)
    run_phase<2>(1, smem); XBAR(); run_phase<3>(1, smem); XBAR(); run_phase<4>(1, smem); XBAR(); run_phase<5>(1, smem); XBAR(); run_phase<8>(1, smem); XBAR(); run_phase<7>(1, smem);
#ifdef PROBE_IDX
    if (blockIdx.x == 0) { const unsigned long long t0 = __builtin_amdgcn_s_memrealtime(), want = (tB - tA) * 32ull; while (__builtin_amdgcn_s_memrealtime() - t0 < want) __builtin_amdgcn_s_sleep(32); }
#endif
#undef XBAR
#ifdef PROBE_CLS
    if (blockIdx.x == PROBE_BLK) { __syncthreads(); const LAS unsigned* pa = (const LAS unsigned*)((LAS char*)smem + L_MISC + 32); const unsigned long long tk = pa[0], nt = pa[1] ? pa[1] : 1u;
        const unsigned long long t0 = __builtin_amdgcn_s_memrealtime(), want = tk * 128ull / nt; while (__builtin_amdgcn_s_memrealtime() - t0 < want) __builtin_amdgcn_s_sleep(32); }
#endif
}
}

extern "C" void kernel_launch(void* const* d_in, const int* in_sizes, int n_in, void* d_out, int out_size, void* d_ws, size_t ws_size, hipStream_t stream) {
    Params P{};
    P.x = (const float*)d_in[0]; P.p = (const float*)d_in[1]; P.ln_g = (const float*)d_in[2]; P.w_in = (const float*)d_in[3]; P.b_forget = (const float*)d_in[4]; P.qk_gain = (const float*)d_in[5];
    P.mla_q_norm = (const float*)d_in[6]; P.mla_kv_norm = (const float*)d_in[7]; P.mla_nope_gain = (const float*)d_in[8]; P.mla_rope_gain = (const float*)d_in[9]; P.w_uq = (const float*)d_in[10];
    P.w_ukv = (const float*)d_in[11]; P.w_out = (const float*)d_in[12]; P.rel_bias = (const float*)d_in[13]; P.ple_norm_g = (const float*)d_in[14]; P.w_ple_gate = (const float*)d_in[15]; P.w_ple_proj = (const float*)d_in[16];
    P.out = (float*)d_out; P.ws = (char*)d_ws;
    if (ws_size < WS_NEED) { fprintf(stderr, "workspace too small: %zu < %zu\n", ws_size, (size_t)WS_NEED); return; }
    static int grid_blocks = 0;
    if (!grid_blocks) {
        int dev = 0, cus = 0, per_cu = 0;
        hipGetDevice(&dev);
        hipDeviceGetAttribute(&cus, hipDeviceAttributeMultiprocessorCount, dev);
        hipOccupancyMaxActiveBlocksPerMultiprocessor(&per_cu, k_mega, NTHREADS, 0);
        if (per_cu > 1) per_cu = 1;
        grid_blocks = cus * per_cu;
    }
    hipMemsetAsync((char*)d_ws + OFF_CTR, 0, 512 + 3456 * 4, stream);
    void* args[] = {&P};
    hipError_t e = hipLaunchCooperativeKernel((void*)k_mega, dim3(grid_blocks), dim3(NTHREADS), args, 0, stream);
    if (e != hipSuccess) fprintf(stderr, "cooperative launch failed: %s (grid %d)\n", hipGetErrorString(e), grid_blocks);
}
```

```cpp
#include <hip/hip_runtime.h>
#include <hip/hip_cooperative_groups.h>
#include <cstdint>
#include <cstdio>

#ifndef ONE_LAUNCH
#define ONE_LAUNCH 1
#endif

namespace {
#define DEVINL __device__ __forceinline__
typedef unsigned short bf16_t;
typedef short bf16x8 __attribute__((ext_vector_type(8)));
typedef float f32x4 __attribute__((ext_vector_type(4)));
typedef unsigned u32x2 __attribute__((ext_vector_type(2)));
typedef unsigned u32x4 __attribute__((ext_vector_type(4)));

constexpr int NB = 4, SEQ = 4096, DM = 1024, NT = NB * SEQ, NH = 4, NBH = NB * NH;
constexpr int INW = 3748, NP1 = 3840;
constexpr float EPS = 1e-6f, LOG2E = 1.4426950408889634f;
constexpr float SC_Q = 0.125f * LOG2E;
constexpr float SC_MLA = 0.10206207261596575f * LOG2E;
constexpr int NTHREADS = 512;

constexpr size_t SZ_WT_IN = (size_t)NP1 * 1024 * 2, SZ_WT_UQ = 512 * 256 * 2  , SZ_WT_UKV = 512 * 256 * 2  , SZ_WT_SQ = 1024 * 1024 * 2, SZ_WT_PP = 1024 * 256 * 2;
constexpr size_t OFF_WT_IN = 0;
constexpr size_t OFF_WT_UQ = OFF_WT_IN + 2 * SZ_WT_IN;
constexpr size_t OFF_WT_UKV = OFF_WT_UQ + 2 * SZ_WT_UQ;
constexpr size_t OFF_WT_OUT = OFF_WT_UKV + 2 * SZ_WT_UKV;
constexpr size_t OFF_WT_PG = OFF_WT_OUT + 2 * SZ_WT_SQ;
constexpr size_t OFF_WT_PP = OFF_WT_PG + 2 * SZ_WT_SQ;
constexpr size_t OFF_LUT = OFF_WT_PP + 2 * SZ_WT_PP;
constexpr size_t OFF_ROPE = OFF_LUT + 8 * 4096 * 4;
constexpr size_t OFF_H = OFF_ROPE + 4096 * 16 * 8;
constexpr size_t SZ_HEADBUF = (size_t)NT * 256 * 2;
constexpr size_t OFF_QKV = OFF_H + (size_t)NT * 1024 * 2;
constexpr size_t OFF_XABF = OFF_QKV + (size_t)NT * 1024 * 2;
constexpr size_t OFF_CQ = OFF_QKV + 9 * SZ_HEADBUF;
constexpr size_t OFF_CKV = OFF_CQ + (size_t)NT * 256 * 2;
constexpr size_t OFF_CQSS = OFF_CKV + (size_t)NT * 256 * 2;
constexpr size_t OFF_CKVSS = OFF_CQSS + (size_t)NT * 4 * 4;
constexpr size_t OFF_LOGF = OFF_CKVSS + (size_t)NT * 2 * 4;
constexpr size_t OFF_KMEAN = OFF_LOGF + (size_t)NBH * SEQ * 4;
constexpr size_t OFF_PB = OFF_KMEAN + (size_t)NBH * 16 * 64 * 4;
constexpr size_t OFF_X = OFF_PB + (size_t)NT * 256 * 2;
constexpr size_t OFF_A2 = OFF_X;
constexpr size_t OFF_PB2 = OFF_X + (size_t)NT * 1024 * 4;
constexpr size_t OFF_SSQX = OFF_PB2 + (size_t)NT * 256 * 2;
constexpr size_t OFF_SSQA = OFF_SSQX + (size_t)NT * 16 * 4;
constexpr size_t OFF_DPART = OFF_SSQA + (size_t)NT * 16 * 4;
constexpr size_t OFF_DLSE = OFF_DPART + 3 * (size_t)NT * 256 * 2;
constexpr size_t OFF_CTR = OFF_DLSE + 3 * (size_t)NT * 4 * 4;
constexpr size_t OFF_BOUND = OFF_CTR + 256;
constexpr size_t OFF_BAR = OFF_BOUND + 256;
constexpr size_t OFF_KR = OFF_BAR + 3456 * 4;
constexpr size_t WS_NEED = OFF_KR + (size_t)NT * 32 * 2;
constexpr size_t OOFF_G = 0;
constexpr size_t OOFF_QM = (size_t)NT * 1024 * 2;
constexpr size_t OOFF_KM = OOFF_QM + (size_t)NBH * SEQ * 96 * 2;
constexpr size_t OOFF_VM = OOFF_KM + (size_t)NBH * SEQ * 96 * 2;

struct Params {
    const float *x, *p, *ln_g, *w_in, *b_forget, *qk_gain, *mla_q_norm, *mla_kv_norm, *mla_nope_gain, *mla_rope_gain, *w_uq, *w_ukv, *w_out, *rel_bias, *ple_norm_g, *w_ple_gate, *w_ple_proj;
    float* out;
    char* ws;
};

DEVINL char* as_global(const void* p) { __attribute__((address_space(1))) char* g; asm volatile("" : "=s"(g) : "0"(p)); return (char*)g; }
constexpr int L_MISC = 131072;
constexpr int L_XB = L_MISC + 16, L_WTAB = L_MISC + 64, SMEM_BYTES = L_MISC + 64 + 256;
__shared__ __attribute__((aligned(16))) char g_smem[SMEM_BYTES];
DEVINL int ltid() {
    const unsigned hw = (unsigned)__builtin_amdgcn_s_getreg(0x2804);
    const int w = __builtin_amdgcn_readfirstlane(*(const __attribute__((address_space(3))) int*)((__attribute__((address_space(3))) char*)g_smem + L_WTAB + hw * 4));
    int lane; asm volatile("v_mbcnt_lo_u32_b32 %0, -1, 0\n\tv_mbcnt_hi_u32_b32 %0, -1, %0" : "=v"(lane));
    return w * 64 + lane; }
DEVINL float shx(float v, int mask) { return __int_as_float(__builtin_amdgcn_ds_bpermute(((ltid() & 63) ^ mask) << 2, __float_as_int(v))); }
DEVINL float shup(float v, int o) { return __int_as_float(__builtin_amdgcn_ds_bpermute(((ltid() & 63) - o) << 2, __float_as_int(v))); }
DEVINL float sq4(const f32x4& a) { return a[0] * a[0] + a[1] * a[1] + a[2] * a[2] + a[3] * a[3]; }
template <int XM> DEVINL float swz_xor(float v) { return __int_as_float(__builtin_amdgcn_ds_swizzle(__float_as_int(v), (XM << 10) | 0x1F)); }
DEVINL float half_swap_sum(float v) { auto rr = __builtin_amdgcn_permlane32_swap(__float_as_uint(v), __float_as_uint(v), false, false); return __uint_as_float(rr[0]) + __uint_as_float(rr[1]); }
DEVINL float wave_sum(float v) { v += swz_xor<1>(v); v += swz_xor<2>(v); v += swz_xor<4>(v); v += swz_xor<8>(v); v += swz_xor<16>(v); return half_swap_sum(v); }
DEVINL bf16_t f2bf(float f) { unsigned u = __float_as_uint(f); u += 0x7fffu + ((u >> 16) & 1u); return (bf16_t)(u >> 16); }
DEVINL float bf2f(bf16_t h) { return __uint_as_float(((unsigned)h) << 16); }
DEVINL unsigned pack2(float a, float b) { return (unsigned)f2bf(a) | ((unsigned)f2bf(b) << 16); }
typedef __bf16 bf16v2 __attribute__((ext_vector_type(2)));
typedef float f32v2 __attribute__((ext_vector_type(2)));
DEVINL unsigned cvt2(float a, float b) { f32v2 v = {a, b}; return __builtin_bit_cast(unsigned, __builtin_convertvector(v, bf16v2)); }
DEVINL float bflo(unsigned u) { return __uint_as_float(u << 16); }
DEVINL float bfhi(unsigned u) { return __uint_as_float(u & 0xffff0000u); }

__device__ __constant__ float ROPE_INV[16] = {1.0f, 0.5623413251903491f, 0.31622776601683794f, 0.1778279410038923f, 0.1f, 0.05623413251903491f, 0.03162277660168379f, 0.01778279410038923f,
                                              0.01f, 0.005623413251903491f, 0.0031622776601683794f, 0.0017782794100389228f, 0.001f, 0.0005623413251903491f, 0.00031622776601683794f, 0.00017782794100389227f};

DEVINL int t5_bucket(int d) {
    if (d < 16) return d;
    int b = 16;
    b += (d >= 22); b += (d >= 30); b += (d >= 40); b += (d >= 54); b += (d >= 73); b += (d >= 99); b += (d >= 134); b += (d >= 182);
    b += (d >= 246); b += (d >= 332); b += (d >= 450); b += (d >= 609); b += (d >= 825); b += (d >= 1117); b += (d >= 1513);
    return b;
}

DEVINL int map_w_in(int n) { return n < 768 ? n : (n < 2720 ? n + 4 : (n < 2724 ? n - 2720 + 768 : (n < 2816 ? -1 : n - 92))); }
DEVINL int virt_col(int nv) { const int v = nv & 255; return (nv & ~255) + 64 * ((v >> 5) & 3) + 32 * (v >> 7) + (v & 31); }
DEVINL int map_w_in_virt(int nv) { int a = virt_col(nv); const int chunk = a >> 6; int hc = a & 63;
    if (chunk == 42 && hc < 32) hc = 16 * ((hc >> 2) & 1) + 4 * (hc >> 3) + (hc & 3);
    return map_w_in(chunk * 64 + hc); }
DEVINL int map_w_uq_virt(int nv) { const int a = virt_col(nv), chunk = a >> 6; int hc = a & 63; if (chunk >= 6) return -1;
    if (chunk >= 4) { const int e = hc & 31; hc = (hc & 32) + 16 * ((e >> 2) & 1) + 4 * (e >> 3) + (e & 3); }
    const int n = chunk * 64 + hc; if (n < 256) return (n >> 6) * 96 + (n & 63); const int r = n - 256; return (r >> 5) * 96 + 64 + (r & 31); }
DEVINL int map_w_uq(int n) { if (n < 256) return (n >> 6) * 96 + (n & 63); const int r = n - 256; return (r >> 5) * 96 + 64 + (r & 31); }

template <int KT>
DEVINL void transpose_tile(const float* src, int Nsrc, bf16_t* dst, int K, int tn, int tk, int mode, const float* fold, float* tile  ) {
    const int tid = ltid(), c4 = (tid & 15) * 4, kr = tid >> 4  , n0 = tn * 64, k0 = tk * KT;
    const int n = n0 + c4, oc = mode == 1 ? map_w_in_virt(n) : (mode == 2 ? map_w_uq(n) : (mode == 3 ? virt_col(n) : (mode == 4 ? map_w_uq_virt(n) : (mode == 5 ? virt_col(n) : n))));
    f32x4 v[KT / 32];
#pragma unroll
    for (int i = 0; i < KT / 32; ++i) { const int kk = kr + 32 * i; v[i] = (f32x4){0.f, 0.f, 0.f, 0.f}; if (oc >= 0 && !(mode == 5 && k0 + kk >= 128)) { v[i] = __builtin_nontemporal_load((const f32x4*)(src + (size_t)(k0 + kk) * Nsrc + oc)); if (fold) v[i] = v[i] * fold[k0 + kk]; } }
    __syncthreads();
#pragma unroll
    for (int i = 0; i < KT / 32; ++i) *(f32x4*)(tile + (kr + 32 * i) * 68 + c4) = v[i];
    __syncthreads();
#pragma unroll
    for (int h = 0; h < KT / 64; ++h) { const int nn = tid & 63, kc = h * 64 + (tid >> 6) * 8; const float* tp = tile + kc * 68 + nn; u32x4 w;
      w.x = cvt2(tp[0], tp[68]); w.y = cvt2(tp[136], tp[204]); w.z = cvt2(tp[272], tp[340]); w.w = cvt2(tp[408], tp[476]);
      *(u32x4*)(dst + (size_t)(n0 + nn) * K + k0 + kc) = w; }
}

constexpr int PREP_T_IN = 60 * 4, PREP_T_UQ = 8 * 1, PREP_T_UKV = 8 * 1, PREP_T_SQ = 16 * 4, PREP_T_PP = 16 * 1;
constexpr int PREP_PER_LAYER = PREP_T_IN + PREP_T_UQ + PREP_T_UKV + 2 * PREP_T_SQ + PREP_T_PP;
constexpr int PREP_LUT_UNITS = 8 * 4096 / 512, PREP_ROPE_UNITS = 4096 * 16 / 512;
constexpr int PREP_X_UNITS = NT / 32, PREP_P_UNITS = 2 * NT / 64;
constexpr int PREP_UNITS = 2 * PREP_PER_LAYER + PREP_LUT_UNITS + PREP_ROPE_UNITS + PREP_X_UNITS + PREP_P_UNITS;

DEVINL void prep_w_unit(const Params& P, int l, int r, float* tile) {
    if (r < PREP_T_IN) { transpose_tile<256>(P.w_in + (size_t)l * 1024 * INW, INW, (bf16_t*)(P.ws + OFF_WT_IN + l * SZ_WT_IN), 1024, r % 60, r / 60, 1, P.ln_g + l * DM, tile); return; }
    r -= PREP_T_IN;
    if (r < PREP_T_UQ) { transpose_tile<256>(P.w_uq + (size_t)l * 256 * 384, 384, (bf16_t*)(P.ws + OFF_WT_UQ + l * SZ_WT_UQ), 256, r % 8, r / 8, 4, P.mla_q_norm + l * 256, tile); return; }
    r -= PREP_T_UQ;
    if (r < PREP_T_UKV) { transpose_tile<256>(P.w_ukv + (size_t)l * 128 * 512, 512, (bf16_t*)(P.ws + OFF_WT_UKV + l * SZ_WT_UKV), 256, r % 8, r / 8, 5, P.mla_kv_norm + l * 128, tile); return; }
    r -= PREP_T_UKV;
    if (r < PREP_T_SQ) { transpose_tile<256>(P.w_out + (size_t)l * 1024 * 1024, 1024, (bf16_t*)(P.ws + OFF_WT_OUT + l * SZ_WT_SQ), 1024, r % 16, r / 16, 3, nullptr, tile); return; }
    r -= PREP_T_SQ;
    if (r < PREP_T_SQ) { transpose_tile<256>(P.w_ple_gate + (size_t)l * 1024 * 1024, 1024, (bf16_t*)(P.ws + OFF_WT_PG + l * SZ_WT_SQ), 1024, r % 16, r / 16, 3, P.ple_norm_g + l * DM, tile); return; }
    r -= PREP_T_SQ;
    transpose_tile<256>(P.w_ple_proj + (size_t)l * 256 * 1024, 1024, (bf16_t*)(P.ws + OFF_WT_PP + l * SZ_WT_PP), 256, r % 16, r / 16, 3, nullptr, tile);
}
DEVINL void prep_p_unit(const Params& P, int v) {
    const int wid = ltid() >> 6, lane = ltid() & 63; f32x4 a[8];
#pragma unroll
    for (int rr = 0; rr < 8; ++rr) a[rr] = __builtin_nontemporal_load((const f32x4*)(P.p + (size_t)(v * 64 + wid * 8 + rr) * 256 + lane * 4));
#pragma unroll
    for (int rr = 0; rr < 8; ++rr) { const int row = v * 64 + wid * 8 + rr; u32x2 w; w.x = cvt2(a[rr][0], a[rr][1]); w.y = cvt2(a[rr][2], a[rr][3]);
        bf16_t* pb = row < NT ? (bf16_t*)(P.ws + OFF_PB) + (size_t)row * 256 : (bf16_t*)(P.ws + OFF_PB2) + (size_t)(row - NT) * 256; *(u32x2*)(pb + lane * 4) = w; }
}
DEVINL void phase_prep(const Params& P, char* smem) {
    float* tile = (float*)smem;
    if (ltid() == 0) (void)__hip_atomic_fetch_or((unsigned*)(P.ws + OFF_BAR) + 8 + (blockIdx.x & 7u), 1u << ((unsigned)__builtin_amdgcn_s_getreg((3 << 11) | 20) & 0xFu), __ATOMIC_RELAXED, __HIP_MEMORY_SCOPE_AGENT);
    if (blockIdx.x == 0) {
        const int w_ = ltid() >> 6, ln_ = ltid() & 63, l = w_ >> 2, md = w_ & 3; float bound;
        auto amax = [&](const float* p, int n) { float a = 0.f; for (int i = ln_; i < n; i += 64) a = fmaxf(a, fabsf(p[i]));
            a = fmaxf(a, swz_xor<1>(a)); a = fmaxf(a, swz_xor<2>(a)); a = fmaxf(a, swz_xor<4>(a)); a = fmaxf(a, swz_xor<8>(a)); a = fmaxf(a, swz_xor<16>(a));
            auto rr = __builtin_amdgcn_permlane32_swap(__float_as_uint(a), __float_as_uint(a), false, false); return fmaxf(__uint_as_float(rr[0]), __uint_as_float(rr[1])); };
        if (md == 2) { const float nq = amax(P.mla_nope_gain + (l * 2 + 0) * 64, 64), nk = amax(P.mla_nope_gain + (l * 2 + 1) * 64, 64), rq = amax(P.mla_rope_gain + (l * 2 + 0) * 32, 32), rk = amax(P.mla_rope_gain + (l * 2 + 1) * 32, 32);
            bound = sqrtf(64.f * nq * nq + 32.f * rq * rq) * sqrtf(64.f * nk * nk + 32.f * rk * rk) * SC_MLA; }
        else { const int mix = md == 0 ? 0 : (md == 1 ? 1 : 2); bound = 64.f * amax(P.qk_gain + (l * 6 + 2 * mix) * 64, 64) * amax(P.qk_gain + (l * 6 + 2 * mix + 1) * 64, 64) * SC_Q;
            if (md == 0) bound += 8.f; else bound += amax(P.rel_bias, 256) * LOG2E; }
        if (ln_ == 0) ((float*)(P.ws + OFF_BOUND))[l * 4 + md] = bound;
    }
    constexpr int U_W = PREP_PER_LAYER, U_LUT = U_W + PREP_LUT_UNITS, U_ROPE = U_LUT + PREP_ROPE_UNITS, U_X = U_ROPE + PREP_X_UNITS, U_P = U_X + PREP_P_UNITS / 2;
    for (int u = blockIdx.x; u < U_P; u += gridDim.x) {
        if (u < U_W) { if (u < PREP_T_IN + PREP_T_UQ + PREP_T_UKV) prep_w_unit(P, 0, u, tile); }
        else if (u < U_LUT) { const int e = (u - U_W) * 512 + ltid(), hh = e >> 12, d = e & 4095; ((float*)(P.ws + OFF_LUT))[e] = P.rel_bias[t5_bucket(d) * 8 + hh] * LOG2E; }
        else if (u < U_ROPE) { const int e = (u - U_LUT) * 512 + ltid(), pos = e >> 4, i = e & 15;
            const double rev = (double)pos * (double)ROPE_INV[i] * 0.15915494309189535; const float fr = (float)(rev - floor(rev));
            ((float2*)(P.ws + OFF_ROPE))[e] = make_float2(__builtin_amdgcn_cosf(fr), __builtin_amdgcn_sinf(fr)); }
        else if (u < U_X) { const int v = u - U_ROPE, wid = ltid() >> 6, lane = ltid() & 63;
            f32x4 a[4][4];
#pragma unroll
            for (int rr = 0; rr < 4; ++rr)
#pragma unroll
                for (int i = 0; i < 4; ++i) a[rr][i] = __builtin_nontemporal_load((const f32x4*)(P.x + (size_t)(v * 32 + wid * 4 + rr) * DM + i * 256 + lane * 4));
#pragma unroll
            for (int rr = 0; rr < 4; ++rr) { const int row = v * 32 + wid * 4 + rr; float ss = 0.f;
#pragma unroll
                for (int i = 0; i < 4; ++i) { ss += sq4(a[rr][i]); u32x2 w; w.x = cvt2(a[rr][i][0], a[rr][i][1]); w.y = cvt2(a[rr][i][2], a[rr][i][3]); *(u32x2*)((bf16_t*)(P.ws + OFF_H) + (size_t)row * DM + i * 256 + lane * 4) = w; }
                ss = wave_sum(ss); if (lane < 16) ((float*)(P.ws + OFF_SSQX))[(size_t)row * 16 + lane] = lane == 0 ? ss : 0.f;
                if (lane < 16) *(u32x4*)((bf16_t*)(P.ws + OFF_CKV) + (size_t)row * 256 + 128 + lane * 8) = (u32x4){0u, 0u, 0u, 0u}; } }
        else {   }
    }
}

DEVINL void phase_rms(const float* src, const float* g, bf16_t* dst, const float* psrc, bf16_t* pb) {
    const int wid = ltid() >> 6, lane = ltid() & 63;
    for (int u = blockIdx.x; u < NT / 8; u += gridDim.x) {
        const int row = u * 8 + wid; const float* xr = src + (size_t)row * DM;
        f32x4 v[4]; float ss = 0.f;
#pragma unroll
        for (int i = 0; i < 4; ++i) { v[i] = *(const f32x4*)(xr + i * 256 + lane * 4); ss += v[i][0] * v[i][0] + v[i][1] * v[i][1] + v[i][2] * v[i][2] + v[i][3] * v[i][3]; }
        ss = wave_sum(ss); const float r = rsqrtf(ss * (1.0f / DM) + EPS);
#pragma unroll
        for (int i = 0; i < 4; ++i) { const f32x4 gg = *(const f32x4*)(g + i * 256 + lane * 4); u32x2 w; w.x = pack2(v[i][0] * r * gg[0], v[i][1] * r * gg[1]); w.y = pack2(v[i][2] * r * gg[2], v[i][3] * r * gg[3]);
            *(u32x2*)(dst + (size_t)row * DM + i * 256 + lane * 4) = w; }
        if (psrc) { const f32x4 pv = *(const f32x4*)(psrc + (size_t)row * 256 + lane * 4); u32x2 w; w.x = pack2(pv[0], pv[1]); w.y = pack2(pv[2], pv[3]); *(u32x2*)(pb + (size_t)row * 256 + lane * 4) = w; }
    }
}

constexpr int GST = 40;
template <class Epi>
DEVINL void gemm_phase(const bf16_t* A, const bf16_t* Bt, int M, int N, int K, const Epi& epi, char* smem) {
    bf16_t* As = (bf16_t*)smem; bf16_t* Bs = As + 256 * GST;
    const int tid = ltid(), wid = tid >> 6, lane = tid & 63, wr = wid >> 1, wc = wid & 1, fr = lane & 15, fq = lane >> 4;
    const int ntm = M / 256, ntn = N / 128, nk = K / 32;
    const int lr = tid >> 2, lc = (tid & 3) * 8;
    for (int tile = blockIdx.x; tile < ntm * ntn; tile += gridDim.x) {
        const int tm = tile % ntm, tn = tile / ntm;
        const bf16_t* Ag = A + (size_t)(tm * 256 + lr) * K + lc; const bf16_t* Bg = Bt + (size_t)(tn * 128 + lr) * K + lc;
        f32x4 acc[4][4];
#pragma unroll
        for (int m = 0; m < 4; ++m)
#pragma unroll
            for (int n = 0; n < 4; ++n) acc[m][n] = (f32x4){0.f, 0.f, 0.f, 0.f};
        u32x4 ra0 = *(const u32x4*)Ag, ra1 = *(const u32x4*)(Ag + (size_t)128 * K), rb0 = *(const u32x4*)Bg;
        for (int kt = 0; kt < nk; ++kt) {
            __syncthreads();
            *(u32x4*)(As + lr * GST + lc) = ra0; *(u32x4*)(As + (lr + 128) * GST + lc) = ra1; *(u32x4*)(Bs + lr * GST + lc) = rb0;
            __syncthreads();
            if (kt + 1 < nk) { const int ko = (kt + 1) * 32; ra0 = *(const u32x4*)(Ag + ko); ra1 = *(const u32x4*)(Ag + (size_t)128 * K + ko); rb0 = *(const u32x4*)(Bg + ko); }
            bf16x8 af[4], bfr[4];
#pragma unroll
            for (int m = 0; m < 4; ++m) af[m] = *(const bf16x8*)(As + (wr * 64 + m * 16 + fr) * GST + fq * 8);
#pragma unroll
            for (int n = 0; n < 4; ++n) bfr[n] = *(const bf16x8*)(Bs + (wc * 64 + n * 16 + fr) * GST + fq * 8);
#pragma unroll
            for (int m = 0; m < 4; ++m)
#pragma unroll
                for (int n = 0; n < 4; ++n) acc[m][n] = __builtin_amdgcn_mfma_f32_16x16x32_bf16(bfr[n], af[m], acc[m][n], 0, 0, 0);
        }
        epi(acc, tm * 256 + wr * 64, tn * 2 + wc, fr, fq);
    }
    __syncthreads();
}

DEVINL float quad_sum(float v) { v += swz_xor<16>(v); return half_swap_sum(v); }
DEVINL void store4bf(bf16_t* p, float a, float b, float c, float d) { u32x2 w; w.x = pack2(a, b); w.y = pack2(c, d); *(u32x2*)p = w; }
DEVINL float fsigmoid(float z) { return __builtin_amdgcn_rcpf(1.0f + __builtin_amdgcn_exp2f(-LOG2E * z)); }
DEVINL float log_sigmoid(float z) { return fminf(z, 0.f) - log1pf(__expf(-fabsf(z))); }

struct EpiIn {
    Params P; int l;
    DEVINL void operator()(f32x4 (&acc)[4][4], int row0, int chunk, int fr, int fq) const {
        char* ws = P.ws; char* ob = (char*)P.out;
        if (chunk < 36) {
            const int g = chunk >> 2, h = chunk & 3, role = g % 3, mix = g / 3;
            bf16_t* dst = (bf16_t*)(ws + OFF_QKV + (size_t)g * SZ_HEADBUF);
            const float* gain = P.qk_gain + ((size_t)l * 6 + 2 * mix + (role == 1 ? 1 : 0)) * 64;
#pragma unroll
            for (int m = 0; m < 4; ++m) {
                const int t = row0 + 16 * m + fr, b = t >> 12, s = t & 4095; bf16_t* d = dst + ((size_t)(b * 4 + h) * SEQ + s) * 64 + 4 * fq;
                float r = 1.f;
                if (role != 2) { float ss = 0.f;
#pragma unroll
                    for (int n = 0; n < 4; ++n) ss += acc[m][n][0] * acc[m][n][0] + acc[m][n][1] * acc[m][n][1] + acc[m][n][2] * acc[m][n][2] + acc[m][n][3] * acc[m][n][3];
                    ss = quad_sum(ss); r = rsqrtf(ss * (1.0f / 64.0f) + EPS) * (role == 0 ? SC_Q : 1.0f); }
#pragma unroll
                for (int n = 0; n < 4; ++n) { f32x4 gg = (f32x4){1.f, 1.f, 1.f, 1.f}; if (role != 2) gg = *(const f32x4*)(gain + 16 * n + 4 * fq);
                    store4bf(d + 16 * n, acc[m][n][0] * r * gg[0], acc[m][n][1] * r * gg[1], acc[m][n][2] * r * gg[2], acc[m][n][3] * r * gg[3]); }
            }
        } else if (chunk < 42) {
            const bool isq = chunk < 40; const int c = isq ? chunk - 36 : chunk - 40;
            bf16_t* dst = isq ? (bf16_t*)(ws + OFF_CQ) : (bf16_t*)(ws + OFF_CKV); const int ld = isq ? 256 : 128;
            float* ssp = isq ? (float*)(ws + OFF_CQSS) : (float*)(ws + OFF_CKVSS); const int nss = isq ? 4 : 2;
#pragma unroll
            for (int m = 0; m < 4; ++m) {
                const int t = row0 + 16 * m + fr; float ss = 0.f;
#pragma unroll
                for (int n = 0; n < 4; ++n) { ss += acc[m][n][0] * acc[m][n][0] + acc[m][n][1] * acc[m][n][1] + acc[m][n][2] * acc[m][n][2] + acc[m][n][3] * acc[m][n][3];
                    store4bf(dst + (size_t)t * ld + c * 64 + 16 * n + 4 * fq, acc[m][n][0], acc[m][n][1], acc[m][n][2], acc[m][n][3]); }
                ss = quad_sum(ss); if (fq == 0) ssp[(size_t)t * nss + c] = ss;
            }
        } else if (chunk == 42) {
            const float* gr = P.mla_rope_gain + ((size_t)l * 2 + 1) * 32; const float2* rope = (const float2*)(ws + OFF_ROPE);
            bf16_t* km = (bf16_t*)(ob + OOFF_KM); float* logf_ = (float*)(ws + OFF_LOGF);
            const f32x4 g1 = *(const f32x4*)(gr + 4 * fq), g2 = *(const f32x4*)(gr + 16 + 4 * fq); const f32x4 bfv = *(const f32x4*)(P.b_forget + l * 4);
#pragma unroll
            for (int m = 0; m < 4; ++m) {
                const int t = row0 + 16 * m + fr, b = t >> 12, s = t & 4095;
                float ss = 0.f;
#pragma unroll
                for (int n = 0; n < 2; ++n) ss += acc[m][n][0] * acc[m][n][0] + acc[m][n][1] * acc[m][n][1] + acc[m][n][2] * acc[m][n][2] + acc[m][n][3] * acc[m][n][3];
                ss = quad_sum(ss); const float r = rsqrtf(ss * (1.0f / 32.0f) + EPS);
                float o1[4], o2[4];
#pragma unroll
                for (int j = 0; j < 4; ++j) { const float2 cs = rope[s * 16 + 4 * fq + j]; const float x1 = acc[m][0][j] * r * g1[j], x2 = acc[m][1][j] * r * g2[j]; o1[j] = x1 * cs.x - x2 * cs.y; o2[j] = x1 * cs.y + x2 * cs.x; }
#pragma unroll
                for (int h = 0; h < 4; ++h) { bf16_t* d = km + ((size_t)(b * 4 + h) * SEQ + s) * 96 + 64 + 4 * fq; store4bf(d, o1[0], o1[1], o1[2], o1[3]); store4bf(d + 16, o2[0], o2[1], o2[2], o2[3]); }
                if (fq == 0) {
#pragma unroll
                    for (int j = 0; j < 4; ++j) logf_[(size_t)(b * 4 + j) * SEQ + s] = log_sigmoid(acc[m][2][j] + bfv[j]) * LOG2E;
                }
            }
        } else if (chunk >= 44) {
            bf16_t* G = (bf16_t*)(ob + OOFF_G); const int c0 = (chunk - 44) * 64;
#pragma unroll
            for (int m = 0; m < 4; ++m) { const int t = row0 + 16 * m + fr;
#pragma unroll
                for (int n = 0; n < 4; ++n) { float o[4];
#pragma unroll
                    for (int j = 0; j < 4; ++j) { const float z = acc[m][n][j]; o[j] = z / (1.0f + __expf(-z)); }
                    store4bf(G + (size_t)t * DM + c0 + 16 * n + 4 * fq, o[0], o[1], o[2], o[3]); } }
        }
    }
};

struct EpiUq {
    Params P; int l;
    DEVINL void operator()(f32x4 (&acc)[4][4], int row0, int chunk, int fr, int fq) const {
        const float* cqss = (const float*)(P.ws + OFF_CQSS); bf16_t* qm = (bf16_t*)((char*)P.out + OOFF_QM); const float2* rope = (const float2*)(P.ws + OFF_ROPE);
#pragma unroll
        for (int m = 0; m < 4; ++m) {
            const int t = row0 + 16 * m + fr, b = t >> 12, s = t & 4095; const f32x4 pss = *(const f32x4*)(cqss + (size_t)t * 4);
            const float rt = rsqrtf((pss[0] + pss[1] + pss[2] + pss[3]) * (1.0f / 256.0f) + EPS);
            if (chunk < 4) {
                const float* gain = P.mla_nope_gain + ((size_t)l * 2 + 0) * 64; float ss = 0.f;
#pragma unroll
                for (int n = 0; n < 4; ++n) { acc[m][n] = acc[m][n] * rt; ss += acc[m][n][0] * acc[m][n][0] + acc[m][n][1] * acc[m][n][1] + acc[m][n][2] * acc[m][n][2] + acc[m][n][3] * acc[m][n][3]; }
                ss = quad_sum(ss); const float r = rsqrtf(ss * (1.0f / 64.0f) + EPS) * SC_MLA; bf16_t* d = qm + ((size_t)(b * 4 + chunk) * SEQ + s) * 96 + 4 * fq;
#pragma unroll
                for (int n = 0; n < 4; ++n) { const f32x4 gg = *(const f32x4*)(gain + 16 * n + 4 * fq); store4bf(d + 16 * n, acc[m][n][0] * r * gg[0], acc[m][n][1] * r * gg[1], acc[m][n][2] * r * gg[2], acc[m][n][3] * r * gg[3]); }
            } else {
                const float* gr = P.mla_rope_gain + ((size_t)l * 2 + 0) * 32; const f32x4 g1 = *(const f32x4*)(gr + 4 * fq), g2 = *(const f32x4*)(gr + 16 + 4 * fq);
#pragma unroll
                for (int hh = 0; hh < 2; ++hh) {
                    const int h = (chunk - 4) * 2 + hh; float ss = 0.f;
#pragma unroll
                    for (int n = 0; n < 2; ++n) { acc[m][2 * hh + n] = acc[m][2 * hh + n] * rt; const f32x4 a = acc[m][2 * hh + n]; ss += a[0] * a[0] + a[1] * a[1] + a[2] * a[2] + a[3] * a[3]; }
                    ss = quad_sum(ss); const float r = rsqrtf(ss * (1.0f / 32.0f) + EPS);
                    float o1[4], o2[4];
#pragma unroll
                    for (int j = 0; j < 4; ++j) { const float2 cs = rope[s * 16 + 4 * fq + j]; const float x1 = acc[m][2 * hh][j] * r * g1[j], x2 = acc[m][2 * hh + 1][j] * r * g2[j];
                        o1[j] = (x1 * cs.x - x2 * cs.y) * SC_MLA; o2[j] = (x1 * cs.y + x2 * cs.x) * SC_MLA; }
                    bf16_t* d = qm + ((size_t)(b * 4 + h) * SEQ + s) * 96 + 64 + 4 * fq; store4bf(d, o1[0], o1[1], o1[2], o1[3]); store4bf(d + 16, o2[0], o2[1], o2[2], o2[3]);
                }
            }
        }
    }
};
struct EpiUkv {
    Params P; int l;
    DEVINL void operator()(f32x4 (&acc)[4][4], int row0, int chunk, int fr, int fq) const {
        const float* ckvss = (const float*)(P.ws + OFF_CKVSS); bf16_t* km = (bf16_t*)((char*)P.out + OOFF_KM); bf16_t* vm = (bf16_t*)((char*)P.out + OOFF_VM);
        const int h = chunk >> 1; const bool isk = (chunk & 1) == 0; const float* gain = P.mla_nope_gain + ((size_t)l * 2 + 1) * 64;
#pragma unroll
        for (int m = 0; m < 4; ++m) {
            const int t = row0 + 16 * m + fr, b = t >> 12, s = t & 4095; const float rt = rsqrtf((ckvss[(size_t)t * 2] + ckvss[(size_t)t * 2 + 1]) * (1.0f / 128.0f) + EPS);
            float ss = 0.f;
#pragma unroll
            for (int n = 0; n < 4; ++n) { acc[m][n] = acc[m][n] * rt; ss += acc[m][n][0] * acc[m][n][0] + acc[m][n][1] * acc[m][n][1] + acc[m][n][2] * acc[m][n][2] + acc[m][n][3] * acc[m][n][3]; }
            if (isk) { ss = quad_sum(ss); const float r = rsqrtf(ss * (1.0f / 64.0f) + EPS); bf16_t* d = km + ((size_t)(b * 4 + h) * SEQ + s) * 96 + 4 * fq;
#pragma unroll
                for (int n = 0; n < 4; ++n) { const f32x4 gg = *(const f32x4*)(gain + 16 * n + 4 * fq); store4bf(d + 16 * n, acc[m][n][0] * r * gg[0], acc[m][n][1] * r * gg[1], acc[m][n][2] * r * gg[2], acc[m][n][3] * r * gg[3]); }
            } else { bf16_t* d = vm + ((size_t)(b * 4 + h) * SEQ + s) * 64 + 4 * fq;
#pragma unroll
                for (int n = 0; n < 4; ++n) store4bf(d + 16 * n, acc[m][n][0], acc[m][n][1], acc[m][n][2], acc[m][n][3]); }
        }
    }
};
struct EpiResid { const float* base; float* out;
    DEVINL void operator()(f32x4 (&acc)[4][4], int row0, int chunk, int fr, int fq) const {
#pragma unroll
        for (int m = 0; m < 4; ++m) { const size_t o = (size_t)(row0 + 16 * m + fr) * DM + chunk * 64 + 4 * fq;
#pragma unroll
            for (int n = 0; n < 4; ++n) { const f32x4 bv = *(const f32x4*)(base + o + 16 * n); *(f32x4*)(out + o + 16 * n) = bv + acc[m][n]; } } } };
struct EpiStore { float* out;
    DEVINL void operator()(f32x4 (&acc)[4][4], int row0, int chunk, int fr, int fq) const {
#pragma unroll
        for (int m = 0; m < 4; ++m) { const size_t o = (size_t)(row0 + 16 * m + fr) * DM + chunk * 64 + 4 * fq;
#pragma unroll
            for (int n = 0; n < 4; ++n) *(f32x4*)(out + o + 16 * n) = acc[m][n]; } } };
struct EpiPle { const float* xa; const float* pp; float* out;
    DEVINL void operator()(f32x4 (&acc)[4][4], int row0, int chunk, int fr, int fq) const {
#pragma unroll
        for (int m = 0; m < 4; ++m) { const size_t o = (size_t)(row0 + 16 * m + fr) * DM + chunk * 64 + 4 * fq;
#pragma unroll
            for (int n = 0; n < 4; ++n) { const f32x4 xv = *(const f32x4*)(xa + o + 16 * n), pv = *(const f32x4*)(pp + o + 16 * n); f32x4 r;
#pragma unroll
                for (int j = 0; j < 4; ++j) r[j] = xv[j] + pv[j] / (1.0f + __expf(-acc[m][n][j]));
                *(f32x4*)(out + o + 16 * n) = r; } } } };

namespace pg8 {
#define PG8_LAS __attribute__((address_space(3)))
constexpr int BM = 256, BK = 64, HALF = 128, HTB = HALF * BK * 2  , STAGE_BYTES = 8 * HTB, NXCD = 8, WGM = 8;

__host__ __device__ __forceinline__ int lds_byte(int r, int c) { const int st = (r >> 4) * 2 + (c >> 5), rr = r & 15, cc = c & 31, ob = rr * 64 + cc * 2; return st * 1024 + (ob ^ (((ob >> 9) & 1) << 5)); }
__host__ __device__ __forceinline__ void stage_rc(int b, int& R, int& C) { const int st = b / 1024, sb = b % 1024, swz = sb ^ (((sb >> 9) & 1) << 5); R = (st >> 1) * 16 + swz / 64; C = (st & 1) * 32 + (swz % 64) / 2; }
__host__ __device__ __forceinline__ int perm32(int rho) { const int n = rho >> 4, i = rho & 15; return 8 * (i >> 2) + 4 * n + (i & 3); }

struct Unit { int pm, pn; };
struct Gemm { const bf16_t* A; const bf16_t* Bt; int M, N, K; };

struct StaticOrder {
    int nM, nN, nwg, G, c;
    __host__ __device__ void init(int M, int N, int G_, int c_) { nM = M / BM; nN = N / BM; nwg = nM * nN; G = G_; c = c_; }
    __host__ __device__ bool next(int i, Unit& u) const {
        const long L = (long)i * G + c; if (L >= nwg) return false;
        int wgid = (int)L; { const int q = nwg / NXCD, r = nwg % NXCD, xcd = wgid % NXCD, off = wgid / NXCD; wgid = (xcd < r ? xcd * (q + 1) : r * (q + 1) + (xcd - r) * q) + off; }
        const int nig = WGM * nN, gid = wgid / nig, fm = gid * WGM, gsz = (nM - fm) < WGM ? (nM - fm) : WGM;
        u.pm = fm + ((wgid % nig) % gsz); u.pn = (wgid % nig) / gsz; return true;
    }
    __device__ __forceinline__ void a_ready(const Unit&) const {}
    __device__ __forceinline__ void done(const Unit&) const {}
};

template <class Epi, class Sched, bool ALIGN_EPI = false, bool SP2 = false>
__device__ __forceinline__ void gemm_phase(PG8_LAS unsigned char* lds, const Gemm g, const Sched& S, const Epi& E) {
    const int tid = ltid(), wid = __builtin_amdgcn_readfirstlane(tid >> 6), lane = tid & 63, wr = wid >> 2, wc = wid & 3, fr = lane & 15, fq = lane >> 4;
    const int K = g.K, nt = K / BK;
    unsigned voffA[2], voffB[2];
#pragma unroll
    for (int i = 0; i < 2; ++i) { int R, C; stage_rc(tid * 16 + i * 8192, R, C); const int Rb = Epi::PERM ? ((R & ~31) + perm32(R & 31)) : R;
        voffA[i] = (unsigned)(R * K + C) * 2u; voffB[i] = (unsigned)(Rb * K + C) * 2u; }
    const size_t kstep = (size_t)(BK * 2);
    const size_t hstep = (size_t)HALF * K * 2;
    const size_t tstep = 2 * hstep;
    const unsigned ldsw = (unsigned)wid * 1024u;
    const int aoff = lds_byte(wr * 64 + fr, fq * 8), boff = lds_byte(wc * 32 + fr, fq * 8);
    PG8_LAS unsigned char* ldsA = lds + aoff; PG8_LAS unsigned char* ldsB = lds + 65536 + boff; asm volatile("" : "+v"(ldsA), "+v"(ldsB));
#define PG8_SA(b, h) (((b) * 2 + (h)) * HTB)
#define PG8_SB(b, h) ((4 + (b) * 2 + (h)) * HTB)
#define PG8_STAGE(bufoff, gbase, voff) do { _Pragma("unroll") for (int _i = 0; _i < 2; ++_i) \
        __builtin_amdgcn_global_load_lds((const unsigned*)((const char*)(gbase) + (voff)[_i]), (PG8_LAS unsigned*)(lds + (bufoff) + ldsw + _i * 8192), 16, 0, 0); } while (0)
#define PG8_LDA(dst, b, h) do { _Pragma("unroll") for (int m = 0; m < 4; ++m) _Pragma("unroll") for (int k = 0; k < 2; ++k) dst[m][k] = *(const PG8_LAS bf16x8*)(ldsA + PG8_SA(b, h) + m * 2048 + k * 1024); } while (0)
#define PG8_LDB(dst, b, h) do { _Pragma("unroll") for (int n = 0; n < 2; ++n) _Pragma("unroll") for (int k = 0; k < 2; ++k) dst[n][k] = *(const PG8_LAS bf16x8*)(ldsB + (PG8_SB(b, h) - 65536) + n * 2048 + k * 1024); } while (0)
#define PG8_MMA(ai, bj, At, Bt) do { __builtin_amdgcn_s_setprio(1); _Pragma("unroll") for (int m = 0; m < 4; ++m) _Pragma("unroll") for (int n = 0; n < 2; ++n) _Pragma("unroll") for (int k = 0; k < 2; ++k) \
        acc[ai][bj][m][n] = __builtin_amdgcn_mfma_f32_16x16x32_bf16(Bt[n][k], At[m][k], acc[ai][bj][m][n], 0, 0, 0); __builtin_amdgcn_s_setprio(0); } while (0)
#define PG8_WAIT_V(n) asm volatile("s_waitcnt vmcnt(" #n ")" ::: "memory")
#define PG8_WAIT_L(n) asm volatile("s_waitcnt lgkmcnt(" #n ")" ::: "memory")
#define PG8_BAR __builtin_amdgcn_s_barrier()
#define PG8_SCHED __builtin_amdgcn_sched_barrier(0)
    Unit cur, nxt; int ui = 0;
    if (!S.next(0, cur)) return;
    f32x4 acc[2][2][4][2];
#pragma unroll
    for (int a = 0; a < 2; ++a)
#pragma unroll
        for (int b = 0; b < 2; ++b)
#pragma unroll
            for (int m = 0; m < 4; ++m)
#pragma unroll
                for (int n = 0; n < 2; ++n) acc[a][b][m][n] = (f32x4){0.f, 0.f, 0.f, 0.f};
    bf16x8 At[4][2], B0[2][2], B1[2][2];
    const char* cA = (const char*)g.A + (size_t)cur.pm * tstep; const char* cB = (const char*)g.Bt + (size_t)cur.pn * tstep;
    S.a_ready(cur);
    if constexpr (SP2) {
        PG8_STAGE(PG8_SB(0, 0), cB, voffB); PG8_STAGE(PG8_SB(0, 1), cB + hstep, voffB); PG8_STAGE(PG8_SA(0, 0), cA, voffA); PG8_STAGE(PG8_SA(0, 1), cA + hstep, voffA);
        if (wr == 1) PG8_BAR;
        PG8_WAIT_V(2); PG8_BAR;
        PG8_STAGE(PG8_SB(1, 0), cB + kstep, voffB); PG8_STAGE(PG8_SA(1, 0), cA + kstep, voffA); PG8_STAGE(PG8_SB(1, 1), cB + hstep + kstep, voffB);
        PG8_WAIT_V(6); PG8_BAR;
    } else {
        PG8_STAGE(PG8_SB(0, 0), cB, voffB); PG8_STAGE(PG8_SA(0, 0), cA, voffA); PG8_STAGE(PG8_SB(0, 1), cB + hstep, voffB); PG8_STAGE(PG8_SA(0, 1), cA + hstep, voffA);
        if (wr == 1) PG8_BAR;
        PG8_WAIT_V(4); PG8_BAR;
        PG8_STAGE(PG8_SB(1, 0), cB + kstep, voffB); PG8_STAGE(PG8_SA(1, 0), cA + kstep, voffA); PG8_STAGE(PG8_SB(1, 1), cB + hstep + kstep, voffB);
        PG8_WAIT_V(6); PG8_BAR;
    }
    for (;;) {
        const bool has_next = S.next(ui + 1, nxt);
        const char* nA = has_next ? (const char*)g.A + (size_t)nxt.pm * tstep : cA; const char* nB = has_next ? (const char*)g.Bt + (size_t)nxt.pn * tstep : cB;
        for (int t = 0; t < nt; t += 2) {
            const bool last = (t == nt - 2);
            const char* a1 = cA + (size_t)(t + 1) * kstep;
            const char* a2 = last ? nA : cA + (size_t)(t + 2) * kstep; const char* b2 = last ? nB : cB + (size_t)(t + 2) * kstep;
            const char* a3 = a2 + kstep; const char* b3 = b2 + kstep;
            if (last && has_next) S.a_ready(nxt);
            if constexpr (SP2) {
            PG8_LDB(B0, 0, 0); PG8_LDB(B1, 0, 1); PG8_SCHED; PG8_LDA(At, 0, 0); PG8_STAGE(PG8_SA(1, 1), a1 + hstep, voffA);
            PG8_WAIT_V(8); PG8_WAIT_L(0); PG8_BAR; PG8_MMA(0, 0, At, B0); PG8_MMA(0, 1, At, B1); PG8_BAR; PG8_SCHED;
            PG8_LDA(At, 0, 1); PG8_STAGE(PG8_SB(0, 0), b2, voffB); PG8_STAGE(PG8_SB(0, 1), b2 + hstep, voffB); PG8_STAGE(PG8_SA(0, 0), a2, voffA);
            PG8_WAIT_V(8); PG8_WAIT_L(0); PG8_BAR; PG8_MMA(1, 0, At, B0); PG8_MMA(1, 1, At, B1); PG8_BAR; PG8_SCHED;
            PG8_LDB(B0, 1, 0); PG8_LDB(B1, 1, 1); PG8_SCHED; PG8_LDA(At, 1, 0); PG8_STAGE(PG8_SA(0, 1), a2 + hstep, voffA);
            PG8_WAIT_V(8); PG8_WAIT_L(0); PG8_BAR; PG8_MMA(0, 0, At, B0); PG8_MMA(0, 1, At, B1); PG8_BAR; PG8_SCHED;
            PG8_LDA(At, 1, 1); PG8_STAGE(PG8_SB(1, 0), b3, voffB); PG8_STAGE(PG8_SB(1, 1), b3 + hstep, voffB); PG8_STAGE(PG8_SA(1, 0), a3, voffA);
            PG8_WAIT_V(8); PG8_WAIT_L(0); PG8_BAR; PG8_MMA(1, 0, At, B0); PG8_MMA(1, 1, At, B1); PG8_BAR; PG8_SCHED;
            } else {
            PG8_LDB(B0, 0, 0); PG8_SCHED; PG8_LDA(At, 0, 0); PG8_STAGE(PG8_SA(1, 1), a1 + hstep, voffA);
            PG8_WAIT_L(8); PG8_BAR; PG8_WAIT_L(0); PG8_MMA(0, 0, At, B0); PG8_BAR; PG8_SCHED;
            PG8_LDB(B1, 0, 1); PG8_STAGE(PG8_SB(0, 0), b2, voffB);
            PG8_BAR; PG8_WAIT_L(0); PG8_MMA(0, 1, At, B1); PG8_BAR;
            PG8_LDA(At, 0, 1); PG8_STAGE(PG8_SA(0, 0), a2, voffA);
            PG8_BAR; PG8_WAIT_L(0); PG8_MMA(1, 0, At, B0); PG8_BAR; PG8_SCHED;
            PG8_STAGE(PG8_SB(0, 1), b2 + hstep, voffB);
            PG8_WAIT_V(6); PG8_BAR; PG8_MMA(1, 1, At, B1); PG8_BAR;
            PG8_LDB(B0, 1, 0); PG8_SCHED; PG8_LDA(At, 1, 0); PG8_STAGE(PG8_SA(0, 1), a2 + hstep, voffA);
            PG8_WAIT_L(8); PG8_BAR; PG8_WAIT_L(0); PG8_MMA(0, 0, At, B0); PG8_BAR; PG8_SCHED;
            PG8_LDB(B1, 1, 1); PG8_STAGE(PG8_SB(1, 0), b3, voffB);
            PG8_BAR; PG8_WAIT_L(0); PG8_MMA(0, 1, At, B1); PG8_BAR;
            PG8_LDA(At, 1, 1); PG8_STAGE(PG8_SA(1, 0), a3, voffA);
            PG8_BAR; PG8_WAIT_L(0); PG8_MMA(1, 0, At, B0); PG8_BAR; PG8_SCHED;
            PG8_STAGE(PG8_SB(1, 1), b3 + hstep, voffB);
            PG8_WAIT_V(6); PG8_BAR; PG8_MMA(1, 1, At, B1); PG8_BAR;
            }
        }
        if constexpr (ALIGN_EPI) { if (wr == 0) PG8_BAR; }
        if constexpr (!Epi::AFTER_DRAIN) { E(acc, cur, wr, wc, fr, fq); S.done(cur); }
        if (!has_next) break;
#pragma unroll
        for (int a = 0; a < 2; ++a)
#pragma unroll
            for (int b = 0; b < 2; ++b)
#pragma unroll
                for (int m = 0; m < 4; ++m)
#pragma unroll
                    for (int n = 0; n < 2; ++n) acc[a][b][m][n] = (f32x4){0.f, 0.f, 0.f, 0.f};
        cur = nxt; cA = nA; cB = nB; ++ui;
        if constexpr (ALIGN_EPI) { if (wr == 1) PG8_BAR; }
    }
    PG8_WAIT_V(0);
    if constexpr (!ALIGN_EPI) { if (wr == 0) PG8_BAR; }
    PG8_BAR;
    if constexpr (Epi::AFTER_DRAIN) { E.fused(acc, cur, wr, wc, fr, fq, lds, wid, lane); S.done(cur); }
#undef PG8_SA
#undef PG8_SB
#undef PG8_STAGE
#undef PG8_LDA
#undef PG8_LDB
#undef PG8_MMA
#undef PG8_WAIT_V
#undef PG8_WAIT_L
#undef PG8_BAR
#undef PG8_SCHED
}
}


DEVINL u32x4 pack8(const f32x4& a, const f32x4& b) { u32x4 w; w.x = cvt2(a[0], a[1]); w.y = cvt2(a[2], a[3]); w.z = cvt2(b[0], b[1]); w.w = cvt2(b[2], b[3]); return w; }
DEVINL float row_rscale(const float* ssq, int t, int fq) { const f32x4 a = *(const f32x4*)(ssq + (size_t)t * 16 + 4 * fq); return rsqrtf(quad_sum(a[0] + a[1] + a[2] + a[3]) * (1.0f / DM) + EPS); }
#define EPI_ROW(i) (u.pm * 256 + 128 * ((i) >> 2) + 64 * wr + 16 * ((i) & 3) + fr)
struct EpiIn8 {
    static constexpr bool PERM = true, AFTER_DRAIN = false;
    Params P; int l;
    DEVINL void operator()(const f32x4 (&acc0)[2][2][4][2], const pg8::Unit& u, int wr, int wc, int fr, int fq) const {
        { const int t_ = ltid(); fr = t_ & 15; fq = (t_ >> 4) & 3; wc = __builtin_amdgcn_readfirstlane((t_ >> 6) & 3); wr = __builtin_amdgcn_readfirstlane(t_ >> 8); }
        char* ws = P.ws; char* ob = (char*)P.out; const int chunk = u.pn * 4 + wc;
        const float* ssqx = (const float*)(ws + OFF_SSQX);
        float rt8[8];
        { f32x4 sq[8];
#pragma unroll
          for (int i = 0; i < 8; ++i) sq[i] = *(const f32x4*)(ssqx + (size_t)EPI_ROW(i) * 16 + 4 * fq);
#pragma unroll
          for (int i = 0; i < 8; ++i) rt8[i] = rsqrtf(quad_sum(sq[i][0] + sq[i][1] + sq[i][2] + sq[i][3]) * (1.0f / DM) + EPS); }
        if (chunk < 36) {
            const int g = chunk >> 2, h = chunk & 3, role = g % 3, mix = g / 3;
            bf16_t* dst = (bf16_t*)(ws + OFF_QKV + (size_t)g * SZ_HEADBUF);
            const float* gain = P.qk_gain + ((size_t)l * 6 + 2 * mix + (role == 1 ? 1 : 0)) * 64 + 8 * fq;
            f32x4 gg[2][2];
#pragma unroll
            for (int bj = 0; bj < 2; ++bj)
#pragma unroll
                for (int n = 0; n < 2; ++n) gg[bj][n] = role != 2 ? *(const f32x4*)(gain + 32 * bj + 4 * n) : (f32x4){1.f, 1.f, 1.f, 1.f};
#pragma unroll
            for (int ai = 0; ai < 2; ++ai)
#pragma unroll
                for (int m = 0; m < 4; ++m) {
                    const int t = u.pm * 256 + 128 * ai + 64 * wr + 16 * m + fr, b = t >> 12, s = t & 4095; const float rt_ = rt8[ai * 4 + m]; const f32x4 a[2][2] = {{acc0[ai][0][m][0] * rt_, acc0[ai][0][m][1] * rt_}, {acc0[ai][1][m][0] * rt_, acc0[ai][1][m][1] * rt_}}; bf16_t* d = dst + ((size_t)(b * 4 + h) * SEQ + s) * 64 + 8 * fq;
                    float r = 1.f;
                    if (role != 2) { float ss = sq4(a[0][0]) + sq4(a[0][1]) + sq4(a[1][0]) + sq4(a[1][1]); ss = quad_sum(ss); r = rsqrtf(ss * (1.0f / 64.0f) + EPS) * (role == 0 ? SC_Q : 1.0f); }
#pragma unroll
                    for (int bj = 0; bj < 2; ++bj) *(u32x4*)(d + 32 * bj) = pack8(a[bj][0] * r * gg[bj][0], a[bj][1] * r * gg[bj][1]);
                }
        } else if (chunk < 42) {
            const bool isq = chunk < 40; const int c = isq ? chunk - 36 : chunk - 40;
            bf16_t* dst = isq ? (bf16_t*)(ws + OFF_CQ) : (bf16_t*)(ws + OFF_CKV); const int ld = 256;
            float* ssp = isq ? (float*)(ws + OFF_CQSS) : (float*)(ws + OFF_CKVSS); const int nss = isq ? 4 : 2;
#pragma unroll
            for (int ai = 0; ai < 2; ++ai)
#pragma unroll
                for (int m = 0; m < 4; ++m) {
                    const int t = u.pm * 256 + 128 * ai + 64 * wr + 16 * m + fr; const float rt_ = rt8[ai * 4 + m]; const f32x4 a[2][2] = {{acc0[ai][0][m][0] * rt_, acc0[ai][0][m][1] * rt_}, {acc0[ai][1][m][0] * rt_, acc0[ai][1][m][1] * rt_}};
                    float ss = sq4(a[0][0]) + sq4(a[0][1]) + sq4(a[1][0]) + sq4(a[1][1]); ss = quad_sum(ss);
#pragma unroll
                    for (int bj = 0; bj < 2; ++bj) *(u32x4*)(dst + (size_t)t * ld + c * 64 + 32 * bj + 8 * fq) = pack8(a[bj][0], a[bj][1]);
                    if (fq == 0) ssp[(size_t)t * nss + c] = ss;
                }
        } else if (chunk == 42) {
            const float* gr = P.mla_rope_gain + ((size_t)l * 2 + 1) * 32; const float2* rope = (const float2*)(ws + OFF_ROPE);
            bf16_t* kr = (bf16_t*)(ws + OFF_KR); float* logf_ = (float*)(ws + OFF_LOGF);
            const f32x4 g1 = *(const f32x4*)(gr + 4 * fq), g2 = *(const f32x4*)(gr + 16 + 4 * fq); const f32x4 bfv = *(const f32x4*)(P.b_forget + l * 4);
#pragma unroll
            for (int ai = 0; ai < 2; ++ai) {
                f32x4 cs4[4][2];
#pragma unroll
                for (int m = 0; m < 4; ++m) { const f32x4* rp = (const f32x4*)(rope + (EPI_ROW(ai * 4 + m) & 4095) * 16 + 4 * fq); cs4[m][0] = rp[0]; cs4[m][1] = rp[1]; }
#pragma unroll
                for (int m = 0; m < 4; ++m) {
                    const int t = u.pm * 256 + 128 * ai + 64 * wr + 16 * m + fr, b = t >> 12, s = t & 4095; const float rt_ = rt8[ai * 4 + m]; const f32x4 a[2][2] = {{acc0[ai][0][m][0] * rt_, acc0[ai][0][m][1] * rt_}, {acc0[ai][1][m][0] * rt_, acc0[ai][1][m][1] * rt_}};
                    float ss = sq4(a[0][0]) + sq4(a[0][1]); ss = quad_sum(ss); const float r = rsqrtf(ss * (1.0f / 32.0f) + EPS);
                    float o1[4], o2[4];
#pragma unroll
                    for (int j = 0; j < 4; ++j) { const float cx = cs4[m][j >> 1][2 * (j & 1)], sy = cs4[m][j >> 1][2 * (j & 1) + 1]; const float x1 = a[0][0][j] * r * g1[j], x2 = a[0][1][j] * r * g2[j]; o1[j] = x1 * cx - x2 * sy; o2[j] = x1 * sy + x2 * cx; }
                    {
                      const unsigned p1x = cvt2(o1[0], o1[1]), p1y = cvt2(o1[2], o1[3]), p2x = cvt2(o2[0], o2[1]), p2y = cvt2(o2[2], o2[3]); const bool odd = (fq & 1) != 0;
                      const unsigned rx = (unsigned)__builtin_amdgcn_ds_swizzle((int)(odd ? p1x : p2x), (16 << 10) | 0x1F), ry = (unsigned)__builtin_amdgcn_ds_swizzle((int)(odd ? p1y : p2y), (16 << 10) | 0x1F);
                      const u32x4 w = odd ? (u32x4){rx, ry, p2x, p2y} : (u32x4){p1x, p1y, rx, ry};
                      *(u32x4*)(kr + ((size_t)b * SEQ + s) * 32 + (odd ? 16 + 4 * (fq - 1) : 4 * fq)) = w; }
                    if (fq == 0) {
#pragma unroll
                        for (int j = 0; j < 4; ++j) logf_[(size_t)(b * 4 + j) * SEQ + s] = log_sigmoid(a[1][0][j] + bfv[j]) * LOG2E;
                    }
                } }
        } else if (chunk >= 44) {
            bf16_t* G = (bf16_t*)(ob + OOFF_G); const int c0 = (chunk - 44) * 64 + 8 * fq;
#pragma unroll
            for (int ai = 0; ai < 2; ++ai)
#pragma unroll
                for (int m = 0; m < 4; ++m) {
                    const int t = u.pm * 256 + 128 * ai + 64 * wr + 16 * m + fr; const float rt_ = rt8[ai * 4 + m]; const f32x4 a[2][2] = {{acc0[ai][0][m][0] * rt_, acc0[ai][0][m][1] * rt_}, {acc0[ai][1][m][0] * rt_, acc0[ai][1][m][1] * rt_}};
#pragma unroll
                    for (int bj = 0; bj < 2; ++bj) { f32x4 o0, o1;
#pragma unroll
                        for (int j = 0; j < 4; ++j) { const float z0 = a[bj][0][j], z1 = a[bj][1][j]; o0[j] = z0 * fsigmoid(z0); o1[j] = z1 * fsigmoid(z1); }
                        *(u32x4*)(G + (size_t)t * DM + c0 + 32 * bj) = pack8(o0, o1); }
                }
        }
    }
};
struct EpiResid8 { static constexpr bool PERM = true, AFTER_DRAIN = false; const float* base; const bf16_t* bbase; bf16_t* obf; float* ssq;
    DEVINL void operator()(const f32x4 (&acc)[2][2][4][2], const pg8::Unit& u, int wr, int wc, int fr, int fq) const {
        { const int t_ = ltid(); fr = t_ & 15; fq = (t_ >> 4) & 3; wc = __builtin_amdgcn_readfirstlane((t_ >> 6) & 3); wr = __builtin_amdgcn_readfirstlane(t_ >> 8); }
        const size_t cb = (size_t)u.pn * 256 + 64 * wc + 8 * fq;
        if (bbase) {
            u32x4 bw[8][2];
#pragma unroll
            for (int i = 0; i < 8; ++i)
#pragma unroll
                for (int bj = 0; bj < 2; ++bj) bw[i][bj] = *(const u32x4*)(bbase + (size_t)EPI_ROW(i) * DM + cb + 32 * bj);
#pragma unroll
            for (int i = 0; i < 8; ++i) { const int t = EPI_ROW(i); const size_t o = (size_t)t * DM + cb; float ss = 0.f;
#pragma unroll
                for (int bj = 0; bj < 2; ++bj) { const u32x4 w = bw[i][bj];
                    const f32x4 v0 = (f32x4){bflo(w.x), bfhi(w.x), bflo(w.y), bfhi(w.y)} + acc[i >> 2][bj][i & 3][0], v1 = (f32x4){bflo(w.z), bfhi(w.z), bflo(w.w), bfhi(w.w)} + acc[i >> 2][bj][i & 3][1];
                    *(u32x4*)(obf + o + 32 * bj) = pack8(v0, v1); ss += sq4(v0) + sq4(v1); }
                ss = quad_sum(ss); if (fq == 0) ssq[(size_t)t * 16 + u.pn * 4 + wc] = ss; }
        } else {
#pragma unroll
            for (int ai = 0; ai < 2; ++ai) {
                f32x4 bv[4][2][2];
#pragma unroll
                for (int m = 0; m < 4; ++m)
#pragma unroll
                    for (int bj = 0; bj < 2; ++bj) { const float* bp = base + (size_t)EPI_ROW(ai * 4 + m) * DM + cb + 32 * bj; bv[m][bj][0] = __builtin_nontemporal_load((const f32x4*)bp); bv[m][bj][1] = __builtin_nontemporal_load((const f32x4*)(bp + 4)); }
#pragma unroll
                for (int m = 0; m < 4; ++m) { const int t = EPI_ROW(ai * 4 + m); const size_t o = (size_t)t * DM + cb; float ss = 0.f;
#pragma unroll
                    for (int bj = 0; bj < 2; ++bj) { const f32x4 v0 = bv[m][bj][0] + acc[ai][bj][m][0], v1 = bv[m][bj][1] + acc[ai][bj][m][1];
                        *(u32x4*)(obf + o + 32 * bj) = pack8(v0, v1); ss += sq4(v0) + sq4(v1); }
                    ss = quad_sum(ss); if (fq == 0) ssq[(size_t)t * 16 + u.pn * 4 + wc] = ss; } }
        } } };
struct EpiStoreBf { static constexpr bool PERM = true, AFTER_DRAIN = false; bf16_t* out;
    DEVINL void operator()(const f32x4 (&acc)[2][2][4][2], const pg8::Unit& u, int wr, int wc, int fr, int fq) const {
        { const int t_ = ltid(); fr = t_ & 15; fq = (t_ >> 4) & 3; wc = __builtin_amdgcn_readfirstlane((t_ >> 6) & 3); wr = __builtin_amdgcn_readfirstlane(t_ >> 8); }
#pragma unroll
        for (int ai = 0; ai < 2; ++ai)
#pragma unroll
            for (int m = 0; m < 4; ++m) { const size_t o = (size_t)(u.pm * 256 + 128 * ai + 64 * wr + 16 * m + fr) * DM + u.pn * 256 + 64 * wc + 8 * fq;
#pragma unroll
                for (int bj = 0; bj < 2; ++bj) *(u32x4*)(out + o + 32 * bj) = pack8(acc[ai][bj][m][0], acc[ai][bj][m][1]); } } };
struct EpiPle8 { static constexpr bool PERM = true, AFTER_DRAIN = false; const bf16_t* xa; const bf16_t* pp; float* out; const float* ssq_in; bf16_t* obf; float* ssq_out;
    DEVINL void operator()(const f32x4 (&acc)[2][2][4][2], const pg8::Unit& u, int wr, int wc, int fr, int fq) const {
        { const int t_ = ltid(); fr = t_ & 15; fq = (t_ >> 4) & 3; wc = __builtin_amdgcn_readfirstlane((t_ >> 6) & 3); wr = __builtin_amdgcn_readfirstlane(t_ >> 8); }
        const size_t cb = (size_t)u.pn * 256 + 64 * wc + 8 * fq;
        float rt8[8];
        { f32x4 sq[8];
#pragma unroll
          for (int i = 0; i < 8; ++i) sq[i] = *(const f32x4*)(ssq_in + (size_t)EPI_ROW(i) * 16 + 4 * fq);
#pragma unroll
          for (int i = 0; i < 8; ++i) rt8[i] = rsqrtf(quad_sum(sq[i][0] + sq[i][1] + sq[i][2] + sq[i][3]) * (1.0f / DM) + EPS); }
#pragma unroll
        for (int qi = 0; qi < 4; ++qi) {
            const int ai = qi >> 1; u32x4 xw[4][2], pw[4][2];
#pragma unroll
            for (int m = 2 * (qi & 1); m < 2 * (qi & 1) + 2; ++m)
#pragma unroll
                for (int bj = 0; bj < 2; ++bj) { const size_t o = (size_t)EPI_ROW(ai * 4 + m) * DM + cb + 32 * bj; xw[m][bj] = *(const u32x4*)(xa + o); pw[m][bj] = *(const u32x4*)(pp + o); }
#pragma unroll
            for (int m = 2 * (qi & 1); m < 2 * (qi & 1) + 2; ++m) { const int t = EPI_ROW(ai * 4 + m); const size_t o = (size_t)t * DM + cb;
                const float rt = rt8[ai * 4 + m]; float ss = 0.f;
#pragma unroll
                for (int bj = 0; bj < 2; ++bj) { const u32x4 xv = xw[m][bj], pq = pw[m][bj]; const f32x4 x0 = (f32x4){bflo(xv.x), bfhi(xv.x), bflo(xv.y), bfhi(xv.y)}, x1 = (f32x4){bflo(xv.z), bfhi(xv.z), bflo(xv.w), bfhi(xv.w)}; f32x4 r0, r1;
                    const float pv[8] = {bflo(pq.x), bfhi(pq.x), bflo(pq.y), bfhi(pq.y), bflo(pq.z), bfhi(pq.z), bflo(pq.w), bfhi(pq.w)};
#pragma unroll
                    for (int jj = 0; jj < 4; ++jj) { r0[jj] = x0[jj] + pv[jj] * fsigmoid(rt * acc[ai][bj][m][0][jj]); r1[jj] = x1[jj] + pv[4 + jj] * fsigmoid(rt * acc[ai][bj][m][1][jj]); }
                    if (out) { __builtin_nontemporal_store(r0, (f32x4*)(out + o + 32 * bj)); __builtin_nontemporal_store(r1, (f32x4*)(out + o + 32 * bj + 4)); }
                    if (obf) { *(u32x4*)(obf + o + 32 * bj) = pack8(r0, r1); ss += sq4(r0) + sq4(r1); } }
                if (obf) { ss = quad_sum(ss); if (fq == 0) ssq_out[(size_t)t * 16 + u.pn * 4 + wc] = ss; } } } } };
struct EpiUq8 { static constexpr bool PERM = true, AFTER_DRAIN = false; Params P; int l;
    DEVINL void operator()(const f32x4 (&acc)[2][2][4][2], const pg8::Unit& u, int wr, int wc, int fr, int fq) const {
        { const int t_ = ltid(); fr = t_ & 15; fq = (t_ >> 4) & 3; wc = __builtin_amdgcn_readfirstlane((t_ >> 6) & 3); wr = __builtin_amdgcn_readfirstlane(t_ >> 8); }
        const int chunk = u.pn * 4 + wc; if (chunk >= 6) return;
        const float* cqss = (const float*)(P.ws + OFF_CQSS); bf16_t* qm = (bf16_t*)((char*)P.out + OOFF_QM); const float2* rope = (const float2*)(P.ws + OFF_ROPE);
        float rt8[8];
        { float sq[8];
#pragma unroll
          for (int i = 0; i < 8; ++i) sq[i] = cqss[(size_t)EPI_ROW(i) * 4 + fq];
#pragma unroll
          for (int i = 0; i < 8; ++i) rt8[i] = rsqrtf(quad_sum(sq[i]) * (1.0f / 256.0f) + EPS); }
        if (chunk < 4) {
            const float* gain = P.mla_nope_gain + ((size_t)l * 2 + 0) * 64 + 8 * fq;
            f32x4 gg[2][2];
#pragma unroll
            for (int bj = 0; bj < 2; ++bj) { gg[bj][0] = *(const f32x4*)(gain + 32 * bj); gg[bj][1] = *(const f32x4*)(gain + 32 * bj + 4); }
#pragma unroll
            for (int i = 0; i < 8; ++i) { const int ai = i >> 2, m = i & 3, t = EPI_ROW(i), b = t >> 12, s = t & 4095; const float rt = rt8[i];
                const f32x4 a[2][2] = {{acc[ai][0][m][0] * rt, acc[ai][0][m][1] * rt}, {acc[ai][1][m][0] * rt, acc[ai][1][m][1] * rt}};
                float ss = sq4(a[0][0]) + sq4(a[0][1]) + sq4(a[1][0]) + sq4(a[1][1]); ss = quad_sum(ss); const float r = rsqrtf(ss * (1.0f / 64.0f) + EPS) * SC_MLA;
                bf16_t* d = qm + ((size_t)(b * 4 + chunk) * SEQ + s) * 96 + 8 * fq;
#pragma unroll
                for (int bj = 0; bj < 2; ++bj) *(u32x4*)(d + 32 * bj) = pack8(a[bj][0] * r * gg[bj][0], a[bj][1] * r * gg[bj][1]); }
        } else {
            const float* gr = P.mla_rope_gain + ((size_t)l * 2 + 0) * 32; const f32x4 g1 = *(const f32x4*)(gr + 4 * fq), g2 = *(const f32x4*)(gr + 16 + 4 * fq);
#pragma unroll
            for (int hf = 0; hf < 2; ++hf) {
            f32x4 cs4[4][2];
#pragma unroll
            for (int m = 0; m < 4; ++m) { const f32x4* rp = (const f32x4*)(rope + (EPI_ROW(hf * 4 + m) & 4095) * 16 + 4 * fq); cs4[m][0] = rp[0]; cs4[m][1] = rp[1]; }
#pragma unroll
            for (int i = hf * 4; i < hf * 4 + 4; ++i) { const int ai = i >> 2, m = i & 3, t = EPI_ROW(i), b = t >> 12, s = t & 4095; const float rt = rt8[i];
                const f32x4 a[2][2] = {{acc[ai][0][m][0] * rt, acc[ai][0][m][1] * rt}, {acc[ai][1][m][0] * rt, acc[ai][1][m][1] * rt}};
#pragma unroll
                for (int bj = 0; bj < 2; ++bj) { const int h = (chunk - 4) * 2 + bj;
                    float ss = sq4(a[bj][0]) + sq4(a[bj][1]); ss = quad_sum(ss); const float r = rsqrtf(ss * (1.0f / 32.0f) + EPS);
                    float o1[4], o2[4];
#pragma unroll
                    for (int j = 0; j < 4; ++j) { const float cx = cs4[m][j >> 1][2 * (j & 1)], sy = cs4[m][j >> 1][2 * (j & 1) + 1]; const float x1 = a[bj][0][j] * r * g1[j], x2 = a[bj][1][j] * r * g2[j]; o1[j] = (x1 * cx - x2 * sy) * SC_MLA; o2[j] = (x1 * sy + x2 * cx) * SC_MLA; }
                    {
                      const unsigned p1x = cvt2(o1[0], o1[1]), p1y = cvt2(o1[2], o1[3]), p2x = cvt2(o2[0], o2[1]), p2y = cvt2(o2[2], o2[3]); const bool odd = (fq & 1) != 0;
                      const unsigned rx = (unsigned)__builtin_amdgcn_ds_swizzle((int)(odd ? p1x : p2x), (16 << 10) | 0x1F), ry = (unsigned)__builtin_amdgcn_ds_swizzle((int)(odd ? p1y : p2y), (16 << 10) | 0x1F);
                      const u32x4 w = odd ? (u32x4){rx, ry, p2x, p2y} : (u32x4){p1x, p1y, rx, ry};
                      *(u32x4*)(qm + ((size_t)(b * 4 + h) * SEQ + s) * 96 + 64 + (odd ? 16 + 4 * (fq - 1) : 4 * fq)) = w; } } } }
        }
    }
};
struct EpiUkv8 { static constexpr bool PERM = true, AFTER_DRAIN = false; Params P; int l;
    DEVINL void operator()(const f32x4 (&acc)[2][2][4][2], const pg8::Unit& u, int wr, int wc, int fr, int fq) const {
        { const int t_ = ltid(); fr = t_ & 15; fq = (t_ >> 4) & 3; wc = __builtin_amdgcn_readfirstlane((t_ >> 6) & 3); wr = __builtin_amdgcn_readfirstlane(t_ >> 8); }
        const int chunk = u.pn * 4 + wc, h = chunk >> 1; const bool isk = (chunk & 1) == 0;
        const float* ckvss = (const float*)(P.ws + OFF_CKVSS); bf16_t* km = (bf16_t*)((char*)P.out + OOFF_KM); bf16_t* vm = (bf16_t*)((char*)P.out + OOFF_VM);
        const float* gain = P.mla_nope_gain + ((size_t)l * 2 + 1) * 64 + 8 * fq;
        float rt8[8];
        { float sq[8];
#pragma unroll
          for (int i = 0; i < 8; ++i) sq[i] = fq < 2 ? ckvss[(size_t)EPI_ROW(i) * 2 + fq] : 0.f;
#pragma unroll
          for (int i = 0; i < 8; ++i) rt8[i] = rsqrtf(quad_sum(sq[i]) * (1.0f / 128.0f) + EPS); }
        f32x4 gg[2][2];
#pragma unroll
        for (int bj = 0; bj < 2; ++bj) { gg[bj][0] = *(const f32x4*)(gain + 32 * bj); gg[bj][1] = *(const f32x4*)(gain + 32 * bj + 4); }
#pragma unroll
        for (int i = 0; i < 8; ++i) { const int ai = i >> 2, m = i & 3, t = EPI_ROW(i), b = t >> 12, s = t & 4095; const float rt = rt8[i];
            const f32x4 a[2][2] = {{acc[ai][0][m][0] * rt, acc[ai][0][m][1] * rt}, {acc[ai][1][m][0] * rt, acc[ai][1][m][1] * rt}};
            if (isk) { float ss = sq4(a[0][0]) + sq4(a[0][1]) + sq4(a[1][0]) + sq4(a[1][1]); ss = quad_sum(ss); const float r = rsqrtf(ss * (1.0f / 64.0f) + EPS);
                bf16_t* d = km + ((size_t)(b * 4 + h) * SEQ + s) * 96 + 8 * fq;
#pragma unroll
                for (int bj = 0; bj < 2; ++bj) *(u32x4*)(d + 32 * bj) = pack8(a[bj][0] * r * gg[bj][0], a[bj][1] * r * gg[bj][1]);
            } else { bf16_t* d = vm + ((size_t)(b * 4 + h) * SEQ + s) * 64 + 8 * fq;
#pragma unroll
                for (int bj = 0; bj < 2; ++bj) *(u32x4*)(d + 32 * bj) = pack8(a[bj][0], a[bj][1]); }
        }
    }
};
template <class Epi> DEVINL void gemm8(const bf16_t* A, const bf16_t* Bt, int M, int N, int K, const Epi& E, char* smem) {
    int G = (int)gridDim.x, c = (int)blockIdx.x; asm volatile("" : "+s"(G), "+s"(c));
    pg8::Gemm g{A, Bt, M, N, K}; pg8::StaticOrder S; S.init(M, N, G, c);
    pg8::gemm_phase<Epi, pg8::StaticOrder, true, true>((PG8_LAS unsigned char*)smem, g, S, E);
}

DEVINL void kmean_unit(const Params& P, int u, char* smem) {
    float* red = (float*)smem; const bf16_t* K = (const bf16_t*)(P.ws + OFF_QKV + 4 * SZ_HEADBUF); float* km = (float*)(P.ws + OFF_KMEAN);
    const int tid = ltid(), dc = tid & 7, rg = tid >> 3;
    const bf16_t* kp = K + ((size_t)(u >> 4) * SEQ + (u & 15) * 256 + rg) * 64 + dc * 8;
    u32x4 w[4];
#pragma unroll
    for (int i = 0; i < 4; ++i) w[i] = *(const u32x4*)(kp + (size_t)i * 64 * 64);
    float s[8] = {0.f, 0.f, 0.f, 0.f, 0.f, 0.f, 0.f, 0.f};
#pragma unroll
    for (int i = 0; i < 4; ++i) { s[0] += bflo(w[i].x); s[1] += bfhi(w[i].x); s[2] += bflo(w[i].y); s[3] += bfhi(w[i].y); s[4] += bflo(w[i].z); s[5] += bfhi(w[i].z); s[6] += bflo(w[i].w); s[7] += bfhi(w[i].w); }
    __syncthreads();
#pragma unroll
    for (int e = 0; e < 8; ++e) red[rg * 65 + dc * 8 + e] = s[e];
    __syncthreads();
    if (tid < 64) { float a = 0.f;
#pragma unroll 8
        for (int i = 0; i < 64; ++i) a += red[i * 65 + tid];
        km[(size_t)u * 64 + tid] = a * (1.0f / 256.0f); }
}

typedef float f32x16 __attribute__((ext_vector_type(16)));
typedef short s16x4 __attribute__((ext_vector_type(4)));
typedef short v4i16_t __attribute__((ext_vector_type(4)));
#define LAS __attribute__((address_space(3)))
#define MFMA32(a, b, c) __builtin_amdgcn_mfma_f32_32x32x16_bf16(a, b, c, 0, 0, 0)
DEVINL s16x4 vtr(const LAS char* p) { return __builtin_bit_cast(s16x4, __builtin_amdgcn_ds_read_tr16_b64_v4i16((LAS v4i16_t*)p)); }
DEVINL float swap_max(float v) { auto rr = __builtin_amdgcn_permlane32_swap(__float_as_uint(v), __float_as_uint(v), false, false); return fmaxf(__uint_as_float(rr[0]), __uint_as_float(rr[1])); }
DEVINL float swap_sum(float v) { auto rr = __builtin_amdgcn_permlane32_swap(__float_as_uint(v), __float_as_uint(v), false, false); return __uint_as_float(rr[0]) + __uint_as_float(rr[1]); }
DEVINL void half_xchg(unsigned& a, unsigned& b) { auto rr = __builtin_amdgcn_permlane32_swap(a, b, false, false); a = rr[0]; b = rr[1]; }
DEVINL float fadd1(float a, float b) { float r; asm("v_add_f32 %0, %1, %2" : "=v"(r) : "v"(a), "v"(b)); return r; }
DEVINL constexpr int crow(int r) { return (r & 3) + 8 * (r >> 2); }

constexpr int KSLOT = 64 * 144, RSLOT = 64 * 80;
constexpr int L_KB = 0, L_VB = 3 * KSLOT, L_KR = L_VB + 16384, L_AUX = L_KR + 3 * RSLOT, L_SCR = L_AUX + 16640 + 256, L_KMS = L_SCR + 2048, L_ATT_END = L_KMS + 4096;
constexpr float NEGBIG = -3.0e38f, THR = 8.0f;

template <int MODE>
DEVINL void attn_unit(const Params& P, int l, int u, char* smem) {
    constexpr int DK = MODE == 2 ? 96 : 64, ND0 = DK / 16;
    LAS char* lds = (LAS char*)smem;
    const int tid = ltid(), lane = tid & 63, r32 = lane & 31, hi = lane >> 5; const int wid = __builtin_amdgcn_readfirstlane(tid >> 6);
    const bool fast = ((const float*)(P.ws + OFF_BOUND))[l * 4 + MODE] < 100.0f;
    int bh, q0, t_lo, t_hi, dil = 1, res = 0, pat = 0, qb = 0;
    if (MODE != 3) { bh = u & 15; qb = 15 - (u >> 4); q0 = qb * 256; t_lo = 0; t_hi = (q0 + 255) >> 6; }
    else { pat = u >> 8; const int v = u & 255; bh = v & 15; const int w = v >> 4; dil = pat == 0 ? 1 : (pat == 1 ? 4 : 16); res = w % dil; q0 = (w / dil) * 256; t_lo = (q0 >= 128 ? q0 - 128 : 0) >> 6; t_hi = (q0 + 255) >> 6; }
    const int b = bh >> 2, h = bh & 3;
    const bf16_t *Qg, *Kg, *Vg; int rsq, rsk, rsv;
    if (MODE == 0) { Qg = (const bf16_t*)(P.ws + OFF_QKV) + (size_t)bh * SEQ * 64; Kg = Qg + SZ_HEADBUF / 2; Vg = Kg + SZ_HEADBUF / 2; rsq = rsk = rsv = 64; }
    else if (MODE == 1) { Qg = (const bf16_t*)(P.ws + OFF_QKV + 3 * SZ_HEADBUF) + (size_t)bh * SEQ * 64; Kg = Qg + SZ_HEADBUF / 2; Vg = Kg + SZ_HEADBUF / 2; rsq = rsk = rsv = 64; }
    else if (MODE == 2) { Qg = (const bf16_t*)((const char*)P.out + OOFF_QM) + (size_t)bh * SEQ * 96; Kg = (const bf16_t*)((const char*)P.out + OOFF_KM) + (size_t)bh * SEQ * 96; Vg = (const bf16_t*)((const char*)P.out + OOFF_VM) + (size_t)bh * SEQ * 64; rsq = rsk = 96; rsv = 64; }
    else { Qg = (const bf16_t*)(P.ws + OFF_QKV + 6 * SZ_HEADBUF) + ((size_t)bh * SEQ + res) * 64; Kg = Qg + SZ_HEADBUF / 2; Vg = Kg + SZ_HEADBUF / 2; rsq = rsk = rsv = 64 * dil; }
    const int qw = q0 + 32 * wid;
    const bf16_t* KRg = (const bf16_t*)(P.ws + OFF_KR) + (size_t)b * SEQ * 32;

    __syncthreads();
    const unsigned kgo = (unsigned)((tid >> 3) * rsk + (tid & 7) * 8), vgo = (unsigned)(((tid >> 2) & 63) * rsv + (tid >> 8) * 32 + (tid & 3) * 8), rgo = (unsigned)(((tid >> 2) & 63) * 32 + (tid & 3) * 8);
    const int kws = (tid >> 3) * 144 + (tid & 7) * 16;
    const int rws = ((tid >> 2) & 63) * 80 + (tid & 3) * 16;
    u32x4 kA, rA, kB, rB;
#define ATT_LOADK(j, K_, R_) do { if ((j) <= t_hi) { K_ = *(const u32x4*)(Kg + (size_t)(j) * 64 * rsk + kgo); if (MODE == 2 && tid < 256) R_ = *(const u32x4*)(KRg + (size_t)(j) * 64 * 32 + rgo); } } while (0)
#define ATT_DMAV(j, slot) do { if ((j) <= t_hi) __builtin_amdgcn_global_load_lds((const unsigned*)(Vg + (size_t)(j) * 64 * rsv + vgo), (LAS unsigned*)(lds + L_VB + (slot) * 8192 + wid * 1024), 16, 0, 0); } while (0)
#define ATT_WRITEK(slot, j, K_, R_) do { if ((j) <= t_hi) { *(LAS u32x4*)(lds + L_KB + (slot) * KSLOT + kws) = K_; if (MODE == 2 && tid < 256) *(LAS u32x4*)(lds + L_KR + (slot) * RSLOT + rws) = R_; \
        if (MODE == 0 && tid < 64) { const float bs = aux[(j) * 64 + tid] - auxU; const unsigned hb = cvt2(bs, 0.f) & 0xffffu; const float lo = bs - __uint_as_float(hb << 16); u32x4 w; w.x = hb | (cvt2(lo, 0.f) << 16); w.y = 0x3F80u; w.z = 0u; w.w = 0u; \
            *(LAS u32x4*)(lds + L_KR + (slot) * 1024 + tid * 16) = w; } } } while (0)
    bf16x8 qf[ND0];
    { const bf16_t* qp = Qg + (size_t)(qw + r32) * rsq + 8 * hi;
#pragma unroll
      for (int d0 = 0; d0 < ND0; ++d0) qf[d0] = *(const bf16x8*)(qp + 16 * d0); }
    if (MODE != 0) { ATT_LOADK(t_lo, kA, rA); ATT_LOADK(t_lo + 1, kB, rB); }
    LAS float* aux = (LAS float*)(lds + L_AUX);
    if (MODE == 0) {
        LAS float* tot = (LAS float*)(lds + L_SCR);
        const float* lf = (const float*)(P.ws + OFF_LOGF) + (size_t)bh * SEQ + tid * 8; float v[8]; float run = 0.f;
        { const f32x4 a = *(const f32x4*)lf, c = *(const f32x4*)(lf + 4); v[0] = a[0]; v[1] = a[1]; v[2] = a[2]; v[3] = a[3]; v[4] = c[0]; v[5] = c[1]; v[6] = c[2]; v[7] = c[3]; }
#pragma unroll
        for (int i = 0; i < 8; ++i) { run += v[i]; v[i] = run; }
        tot[tid] = run; __syncthreads();
        if (tid < 64) { float a[8]; float acc = 0.f;
#pragma unroll
            for (int i = 0; i < 8; ++i) { acc += tot[tid * 8 + i]; a[i] = acc; }
            float incl = acc;
#pragma unroll
            for (int o = 1; o < 64; o <<= 1) { const float nb = shup(incl, o); if (tid >= o) incl += nb; }
            const float ex = incl - acc; tot[tid * 8] = ex;
#pragma unroll
            for (int i = 1; i < 8; ++i) tot[tid * 8 + i] = ex + a[i - 1]; }
        __syncthreads();
        const float base = tot[tid];
#pragma unroll
        for (int i = 0; i < 8; ++i) aux[tid * 8 + i] = -(base + v[i]);
        if (tid < 4) ((LAS unsigned*)(lds + L_KR + 3072))[tid] = 0u;
    } else if (MODE == 1) {
        const float* lut = (const float*)(P.ws + OFF_LUT) + (size_t)h * 4096;
        for (int i = ((4095 - (q0 + 255)) & ~3) + 4 * tid; i < 4160; i += 4 * NTHREADS) {
            f32x4 v = (f32x4){0.f, 0.f, 0.f, 0.f}; if (i < 4096) { const f32x4 s = *(const f32x4*)(lut + 4092 - i); v = (f32x4){s[3], s[2], s[1], s[0]}; }
            *(LAS f32x4*)(aux + i) = v; }
        if (tid < 64) aux[4160 + tid] = -INFINITY;
        LAS float* kms = (LAS float*)(lds + L_KMS); const float* km = (const float*)(P.ws + OFF_KMEAN) + (size_t)bh * 1024;
        for (int i = tid; i < 1024; i += NTHREADS) kms[i] = km[i];
    } else if (MODE == 3) {
        const float* lut = (const float*)(P.ws + OFF_LUT) + (size_t)(4 + h) * 4096;
        if (tid < 320) { const int rel = 255 - tid; aux[tid] = (rel >= 0 && rel * dil < 4096) ? lut[rel * dil] : 0.f; }
    }
    if (MODE == 0 && fast) {
        __syncthreads();
        const float bnd = ((const float*)(P.ws + OFF_BOUND))[l * 4 + (tid >> 30)];
        const bool sk = (lane <= t_hi) && ((aux[64 * lane + 63] - aux[q0]) + bnd < -150.0f);
        t_lo = (int)__builtin_popcountll(__ballot(sk));
    }
    __syncthreads();
    bf16x8 qx = {0, 0, 0, 0, 0, 0, 0, 0}; float auxU = 0.f;
    if (MODE == 0) { auxU = aux[q0 + 255]; const float sh = auxU - aux[qw + r32];
        if (hi == 0) { u32x4 w; w.x = 0x3F803F80u; w.y = cvt2(sh, 0.f); w.z = 0u; w.w = 0u; qx = __builtin_bit_cast(bf16x8, w); } }
    unsigned sel = 0;
    if (MODE == 1) {
        const LAS float* kms = (const LAS float*)(lds + L_KMS); float gt[15];
#pragma unroll
        for (int n = 0; n < 15; ++n) { float s = 0.f;
            if (n < qb) {
#pragma unroll
                for (int d0 = 0; d0 < 4; ++d0) { const f32x4 ka = *(const LAS f32x4*)(kms + n * 64 + 16 * d0 + 8 * hi), kb = *(const LAS f32x4*)(kms + n * 64 + 16 * d0 + 8 * hi + 4);
                    const u32x4 w = __builtin_bit_cast(u32x4, qf[d0]);
                    s += bflo(w.x) * ka[0] + bfhi(w.x) * ka[1] + bflo(w.y) * ka[2] + bfhi(w.y) * ka[3] + bflo(w.z) * kb[0] + bfhi(w.z) * kb[1] + bflo(w.w) * kb[2] + bfhi(w.w) * kb[3]; }
                s = swap_sum(s); }
            gt[n] = s; }
#pragma unroll
        for (int k = 0; k < 3; ++k) { float best = NEGBIG; int bi = -1;
#pragma unroll
            for (int n = 0; n < 15; ++n) if (n < qb && !((sel >> n) & 1u) && gt[n] > best) { best = gt[n]; bi = n; }
            if (bi >= 0) sel |= 1u << bi; }
        sel |= 1u << qb;
    }
    const int kfo = L_KB + r32 * 144 + hi * 16, rfo = L_KR + r32 * 80 + hi * 16;
    const int vfo = L_VB + ((lane >> 4) & 1) * 32 + (lane & 3) * 8 + (4 * hi + ((lane & 15) >> 2)) * 64;

    f32x16 o0, o1;
#pragma unroll
    for (int r = 0; r < 16; ++r) { o0[r] = 0.f; o1[r] = 0.f; }
    float m = fast ? 0.f : NEGBIG, lsum = 0.f;

    auto anysel = [&](int j) -> bool { return MODE != 1 || __any((sel >> (j >> 2)) & 1u); };
    auto is_full = [&](int j) -> bool {
        bool f = fast && (64 * j + 63 <= qw) && anysel(j);
        if (MODE == 3) f = f && (64 * j >= qw + 31 - 128);
        return f; };
    auto stage_a = [&](int j, int ks, int kb, f32x16& p) {
        if (MODE == 1 || MODE == 3) { const LAS float* lp = aux + ((MODE == 1 ? 4095 : 255) - (qw + r32 - 64 * j - 4 * hi));
            if (MODE == 1) lp = ((sel >> (j >> 2)) & 1u) ? lp : aux + 4160;
#pragma unroll
            for (int r = 0; r < 16; ++r) p[r] = lp[crow(r) + 32 * kb];
        } else {
#pragma unroll
            for (int r = 0; r < 16; ++r) p[r] = 0.f;
        }
        const LAS char* kb_ = lds + ks * KSLOT + kb * (32 * 144) + kfo;
#pragma unroll
        for (int d0 = 0; d0 < 4; ++d0) p = MFMA32(*(const LAS bf16x8*)(kb_ + d0 * 32), qf[d0], p);
        if (MODE == 2) { const LAS char* rb_ = lds + ks * RSLOT + kb * (32 * 80) + rfo;
#pragma unroll
            for (int d0 = 0; d0 < 2; ++d0) p = MFMA32(*(const LAS bf16x8*)(rb_ + d0 * 32), qf[4 + d0], p); }
        if (MODE == 0) p = MFMA32(*(const LAS bf16x8*)(lds + (hi ? (L_KR + 3072) : (L_KR + ks * 1024 + kb * 512 + r32 * 16))), qx, p);
    };
    auto stage_b = [&](int j, f32x16& p, u32x4& wa, u32x4& wb) {
#pragma unroll
        for (int r = 0; r < 16; ++r) { p[r] = __builtin_amdgcn_exp2f(p[r]); lsum += p[r]; }
        wa.x = cvt2(p[0], p[1]); wa.y = cvt2(p[2], p[3]); wa.z = cvt2(p[4], p[5]); wa.w = cvt2(p[6], p[7]);
        wb.x = cvt2(p[8], p[9]); wb.y = cvt2(p[10], p[11]); wb.z = cvt2(p[12], p[13]); wb.w = cvt2(p[14], p[15]);
        asm volatile("" : "+v"(lsum));
    };
    auto stage_c = [&](int vs, int kb, const u32x4& wa, const u32x4& wb) {
        const LAS char* vb_ = lds + vs * 8192 + vfo + kb * 2048;
        { const s16x4 a0 = vtr(vb_), a1 = vtr(vb_ + 512), c0 = vtr(vb_ + 4096), c1 = vtr(vb_ + 4096 + 512);
          o0 = MFMA32(__builtin_shufflevector(a0, a1, 0, 1, 2, 3, 4, 5, 6, 7), __builtin_bit_cast(bf16x8, wa), o0); o1 = MFMA32(__builtin_shufflevector(c0, c1, 0, 1, 2, 3, 4, 5, 6, 7), __builtin_bit_cast(bf16x8, wa), o1); }
        { const s16x4 a0 = vtr(vb_ + 1024), a1 = vtr(vb_ + 1024 + 512), c0 = vtr(vb_ + 4096 + 1024), c1 = vtr(vb_ + 4096 + 1024 + 512);
          o0 = MFMA32(__builtin_shufflevector(a0, a1, 0, 1, 2, 3, 4, 5, 6, 7), __builtin_bit_cast(bf16x8, wb), o0); o1 = MFMA32(__builtin_shufflevector(c0, c1, 0, 1, 2, 3, 4, 5, 6, 7), __builtin_bit_cast(bf16x8, wb), o1); }
    };
    auto general = [&](int t, int ks, int vs) {
        const int k0 = t * 64; const bool selected = MODE != 1 || ((sel >> (t >> 2)) & 1u); const bool asel = anysel(t);
        int dl = qw + r32 - k0 - 4 * hi; asm volatile("" : "+v"(dl));
#pragma unroll
        for (int kb = 0; kb < 2; ++kb) {
            const int kh = k0 + 32 * kb;
            bool act = kh <= qw + 31 && asel, need_mask = kh + 31 > qw;
            if (MODE == 3) { act = act && (kh + 31 >= qw - 128); need_mask = need_mask || (kh < qw + 31 - 128); }
            if (!act) continue;
            f32x16 p;
            if (MODE == 1 || MODE == 3) { const LAS float* lp = aux + ((MODE == 1 ? 4095 : 255) - dl);
#pragma unroll
                for (int r = 0; r < 16; ++r) p[r] = lp[crow(r) + 32 * kb];
            } else {
#pragma unroll
                for (int r = 0; r < 16; ++r) p[r] = 0.f;
            }
            const LAS char* kb_ = lds + ks * KSLOT + kb * (32 * 144) + kfo;
#pragma unroll
            for (int d0 = 0; d0 < 4; ++d0) p = MFMA32(*(const LAS bf16x8*)(kb_ + d0 * 32), qf[d0], p);
            if (MODE == 2) { const LAS char* rb_ = lds + ks * RSLOT + kb * (32 * 80) + rfo;
#pragma unroll
                for (int d0 = 0; d0 < 2; ++d0) p = MFMA32(*(const LAS bf16x8*)(rb_ + d0 * 32), qf[4 + d0], p); }
            if (MODE == 0) p = MFMA32(*(const LAS bf16x8*)(lds + (hi ? (L_KR + 3072) : (L_KR + ks * 1024 + kb * 512 + r32 * 16))), qx, p);
            if (need_mask) {
#pragma unroll
                for (int r = 0; r < 16; ++r) { const int rel = dl - crow(r) - 32 * kb; const bool v = MODE == 3 ? ((unsigned)rel <= 128u) : (rel >= 0); p[r] = v ? p[r] : -INFINITY; }
            }
            float ps = 0.f;
            if (fast) {
#pragma unroll
                for (int r = 0; r < 16; ++r) { p[r] = __builtin_amdgcn_exp2f(p[r]); ps += p[r]; }
            } else {
                float mx = fmaxf(p[0], p[1]);
#pragma unroll
                for (int r = 2; r < 16; ++r) mx = fmaxf(mx, p[r]);
                mx = swap_max(mx);
                if (MODE == 1) mx = selected ? mx : NEGBIG;
                if (__any(mx > m + THR)) {
                    const float mn = fmaxf(m, mx), alpha = __builtin_amdgcn_exp2f(m - mn); m = mn; lsum *= alpha;
#pragma unroll
                    for (int r = 0; r < 16; ++r) { o0[r] *= alpha; o1[r] *= alpha; }
                }
#pragma unroll
                for (int r = 0; r < 16; ++r) { p[r] = __builtin_amdgcn_exp2f(p[r] - m); ps += p[r]; }
            }
            u32x4 w0, w1;
            w0.x = cvt2(p[0], p[1]); w0.y = cvt2(p[2], p[3]); w0.z = cvt2(p[4], p[5]); w0.w = cvt2(p[6], p[7]);
            w1.x = cvt2(p[8], p[9]); w1.y = cvt2(p[10], p[11]); w1.z = cvt2(p[12], p[13]); w1.w = cvt2(p[14], p[15]);
            if (MODE == 1) { const unsigned mk = selected ? 0xffffffffu : 0u; ps = selected ? ps : 0.f; w0 = w0 & mk; w1 = w1 & mk; }
            lsum += ps;
            const bf16x8 pb0 = __builtin_bit_cast(bf16x8, w0), pb1 = __builtin_bit_cast(bf16x8, w1);
            const LAS char* vb_ = lds + vs * 8192 + vfo + kb * 2048;
            { const s16x4 a0 = vtr(vb_), a1 = vtr(vb_ + 512), c0 = vtr(vb_ + 4096), c1 = vtr(vb_ + 4096 + 512);
              o0 = MFMA32(__builtin_shufflevector(a0, a1, 0, 1, 2, 3, 4, 5, 6, 7), pb0, o0); o1 = MFMA32(__builtin_shufflevector(c0, c1, 0, 1, 2, 3, 4, 5, 6, 7), pb0, o1); }
            { const s16x4 a0 = vtr(vb_ + 1024), a1 = vtr(vb_ + 1024 + 512), c0 = vtr(vb_ + 4096 + 1024), c1 = vtr(vb_ + 4096 + 1024 + 512);
              o0 = MFMA32(__builtin_shufflevector(a0, a1, 0, 1, 2, 3, 4, 5, 6, 7), pb1, o0); o1 = MFMA32(__builtin_shufflevector(c0, c1, 0, 1, 2, 3, 4, 5, 6, 7), pb1, o1); }
        }
    };

    if (MODE == 0) { ATT_LOADK(t_lo, kA, rA); ATT_LOADK(t_lo + 1, kB, rB); }
    ATT_DMAV(t_lo, 0); ATT_DMAV(t_lo + 1, 1);
    ATT_WRITEK(0, t_lo, kA, rA); ATT_WRITEK(1, t_lo + 1, kB, rB);
    __syncthreads();
    ATT_LOADK(t_lo + 2, kA, rA);
    int ks0 = 0, ks1 = 1, ks2 = 2, vs = 0;
    bool pend = is_full(t_lo);
    f32x16 sa0, sa1, sb0, sb1;
    if (pend) { stage_a(t_lo, 0, 0, sa0); stage_a(t_lo, 0, 1, sa1); }
    auto advance = [&](const int t) {
        ATT_WRITEK(ks2, t + 2, kA, rA);
        __syncthreads();
        ATT_DMAV(t + 2, vs); ATT_LOADK(t + 3, kA, rA);
        { const int tmp = ks0; ks0 = ks1; ks1 = ks2; ks2 = tmp; } vs ^= 1;
    };
    auto steady = [&](const int t, f32x16& c0, f32x16& c1, f32x16& n0, f32x16& n1) {
        u32x4 wa, wb, wc, wd;
        stage_a(t + 1, ks1, 0, n0); stage_b(t, c0, wa, wb); __builtin_amdgcn_sched_barrier(0);
        stage_a(t + 1, ks1, 1, n1); stage_c(vs, 0, wa, wb); stage_b(t, c1, wc, wd); __builtin_amdgcn_sched_barrier(0);
        stage_c(vs, 1, wc, wd);
        advance(t);
    };
    int t = t_lo;
    while (t <= t_hi) {
        if (pend) while (t + 2 <= t_hi && is_full(t + 1) && is_full(t + 2)) { steady(t, sa0, sa1, sb0, sb1); steady(t + 1, sb0, sb1, sa0, sa1); t += 2; }
        const bool nxt = (t + 1 <= t_hi) && is_full(t + 1);
        if (pend) { u32x4 wa, wb; stage_b(t, sa0, wa, wb); stage_c(vs, 0, wa, wb); stage_b(t, sa1, wa, wb); stage_c(vs, 1, wa, wb); } else general(t, ks0, vs);
        if (nxt) { stage_a(t + 1, ks1, 0, sa0); stage_a(t + 1, ks1, 1, sa1); }
        pend = nxt;
        advance(t);
        ++t;
    }
#undef ATT_LOADK
#undef ATT_DMAV
#undef ATT_WRITEK
    const int te_ = ltid(), r32e = te_ & 31, hie = (te_ >> 5) & 1, qwe = q0 + 32 * (te_ >> 6);
    const float ltot = swap_sum(lsum), inv = 1.0f / ltot;
    if (MODE != 3) {
        const size_t tok = (size_t)b * SEQ + qwe + r32e; const int colbase = (MODE == 0 ? 0 : (MODE == 1 ? 256 : 768)) + h * 64;
        const bf16_t* G = (const bf16_t*)((const char*)P.out + OOFF_G) + tok * DM + colbase; bf16_t* A2 = (bf16_t*)(P.ws + OFF_A2) + tok * DM + colbase;
        u32x4 gq[2][2];
#pragma unroll
        for (int gp = 0; gp < 2; ++gp) { const int co = hie ? 16 * gp + 8 : 16 * gp; gq[gp][0] = *(const u32x4*)(G + co); gq[gp][1] = *(const u32x4*)(G + 32 + co); }
#pragma unroll
        for (int gp = 0; gp < 2; ++gp) { const int g = 2 * gp, co = hie ? 16 * gp + 8 : 16 * gp;
#pragma unroll
            for (int db = 0; db < 2; ++db) { const f32x16& o = db == 0 ? o0 : o1;
                unsigned qx = gq[gp][db].x, qy = gq[gp][db].y, qz = gq[gp][db].z, qw_ = gq[gp][db].w; half_xchg(qx, qz); half_xchg(qy, qw_);
                unsigned ax = cvt2(o[4 * g] * inv * bflo(qx), o[4 * g + 1] * inv * bfhi(qx)), ay = cvt2(o[4 * g + 2] * inv * bflo(qy), o[4 * g + 3] * inv * bfhi(qy));
                unsigned bx = cvt2(o[4 * g + 4] * inv * bflo(qz), o[4 * g + 5] * inv * bfhi(qz)), by = cvt2(o[4 * g + 6] * inv * bflo(qw_), o[4 * g + 7] * inv * bfhi(qw_));
                half_xchg(ax, bx); half_xchg(ay, by);
                *(u32x4*)(A2 + 32 * db + co) = (u32x4){ax, ay, bx, by}; } }
    } else {
        const size_t tok = (size_t)b * SEQ + (size_t)(qwe + r32e) * dil + res;
        bf16_t* dp = (bf16_t*)(P.ws + OFF_DPART) + ((size_t)pat * NT + tok) * 256 + h * 64 + 4 * hie;
#pragma unroll
        for (int g = 0; g < 4; ++g) { u32x2 w0, w1;
            w0.x = cvt2(o0[4 * g] * inv, o0[4 * g + 1] * inv); w0.y = cvt2(o0[4 * g + 2] * inv, o0[4 * g + 3] * inv);
            w1.x = cvt2(o1[4 * g] * inv, o1[4 * g + 1] * inv); w1.y = cvt2(o1[4 * g + 2] * inv, o1[4 * g + 3] * inv);
            *(u32x2*)(dp + 8 * g) = w0; *(u32x2*)(dp + 32 + 8 * g) = w1; }
        if (hie == 0) ((float*)(P.ws + OFF_DLSE))[((size_t)pat * NT + tok) * 4 + h] = m + __builtin_amdgcn_logf(ltot);
    }
}

DEVINL void dil_unit(const Params& P, int l, int u, int nh, char* smem) {
    LAS char* lds = (LAS char*)smem;
    const int tid = ltid(), lane = tid & 63, r32 = lane & 31, hi = lane >> 5; const int wid = __builtin_amdgcn_readfirstlane(tid >> 6);
    const int pat = u >> 8, v = u & 255, bh0 = v & 15, w = v >> 4, dil = pat == 0 ? 1 : (pat == 1 ? 4 : 16), res = w % dil, q0 = (w / dil) * 256;
    const int t_lo = (q0 >= 128 ? q0 - 128 : 0) >> 6, t_hi = (q0 + 255) >> 6, nt = t_hi - t_lo + 1;
    const int rs = 64 * dil;
    const int qw = q0 + 32 * wid;
    constexpr int D_KB = 0, D_VB = 6 * KSLOT, D_AUX = D_VB + 6 * 8192;
    LAS float* aux = (LAS float*)(lds + D_AUX);
    const unsigned kgo = (unsigned)((tid >> 3) * rs + (tid & 7) * 8), vgo = (unsigned)(((tid >> 2) & 63) * rs + (tid >> 8) * 32 + (tid & 3) * 8);
    const int kws = (tid >> 3) * 144 + (tid & 7) * 16;
    const int kfo = D_KB + r32 * 144 + hi * 16;
    const int vfo = D_VB + ((lane >> 4) & 1) * 32 + (lane & 3) * 8 + (4 * hi + ((lane & 15) >> 2)) * 64;
    u32x4 kr[6], vr[6]; bf16x8 qf[4]; float lutv = 0.f;
    auto request = [&](int bh) {
        const bf16_t* Qg = (const bf16_t*)(P.ws + OFF_QKV + 6 * SZ_HEADBUF) + ((size_t)bh * SEQ + res) * 64; const bf16_t* Kg = Qg + SZ_HEADBUF / 2; const bf16_t* Vg = Kg + SZ_HEADBUF / 2;
#pragma unroll
        for (int j = 0; j < 6; ++j) if (j < nt) { kr[j] = *(const u32x4*)(Kg + (size_t)(t_lo + j) * 64 * rs + kgo); vr[j] = *(const u32x4*)(Vg + (size_t)(t_lo + j) * 64 * rs + vgo); }
        const bf16_t* qp = Qg + (size_t)(qw + r32) * rs + 8 * hi;
#pragma unroll
        for (int d0 = 0; d0 < 4; ++d0) qf[d0] = *(const bf16x8*)(qp + 16 * d0);
        const float* lut = (const float*)(P.ws + OFF_LUT) + (size_t)(4 + (bh & 3)) * 4096;
        if (tid < 320) { const int rel = 255 - tid; lutv = (rel >= 0 && rel <= 128) ? lut[rel * dil] : -INFINITY; }
    };
    auto stage = [&]() {
        if (tid < 320) aux[tid] = lutv;
#pragma unroll
        for (int j = 0; j < 6; ++j) if (j < nt) { *(LAS u32x4*)(lds + D_KB + j * KSLOT + kws) = kr[j]; *(LAS u32x4*)(lds + D_VB + j * 8192 + tid * 16) = vr[j]; }
    };
    auto compute = [&](int bh, const bf16x8 (&q)[4]) {
        const int b = bh >> 2, h = bh & 3;
        f32x16 o0, o1;
#pragma unroll
        for (int r = 0; r < 16; ++r) { o0[r] = 0.f; o1[r] = 0.f; }
        float lsum = 0.f;
        const int hb_hi = qw >> 5;
        f32x16 p[5];
#pragma unroll
        for (int i = 0; i < 5; ++i) {
            const int hb = hb_hi - 4 + i; const bool valid = hb >= 0; const int hbc = valid ? hb : 0, jl = (hbc >> 1) - t_lo, kb = hbc & 1;
            const int dl = qw + r32 - 32 * hbc - 4 * hi;
            const LAS float* lp = valid ? aux + (255 - dl) : aux;
#pragma unroll
            for (int r = 0; r < 16; ++r) p[i][r] = lp[crow(r)];
            const LAS char* kb_ = lds + jl * KSLOT + kb * (32 * 144) + kfo;
#pragma unroll
            for (int d0 = 0; d0 < 4; ++d0) p[i] = MFMA32(*(const LAS bf16x8*)(kb_ + d0 * 32), q[d0], p[i]);
        }
#pragma unroll
        for (int i = 0; i < 5; ++i) {
            const int hb = hb_hi - 4 + i; const int hbc = hb >= 0 ? hb : 0, jl = (hbc >> 1) - t_lo, kb = hbc & 1;
#pragma unroll
            for (int r = 0; r < 16; ++r) { p[i][r] = __builtin_amdgcn_exp2f(p[i][r]); lsum += p[i][r]; }
            asm volatile("" : "+v"(lsum));
            u32x4 w0, w1;
            w0.x = cvt2(p[i][0], p[i][1]); w0.y = cvt2(p[i][2], p[i][3]); w0.z = cvt2(p[i][4], p[i][5]); w0.w = cvt2(p[i][6], p[i][7]);
            w1.x = cvt2(p[i][8], p[i][9]); w1.y = cvt2(p[i][10], p[i][11]); w1.z = cvt2(p[i][12], p[i][13]); w1.w = cvt2(p[i][14], p[i][15]);
            const LAS char* vb_ = lds + jl * 8192 + vfo + kb * 2048;
            { const s16x4 a0 = vtr(vb_), a1 = vtr(vb_ + 512), c0 = vtr(vb_ + 4096), c1 = vtr(vb_ + 4096 + 512);
              o0 = MFMA32(__builtin_shufflevector(a0, a1, 0, 1, 2, 3, 4, 5, 6, 7), __builtin_bit_cast(bf16x8, w0), o0); o1 = MFMA32(__builtin_shufflevector(c0, c1, 0, 1, 2, 3, 4, 5, 6, 7), __builtin_bit_cast(bf16x8, w0), o1); }
            { const s16x4 a0 = vtr(vb_ + 1024), a1 = vtr(vb_ + 1024 + 512), c0 = vtr(vb_ + 4096 + 1024), c1 = vtr(vb_ + 4096 + 1024 + 512);
              o0 = MFMA32(__builtin_shufflevector(a0, a1, 0, 1, 2, 3, 4, 5, 6, 7), __builtin_bit_cast(bf16x8, w1), o0); o1 = MFMA32(__builtin_shufflevector(c0, c1, 0, 1, 2, 3, 4, 5, 6, 7), __builtin_bit_cast(bf16x8, w1), o1); }
        }
        const float ltot = swap_sum(lsum), inv = 1.0f / ltot;
        const size_t tok = (size_t)b * SEQ + (size_t)(qw + r32) * dil + res;
        bf16_t* dp = (bf16_t*)(P.ws + OFF_DPART) + ((size_t)pat * NT + tok) * 256 + h * 64;
#pragma unroll
        for (int gp = 0; gp < 2; ++gp) { const int g = 2 * gp, co = hi ? 16 * gp + 8 : 16 * gp;
#pragma unroll
            for (int db = 0; db < 2; ++db) { const f32x16& o = db == 0 ? o0 : o1;
                unsigned ax = cvt2(o[4 * g] * inv, o[4 * g + 1] * inv), ay = cvt2(o[4 * g + 2] * inv, o[4 * g + 3] * inv), bx = cvt2(o[4 * g + 4] * inv, o[4 * g + 5] * inv), by = cvt2(o[4 * g + 6] * inv, o[4 * g + 7] * inv);
                half_xchg(ax, bx); half_xchg(ay, by);
                *(u32x4*)(dp + 32 * db + co) = (u32x4){ax, ay, bx, by}; } }
        if (hi == 0) ((float*)(P.ws + OFF_DLSE))[((size_t)pat * NT + tok) * 4 + h] = __builtin_amdgcn_logf(ltot);
    };
    __syncthreads();
    request(bh0);
    bf16x8 qa[4];
#pragma unroll
    for (int d0 = 0; d0 < 4; ++d0) qa[d0] = qf[d0];
    stage();
    __syncthreads();
    if (nh == 2) request(bh0 + 1);
    compute(bh0, qa);
    if (nh == 2) {
        __syncthreads();
        stage();
        __syncthreads();
        compute(bh0 + 1, qf);
    }
}

DEVINL void dilmix_unit(const Params& P, int u) {
    const int e = u * NTHREADS + ltid(), tok = e >> 5, hd = e & 31, h = hd >> 3, d8 = (hd & 7) * 8;
    const float* ls = (const float*)(P.ws + OFF_DLSE); const bf16_t* dp = (const bf16_t*)(P.ws + OFF_DPART);
    const float l0 = ls[(size_t)tok * 4 + h], l1 = ls[((size_t)NT + tok) * 4 + h], l2 = ls[((size_t)2 * NT + tok) * 4 + h];
    const float mx = fmaxf(l0, fmaxf(l1, l2)); float w0 = __builtin_amdgcn_exp2f(l0 - mx), w1 = __builtin_amdgcn_exp2f(l1 - mx), w2 = __builtin_amdgcn_exp2f(l2 - mx);
    const float inv = 1.0f / (w0 + w1 + w2); w0 *= inv; w1 *= inv; w2 *= inv;
    const size_t off = (size_t)tok * 256 + h * 64 + d8;
    const u32x4 a = *(const u32x4*)(dp + off), b = *(const u32x4*)(dp + (size_t)NT * 256 + off), c = *(const u32x4*)(dp + (size_t)2 * NT * 256 + off);
    const u32x4 g = *(const u32x4*)((const bf16_t*)((const char*)P.out + OOFF_G) + (size_t)tok * DM + 512 + h * 64 + d8);
    u32x4 r;
    r.x = cvt2((w0 * bflo(a.x) + w1 * bflo(b.x) + w2 * bflo(c.x)) * bflo(g.x), (w0 * bfhi(a.x) + w1 * bfhi(b.x) + w2 * bfhi(c.x)) * bfhi(g.x));
    r.y = cvt2((w0 * bflo(a.y) + w1 * bflo(b.y) + w2 * bflo(c.y)) * bflo(g.y), (w0 * bfhi(a.y) + w1 * bfhi(b.y) + w2 * bfhi(c.y)) * bfhi(g.y));
    r.z = cvt2((w0 * bflo(a.z) + w1 * bflo(b.z) + w2 * bflo(c.z)) * bflo(g.z), (w0 * bfhi(a.z) + w1 * bfhi(b.z) + w2 * bfhi(c.z)) * bfhi(g.z));
    r.w = cvt2((w0 * bflo(a.w) + w1 * bflo(b.w) + w2 * bflo(c.w)) * bflo(g.w), (w0 * bfhi(a.w) + w1 * bfhi(b.w) + w2 * bfhi(c.w)) * bfhi(g.w));
    *(u32x4*)((bf16_t*)(P.ws + OFF_A2) + (size_t)tok * DM + 512 + h * 64 + d8) = r;
}


#define XB_TMO      128
#define XB_XCNT(j)  (256  + 64 * (j))
#define XB_XSUB(j)  (1280 + 64 * (j))
#define XB_XGEN(j)  (2304 + 64 * (j))
#define XB_TOP      3328
#define XB_TOPGEN   3392
#define XCD_BAR_WORDS 3456
#define XB_SPIN_CAP (1u << 20)
DEVINL unsigned xb_ld(unsigned* p) { return __hip_atomic_load(p, __ATOMIC_RELAXED, __HIP_MEMORY_SCOPE_AGENT); }
DEVINL unsigned xb_add(unsigned* p, unsigned v) { return __hip_atomic_fetch_add(p, v, __ATOMIC_RELAXED, __HIP_MEMORY_SCOPE_AGENT); }
DEVINL unsigned xb_xcc_id() { return (unsigned)__builtin_amdgcn_s_getreg((3 << 11) | 20) & 0xFu; }
#define XB_SPIN(cond, bar) do { unsigned _sp = 0; while (cond) { __builtin_amdgcn_s_sleep(1); \
    if ((++_sp & 255u) == 0u) { if (xb_ld(&(bar)[XB_TMO])) break; if (_sp > XB_SPIN_CAP) { atomicAdd(&(bar)[XB_TMO], 1u); break; } } } } while (0)
#define XB_CENS(k)  (8 + (k))
#define XB_LOC(k)   (2304 + 64 * (k))
DEVINL void xcd_barrier_post(unsigned* bar) { if (ltid() == 0) (void)xb_add(&bar[XB_XCNT(xb_xcc_id())], 1u); }
DEVINL void xcd_barrier_complete(unsigned* bar, unsigned x, unsigned& nloc, unsigned& nx) {
    const unsigned G = gridDim.x * gridDim.y * gridDim.z;
    unsigned sum, cnt, mine, sp = 0u;
    for (;;) {
        sum = 0u; cnt = 0u; mine = 0u;
        for (unsigned j = 0; j < 16; ++j) { const unsigned c = xb_ld(&bar[XB_XCNT(j)]); sum += c; cnt += (c > 0u) ? 1u : 0u; mine = (j == x) ? c : mine; }
        if (sum == G) break;
        __builtin_amdgcn_s_sleep(1);
        if ((++sp & 255u) == 0u) { if (xb_ld(&bar[XB_TMO])) break; if (sp > XB_SPIN_CAP) { atomicAdd(&bar[XB_TMO], 1u); break; } }
    }
    nloc = mine > 0u ? mine : 1u; nx = cnt > 0u ? cnt : 1u;
}
DEVINL void xcd_barrier(unsigned* bar_in, volatile LAS unsigned* st) {
    asm volatile("s_waitcnt vmcnt(0)" ::: "memory");
    __syncthreads();
    if (ltid() == 0) {
        unsigned* bar = bar_in;
        const unsigned x = xb_xcc_id();
        __builtin_amdgcn_s_waitcnt(0);
        unsigned nloc = st[0], nx = st[1];
        if (nloc == 0u) { xcd_barrier_complete(bar, x, nloc, nx); st[0] = nloc; st[1] = nx; }
        const unsigned old = xb_add(&bar[XB_XSUB(x)], 1u);
        const unsigned gen = old / nloc;
        if (old + 1u == (gen + 1u) * nloc) {
            __builtin_amdgcn_fence(__ATOMIC_RELEASE, "agent");
            asm volatile("s_waitcnt vmcnt(0)" ::: "memory");
            const unsigned og = xb_add(&bar[XB_TOP], 1u);
            const unsigned tg = og / nx;
            if (og + 1u == (tg + 1u) * nx) xb_add(&bar[XB_TOPGEN], 1u);
            else XB_SPIN(xb_ld(&bar[XB_TOPGEN]) == tg, bar);
            __builtin_amdgcn_fence(__ATOMIC_ACQUIRE, "agent");
            asm volatile("s_waitcnt vmcnt(0)" ::: "memory");
        } else {
            XB_SPIN(xb_ld(&bar[XB_TOPGEN]) == gen, bar);
            __builtin_amdgcn_fence(__ATOMIC_ACQUIRE, "agent");
            asm volatile("s_waitcnt vmcnt(0)" ::: "memory");
        }
    }
    __syncthreads();
}

DEVINL void xcd_group_census(unsigned* bar, volatile LAS unsigned* st) {
    const unsigned Gc = (unsigned)__builtin_amdgcn_readfirstlane((int)gridDim.x);
    if (ltid() == 0) { bool ok = (Gc & 7u) == 0u && Gc >= 8u;
        for (unsigned k = 0; k < 8; ++k) { const unsigned m = xb_ld(&bar[XB_CENS(k)]); ok = ok && m != 0u && (m & (m - 1u)) == 0u; }
        st[2] = ok ? 1u : 2u; }
    __syncthreads();
}
DEVINL void xcd_barrier_group(unsigned* bar_in, volatile LAS unsigned* st) {
    if ((unsigned)__builtin_amdgcn_readfirstlane((int)st[2]) != 1u) { xcd_barrier(bar_in, st); return; }
    asm volatile("s_waitcnt vmcnt(0)" ::: "memory");
    __syncthreads();
    const unsigned k = (unsigned)__builtin_amdgcn_readfirstlane((int)(blockIdx.x & 7u)), cnt = (unsigned)__builtin_amdgcn_readfirstlane((int)(gridDim.x >> 3));
    if (ltid() == 0) {
        unsigned* bar = bar_in;
        const unsigned old = xb_add(&bar[XB_LOC(k)], 1u), gen = old / cnt;
        XB_SPIN(xb_ld(&bar[XB_LOC(k)]) < (gen + 1u) * cnt, bar);
        __builtin_amdgcn_fence(__ATOMIC_ACQUIRE, "agent");
        asm volatile("s_waitcnt vmcnt(0)" ::: "memory");
    }
    __syncthreads();
}


DEVINL int next_unit(unsigned* ctr, char* smem) {
    int* su = (int*)(smem + L_MISC);
    __syncthreads();
    if (ltid() == 0) *su = (int)atomicAdd(ctr, 1u);
    __syncthreads();
    return *su;
}

template <class Epi> DEVINL void gemm8_sub(const bf16_t* A, const bf16_t* Bt, int M, int N, int K, const Epi& E, char* smem, int G, int c) {
    asm volatile("" : "+s"(G), "+s"(c));
    pg8::Gemm g{A, Bt, M, N, K}; pg8::StaticOrder S; S.init(M, N, G, c);
    pg8::gemm_phase<Epi, pg8::StaticOrder, true, true>((PG8_LAS unsigned char*)smem, g, S, E);
}
DEVINL void phase_pre(const Params& P, int l, char* smem) {
    const int half = (int)gridDim.x >> 1, bid = (int)blockIdx.x;
    if (bid < half) gemm8_sub((const bf16_t*)(P.ws + OFF_CQ), (const bf16_t*)(P.ws + OFF_WT_UQ + l * SZ_WT_UQ), NT, 512, 256, EpiUq8{P, l}, smem, half, bid);
    else gemm8_sub((const bf16_t*)(P.ws + OFF_CKV), (const bf16_t*)(P.ws + OFF_WT_UKV + l * SZ_WT_UKV), NT, 512, 256, EpiUkv8{P, l}, smem, (int)gridDim.x - half, bid - half);
    if ((int)gridDim.x == 256) { const int c = (int)blockIdx.x, k = c & 7, j = c >> 3, pm = 8 * k + (j >> 2), hh = j & 3;
        kmean_unit(P, (((pm >> 4) * 4 + hh) << 4) | (pm & 15), smem); }
    else for (int u = blockIdx.x; u < 256; u += gridDim.x) kmean_unit(P, u, smem);
}
DEVINL void phase_att(const Params& P, int l, char* smem, int rep) {
    unsigned* ctr = (unsigned*)(P.ws + OFF_CTR) + l * 2 + rep * 8;
    constexpr int N_ATT = 384 + 256 + 96 + 32 + 256 + 256;
    const int n_all = N_ATT + (l == 0 ? PREP_T_IN + PREP_T_UQ + PREP_T_UKV : 0);
    for (;;) {
#ifdef PROBE_CLS
        const unsigned long long tq0 = __builtin_amdgcn_s_memrealtime(); int cls = 4;
#define PCLS(c) cls = (c);
#else
#define PCLS(c)
#endif
        int u = next_unit(ctr, smem); if (u >= n_all) break;
        if (u >= N_ATT) { __syncthreads(); prep_w_unit(P, 1, u - N_ATT, (float*)smem); }
        else if (u >= 384 && u < 640) { PCLS(0) attn_unit<0>(P, l, u - 384, smem); }
        else if (u >= 768) { PCLS(3) const int nh = u < 1024 ? 2 : 1, du = u < 1024 ? 2 * (u - 768) : 512 + (u - 1024);
            if (((const float*)(P.ws + OFF_BOUND))[l * 4 + 3] < 100.0f) dil_unit(P, l, du, nh, smem); else { attn_unit<3>(P, l, du, smem); if (nh == 2) attn_unit<3>(P, l, du + 1, smem); } }
        else {
            if (u >= 640) u -= 256;
            const int g = u >> 5, r = u & 31, uu = g * 16 + (r & 15);
            if (r < 16) { PCLS(2) attn_unit<2>(P, l, uu, smem); } else { PCLS(1) attn_unit<1>(P, l, uu, smem); } }
#ifdef PROBE_CLS
        if (blockIdx.x == PROBE_BLK && cls == PROBE_CLS && ltid() == 0) { LAS unsigned* pa = (LAS unsigned*)((LAS char*)smem + L_MISC + 32); pa[0] += (unsigned)(__builtin_amdgcn_s_memrealtime() - tq0); pa[1] += 1u; }
#endif
#undef PCLS
    }
}

template <int PH> DEVINL void run_phase(int l, char* smem, int rep = 0) {
    asm volatile("" : "+s"(l));
    const __attribute__((address_space(4))) Params* kp = (const __attribute__((address_space(4))) Params*)__builtin_amdgcn_kernarg_segment_ptr(); asm volatile("" : "+s"(kp));
    Params P;
    P.x = (const float*)as_global(kp->x); P.p = (const float*)as_global(kp->p); P.ln_g = (const float*)as_global(kp->ln_g); P.w_in = (const float*)as_global(kp->w_in); P.b_forget = (const float*)as_global(kp->b_forget);
    P.qk_gain = (const float*)as_global(kp->qk_gain); P.mla_q_norm = (const float*)as_global(kp->mla_q_norm); P.mla_kv_norm = (const float*)as_global(kp->mla_kv_norm); P.mla_nope_gain = (const float*)as_global(kp->mla_nope_gain);
    P.mla_rope_gain = (const float*)as_global(kp->mla_rope_gain); P.w_uq = (const float*)as_global(kp->w_uq); P.w_ukv = (const float*)as_global(kp->w_ukv); P.w_out = (const float*)as_global(kp->w_out); P.rel_bias = (const float*)as_global(kp->rel_bias);
    P.ple_norm_g = (const float*)as_global(kp->ple_norm_g); P.w_ple_gate = (const float*)as_global(kp->w_ple_gate); P.w_ple_proj = (const float*)as_global(kp->w_ple_proj); P.out = (float*)as_global(kp->out); P.ws = as_global(kp->ws);
    char* ws = P.ws;
    const bf16_t* xbase = (const bf16_t*)(ws + OFF_H);
    float* xout = l == 0 ? (float*)nullptr : P.out;
    if (PH == 0) phase_prep(P, smem);
    if (PH == 2) { gemm8((const bf16_t*)(ws + OFF_H), (const bf16_t*)(ws + OFF_WT_IN + l * SZ_WT_IN), NT, NP1, 1024, EpiIn8{P, l}, smem);
                   const int G_ = (int)gridDim.x, w0_ = G_ > 192 ? 192 : 0;
                   if ((int)blockIdx.x >= w0_) { __syncthreads(); constexpr int W0 = PREP_T_IN + PREP_T_UQ + PREP_T_UKV, NWL = PREP_PER_LAYER - W0;
                       for (int u = (int)blockIdx.x - w0_; u < NWL + PREP_P_UNITS / 2; u += G_ - w0_) { if (u < NWL) prep_w_unit(P, l, W0 + u, (float*)smem); else prep_p_unit(P, l * (PREP_P_UNITS / 2) + u - NWL); } } }
    if (PH == 3) phase_pre(P, l, smem);
    if (PH == 4) phase_att(P, l, smem, rep);
    if (PH == 5) { if ((int)gridDim.x == 256) { const int c = (int)blockIdx.x, u0 = 128 * (c & 7) + 4 * (c >> 3);
                       for (int i = 0; i < 4; ++i) dilmix_unit(P, u0 + i); }
                   else for (int u = blockIdx.x; u < 1024; u += gridDim.x) dilmix_unit(P, u); }
    if (PH == 8) gemm8((const bf16_t*)(ws + OFF_A2), (const bf16_t*)(ws + OFF_WT_OUT + l * SZ_WT_SQ), NT, 1024, 1024, EpiResid8{P.x, xbase, (bf16_t*)(ws + OFF_XABF), (float*)(ws + OFF_SSQA)}, smem);
    if (PH == 7) { gemm8((const bf16_t*)(ws + (l == 0 ? OFF_PB : OFF_PB2)), (const bf16_t*)(ws + OFF_WT_PP + l * SZ_WT_PP), NT, 1024, 256, EpiStoreBf{(bf16_t*)(ws + OFF_QKV)}, smem);
                   __syncthreads();
                   gemm8((const bf16_t*)(ws + OFF_XABF), (const bf16_t*)(ws + OFF_WT_PG + l * SZ_WT_SQ), NT, 1024, 1024, EpiPle8{(const bf16_t*)(ws + OFF_XABF), (const bf16_t*)(ws + OFF_QKV), xout, (const float*)(ws + OFF_SSQA), l == 0 ? (bf16_t*)(ws + OFF_H) : (bf16_t*)nullptr, (float*)(ws + OFF_SSQX)}, smem); }
}

__global__ void __launch_bounds__(NTHREADS) k_mega(Params Parg) {
    char* smem = g_smem;
    { const int t0 = (int)threadIdx.x; if (t0 < 12) ((LAS unsigned*)((LAS char*)smem + L_XB))[t0] = 0u;
      if ((t0 & 63) == 0) *(LAS int*)((LAS char*)smem + L_WTAB + 4u * (unsigned)__builtin_amdgcn_s_getreg(0x2804)) = t0 >> 6; }
    __syncthreads();
    const __attribute__((address_space(4))) Params* kp0 = (const __attribute__((address_space(4))) Params*)__builtin_amdgcn_kernarg_segment_ptr();
    xcd_barrier_post((unsigned*)(as_global(kp0->ws) + OFF_BAR));
#define XBAR() xcd_barrier((unsigned*)(as_global(kp0->ws) + OFF_BAR), (volatile LAS unsigned*)((LAS char*)smem + L_XB))
#ifdef PROBE_IDX
    unsigned long long tA = 0, tB = 0;
#define PT0(i) if (PROBE_IDX == (i)) tA = __builtin_amdgcn_s_memrealtime();
#define PT1(i) if (PROBE_IDX == (i)) tB = __builtin_amdgcn_s_memrealtime();
#else
#define PT0(i)
#define PT1(i)
#endif
#define XBAR_G() xcd_barrier_group((unsigned*)(as_global(kp0->ws) + OFF_BAR), (volatile LAS unsigned*)((LAS char*)smem + L_XB))
    PT0(0) run_phase<0>(0, smem); XBAR(); PT1(0)
    xcd_group_census((unsigned*)(as_global(kp0->ws) + OFF_BAR), (volatile LAS unsigned*)((LAS char*)smem + L_XB));
    PT0(2) run_phase<2>(0, smem); XBAR_G(); PT1(2) PT0(3) run_phase<3>(0, smem); XBAR(); PT1(3) PT0(4) run_phase<4>(0, smem); XBAR(); PT1(4)
    PT0(5) run_phase<5>(0, smem); XBAR_G(); PT1(5) PT0(6) run_phase<8>(0, smem); XBAR_G(); PT1(6) PT0(8) run_phase<7>(0, smem); XBAR(); PT1(8)
    run_phase<2>(1, smem); XBAR_G(); run_phase<3>(1, smem); XBAR(); run_phase<4>(1, smem); XBAR(); run_phase<5>(1, smem); XBAR(); run_phase<8>(1, smem); XBAR_G(); run_phase<7>(1, smem);
#undef XBAR_G
#ifdef PROBE_IDX
    if (blockIdx.x == 0) { const unsigned long long t0 = __builtin_amdgcn_s_memrealtime(), want = (tB - tA) * 32ull; while (__builtin_amdgcn_s_memrealtime() - t0 < want) __builtin_amdgcn_s_sleep(32); }
#endif
#undef XBAR
#ifdef PROBE_CLS
    if (blockIdx.x == PROBE_BLK) { __syncthreads(); const LAS unsigned* pa = (const LAS unsigned*)((LAS char*)smem + L_MISC + 32); const unsigned long long tk = pa[0], nt = pa[1] ? pa[1] : 1u;
        const unsigned long long t0 = __builtin_amdgcn_s_memrealtime(), want = tk * 128ull / nt; while (__builtin_amdgcn_s_memrealtime() - t0 < want) __builtin_amdgcn_s_sleep(32); }
#endif
}
}

extern "C" void kernel_launch(void* const* d_in, const int* in_sizes, int n_in, void* d_out, int out_size, void* d_ws, size_t ws_size, hipStream_t stream) {
    Params P{};
    P.x = (const float*)d_in[0]; P.p = (const float*)d_in[1]; P.ln_g = (const float*)d_in[2]; P.w_in = (const float*)d_in[3]; P.b_forget = (const float*)d_in[4]; P.qk_gain = (const float*)d_in[5];
    P.mla_q_norm = (const float*)d_in[6]; P.mla_kv_norm = (const float*)d_in[7]; P.mla_nope_gain = (const float*)d_in[8]; P.mla_rope_gain = (const float*)d_in[9]; P.w_uq = (const float*)d_in[10];
    P.w_ukv = (const float*)d_in[11]; P.w_out = (const float*)d_in[12]; P.rel_bias = (const float*)d_in[13]; P.ple_norm_g = (const float*)d_in[14]; P.w_ple_gate = (const float*)d_in[15]; P.w_ple_proj = (const float*)d_in[16];
    P.out = (float*)d_out; P.ws = (char*)d_ws;
    if (ws_size < WS_NEED) { fprintf(stderr, "workspace too small: %zu < %zu\n", ws_size, (size_t)WS_NEED); return; }
    static int grid_blocks = 0;
    if (!grid_blocks) {
        int dev = 0, cus = 0, per_cu = 0;
        hipGetDevice(&dev);
        hipDeviceGetAttribute(&cus, hipDeviceAttributeMultiprocessorCount, dev);
        hipOccupancyMaxActiveBlocksPerMultiprocessor(&per_cu, k_mega, NTHREADS, 0);
        if (per_cu > 1) per_cu = 1;
        grid_blocks = cus * per_cu;
    }
    hipMemsetAsync((char*)d_ws + OFF_CTR, 0, 512 + 3456 * 4, stream);
    void* args[] = {&P};
    hipError_t e = hipLaunchCooperativeKernel((void*)k_mega, dim3(grid_blocks), dim3(NTHREADS), args, 0, stream);
    if (e != hipSuccess) fprintf(stderr, "cooperative launch failed: %s (grid %d)\n", hipGetErrorString(e), grid_blocks);
}
```
